# Optimizing an MI355X kernel written in HIP

```python
import jax
import jax.numpy as jnp
from jax import lax
import numpy as np

D_MODEL = 1024
BATCH = 8
SEQ = 4096
DEPTH = 4

CTX_LEN = 256
GRID_W = 64
EPS = 1e-6
N_BRANCH = 3
BRANCH_W = 1024
CHUNK = 64

GDN_HEADS = 8
GDN_DK = 128
GDN_DV = 128
GDN_QK = GDN_HEADS * GDN_DK
GDN_W = GDN_HEADS * GDN_DV
CONV_K = 5

S5_W = BRANCH_W
S5_H = 16
S5_G = S5_W // S5_H
S5_P = 64
STEP_MIN = 1e-3
STEP_MAX = 1e-1

ML_HEADS = 4
ML_DH = 256
ML_W = ML_HEADS * ML_DH

IN_SIZES = (GDN_QK, GDN_QK, GDN_W, GDN_W, 2 * GDN_HEADS, 2 * GDN_HEADS,
            S5_W, S5_W,
            ML_W, ML_W, ML_W, ML_W, ML_W, 2 * ML_HEADS, 2 * ML_HEADS,
            N_BRANCH * D_MODEL)
N_IN = sum(IN_SIZES)

kernel_name = "hybrid_gdn_s5_mlstm_prefix_dit"


def rms_norm(x, g):
    xf = x.astype(jnp.float32)
    y = xf * lax.rsqrt(jnp.mean(xf * xf, axis=-1, keepdims=True) + EPS)
    return (y * g).astype(x.dtype)


def l2_normalize(t):
    tf = t.astype(jnp.float32)
    return tf * lax.rsqrt(jnp.sum(tf * tf, axis=-1, keepdims=True) + EPS)


def split_cols(p):
    return jnp.split(p, [int(s) for s in np.cumsum(IN_SIZES)[:-1]], axis=-1)


def to_scan_order(t, column_major):
    if not column_major:
        return t
    b, l, d = t.shape
    rows = l // GRID_W
    return t.reshape(b, rows, GRID_W, d).swapaxes(1, 2).reshape(b, l, d)


def from_scan_order(t, column_major):
    if not column_major:
        return t
    b, l, d = t.shape
    rows = l // GRID_W
    return t.reshape(b, GRID_W, rows, d).swapaxes(1, 2).reshape(b, l, d)


def short_conv(x, w):
    pad = CONV_K // 2
    l = x.shape[1]
    xp = jnp.pad(x, ((0, 0), (pad, pad), (0, 0)))
    return sum(w[j] * xp[:, j:j + l] for j in range(CONV_K))


def to_chunks(t):
    b, l, h = t.shape[:3]
    t = t.reshape((b, l // CHUNK, CHUNK, h) + t.shape[3:])
    return jnp.moveaxis(t, (1, 3), (0, 2))


def from_chunks(t):
    n, b, h, c = t.shape[:4]
    return jnp.moveaxis(t, (0, 2), (1, 3)).reshape((b, n * c, h) + t.shape[4:])


def prefix_bidir(run, ctx_in, lat_in, s0):
    flip = lambda arrs: tuple(jnp.flip(a, 1) for a in arrs)
    y_cf, s_f = run(ctx_in, 0, s0)
    y_cb, s_b = run(flip(ctx_in), 1, s0)
    y_lf, _ = run(lat_in, 0, s_f)
    y_lb, _ = run(flip(lat_in), 1, s_b)
    return y_cf + jnp.flip(y_cb, 1), y_lf + jnp.flip(y_lb, 1)


def gdn_chunked(q, k, v, g, beta, s0):
    q, k, v, g, beta = (to_chunks(t.astype(jnp.float32)) for t in (q, k, v, g, beta))
    tril = jnp.tril(jnp.ones((CHUNK, CHUNK), dtype=bool))
    strict = jnp.tril(jnp.ones((CHUNK, CHUNK), dtype=bool), -1)
    gc = jnp.cumsum(g, axis=-1)
    seg = jnp.where(tril, gc[..., :, None] - gc[..., None, :], 0.0)
    decay_mat = jnp.where(tril, jnp.exp(seg), 0.0)
    kb = k * beta[..., None]
    a = jnp.where(strict, jnp.einsum("nbhid,nbhjd->nbhij", kb, k) * decay_mat, 0.0)
    eye = jnp.eye(CHUNK, dtype=jnp.float32)
    t_inv = lax.linalg.triangular_solve(eye + a, jnp.broadcast_to(eye, a.shape),
                                        left_side=True, lower=True, unit_diagonal=True)
    u = jnp.einsum("nbhij,nbhje->nbhie", t_inv, v * beta[..., None])
    w = jnp.einsum("nbhij,nbhjd->nbhid", t_inv, kb * jnp.exp(gc)[..., None])
    qk = jnp.where(tril, jnp.einsum("nbhid,nbhjd->nbhij", q, k) * decay_mat, 0.0)
    k_end = k * jnp.exp(gc[..., -1:] - gc)[..., None]
    q_dec = q * jnp.exp(gc)[..., None]
    g_end = jnp.exp(gc[..., -1])

    def step(s, xs):
        u_c, w_c, qk_c, kend_c, qdec_c, gend_c = xs
        v_new = u_c - jnp.einsum("bhid,bhde->bhie", w_c, s)
        o = jnp.einsum("bhid,bhde->bhie", qdec_c, s) + jnp.einsum("bhij,bhje->bhie", qk_c, v_new)
        s = s * gend_c[..., None, None] + jnp.einsum("bhid,bhie->bhde", kend_c, v_new)
        return s, o

    s_fin, o = lax.scan(step, s0.astype(jnp.float32), (u, w, qk, k_end, q_dec, g_end))
    return from_chunks(o), s_fin


def gdn_branch(cols_ctx, cols_lat, conv_w, a_log, dt_bias, norm_g):
    def prep(cols):
        q, k, v, z, a, b = cols
        qkv = jax.nn.silu(short_conv(jnp.concatenate([q, k, v], axis=-1), conv_w))
        q, k, v = jnp.split(qkv, [GDN_QK, 2 * GDN_QK], axis=-1)
        heads = lambda t: t.reshape(t.shape[:2] + (GDN_HEADS, -1))
        q = l2_normalize(heads(q)) * GDN_DK ** -0.5
        k = l2_normalize(heads(k))
        a = a.reshape(a.shape[:2] + (2, GDN_HEADS)).astype(jnp.float32)
        g = -jnp.exp(a_log.astype(jnp.float32)) * jax.nn.softplus(a + dt_bias.astype(jnp.float32))
        beta = jax.nn.sigmoid(b.reshape(b.shape[:2] + (2, GDN_HEADS)).astype(jnp.float32))
        return (q, k, heads(v), g, beta), z

    def run(inp, d, s0):
        q, k, v, g, beta = inp
        return gdn_chunked(q, k, v, g[:, :, d], beta[:, :, d], s0)

    inp_c, z_c = prep(cols_ctx)
    inp_l, z_l = prep(cols_lat)
    s0 = jnp.zeros((z_l.shape[0], GDN_HEADS, GDN_DK, GDN_DV), jnp.float32)
    o_c, o_l = prefix_bidir(run, inp_c, inp_l, s0)
    post = lambda o, z: rms_norm(o, norm_g).reshape(z.shape).astype(z.dtype) * jax.nn.silu(z)
    return post(o_c, z_c), post(o_l, z_l)


def s5_discretise(lam_re, lam_im, log_step, b_re, b_im):
    lam_re, lam_im, log_step, b_re, b_im = (t.astype(jnp.float32) for t in (lam_re, lam_im, log_step, b_re, b_im))
    step = jnp.exp(log_step)[:, None]
    mag = jnp.exp(lam_re * step)
    lb_re, lb_im = mag * jnp.cos(lam_im * step), mag * jnp.sin(lam_im * step)
    den = lam_re * lam_re + lam_im * lam_im
    f_re = ((lb_re - 1.0) * lam_re + lb_im * lam_im) / den
    f_im = (lb_im * lam_re - (lb_re - 1.0) * lam_im) / den
    bb_re = f_re[..., None] * b_re - f_im[..., None] * b_im
    bb_im = f_re[..., None] * b_im + f_im[..., None] * b_re
    return lb_re, lb_im, bb_re, bb_im


def s5_scan(u, lb_re, lb_im, bb_re, bb_im, x0_re, x0_im):
    bu_re = jnp.einsum("gph,blgh->blgp", bb_re, u)
    bu_im = jnp.einsum("gph,blgh->blgp", bb_im, u)
    bu_re = bu_re.at[:, 0].add(lb_re * x0_re - lb_im * x0_im)
    bu_im = bu_im.at[:, 0].add(lb_re * x0_im + lb_im * x0_re)
    l = u.shape[1]
    a_re = jnp.broadcast_to(lb_re[None, None], (1, l) + lb_re.shape)
    a_im = jnp.broadcast_to(lb_im[None, None], (1, l) + lb_im.shape)

    def combine(e1, e2):
        a1r, a1i, b1r, b1i = e1
        a2r, a2i, b2r, b2i = e2
        return (a2r * a1r - a2i * a1i, a2r * a1i + a2i * a1r,
                a2r * b1r - a2i * b1i + b2r, a2r * b1i + a2i * b1r + b2i)

    _, _, xr, xi = lax.associative_scan(combine, (a_re, a_im, bu_re, bu_im), axis=1)
    return xr, xi


def s5_branch(cols_ctx, cols_lat, lam_re, lam_im, log_step, b_re, b_im, c_re, c_im, d_skip, w_glu, b_glu):
    disc = [s5_discretise(lam_re[d], lam_im[d], log_step[d], b_re, b_im) for d in range(2)]
    c_re32, c_im32 = c_re.astype(jnp.float32), c_im.astype(jnp.float32)

    def run(inp, d, s0):
        (u,) = inp
        xr, xi = s5_scan(u, *disc[d], *s0)
        y = jnp.einsum("ghp,blgp->blgh", c_re32, xr) - jnp.einsum("ghp,blgp->blgh", c_im32, xi)
        return y, (xr[:, -1], xi[:, -1])

    grp = lambda u: u.reshape(u.shape[:2] + (S5_G, S5_H)).astype(jnp.float32)
    u_c, z_c = cols_ctx
    u_l, z_l = cols_lat
    zero = jnp.zeros((u_l.shape[0], S5_G, S5_P), jnp.float32)
    y_c, y_l = prefix_bidir(run, (grp(u_c),), (grp(u_l),), (zero, zero))

    def post(y, u, z):
        y = jax.nn.gelu(y.reshape(z.shape).astype(z.dtype) + d_skip * u)
        ab = y @ w_glu + b_glu
        return ab[..., :S5_W] * jax.nn.sigmoid(ab[..., S5_W:]) * jax.nn.silu(z)

    return post(y_c, u_c, z_c), post(y_l, u_l, z_l)


def mlstm_chunked(q, k, v, i_pre, log_f, state):
    q, k, v, i_pre, log_f = (to_chunks(t.astype(jnp.float32)) for t in (q, k, v, i_pre, log_f))
    tril = jnp.tril(jnp.ones((CHUNK, CHUNK), dtype=bool))
    b_cum = jnp.cumsum(log_f, axis=-1)
    log_d = jnp.where(tril, b_cum[..., :, None] - b_cum[..., None, :] + i_pre[..., None, :], -jnp.inf)
    m_intra = jnp.max(log_d, axis=-1)
    qk = jnp.einsum("nbhid,nbhjd->nbhij", q, k)
    log_end = b_cum[..., -1:] - b_cum + i_pre
    b_end = b_cum[..., -1]

    def step(carry, xs):
        c_s, n_s, m_s = carry
        q_c, k_c, v_c, qk_c, ld_c, mi_c, bc_c, le_c, be_c = xs
        m_t = jnp.maximum(bc_c + m_s[..., None], mi_c)
        w_intra = jnp.exp(ld_c - m_t[..., None]) * qk_c
        w_inter = jnp.exp(bc_c + m_s[..., None] - m_t)
        num = (jnp.einsum("bhij,bhje->bhie", w_intra, v_c)
               + w_inter[..., None] * jnp.einsum("bhid,bhed->bhie", q_c, c_s))
        den = jnp.sum(w_intra, axis=-1) + w_inter * jnp.einsum("bhid,bhd->bhi", q_c, n_s)
        h = num / jnp.maximum(jnp.abs(den), jnp.exp(-m_t))[..., None]
        m_new = jnp.maximum(be_c + m_s, jnp.max(le_c, axis=-1))
        w_state = jnp.exp(le_c - m_new[..., None])
        decay = jnp.exp(be_c + m_s - m_new)
        c_new = decay[..., None, None] * c_s + jnp.einsum("bhj,bhje,bhjd->bhed", w_state, v_c, k_c)
        n_new = decay[..., None] * n_s + jnp.einsum("bhj,bhjd->bhd", w_state, k_c)
        return (c_new, n_new, m_new), h

    init = tuple(s.astype(jnp.float32) for s in state)
    state, h = lax.scan(step, init, (q, k, v, qk, log_d, m_intra, b_cum, log_end, b_end))
    return from_chunks(h), state


def mlstm_branch(cols_ctx, cols_lat, i_bias, f_bias, norm_g):
    def prep(cols):
        q, k, v, o, z, ig, fg = cols
        heads = lambda t: t.reshape(t.shape[:2] + (ML_HEADS, ML_DH))
        dirs = lambda t: t.reshape(t.shape[:2] + (2, ML_HEADS)).astype(jnp.float32)
        i_pre = dirs(ig) + i_bias.astype(jnp.float32)
        log_f = jax.nn.log_sigmoid(dirs(fg) + f_bias.astype(jnp.float32))
        return (heads(q), heads(k) * ML_DH ** -0.5, heads(v), i_pre, log_f), o, z

    def run(inp, d, s0):
        q, k, v, i_pre, log_f = inp
        return mlstm_chunked(q, k, v, i_pre[:, :, d], log_f[:, :, d], s0)

    inp_c, o_c, z_c = prep(cols_ctx)
    inp_l, o_l, z_l = prep(cols_lat)
    b = z_l.shape[0]
    s0 = (jnp.zeros((b, ML_HEADS, ML_DH, ML_DH), jnp.float32),
          jnp.zeros((b, ML_HEADS, ML_DH), jnp.float32),
          jnp.zeros((b, ML_HEADS), jnp.float32))
    h_c, h_l = prefix_bidir(run, inp_c, inp_l, s0)

    def post(h, o, z):
        h = jax.nn.sigmoid(o) * h.reshape(z.shape).astype(z.dtype)
        h = rms_norm(h.reshape(h.shape[:2] + (ML_HEADS, ML_DH)), norm_g).reshape(z.shape)
        return h * jax.nn.silu(z)

    return post(h_c, o_c, z_c), post(h_l, o_l, z_l)


def merge_branches(ys, gate_cols, w_branch, w_out):
    gates = jax.nn.sigmoid(gate_cols)
    merged = sum(gates[..., i * D_MODEL:(i + 1) * D_MODEL] * (ys[i] @ w_branch[i]) for i in range(N_BRANCH))
    return merged @ w_out


def hybrid_layer(x_ctx, x_lat, mod_ctx, mod_lat, column_major, last,
                 norm_g, w_in, gdn_conv, gdn_a_log, gdn_dt_bias, gdn_norm_g,
                 s5_lam_re, s5_lam_im, s5_log_step, s5_b_re, s5_b_im, s5_c_re, s5_c_im,
                 s5_d, s5_w_glu, s5_b_glu, ml_i_bias, ml_f_bias, ml_norm_g, w_branch, w_out):
    shift_c, scale_c, gate_c = jnp.split(mod_ctx, 3, axis=-1)
    shift_l, scale_l, gate_l = jnp.split(mod_lat[:, None, :], 3, axis=-1)
    h_ctx = rms_norm(x_ctx, norm_g) * (1.0 + scale_c) + shift_c
    h_lat = to_scan_order(rms_norm(x_lat, norm_g) * (1.0 + scale_l) + shift_l, column_major)
    cc = split_cols(h_ctx @ w_in)
    cl = split_cols(h_lat @ w_in)
    ya_c, ya_l = gdn_branch(cc[0:6], cl[0:6], gdn_conv, gdn_a_log, gdn_dt_bias, gdn_norm_g)
    yb_c, yb_l = s5_branch(cc[6:8], cl[6:8], s5_lam_re, s5_lam_im, s5_log_step, s5_b_re, s5_b_im,
                           s5_c_re, s5_c_im, s5_d, s5_w_glu, s5_b_glu)
    yc_c, yc_l = mlstm_branch(cc[8:15], cl[8:15], ml_i_bias, ml_f_bias, ml_norm_g)
    out_l = merge_branches((ya_l, yb_l, yc_l), cl[15], w_branch, w_out)
    x_lat_new = x_lat + gate_l * from_scan_order(out_l, column_major)
    if last:
        return x_ctx, x_lat_new
    out_c = merge_branches((ya_c, yb_c, yc_c), cc[15], w_branch, w_out)
    return x_ctx + gate_c * out_c, x_lat_new


def setup_inputs(seed: int = 0) -> dict:
    key = jax.random.key(seed)
    ks = list(jax.random.split(key, 32))

    def nrm(shape, scale):
        return jax.random.normal(ks.pop(), shape, jnp.float32) * scale

    def unif(shape, lo, hi):
        return jax.random.uniform(ks.pop(), shape, jnp.float32, lo, hi)

    x = nrm((BATCH, SEQ, D_MODEL), 1.0)
    c = nrm((BATCH, D_MODEL), 1.0)
    ctx = nrm((BATCH, CTX_LEN, D_MODEL), 1.0)
    c_ctx = nrm((D_MODEL,), 1.0)
    w_ada = nrm((DEPTH, D_MODEL, 3 * D_MODEL), 0.5 * D_MODEL ** -0.5)
    b_ada = nrm((DEPTH, 3 * D_MODEL), 0.02)
    norm_g = 1.0 + nrm((DEPTH, D_MODEL), 0.05)
    w_in = nrm((DEPTH, D_MODEL, N_IN), D_MODEL ** -0.5)
    gdn_conv = nrm((DEPTH, CONV_K, 2 * GDN_QK + GDN_W), CONV_K ** -0.5)
    gdn_a_log = jnp.log(unif((DEPTH, 2, GDN_HEADS), 1.0, 16.0))
    dt = jnp.exp(unif((DEPTH, 2, GDN_HEADS), float(np.log(STEP_MIN)), float(np.log(STEP_MAX))))
    gdn_dt_bias = dt + jnp.log(-jnp.expm1(-dt))
    gdn_norm_g = 1.0 + nrm((DEPTH, GDN_DV), 0.05)
    n_idx = jnp.arange(S5_P, dtype=jnp.float32)
    s5_lam_re = -0.5 + nrm((DEPTH, 2, S5_G, S5_P), 0.01)
    s5_lam_im = jnp.pi * n_idx + nrm((DEPTH, 2, S5_G, S5_P), 0.01)
    s5_log_step = unif((DEPTH, 2, S5_G), float(np.log(STEP_MIN)), float(np.log(STEP_MAX)))
    s5_b_re = nrm((DEPTH, S5_G, S5_P, S5_H), (2 * S5_H) ** -0.5)
    s5_b_im = nrm((DEPTH, S5_G, S5_P, S5_H), (2 * S5_H) ** -0.5)
    s5_c_re = nrm((DEPTH, S5_G, S5_H, S5_P), S5_P ** -0.5)
    s5_c_im = nrm((DEPTH, S5_G, S5_H, S5_P), S5_P ** -0.5)
    s5_d = nrm((DEPTH, S5_W), 0.5)
    s5_w_glu = nrm((DEPTH, S5_W, 2 * S5_W), S5_W ** -0.5)
    s5_b_glu = nrm((DEPTH, 2 * S5_W), 0.02)
    ml_i_bias = nrm((DEPTH, 2, ML_HEADS), 0.1)
    ml_f_bias = jnp.linspace(3.0, 6.0, ML_HEADS, dtype=jnp.float32) + nrm((DEPTH, 2, ML_HEADS), 0.1)
    ml_norm_g = 1.0 + nrm((DEPTH, ML_DH), 0.05)
    w_branch = nrm((DEPTH, N_BRANCH, BRANCH_W, D_MODEL), BRANCH_W ** -0.5)
    w_out = nrm((DEPTH, D_MODEL, D_MODEL), D_MODEL ** -0.5)
    final_norm_g = 1.0 + nrm((D_MODEL,), 0.05)
    return {"x": x, "c": c, "ctx": ctx, "c_ctx": c_ctx, "w_ada": w_ada, "b_ada": b_ada,
            "norm_g": norm_g, "w_in": w_in, "gdn_conv": gdn_conv, "gdn_a_log": gdn_a_log,
            "gdn_dt_bias": gdn_dt_bias, "gdn_norm_g": gdn_norm_g,
            "s5_lam_re": s5_lam_re, "s5_lam_im": s5_lam_im, "s5_log_step": s5_log_step,
            "s5_b_re": s5_b_re, "s5_b_im": s5_b_im, "s5_c_re": s5_c_re, "s5_c_im": s5_c_im,
            "s5_d": s5_d, "s5_w_glu": s5_w_glu, "s5_b_glu": s5_b_glu,
            "ml_i_bias": ml_i_bias, "ml_f_bias": ml_f_bias, "ml_norm_g": ml_norm_g,
            "w_branch": w_branch, "w_out": w_out, "final_norm_g": final_norm_g}


def reference(x, c, ctx, c_ctx, w_ada, b_ada, norm_g, w_in, gdn_conv, gdn_a_log, gdn_dt_bias, gdn_norm_g,
              s5_lam_re, s5_lam_im, s5_log_step, s5_b_re, s5_b_im, s5_c_re, s5_c_im, s5_d, s5_w_glu, s5_b_glu,
              ml_i_bias, ml_f_bias, ml_norm_g, w_branch, w_out, final_norm_g):
    x_ctx, x_lat = ctx, x
    silu_c, silu_cc = jax.nn.silu(c), jax.nn.silu(c_ctx)
    for l in range(DEPTH):
        mod_lat = silu_c @ w_ada[l] + b_ada[l]
        mod_ctx = silu_cc @ w_ada[l] + b_ada[l]
        x_ctx, x_lat = hybrid_layer(
            x_ctx, x_lat, mod_ctx, mod_lat, l % 2 == 1, l == DEPTH - 1,
            norm_g[l], w_in[l], gdn_conv[l], gdn_a_log[l], gdn_dt_bias[l], gdn_norm_g[l],
            s5_lam_re[l], s5_lam_im[l], s5_log_step[l], s5_b_re[l], s5_b_im[l], s5_c_re[l], s5_c_im[l],
            s5_d[l], s5_w_glu[l], s5_b_glu[l], ml_i_bias[l], ml_f_bias[l], ml_norm_g[l],
            w_branch[l], w_out[l])
    return rms_norm(x_lat, final_norm_g)
```

```cpp
#include <hip/hip_runtime.h>
#include <cstdio>
#include <cstdint>
#define MK_LAUNCHES 1


#define XB_TMO      128
#define XB_XCNT(j)  (256  + 64 * (j))
#define XB_XSUB(j)  (1280 + 64 * (j))
#define XB_XGEN(j)  (2304 + 64 * (j))
#define XB_TOP      3328
#define XB_TOPGEN   3392
#define XCD_BAR_WORDS 3456
#define XB_SPIN_CAP (1u << 18)
#define LAS __attribute__((address_space(3)))

__device__ __forceinline__ unsigned xb_ld(unsigned* p)              { return __hip_atomic_load(p, __ATOMIC_RELAXED, __HIP_MEMORY_SCOPE_AGENT); }
__device__ __forceinline__ unsigned xb_add(unsigned* p, unsigned v) { return __hip_atomic_fetch_add(p, v, __ATOMIC_RELAXED, __HIP_MEMORY_SCOPE_AGENT); }
__device__ __forceinline__ unsigned xb_xcc_id() { return (unsigned)__builtin_amdgcn_s_getreg((3 << 11) | 20) & 0xFu; }
#define XB_SPIN(cond, bar) do { unsigned _sp = 0; while (cond) { __builtin_amdgcn_s_sleep(1); \
    if ((++_sp & 255u) == 0u) { if (xb_ld(&(bar)[XB_TMO])) break; if (_sp > XB_SPIN_CAP) { atomicAdd(&(bar)[XB_TMO], 1u); break; } } } } while (0)

struct XcdBarrier {
    unsigned* bar; unsigned x;
    volatile LAS unsigned* st;
};

__device__ __forceinline__ XcdBarrier xcd_barrier_post(unsigned* bar, volatile LAS unsigned* st) {
    XcdBarrier b; b.bar = bar; b.x = xb_xcc_id(); b.st = st;
    if (threadIdx.x == 0) (void)xb_add(&bar[XB_XCNT(b.x)], 1u);
    return b;
}
__device__ __forceinline__ void xcd_barrier_complete(unsigned* bar, unsigned x, unsigned& nloc, unsigned& nx) {
    const unsigned G = gridDim.x * gridDim.y * gridDim.z;
    unsigned sum, cnt, mine, sp = 0u;
    for (;;) {
        sum = 0u; cnt = 0u; mine = 0u;
#pragma unroll
        for (unsigned j = 0; j < 16; ++j) { const unsigned c = xb_ld(&bar[XB_XCNT(j)]); sum += c; cnt += (c > 0u) ? 1u : 0u; mine = (j == x) ? c : mine; }
        if (sum == G) break;
        __builtin_amdgcn_s_sleep(1);
        if ((++sp & 255u) == 0u) { if (xb_ld(&bar[XB_TMO])) break; if (sp > XB_SPIN_CAP) { atomicAdd(&bar[XB_TMO], 1u); break; } }
    }
    nloc = mine > 0u ? mine : 1u; nx = cnt > 0u ? cnt : 1u;
}

__device__ __forceinline__ void xcd_barrier(const XcdBarrier& b) {
    asm volatile("s_waitcnt vmcnt(0)" ::: "memory");
    __syncthreads();
    if (threadIdx.x == 0) {
        unsigned* bar = b.bar;
        __builtin_amdgcn_s_waitcnt(0);
        unsigned nloc = b.st[0], nx = b.st[1];
        if (nloc == 0u) { xcd_barrier_complete(bar, b.x, nloc, nx); b.st[0] = nloc; b.st[1] = nx; }
        const unsigned old = xb_add(&bar[XB_XSUB(b.x)], 1u);
        const unsigned gen = old / nloc;
        if (old + 1u == (gen + 1u) * nloc) {
            __builtin_amdgcn_fence(__ATOMIC_RELEASE, "agent");
            asm volatile("s_waitcnt vmcnt(0)" ::: "memory");
            const unsigned og = xb_add(&bar[XB_TOP], 1u);
            const unsigned tg = og / nx;
            if (og + 1u == (tg + 1u) * nx) xb_add(&bar[XB_TOPGEN], 1u);
            else XB_SPIN(xb_ld(&bar[XB_TOPGEN]) == tg, bar);
            __builtin_amdgcn_fence(__ATOMIC_ACQUIRE, "agent");
            xb_add(&bar[XB_XGEN(b.x)], 1u);
            asm volatile("s_waitcnt vmcnt(0)" ::: "memory");
        } else {
            XB_SPIN(xb_ld(&bar[XB_XGEN(b.x)]) == gen, bar);
            __builtin_amdgcn_fence(__ATOMIC_ACQUIRE, "agent");
            asm volatile("s_waitcnt vmcnt(0)" ::: "memory");
        }
    }
    __syncthreads();
}


namespace pg8 {
#define PG8_LAS __attribute__((address_space(3)))
typedef unsigned short bf16_t;
typedef short bf16x8 __attribute__((ext_vector_type(8)));
typedef float f32x4 __attribute__((ext_vector_type(4)));
typedef unsigned u32x4 __attribute__((ext_vector_type(4)));
constexpr int BM = 256, BK = 64, HALF = 128, HTB = HALF * BK * 2  , STAGE_BYTES = 8 * HTB, NXCD = 8, WGM = 8;

__host__ __device__ __forceinline__ int lds_byte(int r, int c) { const int st = (r >> 4) * 2 + (c >> 5), rr = r & 15, cc = c & 31, ob = rr * 64 + cc * 2; return st * 1024 + (ob ^ (((ob >> 9) & 1) << 5)); }
__host__ __device__ __forceinline__ void stage_rc(int b, int& R, int& C) { const int st = b / 1024, sb = b % 1024, swz = sb ^ (((sb >> 9) & 1) << 5); R = (st >> 1) * 16 + swz / 64; C = (st & 1) * 32 + (swz % 64) / 2; }
__host__ __device__ __forceinline__ int perm32(int rho) { const int n = rho >> 4, i = rho & 15; return 8 * (i >> 2) + 4 * n + (i & 3); }

struct Unit { int pm, pn; };
struct Gemm { const bf16_t* A; const bf16_t* Bt; int M, N, K; };

struct StaticOrder {
    int nM, nN, nwg, G, c;
    __host__ __device__ void init(int M, int N, int G_, int c_) { nM = M / BM; nN = N / BM; nwg = nM * nN; G = G_; c = c_; }
    __host__ __device__ bool next(int i, Unit& u) const {
        const long L = (long)i * G + c; if (L >= nwg) return false;
        int wgid = (int)L; { const int q = nwg / NXCD, r = nwg % NXCD, xcd = wgid % NXCD, off = wgid / NXCD; wgid = (xcd < r ? xcd * (q + 1) : r * (q + 1) + (xcd - r) * q) + off; }
        const int nig = WGM * nN, gid = wgid / nig, fm = gid * WGM, gsz = (nM - fm) < WGM ? (nM - fm) : WGM;
        u.pm = fm + ((wgid % nig) % gsz); u.pn = (wgid % nig) / gsz; return true;
    }
    __device__ __forceinline__ void a_ready(const Unit&) const {}
    __device__ __forceinline__ void done(const Unit&) const {}
};
__device__ __forceinline__ unsigned cvt_pk_bf16(float lo, float hi) { unsigned r; asm volatile("v_cvt_pk_bf16_f32 %0, %1, %2" : "=v"(r) : "v"(lo), "v"(hi)); return r; }
typedef float f32x2 __attribute__((ext_vector_type(2)));
template <class Epi, class Sched, bool STAMP = false>
__device__ __forceinline__ void gemm_phase(PG8_LAS unsigned char* lds, const Gemm g, const Sched& S, const Epi& E, unsigned long long* stamps) {
    int tid_l = threadIdx.x; asm volatile("" : "+v"(tid_l));
    const int tid = tid_l, wid = __builtin_amdgcn_readfirstlane(tid >> 6), lane = tid & 63, wr = wid >> 2, wc = wid & 3, fr = lane & 15, fq = lane >> 4;
    const int K = g.K, nt = K / BK;
    int ts_lo = 0, ts_hi = 0, nts = 0; const unsigned long long rt_entry = STAMP ? (unsigned long long)wall_clock64() : 0ull;
#define PG8_STAMP() do { if (STAMP && wid == 0 && nts < 64) { const unsigned long long _c = (unsigned long long)clock64(); \
        ts_lo = (lane == nts) ? (int)(unsigned)_c : ts_lo; ts_hi = (lane == nts) ? (int)(unsigned)(_c >> 32) : ts_hi; ++nts; } } while (0)
    PG8_STAMP();
    unsigned voffA[2], voffB[2];
#pragma unroll
    for (int i = 0; i < 2; ++i) { int R, C; stage_rc(tid * 16 + i * 8192, R, C); const int Rb = Epi::PERM ? ((R & ~31) + perm32(R & 31)) : R;
        voffA[i] = (unsigned)(R * K + C) * 2u; voffB[i] = (unsigned)(Rb * K + C) * 2u; }
    const size_t kstep = (size_t)(BK * 2);
    const size_t hstep = (size_t)HALF * K * 2;
    const size_t tstep = 2 * hstep;
    const unsigned ldsw = (unsigned)wid * 1024u;
    const int aoff = lds_byte(wr * 64 + fr, fq * 8), boff = lds_byte(wc * 32 + fr, fq * 8);
#define PG8_SA(b, h) (((b) * 2 + (h)) * HTB)
#define PG8_SB(b, h) ((4 + (b) * 2 + (h)) * HTB)
#define PG8_STAGE(bufoff, gbase, voff) do { _Pragma("unroll") for (int _i = 0; _i < 2; ++_i) \
        __builtin_amdgcn_global_load_lds((const unsigned*)((const char*)(gbase) + (voff)[_i]), (PG8_LAS unsigned*)(lds + (bufoff) + ldsw + _i * 8192), 16, 0, 0); } while (0)
#define PG8_LDA(dst, b, h) do { _Pragma("unroll") for (int m = 0; m < 4; ++m) _Pragma("unroll") for (int k = 0; k < 2; ++k) dst[m][k] = *(const PG8_LAS bf16x8*)(lds + PG8_SA(b, h) + aoff + m * 2048 + k * 1024); } while (0)
#define PG8_LDB(dst, b, h) do { _Pragma("unroll") for (int n = 0; n < 2; ++n) _Pragma("unroll") for (int k = 0; k < 2; ++k) dst[n][k] = *(const PG8_LAS bf16x8*)(lds + PG8_SB(b, h) + boff + n * 2048 + k * 1024); } while (0)
#define PG8_MMA(ai, bj, At, Bt) do { __builtin_amdgcn_s_setprio(1); _Pragma("unroll") for (int m = 0; m < 4; ++m) _Pragma("unroll") for (int n = 0; n < 2; ++n) _Pragma("unroll") for (int k = 0; k < 2; ++k) \
        acc[ai][bj][m][n] = __builtin_amdgcn_mfma_f32_16x16x32_bf16(Bt[n][k], At[m][k], acc[ai][bj][m][n], 0, 0, 0); __builtin_amdgcn_s_setprio(0); } while (0)
#define PG8_WAIT_V(n) asm volatile("s_waitcnt vmcnt(" #n ")" ::: "memory")
#define PG8_WAIT_L(n) asm volatile("s_waitcnt lgkmcnt(" #n ")" ::: "memory")
#define PG8_BAR __builtin_amdgcn_s_barrier()
#define PG8_SCHED __builtin_amdgcn_sched_barrier(0)
    Unit cur, nxt; int ui = 0;
    if (!S.next(0, cur)) return;
    f32x4 acc[2][2][4][2];
#pragma unroll
    for (int a = 0; a < 2; ++a)
#pragma unroll
        for (int b = 0; b < 2; ++b)
#pragma unroll
            for (int m = 0; m < 4; ++m)
#pragma unroll
                for (int n = 0; n < 2; ++n) acc[a][b][m][n] = (f32x4){0.f, 0.f, 0.f, 0.f};
    bf16x8 At[4][2], B0[2][2], B1[2][2];
    const char* cA = (const char*)g.A + (size_t)cur.pm * tstep; const char* cB = (const char*)g.Bt + (size_t)cur.pn * tstep;
    S.a_ready(cur);
    PG8_STAGE(PG8_SB(0, 0), cB, voffB); PG8_STAGE(PG8_SA(0, 0), cA, voffA); PG8_STAGE(PG8_SB(0, 1), cB + hstep, voffB); PG8_STAGE(PG8_SA(0, 1), cA + hstep, voffA);
    if (wr == 1) PG8_BAR;
    PG8_WAIT_V(4); PG8_BAR;
    PG8_STAGE(PG8_SB(1, 0), cB + kstep, voffB); PG8_STAGE(PG8_SA(1, 0), cA + kstep, voffA); PG8_STAGE(PG8_SB(1, 1), cB + hstep + kstep, voffB);
    PG8_WAIT_V(6); PG8_BAR;
    PG8_STAMP();
    for (;;) {
        const bool has_next = S.next(ui + 1, nxt);
        const char* nA = has_next ? (const char*)g.A + (size_t)nxt.pm * tstep : cA; const char* nB = has_next ? (const char*)g.Bt + (size_t)nxt.pn * tstep : cB;
        for (int t = 0; t < nt; t += 2) {
            const bool last = (t == nt - 2);
            const char* a1 = cA + (size_t)(t + 1) * kstep;
            const char* a2 = last ? nA : cA + (size_t)(t + 2) * kstep; const char* b2 = last ? nB : cB + (size_t)(t + 2) * kstep;
            const char* a3 = a2 + kstep; const char* b3 = b2 + kstep;
            if (last && has_next) S.a_ready(nxt);
            PG8_LDB(B0, 0, 0); PG8_SCHED; PG8_LDA(At, 0, 0); PG8_STAGE(PG8_SA(1, 1), a1 + hstep, voffA);
            PG8_WAIT_L(8); PG8_BAR; PG8_WAIT_L(0); PG8_MMA(0, 0, At, B0); PG8_BAR; PG8_SCHED;
            PG8_LDB(B1, 0, 1); PG8_STAGE(PG8_SB(0, 0), b2, voffB);
            PG8_BAR; PG8_WAIT_L(0); PG8_MMA(0, 1, At, B1); PG8_BAR;
            PG8_LDA(At, 0, 1); PG8_STAGE(PG8_SA(0, 0), a2, voffA);
            PG8_BAR; PG8_WAIT_L(0); PG8_MMA(1, 0, At, B0); PG8_BAR; PG8_SCHED;
            PG8_STAGE(PG8_SB(0, 1), b2 + hstep, voffB);
            PG8_WAIT_V(6); PG8_BAR; PG8_MMA(1, 1, At, B1); PG8_BAR;
            PG8_LDB(B0, 1, 0); PG8_SCHED; PG8_LDA(At, 1, 0); PG8_STAGE(PG8_SA(0, 1), a2 + hstep, voffA);
            PG8_WAIT_L(8); PG8_BAR; PG8_WAIT_L(0); PG8_MMA(0, 0, At, B0); PG8_BAR; PG8_SCHED;
            PG8_LDB(B1, 1, 1); PG8_STAGE(PG8_SB(1, 0), b3, voffB);
            PG8_BAR; PG8_WAIT_L(0); PG8_MMA(0, 1, At, B1); PG8_BAR;
            PG8_LDA(At, 1, 1); PG8_STAGE(PG8_SA(1, 0), a3, voffA);
            PG8_BAR; PG8_WAIT_L(0); PG8_MMA(1, 0, At, B0); PG8_BAR; PG8_SCHED;
            PG8_STAGE(PG8_SB(1, 1), b3 + hstep, voffB);
            PG8_WAIT_V(6); PG8_BAR; PG8_MMA(1, 1, At, B1); PG8_BAR;
        }
        PG8_STAMP();
        if constexpr (!Epi::AFTER_DRAIN) { E(acc, cur, wr, wc, fr, fq); S.done(cur); }
        PG8_STAMP();
        if (!has_next) break;
#pragma unroll
        for (int a = 0; a < 2; ++a)
#pragma unroll
            for (int b = 0; b < 2; ++b)
#pragma unroll
                for (int m = 0; m < 4; ++m)
#pragma unroll
                    for (int n = 0; n < 2; ++n) acc[a][b][m][n] = (f32x4){0.f, 0.f, 0.f, 0.f};
        cur = nxt; cA = nA; cB = nB; ++ui;
    }
    PG8_WAIT_V(0);
    if (wr == 0) PG8_BAR;
    PG8_BAR;
    if constexpr (Epi::AFTER_DRAIN) { E.fused(acc, cur, wr, wc, fr, fq, lds, wid, lane); S.done(cur); }
    PG8_STAMP();
    if (STAMP && wid == 0) { stamps[lane] = lane < nts ? (((unsigned long long)(unsigned)ts_hi << 32) | (unsigned)ts_lo) : 0ull;
        if (lane == 62) stamps[62] = rt_entry; if (lane == 63) stamps[63] = (unsigned long long)wall_clock64(); }
#undef PG8_STAMP
#undef PG8_SA
#undef PG8_SB
#undef PG8_STAGE
#undef PG8_LDA
#undef PG8_LDB
#undef PG8_MMA
#undef PG8_WAIT_V
#undef PG8_WAIT_L
#undef PG8_BAR
#undef PG8_SCHED
}
}


namespace hy {
using pg8::bf16_t; using pg8::f32x4; using pg8::u32x4; using pg8::Unit;
typedef unsigned u32x2 __attribute__((ext_vector_type(2)));
#define DI __device__ __forceinline__
constexpr int D = 1024, NBATCH = 8, SEQ = 4096, CTXL = 256, DEPTH = 4;
constexpr int CTXROWS = NBATCH * CTXL;
constexpr int MROWS = CTXROWS + NBATCH * SEQ;
constexpr int NCHUNK = MROWS / 64;
constexpr int NIN = 14384;
constexpr int NT = 512;
constexpr int LDS_BYTES = 131072 + 256;
constexpr int C_GQ = 0, C_GZ = 3072, C_GA = 4096, C_SU = 4128, C_MQ = 6176, C_MO = 9248, C_MI = 11296, C_GATE = 11312;

constexpr size_t al256(size_t x) { return (x + 255) & ~(size_t)255; }
constexpr size_t SZ_ACT = (size_t)MROWS * 1024 * 2;
constexpr size_t SZ_GATE = (size_t)MROWS * 32 * 4;
constexpr size_t SZ_HALO = (size_t)3 * NCHUNK * 4 * 1024 * 2;
constexpr size_t WS_CTL = 0;
constexpr size_t WS_MOD = 65536, SZ_MOD = (size_t)DEPTH * 9 * 3072 * 4;
constexpr size_t WS_XCTX = al256(WS_MOD + SZ_MOD);
constexpr size_t WS_H = WS_XCTX + (size_t)CTXROWS * 1024 * 4;
constexpr size_t WS_MERGED = WS_H + SZ_ACT;
constexpr size_t SZ_WB = (size_t)3328 * 1024 * 2;
constexpr size_t WS_WB0 = WS_MERGED + SZ_ACT;
constexpr size_t WS_WB1 = WS_WB0 + SZ_WB;
constexpr size_t WS_R = WS_WB1 + SZ_WB;
constexpr size_t R_P0 = 0, R_P1 = SZ_ACT, R_P2 = 2 * SZ_ACT, R_OF = 3 * SZ_ACT, R_OB = 4 * SZ_ACT, R_G2 = 5 * SZ_ACT;
constexpr size_t WS_END = WS_R + R_G2 + SZ_GATE;
static_assert(SZ_GATE + SZ_HALO <= SZ_ACT, "GDN gate + halo buffers live in the (not yet written) MERGED region");
static_assert((size_t)16 * DEPTH * 9 * 3072 * 4 <= SZ_ACT, "mod partials live in the R region");

struct Args { const float* in[28]; float* out; unsigned char* ws; int ph_lo, ph_hi; };
enum { I_X = 0, I_C, I_CTX, I_CCTX, I_WADA, I_BADA, I_NORMG, I_WIN, I_GCONV, I_GALOG, I_GDTB, I_GNORM, I_SLRE, I_SLIM, I_SLOG, I_SBRE, I_SBIM, I_SCRE, I_SCIM, I_SD, I_SWGLU, I_SBGLU, I_MIB, I_MFB, I_MNORM, I_WBR, I_WOUT, I_FNORM };

typedef const Args __attribute__((address_space(4)))* ArgsP;
DI ArgsP args_ptr() { ArgsP p = (ArgsP)__builtin_amdgcn_kernarg_segment_ptr(); asm volatile("" : "+s"(p)); return p; }
DI int ltid() { int t = threadIdx.x; asm volatile("" : "+v"(t)); return t; }
DI float bf2f(bf16_t v) { return __uint_as_float(((unsigned)v) << 16); }
DI float bflo(unsigned w) { return __uint_as_float(w << 16); }
DI float bfhi(unsigned w) { return __uint_as_float(w & 0xffff0000u); }
DI bf16_t f2bf(float f) { return (bf16_t)(pg8::cvt_pk_bf16(f, 0.f) & 0xffffu); }
DI float sigmoidf_(float x) { return 1.0f / (1.0f + __expf(-x)); }
DI float siluf_(float x) { return x / (1.0f + __expf(-x)); }
DI float softplusf_(float x) { return x > 20.f ? x : log1pf(__expf(x)); }
DI float gelu_tanh_(float x) { const float u = 0.7978845608028654f * (x + 0.044715f * x * x * x); return 0.5f * x * (1.0f + tanhf(u)); }
DI float wave_sum(float v) {
#pragma unroll
    for (int o = 32; o >= 1; o >>= 1) v += __shfl_xor(v, o);
    return v; }
DI void unpack8(const u32x4 w, float (&f)[8]) { f[0] = bflo(w.x); f[1] = bfhi(w.x); f[2] = bflo(w.y); f[3] = bfhi(w.y); f[4] = bflo(w.z); f[5] = bfhi(w.z); f[6] = bflo(w.w); f[7] = bfhi(w.w); }
DI int lat_pos(int l, int s) { return (l & 1) ? (((s & 63) << 6) | (s >> 6)) : s; }

struct EpiProj {
    static constexpr bool PERM = true, AFTER_DRAIN = false;
    bf16_t* d0; int modes; float* gdst; int gtile; bf16_t* halo;
    __device__ __forceinline__ void operator()(const f32x4 (&acc)[2][2][4][2], const Unit& u, int wr, int wc, int fr, int fq) const {
        const int row0 = u.pm * 256 + wr * 64 + fr;
        if (u.pn == gtile) {
            if (wc == 0) {
#pragma unroll
                for (int ai = 0; ai < 2; ++ai)
#pragma unroll
                    for (int m = 0; m < 4; ++m) { float* rp = gdst + (size_t)(row0 + ai * 128 + m * 16) * 32 + 8 * fq; *(f32x4*)rp = acc[ai][0][m][0]; *(f32x4*)(rp + 4) = acc[ai][0][m][1]; }
            }
            return;
        }
        const int seg = u.pn >> 2; bf16_t* base = d0 + (size_t)seg * (SZ_ACT / 2); const int md = (modes >> (2 * seg)) & 3;
        const int col0 = (u.pn & 3) * 256 + wc * 32 + 8 * fq;
#pragma unroll
        for (int ai = 0; ai < 2; ++ai)
#pragma unroll
            for (int m = 0; m < 4; ++m) {
                const int r = row0 + ai * 128 + m * 16;
                bf16_t* rowp = base + (size_t)r * 1024 + col0;
                int hidx = -1;
                if (halo) { if (m == 0 && fr < 2) hidx = fr; if (m == 3 && fr >= 14) hidx = fr - 12; }
#pragma unroll
                for (int bj = 0; bj < 2; ++bj) {
                    f32x4 v0 = acc[ai][bj][m][0], v1 = acc[ai][bj][m][1];
                    if (md == 1) {
#pragma unroll
                        for (int j = 0; j < 4; ++j) { v0[j] = siluf_(v0[j]); v1[j] = siluf_(v1[j]); } }
                    else if (md == 2) {
#pragma unroll
                        for (int j = 0; j < 4; ++j) { v0[j] = sigmoidf_(v0[j]); v1[j] = sigmoidf_(v1[j]); } }
                    u32x4 w; w.x = pg8::cvt_pk_bf16(v0[0], v0[1]); w.y = pg8::cvt_pk_bf16(v0[2], v0[3]); w.z = pg8::cvt_pk_bf16(v1[0], v1[1]); w.w = pg8::cvt_pk_bf16(v1[2], v1[3]);
                    *(u32x4*)(rowp + bj * 128) = w;
                    if (hidx >= 0) *(u32x4*)(halo + ((size_t)seg * (NCHUNK * 4) + (size_t)(r >> 6) * 4 + hidx) * 1024 + col0 + bj * 128) = w;
                }
            }
    }
};
struct EpiBranch {
    static constexpr bool PERM = true, AFTER_DRAIN = false;
    const bf16_t* G; bf16_t* MG; int first;
    __device__ __forceinline__ void operator()(const f32x4 (&acc)[2][2][4][2], const Unit& u, int wr, int wc, int fr, int fq) const {
        const int row0 = u.pm * 256 + wr * 64 + fr, col0 = u.pn * 256 + wc * 32 + 8 * fq;
#pragma unroll
        for (int ai = 0; ai < 2; ++ai)
#pragma unroll
            for (int m = 0; m < 4; ++m) {
                const size_t off = (size_t)(row0 + ai * 128 + m * 16) * 1024 + col0;
#pragma unroll
                for (int bj = 0; bj < 2; ++bj) {
                    const u32x4 gw = *(const u32x4*)(G + off + bj * 128);
                    float g[8], o[8]; unpack8(gw, g);
                    if (first) {
#pragma unroll
                        for (int j = 0; j < 8; ++j) o[j] = 0.f; }
                    else { const u32x4 ow = *(const u32x4*)(MG + off + bj * 128); unpack8(ow, o); }
                    const f32x4 v0 = acc[ai][bj][m][0], v1 = acc[ai][bj][m][1];
#pragma unroll
                    for (int j = 0; j < 4; ++j) { o[j] += g[j] * v0[j]; o[4 + j] += g[4 + j] * v1[j]; }
                    u32x4 w; w.x = pg8::cvt_pk_bf16(o[0], o[1]); w.y = pg8::cvt_pk_bf16(o[2], o[3]); w.z = pg8::cvt_pk_bf16(o[4], o[5]); w.w = pg8::cvt_pk_bf16(o[6], o[7]);
                    *(u32x4*)(MG + off + bj * 128) = w;
                }
                asm volatile("" ::: "memory");
            }
    }
};
struct EpiGlu {
    static constexpr bool PERM = true, AFTER_DRAIN = false;
    const bf16_t* SZ; bf16_t* O; const float* bias;
    __device__ __forceinline__ void operator()(const f32x4 (&acc)[2][2][4][2], const Unit& u, int wr, int wc, int fr, int fq) const {
        const int row0 = u.pm * 256 + wr * 64 + fr, col0 = u.pn * 128 + wc * 32 + 8 * fq;
        float ba[8], bg[8];
#pragma unroll
        for (int j = 0; j < 8; ++j) { ba[j] = bias[col0 + j]; bg[j] = bias[1024 + col0 + j]; }
#pragma unroll
        for (int ai = 0; ai < 2; ++ai)
#pragma unroll
            for (int m = 0; m < 4; ++m) {
                const size_t off = (size_t)(row0 + ai * 128 + m * 16) * 1024 + col0;
                const u32x4 zw = *(const u32x4*)(SZ + off); float z[8], o[8]; unpack8(zw, z);
#pragma unroll
                for (int n = 0; n < 2; ++n)
#pragma unroll
                    for (int j = 0; j < 4; ++j) { const int c = 4 * n + j; o[c] = (acc[ai][0][m][n][j] + ba[c]) * sigmoidf_(acc[ai][1][m][n][j] + bg[c]) * z[c]; }
                u32x4 w; w.x = pg8::cvt_pk_bf16(o[0], o[1]); w.y = pg8::cvt_pk_bf16(o[2], o[3]); w.z = pg8::cvt_pk_bf16(o[4], o[5]); w.w = pg8::cvt_pk_bf16(o[6], o[7]);
                *(u32x4*)(O + off) = w;
            }
    }
};
struct EpiOut {
    static constexpr bool PERM = false, AFTER_DRAIN = false;
    const float* xlat_src; float* xlat_dst; const float* xctx_src; float* xctx_dst; const float* mod; int l; int row_off;
    __device__ __forceinline__ void operator()(const f32x4 (&acc)[2][2][4][2], const Unit& u, int wr, int wc, int fr, int fq) const {
        const int row0 = row_off + u.pm * 256 + wr * 64 + fr, col0 = u.pn * 256 + wc * 32 + 4 * fq;
#pragma unroll
        for (int ai = 0; ai < 2; ++ai)
#pragma unroll
            for (int m = 0; m < 4; ++m) {
                const int r = row0 + ai * 128 + m * 16;
                const float* xs; float* xd; const float* gp;
                if (r < CTXROWS) { xs = xctx_src + (size_t)r * 1024; xd = xctx_dst + (size_t)r * 1024; gp = mod + 8 * 3072 + 2048; }
                else { const int q = r - CTXROWS, b = q >> 12, p = lat_pos(l, q & 4095); const size_t o = ((size_t)b * 4096 + p) * 1024; xs = xlat_src + o; xd = xlat_dst + o; gp = mod + b * 3072 + 2048; }
#pragma unroll
                for (int bj = 0; bj < 2; ++bj)
#pragma unroll
                    for (int n = 0; n < 2; ++n) { const int c = col0 + bj * 128 + n * 16; const f32x4 x = *(const f32x4*)(xs + c), g = *(const f32x4*)(gp + c); *(f32x4*)(xd + c) = x + g * acc[ai][bj][m][n]; }
                asm volatile("" ::: "memory");
            }
    }
};

DI void ph_modp(const Args& a, float* modp, LAS float* sl) {
    for (int it = blockIdx.x; it < 384; it += gridDim.x) {
        const int l = it / 96, kq = (it / 6) % 16, nt = it % 6;
        __syncthreads();
        for (int i = ltid(); i < 576; i += NT) { const int j = i >> 6, k = kq * 64 + (i & 63); const float cv = (j < 8) ? a.in[I_C][j * 1024 + k] : a.in[I_CCTX][k]; sl[i] = siluf_(cv); }
        __syncthreads();
        const int n = nt * 512 + ltid();
        float acc[9];
#pragma unroll
        for (int j = 0; j < 9; ++j) acc[j] = 0.f;
        const float* w = a.in[I_WADA] + ((size_t)l * 1024 + kq * 64) * 3072 + n;
#pragma unroll 4
        for (int k = 0; k < 64; ++k) { const float wv = w[(size_t)k * 3072];
#pragma unroll
            for (int j = 0; j < 9; ++j) acc[j] += sl[j * 64 + k] * wv; }
#pragma unroll
        for (int j = 0; j < 9; ++j) modp[(((size_t)kq * 4 + l) * 9 + j) * 3072 + n] = acc[j];
    }
}
DI void ph_mod(const Args& a, const float* modp, float* mod) {
    for (int i = blockIdx.x * NT + ltid(); i < DEPTH * 9 * 3072; i += gridDim.x * NT) {
        const int l = i / (9 * 3072), n = i % 3072; float s = a.in[I_BADA][l * 3072 + n];
#pragma unroll
        for (int kq = 0; kq < 16; ++kq) s += modp[(size_t)kq * (DEPTH * 9 * 3072) + i];
        mod[i] = s;
    }
}
DI void ph_norm(const Args& a, int l, const float* xlat, const float* xctx, const float* mod, bf16_t* H) {
    const int wave = ltid() >> 6, lane = ltid() & 63;
    const float* g = a.in[I_NORMG] + l * 1024;
    for (int r = blockIdx.x * 8 + wave; r < MROWS; r += gridDim.x * 8) {
        const float* src; const float* md;
        if (r < CTXROWS) { src = xctx + (size_t)r * 1024; md = mod + 8 * 3072; }
        else { const int q = r - CTXROWS, b = q >> 12, p = lat_pos(l, q & 4095); src = xlat + ((size_t)b * 4096 + p) * 1024; md = mod + b * 3072; }
        f32x4 v[4]; float ss = 0.f;
#pragma unroll
        for (int i = 0; i < 4; ++i) { v[i] = *(const f32x4*)(src + i * 256 + lane * 4); ss += v[i][0] * v[i][0] + v[i][1] * v[i][1] + v[i][2] * v[i][2] + v[i][3] * v[i][3]; }
        ss = wave_sum(ss);
        const float rs = rsqrtf(ss * (1.0f / 1024.0f) + 1e-6f);
#pragma unroll
        for (int i = 0; i < 4; ++i) { const int c = i * 256 + lane * 4;
            const f32x4 gv = *(const f32x4*)(g + c), sh = *(const f32x4*)(md + c), sc = *(const f32x4*)(md + 1024 + c);
            const f32x4 y = (v[i] * rs) * gv * (sc + 1.0f) + sh;
            u32x2 w; w.x = pg8::cvt_pk_bf16(y[0], y[1]); w.y = pg8::cvt_pk_bf16(y[2], y[3]);
            *(u32x2*)(H + (size_t)r * 1024 + c) = w; }
    }
}
DI void ph_final(const Args& a, float* x) {
    const int wave = ltid() >> 6, lane = ltid() & 63;
    const float* g = a.in[I_FNORM];
    for (int r = blockIdx.x * 8 + wave; r < NBATCH * SEQ; r += gridDim.x * 8) {
        float* src = x + (size_t)r * 1024;
        f32x4 v[4]; float ss = 0.f;
#pragma unroll
        for (int i = 0; i < 4; ++i) { v[i] = *(const f32x4*)(src + i * 256 + lane * 4); ss += v[i][0] * v[i][0] + v[i][1] * v[i][1] + v[i][2] * v[i][2] + v[i][3] * v[i][3]; }
        ss = wave_sum(ss);
        const float rs = rsqrtf(ss * (1.0f / 1024.0f) + 1e-6f);
#pragma unroll
        for (int i = 0; i < 4; ++i) { const int c = i * 256 + lane * 4; const f32x4 gv = *(const f32x4*)(g + c); *(f32x4*)(src + c) = (v[i] * rs) * gv; }
    }
}
struct WDesc { const float* src; int ld, id, n64; };
DI void wmap(int id, int nb, int& col, int& valid) {
    valid = 64;
    switch (id) {
        case 0: if (nb < 48) col = C_GQ + 64 * nb; else if (nb == 48) { col = C_GA; valid = 32; } else { col = 0; valid = 0; } break;
        case 1: col = (nb < 16) ? C_GZ + 64 * nb : C_GATE + 64 * (nb - 16); break;
        case 2: if (nb < 48) col = C_MQ + 64 * nb; else if (nb == 48) { col = C_MI; valid = 16; } else { col = 0; valid = 0; } break;
        case 3: col = (nb < 32) ? C_MO + 64 * nb : C_GATE + 2048 + 64 * (nb - 32); break;
        case 4: col = (nb < 32) ? C_SU + 64 * nb : C_GATE + 1024 + 64 * (nb - 32); break;
        case 5: { const int pn = nb >> 2, q = nb & 3; col = (q >> 1) * 1024 + 128 * pn + (q & 1) * 64; } break;
        default: col = 64 * nb; break;
    }
}
DI WDesc wdesc(const Args& a, int l, int id) {
    WDesc w; w.id = id;
    if (id <= 4) { w.src = a.in[I_WIN] + (size_t)l * 1024 * NIN; w.ld = NIN; w.n64 = (id == 0 || id == 2) ? 52 : (id == 1 ? 32 : 48); }
    else if (id == 5) { w.src = a.in[I_SWGLU] + (size_t)l * 1024 * 2048; w.ld = 2048; w.n64 = 32; }
    else if (id <= 8) { w.src = a.in[I_WBR] + ((size_t)l * 3 + (id - 6)) * 1024 * 1024; w.ld = 1024; w.n64 = 16; }
    else { w.src = a.in[I_WOUT] + (size_t)l * 1024 * 1024; w.ld = 1024; w.n64 = 16; }
    return w;
}
DI void ph_cvt(const WDesc w, bf16_t* dst, LAS float* tile) {
    const int tid = ltid(), ntile = w.n64 * 16;
    for (int t = blockIdx.x; t < ntile; t += gridDim.x) {
        const int nb = t >> 4, kb = t & 15; int col, valid; wmap(w.id, nb, col, valid);
        __syncthreads();
        { const int c = tid & 63, k0 = tid >> 6;
#pragma unroll
          for (int i = 0; i < 8; ++i) { const int k = k0 + 8 * i; tile[k * 65 + c] = (c < valid) ? w.src[(size_t)(kb * 64 + k) * w.ld + col + c] : 0.f; } }
        __syncthreads();
        { const int n = tid >> 3, kk = (tid & 7) * 8; u32x4 o;
          o.x = pg8::cvt_pk_bf16(tile[(kk + 0) * 65 + n], tile[(kk + 1) * 65 + n]); o.y = pg8::cvt_pk_bf16(tile[(kk + 2) * 65 + n], tile[(kk + 3) * 65 + n]);
          o.z = pg8::cvt_pk_bf16(tile[(kk + 4) * 65 + n], tile[(kk + 5) * 65 + n]); o.w = pg8::cvt_pk_bf16(tile[(kk + 6) * 65 + n], tile[(kk + 7) * 65 + n]);
          *(u32x4*)(dst + (size_t)(nb * 64 + n) * 1024 + kb * 64 + kk) = o; }
    }
    __syncthreads();
}

DI void ph_gdn_conv(const Args& a, int l, bf16_t* QKV  , const bf16_t* halo, LAS unsigned char* lds) {
    LAS bf16_t* raw = (LAS bf16_t*)lds;
    constexpr int P = 136;
    const int tid = ltid();
    const float* cw = a.in[I_GCONV] + (size_t)l * 5 * 3072;
    for (int unit = blockIdx.x; unit < NCHUNK * 24; unit += gridDim.x) {
        const int cb = unit / 24, seg = (unit % 24) >> 3, h = unit & 7;
        bf16_t* T = QKV + (size_t)seg * (SZ_ACT / 2);
        const bool first = (cb < 32) ? ((cb & 3) == 0) : (((cb - 32) & 63) == 0);
        const bool last = (cb < 32) ? ((cb & 3) == 3) : (((cb - 32) & 63) == 63);
        __syncthreads();
        for (int i = tid; i < 68 * 16; i += NT) {
            const int rr = i >> 4, c8 = (i & 15) * 8; u32x4 w = (u32x4){0u, 0u, 0u, 0u};
            if (rr >= 2 && rr < 66) w = *(const u32x4*)(T + (size_t)(cb * 64 + rr - 2) * 1024 + h * 128 + c8);
            else if (rr < 2) { if (!first) w = *(const u32x4*)(halo + ((size_t)seg * (NCHUNK * 4) + (size_t)(cb - 1) * 4 + 2 + rr) * 1024 + h * 128 + c8); }
            else { if (!last) w = *(const u32x4*)(halo + ((size_t)seg * (NCHUNK * 4) + (size_t)(cb + 1) * 4 + (rr - 66)) * 1024 + h * 128 + c8); }
            *(LAS u32x4*)(raw + rr * P + c8) = w;
        }
        __syncthreads();
        const int t = tid >> 3, c0 = (tid & 7) * 16;
        float o[16]; float ss = 0.f;
#pragma unroll
        for (int half = 0; half < 2; ++half) {
            float acc[8];
#pragma unroll
            for (int j = 0; j < 8; ++j) acc[j] = 0.f;
#pragma unroll
            for (int k = 0; k < 5; ++k) {
                const u32x4 w = *(const LAS u32x4*)(raw + (t + k) * P + c0 + half * 8); float x[8]; unpack8(w, x);
                const float* wp = cw + (size_t)k * 3072 + seg * 1024 + h * 128 + c0 + half * 8;
                const f32x4 w0 = *(const f32x4*)wp, w1 = *(const f32x4*)(wp + 4);
#pragma unroll
                for (int j = 0; j < 4; ++j) { acc[j] += w0[j] * x[j]; acc[4 + j] += w1[j] * x[4 + j]; }
            }
#pragma unroll
            for (int j = 0; j < 8; ++j) { const float s = siluf_(acc[j]); o[half * 8 + j] = s; ss += s * s; }
        }
        ss += __shfl_xor(ss, 1); ss += __shfl_xor(ss, 2); ss += __shfl_xor(ss, 4);
        float scale = 1.0f;
        if (seg == 0) scale = rsqrtf(ss + 1e-6f) * 0.08838834764831845f;
        else if (seg == 1) scale = rsqrtf(ss + 1e-6f);
        u32x4 w0, w1;
        w0.x = pg8::cvt_pk_bf16(o[0] * scale, o[1] * scale); w0.y = pg8::cvt_pk_bf16(o[2] * scale, o[3] * scale); w0.z = pg8::cvt_pk_bf16(o[4] * scale, o[5] * scale); w0.w = pg8::cvt_pk_bf16(o[6] * scale, o[7] * scale);
        w1.x = pg8::cvt_pk_bf16(o[8] * scale, o[9] * scale); w1.y = pg8::cvt_pk_bf16(o[10] * scale, o[11] * scale); w1.z = pg8::cvt_pk_bf16(o[12] * scale, o[13] * scale); w1.w = pg8::cvt_pk_bf16(o[14] * scale, o[15] * scale);
        bf16_t* op = T + (size_t)(cb * 64 + t) * 1024 + h * 128 + c0;
        *(u32x4*)op = w0; *(u32x4*)(op + 8) = w1;
    }
    __syncthreads();
}
DI void ph_gdn_scan(const Args& a, int l, const bf16_t* Q, const bf16_t* K, const bf16_t* V, const float* GATE, bf16_t* OF, bf16_t* OB, LAS unsigned char* lds) {
    LAS float* qf = (LAS float*)lds;
    LAS float* kf = qf + 64 * 128;
    LAS float* vf = kf + 64 * 128;
    LAS float* av = vf + 64 * 64;
    LAS float* bt = av + 64;
    LAS float* part = bt + 64;
    LAS float* po = part + 1024;
    const int tid = ltid(), e = tid & 63, dq = tid >> 6;
    for (int unit = blockIdx.x; unit < 256; unit += gridDim.x) {
        const int eh = unit & 1, d = (unit >> 1) & 1, h = (unit >> 2) & 7, b = unit >> 5;
        const float nea = -__expf(a.in[I_GALOG][(l * 2 + d) * 8 + h]), dtb = a.in[I_GDTB][(l * 2 + d) * 8 + h];
        bf16_t* O = d ? OB : OF;
        float S[16];
#pragma unroll
        for (int j = 0; j < 16; ++j) S[j] = 0.f;
        float opart = 0.f; int prow = -1, par = 0;
        for (int step = 0; step < 68; ++step) {
            const int cc = (step < 4) ? (d ? 3 - step : step) : (d ? 67 - step : step - 4);
            const int row0 = (step < 4) ? b * 256 + cc * 64 : CTXROWS + b * 4096 + cc * 64;
            __syncthreads();
            for (int i = tid; i < 1024; i += NT) { const int r = i >> 4, c8 = (i & 15) * 8; float f[8];
                unpack8(*(const u32x4*)(Q + (size_t)(row0 + r) * 1024 + h * 128 + c8), f);
#pragma unroll
                for (int j = 0; j < 8; ++j) qf[r * 128 + c8 + j] = f[j];
                unpack8(*(const u32x4*)(K + (size_t)(row0 + r) * 1024 + h * 128 + c8), f);
#pragma unroll
                for (int j = 0; j < 8; ++j) kf[r * 128 + c8 + j] = f[j]; }
            { const int r = tid >> 3, c8 = (tid & 7) * 8; float f[8]; unpack8(*(const u32x4*)(V + (size_t)(row0 + r) * 1024 + h * 128 + eh * 64 + c8), f);
#pragma unroll
              for (int j = 0; j < 8; ++j) vf[r * 64 + c8 + j] = f[j]; }
            if (tid < 64) { const float* gp = GATE + (size_t)(row0 + tid) * 32; av[tid] = __expf(nea * softplusf_(gp[d * 8 + h] + dtb)); bt[tid] = sigmoidf_(gp[16 + d * 8 + h]); }
            __syncthreads();
            for (int tt = 0; tt < 64; ++tt) {
                const int t = d ? 63 - tt : tt;
                float kk[16];
#pragma unroll
                for (int j4 = 0; j4 < 4; ++j4) { const f32x4 x = *(const LAS f32x4*)(kf + t * 128 + dq * 16 + j4 * 4); kk[j4 * 4] = x[0]; kk[j4 * 4 + 1] = x[1]; kk[j4 * 4 + 2] = x[2]; kk[j4 * 4 + 3] = x[3]; }
                float p = 0.f;
#pragma unroll
                for (int j = 0; j < 16; ++j) p += kk[j] * S[j];
                part[(par * 8 + dq) * 64 + e] = p; po[(par * 8 + dq) * 64 + e] = opart;
                __syncthreads();
                if (dq == 0 && prow >= 0) { float o = 0.f;
#pragma unroll
                    for (int q = 0; q < 8; ++q) o += po[(par * 8 + q) * 64 + e];
                    O[(size_t)prow * 1024 + h * 128 + eh * 64 + e] = f2bf(o); }
                float ks = 0.f;
#pragma unroll
                for (int q = 0; q < 8; ++q) ks += part[(par * 8 + q) * 64 + e];
                const float at = av[t], vn = bt[t] * (vf[t * 64 + e] - at * ks);
#pragma unroll
                for (int j = 0; j < 16; ++j) S[j] = at * S[j] + kk[j] * vn;
                float qo = 0.f;
#pragma unroll
                for (int j4 = 0; j4 < 4; ++j4) { const f32x4 x = *(const LAS f32x4*)(qf + t * 128 + dq * 16 + j4 * 4); qo += x[0] * S[j4 * 4] + x[1] * S[j4 * 4 + 1] + x[2] * S[j4 * 4 + 2] + x[3] * S[j4 * 4 + 3]; }
                opart = qo; prow = row0 + t; par ^= 1;
            }
        }
        po[(par * 8 + dq) * 64 + e] = opart;
        __syncthreads();
        if (dq == 0) { float o = 0.f;
#pragma unroll
            for (int q = 0; q < 8; ++q) o += po[(par * 8 + q) * 64 + e];
            O[(size_t)prow * 1024 + h * 128 + eh * 64 + e] = f2bf(o); }
        __syncthreads();
    }
}
DI void ph_gdn_post(const Args& a, int l, bf16_t* OF, const bf16_t* OB, const bf16_t* SZ) {
    const int wave = ltid() >> 6, lane = ltid() & 63;
    const float* g = a.in[I_GNORM] + l * 128;
    const float g0 = g[2 * lane], g1 = g[2 * lane + 1];
    for (int it = blockIdx.x * 8 + wave; it < MROWS * 8; it += gridDim.x * 8) {
        const size_t off = (size_t)(it >> 3) * 1024 + (it & 7) * 128 + 2 * lane;
        const unsigned wf = *(const unsigned*)(OF + off), wb = *(const unsigned*)(OB + off), wz = *(const unsigned*)(SZ + off);
        const float o0 = bflo(wf) + bflo(wb), o1 = bfhi(wf) + bfhi(wb);
        const float ss = wave_sum(o0 * o0 + o1 * o1);
        const float rs = rsqrtf(ss * (1.0f / 128.0f) + 1e-6f);
        *(unsigned*)(OF + off) = pg8::cvt_pk_bf16(o0 * rs * g0 * bflo(wz), o1 * rs * g1 * bfhi(wz));
    }
}

DI void ph_ml_scan(const Args& a, int l, const bf16_t* Q, const bf16_t* K, const bf16_t* V, const float* GATE, bf16_t* HF, bf16_t* HB, LAS unsigned char* lds) {
    LAS bf16_t* qs = (LAS bf16_t*)lds;
    LAS bf16_t* ks = qs + 64 * 256;
    LAS float* vf = (LAS float*)(ks + 64 * 256);
    LAS float* ip = vf + 64 * 64;
    LAS float* lf = ip + 64;
    LAS float* part = lf + 64;
    LAS float* dpart = part + 1024;
    const int tid = ltid(), e = tid & 63, dq = tid >> 6;
    for (int unit = blockIdx.x; unit < 256; unit += gridDim.x) {
        const int eq = unit & 3, d = (unit >> 2) & 1, hd = (unit >> 3) & 3, b = unit >> 5;
        const float ibias = a.in[I_MIB][(l * 2 + d) * 4 + hd], fbias = a.in[I_MFB][(l * 2 + d) * 4 + hd];
        bf16_t* HO = d ? HB : HF;
        float C[32];
#pragma unroll
        for (int j = 0; j < 32; ++j) C[j] = 0.f;
        float nn = 0.f, m = 0.f; int par = 0;
        for (int step = 0; step < 68; ++step) {
            const int cc = (step < 4) ? (d ? 3 - step : step) : (d ? 67 - step : step - 4);
            const int row0 = (step < 4) ? b * 256 + cc * 64 : CTXROWS + b * 4096 + cc * 64;
            __syncthreads();
            for (int i = tid; i < 2048; i += NT) { const int r = i >> 5, c8 = (i & 31) * 8;
                *(LAS u32x4*)(qs + r * 256 + c8) = *(const u32x4*)(Q + (size_t)(row0 + r) * 1024 + hd * 256 + c8);
                *(LAS u32x4*)(ks + r * 256 + c8) = *(const u32x4*)(K + (size_t)(row0 + r) * 1024 + hd * 256 + c8); }
            { const int r = tid >> 3, c8 = (tid & 7) * 8; float f[8]; unpack8(*(const u32x4*)(V + (size_t)(row0 + r) * 1024 + hd * 256 + eq * 64 + c8), f);
#pragma unroll
              for (int j = 0; j < 8; ++j) vf[r * 64 + c8 + j] = f[j]; }
            if (tid < 64) { const float* gp = GATE + (size_t)(row0 + tid) * 32; ip[tid] = gp[d * 4 + hd] + ibias; lf[tid] = -softplusf_(-(gp[8 + d * 4 + hd] + fbias)); }
            __syncthreads();
            for (int tt = 0; tt < 64; ++tt) {
                const int t = d ? 63 - tt : tt;
                const float it = ip[t], ft = lf[t];
                const float mn = fmaxf(ft + m, it);
                const float fdec = __expf(ft + m - mn), iw = __expf(it - mn) * 0.0625f, nrm = __expf(-mn);
                m = mn;
                const float vv = iw * vf[t * 64 + e];
                float pn = 0.f;
#pragma unroll
                for (int j8 = 0; j8 < 4; ++j8) {
                    float kk[8], qq[8];
                    unpack8(*(const LAS u32x4*)(ks + t * 256 + dq * 32 + j8 * 8), kk);
                    unpack8(*(const LAS u32x4*)(qs + t * 256 + dq * 32 + j8 * 8), qq);
#pragma unroll
                    for (int j = 0; j < 8; ++j) { const float c = fdec * C[j8 * 8 + j] + vv * kk[j]; C[j8 * 8 + j] = c; pn += c * qq[j]; }
                }
                const int dn = dq * 32 + (e & 31);
                nn = fdec * nn + iw * bf2f(ks[t * 256 + dn]);
                float pd = (e < 32) ? nn * bf2f(qs[t * 256 + dn]) : 0.f;
                pd = wave_sum(pd);
                part[(par * 8 + dq) * 64 + e] = pn; if (e == 0) dpart[par * 8 + dq] = pd;
                __syncthreads();
                if (dq == 0) { float num = 0.f, den = 0.f;
#pragma unroll
                    for (int q = 0; q < 8; ++q) { num += part[(par * 8 + q) * 64 + e]; den += dpart[par * 8 + q]; }
                    HO[(size_t)(row0 + t) * 1024 + hd * 256 + eq * 64 + e] = f2bf(num / fmaxf(fabsf(den), nrm)); }
                par ^= 1;
            }
        }
        __syncthreads();
    }
}
DI void ph_ml_post(const Args& a, int l, bf16_t* HF, const bf16_t* HB, const bf16_t* SO, const bf16_t* SZ) {
    const int wave = ltid() >> 6, lane = ltid() & 63;
    const f32x4 g = *(const f32x4*)(a.in[I_MNORM] + l * 256 + 4 * lane);
    for (int it = blockIdx.x * 8 + wave; it < MROWS * 4; it += gridDim.x * 8) {
        const size_t off = (size_t)(it >> 2) * 1024 + (it & 3) * 256 + 4 * lane;
        const u32x2 wf = *(const u32x2*)(HF + off), wb = *(const u32x2*)(HB + off), wo = *(const u32x2*)(SO + off), wz = *(const u32x2*)(SZ + off);
        const float h0 = (bflo(wf.x) + bflo(wb.x)) * bflo(wo.x), h1 = (bfhi(wf.x) + bfhi(wb.x)) * bfhi(wo.x), h2 = (bflo(wf.y) + bflo(wb.y)) * bflo(wo.y), h3 = (bfhi(wf.y) + bfhi(wb.y)) * bfhi(wo.y);
        const float ss = wave_sum(h0 * h0 + h1 * h1 + h2 * h2 + h3 * h3);
        const float rs = rsqrtf(ss * (1.0f / 256.0f) + 1e-6f);
        u32x2 w; w.x = pg8::cvt_pk_bf16(h0 * rs * g[0] * bflo(wz.x), h1 * rs * g[1] * bfhi(wz.x)); w.y = pg8::cvt_pk_bf16(h2 * rs * g[2] * bflo(wz.y), h3 * rs * g[3] * bfhi(wz.y));
        *(u32x2*)(HF + off) = w;
    }
}

DI void ph_s5_scan(const Args& a, int l, const bf16_t* U, bf16_t* YF, bf16_t* YB, LAS unsigned char* lds) {
    const int tid = ltid(), w = tid >> 6, p = tid & 63;
    LAS float* ub = (LAS float*)lds + w * 2304;
    LAS float* yb = ub + 1024;
    LAS float* xb = yb + 1024;
    for (int unit = blockIdx.x; unit < 128; unit += gridDim.x) {
        const int gb = unit & 7, d = (unit >> 3) & 1, b = unit >> 4, g = gb * 8 + w;
        const float stp = expf(a.in[I_SLOG][(l * 2 + d) * 64 + g]);
        const float lre = a.in[I_SLRE][((size_t)(l * 2 + d) * 64 + g) * 64 + p], lim = a.in[I_SLIM][((size_t)(l * 2 + d) * 64 + g) * 64 + p];
        const float mag = expf(lre * stp), lbr = mag * cosf(lim * stp), lbi = mag * sinf(lim * stp);
        const float dnm = lre * lre + lim * lim;
        const float fre = ((lbr - 1.0f) * lre + lbi * lim) / dnm, fim = (lbi * lre - (lbr - 1.0f) * lim) / dnm;
        float bbr[16], bbi[16];
        { const float* br = a.in[I_SBRE] + (((size_t)l * 64 + g) * 64 + p) * 16; const float* bi = a.in[I_SBIM] + (((size_t)l * 64 + g) * 64 + p) * 16;
#pragma unroll
          for (int h = 0; h < 16; ++h) { bbr[h] = fre * br[h] - fim * bi[h]; bbi[h] = fre * bi[h] + fim * br[h]; } }
        const int hh = p & 15, pt = p >> 4;
        float cr[16], ci[16];
        { const float* c0 = a.in[I_SCRE] + (((size_t)l * 64 + g) * 16 + hh) * 64 + pt * 16; const float* c1 = a.in[I_SCIM] + (((size_t)l * 64 + g) * 16 + hh) * 64 + pt * 16;
#pragma unroll
          for (int j = 0; j < 16; ++j) { cr[j] = c0[j]; ci[j] = c1[j]; } }
        bf16_t* Y = d ? YB : YF;
        float xr = 0.f, xi = 0.f; int par = 0;
        for (int step = 0; step < 68; ++step) {
            const int cc = (step < 4) ? (d ? 3 - step : step) : (d ? 67 - step : step - 4);
            const int row0 = (step < 4) ? b * 256 + cc * 64 : CTXROWS + b * 4096 + cc * 64;
            __syncthreads();
            { const bf16_t* up = U + (size_t)(row0 + p) * 1024 + g * 16; float f[8];
              unpack8(*(const u32x4*)up, f);
#pragma unroll
              for (int j = 0; j < 8; ++j) ub[p * 16 + j] = f[j];
              unpack8(*(const u32x4*)(up + 8), f);
#pragma unroll
              for (int j = 0; j < 8; ++j) ub[p * 16 + 8 + j] = f[j]; }
            __syncthreads();
            for (int tt = 0; tt < 64; ++tt) {
                const int t = d ? 63 - tt : tt;
                float bur = 0.f, bui = 0.f;
#pragma unroll
                for (int h4 = 0; h4 < 4; ++h4) { const f32x4 u = *(const LAS f32x4*)(ub + t * 16 + h4 * 4);
#pragma unroll
                    for (int j = 0; j < 4; ++j) { bur += bbr[h4 * 4 + j] * u[j]; bui += bbi[h4 * 4 + j] * u[j]; } }
                const float nxr = lbr * xr - lbi * xi + bur, nxi = lbr * xi + lbi * xr + bui;
                xr = nxr; xi = nxi;
                xb[par * 128 + p] = xr; xb[par * 128 + 64 + p] = xi;
                __syncthreads();
                float y = 0.f;
#pragma unroll
                for (int j4 = 0; j4 < 4; ++j4) { const f32x4 vr = *(const LAS f32x4*)(xb + par * 128 + pt * 16 + j4 * 4), vi = *(const LAS f32x4*)(xb + par * 128 + 64 + pt * 16 + j4 * 4);
#pragma unroll
                    for (int j = 0; j < 4; ++j) y += cr[j4 * 4 + j] * vr[j] - ci[j4 * 4 + j] * vi[j]; }
                y += __shfl_xor(y, 16); y += __shfl_xor(y, 32);
                if (p < 16) yb[t * 16 + p] = y;
                par ^= 1;
            }
            __syncthreads();
            { u32x4 w0, w1; const LAS float* ys = yb + p * 16;
              w0.x = pg8::cvt_pk_bf16(ys[0], ys[1]); w0.y = pg8::cvt_pk_bf16(ys[2], ys[3]); w0.z = pg8::cvt_pk_bf16(ys[4], ys[5]); w0.w = pg8::cvt_pk_bf16(ys[6], ys[7]);
              w1.x = pg8::cvt_pk_bf16(ys[8], ys[9]); w1.y = pg8::cvt_pk_bf16(ys[10], ys[11]); w1.z = pg8::cvt_pk_bf16(ys[12], ys[13]); w1.w = pg8::cvt_pk_bf16(ys[14], ys[15]);
              bf16_t* yp = Y + (size_t)(row0 + p) * 1024 + g * 16; *(u32x4*)yp = w0; *(u32x4*)(yp + 8) = w1; }
        }
        __syncthreads();
    }
}
DI void ph_s5_post(const Args& a, int l, bf16_t* YF, const bf16_t* YB, const bf16_t* U) {
    const float* dsk = a.in[I_SD] + l * 1024;
    for (size_t i = (size_t)blockIdx.x * NT + ltid(); i < (size_t)MROWS * 128; i += (size_t)gridDim.x * NT) {
        const size_t off = i * 8; const int c = (int)(off & 1023);
        float f[8], bq[8], u[8]; unpack8(*(const u32x4*)(YF + off), f); unpack8(*(const u32x4*)(YB + off), bq); unpack8(*(const u32x4*)(U + off), u);
        const f32x4 d0 = *(const f32x4*)(dsk + c), d1 = *(const f32x4*)(dsk + c + 4);
        float o[8];
#pragma unroll
        for (int j = 0; j < 4; ++j) { o[j] = gelu_tanh_(f[j] + bq[j] + d0[j] * u[j]); o[4 + j] = gelu_tanh_(f[4 + j] + bq[4 + j] + d1[j] * u[4 + j]); }
        u32x4 w; w.x = pg8::cvt_pk_bf16(o[0], o[1]); w.y = pg8::cvt_pk_bf16(o[2], o[3]); w.z = pg8::cvt_pk_bf16(o[4], o[5]); w.w = pg8::cvt_pk_bf16(o[6], o[7]);
        *(u32x4*)(YF + off) = w;
    }
}

constexpr int NPH_LAYER = 18, PH_FINAL = 2 + DEPTH * NPH_LAYER, NPHASE = PH_FINAL + 1;
template <class Epi>
DI void run_gemm(LAS unsigned char* lds, const bf16_t* A, const bf16_t* Bt, int M, int N, const Epi& E) {
    pg8::Gemm g{A, Bt, M, N, 1024}; pg8::StaticOrder S; S.init(M, N, (int)gridDim.x, (int)blockIdx.x);
    pg8::gemm_phase<Epi, pg8::StaticOrder, false>(lds, g, S, E, nullptr);
}
__global__ void __launch_bounds__(NT, 2) hy_fwd(Args ka) {
    extern __shared__ __attribute__((aligned(16))) unsigned char lds_raw[];
    LAS unsigned char* lds = (LAS unsigned char*)lds_raw;
    volatile LAS unsigned* xbw = (volatile LAS unsigned*)(lds + 131072);
    if (threadIdx.x < 4) xbw[threadIdx.x] = 0u;
    __syncthreads();
    const int lo = ka.ph_lo, hi = ka.ph_hi;
    XcdBarrier bar; bar.bar = (unsigned*)(ka.ws + WS_CTL); bar.x = 0u; bar.st = xbw;
    if (hi - lo > 1) bar = xcd_barrier_post((unsigned*)(ka.ws + WS_CTL), xbw);
#ifdef PH_ONLY
#define PHEN(p) ((p) == PH_ONLY)
#else
#define PHEN(p) 1
#endif
#define IN(k) (lo <= (k) && (k) < hi)
#define INL(p) (PHEN(p) && IN(pb + (p)))
#define SEAM(k) do { if (IN((k) + 1)) xcd_barrier(bar); } while (0)
#define PH_LOAD \
    Args a; __builtin_memcpy(&a, args_ptr(), sizeof(Args)); \
    unsigned char* ws = a.ws; \
    float* MOD = (float*)(ws + WS_MOD); float* XCTX = (float*)(ws + WS_XCTX); \
    bf16_t* H = (bf16_t*)(ws + WS_H); bf16_t* MERGED = (bf16_t*)(ws + WS_MERGED); \
    bf16_t* WB0 = (bf16_t*)(ws + WS_WB0); bf16_t* WB1 = (bf16_t*)(ws + WS_WB1); \
    unsigned char* R = ws + WS_R; \
    bf16_t* P0 = (bf16_t*)(R + R_P0); bf16_t* P1 = (bf16_t*)(R + R_P1); bf16_t* P2 = (bf16_t*)(R + R_P2); bf16_t* OF = (bf16_t*)(R + R_OF); bf16_t* OB = (bf16_t*)(R + R_OB); \
    float* GATE2 = (float*)(R + R_G2); \
    float* GATE1 = (float*)(ws + WS_MERGED); bf16_t* HALO = (bf16_t*)(ws + WS_MERGED + SZ_GATE);     \
    float* MODP = (float*)R; \
    const float* xlat_src = l == 0 ? a.in[I_X] : a.out; const float* xctx_src = l == 0 ? a.in[I_CTX] : XCTX; const float* modl = MOD + (size_t)l * 9 * 3072; \
    (void)MOD; (void)XCTX; (void)H; (void)MERGED; (void)WB0; (void)WB1; (void)P0; (void)P1; (void)P2; (void)OF; (void)OB; (void)GATE2; (void)GATE1; (void)HALO; (void)MODP; (void)xlat_src; (void)xctx_src; (void)modl;
    LAS float* ldsf = (LAS float*)lds;

    { const int l = 0;
    if (PHEN(100) && IN(0)) { PH_LOAD; ph_modp(a, MODP, ldsf); SEAM(0); }
    if (PHEN(101) && IN(1)) { PH_LOAD; ph_mod(a, MODP, MOD); SEAM(1); } }
    for (int l = 0; l < DEPTH; ++l) {
        const int pb = 2 + l * NPH_LAYER;
        if (INL(0)) { PH_LOAD; ph_norm(a, l, xlat_src, xctx_src, modl, H); ph_cvt(wdesc(a, l, 0), WB0, ldsf); SEAM(pb + 0); }
        if (INL(1)) { PH_LOAD; EpiProj E{P0, 0, GATE1, 12, HALO}; run_gemm(lds, H, WB0, MROWS, 3328, E); SEAM(pb + 1); }
        if (INL(2)) { PH_LOAD; ph_gdn_conv(a, l, P0, HALO, lds); ph_cvt(wdesc(a, l, 1), WB1, ldsf); SEAM(pb + 2); }
        if (INL(3)) { PH_LOAD; ph_gdn_scan(a, l, P0, P1, P2, GATE1, OF, OB, lds); SEAM(pb + 3); }
        if (INL(4)) { PH_LOAD; EpiProj E{P0, 9, nullptr, -1, nullptr}; run_gemm(lds, H, WB1, MROWS, 2048, E); SEAM(pb + 4); }
        if (INL(5)) { PH_LOAD; ph_gdn_post(a, l, OF, OB, P0); ph_cvt(wdesc(a, l, 6), WB0, ldsf); SEAM(pb + 5); }
        if (INL(6)) { PH_LOAD; ph_cvt(wdesc(a, l, 2), WB1, ldsf); EpiBranch E{P1, MERGED, 1}; run_gemm(lds, OF, WB0, MROWS, 1024, E); SEAM(pb + 6); }
        if (INL(7)) { PH_LOAD; ph_cvt(wdesc(a, l, 3), WB0, ldsf); EpiProj E{P0, 0, GATE2, 12, nullptr}; run_gemm(lds, H, WB1, MROWS, 3328, E); SEAM(pb + 7); }
        if (INL(8)) { PH_LOAD; ph_ml_scan(a, l, P0, P1, P2, GATE2, OF, OB, lds); SEAM(pb + 8); }
        if (INL(9)) { PH_LOAD; ph_cvt(wdesc(a, l, 8), WB1, ldsf); EpiProj E{P0, 38, nullptr, -1, nullptr}; run_gemm(lds, H, WB0, MROWS, 3072, E); SEAM(pb + 9); }
        if (INL(10)) { PH_LOAD; ph_ml_post(a, l, OF, OB, P0, P1); SEAM(pb + 10); }
        if (INL(11)) { PH_LOAD; ph_cvt(wdesc(a, l, 4), WB0, ldsf); EpiBranch E{P2, MERGED, 0}; run_gemm(lds, OF, WB1, MROWS, 1024, E); SEAM(pb + 11); }
        if (INL(12)) { PH_LOAD; ph_cvt(wdesc(a, l, 5), WB1, ldsf); EpiProj E{P0, 36, nullptr, -1, nullptr}; run_gemm(lds, H, WB0, MROWS, 3072, E); SEAM(pb + 12); }
        if (INL(13)) { PH_LOAD; ph_s5_scan(a, l, P0, OF, OB, lds); SEAM(pb + 13); }
        if (INL(14)) { PH_LOAD; ph_s5_post(a, l, OF, OB, P0); SEAM(pb + 14); }
        if (INL(15)) { PH_LOAD; ph_cvt(wdesc(a, l, 7), WB0, ldsf); EpiGlu E{P1, OB, a.in[I_SBGLU] + l * 2048}; run_gemm(lds, OF, WB1, MROWS, 2048, E); SEAM(pb + 15); }
        if (INL(16)) { PH_LOAD; ph_cvt(wdesc(a, l, 9), WB1, ldsf); EpiBranch E{P2, MERGED, 0}; run_gemm(lds, OB, WB0, MROWS, 1024, E); SEAM(pb + 16); }
        if (INL(17)) { PH_LOAD;
            const int ro = (l == DEPTH - 1) ? CTXROWS : 0;
            EpiOut E{xlat_src, a.out, xctx_src, XCTX, modl, l, ro};
            run_gemm(lds, MERGED + (size_t)ro * 1024, WB1, MROWS - ro, 1024, E);
            SEAM(pb + 17);
        }
    }
    if (PHEN(102) && IN(PH_FINAL)) { const int l = 0; PH_LOAD; ph_final(a, a.out); }
#undef IN
#undef SEAM
#undef PH_LOAD
}
}

#ifndef MK_LAUNCHES
#define MK_LAUNCHES 1
#endif
extern "C" void kernel_launch(void* const* d_in, const int* in_sizes, int n_in, void* d_out, int out_size, void* d_ws, size_t ws_size, hipStream_t stream) {
    static int grid = 0;
    if (grid == 0) {
        if (n_in != 28 || out_size != hy::NBATCH * hy::SEQ * hy::D || ws_size < hy::WS_END) { fprintf(stderr, "kernel_launch: unexpected shapes (n_in %d, out %d, ws %zu < %zu)\n", n_in, out_size, ws_size, (size_t)hy::WS_END); grid = -1; return; }
        int dev = 0, cus = 0, per_cu = 0;
        if (hipGetDevice(&dev) != hipSuccess || hipDeviceGetAttribute(&cus, hipDeviceAttributeMultiprocessorCount, dev) != hipSuccess) { grid = -1; return; }
        if (hipFuncSetAttribute((const void*)hy::hy_fwd, hipFuncAttributeMaxDynamicSharedMemorySize, hy::LDS_BYTES) != hipSuccess) { fprintf(stderr, "kernel_launch: hipFuncSetAttribute failed\n"); grid = -1; return; }
        if (hipOccupancyMaxActiveBlocksPerMultiprocessor(&per_cu, (const void*)hy::hy_fwd, hy::NT, hy::LDS_BYTES) != hipSuccess || per_cu < 1) { fprintf(stderr, "kernel_launch: occupancy query says %d\n", per_cu); (void)hipGetLastError(); }
        grid = cus;
    }
    if (grid < 0) return;
    (void)hipMemsetAsync((char*)d_ws + hy::WS_CTL, 0, 65536, stream);
    hy::Args a{};
    for (int i = 0; i < 28; ++i) a.in[i] = (const float*)d_in[i];
    a.out = (float*)d_out; a.ws = (unsigned char*)d_ws;
#if MK_LAUNCHES == 1
    a.ph_lo = 0; a.ph_hi = hy::NPHASE;
    hipLaunchKernelGGL(hy::hy_fwd, dim3(grid), dim3(hy::NT), hy::LDS_BYTES, stream, a);
#else
    for (int p = 0; p < hy::NPHASE; ++p) { a.ph_lo = p; a.ph_hi = p + 1; hipLaunchKernelGGL(hy::hy_fwd, dim3(grid), dim3(hy::NT), hy::LDS_BYTES, stream, a); }
#endif
}
```

```cpp
#include <hip/hip_runtime.h>
#include <cstdio>
#include <cstdint>
#define MK_LAUNCHES 1


#define XB_TMO      128
#define XB_XCNT(j)  (256  + 64 * (j))
#define XB_XSUB(j)  (1280 + 64 * (j))
#define XB_XGEN(j)  (2304 + 64 * (j))
#define XB_TOP      3328
#define XB_TOPGEN   3392
#define XCD_BAR_WORDS 3456
#define XB_SPIN_CAP (1u << 18)
#define LAS __attribute__((address_space(3)))

__device__ __forceinline__ unsigned xb_ld(unsigned* p)              { return __hip_atomic_load(p, __ATOMIC_RELAXED, __HIP_MEMORY_SCOPE_AGENT); }
__device__ __forceinline__ unsigned xb_add(unsigned* p, unsigned v) { return __hip_atomic_fetch_add(p, v, __ATOMIC_RELAXED, __HIP_MEMORY_SCOPE_AGENT); }
__device__ __forceinline__ unsigned xb_xcc_id() { return (unsigned)__builtin_amdgcn_s_getreg((3 << 11) | 20) & 0xFu; }
#define XB_SPIN(cond, bar) do { unsigned _sp = 0; while (cond) { __builtin_amdgcn_s_sleep(1); \
    if ((++_sp & 255u) == 0u) { if (xb_ld(&(bar)[XB_TMO])) break; if (_sp > XB_SPIN_CAP) { atomicAdd(&(bar)[XB_TMO], 1u); break; } } } } while (0)

struct XcdBarrier {
    unsigned* bar; unsigned x;
    volatile LAS unsigned* st;
};

__device__ __forceinline__ XcdBarrier xcd_barrier_post(unsigned* bar, volatile LAS unsigned* st) {
    XcdBarrier b; b.bar = bar; b.x = xb_xcc_id(); b.st = st;
    if (threadIdx.x == 0) (void)xb_add(&bar[XB_XCNT(b.x)], 1u);
    return b;
}
__device__ __forceinline__ void xcd_barrier_complete(unsigned* bar, unsigned x, unsigned& nloc, unsigned& nx) {
    const unsigned G = gridDim.x * gridDim.y * gridDim.z;
    unsigned sum, cnt, mine, sp = 0u;
    for (;;) {
        sum = 0u; cnt = 0u; mine = 0u;
#pragma unroll
        for (unsigned j = 0; j < 16; ++j) { const unsigned c = xb_ld(&bar[XB_XCNT(j)]); sum += c; cnt += (c > 0u) ? 1u : 0u; mine = (j == x) ? c : mine; }
        if (sum == G) break;
        __builtin_amdgcn_s_sleep(1);
        if ((++sp & 255u) == 0u) { if (xb_ld(&bar[XB_TMO])) break; if (sp > XB_SPIN_CAP) { atomicAdd(&bar[XB_TMO], 1u); break; } }
    }
    nloc = mine > 0u ? mine : 1u; nx = cnt > 0u ? cnt : 1u;
}

__device__ __forceinline__ void xcd_barrier(const XcdBarrier& b) {
    asm volatile("s_waitcnt vmcnt(0)" ::: "memory");
    __syncthreads();
    if (threadIdx.x == 0) {
        unsigned* bar = b.bar;
        __builtin_amdgcn_s_waitcnt(0);
        unsigned nloc = b.st[0], nx = b.st[1];
        if (nloc == 0u) { xcd_barrier_complete(bar, b.x, nloc, nx); b.st[0] = nloc; b.st[1] = nx; }
        const unsigned old = xb_add(&bar[XB_XSUB(b.x)], 1u);
        const unsigned gen = old / nloc;
        if (old + 1u == (gen + 1u) * nloc) {
            __builtin_amdgcn_fence(__ATOMIC_RELEASE, "agent");
            asm volatile("s_waitcnt vmcnt(0)" ::: "memory");
            const unsigned og = xb_add(&bar[XB_TOP], 1u);
            const unsigned tg = og / nx;
            if (og + 1u == (tg + 1u) * nx) xb_add(&bar[XB_TOPGEN], 1u);
            else XB_SPIN(xb_ld(&bar[XB_TOPGEN]) == tg, bar);
            __builtin_amdgcn_fence(__ATOMIC_ACQUIRE, "agent");
            xb_add(&bar[XB_XGEN(b.x)], 1u);
            asm volatile("s_waitcnt vmcnt(0)" ::: "memory");
        } else {
            XB_SPIN(xb_ld(&bar[XB_XGEN(b.x)]) == gen, bar);
            __builtin_amdgcn_fence(__ATOMIC_ACQUIRE, "agent");
            asm volatile("s_waitcnt vmcnt(0)" ::: "memory");
        }
    }
    __syncthreads();
}


namespace pg8 {
#define PG8_LAS __attribute__((address_space(3)))
typedef unsigned short bf16_t;
typedef short bf16x8 __attribute__((ext_vector_type(8)));
typedef float f32x4 __attribute__((ext_vector_type(4)));
typedef unsigned u32x4 __attribute__((ext_vector_type(4)));
constexpr int BM = 256, BK = 64, HALF = 128, HTB = HALF * BK * 2  , STAGE_BYTES = 8 * HTB, NXCD = 8, WGM = 8;

__host__ __device__ __forceinline__ int lds_byte(int r, int c) { const int st = (r >> 4) * 2 + (c >> 5), rr = r & 15, cc = c & 31, ob = rr * 64 + cc * 2; return st * 1024 + (ob ^ (((ob >> 9) & 1) << 5)); }
__host__ __device__ __forceinline__ void stage_rc(int b, int& R, int& C) { const int st = b / 1024, sb = b % 1024, swz = sb ^ (((sb >> 9) & 1) << 5); R = (st >> 1) * 16 + swz / 64; C = (st & 1) * 32 + (swz % 64) / 2; }
__host__ __device__ __forceinline__ int perm32(int rho) { const int n = rho >> 4, i = rho & 15; return 8 * (i >> 2) + 4 * n + (i & 3); }

struct Unit { int pm, pn; };
struct Gemm { const bf16_t* A; const bf16_t* Bt; int M, N, K, lda, pmg; size_t gstride; };

struct StaticOrder {
    int nM, nN, nwg, G, c;
    __host__ __device__ void init(int M, int N, int G_, int c_) { nM = M / BM; nN = N / BM; nwg = nM * nN; G = G_; c = c_; }
    __host__ __device__ bool next(int i, Unit& u) const {
        const long L = (long)i * G + c; if (L >= nwg) return false;
        int wgid = (int)L; { const int q = nwg / NXCD, r = nwg % NXCD, xcd = wgid % NXCD, off = wgid / NXCD; wgid = (xcd < r ? xcd * (q + 1) : r * (q + 1) + (xcd - r) * q) + off; }
        const int nig = WGM * nN, gid = wgid / nig, fm = gid * WGM, gsz = (nM - fm) < WGM ? (nM - fm) : WGM;
        u.pm = fm + ((wgid % nig) % gsz); u.pn = (wgid % nig) / gsz; return true;
    }
    __device__ __forceinline__ void a_ready(const Unit&) const {}
    __device__ __forceinline__ void done(const Unit&) const {}
};
__device__ __forceinline__ unsigned cvt_pk_bf16(float lo, float hi) { unsigned r; asm volatile("v_cvt_pk_bf16_f32 %0, %1, %2" : "=v"(r) : "v"(lo), "v"(hi)); return r; }
typedef float f32x2 __attribute__((ext_vector_type(2)));
template <class Epi, class Sched, bool STAMP = false>
__device__ __forceinline__ void gemm_phase(PG8_LAS unsigned char* lds, const Gemm g, const Sched& S, const Epi& E, unsigned long long* stamps) {
    int tid_l = threadIdx.x; asm volatile("" : "+v"(tid_l));
    const int tid = tid_l, wid = __builtin_amdgcn_readfirstlane(tid >> 6), lane = tid & 63, wr = wid >> 2, wc = wid & 3, fr = lane & 15, fq = lane >> 4;
    const int K = g.K, nt = K / BK;
    int ts_lo = 0, ts_hi = 0, nts = 0; const unsigned long long rt_entry = STAMP ? (unsigned long long)wall_clock64() : 0ull;
#define PG8_STAMP() do { if (STAMP && wid == 0 && nts < 64) { const unsigned long long _c = (unsigned long long)clock64(); \
        ts_lo = (lane == nts) ? (int)(unsigned)_c : ts_lo; ts_hi = (lane == nts) ? (int)(unsigned)(_c >> 32) : ts_hi; ++nts; } } while (0)
    PG8_STAMP();
    unsigned voffA[2], voffB[2];
#pragma unroll
    for (int i = 0; i < 2; ++i) { int R, C; stage_rc(tid * 16 + i * 8192, R, C); const int Rb = Epi::PERM ? ((R & ~31) + perm32(R & 31)) : R;
        voffA[i] = (unsigned)(R * g.lda + C) * 2u; voffB[i] = (unsigned)(Rb * K + C) * 2u; }
    const size_t kstep = (size_t)(BK * 2);
    const size_t hstepA = (size_t)HALF * g.lda * 2, hstepB = (size_t)HALF * K * 2;
    const size_t tstepA = 2 * hstepA, tstepB = 2 * hstepB;
    const unsigned ldsw = (unsigned)wid * 1024u;
    const int aoff = lds_byte(wr * 64 + fr, fq * 8), boff = lds_byte(wc * 32 + fr, fq * 8);
#define PG8_SA(b, h) (((b) * 2 + (h)) * HTB)
#define PG8_SB(b, h) ((4 + (b) * 2 + (h)) * HTB)
#define PG8_STAGE(bufoff, gbase, voff) do { _Pragma("unroll") for (int _i = 0; _i < 2; ++_i) \
        __builtin_amdgcn_global_load_lds((const unsigned*)((const char*)(gbase) + (voff)[_i]), (PG8_LAS unsigned*)(lds + (bufoff) + ldsw + _i * 8192), 16, 0, 0); } while (0)
#define PG8_LDA(dst, b, h) do { _Pragma("unroll") for (int m = 0; m < 4; ++m) _Pragma("unroll") for (int k = 0; k < 2; ++k) dst[m][k] = *(const PG8_LAS bf16x8*)(lds + PG8_SA(b, h) + aoff + m * 2048 + k * 1024); } while (0)
#define PG8_LDB(dst, b, h) do { _Pragma("unroll") for (int n = 0; n < 2; ++n) _Pragma("unroll") for (int k = 0; k < 2; ++k) dst[n][k] = *(const PG8_LAS bf16x8*)(lds + PG8_SB(b, h) + boff + n * 2048 + k * 1024); } while (0)
#define PG8_MMA(ai, bj, At, Bt) do { __builtin_amdgcn_s_setprio(1); _Pragma("unroll") for (int m = 0; m < 4; ++m) _Pragma("unroll") for (int n = 0; n < 2; ++n) _Pragma("unroll") for (int k = 0; k < 2; ++k) \
        acc[ai][bj][m][n] = __builtin_amdgcn_mfma_f32_16x16x32_bf16(Bt[n][k], At[m][k], acc[ai][bj][m][n], 0, 0, 0); __builtin_amdgcn_s_setprio(0); } while (0)
#define PG8_WAIT_V(n) asm volatile("s_waitcnt vmcnt(" #n ")" ::: "memory")
#define PG8_WAIT_L(n) asm volatile("s_waitcnt lgkmcnt(" #n ")" ::: "memory")
#define PG8_BAR __builtin_amdgcn_s_barrier()
#define PG8_SCHED __builtin_amdgcn_sched_barrier(0)
    Unit cur, nxt; int ui = 0;
    if (!S.next(0, cur)) return;
    f32x4 acc[2][2][4][2];
#pragma unroll
    for (int a = 0; a < 2; ++a)
#pragma unroll
        for (int b = 0; b < 2; ++b)
#pragma unroll
            for (int m = 0; m < 4; ++m)
#pragma unroll
                for (int n = 0; n < 2; ++n) acc[a][b][m][n] = (f32x4){0.f, 0.f, 0.f, 0.f};
    bf16x8 At[4][2], B0[2][2], B1[2][2];
    const char* cA = (const char*)g.A + (size_t)cur.pm * tstepA; const char* cB = (const char*)g.Bt + (size_t)(cur.pm / g.pmg) * g.gstride + (size_t)cur.pn * tstepB;
    S.a_ready(cur);
    PG8_STAGE(PG8_SB(0, 0), cB, voffB); PG8_STAGE(PG8_SA(0, 0), cA, voffA); PG8_STAGE(PG8_SB(0, 1), cB + hstepB, voffB); PG8_STAGE(PG8_SA(0, 1), cA + hstepA, voffA);
    if (wr == 1) PG8_BAR;
    PG8_WAIT_V(4); PG8_BAR;
    PG8_STAGE(PG8_SB(1, 0), cB + kstep, voffB); PG8_STAGE(PG8_SA(1, 0), cA + kstep, voffA); PG8_STAGE(PG8_SB(1, 1), cB + hstepB + kstep, voffB);
    PG8_WAIT_V(6); PG8_BAR;
    PG8_STAMP();
    for (;;) {
        const bool has_next = S.next(ui + 1, nxt);
        const char* nA = has_next ? (const char*)g.A + (size_t)nxt.pm * tstepA : cA; const char* nB = has_next ? (const char*)g.Bt + (size_t)(nxt.pm / g.pmg) * g.gstride + (size_t)nxt.pn * tstepB : cB;
#pragma unroll 1
        for (int t = 0; t < nt; t += 2) {
            const bool last = (t == nt - 2);
            const char* a1 = cA + (size_t)(t + 1) * kstep;
            const char* a2 = last ? nA : cA + (size_t)(t + 2) * kstep; const char* b2 = last ? nB : cB + (size_t)(t + 2) * kstep;
            const char* a3 = a2 + kstep; const char* b3 = b2 + kstep;
            if (last && has_next) S.a_ready(nxt);
            PG8_LDB(B0, 0, 0); PG8_SCHED; PG8_LDA(At, 0, 0); PG8_STAGE(PG8_SA(1, 1), a1 + hstepA, voffA);
            PG8_WAIT_L(8); PG8_BAR; PG8_WAIT_L(0); PG8_MMA(0, 0, At, B0); PG8_BAR; PG8_SCHED;
            PG8_LDB(B1, 0, 1); PG8_STAGE(PG8_SB(0, 0), b2, voffB);
            PG8_BAR; PG8_WAIT_L(0); PG8_MMA(0, 1, At, B1); PG8_BAR;
            PG8_LDA(At, 0, 1); PG8_STAGE(PG8_SA(0, 0), a2, voffA);
            PG8_BAR; PG8_WAIT_L(0); PG8_MMA(1, 0, At, B0); PG8_BAR; PG8_SCHED;
            PG8_STAGE(PG8_SB(0, 1), b2 + hstepB, voffB);
            PG8_WAIT_V(6); PG8_BAR; PG8_MMA(1, 1, At, B1); PG8_BAR;
            PG8_LDB(B0, 1, 0); PG8_SCHED; PG8_LDA(At, 1, 0); PG8_STAGE(PG8_SA(0, 1), a2 + hstepA, voffA);
            PG8_WAIT_L(8); PG8_BAR; PG8_WAIT_L(0); PG8_MMA(0, 0, At, B0); PG8_BAR; PG8_SCHED;
            PG8_LDB(B1, 1, 1); PG8_STAGE(PG8_SB(1, 0), b3, voffB);
            PG8_BAR; PG8_WAIT_L(0); PG8_MMA(0, 1, At, B1); PG8_BAR;
            PG8_LDA(At, 1, 1); PG8_STAGE(PG8_SA(1, 0), a3, voffA);
            PG8_BAR; PG8_WAIT_L(0); PG8_MMA(1, 0, At, B0); PG8_BAR; PG8_SCHED;
            PG8_STAGE(PG8_SB(1, 1), b3 + hstepB, voffB);
            PG8_WAIT_V(6); PG8_BAR; PG8_MMA(1, 1, At, B1); PG8_BAR;
        }
        PG8_STAMP();
        if constexpr (!Epi::AFTER_DRAIN) { E(acc, cur, wr, wc, fr, fq); S.done(cur); }
        PG8_STAMP();
        if (!has_next) break;
#pragma unroll
        for (int a = 0; a < 2; ++a)
#pragma unroll
            for (int b = 0; b < 2; ++b)
#pragma unroll
                for (int m = 0; m < 4; ++m)
#pragma unroll
                    for (int n = 0; n < 2; ++n) acc[a][b][m][n] = (f32x4){0.f, 0.f, 0.f, 0.f};
        cur = nxt; cA = nA; cB = nB; ++ui;
    }
    PG8_WAIT_V(0);
    if (wr == 0) PG8_BAR;
    PG8_BAR;
    if constexpr (Epi::AFTER_DRAIN) { E.fused(acc, cur, wr, wc, fr, fq, lds, wid, lane); S.done(cur); }
    PG8_STAMP();
    if (STAMP && wid == 0) { stamps[lane] = lane < nts ? (((unsigned long long)(unsigned)ts_hi << 32) | (unsigned)ts_lo) : 0ull;
        if (lane == 62) stamps[62] = rt_entry; if (lane == 63) stamps[63] = (unsigned long long)wall_clock64(); }
#undef PG8_STAMP
#undef PG8_SA
#undef PG8_SB
#undef PG8_STAGE
#undef PG8_LDA
#undef PG8_LDB
#undef PG8_MMA
#undef PG8_WAIT_V
#undef PG8_WAIT_L
#undef PG8_BAR
#undef PG8_SCHED
}
}


namespace hy {
using pg8::bf16_t; using pg8::f32x4; using pg8::u32x4; using pg8::Unit;
typedef unsigned u32x2 __attribute__((ext_vector_type(2)));
#define DI __device__ __forceinline__
constexpr int D = 1024, NBATCH = 8, SEQ = 4096, CTXL = 256, DEPTH = 4;
constexpr int CTXROWS = NBATCH * CTXL;
constexpr int MROWS = CTXROWS + NBATCH * SEQ;
constexpr int NCHUNK = MROWS / 64;
constexpr int NIN = 14384;
constexpr int NT = 512;
constexpr int LDS_BYTES = 131072 + 256;
constexpr int C_GQ = 0, C_GZ = 3072, C_GA = 4096, C_SU = 4128, C_MQ = 6176, C_MO = 9248, C_MI = 11296, C_GATE = 11312;

constexpr size_t al256(size_t x) { return (x + 255) & ~(size_t)255; }
constexpr size_t SZ_ACT = (size_t)MROWS * 1024 * 2;
constexpr size_t SZ_GATE = (size_t)MROWS * 32 * 4;
constexpr size_t SZ_HALO = (size_t)3 * NCHUNK * 4 * 1024 * 2;
constexpr size_t WS_CTL = 0;
constexpr size_t WS_MOD = 65536, SZ_MOD = (size_t)DEPTH * 9 * 3072 * 4;
constexpr size_t WS_XCTX = al256(WS_MOD + SZ_MOD);
constexpr size_t WS_H = WS_XCTX + (size_t)CTXROWS * 1024 * 4;
constexpr size_t WS_MERGED = WS_H + SZ_ACT;
constexpr size_t SZ_WB = (size_t)3328 * 1024 * 2;
constexpr size_t WS_WB0 = WS_MERGED + SZ_ACT;
constexpr size_t WS_WB1 = WS_WB0 + SZ_WB;
constexpr size_t WS_R = WS_WB1 + SZ_WB;
constexpr size_t R_P0 = 0, R_P1 = SZ_ACT, R_P2 = 2 * SZ_ACT, R_OF = 3 * SZ_ACT, R_OB = 4 * SZ_ACT, R_G2 = 5 * SZ_ACT;
constexpr size_t WS_END = WS_R + R_G2 + SZ_GATE + (size_t)4 * 1024 * 1024;
static_assert(SZ_GATE + SZ_HALO <= SZ_ACT, "GDN gate + halo buffers live in the (not yet written) MERGED region");
static_assert((size_t)16 * DEPTH * 9 * 3072 * 4 <= SZ_ACT, "mod partials live in the R region");

struct Args { const float* in[28]; float* out; unsigned char* ws; int ph_lo, ph_hi; };
enum { I_X = 0, I_C, I_CTX, I_CCTX, I_WADA, I_BADA, I_NORMG, I_WIN, I_GCONV, I_GALOG, I_GDTB, I_GNORM, I_SLRE, I_SLIM, I_SLOG, I_SBRE, I_SBIM, I_SCRE, I_SCIM, I_SD, I_SWGLU, I_SBGLU, I_MIB, I_MFB, I_MNORM, I_WBR, I_WOUT, I_FNORM };

typedef const Args __attribute__((address_space(4)))* ArgsP;
DI ArgsP args_ptr() { ArgsP p = (ArgsP)__builtin_amdgcn_kernarg_segment_ptr(); asm volatile("" : "+s"(p)); return p; }
DI int ltid() { int t = threadIdx.x; asm volatile("" : "+v"(t)); return t; }
DI float bf2f(bf16_t v) { return __uint_as_float(((unsigned)v) << 16); }
DI float bflo(unsigned w) { return __uint_as_float(w << 16); }
DI float bfhi(unsigned w) { return __uint_as_float(w & 0xffff0000u); }
DI bf16_t f2bf(float f) { return (bf16_t)(pg8::cvt_pk_bf16(f, 0.f) & 0xffffu); }
DI float sigmoidf_(float x) { return 1.0f / (1.0f + __expf(-x)); }
DI float siluf_(float x) { return x / (1.0f + __expf(-x)); }
DI float softplusf_(float x) { return x > 20.f ? x : log1pf(__expf(x)); }
DI float gelu_tanh_(float x) { const float u = 0.7978845608028654f * (x + 0.044715f * x * x * x); return 0.5f * x * (1.0f + tanhf(u)); }
DI float wave_sum(float v) {
#pragma unroll
    for (int o = 32; o >= 1; o >>= 1) v += __shfl_xor(v, o);
    return v; }
DI void unpack8(const u32x4 w, float (&f)[8]) { f[0] = bflo(w.x); f[1] = bfhi(w.x); f[2] = bflo(w.y); f[3] = bfhi(w.y); f[4] = bflo(w.z); f[5] = bfhi(w.z); f[6] = bflo(w.w); f[7] = bfhi(w.w); }
DI int lat_pos(int l, int s) { return (l & 1) ? (((s & 63) << 6) | (s >> 6)) : s; }

struct EpiProj {
    static constexpr bool PERM = true, AFTER_DRAIN = false;
    bf16_t* d0; int modes; float* gdst; int gtile; bf16_t* halo;
    __device__ __forceinline__ void operator()(const f32x4 (&acc)[2][2][4][2], const Unit& u, int wr, int wc, int fr, int fq) const {
        const int row0 = u.pm * 256 + wr * 64 + fr;
        if (u.pn == gtile) {
            if (wc == 0) {
#pragma unroll
                for (int ai = 0; ai < 2; ++ai)
#pragma unroll
                    for (int m = 0; m < 4; ++m) { float* rp = gdst + (size_t)(row0 + ai * 128 + m * 16) * 32 + 8 * fq; *(f32x4*)rp = acc[ai][0][m][0]; *(f32x4*)(rp + 4) = acc[ai][0][m][1]; }
            }
            return;
        }
        const int seg = u.pn >> 2; bf16_t* base = d0 + (size_t)seg * (SZ_ACT / 2); const int md = (modes >> (2 * seg)) & 3;
        const int col0 = (u.pn & 3) * 256 + wc * 32 + 8 * fq;
#pragma unroll
        for (int ai = 0; ai < 2; ++ai)
#pragma unroll
            for (int m = 0; m < 4; ++m) {
                const int r = row0 + ai * 128 + m * 16;
                bf16_t* rowp = base + (size_t)r * 1024 + col0;
                int hidx = -1;
                if (halo) { if (m == 0 && fr < 2) hidx = fr; if (m == 3 && fr >= 14) hidx = fr - 12; }
#pragma unroll
                for (int bj = 0; bj < 2; ++bj) {
                    f32x4 v0 = acc[ai][bj][m][0], v1 = acc[ai][bj][m][1];
                    if (md == 1) {
#pragma unroll
                        for (int j = 0; j < 4; ++j) { v0[j] = siluf_(v0[j]); v1[j] = siluf_(v1[j]); } }
                    else if (md == 2) {
#pragma unroll
                        for (int j = 0; j < 4; ++j) { v0[j] = sigmoidf_(v0[j]); v1[j] = sigmoidf_(v1[j]); } }
                    u32x4 w; w.x = pg8::cvt_pk_bf16(v0[0], v0[1]); w.y = pg8::cvt_pk_bf16(v0[2], v0[3]); w.z = pg8::cvt_pk_bf16(v1[0], v1[1]); w.w = pg8::cvt_pk_bf16(v1[2], v1[3]);
                    *(u32x4*)(rowp + bj * 128) = w;
                    if (hidx >= 0) *(u32x4*)(halo + ((size_t)seg * (NCHUNK * 4) + (size_t)(r >> 6) * 4 + hidx) * 1024 + col0 + bj * 128) = w;
                }
            }
    }
};
struct EpiBranch {
    static constexpr bool PERM = true, AFTER_DRAIN = false;
    const bf16_t* G; bf16_t* MG; int first;
    __device__ __forceinline__ void operator()(const f32x4 (&acc)[2][2][4][2], const Unit& u, int wr, int wc, int fr, int fq) const {
        const int row0 = u.pm * 256 + wr * 64 + fr, col0 = u.pn * 256 + wc * 32 + 8 * fq;
#pragma unroll
        for (int ai = 0; ai < 2; ++ai)
#pragma unroll
            for (int m = 0; m < 4; ++m) {
                const size_t off = (size_t)(row0 + ai * 128 + m * 16) * 1024 + col0;
#pragma unroll
                for (int bj = 0; bj < 2; ++bj) {
                    const u32x4 gw = *(const u32x4*)(G + off + bj * 128);
                    float g[8], o[8]; unpack8(gw, g);
                    if (first) {
#pragma unroll
                        for (int j = 0; j < 8; ++j) o[j] = 0.f; }
                    else { const u32x4 ow = *(const u32x4*)(MG + off + bj * 128); unpack8(ow, o); }
                    const f32x4 v0 = acc[ai][bj][m][0], v1 = acc[ai][bj][m][1];
#pragma unroll
                    for (int j = 0; j < 4; ++j) { o[j] += g[j] * v0[j]; o[4 + j] += g[4 + j] * v1[j]; }
                    u32x4 w; w.x = pg8::cvt_pk_bf16(o[0], o[1]); w.y = pg8::cvt_pk_bf16(o[2], o[3]); w.z = pg8::cvt_pk_bf16(o[4], o[5]); w.w = pg8::cvt_pk_bf16(o[6], o[7]);
                    *(u32x4*)(MG + off + bj * 128) = w;
                }
                asm volatile("" ::: "memory");
            }
    }
};
struct EpiGlu {
    static constexpr bool PERM = true, AFTER_DRAIN = false;
    const bf16_t* SZ; bf16_t* O; const float* bias;
    __device__ __forceinline__ void operator()(const f32x4 (&acc)[2][2][4][2], const Unit& u, int wr, int wc, int fr, int fq) const {
        const int row0 = u.pm * 256 + wr * 64 + fr, col0 = u.pn * 128 + wc * 32 + 8 * fq;
        float ba[8], bg[8];
#pragma unroll
        for (int j = 0; j < 8; ++j) { ba[j] = bias[col0 + j]; bg[j] = bias[1024 + col0 + j]; }
#pragma unroll
        for (int ai = 0; ai < 2; ++ai)
#pragma unroll
            for (int m = 0; m < 4; ++m) {
                const size_t off = (size_t)(row0 + ai * 128 + m * 16) * 1024 + col0;
                const u32x4 zw = *(const u32x4*)(SZ + off); float z[8], o[8]; unpack8(zw, z);
#pragma unroll
                for (int n = 0; n < 2; ++n)
#pragma unroll
                    for (int j = 0; j < 4; ++j) { const int c = 4 * n + j; o[c] = (acc[ai][0][m][n][j] + ba[c]) * sigmoidf_(acc[ai][1][m][n][j] + bg[c]) * z[c]; }
                u32x4 w; w.x = pg8::cvt_pk_bf16(o[0], o[1]); w.y = pg8::cvt_pk_bf16(o[2], o[3]); w.z = pg8::cvt_pk_bf16(o[4], o[5]); w.w = pg8::cvt_pk_bf16(o[6], o[7]);
                *(u32x4*)(O + off) = w;
            }
    }
};
struct EpiOut {
    static constexpr bool PERM = false, AFTER_DRAIN = false;
    const float* xlat_src; float* xlat_dst; const float* xctx_src; float* xctx_dst; const float* mod; int l; int row_off;
    __device__ __forceinline__ void operator()(const f32x4 (&acc)[2][2][4][2], const Unit& u, int wr, int wc, int fr, int fq) const {
        const int row0 = row_off + u.pm * 256 + wr * 64 + fr, col0 = u.pn * 256 + wc * 32 + 4 * fq;
#pragma unroll
        for (int ai = 0; ai < 2; ++ai)
#pragma unroll
            for (int m = 0; m < 4; ++m) {
                const int r = row0 + ai * 128 + m * 16;
                const float* xs; float* xd; const float* gp;
                if (r < CTXROWS) { xs = xctx_src + (size_t)r * 1024; xd = xctx_dst + (size_t)r * 1024; gp = mod + 8 * 3072 + 2048; }
                else { const int q = r - CTXROWS, b = q >> 12, p = lat_pos(l, q & 4095); const size_t o = ((size_t)b * 4096 + p) * 1024; xs = xlat_src + o; xd = xlat_dst + o; gp = mod + b * 3072 + 2048; }
#pragma unroll
                for (int bj = 0; bj < 2; ++bj)
#pragma unroll
                    for (int n = 0; n < 2; ++n) { const int c = col0 + bj * 128 + n * 16; const f32x4 x = *(const f32x4*)(xs + c), g = *(const f32x4*)(gp + c); *(f32x4*)(xd + c) = x + g * acc[ai][bj][m][n]; }
                asm volatile("" ::: "memory");
            }
    }
};

DI void ph_modp(const Args& a, float* modp, LAS float* sl) {
    for (int it = blockIdx.x; it < 384; it += gridDim.x) {
        const int l = it / 96, kq = (it / 6) % 16, nt = it % 6;
        __syncthreads();
        for (int i = ltid(); i < 576; i += NT) { const int j = i >> 6, k = kq * 64 + (i & 63); const float cv = (j < 8) ? a.in[I_C][j * 1024 + k] : a.in[I_CCTX][k]; sl[i] = siluf_(cv); }
        __syncthreads();
        const int n = nt * 512 + ltid();
        float acc[9];
#pragma unroll
        for (int j = 0; j < 9; ++j) acc[j] = 0.f;
        const float* w = a.in[I_WADA] + ((size_t)l * 1024 + kq * 64) * 3072 + n;
#pragma unroll 4
        for (int k = 0; k < 64; ++k) { const float wv = w[(size_t)k * 3072];
#pragma unroll
            for (int j = 0; j < 9; ++j) acc[j] += sl[j * 64 + k] * wv; }
#pragma unroll
        for (int j = 0; j < 9; ++j) modp[(((size_t)kq * 4 + l) * 9 + j) * 3072 + n] = acc[j];
    }
}
DI void ph_mod(const Args& a, const float* modp, float* mod) {
    for (int i = blockIdx.x * NT + ltid(); i < DEPTH * 9 * 3072; i += gridDim.x * NT) {
        const int l = i / (9 * 3072), n = i % 3072; float s = a.in[I_BADA][l * 3072 + n];
#pragma unroll
        for (int kq = 0; kq < 16; ++kq) s += modp[(size_t)kq * (DEPTH * 9 * 3072) + i];
        mod[i] = s;
    }
}
DI void ph_norm(const Args& a, int l, const float* xlat, const float* xctx, const float* mod, bf16_t* H) {
    const int wave = ltid() >> 6, lane = ltid() & 63;
    const float* g = a.in[I_NORMG] + l * 1024;
    for (int r = blockIdx.x * 8 + wave; r < MROWS; r += gridDim.x * 8) {
        const float* src; const float* md;
        if (r < CTXROWS) { src = xctx + (size_t)r * 1024; md = mod + 8 * 3072; }
        else { const int q = r - CTXROWS, b = q >> 12, p = lat_pos(l, q & 4095); src = xlat + ((size_t)b * 4096 + p) * 1024; md = mod + b * 3072; }
        f32x4 v[4]; float ss = 0.f;
#pragma unroll
        for (int i = 0; i < 4; ++i) { v[i] = *(const f32x4*)(src + i * 256 + lane * 4); ss += v[i][0] * v[i][0] + v[i][1] * v[i][1] + v[i][2] * v[i][2] + v[i][3] * v[i][3]; }
        ss = wave_sum(ss);
        const float rs = rsqrtf(ss * (1.0f / 1024.0f) + 1e-6f);
#pragma unroll
        for (int i = 0; i < 4; ++i) { const int c = i * 256 + lane * 4;
            const f32x4 gv = *(const f32x4*)(g + c), sh = *(const f32x4*)(md + c), sc = *(const f32x4*)(md + 1024 + c);
            const f32x4 y = (v[i] * rs) * gv * (sc + 1.0f) + sh;
            u32x2 w; w.x = pg8::cvt_pk_bf16(y[0], y[1]); w.y = pg8::cvt_pk_bf16(y[2], y[3]);
            *(u32x2*)(H + (size_t)r * 1024 + c) = w; }
    }
}
DI void ph_final(const Args& a, float* x) {
    const int wave = ltid() >> 6, lane = ltid() & 63;
    const float* g = a.in[I_FNORM];
    for (int r = blockIdx.x * 8 + wave; r < NBATCH * SEQ; r += gridDim.x * 8) {
        float* src = x + (size_t)r * 1024;
        f32x4 v[4]; float ss = 0.f;
#pragma unroll
        for (int i = 0; i < 4; ++i) { v[i] = *(const f32x4*)(src + i * 256 + lane * 4); ss += v[i][0] * v[i][0] + v[i][1] * v[i][1] + v[i][2] * v[i][2] + v[i][3] * v[i][3]; }
        ss = wave_sum(ss);
        const float rs = rsqrtf(ss * (1.0f / 1024.0f) + 1e-6f);
#pragma unroll
        for (int i = 0; i < 4; ++i) { const int c = i * 256 + lane * 4; const f32x4 gv = *(const f32x4*)(g + c); *(f32x4*)(src + c) = (v[i] * rs) * gv; }
    }
}
struct WDesc { const float* src; int ld, id, n64; };
DI void wmap(int id, int nb, int& col, int& valid) {
    valid = 64;
    switch (id) {
        case 0: if (nb < 48) col = C_GQ + 64 * nb; else if (nb == 48) { col = C_GA; valid = 32; } else { col = 0; valid = 0; } break;
        case 1: col = (nb < 16) ? C_GZ + 64 * nb : C_GATE + 64 * (nb - 16); break;
        case 2: if (nb < 48) col = C_MQ + 64 * nb; else if (nb == 48) { col = C_MI; valid = 16; } else { col = 0; valid = 0; } break;
        case 3: col = (nb < 32) ? C_MO + 64 * nb : C_GATE + 2048 + 64 * (nb - 32); break;
        case 4: col = (nb < 32) ? C_SU + 64 * nb : C_GATE + 1024 + 64 * (nb - 32); break;
        case 5: { const int pn = nb >> 2, q = nb & 3; col = (q >> 1) * 1024 + 128 * pn + (q & 1) * 64; } break;
        default: col = 64 * nb; break;
    }
}
DI WDesc wdesc(const Args& a, int l, int id) {
    WDesc w; w.id = id;
    if (id <= 4) { w.src = a.in[I_WIN] + (size_t)l * 1024 * NIN; w.ld = NIN; w.n64 = (id == 0 || id == 2) ? 52 : (id == 1 ? 32 : 48); }
    else if (id == 5) { w.src = a.in[I_SWGLU] + (size_t)l * 1024 * 2048; w.ld = 2048; w.n64 = 32; }
    else if (id <= 8) { w.src = a.in[I_WBR] + ((size_t)l * 3 + (id - 6)) * 1024 * 1024; w.ld = 1024; w.n64 = 16; }
    else { w.src = a.in[I_WOUT] + (size_t)l * 1024 * 1024; w.ld = 1024; w.n64 = 16; }
    return w;
}
DI void ph_cvt(const WDesc w, bf16_t* dst, LAS float* tile) {
    const int tid = ltid(), ntile = w.n64 * 16;
    for (int t = blockIdx.x; t < ntile; t += gridDim.x) {
        const int nb = t >> 4, kb = t & 15; int col, valid; wmap(w.id, nb, col, valid);
        __syncthreads();
        { const int c = tid & 63, k0 = tid >> 6;
#pragma unroll
          for (int i = 0; i < 8; ++i) { const int k = k0 + 8 * i; tile[k * 65 + c] = (c < valid) ? w.src[(size_t)(kb * 64 + k) * w.ld + col + c] : 0.f; } }
        __syncthreads();
        { const int n = tid >> 3, kk = (tid & 7) * 8; u32x4 o;
          o.x = pg8::cvt_pk_bf16(tile[(kk + 0) * 65 + n], tile[(kk + 1) * 65 + n]); o.y = pg8::cvt_pk_bf16(tile[(kk + 2) * 65 + n], tile[(kk + 3) * 65 + n]);
          o.z = pg8::cvt_pk_bf16(tile[(kk + 4) * 65 + n], tile[(kk + 5) * 65 + n]); o.w = pg8::cvt_pk_bf16(tile[(kk + 6) * 65 + n], tile[(kk + 7) * 65 + n]);
          *(u32x4*)(dst + (size_t)(nb * 64 + n) * 1024 + kb * 64 + kk) = o; }
    }
    __syncthreads();
}

DI void ph_gdn_conv(const Args& a, int l, bf16_t* QKV  , const bf16_t* halo, LAS unsigned char* lds) {
    LAS bf16_t* raw = (LAS bf16_t*)lds;
    constexpr int P = 136;
    const int tid = ltid();
    const float* cw = a.in[I_GCONV] + (size_t)l * 5 * 3072;
    for (int unit = blockIdx.x; unit < NCHUNK * 24; unit += gridDim.x) {
        const int cb = unit / 24, seg = (unit % 24) >> 3, h = unit & 7;
        bf16_t* T = QKV + (size_t)seg * (SZ_ACT / 2);
        const bool first = (cb < 32) ? ((cb & 3) == 0) : (((cb - 32) & 63) == 0);
        const bool last = (cb < 32) ? ((cb & 3) == 3) : (((cb - 32) & 63) == 63);
        __syncthreads();
        for (int i = tid; i < 68 * 16; i += NT) {
            const int rr = i >> 4, c8 = (i & 15) * 8; u32x4 w = (u32x4){0u, 0u, 0u, 0u};
            if (rr >= 2 && rr < 66) w = *(const u32x4*)(T + (size_t)(cb * 64 + rr - 2) * 1024 + h * 128 + c8);
            else if (rr < 2) { if (!first) w = *(const u32x4*)(halo + ((size_t)seg * (NCHUNK * 4) + (size_t)(cb - 1) * 4 + 2 + rr) * 1024 + h * 128 + c8); }
            else { if (!last) w = *(const u32x4*)(halo + ((size_t)seg * (NCHUNK * 4) + (size_t)(cb + 1) * 4 + (rr - 66)) * 1024 + h * 128 + c8); }
            *(LAS u32x4*)(raw + rr * P + c8) = w;
        }
        __syncthreads();
        const int t = tid >> 3, c0 = (tid & 7) * 16;
        float o[16]; float ss = 0.f;
#pragma unroll
        for (int half = 0; half < 2; ++half) {
            float acc[8];
#pragma unroll
            for (int j = 0; j < 8; ++j) acc[j] = 0.f;
#pragma unroll
            for (int k = 0; k < 5; ++k) {
                const u32x4 w = *(const LAS u32x4*)(raw + (t + k) * P + c0 + half * 8); float x[8]; unpack8(w, x);
                const float* wp = cw + (size_t)k * 3072 + seg * 1024 + h * 128 + c0 + half * 8;
                const f32x4 w0 = *(const f32x4*)wp, w1 = *(const f32x4*)(wp + 4);
#pragma unroll
                for (int j = 0; j < 4; ++j) { acc[j] += w0[j] * x[j]; acc[4 + j] += w1[j] * x[4 + j]; }
            }
#pragma unroll
            for (int j = 0; j < 8; ++j) { const float s = siluf_(acc[j]); o[half * 8 + j] = s; ss += s * s; }
        }
        ss += __shfl_xor(ss, 1); ss += __shfl_xor(ss, 2); ss += __shfl_xor(ss, 4);
        float scale = 1.0f;
        if (seg == 0) scale = rsqrtf(ss + 1e-6f) * 0.08838834764831845f;
        else if (seg == 1) scale = rsqrtf(ss + 1e-6f);
        u32x4 w0, w1;
        w0.x = pg8::cvt_pk_bf16(o[0] * scale, o[1] * scale); w0.y = pg8::cvt_pk_bf16(o[2] * scale, o[3] * scale); w0.z = pg8::cvt_pk_bf16(o[4] * scale, o[5] * scale); w0.w = pg8::cvt_pk_bf16(o[6] * scale, o[7] * scale);
        w1.x = pg8::cvt_pk_bf16(o[8] * scale, o[9] * scale); w1.y = pg8::cvt_pk_bf16(o[10] * scale, o[11] * scale); w1.z = pg8::cvt_pk_bf16(o[12] * scale, o[13] * scale); w1.w = pg8::cvt_pk_bf16(o[14] * scale, o[15] * scale);
        bf16_t* op = T + (size_t)(cb * 64 + t) * 1024 + h * 128 + c0;
        *(u32x4*)op = w0; *(u32x4*)(op + 8) = w1;
    }
    __syncthreads();
}
DI void ph_gdn_scan(const Args& a, int l, const bf16_t* Q, const bf16_t* K, const bf16_t* V, const float* GATE, bf16_t* OF, bf16_t* OB, LAS unsigned char* lds) {
    LAS float* qf = (LAS float*)lds;
    LAS float* kf = qf + 64 * 128;
    LAS float* vf = kf + 64 * 128;
    LAS float* av = vf + 64 * 64;
    LAS float* bt = av + 64;
    LAS float* part = bt + 64;
    LAS float* po = part + 1024;
    const int tid = ltid(), e = tid & 63, dq = tid >> 6;
    for (int unit = blockIdx.x; unit < 256; unit += gridDim.x) {
        const int eh = unit & 1, d = (unit >> 1) & 1, h = (unit >> 2) & 7, b = unit >> 5;
        const float nea = -__expf(a.in[I_GALOG][(l * 2 + d) * 8 + h]), dtb = a.in[I_GDTB][(l * 2 + d) * 8 + h];
        bf16_t* O = d ? OB : OF;
        float S[16];
#pragma unroll
        for (int j = 0; j < 16; ++j) S[j] = 0.f;
        float opart = 0.f; int prow = -1, par = 0;
        for (int step = 0; step < 68; ++step) {
            const int cc = (step < 4) ? (d ? 3 - step : step) : (d ? 67 - step : step - 4);
            const int row0 = (step < 4) ? b * 256 + cc * 64 : CTXROWS + b * 4096 + cc * 64;
            __syncthreads();
            for (int i = tid; i < 1024; i += NT) { const int r = i >> 4, c8 = (i & 15) * 8; float f[8];
                unpack8(*(const u32x4*)(Q + (size_t)(row0 + r) * 1024 + h * 128 + c8), f);
#pragma unroll
                for (int j = 0; j < 8; ++j) qf[r * 128 + c8 + j] = f[j];
                unpack8(*(const u32x4*)(K + (size_t)(row0 + r) * 1024 + h * 128 + c8), f);
#pragma unroll
                for (int j = 0; j < 8; ++j) kf[r * 128 + c8 + j] = f[j]; }
            { const int r = tid >> 3, c8 = (tid & 7) * 8; float f[8]; unpack8(*(const u32x4*)(V + (size_t)(row0 + r) * 1024 + h * 128 + eh * 64 + c8), f);
#pragma unroll
              for (int j = 0; j < 8; ++j) vf[r * 64 + c8 + j] = f[j]; }
            if (tid < 64) { const float* gp = GATE + (size_t)(row0 + tid) * 32; av[tid] = __expf(nea * softplusf_(gp[d * 8 + h] + dtb)); bt[tid] = sigmoidf_(gp[16 + d * 8 + h]); }
            __syncthreads();
            for (int tt = 0; tt < 64; ++tt) {
                const int t = d ? 63 - tt : tt;
                float kk[16];
#pragma unroll
                for (int j4 = 0; j4 < 4; ++j4) { const f32x4 x = *(const LAS f32x4*)(kf + t * 128 + dq * 16 + j4 * 4); kk[j4 * 4] = x[0]; kk[j4 * 4 + 1] = x[1]; kk[j4 * 4 + 2] = x[2]; kk[j4 * 4 + 3] = x[3]; }
                float p = 0.f;
#pragma unroll
                for (int j = 0; j < 16; ++j) p += kk[j] * S[j];
                part[(par * 8 + dq) * 64 + e] = p; po[(par * 8 + dq) * 64 + e] = opart;
                __syncthreads();
                if (dq == 0 && prow >= 0) { float o = 0.f;
#pragma unroll
                    for (int q = 0; q < 8; ++q) o += po[(par * 8 + q) * 64 + e];
                    O[(size_t)prow * 1024 + h * 128 + eh * 64 + e] = f2bf(o); }
                float ks = 0.f;
#pragma unroll
                for (int q = 0; q < 8; ++q) ks += part[(par * 8 + q) * 64 + e];
                const float at = av[t], vn = bt[t] * (vf[t * 64 + e] - at * ks);
#pragma unroll
                for (int j = 0; j < 16; ++j) S[j] = at * S[j] + kk[j] * vn;
                float qo = 0.f;
#pragma unroll
                for (int j4 = 0; j4 < 4; ++j4) { const f32x4 x = *(const LAS f32x4*)(qf + t * 128 + dq * 16 + j4 * 4); qo += x[0] * S[j4 * 4] + x[1] * S[j4 * 4 + 1] + x[2] * S[j4 * 4 + 2] + x[3] * S[j4 * 4 + 3]; }
                opart = qo; prow = row0 + t; par ^= 1;
            }
        }
        po[(par * 8 + dq) * 64 + e] = opart;
        __syncthreads();
        if (dq == 0) { float o = 0.f;
#pragma unroll
            for (int q = 0; q < 8; ++q) o += po[(par * 8 + q) * 64 + e];
            O[(size_t)prow * 1024 + h * 128 + eh * 64 + e] = f2bf(o); }
        __syncthreads();
    }
}
DI void ph_gdn_post(const Args& a, int l, bf16_t* OF, const bf16_t* OB, const bf16_t* SZ) {
    const int wave = ltid() >> 6, lane = ltid() & 63;
    const float* g = a.in[I_GNORM] + l * 128;
    const float g0 = g[2 * lane], g1 = g[2 * lane + 1];
    for (int it = blockIdx.x * 8 + wave; it < MROWS * 8; it += gridDim.x * 8) {
        const size_t off = (size_t)(it >> 3) * 1024 + (it & 7) * 128 + 2 * lane;
        const unsigned wf = *(const unsigned*)(OF + off), wb = *(const unsigned*)(OB + off), wz = *(const unsigned*)(SZ + off);
        const float o0 = bflo(wf) + bflo(wb), o1 = bfhi(wf) + bfhi(wb);
        const float ss = wave_sum(o0 * o0 + o1 * o1);
        const float rs = rsqrtf(ss * (1.0f / 128.0f) + 1e-6f);
        *(unsigned*)(OF + off) = pg8::cvt_pk_bf16(o0 * rs * g0 * bflo(wz), o1 * rs * g1 * bfhi(wz));
    }
}

DI void ph_ml_scan(const Args& a, int l, const bf16_t* Q, const bf16_t* K, const bf16_t* V, const float* GATE, bf16_t* HF, bf16_t* HB, LAS unsigned char* lds) {
    LAS bf16_t* qs = (LAS bf16_t*)lds;
    LAS bf16_t* ks = qs + 64 * 256;
    LAS float* vf = (LAS float*)(ks + 64 * 256);
    LAS float* ip = vf + 64 * 64;
    LAS float* lf = ip + 64;
    LAS float* part = lf + 64;
    LAS float* dpart = part + 1024;
    const int tid = ltid(), e = tid & 63, dq = tid >> 6;
    for (int unit = blockIdx.x; unit < 256; unit += gridDim.x) {
        const int eq = unit & 3, d = (unit >> 2) & 1, hd = (unit >> 3) & 3, b = unit >> 5;
        const float ibias = a.in[I_MIB][(l * 2 + d) * 4 + hd], fbias = a.in[I_MFB][(l * 2 + d) * 4 + hd];
        bf16_t* HO = d ? HB : HF;
        float C[32];
#pragma unroll
        for (int j = 0; j < 32; ++j) C[j] = 0.f;
        float nn = 0.f, m = 0.f; int par = 0;
        for (int step = 0; step < 68; ++step) {
            const int cc = (step < 4) ? (d ? 3 - step : step) : (d ? 67 - step : step - 4);
            const int row0 = (step < 4) ? b * 256 + cc * 64 : CTXROWS + b * 4096 + cc * 64;
            __syncthreads();
            for (int i = tid; i < 2048; i += NT) { const int r = i >> 5, c8 = (i & 31) * 8;
                *(LAS u32x4*)(qs + r * 256 + c8) = *(const u32x4*)(Q + (size_t)(row0 + r) * 1024 + hd * 256 + c8);
                *(LAS u32x4*)(ks + r * 256 + c8) = *(const u32x4*)(K + (size_t)(row0 + r) * 1024 + hd * 256 + c8); }
            { const int r = tid >> 3, c8 = (tid & 7) * 8; float f[8]; unpack8(*(const u32x4*)(V + (size_t)(row0 + r) * 1024 + hd * 256 + eq * 64 + c8), f);
#pragma unroll
              for (int j = 0; j < 8; ++j) vf[r * 64 + c8 + j] = f[j]; }
            if (tid < 64) { const float* gp = GATE + (size_t)(row0 + tid) * 32; ip[tid] = gp[d * 4 + hd] + ibias; lf[tid] = -softplusf_(-(gp[8 + d * 4 + hd] + fbias)); }
            __syncthreads();
            for (int tt = 0; tt < 64; ++tt) {
                const int t = d ? 63 - tt : tt;
                const float it = ip[t], ft = lf[t];
                const float mn = fmaxf(ft + m, it);
                const float fdec = __expf(ft + m - mn), iw = __expf(it - mn) * 0.0625f, nrm = __expf(-mn);
                m = mn;
                const float vv = iw * vf[t * 64 + e];
                float pn = 0.f;
#pragma unroll
                for (int j8 = 0; j8 < 4; ++j8) {
                    float kk[8], qq[8];
                    unpack8(*(const LAS u32x4*)(ks + t * 256 + dq * 32 + j8 * 8), kk);
                    unpack8(*(const LAS u32x4*)(qs + t * 256 + dq * 32 + j8 * 8), qq);
#pragma unroll
                    for (int j = 0; j < 8; ++j) { const float c = fdec * C[j8 * 8 + j] + vv * kk[j]; C[j8 * 8 + j] = c; pn += c * qq[j]; }
                }
                const int dn = dq * 32 + (e & 31);
                nn = fdec * nn + iw * bf2f(ks[t * 256 + dn]);
                float pd = (e < 32) ? nn * bf2f(qs[t * 256 + dn]) : 0.f;
                pd = wave_sum(pd);
                part[(par * 8 + dq) * 64 + e] = pn; if (e == 0) dpart[par * 8 + dq] = pd;
                __syncthreads();
                if (dq == 0) { float num = 0.f, den = 0.f;
#pragma unroll
                    for (int q = 0; q < 8; ++q) { num += part[(par * 8 + q) * 64 + e]; den += dpart[par * 8 + q]; }
                    HO[(size_t)(row0 + t) * 1024 + hd * 256 + eq * 64 + e] = f2bf(num / fmaxf(fabsf(den), nrm)); }
                par ^= 1;
            }
        }
        __syncthreads();
    }
}
DI void ph_ml_post(const Args& a, int l, bf16_t* HF, const bf16_t* HB, const bf16_t* SO, const bf16_t* SZ) {
    const int wave = ltid() >> 6, lane = ltid() & 63;
    const f32x4 g = *(const f32x4*)(a.in[I_MNORM] + l * 256 + 4 * lane);
    for (int it = blockIdx.x * 8 + wave; it < MROWS * 4; it += gridDim.x * 8) {
        const size_t off = (size_t)(it >> 2) * 1024 + (it & 3) * 256 + 4 * lane;
        const u32x2 wf = *(const u32x2*)(HF + off), wb = *(const u32x2*)(HB + off), wo = *(const u32x2*)(SO + off), wz = *(const u32x2*)(SZ + off);
        const float h0 = (bflo(wf.x) + bflo(wb.x)) * bflo(wo.x), h1 = (bfhi(wf.x) + bfhi(wb.x)) * bfhi(wo.x), h2 = (bflo(wf.y) + bflo(wb.y)) * bflo(wo.y), h3 = (bfhi(wf.y) + bfhi(wb.y)) * bfhi(wo.y);
        const float ss = wave_sum(h0 * h0 + h1 * h1 + h2 * h2 + h3 * h3);
        const float rs = rsqrtf(ss * (1.0f / 256.0f) + 1e-6f);
        u32x2 w; w.x = pg8::cvt_pk_bf16(h0 * rs * g[0] * bflo(wz.x), h1 * rs * g[1] * bfhi(wz.x)); w.y = pg8::cvt_pk_bf16(h2 * rs * g[2] * bflo(wz.y), h3 * rs * g[3] * bfhi(wz.y));
        *(u32x2*)(HF + off) = w;
    }
}

DI void ph_s5_scan(const Args& a, int l, const bf16_t* U, bf16_t* YF, bf16_t* YB, LAS unsigned char* lds) {
    const int tid = ltid(), w = tid >> 6, p = tid & 63;
    LAS float* ub = (LAS float*)lds + w * 2304;
    LAS float* yb = ub + 1024;
    LAS float* xb = yb + 1024;
    for (int unit = blockIdx.x; unit < 128; unit += gridDim.x) {
        const int gb = unit & 7, d = (unit >> 3) & 1, b = unit >> 4, g = gb * 8 + w;
        const float stp = expf(a.in[I_SLOG][(l * 2 + d) * 64 + g]);
        const float lre = a.in[I_SLRE][((size_t)(l * 2 + d) * 64 + g) * 64 + p], lim = a.in[I_SLIM][((size_t)(l * 2 + d) * 64 + g) * 64 + p];
        const float mag = expf(lre * stp), lbr = mag * cosf(lim * stp), lbi = mag * sinf(lim * stp);
        const float dnm = lre * lre + lim * lim;
        const float fre = ((lbr - 1.0f) * lre + lbi * lim) / dnm, fim = (lbi * lre - (lbr - 1.0f) * lim) / dnm;
        float bbr[16], bbi[16];
        { const float* br = a.in[I_SBRE] + (((size_t)l * 64 + g) * 64 + p) * 16; const float* bi = a.in[I_SBIM] + (((size_t)l * 64 + g) * 64 + p) * 16;
#pragma unroll
          for (int h = 0; h < 16; ++h) { bbr[h] = fre * br[h] - fim * bi[h]; bbi[h] = fre * bi[h] + fim * br[h]; } }
        const int hh = p & 15, pt = p >> 4;
        float cr[16], ci[16];
        { const float* c0 = a.in[I_SCRE] + (((size_t)l * 64 + g) * 16 + hh) * 64 + pt * 16; const float* c1 = a.in[I_SCIM] + (((size_t)l * 64 + g) * 16 + hh) * 64 + pt * 16;
#pragma unroll
          for (int j = 0; j < 16; ++j) { cr[j] = c0[j]; ci[j] = c1[j]; } }
        bf16_t* Y = d ? YB : YF;
        float xr = 0.f, xi = 0.f; int par = 0;
        for (int step = 0; step < 68; ++step) {
            const int cc = (step < 4) ? (d ? 3 - step : step) : (d ? 67 - step : step - 4);
            const int row0 = (step < 4) ? b * 256 + cc * 64 : CTXROWS + b * 4096 + cc * 64;
            __syncthreads();
            { const bf16_t* up = U + (size_t)(row0 + p) * 1024 + g * 16; float f[8];
              unpack8(*(const u32x4*)up, f);
#pragma unroll
              for (int j = 0; j < 8; ++j) ub[p * 16 + j] = f[j];
              unpack8(*(const u32x4*)(up + 8), f);
#pragma unroll
              for (int j = 0; j < 8; ++j) ub[p * 16 + 8 + j] = f[j]; }
            __syncthreads();
            for (int tt = 0; tt < 64; ++tt) {
                const int t = d ? 63 - tt : tt;
                float bur = 0.f, bui = 0.f;
#pragma unroll
                for (int h4 = 0; h4 < 4; ++h4) { const f32x4 u = *(const LAS f32x4*)(ub + t * 16 + h4 * 4);
#pragma unroll
                    for (int j = 0; j < 4; ++j) { bur += bbr[h4 * 4 + j] * u[j]; bui += bbi[h4 * 4 + j] * u[j]; } }
                const float nxr = lbr * xr - lbi * xi + bur, nxi = lbr * xi + lbi * xr + bui;
                xr = nxr; xi = nxi;
                xb[par * 128 + p] = xr; xb[par * 128 + 64 + p] = xi;
                __syncthreads();
                float y = 0.f;
#pragma unroll
                for (int j4 = 0; j4 < 4; ++j4) { const f32x4 vr = *(const LAS f32x4*)(xb + par * 128 + pt * 16 + j4 * 4), vi = *(const LAS f32x4*)(xb + par * 128 + 64 + pt * 16 + j4 * 4);
#pragma unroll
                    for (int j = 0; j < 4; ++j) y += cr[j4 * 4 + j] * vr[j] - ci[j4 * 4 + j] * vi[j]; }
                y += __shfl_xor(y, 16); y += __shfl_xor(y, 32);
                if (p < 16) yb[t * 16 + p] = y;
                par ^= 1;
            }
            __syncthreads();
            { u32x4 w0, w1; const LAS float* ys = yb + p * 16;
              w0.x = pg8::cvt_pk_bf16(ys[0], ys[1]); w0.y = pg8::cvt_pk_bf16(ys[2], ys[3]); w0.z = pg8::cvt_pk_bf16(ys[4], ys[5]); w0.w = pg8::cvt_pk_bf16(ys[6], ys[7]);
              w1.x = pg8::cvt_pk_bf16(ys[8], ys[9]); w1.y = pg8::cvt_pk_bf16(ys[10], ys[11]); w1.z = pg8::cvt_pk_bf16(ys[12], ys[13]); w1.w = pg8::cvt_pk_bf16(ys[14], ys[15]);
              bf16_t* yp = Y + (size_t)(row0 + p) * 1024 + g * 16; *(u32x4*)yp = w0; *(u32x4*)(yp + 8) = w1; }
        }
        __syncthreads();
    }
}
DI void ph_s5_post(const Args& a, int l, bf16_t* YF, const bf16_t* YB, const bf16_t* U) {
    const float* dsk = a.in[I_SD] + l * 1024;
    for (size_t i = (size_t)blockIdx.x * NT + ltid(); i < (size_t)MROWS * 128; i += (size_t)gridDim.x * NT) {
        const size_t off = i * 8; const int c = (int)(off & 1023);
        float f[8], bq[8], u[8]; unpack8(*(const u32x4*)(YF + off), f); unpack8(*(const u32x4*)(YB + off), bq); unpack8(*(const u32x4*)(U + off), u);
        const f32x4 d0 = *(const f32x4*)(dsk + c), d1 = *(const f32x4*)(dsk + c + 4);
        float o[8];
#pragma unroll
        for (int j = 0; j < 4; ++j) { o[j] = gelu_tanh_(f[j] + bq[j] + d0[j] * u[j]); o[4 + j] = gelu_tanh_(f[4 + j] + bq[4 + j] + d1[j] * u[4 + j]); }
        u32x4 w; w.x = pg8::cvt_pk_bf16(o[0], o[1]); w.y = pg8::cvt_pk_bf16(o[2], o[3]); w.z = pg8::cvt_pk_bf16(o[4], o[5]); w.w = pg8::cvt_pk_bf16(o[6], o[7]);
        *(u32x4*)(YF + off) = w;
    }
}

constexpr int S5_T = 16, S5_NCH = MROWS / S5_T  , S5_RG = 2304, S5_PMG = S5_RG / 256;
constexpr size_t SZ_AX = (size_t)64 * S5_RG * 512 * 2, SZ_CW1 = (size_t)64 * 256 * 256 * 2, SZ_CW2 = (size_t)64 * 256 * 512 * 2;
constexpr size_t R5_AX = 0, R5_SZ = SZ_AX, R5_G1 = R5_SZ + SZ_ACT, R5_GLUA = R5_G1 + SZ_ACT, R5_END = R5_GLUA + SZ_ACT;
static_assert(WS_R + R5_END <= WS_END, "S5 stage layout fits the workspace"); static_assert(WS_END <= (size_t)512 * 1024 * 1024, "workspace budget");
static_assert(SZ_CW1 + SZ_CW2 <= SZ_ACT, "S5 constants live in the H region once the last projection from H is done");

struct EpiS1 {
    static constexpr bool PERM = true, AFTER_DRAIN = false;
    bf16_t* AX; bf16_t* SZ; bf16_t* G1;
    __device__ __forceinline__ void operator()(const f32x4 (&acc)[2][2][4][2], const Unit& u, int wr, int wc, int fr, int fq) const {
        const int row0 = u.pm * 256 + wr * 64 + fr, seg = u.pn >> 2;
        const int col0 = (u.pn & 3) * 256 + wc * 32 + 8 * fq;
#pragma unroll
        for (int ai = 0; ai < 2; ++ai)
#pragma unroll
            for (int m = 0; m < 4; ++m) {
                const int r = row0 + ai * 128 + m * 16;
#pragma unroll
                for (int bj = 0; bj < 2; ++bj) {
                    f32x4 v0 = acc[ai][bj][m][0], v1 = acc[ai][bj][m][1];
                    const int c = col0 + bj * 128;
                    bf16_t* dp;
                    if (seg == 0) dp = AX + ((size_t)(c >> 4) * S5_RG + (r >> 4)) * 512 + (r & 15) * 16 + (c & 15);
                    else if (seg == 1) { dp = SZ + (size_t)r * 1024 + c;
#pragma unroll
                        for (int j = 0; j < 4; ++j) { v0[j] = siluf_(v0[j]); v1[j] = siluf_(v1[j]); } }
                    else { dp = G1 + (size_t)r * 1024 + c;
#pragma unroll
                        for (int j = 0; j < 4; ++j) { v0[j] = sigmoidf_(v0[j]); v1[j] = sigmoidf_(v1[j]); } }
                    u32x4 w; w.x = pg8::cvt_pk_bf16(v0[0], v0[1]); w.y = pg8::cvt_pk_bf16(v0[2], v0[3]); w.z = pg8::cvt_pk_bf16(v1[0], v1[1]); w.w = pg8::cvt_pk_bf16(v1[2], v1[3]);
                    *(u32x4*)dp = w;
                }
            }
    }
};
struct EpiS5L {
    static constexpr bool PERM = true, AFTER_DRAIN = false;
    bf16_t* AX;
    __device__ __forceinline__ void operator()(const f32x4 (&acc)[2][2][4][2], const Unit& u, int wr, int wc, int fr, int fq) const {
        const int g = u.pm / S5_PMG, rg0 = (u.pm % S5_PMG) * 256 + wr * 64 + fr, col0 = wc * 32 + 8 * fq;
#pragma unroll
        for (int ai = 0; ai < 2; ++ai)
#pragma unroll
            for (int m = 0; m < 4; ++m) {
                const int rg = rg0 + ai * 128 + m * 16;
                if (rg < S5_NCH) {
                    bf16_t* rp = AX + ((size_t)g * S5_RG + rg) * 512 + 256 + col0;
#pragma unroll
                    for (int bj = 0; bj < 2; ++bj) { const f32x4 v0 = acc[ai][bj][m][0], v1 = acc[ai][bj][m][1];
                        u32x4 w; w.x = pg8::cvt_pk_bf16(v0[0], v0[1]); w.y = pg8::cvt_pk_bf16(v0[2], v0[3]); w.z = pg8::cvt_pk_bf16(v1[0], v1[1]); w.w = pg8::cvt_pk_bf16(v1[2], v1[3]);
                        *(u32x4*)(rp + bj * 128) = w; }
                }
            }
    }
};
struct EpiS5Y {
    static constexpr bool PERM = true, AFTER_DRAIN = false;
    const bf16_t* AX; bf16_t* GLUA; const float* dsk;
    __device__ __forceinline__ void operator()(const f32x4 (&acc)[2][2][4][2], const Unit& u, int wr, int wc, int fr, int fq) const {
        const int g = u.pm / S5_PMG, rg0 = (u.pm % S5_PMG) * 256 + wr * 64 + fr, col0 = wc * 32 + 8 * fq;
        const int h0 = col0 & 15;
        const f32x4 d0 = *(const f32x4*)(dsk + g * 16 + h0), d1 = *(const f32x4*)(dsk + g * 16 + h0 + 4);
#pragma unroll
        for (int ai = 0; ai < 2; ++ai)
#pragma unroll
            for (int m = 0; m < 4; ++m) {
                const int rg = rg0 + ai * 128 + m * 16;
                if (rg < S5_NCH) {
#pragma unroll
                    for (int bj = 0; bj < 2; ++bj) {
                        const int c = col0 + bj * 128, t = c >> 4;
                        float uu[8]; unpack8(*(const u32x4*)(AX + ((size_t)g * S5_RG + rg) * 512 + c), uu);
                        const f32x4 v0 = acc[ai][bj][m][0], v1 = acc[ai][bj][m][1];
                        float o[8];
#pragma unroll
                        for (int j = 0; j < 4; ++j) { o[j] = gelu_tanh_(v0[j] + d0[j] * uu[j]); o[4 + j] = gelu_tanh_(v1[j] + d1[j] * uu[4 + j]); }
                        u32x4 w; w.x = pg8::cvt_pk_bf16(o[0], o[1]); w.y = pg8::cvt_pk_bf16(o[2], o[3]); w.z = pg8::cvt_pk_bf16(o[4], o[5]); w.w = pg8::cvt_pk_bf16(o[6], o[7]);
                        *(u32x4*)(GLUA + (size_t)(rg * 16 + t) * 1024 + g * 16 + h0) = w;
                    }
                }
            }
    }
};
DI void ph_s5_consts(const Args& a, int l, bf16_t* CW1, bf16_t* CW2, LAS unsigned char* lds) {
    LAS float* POW = (LAS float*)lds;
    LAS float* BB = POW + 2 * 17 * 64 * 2;
    LAS float* CC = BB + 2 * 64 * 16 * 2;
    LAS float* KT = CC + 16 * 64 * 2;
    const int tid = ltid();
    for (int g = blockIdx.x; g < 64; g += gridDim.x) {
        __syncthreads();
        for (int i = tid; i < 2 * 17 * 64; i += NT) {
            const int p = i & 63, j = (i >> 6) % 17, d = i / (17 * 64);
            const float stp = expf(a.in[I_SLOG][(l * 2 + d) * 64 + g]);
            const float lre = a.in[I_SLRE][((size_t)(l * 2 + d) * 64 + g) * 64 + p], lim = a.in[I_SLIM][((size_t)(l * 2 + d) * 64 + g) * 64 + p];
            const float mag = expf((float)j * lre * stp), ang = (float)j * (lim * stp);
            POW[i * 2] = mag * cosf(ang); POW[i * 2 + 1] = mag * sinf(ang);
        }
        for (int i = tid; i < 16 * 64; i += NT) { const int p = i & 63, h = i >> 6;
            CC[i * 2] = a.in[I_SCRE][(((size_t)l * 64 + g) * 16 + h) * 64 + p]; CC[i * 2 + 1] = a.in[I_SCIM][(((size_t)l * 64 + g) * 16 + h) * 64 + p]; }
        __syncthreads();
        for (int i = tid; i < 2 * 64 * 16; i += NT) {
            const int h = i & 15, p = (i >> 4) & 63, d = i >> 10;
            const float stp = expf(a.in[I_SLOG][(l * 2 + d) * 64 + g]);
            const float lre = a.in[I_SLRE][((size_t)(l * 2 + d) * 64 + g) * 64 + p], lim = a.in[I_SLIM][((size_t)(l * 2 + d) * 64 + g) * 64 + p];
            const float lbr = POW[((d * 17 + 1) * 64 + p) * 2], lbi = POW[((d * 17 + 1) * 64 + p) * 2 + 1];
            const float dnm = lre * lre + lim * lim;
            const float fre = ((lbr - 1.0f) * lre + lbi * lim) / dnm, fim = (lbi * lre - (lbr - 1.0f) * lim) / dnm;
            const float br = a.in[I_SBRE][(((size_t)l * 64 + g) * 64 + p) * 16 + h], bi = a.in[I_SBIM][(((size_t)l * 64 + g) * 64 + p) * 16 + h];
            BB[i * 2] = fre * br - fim * bi; BB[i * 2 + 1] = fre * bi + fim * br;
        }
        __syncthreads();
        for (int i = tid; i < 2 * 16 * 256; i += NT) {
            const int hp = i & 15, h = (i >> 4) & 15, tau = (i >> 8) & 15, d = i >> 12;
            float s = 0.f;
            for (int p = 0; p < 64; ++p) {
                const float cr = CC[(h * 64 + p) * 2], ci = CC[(h * 64 + p) * 2 + 1];
                const float pr = POW[((d * 17 + tau) * 64 + p) * 2], pi = POW[((d * 17 + tau) * 64 + p) * 2 + 1];
                const float br = BB[((d * 64 + p) * 16 + hp) * 2], bi = BB[((d * 64 + p) * 16 + hp) * 2 + 1];
                const float gr = cr * pr - ci * pi, gi = cr * pi + ci * pr;
                s += gr * br - gi * bi;
            }
            KT[i] = s;
        }
        __syncthreads();
        bf16_t* c1 = CW1 + (size_t)g * 65536;
        for (int i = tid; i < 65536 / 2; i += NT) {
            const int k = (i * 2) & 255, n = (i * 2) >> 8; const int p = n & 63, ri = (n >> 6) & 1, d = n >> 7, s = k >> 4, hp = k & 15;
            const int j = d ? s : 15 - s;
            const float pr = POW[((d * 17 + j) * 64 + p) * 2], pi = POW[((d * 17 + j) * 64 + p) * 2 + 1];
            float o[2];
#pragma unroll
            for (int q = 0; q < 2; ++q) { const float br = BB[((d * 64 + p) * 16 + hp + q) * 2], bi = BB[((d * 64 + p) * 16 + hp + q) * 2 + 1]; o[q] = ri ? (pr * bi + pi * br) : (pr * br - pi * bi); }
            *(unsigned*)(c1 + (size_t)n * 256 + k) = pg8::cvt_pk_bf16(o[0], o[1]);
        }
        bf16_t* c2 = CW2 + (size_t)g * 131072;
        for (int i = tid; i < 131072 / 2; i += NT) {
            const int k = (i * 2) & 511, n = (i * 2) >> 9; const int t = n >> 4, h = n & 15;
            float o[2];
            if (k < 256) { const int s = k >> 4, hp = k & 15;
#pragma unroll
                for (int q = 0; q < 2; ++q) { float v = 0.f; if (s <= t) v += KT[((0 * 16 + (t - s)) * 16 + h) * 16 + hp + q]; if (s >= t) v += KT[((1 * 16 + (s - t)) * 16 + h) * 16 + hp + q]; o[q] = v; } }
            else { const int kk = k - 256, d = kk >> 7, ri = (kk >> 6) & 1; const int j = d ? 16 - t : t + 1;
#pragma unroll
                for (int q = 0; q < 2; ++q) { const int p = (kk & 63) + q; const float cr = CC[(h * 64 + p) * 2], ci = CC[(h * 64 + p) * 2 + 1];
                    const float pr = POW[((d * 17 + j) * 64 + p) * 2], pi = POW[((d * 17 + j) * 64 + p) * 2 + 1];
                    o[q] = ri ? -(cr * pi + ci * pr) : (cr * pr - ci * pi); } }
            *(unsigned*)(c2 + (size_t)n * 512 + k) = pg8::cvt_pk_bf16(o[0], o[1]);
        }
    }
    __syncthreads();
}
DI void ph_s5_carry(const Args& a, int l, bf16_t* AX) {
    const int tid = ltid(), w = tid >> 6, p = tid & 63;
    for (int unit = blockIdx.x * 8 + w; unit < 1024; unit += gridDim.x * 8) {
        const int d = unit & 1, g = (unit >> 1) & 63, b = unit >> 7;
        const float stp = expf(a.in[I_SLOG][(l * 2 + d) * 64 + g]);
        const float lre = a.in[I_SLRE][((size_t)(l * 2 + d) * 64 + g) * 64 + p], lim = a.in[I_SLIM][((size_t)(l * 2 + d) * 64 + g) * 64 + p];
        const float mag = expf(16.0f * lre * stp), ang = 16.0f * (lim * stp);
        const float ar = mag * cosf(ang), ai = mag * sinf(ang);
        bf16_t* base = AX + (size_t)g * S5_RG * 512 + 256 + d * 128 + p;
        float xr = 0.f, xi = 0.f;
        for (int c0 = 0; c0 < 272; c0 += 16) {
            float lr[16], li[16];
#pragma unroll
            for (int q = 0; q < 16; ++q) { const int st = c0 + q; const int cc = (st < 16) ? (d ? 15 - st : st) : (d ? 271 - st : st - 16);
                const int row = (st < 16) ? b * 16 + cc : 128 + b * 256 + cc;
                lr[q] = bf2f(base[(size_t)row * 512]); li[q] = bf2f(base[(size_t)row * 512 + 64]); }
#pragma unroll
            for (int q = 0; q < 16; ++q) { const int st = c0 + q; const int cc = (st < 16) ? (d ? 15 - st : st) : (d ? 271 - st : st - 16);
                const int row = (st < 16) ? b * 16 + cc : 128 + b * 256 + cc;
                base[(size_t)row * 512] = f2bf(xr); base[(size_t)row * 512 + 64] = f2bf(xi);
                const float nr = ar * xr - ai * xi + lr[q], ni = ar * xi + ai * xr + li[q]; xr = nr; xi = ni; }
        }
    }
}

#ifndef DUP_PHASE
#define DUP_PHASE -1
#endif
constexpr int NPH_LAYER = 20, PH_FINAL = 2 + DEPTH * NPH_LAYER, NPHASE = PH_FINAL + 1;
template <class Epi>
DI void run_gemm(LAS unsigned char* lds, const bf16_t* A, const bf16_t* Bt, int M, int N, const Epi& E) {
    pg8::Gemm g{A, Bt, M, N, 1024, 1024, 1 << 20, 0}; pg8::StaticOrder S; S.init(M, N, (int)gridDim.x, (int)blockIdx.x);
    pg8::gemm_phase<Epi, pg8::StaticOrder, false>(lds, g, S, E, nullptr);
}
template <class Epi>
DI void run_gemm_g(LAS unsigned char* lds, const bf16_t* A, int lda, int K, const bf16_t* Bt, int M, int N, int pmg, size_t gstride, const Epi& E) {
    pg8::Gemm g{A, Bt, M, N, K, lda, pmg, gstride}; pg8::StaticOrder S; S.init(M, N, (int)gridDim.x, (int)blockIdx.x);
    pg8::gemm_phase<Epi, pg8::StaticOrder, false>(lds, g, S, E, nullptr);
}
__global__ void __launch_bounds__(NT, 2) hy_fwd(Args ka) {
    extern __shared__ __attribute__((aligned(16))) unsigned char lds_raw[];
    LAS unsigned char* lds = (LAS unsigned char*)lds_raw;
    volatile LAS unsigned* xbw = (volatile LAS unsigned*)(lds + 131072);
    if (threadIdx.x < 4) xbw[threadIdx.x] = 0u;
    __syncthreads();
    const int lo = ka.ph_lo, hi = ka.ph_hi;
    XcdBarrier bar; bar.bar = (unsigned*)(ka.ws + WS_CTL); bar.x = 0u; bar.st = xbw;
    if (hi - lo > 1) bar = xcd_barrier_post((unsigned*)(ka.ws + WS_CTL), xbw);
#ifdef PH_ONLY
#define PHEN(p) ((p) == PH_ONLY)
#else
#define PHEN(p) 1
#endif
#define IN(k) (lo <= (k) && (k) < hi)
#define INL(p) (PHEN(p) && IN(pb + (p)))
#define SEAM(k) do { if (IN((k) + 1)) xcd_barrier(bar); } while (0)
#define PH_LOAD \
    Args a; __builtin_memcpy(&a, args_ptr(), sizeof(Args)); \
    unsigned char* ws = a.ws; \
    float* MOD = (float*)(ws + WS_MOD); float* XCTX = (float*)(ws + WS_XCTX); \
    bf16_t* H = (bf16_t*)(ws + WS_H); bf16_t* MERGED = (bf16_t*)(ws + WS_MERGED); \
    bf16_t* WB0 = (bf16_t*)(ws + WS_WB0); bf16_t* WB1 = (bf16_t*)(ws + WS_WB1); \
    unsigned char* R = ws + WS_R; \
    bf16_t* P0 = (bf16_t*)(R + R_P0); bf16_t* P1 = (bf16_t*)(R + R_P1); bf16_t* P2 = (bf16_t*)(R + R_P2); bf16_t* OF = (bf16_t*)(R + R_OF); bf16_t* OB = (bf16_t*)(R + R_OB); \
    float* GATE2 = (float*)(R + R_G2); \
    float* GATE1 = (float*)(ws + WS_MERGED); bf16_t* HALO = (bf16_t*)(ws + WS_MERGED + SZ_GATE);     \
    float* MODP = (float*)R; \
    bf16_t* AX = (bf16_t*)(R + R5_AX); bf16_t* SZ5 = (bf16_t*)(R + R5_SZ); bf16_t* G15 = (bf16_t*)(R + R5_G1); bf16_t* GLUA = (bf16_t*)(R + R5_GLUA); bf16_t* YBR = (bf16_t*)R; \
    bf16_t* CW1 = (bf16_t*)(ws + WS_H); bf16_t* CW2 = (bf16_t*)(ws + WS_H + SZ_CW1); \
    const float* xlat_src = l == 0 ? a.in[I_X] : a.out; const float* xctx_src = l == 0 ? a.in[I_CTX] : XCTX; const float* modl = MOD + (size_t)l * 9 * 3072; \
    (void)MOD; (void)XCTX; (void)H; (void)MERGED; (void)WB0; (void)WB1; (void)P0; (void)P1; (void)P2; (void)OF; (void)OB; (void)GATE2; (void)GATE1; (void)HALO; (void)MODP; (void)AX; (void)SZ5; (void)G15; (void)GLUA; (void)YBR; (void)CW1; (void)CW2; (void)xlat_src; (void)xctx_src; (void)modl;
    LAS float* ldsf = (LAS float*)lds;

    { const int l = 0;
    if (PHEN(100) && IN(0)) { PH_LOAD; ph_modp(a, MODP, ldsf); SEAM(0); }
    if (PHEN(101) && IN(1)) { PH_LOAD; ph_mod(a, MODP, MOD); SEAM(1); } }
    for (int l = 0; l < DEPTH; ++l) {
        const int pb = 2 + l * NPH_LAYER;
        if (INL(0)) { PH_LOAD; ph_norm(a, l, xlat_src, xctx_src, modl, H); ph_cvt(wdesc(a, l, 0), WB0, ldsf); SEAM(pb + 0); }
        if (INL(1)) { PH_LOAD; EpiProj E{P0, 0, GATE1, 12, HALO}; run_gemm(lds, H, WB0, MROWS, 3328, E); SEAM(pb + 1); }
        if (INL(2)) { PH_LOAD; ph_gdn_conv(a, l, P0, HALO, lds); ph_cvt(wdesc(a, l, 1), WB1, ldsf); SEAM(pb + 2); }
        if (INL(3)) { PH_LOAD; ph_gdn_scan(a, l, P0, P1, P2, GATE1, OF, OB, lds); if (DUP_PHASE == 3) ph_gdn_scan(a, l, P0, P1, P2, GATE1, OF, OB, lds); SEAM(pb + 3); }
        if (INL(4)) { PH_LOAD; EpiProj E{P0, 9, nullptr, -1, nullptr}; run_gemm(lds, H, WB1, MROWS, 2048, E); SEAM(pb + 4); }
        if (INL(5)) { PH_LOAD; ph_gdn_post(a, l, OF, OB, P0); ph_cvt(wdesc(a, l, 6), WB0, ldsf); SEAM(pb + 5); }
        if (INL(6)) { PH_LOAD; ph_cvt(wdesc(a, l, 2), WB1, ldsf); EpiBranch E{P1, MERGED, 1}; run_gemm(lds, OF, WB0, MROWS, 1024, E); SEAM(pb + 6); }
        if (INL(7)) { PH_LOAD; ph_cvt(wdesc(a, l, 3), WB0, ldsf); EpiProj E{P0, 0, GATE2, 12, nullptr}; run_gemm(lds, H, WB1, MROWS, 3328, E); SEAM(pb + 7); }
        if (INL(8)) { PH_LOAD; ph_ml_scan(a, l, P0, P1, P2, GATE2, OF, OB, lds); if (DUP_PHASE == 8) ph_ml_scan(a, l, P0, P1, P2, GATE2, OF, OB, lds); SEAM(pb + 8); }
        if (INL(9)) { PH_LOAD; ph_cvt(wdesc(a, l, 8), WB1, ldsf); EpiProj E{P0, 38, nullptr, -1, nullptr}; run_gemm(lds, H, WB0, MROWS, 3072, E); SEAM(pb + 9); }
        if (INL(10)) { PH_LOAD; ph_ml_post(a, l, OF, OB, P0, P1); SEAM(pb + 10); }
        if (INL(11)) { PH_LOAD; ph_cvt(wdesc(a, l, 4), WB0, ldsf); EpiBranch E{P2, MERGED, 0}; run_gemm(lds, OF, WB1, MROWS, 1024, E); SEAM(pb + 11); }
        if (INL(12)) { PH_LOAD; ph_cvt(wdesc(a, l, 5), WB1, ldsf); EpiS1 E{AX, SZ5, G15}; run_gemm(lds, H, WB0, MROWS, 3072, E); SEAM(pb + 12); }
        if (INL(13)) { PH_LOAD; ph_s5_consts(a, l, CW1, CW2, lds); ph_cvt(wdesc(a, l, 7), WB0, ldsf); SEAM(pb + 13); }
        if (INL(14)) { PH_LOAD; EpiS5L E{AX}; run_gemm_g(lds, AX, 512, 256, CW1, 64 * S5_RG, 256, S5_PMG, (size_t)256 * 256 * 2, E); SEAM(pb + 14); }
        if (INL(15)) { PH_LOAD; ph_s5_carry(a, l, AX); SEAM(pb + 15); }
        if (INL(16)) { PH_LOAD; EpiS5Y E{AX, GLUA, a.in[I_SD] + l * 1024}; run_gemm_g(lds, AX, 512, 512, CW2, 64 * S5_RG, 256, S5_PMG, (size_t)256 * 512 * 2, E); SEAM(pb + 16); }
        if (INL(17)) { PH_LOAD; EpiGlu E{SZ5, YBR, a.in[I_SBGLU] + l * 2048}; run_gemm(lds, GLUA, WB1, MROWS, 2048, E); SEAM(pb + 17); }
        if (INL(18)) { PH_LOAD; ph_cvt(wdesc(a, l, 9), WB1, ldsf); EpiBranch E{G15, MERGED, 0}; run_gemm(lds, YBR, WB0, MROWS, 1024, E); SEAM(pb + 18); }
        if (INL(19)) { PH_LOAD;
            const int ro = (l == DEPTH - 1) ? CTXROWS : 0;
            EpiOut E{xlat_src, a.out, xctx_src, XCTX, modl, l, ro};
            run_gemm(lds, MERGED + (size_t)ro * 1024, WB1, MROWS - ro, 1024, E);
            SEAM(pb + 19);
        }
    }
    if (PHEN(102) && IN(PH_FINAL)) { const int l = 0; PH_LOAD; ph_final(a, a.out); }
#undef IN
#undef SEAM
#undef PH_LOAD
}
}

#ifndef MK_LAUNCHES
#define MK_LAUNCHES 1
#endif
extern "C" void kernel_launch(void* const* d_in, const int* in_sizes, int n_in, void* d_out, int out_size, void* d_ws, size_t ws_size, hipStream_t stream) {
    static int grid = 0;
    if (grid == 0) {
        if (n_in != 28 || out_size != hy::NBATCH * hy::SEQ * hy::D || ws_size < hy::WS_END) { fprintf(stderr, "kernel_launch: unexpected shapes (n_in %d, out %d, ws %zu < %zu)\n", n_in, out_size, ws_size, (size_t)hy::WS_END); grid = -1; return; }
        int dev = 0, cus = 0, per_cu = 0;
        if (hipGetDevice(&dev) != hipSuccess || hipDeviceGetAttribute(&cus, hipDeviceAttributeMultiprocessorCount, dev) != hipSuccess) { grid = -1; return; }
        if (hipFuncSetAttribute((const void*)hy::hy_fwd, hipFuncAttributeMaxDynamicSharedMemorySize, hy::LDS_BYTES) != hipSuccess) { fprintf(stderr, "kernel_launch: hipFuncSetAttribute failed\n"); grid = -1; return; }
        if (hipOccupancyMaxActiveBlocksPerMultiprocessor(&per_cu, (const void*)hy::hy_fwd, hy::NT, hy::LDS_BYTES) != hipSuccess || per_cu < 1) { fprintf(stderr, "kernel_launch: occupancy query says %d\n", per_cu); (void)hipGetLastError(); }
        grid = cus;
    }
    if (grid < 0) return;
    (void)hipMemsetAsync((char*)d_ws + hy::WS_CTL, 0, 65536, stream);
    hy::Args a{};
    for (int i = 0; i < 28; ++i) a.in[i] = (const float*)d_in[i];
    a.out = (float*)d_out; a.ws = (unsigned char*)d_ws;
#if MK_LAUNCHES == 1
    a.ph_lo = 0; a.ph_hi = hy::NPHASE;
    hipLaunchKernelGGL(hy::hy_fwd, dim3(grid), dim3(hy::NT), hy::LDS_BYTES, stream, a);
#else
    for (int p = 0; p < hy::NPHASE; ++p) { a.ph_lo = p; a.ph_hi = p + 1; hipLaunchKernelGGL(hy::hy_fwd, dim3(grid), dim3(hy::NT), hy::LDS_BYTES, stream, a); }
#endif
}
```

```cpp
#include <hip/hip_runtime.h>
#include <cstdio>
#include <cstdint>
#define MK_LAUNCHES 1


#define XB_TMO      128
#define XB_XCNT(j)  (256  + 64 * (j))
#define XB_XSUB(j)  (1280 + 64 * (j))
#define XB_XGEN(j)  (2304 + 64 * (j))
#define XB_TOP      3328
#define XB_TOPGEN   3392
#define XCD_BAR_WORDS 3456
#define XB_SPIN_CAP (1u << 18)
#define LAS __attribute__((address_space(3)))

__device__ __forceinline__ unsigned xb_ld(unsigned* p)              { return __hip_atomic_load(p, __ATOMIC_RELAXED, __HIP_MEMORY_SCOPE_AGENT); }
__device__ __forceinline__ unsigned xb_add(unsigned* p, unsigned v) { return __hip_atomic_fetch_add(p, v, __ATOMIC_RELAXED, __HIP_MEMORY_SCOPE_AGENT); }
__device__ __forceinline__ unsigned xb_xcc_id() { return (unsigned)__builtin_amdgcn_s_getreg((3 << 11) | 20) & 0xFu; }
#define XB_SPIN(cond, bar) do { unsigned _sp = 0; while (cond) { __builtin_amdgcn_s_sleep(1); \
    if ((++_sp & 255u) == 0u) { if (xb_ld(&(bar)[XB_TMO])) break; if (_sp > XB_SPIN_CAP) { atomicAdd(&(bar)[XB_TMO], 1u); break; } } } } while (0)

struct XcdBarrier {
    unsigned* bar; unsigned x;
    int wid;
    volatile LAS unsigned* st;
};

__device__ __forceinline__ bool xb_lead(int wid) { int l; asm volatile("v_mbcnt_lo_u32_b32 %0, -1, 0\n\tv_mbcnt_hi_u32_b32 %0, -1, %0" : "=v"(l)); return wid == 0 && l == 0; }
__device__ __forceinline__ XcdBarrier xcd_barrier_post(unsigned* bar, volatile LAS unsigned* st, int wid) {
    XcdBarrier b; b.bar = bar; b.x = xb_xcc_id(); b.st = st; b.wid = wid;
    if (xb_lead(wid)) (void)xb_add(&bar[XB_XCNT(b.x)], 1u);
    return b;
}
__device__ __forceinline__ void xcd_barrier_complete(unsigned* bar, unsigned x, unsigned& nloc, unsigned& nx) {
    const unsigned G = gridDim.x * gridDim.y * gridDim.z;
    unsigned sum, cnt, mine, sp = 0u;
    for (;;) {
        sum = 0u; cnt = 0u; mine = 0u;
#pragma unroll
        for (unsigned j = 0; j < 16; ++j) { const unsigned c = xb_ld(&bar[XB_XCNT(j)]); sum += c; cnt += (c > 0u) ? 1u : 0u; mine = (j == x) ? c : mine; }
        if (sum == G) break;
        __builtin_amdgcn_s_sleep(1);
        if ((++sp & 255u) == 0u) { if (xb_ld(&bar[XB_TMO])) break; if (sp > XB_SPIN_CAP) { atomicAdd(&bar[XB_TMO], 1u); break; } }
    }
    nloc = mine > 0u ? mine : 1u; nx = cnt > 0u ? cnt : 1u;
}

__device__ __forceinline__ void xcd_barrier(const XcdBarrier& b) {
    asm volatile("s_waitcnt vmcnt(0)" ::: "memory");
    __syncthreads();
    if (xb_lead(b.wid)) {
        unsigned* bar = b.bar;
        __builtin_amdgcn_s_waitcnt(0);
        unsigned nloc = b.st[0], nx = b.st[1];
        if (nloc == 0u) { xcd_barrier_complete(bar, b.x, nloc, nx); b.st[0] = nloc; b.st[1] = nx; }
        const unsigned old = xb_add(&bar[XB_XSUB(b.x)], 1u);
        const unsigned gen = old / nloc;
        if (old + 1u == (gen + 1u) * nloc) {
            __builtin_amdgcn_fence(__ATOMIC_RELEASE, "agent");
            asm volatile("s_waitcnt vmcnt(0)" ::: "memory");
            const unsigned og = xb_add(&bar[XB_TOP], 1u);
            const unsigned tg = og / nx;
            if (og + 1u == (tg + 1u) * nx) xb_add(&bar[XB_TOPGEN], 1u);
            else XB_SPIN(xb_ld(&bar[XB_TOPGEN]) == tg, bar);
            __builtin_amdgcn_fence(__ATOMIC_ACQUIRE, "agent");
            xb_add(&bar[XB_XGEN(b.x)], 1u);
            asm volatile("s_waitcnt vmcnt(0)" ::: "memory");
        } else {
            XB_SPIN(xb_ld(&bar[XB_XGEN(b.x)]) == gen, bar);
            __builtin_amdgcn_fence(__ATOMIC_ACQUIRE, "agent");
            asm volatile("s_waitcnt vmcnt(0)" ::: "memory");
        }
    }
    __syncthreads();
}


namespace pg8 {
#define PG8_LAS __attribute__((address_space(3)))
typedef unsigned short bf16_t;
typedef short bf16x8 __attribute__((ext_vector_type(8)));
typedef float f32x4 __attribute__((ext_vector_type(4)));
typedef unsigned u32x4 __attribute__((ext_vector_type(4)));
constexpr int BM = 256, BK = 64, HALF = 128, HTB = HALF * BK * 2  , STAGE_BYTES = 8 * HTB, NXCD = 8, WGM = 8;

__host__ __device__ __forceinline__ int lds_byte(int r, int c) { const int st = (r >> 4) * 2 + (c >> 5), rr = r & 15, cc = c & 31, ob = rr * 64 + cc * 2; return st * 1024 + (ob ^ (((ob >> 9) & 1) << 5)); }
__host__ __device__ __forceinline__ void stage_rc(int b, int& R, int& C) { const int st = b / 1024, sb = b % 1024, swz = sb ^ (((sb >> 9) & 1) << 5); R = (st >> 1) * 16 + swz / 64; C = (st & 1) * 32 + (swz % 64) / 2; }
__host__ __device__ __forceinline__ int perm32(int rho) { const int n = rho >> 4, i = rho & 15; return 8 * (i >> 2) + 4 * n + (i & 3); }

struct Unit { int pm, pn; };
struct Gemm { const bf16_t* A; const bf16_t* Bt; int M, N, K, lda, pmg; size_t gstride; int tid; };

struct StaticOrder {
    int nM, nN, nwg, G, c;
    __host__ __device__ void init(int M, int N, int G_, int c_) { nM = M / BM; nN = N / BM; nwg = nM * nN; G = G_; c = c_; }
    __host__ __device__ bool next(int i, Unit& u) const {
        const long L = (long)i * G + c; if (L >= nwg) return false;
        int wgid = (int)L; { const int q = nwg / NXCD, r = nwg % NXCD, xcd = wgid % NXCD, off = wgid / NXCD; wgid = (xcd < r ? xcd * (q + 1) : r * (q + 1) + (xcd - r) * q) + off; }
        const int nig = WGM * nN, gid = wgid / nig, fm = gid * WGM, gsz = (nM - fm) < WGM ? (nM - fm) : WGM;
        u.pm = fm + ((wgid % nig) % gsz); u.pn = (wgid % nig) / gsz; return true;
    }
    __device__ __forceinline__ void a_ready(const Unit&) const {}
    __device__ __forceinline__ void done(const Unit&) const {}
};
__device__ __forceinline__ unsigned cvt_pk_bf16(float lo, float hi) { unsigned r; asm volatile("v_cvt_pk_bf16_f32 %0, %1, %2" : "=v"(r) : "v"(lo), "v"(hi)); return r; }
typedef float f32x2 __attribute__((ext_vector_type(2)));
template <class Epi, class Sched, bool STAMP = false>
__device__ __forceinline__ void gemm_phase(PG8_LAS unsigned char* lds, const Gemm g, const Sched& S, const Epi& E, unsigned long long* stamps) {
    const int tid = g.tid, wid = __builtin_amdgcn_readfirstlane(tid >> 6), lane = tid & 63, wr = wid >> 2, wc = wid & 3, fr = lane & 15, fq = lane >> 4;
    const int K = g.K, nt = K / BK;
    int ts_lo = 0, ts_hi = 0, nts = 0; const unsigned long long rt_entry = STAMP ? (unsigned long long)wall_clock64() : 0ull;
#define PG8_STAMP() do { if (STAMP && wid == 0 && nts < 64) { const unsigned long long _c = (unsigned long long)clock64(); \
        ts_lo = (lane == nts) ? (int)(unsigned)_c : ts_lo; ts_hi = (lane == nts) ? (int)(unsigned)(_c >> 32) : ts_hi; ++nts; } } while (0)
    PG8_STAMP();
    unsigned voffA[2], voffB[2];
#pragma unroll
    for (int i = 0; i < 2; ++i) { int R, C; stage_rc(tid * 16 + i * 8192, R, C); const int Rb = Epi::PERM ? ((R & ~31) + perm32(R & 31)) : R;
        voffA[i] = (unsigned)(R * g.lda + C) * 2u; voffB[i] = (unsigned)(Rb * K + C) * 2u; }
    const size_t kstep = (size_t)(BK * 2);
    const size_t hstepA = (size_t)HALF * g.lda * 2, hstepB = (size_t)HALF * K * 2;
    const size_t tstepA = 2 * hstepA, tstepB = 2 * hstepB;
    const unsigned ldsw = (unsigned)wid * 1024u;
    const int aoff = lds_byte(wr * 64 + fr, fq * 8), boff = lds_byte(wc * 32 + fr, fq * 8);
#define PG8_SA(b, h) (((b) * 2 + (h)) * HTB)
#define PG8_SB(b, h) ((4 + (b) * 2 + (h)) * HTB)
#define PG8_STAGE(bufoff, gbase, voff) do { _Pragma("unroll") for (int _i = 0; _i < 2; ++_i) \
        __builtin_amdgcn_global_load_lds((const unsigned*)((const char*)(gbase) + (voff)[_i]), (PG8_LAS unsigned*)(lds + (bufoff) + ldsw + _i * 8192), 16, 0, 0); } while (0)
#define PG8_LDA(dst, b, h) do { _Pragma("unroll") for (int m = 0; m < 4; ++m) _Pragma("unroll") for (int k = 0; k < 2; ++k) dst[m][k] = *(const PG8_LAS bf16x8*)(lds + PG8_SA(b, h) + aoff + m * 2048 + k * 1024); } while (0)
#define PG8_LDB(dst, b, h) do { _Pragma("unroll") for (int n = 0; n < 2; ++n) _Pragma("unroll") for (int k = 0; k < 2; ++k) dst[n][k] = *(const PG8_LAS bf16x8*)(lds + PG8_SB(b, h) + boff + n * 2048 + k * 1024); } while (0)
#define PG8_MMA(ai, bj, At, Bt) do { __builtin_amdgcn_s_setprio(1); _Pragma("unroll") for (int m = 0; m < 4; ++m) _Pragma("unroll") for (int n = 0; n < 2; ++n) _Pragma("unroll") for (int k = 0; k < 2; ++k) \
        acc[ai][bj][m][n] = __builtin_amdgcn_mfma_f32_16x16x32_bf16(Bt[n][k], At[m][k], acc[ai][bj][m][n], 0, 0, 0); __builtin_amdgcn_s_setprio(0); } while (0)
#define PG8_WAIT_V(n) asm volatile("s_waitcnt vmcnt(" #n ")" ::: "memory")
#define PG8_WAIT_L(n) asm volatile("s_waitcnt lgkmcnt(" #n ")" ::: "memory")
#define PG8_BAR __builtin_amdgcn_s_barrier()
#define PG8_SCHED __builtin_amdgcn_sched_barrier(0)
    Unit cur, nxt; int ui = 0;
    if (!S.next(0, cur)) return;
    f32x4 acc[2][2][4][2];
#pragma unroll
    for (int a = 0; a < 2; ++a)
#pragma unroll
        for (int b = 0; b < 2; ++b)
#pragma unroll
            for (int m = 0; m < 4; ++m)
#pragma unroll
                for (int n = 0; n < 2; ++n) acc[a][b][m][n] = (f32x4){0.f, 0.f, 0.f, 0.f};
    bf16x8 At[4][2], B0[2][2], B1[2][2];
    const char* cA = (const char*)g.A + (size_t)cur.pm * tstepA; const char* cB = (const char*)g.Bt + (size_t)(cur.pm / g.pmg) * g.gstride + (size_t)cur.pn * tstepB;
    S.a_ready(cur);
    PG8_STAGE(PG8_SB(0, 0), cB, voffB); PG8_STAGE(PG8_SA(0, 0), cA, voffA); PG8_STAGE(PG8_SB(0, 1), cB + hstepB, voffB); PG8_STAGE(PG8_SA(0, 1), cA + hstepA, voffA);
    if (wr == 1) PG8_BAR;
    PG8_WAIT_V(4); PG8_BAR;
    PG8_STAGE(PG8_SB(1, 0), cB + kstep, voffB); PG8_STAGE(PG8_SA(1, 0), cA + kstep, voffA); PG8_STAGE(PG8_SB(1, 1), cB + hstepB + kstep, voffB);
    PG8_WAIT_V(6); PG8_BAR;
    PG8_STAMP();
    for (;;) {
        const bool has_next = S.next(ui + 1, nxt);
        const char* nA = has_next ? (const char*)g.A + (size_t)nxt.pm * tstepA : cA; const char* nB = has_next ? (const char*)g.Bt + (size_t)(nxt.pm / g.pmg) * g.gstride + (size_t)nxt.pn * tstepB : cB;
#pragma unroll 1
        for (int t = 0; t < nt; t += 2) {
            const bool last = (t == nt - 2);
            const char* a1 = cA + (size_t)(t + 1) * kstep;
            const char* a2 = last ? nA : cA + (size_t)(t + 2) * kstep; const char* b2 = last ? nB : cB + (size_t)(t + 2) * kstep;
            const char* a3 = a2 + kstep; const char* b3 = b2 + kstep;
            if (last && has_next) S.a_ready(nxt);
            PG8_LDB(B0, 0, 0); PG8_SCHED; PG8_LDA(At, 0, 0); PG8_STAGE(PG8_SA(1, 1), a1 + hstepA, voffA);
            PG8_WAIT_L(8); PG8_BAR; PG8_WAIT_L(0); PG8_MMA(0, 0, At, B0); PG8_BAR; PG8_SCHED;
            PG8_LDB(B1, 0, 1); PG8_STAGE(PG8_SB(0, 0), b2, voffB);
            PG8_BAR; PG8_WAIT_L(0); PG8_MMA(0, 1, At, B1); PG8_BAR;
            PG8_LDA(At, 0, 1); PG8_STAGE(PG8_SA(0, 0), a2, voffA);
            PG8_BAR; PG8_WAIT_L(0); PG8_MMA(1, 0, At, B0); PG8_BAR; PG8_SCHED;
            PG8_STAGE(PG8_SB(0, 1), b2 + hstepB, voffB);
            PG8_WAIT_V(6); PG8_BAR; PG8_MMA(1, 1, At, B1); PG8_BAR;
            PG8_LDB(B0, 1, 0); PG8_SCHED; PG8_LDA(At, 1, 0); PG8_STAGE(PG8_SA(0, 1), a2 + hstepA, voffA);
            PG8_WAIT_L(8); PG8_BAR; PG8_WAIT_L(0); PG8_MMA(0, 0, At, B0); PG8_BAR; PG8_SCHED;
            PG8_LDB(B1, 1, 1); PG8_STAGE(PG8_SB(1, 0), b3, voffB);
            PG8_BAR; PG8_WAIT_L(0); PG8_MMA(0, 1, At, B1); PG8_BAR;
            PG8_LDA(At, 1, 1); PG8_STAGE(PG8_SA(1, 0), a3, voffA);
            PG8_BAR; PG8_WAIT_L(0); PG8_MMA(1, 0, At, B0); PG8_BAR; PG8_SCHED;
            PG8_STAGE(PG8_SB(1, 1), b3 + hstepB, voffB);
            PG8_WAIT_V(6); PG8_BAR; PG8_MMA(1, 1, At, B1); PG8_BAR;
        }
        PG8_STAMP();
        if constexpr (!Epi::AFTER_DRAIN) { E(acc, cur, wr, wc, fr, fq); S.done(cur); }
        PG8_STAMP();
        if (!has_next) break;
#pragma unroll
        for (int a = 0; a < 2; ++a)
#pragma unroll
            for (int b = 0; b < 2; ++b)
#pragma unroll
                for (int m = 0; m < 4; ++m)
#pragma unroll
                    for (int n = 0; n < 2; ++n) acc[a][b][m][n] = (f32x4){0.f, 0.f, 0.f, 0.f};
        cur = nxt; cA = nA; cB = nB; ++ui;
    }
    PG8_WAIT_V(0);
    if (wr == 0) PG8_BAR;
    PG8_BAR;
    if constexpr (Epi::AFTER_DRAIN) { E.fused(acc, cur, wr, wc, fr, fq, lds, wid, lane); S.done(cur); }
    PG8_STAMP();
    if (STAMP && wid == 0) { stamps[lane] = lane < nts ? (((unsigned long long)(unsigned)ts_hi << 32) | (unsigned)ts_lo) : 0ull;
        if (lane == 62) stamps[62] = rt_entry; if (lane == 63) stamps[63] = (unsigned long long)wall_clock64(); }
#undef PG8_STAMP
#undef PG8_SA
#undef PG8_SB
#undef PG8_STAGE
#undef PG8_LDA
#undef PG8_LDB
#undef PG8_MMA
#undef PG8_WAIT_V
#undef PG8_WAIT_L
#undef PG8_BAR
#undef PG8_SCHED
}
}


namespace hy {
using pg8::bf16_t; using pg8::f32x4; using pg8::u32x4; using pg8::Unit;
typedef unsigned u32x2 __attribute__((ext_vector_type(2)));
#define DI __device__ __forceinline__
constexpr int D = 1024, NBATCH = 8, SEQ = 4096, CTXL = 256, DEPTH = 4;
constexpr int CTXROWS = NBATCH * CTXL;
constexpr int MROWS = CTXROWS + NBATCH * SEQ;
constexpr int NCHUNK = MROWS / 64;
constexpr int NIN = 14384;
constexpr int NT = 512;
constexpr int LDS_BYTES = 131072 + 256;
constexpr int C_GQ = 0, C_GZ = 3072, C_GA = 4096, C_SU = 4128, C_MQ = 6176, C_MO = 9248, C_MI = 11296, C_GATE = 11312;

constexpr size_t al256(size_t x) { return (x + 255) & ~(size_t)255; }
constexpr size_t SZ_ACT = (size_t)MROWS * 1024 * 2;
constexpr size_t SZ_GATE = (size_t)MROWS * 32 * 4;
constexpr size_t SZ_HALO = (size_t)3 * NCHUNK * 4 * 1024 * 2;
constexpr size_t WS_CTL = 0;
constexpr size_t WS_MOD = 65536, SZ_MOD = (size_t)DEPTH * 9 * 3072 * 4;
constexpr size_t WS_XCTX = al256(WS_MOD + SZ_MOD);
constexpr size_t WS_H = WS_XCTX + (size_t)CTXROWS * 1024 * 4;
constexpr size_t WS_MERGED = WS_H + SZ_ACT;
constexpr size_t SZ_WB = (size_t)3328 * 1024 * 2;
constexpr size_t WS_WB0 = WS_MERGED + SZ_ACT;
constexpr size_t WS_WB1 = WS_WB0 + SZ_WB;
constexpr size_t WS_R = WS_WB1 + SZ_WB;
constexpr size_t R_P0 = 0, R_P1 = SZ_ACT, R_P2 = 2 * SZ_ACT, R_OF = 3 * SZ_ACT, R_OB = 4 * SZ_ACT, R_G2 = 5 * SZ_ACT;
constexpr size_t WS_END = WS_R + R_G2 + SZ_GATE + (size_t)4 * 1024 * 1024;
static_assert(SZ_GATE + SZ_HALO <= SZ_ACT, "GDN gate + halo buffers live in the (not yet written) MERGED region");
static_assert((size_t)16 * DEPTH * 9 * 3072 * 4 <= SZ_ACT, "mod partials live in the R region");

struct Args { const float* in[28]; float* out; unsigned char* ws; int ph_lo, ph_hi, wid, pad; };
enum { I_X = 0, I_C, I_CTX, I_CCTX, I_WADA, I_BADA, I_NORMG, I_WIN, I_GCONV, I_GALOG, I_GDTB, I_GNORM, I_SLRE, I_SLIM, I_SLOG, I_SBRE, I_SBIM, I_SCRE, I_SCIM, I_SD, I_SWGLU, I_SBGLU, I_MIB, I_MFB, I_MNORM, I_WBR, I_WOUT, I_FNORM };

typedef const Args __attribute__((address_space(4)))* ArgsP;
DI ArgsP args_ptr() { ArgsP p = (ArgsP)__builtin_amdgcn_kernarg_segment_ptr(); asm volatile("" : "+s"(p)); return p; }
DI int lane_id() { int l; asm volatile("v_mbcnt_lo_u32_b32 %0, -1, 0\n\tv_mbcnt_hi_u32_b32 %0, -1, %0" : "=v"(l)); return l; }
DI int ltid(const Args& a) { return (a.wid << 6) | lane_id(); }
DI float bf2f(bf16_t v) { return __uint_as_float(((unsigned)v) << 16); }
DI float bflo(unsigned w) { return __uint_as_float(w << 16); }
DI float bfhi(unsigned w) { return __uint_as_float(w & 0xffff0000u); }
DI bf16_t f2bf(float f) { return (bf16_t)(pg8::cvt_pk_bf16(f, 0.f) & 0xffffu); }
DI float sigmoidf_(float x) { return 1.0f / (1.0f + __expf(-x)); }
DI float siluf_(float x) { return x / (1.0f + __expf(-x)); }
DI float softplusf_(float x) { return x > 20.f ? x : log1pf(__expf(x)); }
DI float gelu_tanh_(float x) { const float u = 0.7978845608028654f * (x + 0.044715f * x * x * x); return 0.5f * x * (1.0f + tanhf(u)); }
DI float shx(float v, int o, int lane) { return __int_as_float(__builtin_amdgcn_ds_bpermute((lane ^ o) << 2, __float_as_int(v))); }
DI float shup(float v, int o, int lane) { return __int_as_float(__builtin_amdgcn_ds_bpermute((lane - o) << 2, __float_as_int(v))); }
DI float shidx(float v, int src) { return __int_as_float(__builtin_amdgcn_ds_bpermute(src << 2, __float_as_int(v))); }
DI float wave_sum(float v, int lane) {
#pragma unroll
    for (int o = 32; o >= 1; o >>= 1) v += shx(v, o, lane);
    return v; }
DI void unpack8(const u32x4 w, float (&f)[8]) { f[0] = bflo(w.x); f[1] = bfhi(w.x); f[2] = bflo(w.y); f[3] = bfhi(w.y); f[4] = bflo(w.z); f[5] = bfhi(w.z); f[6] = bflo(w.w); f[7] = bfhi(w.w); }
DI int lat_pos(int l, int s) { return (l & 1) ? (((s & 63) << 6) | (s >> 6)) : s; }

struct EpiProj {
    static constexpr bool PERM = true, AFTER_DRAIN = false;
    bf16_t* d0; int modes; float* gdst; int gtile; bf16_t* halo;
    __device__ __forceinline__ void operator()(const f32x4 (&acc)[2][2][4][2], const Unit& u, int wr, int wc, int fr, int fq) const {
        const int row0 = u.pm * 256 + wr * 64 + fr;
        if (u.pn == gtile) {
            if (wc == 0) {
#pragma unroll
                for (int ai = 0; ai < 2; ++ai)
#pragma unroll
                    for (int m = 0; m < 4; ++m) { float* rp = gdst + (size_t)(row0 + ai * 128 + m * 16) * 32 + 8 * fq; *(f32x4*)rp = acc[ai][0][m][0]; *(f32x4*)(rp + 4) = acc[ai][0][m][1]; }
            }
            return;
        }
        const int seg = u.pn >> 2; bf16_t* base = d0 + (size_t)seg * (SZ_ACT / 2); const int md = (modes >> (2 * seg)) & 3;
        const int col0 = (u.pn & 3) * 256 + wc * 32 + 8 * fq;
#pragma unroll
        for (int ai = 0; ai < 2; ++ai)
#pragma unroll
            for (int m = 0; m < 4; ++m) {
                const int r = row0 + ai * 128 + m * 16;
                bf16_t* rowp = base + (size_t)r * 1024 + col0;
                int hidx = -1;
                if (halo) { if (m == 0 && fr < 2) hidx = fr; if (m == 3 && fr >= 14) hidx = fr - 12; }
#pragma unroll
                for (int bj = 0; bj < 2; ++bj) {
                    f32x4 v0 = acc[ai][bj][m][0], v1 = acc[ai][bj][m][1];
                    if (md == 1) {
#pragma unroll
                        for (int j = 0; j < 4; ++j) { v0[j] = siluf_(v0[j]); v1[j] = siluf_(v1[j]); } }
                    else if (md == 2) {
#pragma unroll
                        for (int j = 0; j < 4; ++j) { v0[j] = sigmoidf_(v0[j]); v1[j] = sigmoidf_(v1[j]); } }
                    u32x4 w; w.x = pg8::cvt_pk_bf16(v0[0], v0[1]); w.y = pg8::cvt_pk_bf16(v0[2], v0[3]); w.z = pg8::cvt_pk_bf16(v1[0], v1[1]); w.w = pg8::cvt_pk_bf16(v1[2], v1[3]);
                    *(u32x4*)(rowp + bj * 128) = w;
                    if (hidx >= 0) *(u32x4*)(halo + ((size_t)seg * (NCHUNK * 4) + (size_t)(r >> 6) * 4 + hidx) * 1024 + col0 + bj * 128) = w;
                }
            }
    }
};
struct EpiBranch {
    static constexpr bool PERM = true, AFTER_DRAIN = false;
    const bf16_t* G; bf16_t* MG; int first;
    __device__ __forceinline__ void operator()(const f32x4 (&acc)[2][2][4][2], const Unit& u, int wr, int wc, int fr, int fq) const {
        const int row0 = u.pm * 256 + wr * 64 + fr, col0 = u.pn * 256 + wc * 32 + 8 * fq;
#pragma unroll
        for (int ai = 0; ai < 2; ++ai)
#pragma unroll
            for (int m = 0; m < 4; ++m) {
                const size_t off = (size_t)(row0 + ai * 128 + m * 16) * 1024 + col0;
#pragma unroll
                for (int bj = 0; bj < 2; ++bj) {
                    const u32x4 gw = *(const u32x4*)(G + off + bj * 128);
                    float g[8], o[8]; unpack8(gw, g);
                    if (first) {
#pragma unroll
                        for (int j = 0; j < 8; ++j) o[j] = 0.f; }
                    else { const u32x4 ow = *(const u32x4*)(MG + off + bj * 128); unpack8(ow, o); }
                    const f32x4 v0 = acc[ai][bj][m][0], v1 = acc[ai][bj][m][1];
#pragma unroll
                    for (int j = 0; j < 4; ++j) { o[j] += g[j] * v0[j]; o[4 + j] += g[4 + j] * v1[j]; }
                    u32x4 w; w.x = pg8::cvt_pk_bf16(o[0], o[1]); w.y = pg8::cvt_pk_bf16(o[2], o[3]); w.z = pg8::cvt_pk_bf16(o[4], o[5]); w.w = pg8::cvt_pk_bf16(o[6], o[7]);
                    *(u32x4*)(MG + off + bj * 128) = w;
                }
                asm volatile("" ::: "memory");
            }
    }
};
struct EpiGlu {
    static constexpr bool PERM = true, AFTER_DRAIN = false;
    const bf16_t* SZ; bf16_t* O; const float* bias;
    __device__ __forceinline__ void operator()(const f32x4 (&acc)[2][2][4][2], const Unit& u, int wr, int wc, int fr, int fq) const {
        const int row0 = u.pm * 256 + wr * 64 + fr, col0 = u.pn * 128 + wc * 32 + 8 * fq;
        float ba[8], bg[8];
#pragma unroll
        for (int j = 0; j < 8; ++j) { ba[j] = bias[col0 + j]; bg[j] = bias[1024 + col0 + j]; }
#pragma unroll
        for (int ai = 0; ai < 2; ++ai)
#pragma unroll
            for (int m = 0; m < 4; ++m) {
                const size_t off = (size_t)(row0 + ai * 128 + m * 16) * 1024 + col0;
                const u32x4 zw = *(const u32x4*)(SZ + off); float z[8], o[8]; unpack8(zw, z);
#pragma unroll
                for (int n = 0; n < 2; ++n)
#pragma unroll
                    for (int j = 0; j < 4; ++j) { const int c = 4 * n + j; o[c] = (acc[ai][0][m][n][j] + ba[c]) * sigmoidf_(acc[ai][1][m][n][j] + bg[c]) * z[c]; }
                u32x4 w; w.x = pg8::cvt_pk_bf16(o[0], o[1]); w.y = pg8::cvt_pk_bf16(o[2], o[3]); w.z = pg8::cvt_pk_bf16(o[4], o[5]); w.w = pg8::cvt_pk_bf16(o[6], o[7]);
                *(u32x4*)(O + off) = w;
            }
    }
};
struct EpiOut {
    static constexpr bool PERM = false, AFTER_DRAIN = false;
    const float* xlat_src; float* xlat_dst; const float* xctx_src; float* xctx_dst; const float* mod; int l; int row_off;
    __device__ __forceinline__ void operator()(const f32x4 (&acc)[2][2][4][2], const Unit& u, int wr, int wc, int fr, int fq) const {
        const int row0 = row_off + u.pm * 256 + wr * 64 + fr, col0 = u.pn * 256 + wc * 32 + 4 * fq;
#pragma unroll
        for (int ai = 0; ai < 2; ++ai)
#pragma unroll
            for (int m = 0; m < 4; ++m) {
                const int r = row0 + ai * 128 + m * 16;
                const float* xs; float* xd; const float* gp;
                if (r < CTXROWS) { xs = xctx_src + (size_t)r * 1024; xd = xctx_dst + (size_t)r * 1024; gp = mod + 8 * 3072 + 2048; }
                else { const int q = r - CTXROWS, b = q >> 12, p = lat_pos(l, q & 4095); const size_t o = ((size_t)b * 4096 + p) * 1024; xs = xlat_src + o; xd = xlat_dst + o; gp = mod + b * 3072 + 2048; }
#pragma unroll
                for (int bj = 0; bj < 2; ++bj)
#pragma unroll
                    for (int n = 0; n < 2; ++n) { const int c = col0 + bj * 128 + n * 16; const f32x4 x = *(const f32x4*)(xs + c), g = *(const f32x4*)(gp + c); *(f32x4*)(xd + c) = x + g * acc[ai][bj][m][n]; }
                asm volatile("" ::: "memory");
            }
    }
};

DI void ph_modp(const Args& a, float* modp, LAS float* sl) {
    for (int it = blockIdx.x; it < 384; it += gridDim.x) {
        const int l = it / 96, kq = (it / 6) % 16, nt = it % 6;
        __syncthreads();
        for (int i = ltid(a); i < 576; i += NT) { const int j = i >> 6, k = kq * 64 + (i & 63); const float cv = (j < 8) ? a.in[I_C][j * 1024 + k] : a.in[I_CCTX][k]; sl[i] = siluf_(cv); }
        __syncthreads();
        const int n = nt * 512 + ltid(a);
        float acc[9];
#pragma unroll
        for (int j = 0; j < 9; ++j) acc[j] = 0.f;
        const float* w = a.in[I_WADA] + ((size_t)l * 1024 + kq * 64) * 3072 + n;
#pragma unroll 4
        for (int k = 0; k < 64; ++k) { const float wv = w[(size_t)k * 3072];
#pragma unroll
            for (int j = 0; j < 9; ++j) acc[j] += sl[j * 64 + k] * wv; }
#pragma unroll
        for (int j = 0; j < 9; ++j) modp[(((size_t)kq * 4 + l) * 9 + j) * 3072 + n] = acc[j];
    }
}
DI void ph_mod(const Args& a, const float* modp, float* mod) {
    for (int i = blockIdx.x * NT + ltid(a); i < DEPTH * 9 * 3072; i += gridDim.x * NT) {
        const int l = i / (9 * 3072), n = i % 3072; float s = a.in[I_BADA][l * 3072 + n];
#pragma unroll
        for (int kq = 0; kq < 16; ++kq) s += modp[(size_t)kq * (DEPTH * 9 * 3072) + i];
        mod[i] = s;
    }
}
DI void ph_norm(const Args& a, int l, const float* xlat, const float* xctx, const float* mod, bf16_t* H) {
    const int wave = ltid(a) >> 6, lane = ltid(a) & 63;
    const float* g = a.in[I_NORMG] + l * 1024;
    for (int r = blockIdx.x * 8 + wave; r < MROWS; r += gridDim.x * 8) {
        const float* src; const float* md;
        if (r < CTXROWS) { src = xctx + (size_t)r * 1024; md = mod + 8 * 3072; }
        else { const int q = r - CTXROWS, b = q >> 12, p = lat_pos(l, q & 4095); src = xlat + ((size_t)b * 4096 + p) * 1024; md = mod + b * 3072; }
        f32x4 v[4]; float ss = 0.f;
#pragma unroll
        for (int i = 0; i < 4; ++i) { v[i] = *(const f32x4*)(src + i * 256 + lane * 4); ss += v[i][0] * v[i][0] + v[i][1] * v[i][1] + v[i][2] * v[i][2] + v[i][3] * v[i][3]; }
        ss = wave_sum(ss, lane);
        const float rs = rsqrtf(ss * (1.0f / 1024.0f) + 1e-6f);
#pragma unroll
        for (int i = 0; i < 4; ++i) { const int c = i * 256 + lane * 4;
            const f32x4 gv = *(const f32x4*)(g + c), sh = *(const f32x4*)(md + c), sc = *(const f32x4*)(md + 1024 + c);
            const f32x4 y = (v[i] * rs) * gv * (sc + 1.0f) + sh;
            u32x2 w; w.x = pg8::cvt_pk_bf16(y[0], y[1]); w.y = pg8::cvt_pk_bf16(y[2], y[3]);
            *(u32x2*)(H + (size_t)r * 1024 + c) = w; }
    }
}
DI void ph_final(const Args& a, float* x) {
    const int wave = ltid(a) >> 6, lane = ltid(a) & 63;
    const float* g = a.in[I_FNORM];
    for (int r = blockIdx.x * 8 + wave; r < NBATCH * SEQ; r += gridDim.x * 8) {
        float* src = x + (size_t)r * 1024;
        f32x4 v[4]; float ss = 0.f;
#pragma unroll
        for (int i = 0; i < 4; ++i) { v[i] = *(const f32x4*)(src + i * 256 + lane * 4); ss += v[i][0] * v[i][0] + v[i][1] * v[i][1] + v[i][2] * v[i][2] + v[i][3] * v[i][3]; }
        ss = wave_sum(ss, lane);
        const float rs = rsqrtf(ss * (1.0f / 1024.0f) + 1e-6f);
#pragma unroll
        for (int i = 0; i < 4; ++i) { const int c = i * 256 + lane * 4; const f32x4 gv = *(const f32x4*)(g + c); *(f32x4*)(src + c) = (v[i] * rs) * gv; }
    }
}
struct WDesc { const float* src; int ld, id, n64, tid; };
DI void wmap(int id, int nb, int& col, int& valid) {
    valid = 64;
    switch (id) {
        case 0: if (nb < 48) col = C_GQ + 64 * nb; else if (nb == 48) { col = C_GA; valid = 32; } else { col = 0; valid = 0; } break;
        case 1: col = (nb < 16) ? C_GZ + 64 * nb : C_GATE + 64 * (nb - 16); break;
        case 2: if (nb < 48) col = C_MQ + 64 * nb; else if (nb == 48) { col = C_MI; valid = 16; } else { col = 0; valid = 0; } break;
        case 3: col = (nb < 32) ? C_MO + 64 * nb : C_GATE + 2048 + 64 * (nb - 32); break;
        case 4: col = (nb < 32) ? C_SU + 64 * nb : C_GATE + 1024 + 64 * (nb - 32); break;
        case 5: { const int pn = nb >> 2, q = nb & 3; col = (q >> 1) * 1024 + 128 * pn + (q & 1) * 64; } break;
        default: col = 64 * nb; break;
    }
}
DI WDesc wdesc(const Args& a, int l, int id) {
    WDesc w; w.id = id; w.tid = ltid(a);
    if (id <= 4) { w.src = a.in[I_WIN] + (size_t)l * 1024 * NIN; w.ld = NIN; w.n64 = (id == 0 || id == 2) ? 52 : (id == 1 ? 32 : 48); }
    else if (id == 5) { w.src = a.in[I_SWGLU] + (size_t)l * 1024 * 2048; w.ld = 2048; w.n64 = 32; }
    else if (id <= 8) { w.src = a.in[I_WBR] + ((size_t)l * 3 + (id - 6)) * 1024 * 1024; w.ld = 1024; w.n64 = 16; }
    else { w.src = a.in[I_WOUT] + (size_t)l * 1024 * 1024; w.ld = 1024; w.n64 = 16; }
    return w;
}
DI void ph_cvt(const WDesc w, bf16_t* dst, LAS float* tile) {
    const int tid = w.tid, ntile = w.n64 * 16;
    for (int t = blockIdx.x; t < ntile; t += gridDim.x) {
        const int nb = t >> 4, kb = t & 15; int col, valid; wmap(w.id, nb, col, valid);
        __syncthreads();
        { const int c = tid & 63, k0 = tid >> 6;
#pragma unroll
          for (int i = 0; i < 8; ++i) { const int k = k0 + 8 * i; tile[k * 65 + c] = (c < valid) ? w.src[(size_t)(kb * 64 + k) * w.ld + col + c] : 0.f; } }
        __syncthreads();
        { const int n = tid >> 3, kk = (tid & 7) * 8; u32x4 o;
          o.x = pg8::cvt_pk_bf16(tile[(kk + 0) * 65 + n], tile[(kk + 1) * 65 + n]); o.y = pg8::cvt_pk_bf16(tile[(kk + 2) * 65 + n], tile[(kk + 3) * 65 + n]);
          o.z = pg8::cvt_pk_bf16(tile[(kk + 4) * 65 + n], tile[(kk + 5) * 65 + n]); o.w = pg8::cvt_pk_bf16(tile[(kk + 6) * 65 + n], tile[(kk + 7) * 65 + n]);
          *(u32x4*)(dst + (size_t)(nb * 64 + n) * 1024 + kb * 64 + kk) = o; }
    }
    __syncthreads();
}

DI void ph_gdn_conv(const Args& a, int l, bf16_t* QKV  , const bf16_t* halo, LAS unsigned char* lds) {
    LAS bf16_t* raw = (LAS bf16_t*)lds;
    constexpr int P = 136;
    const int tid = ltid(a);
    const float* cw = a.in[I_GCONV] + (size_t)l * 5 * 3072;
    for (int unit = blockIdx.x; unit < NCHUNK * 24; unit += gridDim.x) {
        const int cb = unit / 24, seg = (unit % 24) >> 3, h = unit & 7;
        bf16_t* T = QKV + (size_t)seg * (SZ_ACT / 2);
        const bool first = (cb < 32) ? ((cb & 3) == 0) : (((cb - 32) & 63) == 0);
        const bool last = (cb < 32) ? ((cb & 3) == 3) : (((cb - 32) & 63) == 63);
        __syncthreads();
        for (int i = tid; i < 68 * 16; i += NT) {
            const int rr = i >> 4, c8 = (i & 15) * 8; u32x4 w = (u32x4){0u, 0u, 0u, 0u};
            if (rr >= 2 && rr < 66) w = *(const u32x4*)(T + (size_t)(cb * 64 + rr - 2) * 1024 + h * 128 + c8);
            else if (rr < 2) { if (!first) w = *(const u32x4*)(halo + ((size_t)seg * (NCHUNK * 4) + (size_t)(cb - 1) * 4 + 2 + rr) * 1024 + h * 128 + c8); }
            else { if (!last) w = *(const u32x4*)(halo + ((size_t)seg * (NCHUNK * 4) + (size_t)(cb + 1) * 4 + (rr - 66)) * 1024 + h * 128 + c8); }
            *(LAS u32x4*)(raw + rr * P + c8) = w;
        }
        __syncthreads();
        const int t = tid >> 3, c0 = (tid & 7) * 16;
        float o[16]; float ss = 0.f;
#pragma unroll
        for (int half = 0; half < 2; ++half) {
            float acc[8];
#pragma unroll
            for (int j = 0; j < 8; ++j) acc[j] = 0.f;
#pragma unroll
            for (int k = 0; k < 5; ++k) {
                const u32x4 w = *(const LAS u32x4*)(raw + (t + k) * P + c0 + half * 8); float x[8]; unpack8(w, x);
                const float* wp = cw + (size_t)k * 3072 + seg * 1024 + h * 128 + c0 + half * 8;
                const f32x4 w0 = *(const f32x4*)wp, w1 = *(const f32x4*)(wp + 4);
#pragma unroll
                for (int j = 0; j < 4; ++j) { acc[j] += w0[j] * x[j]; acc[4 + j] += w1[j] * x[4 + j]; }
            }
#pragma unroll
            for (int j = 0; j < 8; ++j) { const float s = siluf_(acc[j]); o[half * 8 + j] = s; ss += s * s; }
        }
        ss += shx(ss, 1, tid & 63); ss += shx(ss, 2, tid & 63); ss += shx(ss, 4, tid & 63);
        float scale = 1.0f;
        if (seg == 0) scale = rsqrtf(ss + 1e-6f) * 0.08838834764831845f;
        else if (seg == 1) scale = rsqrtf(ss + 1e-6f);
        u32x4 w0, w1;
        w0.x = pg8::cvt_pk_bf16(o[0] * scale, o[1] * scale); w0.y = pg8::cvt_pk_bf16(o[2] * scale, o[3] * scale); w0.z = pg8::cvt_pk_bf16(o[4] * scale, o[5] * scale); w0.w = pg8::cvt_pk_bf16(o[6] * scale, o[7] * scale);
        w1.x = pg8::cvt_pk_bf16(o[8] * scale, o[9] * scale); w1.y = pg8::cvt_pk_bf16(o[10] * scale, o[11] * scale); w1.z = pg8::cvt_pk_bf16(o[12] * scale, o[13] * scale); w1.w = pg8::cvt_pk_bf16(o[14] * scale, o[15] * scale);
        bf16_t* op = T + (size_t)(cb * 64 + t) * 1024 + h * 128 + c0;
        *(u32x4*)op = w0; *(u32x4*)(op + 8) = w1;
    }
    __syncthreads();
}
DI void ph_gdn_scan(const Args& a, int l, const bf16_t* Q, const bf16_t* K, const bf16_t* V, const float* GATE, bf16_t* OF, bf16_t* OB, LAS unsigned char* lds) {
    LAS float* qf = (LAS float*)lds;
    LAS float* kf = qf + 64 * 128;
    LAS float* vf = kf + 64 * 128;
    LAS float* av = vf + 64 * 64;
    LAS float* bt = av + 64;
    LAS float* part = bt + 64;
    LAS float* po = part + 1024;
    const int tid = ltid(a), e = tid & 63, dq = tid >> 6;
    for (int unit = blockIdx.x; unit < 256; unit += gridDim.x) {
        const int eh = unit & 1, d = (unit >> 1) & 1, h = (unit >> 2) & 7, b = unit >> 5;
        const float nea = -__expf(a.in[I_GALOG][(l * 2 + d) * 8 + h]), dtb = a.in[I_GDTB][(l * 2 + d) * 8 + h];
        bf16_t* O = d ? OB : OF;
        float S[16];
#pragma unroll
        for (int j = 0; j < 16; ++j) S[j] = 0.f;
        float opart = 0.f; int prow = -1, par = 0;
        for (int step = 0; step < 68; ++step) {
            const int cc = (step < 4) ? (d ? 3 - step : step) : (d ? 67 - step : step - 4);
            const int row0 = (step < 4) ? b * 256 + cc * 64 : CTXROWS + b * 4096 + cc * 64;
            __syncthreads();
            for (int i = tid; i < 1024; i += NT) { const int r = i >> 4, c8 = (i & 15) * 8; float f[8];
                unpack8(*(const u32x4*)(Q + (size_t)(row0 + r) * 1024 + h * 128 + c8), f);
#pragma unroll
                for (int j = 0; j < 8; ++j) qf[r * 128 + c8 + j] = f[j];
                unpack8(*(const u32x4*)(K + (size_t)(row0 + r) * 1024 + h * 128 + c8), f);
#pragma unroll
                for (int j = 0; j < 8; ++j) kf[r * 128 + c8 + j] = f[j]; }
            { const int r = tid >> 3, c8 = (tid & 7) * 8; float f[8]; unpack8(*(const u32x4*)(V + (size_t)(row0 + r) * 1024 + h * 128 + eh * 64 + c8), f);
#pragma unroll
              for (int j = 0; j < 8; ++j) vf[r * 64 + c8 + j] = f[j]; }
            if (tid < 64) { const float* gp = GATE + (size_t)(row0 + tid) * 32; av[tid] = __expf(nea * softplusf_(gp[d * 8 + h] + dtb)); bt[tid] = sigmoidf_(gp[16 + d * 8 + h]); }
            __syncthreads();
            for (int tt = 0; tt < 64; ++tt) {
                const int t = d ? 63 - tt : tt;
                float kk[16];
#pragma unroll
                for (int j4 = 0; j4 < 4; ++j4) { const f32x4 x = *(const LAS f32x4*)(kf + t * 128 + dq * 16 + j4 * 4); kk[j4 * 4] = x[0]; kk[j4 * 4 + 1] = x[1]; kk[j4 * 4 + 2] = x[2]; kk[j4 * 4 + 3] = x[3]; }
                float p = 0.f;
#pragma unroll
                for (int j = 0; j < 16; ++j) p += kk[j] * S[j];
                part[(par * 8 + dq) * 64 + e] = p; po[(par * 8 + dq) * 64 + e] = opart;
                __syncthreads();
                if (dq == 0 && prow >= 0) { float o = 0.f;
#pragma unroll
                    for (int q = 0; q < 8; ++q) o += po[(par * 8 + q) * 64 + e];
                    O[(size_t)prow * 1024 + h * 128 + eh * 64 + e] = f2bf(o); }
                float ks = 0.f;
#pragma unroll
                for (int q = 0; q < 8; ++q) ks += part[(par * 8 + q) * 64 + e];
                const float at = av[t], vn = bt[t] * (vf[t * 64 + e] - at * ks);
#pragma unroll
                for (int j = 0; j < 16; ++j) S[j] = at * S[j] + kk[j] * vn;
                float qo = 0.f;
#pragma unroll
                for (int j4 = 0; j4 < 4; ++j4) { const f32x4 x = *(const LAS f32x4*)(qf + t * 128 + dq * 16 + j4 * 4); qo += x[0] * S[j4 * 4] + x[1] * S[j4 * 4 + 1] + x[2] * S[j4 * 4 + 2] + x[3] * S[j4 * 4 + 3]; }
                opart = qo; prow = row0 + t; par ^= 1;
            }
        }
        po[(par * 8 + dq) * 64 + e] = opart;
        __syncthreads();
        if (dq == 0) { float o = 0.f;
#pragma unroll
            for (int q = 0; q < 8; ++q) o += po[(par * 8 + q) * 64 + e];
            O[(size_t)prow * 1024 + h * 128 + eh * 64 + e] = f2bf(o); }
        __syncthreads();
    }
}
DI void ph_gdn_post(const Args& a, int l, bf16_t* OF, const bf16_t* OB, const bf16_t* SZ) {
    const int wave = ltid(a) >> 6, lane = ltid(a) & 63;
    const float* g = a.in[I_GNORM] + l * 128;
    const float g0 = g[2 * lane], g1 = g[2 * lane + 1];
    for (int it = blockIdx.x * 8 + wave; it < MROWS * 8; it += gridDim.x * 8) {
        const size_t off = (size_t)(it >> 3) * 1024 + (it & 7) * 128 + 2 * lane;
        const unsigned wf = *(const unsigned*)(OF + off), wb = *(const unsigned*)(OB + off), wz = *(const unsigned*)(SZ + off);
        const float o0 = bflo(wf) + bflo(wb), o1 = bfhi(wf) + bfhi(wb);
        const float ss = wave_sum(o0 * o0 + o1 * o1, lane);
        const float rs = rsqrtf(ss * (1.0f / 128.0f) + 1e-6f);
        *(unsigned*)(OF + off) = pg8::cvt_pk_bf16(o0 * rs * g0 * bflo(wz), o1 * rs * g1 * bfhi(wz));
    }
}

DI void ph_ml_scan(const Args& a, int l, const bf16_t* Q, const bf16_t* K, const bf16_t* V, const float* GATE, bf16_t* HF, bf16_t* HB, LAS unsigned char* lds) {
    LAS bf16_t* qs = (LAS bf16_t*)lds;
    LAS bf16_t* ks = qs + 64 * 256;
    LAS float* vf = (LAS float*)(ks + 64 * 256);
    LAS float* ip = vf + 64 * 64;
    LAS float* lf = ip + 64;
    LAS float* part = lf + 64;
    LAS float* dpart = part + 1024;
    const int tid = ltid(a), e = tid & 63, dq = tid >> 6;
    for (int unit = blockIdx.x; unit < 256; unit += gridDim.x) {
        const int eq = unit & 3, d = (unit >> 2) & 1, hd = (unit >> 3) & 3, b = unit >> 5;
        const float ibias = a.in[I_MIB][(l * 2 + d) * 4 + hd], fbias = a.in[I_MFB][(l * 2 + d) * 4 + hd];
        bf16_t* HO = d ? HB : HF;
        float C[32];
#pragma unroll
        for (int j = 0; j < 32; ++j) C[j] = 0.f;
        float nn = 0.f, m = 0.f; int par = 0;
        for (int step = 0; step < 68; ++step) {
            const int cc = (step < 4) ? (d ? 3 - step : step) : (d ? 67 - step : step - 4);
            const int row0 = (step < 4) ? b * 256 + cc * 64 : CTXROWS + b * 4096 + cc * 64;
            __syncthreads();
            for (int i = tid; i < 2048; i += NT) { const int r = i >> 5, c8 = (i & 31) * 8;
                *(LAS u32x4*)(qs + r * 256 + c8) = *(const u32x4*)(Q + (size_t)(row0 + r) * 1024 + hd * 256 + c8);
                *(LAS u32x4*)(ks + r * 256 + c8) = *(const u32x4*)(K + (size_t)(row0 + r) * 1024 + hd * 256 + c8); }
            { const int r = tid >> 3, c8 = (tid & 7) * 8; float f[8]; unpack8(*(const u32x4*)(V + (size_t)(row0 + r) * 1024 + hd * 256 + eq * 64 + c8), f);
#pragma unroll
              for (int j = 0; j < 8; ++j) vf[r * 64 + c8 + j] = f[j]; }
            if (tid < 64) { const float* gp = GATE + (size_t)(row0 + tid) * 32; ip[tid] = gp[d * 4 + hd] + ibias; lf[tid] = -softplusf_(-(gp[8 + d * 4 + hd] + fbias)); }
            __syncthreads();
            for (int tt = 0; tt < 64; ++tt) {
                const int t = d ? 63 - tt : tt;
                const float it = ip[t], ft = lf[t];
                const float mn = fmaxf(ft + m, it);
                const float fdec = __expf(ft + m - mn), iw = __expf(it - mn) * 0.0625f, nrm = __expf(-mn);
                m = mn;
                const float vv = iw * vf[t * 64 + e];
                float pn = 0.f;
#pragma unroll
                for (int j8 = 0; j8 < 4; ++j8) {
                    float kk[8], qq[8];
                    unpack8(*(const LAS u32x4*)(ks + t * 256 + dq * 32 + j8 * 8), kk);
                    unpack8(*(const LAS u32x4*)(qs + t * 256 + dq * 32 + j8 * 8), qq);
#pragma unroll
                    for (int j = 0; j < 8; ++j) { const float c = fdec * C[j8 * 8 + j] + vv * kk[j]; C[j8 * 8 + j] = c; pn += c * qq[j]; }
                }
                const int dn = dq * 32 + (e & 31);
                nn = fdec * nn + iw * bf2f(ks[t * 256 + dn]);
                float pd = (e < 32) ? nn * bf2f(qs[t * 256 + dn]) : 0.f;
                pd = wave_sum(pd, e);
                part[(par * 8 + dq) * 64 + e] = pn; if (e == 0) dpart[par * 8 + dq] = pd;
                __syncthreads();
                if (dq == 0) { float num = 0.f, den = 0.f;
#pragma unroll
                    for (int q = 0; q < 8; ++q) { num += part[(par * 8 + q) * 64 + e]; den += dpart[par * 8 + q]; }
                    HO[(size_t)(row0 + t) * 1024 + hd * 256 + eq * 64 + e] = f2bf(num / fmaxf(fabsf(den), nrm)); }
                par ^= 1;
            }
        }
        __syncthreads();
    }
}
DI void ph_ml_post(const Args& a, int l, bf16_t* HF, const bf16_t* HB, const bf16_t* SO, const bf16_t* SZ) {
    const int wave = ltid(a) >> 6, lane = ltid(a) & 63;
    const f32x4 g = *(const f32x4*)(a.in[I_MNORM] + l * 256 + 4 * lane);
    for (int it = blockIdx.x * 8 + wave; it < MROWS * 4; it += gridDim.x * 8) {
        const size_t off = (size_t)(it >> 2) * 1024 + (it & 3) * 256 + 4 * lane;
        const u32x2 wf = *(const u32x2*)(HF + off), wb = *(const u32x2*)(HB + off), wo = *(const u32x2*)(SO + off), wz = *(const u32x2*)(SZ + off);
        const float h0 = (bflo(wf.x) + bflo(wb.x)) * bflo(wo.x), h1 = (bfhi(wf.x) + bfhi(wb.x)) * bfhi(wo.x), h2 = (bflo(wf.y) + bflo(wb.y)) * bflo(wo.y), h3 = (bfhi(wf.y) + bfhi(wb.y)) * bfhi(wo.y);
        const float ss = wave_sum(h0 * h0 + h1 * h1 + h2 * h2 + h3 * h3, lane);
        const float rs = rsqrtf(ss * (1.0f / 256.0f) + 1e-6f);
        u32x2 w; w.x = pg8::cvt_pk_bf16(h0 * rs * g[0] * bflo(wz.x), h1 * rs * g[1] * bfhi(wz.x)); w.y = pg8::cvt_pk_bf16(h2 * rs * g[2] * bflo(wz.y), h3 * rs * g[3] * bfhi(wz.y));
        *(u32x2*)(HF + off) = w;
    }
}

DI void ph_s5_scan(const Args& a, int l, const bf16_t* U, bf16_t* YF, bf16_t* YB, LAS unsigned char* lds) {
    const int tid = ltid(a), w = tid >> 6, p = tid & 63;
    LAS float* ub = (LAS float*)lds + w * 2304;
    LAS float* yb = ub + 1024;
    LAS float* xb = yb + 1024;
    for (int unit = blockIdx.x; unit < 128; unit += gridDim.x) {
        const int gb = unit & 7, d = (unit >> 3) & 1, b = unit >> 4, g = gb * 8 + w;
        const float stp = expf(a.in[I_SLOG][(l * 2 + d) * 64 + g]);
        const float lre = a.in[I_SLRE][((size_t)(l * 2 + d) * 64 + g) * 64 + p], lim = a.in[I_SLIM][((size_t)(l * 2 + d) * 64 + g) * 64 + p];
        const float mag = expf(lre * stp), lbr = mag * cosf(lim * stp), lbi = mag * sinf(lim * stp);
        const float dnm = lre * lre + lim * lim;
        const float fre = ((lbr - 1.0f) * lre + lbi * lim) / dnm, fim = (lbi * lre - (lbr - 1.0f) * lim) / dnm;
        float bbr[16], bbi[16];
        { const float* br = a.in[I_SBRE] + (((size_t)l * 64 + g) * 64 + p) * 16; const float* bi = a.in[I_SBIM] + (((size_t)l * 64 + g) * 64 + p) * 16;
#pragma unroll
          for (int h = 0; h < 16; ++h) { bbr[h] = fre * br[h] - fim * bi[h]; bbi[h] = fre * bi[h] + fim * br[h]; } }
        const int hh = p & 15, pt = p >> 4;
        float cr[16], ci[16];
        { const float* c0 = a.in[I_SCRE] + (((size_t)l * 64 + g) * 16 + hh) * 64 + pt * 16; const float* c1 = a.in[I_SCIM] + (((size_t)l * 64 + g) * 16 + hh) * 64 + pt * 16;
#pragma unroll
          for (int j = 0; j < 16; ++j) { cr[j] = c0[j]; ci[j] = c1[j]; } }
        bf16_t* Y = d ? YB : YF;
        float xr = 0.f, xi = 0.f; int par = 0;
        for (int step = 0; step < 68; ++step) {
            const int cc = (step < 4) ? (d ? 3 - step : step) : (d ? 67 - step : step - 4);
            const int row0 = (step < 4) ? b * 256 + cc * 64 : CTXROWS + b * 4096 + cc * 64;
            __syncthreads();
            { const bf16_t* up = U + (size_t)(row0 + p) * 1024 + g * 16; float f[8];
              unpack8(*(const u32x4*)up, f);
#pragma unroll
              for (int j = 0; j < 8; ++j) ub[p * 16 + j] = f[j];
              unpack8(*(const u32x4*)(up + 8), f);
#pragma unroll
              for (int j = 0; j < 8; ++j) ub[p * 16 + 8 + j] = f[j]; }
            __syncthreads();
            for (int tt = 0; tt < 64; ++tt) {
                const int t = d ? 63 - tt : tt;
                float bur = 0.f, bui = 0.f;
#pragma unroll
                for (int h4 = 0; h4 < 4; ++h4) { const f32x4 u = *(const LAS f32x4*)(ub + t * 16 + h4 * 4);
#pragma unroll
                    for (int j = 0; j < 4; ++j) { bur += bbr[h4 * 4 + j] * u[j]; bui += bbi[h4 * 4 + j] * u[j]; } }
                const float nxr = lbr * xr - lbi * xi + bur, nxi = lbr * xi + lbi * xr + bui;
                xr = nxr; xi = nxi;
                xb[par * 128 + p] = xr; xb[par * 128 + 64 + p] = xi;
                __syncthreads();
                float y = 0.f;
#pragma unroll
                for (int j4 = 0; j4 < 4; ++j4) { const f32x4 vr = *(const LAS f32x4*)(xb + par * 128 + pt * 16 + j4 * 4), vi = *(const LAS f32x4*)(xb + par * 128 + 64 + pt * 16 + j4 * 4);
#pragma unroll
                    for (int j = 0; j < 4; ++j) y += cr[j4 * 4 + j] * vr[j] - ci[j4 * 4 + j] * vi[j]; }
                y += shx(y, 16, p); y += shx(y, 32, p);
                if (p < 16) yb[t * 16 + p] = y;
                par ^= 1;
            }
            __syncthreads();
            { u32x4 w0, w1; const LAS float* ys = yb + p * 16;
              w0.x = pg8::cvt_pk_bf16(ys[0], ys[1]); w0.y = pg8::cvt_pk_bf16(ys[2], ys[3]); w0.z = pg8::cvt_pk_bf16(ys[4], ys[5]); w0.w = pg8::cvt_pk_bf16(ys[6], ys[7]);
              w1.x = pg8::cvt_pk_bf16(ys[8], ys[9]); w1.y = pg8::cvt_pk_bf16(ys[10], ys[11]); w1.z = pg8::cvt_pk_bf16(ys[12], ys[13]); w1.w = pg8::cvt_pk_bf16(ys[14], ys[15]);
              bf16_t* yp = Y + (size_t)(row0 + p) * 1024 + g * 16; *(u32x4*)yp = w0; *(u32x4*)(yp + 8) = w1; }
        }
        __syncthreads();
    }
}
DI void ph_s5_post(const Args& a, int l, bf16_t* YF, const bf16_t* YB, const bf16_t* U) {
    const float* dsk = a.in[I_SD] + l * 1024;
    for (size_t i = (size_t)blockIdx.x * NT + ltid(a); i < (size_t)MROWS * 128; i += (size_t)gridDim.x * NT) {
        const size_t off = i * 8; const int c = (int)(off & 1023);
        float f[8], bq[8], u[8]; unpack8(*(const u32x4*)(YF + off), f); unpack8(*(const u32x4*)(YB + off), bq); unpack8(*(const u32x4*)(U + off), u);
        const f32x4 d0 = *(const f32x4*)(dsk + c), d1 = *(const f32x4*)(dsk + c + 4);
        float o[8];
#pragma unroll
        for (int j = 0; j < 4; ++j) { o[j] = gelu_tanh_(f[j] + bq[j] + d0[j] * u[j]); o[4 + j] = gelu_tanh_(f[4 + j] + bq[4 + j] + d1[j] * u[4 + j]); }
        u32x4 w; w.x = pg8::cvt_pk_bf16(o[0], o[1]); w.y = pg8::cvt_pk_bf16(o[2], o[3]); w.z = pg8::cvt_pk_bf16(o[4], o[5]); w.w = pg8::cvt_pk_bf16(o[6], o[7]);
        *(u32x4*)(YF + off) = w;
    }
}

constexpr int S5_T = 16, S5_NCH = MROWS / S5_T  , S5_RG = 2304, S5_PMG = S5_RG / 256;
constexpr size_t SZ_AX = (size_t)64 * S5_RG * 512 * 2, SZ_CW1 = (size_t)64 * 256 * 256 * 2, SZ_CW2 = (size_t)64 * 256 * 512 * 2;
constexpr size_t R5_AX = 0, R5_SZ = SZ_AX, R5_G1 = R5_SZ + SZ_ACT, R5_GLUA = R5_G1 + SZ_ACT, R5_END = R5_GLUA + SZ_ACT;
static_assert(WS_R + R5_END <= WS_END, "S5 stage layout fits the workspace"); static_assert(WS_END <= (size_t)512 * 1024 * 1024, "workspace budget");
static_assert(SZ_CW1 + SZ_CW2 <= SZ_ACT, "S5 constants live in the H region once the last projection from H is done");

struct EpiS1 {
    static constexpr bool PERM = true, AFTER_DRAIN = false;
    bf16_t* AX; bf16_t* SZ; bf16_t* G1;
    __device__ __forceinline__ void operator()(const f32x4 (&acc)[2][2][4][2], const Unit& u, int wr, int wc, int fr, int fq) const {
        const int row0 = u.pm * 256 + wr * 64 + fr, seg = u.pn >> 2;
        const int col0 = (u.pn & 3) * 256 + wc * 32 + 8 * fq;
#pragma unroll
        for (int ai = 0; ai < 2; ++ai)
#pragma unroll
            for (int m = 0; m < 4; ++m) {
                const int r = row0 + ai * 128 + m * 16;
#pragma unroll
                for (int bj = 0; bj < 2; ++bj) {
                    f32x4 v0 = acc[ai][bj][m][0], v1 = acc[ai][bj][m][1];
                    const int c = col0 + bj * 128;
                    bf16_t* dp;
                    if (seg == 0) dp = AX + ((size_t)(c >> 4) * S5_RG + (r >> 4)) * 512 + (r & 15) * 16 + (c & 15);
                    else if (seg == 1) { dp = SZ + (size_t)r * 1024 + c;
#pragma unroll
                        for (int j = 0; j < 4; ++j) { v0[j] = siluf_(v0[j]); v1[j] = siluf_(v1[j]); } }
                    else { dp = G1 + (size_t)r * 1024 + c;
#pragma unroll
                        for (int j = 0; j < 4; ++j) { v0[j] = sigmoidf_(v0[j]); v1[j] = sigmoidf_(v1[j]); } }
                    u32x4 w; w.x = pg8::cvt_pk_bf16(v0[0], v0[1]); w.y = pg8::cvt_pk_bf16(v0[2], v0[3]); w.z = pg8::cvt_pk_bf16(v1[0], v1[1]); w.w = pg8::cvt_pk_bf16(v1[2], v1[3]);
                    *(u32x4*)dp = w;
                }
            }
    }
};
struct EpiS5L {
    static constexpr bool PERM = true, AFTER_DRAIN = false;
    bf16_t* AX;
    __device__ __forceinline__ void operator()(const f32x4 (&acc)[2][2][4][2], const Unit& u, int wr, int wc, int fr, int fq) const {
        const int g = u.pm / S5_PMG, rg0 = (u.pm % S5_PMG) * 256 + wr * 64 + fr, col0 = wc * 32 + 8 * fq;
#pragma unroll
        for (int ai = 0; ai < 2; ++ai)
#pragma unroll
            for (int m = 0; m < 4; ++m) {
                const int rg = rg0 + ai * 128 + m * 16;
                if (rg < S5_NCH) {
                    bf16_t* rp = AX + ((size_t)g * S5_RG + rg) * 512 + 256 + col0;
#pragma unroll
                    for (int bj = 0; bj < 2; ++bj) { const f32x4 v0 = acc[ai][bj][m][0], v1 = acc[ai][bj][m][1];
                        u32x4 w; w.x = pg8::cvt_pk_bf16(v0[0], v0[1]); w.y = pg8::cvt_pk_bf16(v0[2], v0[3]); w.z = pg8::cvt_pk_bf16(v1[0], v1[1]); w.w = pg8::cvt_pk_bf16(v1[2], v1[3]);
                        *(u32x4*)(rp + bj * 128) = w; }
                }
            }
    }
};
struct EpiS5Y {
    static constexpr bool PERM = true, AFTER_DRAIN = false;
    const bf16_t* AX; bf16_t* GLUA; const float* dsk;
    __device__ __forceinline__ void operator()(const f32x4 (&acc)[2][2][4][2], const Unit& u, int wr, int wc, int fr, int fq) const {
        const int g = u.pm / S5_PMG, rg0 = (u.pm % S5_PMG) * 256 + wr * 64 + fr, col0 = wc * 32 + 8 * fq;
        const int h0 = col0 & 15;
        const f32x4 d0 = *(const f32x4*)(dsk + g * 16 + h0), d1 = *(const f32x4*)(dsk + g * 16 + h0 + 4);
#pragma unroll
        for (int ai = 0; ai < 2; ++ai)
#pragma unroll
            for (int m = 0; m < 4; ++m) {
                const int rg = rg0 + ai * 128 + m * 16;
                if (rg < S5_NCH) {
#pragma unroll
                    for (int bj = 0; bj < 2; ++bj) {
                        const int c = col0 + bj * 128, t = c >> 4;
                        float uu[8]; unpack8(*(const u32x4*)(AX + ((size_t)g * S5_RG + rg) * 512 + c), uu);
                        const f32x4 v0 = acc[ai][bj][m][0], v1 = acc[ai][bj][m][1];
                        float o[8];
#pragma unroll
                        for (int j = 0; j < 4; ++j) { o[j] = gelu_tanh_(v0[j] + d0[j] * uu[j]); o[4 + j] = gelu_tanh_(v1[j] + d1[j] * uu[4 + j]); }
                        u32x4 w; w.x = pg8::cvt_pk_bf16(o[0], o[1]); w.y = pg8::cvt_pk_bf16(o[2], o[3]); w.z = pg8::cvt_pk_bf16(o[4], o[5]); w.w = pg8::cvt_pk_bf16(o[6], o[7]);
                        *(u32x4*)(GLUA + (size_t)(rg * 16 + t) * 1024 + g * 16 + h0) = w;
                    }
                }
            }
    }
};
DI void ph_s5_consts(const Args& a, int l, bf16_t* CW1, bf16_t* CW2, LAS unsigned char* lds) {
    LAS float* POW = (LAS float*)lds;
    LAS float* BB = POW + 2 * 17 * 64 * 2;
    LAS float* CC = BB + 2 * 64 * 16 * 2;
    LAS float* KT = CC + 16 * 64 * 2;
    const int tid = ltid(a);
    for (int g = blockIdx.x; g < 64; g += gridDim.x) {
        __syncthreads();
        for (int i = tid; i < 2 * 17 * 64; i += NT) {
            const int p = i & 63, j = (i >> 6) % 17, d = i / (17 * 64);
            const float stp = expf(a.in[I_SLOG][(l * 2 + d) * 64 + g]);
            const float lre = a.in[I_SLRE][((size_t)(l * 2 + d) * 64 + g) * 64 + p], lim = a.in[I_SLIM][((size_t)(l * 2 + d) * 64 + g) * 64 + p];
            const float mag = expf((float)j * lre * stp), ang = (float)j * (lim * stp);
            POW[i * 2] = mag * cosf(ang); POW[i * 2 + 1] = mag * sinf(ang);
        }
        for (int i = tid; i < 16 * 64; i += NT) { const int p = i & 63, h = i >> 6;
            CC[i * 2] = a.in[I_SCRE][(((size_t)l * 64 + g) * 16 + h) * 64 + p]; CC[i * 2 + 1] = a.in[I_SCIM][(((size_t)l * 64 + g) * 16 + h) * 64 + p]; }
        __syncthreads();
        for (int i = tid; i < 2 * 64 * 16; i += NT) {
            const int h = i & 15, p = (i >> 4) & 63, d = i >> 10;
            const float stp = expf(a.in[I_SLOG][(l * 2 + d) * 64 + g]);
            const float lre = a.in[I_SLRE][((size_t)(l * 2 + d) * 64 + g) * 64 + p], lim = a.in[I_SLIM][((size_t)(l * 2 + d) * 64 + g) * 64 + p];
            const float lbr = POW[((d * 17 + 1) * 64 + p) * 2], lbi = POW[((d * 17 + 1) * 64 + p) * 2 + 1];
            const float dnm = lre * lre + lim * lim;
            const float fre = ((lbr - 1.0f) * lre + lbi * lim) / dnm, fim = (lbi * lre - (lbr - 1.0f) * lim) / dnm;
            const float br = a.in[I_SBRE][(((size_t)l * 64 + g) * 64 + p) * 16 + h], bi = a.in[I_SBIM][(((size_t)l * 64 + g) * 64 + p) * 16 + h];
            BB[i * 2] = fre * br - fim * bi; BB[i * 2 + 1] = fre * bi + fim * br;
        }
        __syncthreads();
        for (int i = tid; i < 2 * 16 * 256; i += NT) {
            const int hp = i & 15, h = (i >> 4) & 15, tau = (i >> 8) & 15, d = i >> 12;
            float s = 0.f;
            for (int p = 0; p < 64; ++p) {
                const float cr = CC[(h * 64 + p) * 2], ci = CC[(h * 64 + p) * 2 + 1];
                const float pr = POW[((d * 17 + tau) * 64 + p) * 2], pi = POW[((d * 17 + tau) * 64 + p) * 2 + 1];
                const float br = BB[((d * 64 + p) * 16 + hp) * 2], bi = BB[((d * 64 + p) * 16 + hp) * 2 + 1];
                const float gr = cr * pr - ci * pi, gi = cr * pi + ci * pr;
                s += gr * br - gi * bi;
            }
            KT[i] = s;
        }
        __syncthreads();
        bf16_t* c1 = CW1 + (size_t)g * 65536;
        for (int i = tid; i < 65536 / 2; i += NT) {
            const int k = (i * 2) & 255, n = (i * 2) >> 8; const int p = n & 63, ri = (n >> 6) & 1, d = n >> 7, s = k >> 4, hp = k & 15;
            const int j = d ? s : 15 - s;
            const float pr = POW[((d * 17 + j) * 64 + p) * 2], pi = POW[((d * 17 + j) * 64 + p) * 2 + 1];
            float o[2];
#pragma unroll
            for (int q = 0; q < 2; ++q) { const float br = BB[((d * 64 + p) * 16 + hp + q) * 2], bi = BB[((d * 64 + p) * 16 + hp + q) * 2 + 1]; o[q] = ri ? (pr * bi + pi * br) : (pr * br - pi * bi); }
            *(unsigned*)(c1 + (size_t)n * 256 + k) = pg8::cvt_pk_bf16(o[0], o[1]);
        }
        bf16_t* c2 = CW2 + (size_t)g * 131072;
        for (int i = tid; i < 131072 / 2; i += NT) {
            const int k = (i * 2) & 511, n = (i * 2) >> 9; const int t = n >> 4, h = n & 15;
            float o[2];
            if (k < 256) { const int s = k >> 4, hp = k & 15;
#pragma unroll
                for (int q = 0; q < 2; ++q) { float v = 0.f; if (s <= t) v += KT[((0 * 16 + (t - s)) * 16 + h) * 16 + hp + q]; if (s >= t) v += KT[((1 * 16 + (s - t)) * 16 + h) * 16 + hp + q]; o[q] = v; } }
            else { const int kk = k - 256, d = kk >> 7, ri = (kk >> 6) & 1; const int j = d ? 16 - t : t + 1;
#pragma unroll
                for (int q = 0; q < 2; ++q) { const int p = (kk & 63) + q; const float cr = CC[(h * 64 + p) * 2], ci = CC[(h * 64 + p) * 2 + 1];
                    const float pr = POW[((d * 17 + j) * 64 + p) * 2], pi = POW[((d * 17 + j) * 64 + p) * 2 + 1];
                    o[q] = ri ? -(cr * pi + ci * pr) : (cr * pr - ci * pi); } }
            *(unsigned*)(c2 + (size_t)n * 512 + k) = pg8::cvt_pk_bf16(o[0], o[1]);
        }
    }
    __syncthreads();
}
DI void ph_s5_carry(const Args& a, int l, bf16_t* AX) {
    const int tid = ltid(a), w = tid >> 6, p = tid & 63;
    for (int unit = blockIdx.x * 8 + w; unit < 1024; unit += gridDim.x * 8) {
        const int d = unit & 1, g = (unit >> 1) & 63, b = unit >> 7;
        const float stp = expf(a.in[I_SLOG][(l * 2 + d) * 64 + g]);
        const float lre = a.in[I_SLRE][((size_t)(l * 2 + d) * 64 + g) * 64 + p], lim = a.in[I_SLIM][((size_t)(l * 2 + d) * 64 + g) * 64 + p];
        const float mag = expf(16.0f * lre * stp), ang = 16.0f * (lim * stp);
        const float ar = mag * cosf(ang), ai = mag * sinf(ang);
        bf16_t* base = AX + (size_t)g * S5_RG * 512 + 256 + d * 128 + p;
        float xr = 0.f, xi = 0.f;
        for (int c0 = 0; c0 < 272; c0 += 16) {
            float lr[16], li[16];
#pragma unroll
            for (int q = 0; q < 16; ++q) { const int st = c0 + q; const int cc = (st < 16) ? (d ? 15 - st : st) : (d ? 271 - st : st - 16);
                const int row = (st < 16) ? b * 16 + cc : 128 + b * 256 + cc;
                lr[q] = bf2f(base[(size_t)row * 512]); li[q] = bf2f(base[(size_t)row * 512 + 64]); }
#pragma unroll
            for (int q = 0; q < 16; ++q) { const int st = c0 + q; const int cc = (st < 16) ? (d ? 15 - st : st) : (d ? 271 - st : st - 16);
                const int row = (st < 16) ? b * 16 + cc : 128 + b * 256 + cc;
                base[(size_t)row * 512] = f2bf(xr); base[(size_t)row * 512 + 64] = f2bf(xi);
                const float nr = ar * xr - ai * xi + lr[q], ni = ar * xi + ai * xr + li[q]; xr = nr; xi = ni; }
        }
    }
}

typedef short bf16x8v __attribute__((ext_vector_type(8)));
typedef short s16x4v __attribute__((ext_vector_type(4)));
typedef __bf16 bfx2_t __attribute__((ext_vector_type(2)));
typedef float f32x2_t __attribute__((ext_vector_type(2)));
#define MFMA16(a_, b_, c_) __builtin_amdgcn_mfma_f32_16x16x32_bf16((a_), (b_), (c_), 0, 0, 0)
DI unsigned pk2(float lo, float hi) { const bfx2_t v = __builtin_convertvector((f32x2_t){lo, hi}, bfx2_t); return __builtin_bit_cast(unsigned, v); }
DI int sw512(int r, int cb) { return r * 512 + (cb ^ ((r & 15) << 4)); }
DI int sw128(int r, int cb) { return r * 128 + (cb ^ ((r & 7) << 4)); }
DI bf16x8v ldsfrag(LAS unsigned char* base, int off) { return *(const LAS bf16x8v*)(base + off); }
DI bf16x8v ldsfrag2(LAS unsigned char* base, int off0, int off1) { const s16x4v lo = *(const LAS s16x4v*)(base + off0), hi = *(const LAS s16x4v*)(base + off1); return __builtin_shufflevector(lo, hi, 0, 1, 2, 3, 4, 5, 6, 7); }
constexpr int ML_GSET = 448;
DI void ml_gates(float igr, float fgr, float ibias, float fbias, int d, float& ms, LAS float* gs, int L) {
    const int t = d ? 63 - L : L;
    const float ipv = igr + ibias, lfv = -softplusf_(-(fgr + fbias));
    float bc = lfv;
#pragma unroll
    for (int o = 1; o < 64; o <<= 1) { const float x = shup(bc, o, L); if (L >= o) bc += x; }
    const float aj = ipv - bc;
    float cm = aj;
#pragma unroll
    for (int o = 1; o < 64; o <<= 1) { const float x = shup(cm, o, L); if (L >= o) cm = fmaxf(cm, x); }
    const float mt = fmaxf(bc + ms, bc + cm);
    const float bend = shidx(bc, 63);
    const float le = bend - bc + ipv;
    float mle = le;
#pragma unroll
    for (int o = 32; o >= 1; o >>= 1) mle = fmaxf(mle, shx(mle, o, L));
    const float mnew = fmaxf(bend + ms, mle);
    gs[t] = bc; gs[64 + t] = aj; gs[128 + t] = mt; gs[192 + t] = __expf(bc + ms - mt); gs[256 + t] = __expf(-mt); gs[320 + t] = __expf(le - mnew) * 0.0625f;
    if (L == 0) gs[384] = __expf(bend + ms - mnew);
    ms = mnew;
}
DI bf16x8v ldstr2(LAS unsigned char* p0, LAS unsigned char* p1) {
    const s16x4v lo = __builtin_amdgcn_ds_read_tr16_b64_v4i16((LAS s16x4v*)p0), hi = __builtin_amdgcn_ds_read_tr16_b64_v4i16((LAS s16x4v*)p1);
    return __builtin_shufflevector(lo, hi, 0, 1, 2, 3, 4, 5, 6, 7); }
DI void ph_ml_scan_mfma(const Args& a, int l, const bf16_t* Q, const bf16_t* K, const bf16_t* V, const float* GATE, bf16_t* HF, bf16_t* HB, LAS unsigned char* lds) {
    constexpr int PQ = 528, PK = 544, PV = 288, PW = 144;
    LAS unsigned char* qs = lds;
    LAS unsigned char* kn = lds + 33792;
    LAS unsigned char* vn = lds + 68608;
    LAS unsigned char* vs = lds + 87040;
    LAS unsigned char* Wm = lds + 105472;
    LAS float* sm = (LAS float*)(lds + 114688);
    LAS float* rsW = sm + 2 * ML_GSET; LAS float* qn = rsW + 128; LAS float* nvec = qn + 64;
    const int tid = ltid(a), w = tid >> 6, ln = tid & 63, l16 = ln & 15, h4 = ln >> 4, tq = (ln & 15) >> 2, tp = ln & 3;
    for (int unit = blockIdx.x; unit < 128; unit += gridDim.x) {
        const int eh = unit & 1, d = (unit >> 1) & 1, hd = (unit >> 2) & 3, b = unit >> 4;
        const float ibias = a.in[I_MIB][(l * 2 + d) * 4 + hd], fbias = a.in[I_MFB][(l * 2 + d) * 4 + hd];
        bf16_t* HO = d ? HB : HF;
        f32x4 Cacc[16];
#pragma unroll
        for (int i = 0; i < 16; ++i) Cacc[i] = (f32x4){0.f, 0.f, 0.f, 0.f};
        float ms = 0.f;
        __syncthreads();
        if (tid < 256) nvec[tid] = 0.f;
#define ML_ROW0(step) (((step) < 4) ? b * 256 + (d ? 3 - (step) : (step)) * 64 : CTXROWS + b * 4096 + (d ? 67 - (step) : (step) - 4) * 64)
        u32x4 pq[4], pk[4], pv[2]; float gi = 0.f, gf = 0.f;
        { const int row0 = ML_ROW0(0);
#pragma unroll
          for (int q = 0; q < 4; ++q) { const int p = tid + 512 * q, r = p >> 5, c8 = p & 31; pq[q] = *(const u32x4*)(Q + (size_t)(row0 + r) * 1024 + hd * 256 + c8 * 8); pk[q] = *(const u32x4*)(K + (size_t)(row0 + r) * 1024 + hd * 256 + c8 * 8); }
#pragma unroll
          for (int q = 0; q < 2; ++q) { const int p = tid + 512 * q, r = p >> 4, c8 = p & 15; pv[q] = *(const u32x4*)(V + (size_t)(row0 + r) * 1024 + hd * 256 + eh * 128 + c8 * 8); }
          if (w == 0) { const int t = d ? 63 - ln : ln; const float* gp = GATE + (size_t)(row0 + t) * 32; gi = gp[d * 4 + hd]; gf = gp[8 + d * 4 + hd]; ml_gates(gi, gf, ibias, fbias, d, ms, sm, ln); } }
        __syncthreads();
        for (int step = 0; step < 68; ++step) {
            const int par = step & 1; LAS float* gs = sm + par * ML_GSET;
            const int row0 = ML_ROW0(step);
#pragma unroll
            for (int q = 0; q < 4; ++q) { const int p = tid + 512 * q, r = p >> 5, c8 = p & 31;
                *(LAS u32x4*)(qs + r * PQ + c8 * 16) = pq[q]; *(LAS u32x4*)(kn + r * PK + c8 * 16) = pk[q]; }
#pragma unroll
            for (int q = 0; q < 2; ++q) { const int p = tid + 512 * q, r = p >> 4, c8 = p & 15;
                *(LAS u32x4*)(vn + r * PV + c8 * 16) = pv[q];
                float f[8]; unpack8(pv[q], f); const float ws = gs[320 + r];
                u32x4 o; o.x = pk2(f[0] * ws, f[1] * ws); o.y = pk2(f[2] * ws, f[3] * ws); o.z = pk2(f[4] * ws, f[5] * ws); o.w = pk2(f[6] * ws, f[7] * ws);
                *(LAS u32x4*)(vs + r * PV + c8 * 16) = o; }
            if (step + 1 < 68) { const int rown = ML_ROW0(step + 1);
#pragma unroll
                for (int q = 0; q < 4; ++q) { const int p = tid + 512 * q, r = p >> 5, c8 = p & 31; pq[q] = *(const u32x4*)(Q + (size_t)(rown + r) * 1024 + hd * 256 + c8 * 8); pk[q] = *(const u32x4*)(K + (size_t)(rown + r) * 1024 + hd * 256 + c8 * 8); }
#pragma unroll
                for (int q = 0; q < 2; ++q) { const int p = tid + 512 * q, r = p >> 4, c8 = p & 15; pv[q] = *(const u32x4*)(V + (size_t)(rown + r) * 1024 + hd * 256 + eh * 128 + c8 * 8); }
                if (w == 0) { const int t = d ? 63 - ln : ln; const float* gp = GATE + (size_t)(rown + t) * 32; gi = gp[d * 4 + hd]; gf = gp[8 + d * 4 + hd]; } }
            __syncthreads();
            { const int it = w >> 1, jp = w & 1, i = it * 16 + l16;
              f32x4 a0 = (f32x4){0.f, 0.f, 0.f, 0.f}, a1 = a0;
              LAS unsigned char* qb = qs + (it * 16 + l16) * PQ + h4 * 16; LAS unsigned char* kb = kn + ((2 * jp) * 16 + l16) * PK + h4 * 16;
#pragma unroll
              for (int ks = 0; ks < 8; ++ks) {
                  const bf16x8v bq = ldsfrag(qb, ks * 64);
                  const bf16x8v k0 = ldsfrag(kb, ks * 64), k1 = ldsfrag(kb, 16 * PK + ks * 64);
                  a0 = MFMA16(k0, bq, a0); a1 = MFMA16(k1, bq, a1); }
              const float bci = gs[i], mti = gs[128 + i];
              float rs = 0.f;
#pragma unroll
              for (int t2 = 0; t2 < 2; ++t2) { const int j0 = (2 * jp + t2) * 16 + 4 * h4; const f32x4 ajv = *(const LAS f32x4*)(gs + 64 + j0); const f32x4 av = t2 ? a1 : a0;
                  float wv[4];
#pragma unroll
                  for (int r = 0; r < 4; ++r) { const int j = j0 + r; const bool valid = d ? (j >= i) : (j <= i); const float e = __expf(bci + ajv[r] - mti) * av[r] * 0.0625f; wv[r] = valid ? e : 0.f; rs += wv[r]; }
                  u32x2 pw; pw.x = pk2(wv[0], wv[1]); pw.y = pk2(wv[2], wv[3]);
                  *(LAS u32x2*)(Wm + i * PW + j0 * 2) = pw; }
              rs += shx(rs, 16, ln); rs += shx(rs, 32, ln);
              if (h4 == 0) rsW[jp * 64 + i] = rs;
              const f32x4 nv = *(const LAS f32x4*)(nvec + 4 * ln);
#pragma unroll
              for (int rr = 0; rr < 8; ++rr) { const int ir = 8 * w + rr; const u32x2 qw = *(const LAS u32x2*)(qs + ir * PQ + 8 * ln);
                  float s = bflo(qw.x) * nv[0] + bfhi(qw.x) * nv[1] + bflo(qw.y) * nv[2] + bfhi(qw.y) * nv[3];
                  s = wave_sum(s, ln); if (ln == 0) qn[ir] = s; } }
            __syncthreads();
            { f32x4 num[4];
#pragma unroll
              for (int it = 0; it < 4; ++it) num[it] = (f32x4){0.f, 0.f, 0.f, 0.f};
              LAS unsigned char* qb2 = qs + l16 * PQ + 8 * h4;
#pragma unroll
              for (int ks = 0; ks < 8; ++ks) {
                  u32x4 bw; bw.x = pk2(Cacc[2 * ks][0], Cacc[2 * ks][1]); bw.y = pk2(Cacc[2 * ks][2], Cacc[2 * ks][3]); bw.z = pk2(Cacc[2 * ks + 1][0], Cacc[2 * ks + 1][1]); bw.w = pk2(Cacc[2 * ks + 1][2], Cacc[2 * ks + 1][3]);
                  const bf16x8v bfr = __builtin_bit_cast(bf16x8v, bw);
#pragma unroll
                  for (int it = 0; it < 4; ++it) { const bf16x8v af = ldsfrag2(qb2, it * 16 * PQ + 64 * ks, it * 16 * PQ + 64 * ks + 32); num[it] = MFMA16(af, bfr, num[it]); } asm volatile("" ::: "memory"); }
#pragma unroll
              for (int it = 0; it < 4; ++it) { const f32x4 wi = *(const LAS f32x4*)(gs + 192 + it * 16 + 4 * h4); num[it] = num[it] * wi; }
              LAS unsigned char* trb = (LAS unsigned char*)0 + (8 * h4 + tq) * PV + 8 * tp + 32 * w;
              bf16x8v bv[2];
#pragma unroll
              for (int kk = 0; kk < 2; ++kk) bv[kk] = ldstr2(vn + (size_t)trb + (32 * kk) * PV, vn + (size_t)trb + (32 * kk + 4) * PV);
              LAS unsigned char* wb = Wm + l16 * PW + 16 * h4;
#pragma unroll
              for (int kk = 0; kk < 2; ++kk)
#pragma unroll
                  for (int it = 0; it < 4; ++it) { const bf16x8v aw = ldsfrag(wb, it * 16 * PW + 64 * kk); num[it] = MFMA16(aw, bv[kk], num[it]); }
              asm volatile("" ::: "memory");
#pragma unroll
              for (int it = 0; it < 4; ++it) { const int i0 = it * 16 + 4 * h4;
                  const f32x4 r0 = *(const LAS f32x4*)(rsW + i0), r1 = *(const LAS f32x4*)(rsW + 64 + i0), wi = *(const LAS f32x4*)(gs + 192 + i0), qv = *(const LAS f32x4*)(qn + i0), nr = *(const LAS f32x4*)(gs + 256 + i0);
#pragma unroll
                  for (int r = 0; r < 4; ++r) { const float den = r0[r] + r1[r] + wi[r] * qv[r]; const float hv = num[it][r] / fmaxf(fabsf(den), nr[r]);
                      HO[(size_t)(row0 + i0 + r) * 1024 + hd * 256 + eh * 128 + 16 * w + l16] = (bf16_t)(pk2(hv, 0.f) & 0xffffu); } asm volatile("" ::: "memory"); }
              const float decay = gs[384];
              bf16x8v bs[2];
#pragma unroll
              for (int kk = 0; kk < 2; ++kk) bs[kk] = ldstr2(vs + (size_t)trb + (32 * kk) * PV, vs + (size_t)trb + (32 * kk + 4) * PV);
#pragma unroll
              for (int dt = 0; dt < 16; ++dt) Cacc[dt] = Cacc[dt] * decay;
              LAS unsigned char* ktb = kn + (8 * h4 + tq) * PK + 8 * tp;
#pragma unroll
              for (int kk = 0; kk < 2; ++kk)
#pragma unroll
                  for (int dt = 0; dt < 16; ++dt) { const bf16x8v ak = ldstr2(ktb + (32 * kk) * PK + 32 * dt, ktb + (32 * kk + 4) * PK + 32 * dt); Cacc[dt] = MFMA16(ak, bs[kk], Cacc[dt]); if ((dt & 1) == 1) asm volatile("" ::: "memory"); }
              if (tid < 256) { float s = 0.f;
#pragma unroll 8
                  for (int j = 0; j < 64; ++j) s += gs[320 + j] * bf2f(*(const LAS bf16_t*)(kn + j * PK + 2 * tid));
                  nvec[tid] = decay * nvec[tid] + s; }
              if (w == 0 && step + 1 < 68) ml_gates(gi, gf, ibias, fbias, d, ms, sm + (par ^ 1) * ML_GSET, ln); }
            __syncthreads();
        }
#undef ML_ROW0
    }
}

#ifndef DUP_PHASE
#define DUP_PHASE -1
#endif
constexpr int NPH_LAYER = 20, PH_FINAL = 2 + DEPTH * NPH_LAYER, NPHASE = PH_FINAL + 1;
template <class Epi>
DI void run_gemm(int tid, LAS unsigned char* lds, const bf16_t* A, const bf16_t* Bt, int M, int N, const Epi& E) {
    pg8::Gemm g{A, Bt, M, N, 1024, 1024, 1 << 20, 0, tid}; pg8::StaticOrder S; S.init(M, N, (int)gridDim.x, (int)blockIdx.x);
    pg8::gemm_phase<Epi, pg8::StaticOrder, false>(lds, g, S, E, nullptr);
}
template <class Epi>
DI void run_gemm_g(int tid, LAS unsigned char* lds, const bf16_t* A, int lda, int K, const bf16_t* Bt, int M, int N, int pmg, size_t gstride, const Epi& E) {
    pg8::Gemm g{A, Bt, M, N, K, lda, pmg, gstride, tid}; pg8::StaticOrder S; S.init(M, N, (int)gridDim.x, (int)blockIdx.x);
    pg8::gemm_phase<Epi, pg8::StaticOrder, false>(lds, g, S, E, nullptr);
}
__global__ void __launch_bounds__(NT, 2) hy_fwd(Args ka) {
    extern __shared__ __attribute__((aligned(16))) unsigned char lds_raw[];
    LAS unsigned char* lds = (LAS unsigned char*)lds_raw;
    volatile LAS unsigned* xbw = (volatile LAS unsigned*)(lds + 131072);
    if (threadIdx.x < 4) xbw[threadIdx.x] = 0u;
    __syncthreads();
    const int lo = ka.ph_lo, hi = ka.ph_hi;
    const int s_wid = __builtin_amdgcn_readfirstlane((int)(threadIdx.x >> 6));
    XcdBarrier bar; bar.bar = (unsigned*)(ka.ws + WS_CTL); bar.x = 0u; bar.st = xbw; bar.wid = s_wid;
    if (hi - lo > 1) bar = xcd_barrier_post((unsigned*)(ka.ws + WS_CTL), xbw, s_wid);
#ifdef PH_ONLY
#define PHEN(p) ((p) == PH_ONLY)
#else
#define PHEN(p) 1
#endif
#define IN(k) (lo <= (k) && (k) < hi)
#define INL(p) (PHEN(p) && IN(pb + (p)))
#define SEAM(k) do { if (IN((k) + 1)) xcd_barrier(bar); } while (0)
#define PH_LOAD \
    Args a; __builtin_memcpy(&a, args_ptr(), sizeof(Args)); a.wid = s_wid; \
    unsigned char* ws = a.ws; \
    float* MOD = (float*)(ws + WS_MOD); float* XCTX = (float*)(ws + WS_XCTX); \
    bf16_t* H = (bf16_t*)(ws + WS_H); bf16_t* MERGED = (bf16_t*)(ws + WS_MERGED); \
    bf16_t* WB0 = (bf16_t*)(ws + WS_WB0); bf16_t* WB1 = (bf16_t*)(ws + WS_WB1); \
    unsigned char* R = ws + WS_R; \
    bf16_t* P0 = (bf16_t*)(R + R_P0); bf16_t* P1 = (bf16_t*)(R + R_P1); bf16_t* P2 = (bf16_t*)(R + R_P2); bf16_t* OF = (bf16_t*)(R + R_OF); bf16_t* OB = (bf16_t*)(R + R_OB); \
    float* GATE2 = (float*)(R + R_G2); \
    float* GATE1 = (float*)(ws + WS_MERGED); bf16_t* HALO = (bf16_t*)(ws + WS_MERGED + SZ_GATE);     \
    float* MODP = (float*)R; \
    bf16_t* AX = (bf16_t*)(R + R5_AX); bf16_t* SZ5 = (bf16_t*)(R + R5_SZ); bf16_t* G15 = (bf16_t*)(R + R5_G1); bf16_t* GLUA = (bf16_t*)(R + R5_GLUA); bf16_t* YBR = (bf16_t*)R; \
    bf16_t* CW1 = (bf16_t*)(ws + WS_H); bf16_t* CW2 = (bf16_t*)(ws + WS_H + SZ_CW1); \
    const float* xlat_src = l == 0 ? a.in[I_X] : a.out; const float* xctx_src = l == 0 ? a.in[I_CTX] : XCTX; const float* modl = MOD + (size_t)l * 9 * 3072; \
    (void)MOD; (void)XCTX; (void)H; (void)MERGED; (void)WB0; (void)WB1; (void)P0; (void)P1; (void)P2; (void)OF; (void)OB; (void)GATE2; (void)GATE1; (void)HALO; (void)MODP; (void)AX; (void)SZ5; (void)G15; (void)GLUA; (void)YBR; (void)CW1; (void)CW2; (void)xlat_src; (void)xctx_src; (void)modl;
    LAS float* ldsf = (LAS float*)lds;

    { const int l = 0;
    if (PHEN(100) && IN(0)) { PH_LOAD; ph_modp(a, MODP, ldsf); SEAM(0); }
    if (PHEN(101) && IN(1)) { PH_LOAD; ph_mod(a, MODP, MOD); SEAM(1); } }
    for (int l = 0; l < DEPTH; ++l) {
        const int pb = 2 + l * NPH_LAYER;
        if (INL(0)) { PH_LOAD; ph_norm(a, l, xlat_src, xctx_src, modl, H); ph_cvt(wdesc(a, l, 0), WB0, ldsf); SEAM(pb + 0); }
        if (INL(1)) { PH_LOAD; EpiProj E{P0, 0, GATE1, 12, HALO}; run_gemm(ltid(a), lds, H, WB0, MROWS, 3328, E); SEAM(pb + 1); }
        if (INL(2)) { PH_LOAD; ph_gdn_conv(a, l, P0, HALO, lds); ph_cvt(wdesc(a, l, 1), WB1, ldsf); SEAM(pb + 2); }
        if (INL(3)) { PH_LOAD; ph_gdn_scan(a, l, P0, P1, P2, GATE1, OF, OB, lds); if (DUP_PHASE == 3) ph_gdn_scan(a, l, P0, P1, P2, GATE1, OF, OB, lds); SEAM(pb + 3); }
        if (INL(4)) { PH_LOAD; EpiProj E{P0, 9, nullptr, -1, nullptr}; run_gemm(ltid(a), lds, H, WB1, MROWS, 2048, E); SEAM(pb + 4); }
        if (INL(5)) { PH_LOAD; ph_gdn_post(a, l, OF, OB, P0); ph_cvt(wdesc(a, l, 6), WB0, ldsf); SEAM(pb + 5); }
        if (INL(6)) { PH_LOAD; ph_cvt(wdesc(a, l, 2), WB1, ldsf); EpiBranch E{P1, MERGED, 1}; run_gemm(ltid(a), lds, OF, WB0, MROWS, 1024, E); SEAM(pb + 6); }
        if (INL(7)) { PH_LOAD; ph_cvt(wdesc(a, l, 3), WB0, ldsf); EpiProj E{P0, 0, GATE2, 12, nullptr}; run_gemm(ltid(a), lds, H, WB1, MROWS, 3328, E); SEAM(pb + 7); }
        if (INL(8)) { PH_LOAD; ph_ml_scan_mfma(a, l, P0, P1, P2, GATE2, OF, OB, lds); if (DUP_PHASE == 8) ph_ml_scan_mfma(a, l, P0, P1, P2, GATE2, OF, OB, lds); SEAM(pb + 8); }
        if (INL(9)) { PH_LOAD; ph_cvt(wdesc(a, l, 8), WB1, ldsf); EpiProj E{P0, 38, nullptr, -1, nullptr}; run_gemm(ltid(a), lds, H, WB0, MROWS, 3072, E); SEAM(pb + 9); }
        if (INL(10)) { PH_LOAD; ph_ml_post(a, l, OF, OB, P0, P1); SEAM(pb + 10); }
        if (INL(11)) { PH_LOAD; ph_cvt(wdesc(a, l, 4), WB0, ldsf); EpiBranch E{P2, MERGED, 0}; run_gemm(ltid(a), lds, OF, WB1, MROWS, 1024, E); SEAM(pb + 11); }
        if (INL(12)) { PH_LOAD; ph_cvt(wdesc(a, l, 5), WB1, ldsf); EpiS1 E{AX, SZ5, G15}; run_gemm(ltid(a), lds, H, WB0, MROWS, 3072, E); SEAM(pb + 12); }
        if (INL(13)) { PH_LOAD; ph_s5_consts(a, l, CW1, CW2, lds); ph_cvt(wdesc(a, l, 7), WB0, ldsf); SEAM(pb + 13); }
        if (INL(14)) { PH_LOAD; EpiS5L E{AX}; run_gemm_g(ltid(a), lds, AX, 512, 256, CW1, 64 * S5_RG, 256, S5_PMG, (size_t)256 * 256 * 2, E); SEAM(pb + 14); }
        if (INL(15)) { PH_LOAD; ph_s5_carry(a, l, AX); SEAM(pb + 15); }
        if (INL(16)) { PH_LOAD; EpiS5Y E{AX, GLUA, a.in[I_SD] + l * 1024}; run_gemm_g(ltid(a), lds, AX, 512, 512, CW2, 64 * S5_RG, 256, S5_PMG, (size_t)256 * 512 * 2, E); SEAM(pb + 16); }
        if (INL(17)) { PH_LOAD; EpiGlu E{SZ5, YBR, a.in[I_SBGLU] + l * 2048}; run_gemm(ltid(a), lds, GLUA, WB1, MROWS, 2048, E); SEAM(pb + 17); }
        if (INL(18)) { PH_LOAD; ph_cvt(wdesc(a, l, 9), WB1, ldsf); EpiBranch E{G15, MERGED, 0}; run_gemm(ltid(a), lds, YBR, WB0, MROWS, 1024, E); SEAM(pb + 18); }
        if (INL(19)) { PH_LOAD;
            const int ro = (l == DEPTH - 1) ? CTXROWS : 0;
            EpiOut E{xlat_src, a.out, xctx_src, XCTX, modl, l, ro};
            run_gemm(ltid(a), lds, MERGED + (size_t)ro * 1024, WB1, MROWS - ro, 1024, E);
            SEAM(pb + 19);
        }
    }
    if (PHEN(102) && IN(PH_FINAL)) { const int l = 0; PH_LOAD; ph_final(a, a.out); }
#undef IN
#undef SEAM
#undef PH_LOAD
}
}

#ifndef MK_LAUNCHES
#define MK_LAUNCHES 1
#endif
extern "C" void kernel_launch(void* const* d_in, const int* in_sizes, int n_in, void* d_out, int out_size, void* d_ws, size_t ws_size, hipStream_t stream) {
    static int grid = 0;
    if (grid == 0) {
        if (n_in != 28 || out_size != hy::NBATCH * hy::SEQ * hy::D || ws_size < hy::WS_END) { fprintf(stderr, "kernel_launch: unexpected shapes (n_in %d, out %d, ws %zu < %zu)\n", n_in, out_size, ws_size, (size_t)hy::WS_END); grid = -1; return; }
        int dev = 0, cus = 0, per_cu = 0;
        if (hipGetDevice(&dev) != hipSuccess || hipDeviceGetAttribute(&cus, hipDeviceAttributeMultiprocessorCount, dev) != hipSuccess) { grid = -1; return; }
        if (hipFuncSetAttribute((const void*)hy::hy_fwd, hipFuncAttributeMaxDynamicSharedMemorySize, hy::LDS_BYTES) != hipSuccess) { fprintf(stderr, "kernel_launch: hipFuncSetAttribute failed\n"); grid = -1; return; }
        if (hipOccupancyMaxActiveBlocksPerMultiprocessor(&per_cu, (const void*)hy::hy_fwd, hy::NT, hy::LDS_BYTES) != hipSuccess || per_cu < 1) { fprintf(stderr, "kernel_launch: occupancy query says %d\n", per_cu); (void)hipGetLastError(); }
        grid = cus;
    }
    if (grid < 0) return;
    (void)hipMemsetAsync((char*)d_ws + hy::WS_CTL, 0, 65536, stream);
    hy::Args a{};
    for (int i = 0; i < 28; ++i) a.in[i] = (const float*)d_in[i];
    a.out = (float*)d_out; a.ws = (unsigned char*)d_ws;
#if MK_LAUNCHES == 1
    a.ph_lo = 0; a.ph_hi = hy::NPHASE;
    hipLaunchKernelGGL(hy::hy_fwd, dim3(grid), dim3(hy::NT), hy::LDS_BYTES, stream, a);
#else
    for (int p = 0; p < hy::NPHASE; ++p) { a.ph_lo = p; a.ph_hi = p + 1; hipLaunchKernelGGL(hy::hy_fwd, dim3(grid), dim3(hy::NT), hy::LDS_BYTES, stream, a); }
#endif
}
```

```cpp
#include <hip/hip_runtime.h>
#include <cstdio>
#include <cstdint>
#define MK_LAUNCHES 1


#define XB_TMO      128
#define XB_XCNT(j)  (256  + 64 * (j))
#define XB_XSUB(j)  (1280 + 64 * (j))
#define XB_XGEN(j)  (2304 + 64 * (j))
#define XB_TOP      3328
#define XB_TOPGEN   3392
#define XCD_BAR_WORDS 3456
#define XB_SPIN_CAP (1u << 18)
#define LAS __attribute__((address_space(3)))

__device__ __forceinline__ unsigned xb_ld(unsigned* p)              { return __hip_atomic_load(p, __ATOMIC_RELAXED, __HIP_MEMORY_SCOPE_AGENT); }
__device__ __forceinline__ unsigned xb_add(unsigned* p, unsigned v) { return __hip_atomic_fetch_add(p, v, __ATOMIC_RELAXED, __HIP_MEMORY_SCOPE_AGENT); }
__device__ __forceinline__ unsigned xb_xcc_id() { return (unsigned)__builtin_amdgcn_s_getreg((3 << 11) | 20) & 0xFu; }
#define XB_SPIN(cond, bar) do { unsigned _sp = 0; while (cond) { __builtin_amdgcn_s_sleep(1); \
    if ((++_sp & 255u) == 0u) { if (xb_ld(&(bar)[XB_TMO])) break; if (_sp > XB_SPIN_CAP) { atomicAdd(&(bar)[XB_TMO], 1u); break; } } } } while (0)

struct XcdBarrier {
    unsigned* bar; unsigned x;
    int wid;
    volatile LAS unsigned* st;
};

__device__ __forceinline__ bool xb_lead(int wid) { int l; asm volatile("v_mbcnt_lo_u32_b32 %0, -1, 0\n\tv_mbcnt_hi_u32_b32 %0, -1, %0" : "=v"(l)); return wid == 0 && l == 0; }
__device__ __forceinline__ XcdBarrier xcd_barrier_post(unsigned* bar, volatile LAS unsigned* st, int wid) {
    XcdBarrier b; b.bar = bar; b.x = xb_xcc_id(); b.st = st; b.wid = wid;
    if (xb_lead(wid)) (void)xb_add(&bar[XB_XCNT(b.x)], 1u);
    return b;
}
__device__ __forceinline__ void xcd_barrier_complete(unsigned* bar, unsigned x, unsigned& nloc, unsigned& nx) {
    const unsigned G = gridDim.x * gridDim.y * gridDim.z;
    unsigned sum, cnt, mine, sp = 0u;
    for (;;) {
        sum = 0u; cnt = 0u; mine = 0u;
#pragma unroll
        for (unsigned j = 0; j < 16; ++j) { const unsigned c = xb_ld(&bar[XB_XCNT(j)]); sum += c; cnt += (c > 0u) ? 1u : 0u; mine = (j == x) ? c : mine; }
        if (sum == G) break;
        __builtin_amdgcn_s_sleep(1);
        if ((++sp & 255u) == 0u) { if (xb_ld(&bar[XB_TMO])) break; if (sp > XB_SPIN_CAP) { atomicAdd(&bar[XB_TMO], 1u); break; } }
    }
    nloc = mine > 0u ? mine : 1u; nx = cnt > 0u ? cnt : 1u;
}

__device__ __forceinline__ void xcd_barrier(const XcdBarrier& b) {
    asm volatile("s_waitcnt vmcnt(0)" ::: "memory");
    __syncthreads();
    if (xb_lead(b.wid)) {
        unsigned* bar = b.bar;
        __builtin_amdgcn_s_waitcnt(0);
        unsigned nloc = b.st[0], nx = b.st[1];
        if (nloc == 0u) { xcd_barrier_complete(bar, b.x, nloc, nx); b.st[0] = nloc; b.st[1] = nx; }
        const unsigned old = xb_add(&bar[XB_XSUB(b.x)], 1u);
        const unsigned gen = old / nloc;
        if (old + 1u == (gen + 1u) * nloc) {
            __builtin_amdgcn_fence(__ATOMIC_RELEASE, "agent");
            asm volatile("s_waitcnt vmcnt(0)" ::: "memory");
            const unsigned og = xb_add(&bar[XB_TOP], 1u);
            const unsigned tg = og / nx;
            if (og + 1u == (tg + 1u) * nx) xb_add(&bar[XB_TOPGEN], 1u);
            else XB_SPIN(xb_ld(&bar[XB_TOPGEN]) == tg, bar);
            __builtin_amdgcn_fence(__ATOMIC_ACQUIRE, "agent");
            xb_add(&bar[XB_XGEN(b.x)], 1u);
            asm volatile("s_waitcnt vmcnt(0)" ::: "memory");
        } else {
            XB_SPIN(xb_ld(&bar[XB_XGEN(b.x)]) == gen, bar);
            __builtin_amdgcn_fence(__ATOMIC_ACQUIRE, "agent");
            asm volatile("s_waitcnt vmcnt(0)" ::: "memory");
        }
    }
    __syncthreads();
}


namespace pg8 {
#define PG8_LAS __attribute__((address_space(3)))
typedef unsigned short bf16_t;
typedef short bf16x8 __attribute__((ext_vector_type(8)));
typedef float f32x4 __attribute__((ext_vector_type(4)));
typedef unsigned u32x4 __attribute__((ext_vector_type(4)));
constexpr int BM = 256, BK = 64, HALF = 128, HTB = HALF * BK * 2  , STAGE_BYTES = 8 * HTB, NXCD = 8, WGM = 8;

__host__ __device__ __forceinline__ int lds_byte(int r, int c) { const int st = (r >> 4) * 2 + (c >> 5), rr = r & 15, cc = c & 31, ob = rr * 64 + cc * 2; return st * 1024 + (ob ^ (((ob >> 9) & 1) << 5)); }
__host__ __device__ __forceinline__ void stage_rc(int b, int& R, int& C) { const int st = b / 1024, sb = b % 1024, swz = sb ^ (((sb >> 9) & 1) << 5); R = (st >> 1) * 16 + swz / 64; C = (st & 1) * 32 + (swz % 64) / 2; }
__host__ __device__ __forceinline__ int perm32(int rho) { const int n = rho >> 4, i = rho & 15; return 8 * (i >> 2) + 4 * n + (i & 3); }

struct Unit { int pm, pn; };
struct Gemm { const bf16_t* A; const bf16_t* Bt; int M, N, K, lda, pmg; size_t gstride; int tid; };

struct StaticOrder {
    int nM, nN, nwg, G, c;
    __host__ __device__ void init(int M, int N, int G_, int c_) { nM = M / BM; nN = N / BM; nwg = nM * nN; G = G_; c = c_; }
    __host__ __device__ bool next(int i, Unit& u) const {
        const long L = (long)i * G + c; if (L >= nwg) return false;
        int wgid = (int)L; { const int q = nwg / NXCD, r = nwg % NXCD, xcd = wgid % NXCD, off = wgid / NXCD; wgid = (xcd < r ? xcd * (q + 1) : r * (q + 1) + (xcd - r) * q) + off; }
        const int nig = WGM * nN, gid = wgid / nig, fm = gid * WGM, gsz = (nM - fm) < WGM ? (nM - fm) : WGM;
        u.pm = fm + ((wgid % nig) % gsz); u.pn = (wgid % nig) / gsz; return true;
    }
    __device__ __forceinline__ void a_ready(const Unit&) const {}
    __device__ __forceinline__ void done(const Unit&) const {}
};
__device__ __forceinline__ unsigned cvt_pk_bf16(float lo, float hi) { unsigned r; asm volatile("v_cvt_pk_bf16_f32 %0, %1, %2" : "=v"(r) : "v"(lo), "v"(hi)); return r; }
typedef float f32x2 __attribute__((ext_vector_type(2)));
template <class Epi, class Sched, bool STAMP = false>
__device__ __forceinline__ void gemm_phase(PG8_LAS unsigned char* lds, const Gemm g, const Sched& S, const Epi& E, unsigned long long* stamps) {
    const int tid = g.tid, wid = __builtin_amdgcn_readfirstlane(tid >> 6), lane = tid & 63, wr = wid >> 2, wc = wid & 3, fr = lane & 15, fq = lane >> 4;
    const int K = g.K, nt = K / BK;
    int ts_lo = 0, ts_hi = 0, nts = 0; const unsigned long long rt_entry = STAMP ? (unsigned long long)wall_clock64() : 0ull;
#define PG8_STAMP() do { if (STAMP && wid == 0 && nts < 64) { const unsigned long long _c = (unsigned long long)clock64(); \
        ts_lo = (lane == nts) ? (int)(unsigned)_c : ts_lo; ts_hi = (lane == nts) ? (int)(unsigned)(_c >> 32) : ts_hi; ++nts; } } while (0)
    PG8_STAMP();
    unsigned voffA[2], voffB[2];
#pragma unroll
    for (int i = 0; i < 2; ++i) { int R, C; stage_rc(tid * 16 + i * 8192, R, C); const int Rb = Epi::PERM ? ((R & ~31) + perm32(R & 31)) : R;
        voffA[i] = (unsigned)(R * g.lda + C) * 2u; voffB[i] = (unsigned)(Rb * K + C) * 2u; }
    const size_t kstep = (size_t)(BK * 2);
    const size_t hstepA = (size_t)HALF * g.lda * 2, hstepB = (size_t)HALF * K * 2;
    const size_t tstepA = 2 * hstepA, tstepB = 2 * hstepB;
    const unsigned ldsw = (unsigned)wid * 1024u;
    const int aoff = lds_byte(wr * 64 + fr, fq * 8), boff = lds_byte(wc * 32 + fr, fq * 8);
#define PG8_SA(b, h) (((b) * 2 + (h)) * HTB)
#define PG8_SB(b, h) ((4 + (b) * 2 + (h)) * HTB)
#define PG8_STAGE(bufoff, gbase, voff) do { _Pragma("unroll") for (int _i = 0; _i < 2; ++_i) \
        __builtin_amdgcn_global_load_lds((const unsigned*)((const char*)(gbase) + (voff)[_i]), (PG8_LAS unsigned*)(lds + (bufoff) + ldsw + _i * 8192), 16, 0, 0); } while (0)
#define PG8_LDA(dst, b, h) do { _Pragma("unroll") for (int m = 0; m < 4; ++m) _Pragma("unroll") for (int k = 0; k < 2; ++k) dst[m][k] = *(const PG8_LAS bf16x8*)(lds + PG8_SA(b, h) + aoff + m * 2048 + k * 1024); } while (0)
#define PG8_LDB(dst, b, h) do { _Pragma("unroll") for (int n = 0; n < 2; ++n) _Pragma("unroll") for (int k = 0; k < 2; ++k) dst[n][k] = *(const PG8_LAS bf16x8*)(lds + PG8_SB(b, h) + boff + n * 2048 + k * 1024); } while (0)
#define PG8_MMA(ai, bj, At, Bt) do { __builtin_amdgcn_s_setprio(1); _Pragma("unroll") for (int m = 0; m < 4; ++m) _Pragma("unroll") for (int n = 0; n < 2; ++n) _Pragma("unroll") for (int k = 0; k < 2; ++k) \
        acc[ai][bj][m][n] = __builtin_amdgcn_mfma_f32_16x16x32_bf16(Bt[n][k], At[m][k], acc[ai][bj][m][n], 0, 0, 0); __builtin_amdgcn_s_setprio(0); } while (0)
#define PG8_WAIT_V(n) asm volatile("s_waitcnt vmcnt(" #n ")" ::: "memory")
#define PG8_WAIT_L(n) asm volatile("s_waitcnt lgkmcnt(" #n ")" ::: "memory")
#define PG8_BAR __builtin_amdgcn_s_barrier()
#define PG8_SCHED __builtin_amdgcn_sched_barrier(0)
    Unit cur, nxt; int ui = 0;
    if (!S.next(0, cur)) return;
    f32x4 acc[2][2][4][2];
#pragma unroll
    for (int a = 0; a < 2; ++a)
#pragma unroll
        for (int b = 0; b < 2; ++b)
#pragma unroll
            for (int m = 0; m < 4; ++m)
#pragma unroll
                for (int n = 0; n < 2; ++n) acc[a][b][m][n] = (f32x4){0.f, 0.f, 0.f, 0.f};
    bf16x8 At[4][2], B0[2][2], B1[2][2];
    const char* cA = (const char*)g.A + (size_t)cur.pm * tstepA; const char* cB = (const char*)g.Bt + (size_t)(cur.pm / g.pmg) * g.gstride + (size_t)cur.pn * tstepB;
    S.a_ready(cur);
    PG8_STAGE(PG8_SB(0, 0), cB, voffB); PG8_STAGE(PG8_SA(0, 0), cA, voffA); PG8_STAGE(PG8_SB(0, 1), cB + hstepB, voffB); PG8_STAGE(PG8_SA(0, 1), cA + hstepA, voffA);
    if (wr == 1) PG8_BAR;
    PG8_WAIT_V(4); PG8_BAR;
    PG8_STAGE(PG8_SB(1, 0), cB + kstep, voffB); PG8_STAGE(PG8_SA(1, 0), cA + kstep, voffA); PG8_STAGE(PG8_SB(1, 1), cB + hstepB + kstep, voffB);
    PG8_WAIT_V(6); PG8_BAR;
    PG8_STAMP();
    for (;;) {
        const bool has_next = S.next(ui + 1, nxt);
        const char* nA = has_next ? (const char*)g.A + (size_t)nxt.pm * tstepA : cA; const char* nB = has_next ? (const char*)g.Bt + (size_t)(nxt.pm / g.pmg) * g.gstride + (size_t)nxt.pn * tstepB : cB;
#pragma unroll 1
        for (int t = 0; t < nt; t += 2) {
            const bool last = (t == nt - 2);
            const char* a1 = cA + (size_t)(t + 1) * kstep;
            const char* a2 = last ? nA : cA + (size_t)(t + 2) * kstep; const char* b2 = last ? nB : cB + (size_t)(t + 2) * kstep;
            const char* a3 = a2 + kstep; const char* b3 = b2 + kstep;
            if (last && has_next) S.a_ready(nxt);
            PG8_LDB(B0, 0, 0); PG8_SCHED; PG8_LDA(At, 0, 0); PG8_STAGE(PG8_SA(1, 1), a1 + hstepA, voffA);
            PG8_WAIT_L(8); PG8_BAR; PG8_WAIT_L(0); PG8_MMA(0, 0, At, B0); PG8_BAR; PG8_SCHED;
            PG8_LDB(B1, 0, 1); PG8_STAGE(PG8_SB(0, 0), b2, voffB);
            PG8_BAR; PG8_WAIT_L(0); PG8_MMA(0, 1, At, B1); PG8_BAR;
            PG8_LDA(At, 0, 1); PG8_STAGE(PG8_SA(0, 0), a2, voffA);
            PG8_BAR; PG8_WAIT_L(0); PG8_MMA(1, 0, At, B0); PG8_BAR; PG8_SCHED;
            PG8_STAGE(PG8_SB(0, 1), b2 + hstepB, voffB);
            PG8_WAIT_V(6); PG8_BAR; PG8_MMA(1, 1, At, B1); PG8_BAR;
            PG8_LDB(B0, 1, 0); PG8_SCHED; PG8_LDA(At, 1, 0); PG8_STAGE(PG8_SA(0, 1), a2 + hstepA, voffA);
            PG8_WAIT_L(8); PG8_BAR; PG8_WAIT_L(0); PG8_MMA(0, 0, At, B0); PG8_BAR; PG8_SCHED;
            PG8_LDB(B1, 1, 1); PG8_STAGE(PG8_SB(1, 0), b3, voffB);
            PG8_BAR; PG8_WAIT_L(0); PG8_MMA(0, 1, At, B1); PG8_BAR;
            PG8_LDA(At, 1, 1); PG8_STAGE(PG8_SA(1, 0), a3, voffA);
            PG8_BAR; PG8_WAIT_L(0); PG8_MMA(1, 0, At, B0); PG8_BAR; PG8_SCHED;
            PG8_STAGE(PG8_SB(1, 1), b3 + hstepB, voffB);
            PG8_WAIT_V(6); PG8_BAR; PG8_MMA(1, 1, At, B1); PG8_BAR;
        }
        PG8_STAMP();
        if constexpr (!Epi::AFTER_DRAIN) { E(acc, cur, wr, wc, fr, fq); S.done(cur); }
        PG8_STAMP();
        if (!has_next) break;
#pragma unroll
        for (int a = 0; a < 2; ++a)
#pragma unroll
            for (int b = 0; b < 2; ++b)
#pragma unroll
                for (int m = 0; m < 4; ++m)
#pragma unroll
                    for (int n = 0; n < 2; ++n) acc[a][b][m][n] = (f32x4){0.f, 0.f, 0.f, 0.f};
        cur = nxt; cA = nA; cB = nB; ++ui;
    }
    PG8_WAIT_V(0);
    if (wr == 0) PG8_BAR;
    PG8_BAR;
    if constexpr (Epi::AFTER_DRAIN) { E.fused(acc, cur, wr, wc, fr, fq, lds, wid, lane); S.done(cur); }
    PG8_STAMP();
    if (STAMP && wid == 0) { stamps[lane] = lane < nts ? (((unsigned long long)(unsigned)ts_hi << 32) | (unsigned)ts_lo) : 0ull;
        if (lane == 62) stamps[62] = rt_entry; if (lane == 63) stamps[63] = (unsigned long long)wall_clock64(); }
#undef PG8_STAMP
#undef PG8_SA
#undef PG8_SB
#undef PG8_STAGE
#undef PG8_LDA
#undef PG8_LDB
#undef PG8_MMA
#undef PG8_WAIT_V
#undef PG8_WAIT_L
#undef PG8_BAR
#undef PG8_SCHED
}
}


namespace hy {
using pg8::bf16_t; using pg8::f32x4; using pg8::u32x4; using pg8::Unit;
typedef unsigned u32x2 __attribute__((ext_vector_type(2)));
#define DI __device__ __forceinline__
constexpr int D = 1024, NBATCH = 8, SEQ = 4096, CTXL = 256, DEPTH = 4;
constexpr int CTXROWS = NBATCH * CTXL;
constexpr int MROWS = CTXROWS + NBATCH * SEQ;
constexpr int NCHUNK = MROWS / 64;
constexpr int NIN = 14384;
constexpr int NT = 512;
constexpr int LDS_BYTES = 131072 + 256;
constexpr int C_GQ = 0, C_GZ = 3072, C_GA = 4096, C_SU = 4128, C_MQ = 6176, C_MO = 9248, C_MI = 11296, C_GATE = 11312;

constexpr size_t al256(size_t x) { return (x + 255) & ~(size_t)255; }
constexpr size_t SZ_ACT = (size_t)MROWS * 1024 * 2;
constexpr size_t SZ_GATE = (size_t)MROWS * 32 * 4;
constexpr size_t SZ_HALO = (size_t)3 * NCHUNK * 4 * 1024 * 2;
constexpr size_t WS_CTL = 0;
constexpr size_t WS_MOD = 65536, SZ_MOD = (size_t)DEPTH * 9 * 3072 * 4;
constexpr size_t WS_XCTX = al256(WS_MOD + SZ_MOD);
constexpr size_t WS_H = WS_XCTX + (size_t)CTXROWS * 1024 * 4;
constexpr size_t WS_MERGED = WS_H + SZ_ACT;
constexpr size_t SZ_WB = (size_t)3328 * 1024 * 2;
constexpr size_t WS_WB0 = WS_MERGED + SZ_ACT;
constexpr size_t WS_WB1 = WS_WB0 + SZ_WB;
constexpr size_t WS_R = WS_WB1 + SZ_WB;
constexpr size_t R_P0 = 0, R_P1 = SZ_ACT, R_P2 = 2 * SZ_ACT, R_OF = 3 * SZ_ACT, R_OB = 4 * SZ_ACT, R_G2 = 5 * SZ_ACT;
constexpr size_t WS_END = WS_R + R_G2 + SZ_GATE + (size_t)4 * 1024 * 1024;
static_assert(SZ_GATE + SZ_HALO <= SZ_ACT, "GDN gate + halo buffers live in the (not yet written) MERGED region");
static_assert((size_t)16 * DEPTH * 9 * 3072 * 4 <= SZ_ACT, "mod partials live in the R region");

struct Args { const float* in[28]; float* out; unsigned char* ws; int ph_lo, ph_hi, wid, pad; };
enum { I_X = 0, I_C, I_CTX, I_CCTX, I_WADA, I_BADA, I_NORMG, I_WIN, I_GCONV, I_GALOG, I_GDTB, I_GNORM, I_SLRE, I_SLIM, I_SLOG, I_SBRE, I_SBIM, I_SCRE, I_SCIM, I_SD, I_SWGLU, I_SBGLU, I_MIB, I_MFB, I_MNORM, I_WBR, I_WOUT, I_FNORM };

typedef const Args __attribute__((address_space(4)))* ArgsP;
DI ArgsP args_ptr() { ArgsP p = (ArgsP)__builtin_amdgcn_kernarg_segment_ptr(); asm volatile("" : "+s"(p)); return p; }
DI int lane_id() { int l; asm volatile("v_mbcnt_lo_u32_b32 %0, -1, 0\n\tv_mbcnt_hi_u32_b32 %0, -1, %0" : "=v"(l)); return l; }
DI int ltid(const Args& a) { return (a.wid << 6) | lane_id(); }
DI float bf2f(bf16_t v) { return __uint_as_float(((unsigned)v) << 16); }
DI float bflo(unsigned w) { return __uint_as_float(w << 16); }
DI float bfhi(unsigned w) { return __uint_as_float(w & 0xffff0000u); }
DI bf16_t f2bf(float f) { return (bf16_t)(pg8::cvt_pk_bf16(f, 0.f) & 0xffffu); }
DI float sigmoidf_(float x) { return 1.0f / (1.0f + __expf(-x)); }
DI float siluf_(float x) { return x / (1.0f + __expf(-x)); }
DI float softplusf_(float x) { return x > 20.f ? x : log1pf(__expf(x)); }
DI float gelu_tanh_(float x) { const float u = 0.7978845608028654f * (x + 0.044715f * x * x * x); return 0.5f * x * (1.0f + tanhf(u)); }
DI float shx(float v, int o, int lane) { return __int_as_float(__builtin_amdgcn_ds_bpermute((lane ^ o) << 2, __float_as_int(v))); }
DI float shup(float v, int o, int lane) { return __int_as_float(__builtin_amdgcn_ds_bpermute((lane - o) << 2, __float_as_int(v))); }
DI float shidx(float v, int src) { return __int_as_float(__builtin_amdgcn_ds_bpermute(src << 2, __float_as_int(v))); }
DI float wave_sum(float v, int lane) {
#pragma unroll
    for (int o = 32; o >= 1; o >>= 1) v += shx(v, o, lane);
    return v; }
DI void unpack8(const u32x4 w, float (&f)[8]) { f[0] = bflo(w.x); f[1] = bfhi(w.x); f[2] = bflo(w.y); f[3] = bfhi(w.y); f[4] = bflo(w.z); f[5] = bfhi(w.z); f[6] = bflo(w.w); f[7] = bfhi(w.w); }
DI int lat_pos(int l, int s) { return (l & 1) ? (((s & 63) << 6) | (s >> 6)) : s; }

struct EpiProj {
    static constexpr bool PERM = true, AFTER_DRAIN = false;
    bf16_t* d0; int modes; float* gdst; int gtile; bf16_t* halo;
    __device__ __forceinline__ void operator()(const f32x4 (&acc)[2][2][4][2], const Unit& u, int wr, int wc, int fr, int fq) const {
        const int row0 = u.pm * 256 + wr * 64 + fr;
        if (u.pn == gtile) {
            if (wc == 0) {
#pragma unroll
                for (int ai = 0; ai < 2; ++ai)
#pragma unroll
                    for (int m = 0; m < 4; ++m) { float* rp = gdst + (size_t)(row0 + ai * 128 + m * 16) * 32 + 8 * fq; *(f32x4*)rp = acc[ai][0][m][0]; *(f32x4*)(rp + 4) = acc[ai][0][m][1]; }
            }
            return;
        }
        const int seg = u.pn >> 2; bf16_t* base = d0 + (size_t)seg * (SZ_ACT / 2); const int md = (modes >> (2 * seg)) & 3;
        const int col0 = (u.pn & 3) * 256 + wc * 32 + 8 * fq;
#pragma unroll
        for (int ai = 0; ai < 2; ++ai)
#pragma unroll
            for (int m = 0; m < 4; ++m) {
                const int r = row0 + ai * 128 + m * 16;
                bf16_t* rowp = base + (size_t)r * 1024 + col0;
                int hidx = -1;
                if (halo) { if (m == 0 && fr < 2) hidx = fr; if (m == 3 && fr >= 14) hidx = fr - 12; }
#pragma unroll
                for (int bj = 0; bj < 2; ++bj) {
                    f32x4 v0 = acc[ai][bj][m][0], v1 = acc[ai][bj][m][1];
                    if (md == 1) {
#pragma unroll
                        for (int j = 0; j < 4; ++j) { v0[j] = siluf_(v0[j]); v1[j] = siluf_(v1[j]); } }
                    else if (md == 2) {
#pragma unroll
                        for (int j = 0; j < 4; ++j) { v0[j] = sigmoidf_(v0[j]); v1[j] = sigmoidf_(v1[j]); } }
                    u32x4 w; w.x = pg8::cvt_pk_bf16(v0[0], v0[1]); w.y = pg8::cvt_pk_bf16(v0[2], v0[3]); w.z = pg8::cvt_pk_bf16(v1[0], v1[1]); w.w = pg8::cvt_pk_bf16(v1[2], v1[3]);
                    *(u32x4*)(rowp + bj * 128) = w;
                    if (hidx >= 0) *(u32x4*)(halo + ((size_t)seg * (NCHUNK * 4) + (size_t)(r >> 6) * 4 + hidx) * 1024 + col0 + bj * 128) = w;
                }
            }
    }
};
struct EpiBranch {
    static constexpr bool PERM = true, AFTER_DRAIN = false;
    const bf16_t* G; bf16_t* MG; int first;
    __device__ __forceinline__ void operator()(const f32x4 (&acc)[2][2][4][2], const Unit& u, int wr, int wc, int fr, int fq) const {
        const int row0 = u.pm * 256 + wr * 64 + fr, col0 = u.pn * 256 + wc * 32 + 8 * fq;
#pragma unroll
        for (int ai = 0; ai < 2; ++ai)
#pragma unroll
            for (int m = 0; m < 4; ++m) {
                const size_t off = (size_t)(row0 + ai * 128 + m * 16) * 1024 + col0;
#pragma unroll
                for (int bj = 0; bj < 2; ++bj) {
                    const u32x4 gw = *(const u32x4*)(G + off + bj * 128);
                    float g[8], o[8]; unpack8(gw, g);
                    if (first) {
#pragma unroll
                        for (int j = 0; j < 8; ++j) o[j] = 0.f; }
                    else { const u32x4 ow = *(const u32x4*)(MG + off + bj * 128); unpack8(ow, o); }
                    const f32x4 v0 = acc[ai][bj][m][0], v1 = acc[ai][bj][m][1];
#pragma unroll
                    for (int j = 0; j < 4; ++j) { o[j] += g[j] * v0[j]; o[4 + j] += g[4 + j] * v1[j]; }
                    u32x4 w; w.x = pg8::cvt_pk_bf16(o[0], o[1]); w.y = pg8::cvt_pk_bf16(o[2], o[3]); w.z = pg8::cvt_pk_bf16(o[4], o[5]); w.w = pg8::cvt_pk_bf16(o[6], o[7]);
                    *(u32x4*)(MG + off + bj * 128) = w;
                }
                asm volatile("" ::: "memory");
            }
    }
};
struct EpiGlu {
    static constexpr bool PERM = true, AFTER_DRAIN = false;
    const bf16_t* SZ; bf16_t* O; const float* bias;
    __device__ __forceinline__ void operator()(const f32x4 (&acc)[2][2][4][2], const Unit& u, int wr, int wc, int fr, int fq) const {
        const int row0 = u.pm * 256 + wr * 64 + fr, col0 = u.pn * 128 + wc * 32 + 8 * fq;
        float ba[8], bg[8];
#pragma unroll
        for (int j = 0; j < 8; ++j) { ba[j] = bias[col0 + j]; bg[j] = bias[1024 + col0 + j]; }
#pragma unroll
        for (int ai = 0; ai < 2; ++ai)
#pragma unroll
            for (int m = 0; m < 4; ++m) {
                const size_t off = (size_t)(row0 + ai * 128 + m * 16) * 1024 + col0;
                const u32x4 zw = *(const u32x4*)(SZ + off); float z[8], o[8]; unpack8(zw, z);
#pragma unroll
                for (int n = 0; n < 2; ++n)
#pragma unroll
                    for (int j = 0; j < 4; ++j) { const int c = 4 * n + j; o[c] = (acc[ai][0][m][n][j] + ba[c]) * sigmoidf_(acc[ai][1][m][n][j] + bg[c]) * z[c]; }
                u32x4 w; w.x = pg8::cvt_pk_bf16(o[0], o[1]); w.y = pg8::cvt_pk_bf16(o[2], o[3]); w.z = pg8::cvt_pk_bf16(o[4], o[5]); w.w = pg8::cvt_pk_bf16(o[6], o[7]);
                *(u32x4*)(O + off) = w;
            }
    }
};
struct EpiOut {
    static constexpr bool PERM = false, AFTER_DRAIN = false;
    const float* xlat_src; float* xlat_dst; const float* xctx_src; float* xctx_dst; const float* mod; int l; int row_off;
    __device__ __forceinline__ void operator()(const f32x4 (&acc)[2][2][4][2], const Unit& u, int wr, int wc, int fr, int fq) const {
        const int row0 = row_off + u.pm * 256 + wr * 64 + fr, col0 = u.pn * 256 + wc * 32 + 4 * fq;
#pragma unroll
        for (int ai = 0; ai < 2; ++ai)
#pragma unroll
            for (int m = 0; m < 4; ++m) {
                const int r = row0 + ai * 128 + m * 16;
                const float* xs; float* xd; const float* gp;
                if (r < CTXROWS) { xs = xctx_src + (size_t)r * 1024; xd = xctx_dst + (size_t)r * 1024; gp = mod + 8 * 3072 + 2048; }
                else { const int q = r - CTXROWS, b = q >> 12, p = lat_pos(l, q & 4095); const size_t o = ((size_t)b * 4096 + p) * 1024; xs = xlat_src + o; xd = xlat_dst + o; gp = mod + b * 3072 + 2048; }
#pragma unroll
                for (int bj = 0; bj < 2; ++bj)
#pragma unroll
                    for (int n = 0; n < 2; ++n) { const int c = col0 + bj * 128 + n * 16; const f32x4 x = *(const f32x4*)(xs + c), g = *(const f32x4*)(gp + c); *(f32x4*)(xd + c) = x + g * acc[ai][bj][m][n]; }
                asm volatile("" ::: "memory");
            }
    }
};

DI void ph_modp(const Args& a, float* modp, LAS float* sl) {
    for (int it = blockIdx.x; it < 384; it += gridDim.x) {
        const int l = it / 96, kq = (it / 6) % 16, nt = it % 6;
        __syncthreads();
        for (int i = ltid(a); i < 576; i += NT) { const int j = i >> 6, k = kq * 64 + (i & 63); const float cv = (j < 8) ? a.in[I_C][j * 1024 + k] : a.in[I_CCTX][k]; sl[i] = siluf_(cv); }
        __syncthreads();
        const int n = nt * 512 + ltid(a);
        float acc[9];
#pragma unroll
        for (int j = 0; j < 9; ++j) acc[j] = 0.f;
        const float* w = a.in[I_WADA] + ((size_t)l * 1024 + kq * 64) * 3072 + n;
#pragma unroll 4
        for (int k = 0; k < 64; ++k) { const float wv = w[(size_t)k * 3072];
#pragma unroll
            for (int j = 0; j < 9; ++j) acc[j] += sl[j * 64 + k] * wv; }
#pragma unroll
        for (int j = 0; j < 9; ++j) modp[(((size_t)kq * 4 + l) * 9 + j) * 3072 + n] = acc[j];
    }
}
DI void ph_mod(const Args& a, const float* modp, float* mod) {
    for (int i = blockIdx.x * NT + ltid(a); i < DEPTH * 9 * 3072; i += gridDim.x * NT) {
        const int l = i / (9 * 3072), n = i % 3072; float s = a.in[I_BADA][l * 3072 + n];
#pragma unroll
        for (int kq = 0; kq < 16; ++kq) s += modp[(size_t)kq * (DEPTH * 9 * 3072) + i];
        mod[i] = s;
    }
}
DI void ph_norm(const Args& a, int l, const float* xlat, const float* xctx, const float* mod, bf16_t* H) {
    const int wave = ltid(a) >> 6, lane = ltid(a) & 63;
    const float* g = a.in[I_NORMG] + l * 1024;
    for (int r = blockIdx.x * 8 + wave; r < MROWS; r += gridDim.x * 8) {
        const float* src; const float* md;
        if (r < CTXROWS) { src = xctx + (size_t)r * 1024; md = mod + 8 * 3072; }
        else { const int q = r - CTXROWS, b = q >> 12, p = lat_pos(l, q & 4095); src = xlat + ((size_t)b * 4096 + p) * 1024; md = mod + b * 3072; }
        f32x4 v[4]; float ss = 0.f;
#pragma unroll
        for (int i = 0; i < 4; ++i) { v[i] = *(const f32x4*)(src + i * 256 + lane * 4); ss += v[i][0] * v[i][0] + v[i][1] * v[i][1] + v[i][2] * v[i][2] + v[i][3] * v[i][3]; }
        ss = wave_sum(ss, lane);
        const float rs = rsqrtf(ss * (1.0f / 1024.0f) + 1e-6f);
#pragma unroll
        for (int i = 0; i < 4; ++i) { const int c = i * 256 + lane * 4;
            const f32x4 gv = *(const f32x4*)(g + c), sh = *(const f32x4*)(md + c), sc = *(const f32x4*)(md + 1024 + c);
            const f32x4 y = (v[i] * rs) * gv * (sc + 1.0f) + sh;
            u32x2 w; w.x = pg8::cvt_pk_bf16(y[0], y[1]); w.y = pg8::cvt_pk_bf16(y[2], y[3]);
            *(u32x2*)(H + (size_t)r * 1024 + c) = w; }
    }
}
DI void ph_final(const Args& a, float* x) {
    const int wave = ltid(a) >> 6, lane = ltid(a) & 63;
    const float* g = a.in[I_FNORM];
    for (int r = blockIdx.x * 8 + wave; r < NBATCH * SEQ; r += gridDim.x * 8) {
        float* src = x + (size_t)r * 1024;
        f32x4 v[4]; float ss = 0.f;
#pragma unroll
        for (int i = 0; i < 4; ++i) { v[i] = *(const f32x4*)(src + i * 256 + lane * 4); ss += v[i][0] * v[i][0] + v[i][1] * v[i][1] + v[i][2] * v[i][2] + v[i][3] * v[i][3]; }
        ss = wave_sum(ss, lane);
        const float rs = rsqrtf(ss * (1.0f / 1024.0f) + 1e-6f);
#pragma unroll
        for (int i = 0; i < 4; ++i) { const int c = i * 256 + lane * 4; const f32x4 gv = *(const f32x4*)(g + c); *(f32x4*)(src + c) = (v[i] * rs) * gv; }
    }
}
struct WDesc { const float* src; int ld, id, n64, tid; };
DI void wmap(int id, int nb, int& col, int& valid) {
    valid = 64;
    switch (id) {
        case 0: if (nb < 48) col = C_GQ + 64 * nb; else if (nb == 48) { col = C_GA; valid = 32; } else { col = 0; valid = 0; } break;
        case 1: col = (nb < 16) ? C_GZ + 64 * nb : C_GATE + 64 * (nb - 16); break;
        case 2: if (nb < 48) col = C_MQ + 64 * nb; else if (nb == 48) { col = C_MI; valid = 16; } else { col = 0; valid = 0; } break;
        case 3: col = (nb < 32) ? C_MO + 64 * nb : C_GATE + 2048 + 64 * (nb - 32); break;
        case 4: col = (nb < 32) ? C_SU + 64 * nb : C_GATE + 1024 + 64 * (nb - 32); break;
        case 5: { const int pn = nb >> 2, q = nb & 3; col = (q >> 1) * 1024 + 128 * pn + (q & 1) * 64; } break;
        default: col = 64 * nb; break;
    }
}
DI WDesc wdesc(const Args& a, int l, int id) {
    WDesc w; w.id = id; w.tid = ltid(a);
    if (id <= 4) { w.src = a.in[I_WIN] + (size_t)l * 1024 * NIN; w.ld = NIN; w.n64 = (id == 0 || id == 2) ? 52 : (id == 1 ? 32 : 48); }
    else if (id == 5) { w.src = a.in[I_SWGLU] + (size_t)l * 1024 * 2048; w.ld = 2048; w.n64 = 32; }
    else if (id <= 8) { w.src = a.in[I_WBR] + ((size_t)l * 3 + (id - 6)) * 1024 * 1024; w.ld = 1024; w.n64 = 16; }
    else { w.src = a.in[I_WOUT] + (size_t)l * 1024 * 1024; w.ld = 1024; w.n64 = 16; }
    return w;
}
DI void ph_cvt(const WDesc w, bf16_t* dst, LAS float* tile) {
    const int tid = w.tid, ntile = w.n64 * 16;
    for (int t = blockIdx.x; t < ntile; t += gridDim.x) {
        const int nb = t >> 4, kb = t & 15; int col, valid; wmap(w.id, nb, col, valid);
        __syncthreads();
        { const int c = tid & 63, k0 = tid >> 6;
#pragma unroll
          for (int i = 0; i < 8; ++i) { const int k = k0 + 8 * i; tile[k * 65 + c] = (c < valid) ? w.src[(size_t)(kb * 64 + k) * w.ld + col + c] : 0.f; } }
        __syncthreads();
        { const int n = tid >> 3, kk = (tid & 7) * 8; u32x4 o;
          o.x = pg8::cvt_pk_bf16(tile[(kk + 0) * 65 + n], tile[(kk + 1) * 65 + n]); o.y = pg8::cvt_pk_bf16(tile[(kk + 2) * 65 + n], tile[(kk + 3) * 65 + n]);
          o.z = pg8::cvt_pk_bf16(tile[(kk + 4) * 65 + n], tile[(kk + 5) * 65 + n]); o.w = pg8::cvt_pk_bf16(tile[(kk + 6) * 65 + n], tile[(kk + 7) * 65 + n]);
          *(u32x4*)(dst + (size_t)(nb * 64 + n) * 1024 + kb * 64 + kk) = o; }
    }
    __syncthreads();
}

DI void ph_gdn_conv(const Args& a, int l, bf16_t* QKV  , const bf16_t* halo, LAS unsigned char* lds) {
    LAS bf16_t* raw = (LAS bf16_t*)lds;
    constexpr int P = 136;
    const int tid = ltid(a);
    const float* cw = a.in[I_GCONV] + (size_t)l * 5 * 3072;
    for (int unit = blockIdx.x; unit < NCHUNK * 24; unit += gridDim.x) {
        const int cb = unit / 24, seg = (unit % 24) >> 3, h = unit & 7;
        bf16_t* T = QKV + (size_t)seg * (SZ_ACT / 2);
        const bool first = (cb < 32) ? ((cb & 3) == 0) : (((cb - 32) & 63) == 0);
        const bool last = (cb < 32) ? ((cb & 3) == 3) : (((cb - 32) & 63) == 63);
        __syncthreads();
        for (int i = tid; i < 68 * 16; i += NT) {
            const int rr = i >> 4, c8 = (i & 15) * 8; u32x4 w = (u32x4){0u, 0u, 0u, 0u};
            if (rr >= 2 && rr < 66) w = *(const u32x4*)(T + (size_t)(cb * 64 + rr - 2) * 1024 + h * 128 + c8);
            else if (rr < 2) { if (!first) w = *(const u32x4*)(halo + ((size_t)seg * (NCHUNK * 4) + (size_t)(cb - 1) * 4 + 2 + rr) * 1024 + h * 128 + c8); }
            else { if (!last) w = *(const u32x4*)(halo + ((size_t)seg * (NCHUNK * 4) + (size_t)(cb + 1) * 4 + (rr - 66)) * 1024 + h * 128 + c8); }
            *(LAS u32x4*)(raw + rr * P + c8) = w;
        }
        __syncthreads();
        const int t = tid >> 3, c0 = (tid & 7) * 16;
        float o[16]; float ss = 0.f;
#pragma unroll
        for (int half = 0; half < 2; ++half) {
            float acc[8];
#pragma unroll
            for (int j = 0; j < 8; ++j) acc[j] = 0.f;
#pragma unroll
            for (int k = 0; k < 5; ++k) {
                const u32x4 w = *(const LAS u32x4*)(raw + (t + k) * P + c0 + half * 8); float x[8]; unpack8(w, x);
                const float* wp = cw + (size_t)k * 3072 + seg * 1024 + h * 128 + c0 + half * 8;
                const f32x4 w0 = *(const f32x4*)wp, w1 = *(const f32x4*)(wp + 4);
#pragma unroll
                for (int j = 0; j < 4; ++j) { acc[j] += w0[j] * x[j]; acc[4 + j] += w1[j] * x[4 + j]; }
            }
#pragma unroll
            for (int j = 0; j < 8; ++j) { const float s = siluf_(acc[j]); o[half * 8 + j] = s; ss += s * s; }
        }
        ss += shx(ss, 1, tid & 63); ss += shx(ss, 2, tid & 63); ss += shx(ss, 4, tid & 63);
        float scale = 1.0f;
        if (seg == 0) scale = rsqrtf(ss + 1e-6f) * 0.08838834764831845f;
        else if (seg == 1) scale = rsqrtf(ss + 1e-6f);
        u32x4 w0, w1;
        w0.x = pg8::cvt_pk_bf16(o[0] * scale, o[1] * scale); w0.y = pg8::cvt_pk_bf16(o[2] * scale, o[3] * scale); w0.z = pg8::cvt_pk_bf16(o[4] * scale, o[5] * scale); w0.w = pg8::cvt_pk_bf16(o[6] * scale, o[7] * scale);
        w1.x = pg8::cvt_pk_bf16(o[8] * scale, o[9] * scale); w1.y = pg8::cvt_pk_bf16(o[10] * scale, o[11] * scale); w1.z = pg8::cvt_pk_bf16(o[12] * scale, o[13] * scale); w1.w = pg8::cvt_pk_bf16(o[14] * scale, o[15] * scale);
        bf16_t* op = T + (size_t)(cb * 64 + t) * 1024 + h * 128 + c0;
        *(u32x4*)op = w0; *(u32x4*)(op + 8) = w1;
    }
    __syncthreads();
}
DI void ph_gdn_scan(const Args& a, int l, const bf16_t* Q, const bf16_t* K, const bf16_t* V, const float* GATE, bf16_t* OF, bf16_t* OB, LAS unsigned char* lds) {
    LAS float* qf = (LAS float*)lds;
    LAS float* kf = qf + 64 * 128;
    LAS float* vf = kf + 64 * 128;
    LAS float* av = vf + 64 * 64;
    LAS float* bt = av + 64;
    LAS float* part = bt + 64;
    LAS float* po = part + 1024;
    const int tid = ltid(a), e = tid & 63, dq = tid >> 6;
    for (int unit = blockIdx.x; unit < 256; unit += gridDim.x) {
        const int eh = unit & 1, d = (unit >> 1) & 1, h = (unit >> 2) & 7, b = unit >> 5;
        const float nea = -__expf(a.in[I_GALOG][(l * 2 + d) * 8 + h]), dtb = a.in[I_GDTB][(l * 2 + d) * 8 + h];
        bf16_t* O = d ? OB : OF;
        float S[16];
#pragma unroll
        for (int j = 0; j < 16; ++j) S[j] = 0.f;
        float opart = 0.f; int prow = -1, par = 0;
        for (int step = 0; step < 68; ++step) {
            const int cc = (step < 4) ? (d ? 3 - step : step) : (d ? 67 - step : step - 4);
            const int row0 = (step < 4) ? b * 256 + cc * 64 : CTXROWS + b * 4096 + cc * 64;
            __syncthreads();
            for (int i = tid; i < 1024; i += NT) { const int r = i >> 4, c8 = (i & 15) * 8; float f[8];
                unpack8(*(const u32x4*)(Q + (size_t)(row0 + r) * 1024 + h * 128 + c8), f);
#pragma unroll
                for (int j = 0; j < 8; ++j) qf[r * 128 + c8 + j] = f[j];
                unpack8(*(const u32x4*)(K + (size_t)(row0 + r) * 1024 + h * 128 + c8), f);
#pragma unroll
                for (int j = 0; j < 8; ++j) kf[r * 128 + c8 + j] = f[j]; }
            { const int r = tid >> 3, c8 = (tid & 7) * 8; float f[8]; unpack8(*(const u32x4*)(V + (size_t)(row0 + r) * 1024 + h * 128 + eh * 64 + c8), f);
#pragma unroll
              for (int j = 0; j < 8; ++j) vf[r * 64 + c8 + j] = f[j]; }
            if (tid < 64) { const float* gp = GATE + (size_t)(row0 + tid) * 32; av[tid] = __expf(nea * softplusf_(gp[d * 8 + h] + dtb)); bt[tid] = sigmoidf_(gp[16 + d * 8 + h]); }
            __syncthreads();
            for (int tt = 0; tt < 64; ++tt) {
                const int t = d ? 63 - tt : tt;
                float kk[16];
#pragma unroll
                for (int j4 = 0; j4 < 4; ++j4) { const f32x4 x = *(const LAS f32x4*)(kf + t * 128 + dq * 16 + j4 * 4); kk[j4 * 4] = x[0]; kk[j4 * 4 + 1] = x[1]; kk[j4 * 4 + 2] = x[2]; kk[j4 * 4 + 3] = x[3]; }
                float p = 0.f;
#pragma unroll
                for (int j = 0; j < 16; ++j) p += kk[j] * S[j];
                part[(par * 8 + dq) * 64 + e] = p; po[(par * 8 + dq) * 64 + e] = opart;
                __syncthreads();
                if (dq == 0 && prow >= 0) { float o = 0.f;
#pragma unroll
                    for (int q = 0; q < 8; ++q) o += po[(par * 8 + q) * 64 + e];
                    O[(size_t)prow * 1024 + h * 128 + eh * 64 + e] = f2bf(o); }
                float ks = 0.f;
#pragma unroll
                for (int q = 0; q < 8; ++q) ks += part[(par * 8 + q) * 64 + e];
                const float at = av[t], vn = bt[t] * (vf[t * 64 + e] - at * ks);
#pragma unroll
                for (int j = 0; j < 16; ++j) S[j] = at * S[j] + kk[j] * vn;
                float qo = 0.f;
#pragma unroll
                for (int j4 = 0; j4 < 4; ++j4) { const f32x4 x = *(const LAS f32x4*)(qf + t * 128 + dq * 16 + j4 * 4); qo += x[0] * S[j4 * 4] + x[1] * S[j4 * 4 + 1] + x[2] * S[j4 * 4 + 2] + x[3] * S[j4 * 4 + 3]; }
                opart = qo; prow = row0 + t; par ^= 1;
            }
        }
        po[(par * 8 + dq) * 64 + e] = opart;
        __syncthreads();
        if (dq == 0) { float o = 0.f;
#pragma unroll
            for (int q = 0; q < 8; ++q) o += po[(par * 8 + q) * 64 + e];
            O[(size_t)prow * 1024 + h * 128 + eh * 64 + e] = f2bf(o); }
        __syncthreads();
    }
}
DI void ph_gdn_post(const Args& a, int l, bf16_t* OF, const bf16_t* OB, const bf16_t* SZ) {
    const int wave = ltid(a) >> 6, lane = ltid(a) & 63;
    const float* g = a.in[I_GNORM] + l * 128;
    const float g0 = g[2 * lane], g1 = g[2 * lane + 1];
    for (int it = blockIdx.x * 8 + wave; it < MROWS * 8; it += gridDim.x * 8) {
        const size_t off = (size_t)(it >> 3) * 1024 + (it & 7) * 128 + 2 * lane;
        const unsigned wf = *(const unsigned*)(OF + off), wb = *(const unsigned*)(OB + off), wz = *(const unsigned*)(SZ + off);
        const float o0 = bflo(wf) + bflo(wb), o1 = bfhi(wf) + bfhi(wb);
        const float ss = wave_sum(o0 * o0 + o1 * o1, lane);
        const float rs = rsqrtf(ss * (1.0f / 128.0f) + 1e-6f);
        *(unsigned*)(OF + off) = pg8::cvt_pk_bf16(o0 * rs * g0 * bflo(wz), o1 * rs * g1 * bfhi(wz));
    }
}

DI void ph_ml_scan(const Args& a, int l, const bf16_t* Q, const bf16_t* K, const bf16_t* V, const float* GATE, bf16_t* HF, bf16_t* HB, LAS unsigned char* lds) {
    LAS bf16_t* qs = (LAS bf16_t*)lds;
    LAS bf16_t* ks = qs + 64 * 256;
    LAS float* vf = (LAS float*)(ks + 64 * 256);
    LAS float* ip = vf + 64 * 64;
    LAS float* lf = ip + 64;
    LAS float* part = lf + 64;
    LAS float* dpart = part + 1024;
    const int tid = ltid(a), e = tid & 63, dq = tid >> 6;
    for (int unit = blockIdx.x; unit < 256; unit += gridDim.x) {
        const int eq = unit & 3, d = (unit >> 2) & 1, hd = (unit >> 3) & 3, b = unit >> 5;
        const float ibias = a.in[I_MIB][(l * 2 + d) * 4 + hd], fbias = a.in[I_MFB][(l * 2 + d) * 4 + hd];
        bf16_t* HO = d ? HB : HF;
        float C[32];
#pragma unroll
        for (int j = 0; j < 32; ++j) C[j] = 0.f;
        float nn = 0.f, m = 0.f; int par = 0;
        for (int step = 0; step < 68; ++step) {
            const int cc = (step < 4) ? (d ? 3 - step : step) : (d ? 67 - step : step - 4);
            const int row0 = (step < 4) ? b * 256 + cc * 64 : CTXROWS + b * 4096 + cc * 64;
            __syncthreads();
            for (int i = tid; i < 2048; i += NT) { const int r = i >> 5, c8 = (i & 31) * 8;
                *(LAS u32x4*)(qs + r * 256 + c8) = *(const u32x4*)(Q + (size_t)(row0 + r) * 1024 + hd * 256 + c8);
                *(LAS u32x4*)(ks + r * 256 + c8) = *(const u32x4*)(K + (size_t)(row0 + r) * 1024 + hd * 256 + c8); }
            { const int r = tid >> 3, c8 = (tid & 7) * 8; float f[8]; unpack8(*(const u32x4*)(V + (size_t)(row0 + r) * 1024 + hd * 256 + eq * 64 + c8), f);
#pragma unroll
              for (int j = 0; j < 8; ++j) vf[r * 64 + c8 + j] = f[j]; }
            if (tid < 64) { const float* gp = GATE + (size_t)(row0 + tid) * 32; ip[tid] = gp[d * 4 + hd] + ibias; lf[tid] = -softplusf_(-(gp[8 + d * 4 + hd] + fbias)); }
            __syncthreads();
            for (int tt = 0; tt < 64; ++tt) {
                const int t = d ? 63 - tt : tt;
                const float it = ip[t], ft = lf[t];
                const float mn = fmaxf(ft + m, it);
                const float fdec = __expf(ft + m - mn), iw = __expf(it - mn) * 0.0625f, nrm = __expf(-mn);
                m = mn;
                const float vv = iw * vf[t * 64 + e];
                float pn = 0.f;
#pragma unroll
                for (int j8 = 0; j8 < 4; ++j8) {
                    float kk[8], qq[8];
                    unpack8(*(const LAS u32x4*)(ks + t * 256 + dq * 32 + j8 * 8), kk);
                    unpack8(*(const LAS u32x4*)(qs + t * 256 + dq * 32 + j8 * 8), qq);
#pragma unroll
                    for (int j = 0; j < 8; ++j) { const float c = fdec * C[j8 * 8 + j] + vv * kk[j]; C[j8 * 8 + j] = c; pn += c * qq[j]; }
                }
                const int dn = dq * 32 + (e & 31);
                nn = fdec * nn + iw * bf2f(ks[t * 256 + dn]);
                float pd = (e < 32) ? nn * bf2f(qs[t * 256 + dn]) : 0.f;
                pd = wave_sum(pd, e);
                part[(par * 8 + dq) * 64 + e] = pn; if (e == 0) dpart[par * 8 + dq] = pd;
                __syncthreads();
                if (dq == 0) { float num = 0.f, den = 0.f;
#pragma unroll
                    for (int q = 0; q < 8; ++q) { num += part[(par * 8 + q) * 64 + e]; den += dpart[par * 8 + q]; }
                    HO[(size_t)(row0 + t) * 1024 + hd * 256 + eq * 64 + e] = f2bf(num / fmaxf(fabsf(den), nrm)); }
                par ^= 1;
            }
        }
        __syncthreads();
    }
}
DI void ph_ml_post(const Args& a, int l, bf16_t* HF, const bf16_t* HB, const bf16_t* SO, const bf16_t* SZ) {
    const int wave = ltid(a) >> 6, lane = ltid(a) & 63;
    const f32x4 g = *(const f32x4*)(a.in[I_MNORM] + l * 256 + 4 * lane);
    for (int it = blockIdx.x * 8 + wave; it < MROWS * 4; it += gridDim.x * 8) {
        const size_t off = (size_t)(it >> 2) * 1024 + (it & 3) * 256 + 4 * lane;
        const u32x2 wf = *(const u32x2*)(HF + off), wb = *(const u32x2*)(HB + off), wo = *(const u32x2*)(SO + off), wz = *(const u32x2*)(SZ + off);
        const float h0 = (bflo(wf.x) + bflo(wb.x)) * bflo(wo.x), h1 = (bfhi(wf.x) + bfhi(wb.x)) * bfhi(wo.x), h2 = (bflo(wf.y) + bflo(wb.y)) * bflo(wo.y), h3 = (bfhi(wf.y) + bfhi(wb.y)) * bfhi(wo.y);
        const float ss = wave_sum(h0 * h0 + h1 * h1 + h2 * h2 + h3 * h3, lane);
        const float rs = rsqrtf(ss * (1.0f / 256.0f) + 1e-6f);
        u32x2 w; w.x = pg8::cvt_pk_bf16(h0 * rs * g[0] * bflo(wz.x), h1 * rs * g[1] * bfhi(wz.x)); w.y = pg8::cvt_pk_bf16(h2 * rs * g[2] * bflo(wz.y), h3 * rs * g[3] * bfhi(wz.y));
        *(u32x2*)(HF + off) = w;
    }
}

DI void ph_s5_scan(const Args& a, int l, const bf16_t* U, bf16_t* YF, bf16_t* YB, LAS unsigned char* lds) {
    const int tid = ltid(a), w = tid >> 6, p = tid & 63;
    LAS float* ub = (LAS float*)lds + w * 2304;
    LAS float* yb = ub + 1024;
    LAS float* xb = yb + 1024;
    for (int unit = blockIdx.x; unit < 128; unit += gridDim.x) {
        const int gb = unit & 7, d = (unit >> 3) & 1, b = unit >> 4, g = gb * 8 + w;
        const float stp = expf(a.in[I_SLOG][(l * 2 + d) * 64 + g]);
        const float lre = a.in[I_SLRE][((size_t)(l * 2 + d) * 64 + g) * 64 + p], lim = a.in[I_SLIM][((size_t)(l * 2 + d) * 64 + g) * 64 + p];
        const float mag = expf(lre * stp), lbr = mag * cosf(lim * stp), lbi = mag * sinf(lim * stp);
        const float dnm = lre * lre + lim * lim;
        const float fre = ((lbr - 1.0f) * lre + lbi * lim) / dnm, fim = (lbi * lre - (lbr - 1.0f) * lim) / dnm;
        float bbr[16], bbi[16];
        { const float* br = a.in[I_SBRE] + (((size_t)l * 64 + g) * 64 + p) * 16; const float* bi = a.in[I_SBIM] + (((size_t)l * 64 + g) * 64 + p) * 16;
#pragma unroll
          for (int h = 0; h < 16; ++h) { bbr[h] = fre * br[h] - fim * bi[h]; bbi[h] = fre * bi[h] + fim * br[h]; } }
        const int hh = p & 15, pt = p >> 4;
        float cr[16], ci[16];
        { const float* c0 = a.in[I_SCRE] + (((size_t)l * 64 + g) * 16 + hh) * 64 + pt * 16; const float* c1 = a.in[I_SCIM] + (((size_t)l * 64 + g) * 16 + hh) * 64 + pt * 16;
#pragma unroll
          for (int j = 0; j < 16; ++j) { cr[j] = c0[j]; ci[j] = c1[j]; } }
        bf16_t* Y = d ? YB : YF;
        float xr = 0.f, xi = 0.f; int par = 0;
        for (int step = 0; step < 68; ++step) {
            const int cc = (step < 4) ? (d ? 3 - step : step) : (d ? 67 - step : step - 4);
            const int row0 = (step < 4) ? b * 256 + cc * 64 : CTXROWS + b * 4096 + cc * 64;
            __syncthreads();
            { const bf16_t* up = U + (size_t)(row0 + p) * 1024 + g * 16; float f[8];
              unpack8(*(const u32x4*)up, f);
#pragma unroll
              for (int j = 0; j < 8; ++j) ub[p * 16 + j] = f[j];
              unpack8(*(const u32x4*)(up + 8), f);
#pragma unroll
              for (int j = 0; j < 8; ++j) ub[p * 16 + 8 + j] = f[j]; }
            __syncthreads();
            for (int tt = 0; tt < 64; ++tt) {
                const int t = d ? 63 - tt : tt;
                float bur = 0.f, bui = 0.f;
#pragma unroll
                for (int h4 = 0; h4 < 4; ++h4) { const f32x4 u = *(const LAS f32x4*)(ub + t * 16 + h4 * 4);
#pragma unroll
                    for (int j = 0; j < 4; ++j) { bur += bbr[h4 * 4 + j] * u[j]; bui += bbi[h4 * 4 + j] * u[j]; } }
                const float nxr = lbr * xr - lbi * xi + bur, nxi = lbr * xi + lbi * xr + bui;
                xr = nxr; xi = nxi;
                xb[par * 128 + p] = xr; xb[par * 128 + 64 + p] = xi;
                __syncthreads();
                float y = 0.f;
#pragma unroll
                for (int j4 = 0; j4 < 4; ++j4) { const f32x4 vr = *(const LAS f32x4*)(xb + par * 128 + pt * 16 + j4 * 4), vi = *(const LAS f32x4*)(xb + par * 128 + 64 + pt * 16 + j4 * 4);
#pragma unroll
                    for (int j = 0; j < 4; ++j) y += cr[j4 * 4 + j] * vr[j] - ci[j4 * 4 + j] * vi[j]; }
                y += shx(y, 16, p); y += shx(y, 32, p);
                if (p < 16) yb[t * 16 + p] = y;
                par ^= 1;
            }
            __syncthreads();
            { u32x4 w0, w1; const LAS float* ys = yb + p * 16;
              w0.x = pg8::cvt_pk_bf16(ys[0], ys[1]); w0.y = pg8::cvt_pk_bf16(ys[2], ys[3]); w0.z = pg8::cvt_pk_bf16(ys[4], ys[5]); w0.w = pg8::cvt_pk_bf16(ys[6], ys[7]);
              w1.x = pg8::cvt_pk_bf16(ys[8], ys[9]); w1.y = pg8::cvt_pk_bf16(ys[10], ys[11]); w1.z = pg8::cvt_pk_bf16(ys[12], ys[13]); w1.w = pg8::cvt_pk_bf16(ys[14], ys[15]);
              bf16_t* yp = Y + (size_t)(row0 + p) * 1024 + g * 16; *(u32x4*)yp = w0; *(u32x4*)(yp + 8) = w1; }
        }
        __syncthreads();
    }
}
DI void ph_s5_post(const Args& a, int l, bf16_t* YF, const bf16_t* YB, const bf16_t* U) {
    const float* dsk = a.in[I_SD] + l * 1024;
    for (size_t i = (size_t)blockIdx.x * NT + ltid(a); i < (size_t)MROWS * 128; i += (size_t)gridDim.x * NT) {
        const size_t off = i * 8; const int c = (int)(off & 1023);
        float f[8], bq[8], u[8]; unpack8(*(const u32x4*)(YF + off), f); unpack8(*(const u32x4*)(YB + off), bq); unpack8(*(const u32x4*)(U + off), u);
        const f32x4 d0 = *(const f32x4*)(dsk + c), d1 = *(const f32x4*)(dsk + c + 4);
        float o[8];
#pragma unroll
        for (int j = 0; j < 4; ++j) { o[j] = gelu_tanh_(f[j] + bq[j] + d0[j] * u[j]); o[4 + j] = gelu_tanh_(f[4 + j] + bq[4 + j] + d1[j] * u[4 + j]); }
        u32x4 w; w.x = pg8::cvt_pk_bf16(o[0], o[1]); w.y = pg8::cvt_pk_bf16(o[2], o[3]); w.z = pg8::cvt_pk_bf16(o[4], o[5]); w.w = pg8::cvt_pk_bf16(o[6], o[7]);
        *(u32x4*)(YF + off) = w;
    }
}

constexpr int S5_T = 16, S5_NCH = MROWS / S5_T  , S5_RG = 2304, S5_PMG = S5_RG / 256;
constexpr size_t SZ_AX = (size_t)64 * S5_RG * 512 * 2, SZ_CW1 = (size_t)64 * 256 * 256 * 2, SZ_CW2 = (size_t)64 * 256 * 512 * 2;
constexpr size_t R5_AX = 0, R5_SZ = SZ_AX, R5_G1 = R5_SZ + SZ_ACT, R5_GLUA = R5_G1 + SZ_ACT, R5_END = R5_GLUA + SZ_ACT;
static_assert(WS_R + R5_END <= WS_END, "S5 stage layout fits the workspace"); static_assert(WS_END <= (size_t)512 * 1024 * 1024, "workspace budget");
static_assert(SZ_CW1 + SZ_CW2 <= SZ_ACT, "S5 constants live in the H region once the last projection from H is done");

struct EpiS1 {
    static constexpr bool PERM = true, AFTER_DRAIN = false;
    bf16_t* AX; bf16_t* SZ; bf16_t* G1;
    __device__ __forceinline__ void operator()(const f32x4 (&acc)[2][2][4][2], const Unit& u, int wr, int wc, int fr, int fq) const {
        const int row0 = u.pm * 256 + wr * 64 + fr, seg = u.pn >> 2;
        const int col0 = (u.pn & 3) * 256 + wc * 32 + 8 * fq;
#pragma unroll
        for (int ai = 0; ai < 2; ++ai)
#pragma unroll
            for (int m = 0; m < 4; ++m) {
                const int r = row0 + ai * 128 + m * 16;
#pragma unroll
                for (int bj = 0; bj < 2; ++bj) {
                    f32x4 v0 = acc[ai][bj][m][0], v1 = acc[ai][bj][m][1];
                    const int c = col0 + bj * 128;
                    bf16_t* dp;
                    if (seg == 0) dp = AX + ((size_t)(c >> 4) * S5_RG + (r >> 4)) * 512 + (r & 15) * 16 + (c & 15);
                    else if (seg == 1) { dp = SZ + (size_t)r * 1024 + c;
#pragma unroll
                        for (int j = 0; j < 4; ++j) { v0[j] = siluf_(v0[j]); v1[j] = siluf_(v1[j]); } }
                    else { dp = G1 + (size_t)r * 1024 + c;
#pragma unroll
                        for (int j = 0; j < 4; ++j) { v0[j] = sigmoidf_(v0[j]); v1[j] = sigmoidf_(v1[j]); } }
                    u32x4 w; w.x = pg8::cvt_pk_bf16(v0[0], v0[1]); w.y = pg8::cvt_pk_bf16(v0[2], v0[3]); w.z = pg8::cvt_pk_bf16(v1[0], v1[1]); w.w = pg8::cvt_pk_bf16(v1[2], v1[3]);
                    *(u32x4*)dp = w;
                }
            }
    }
};
struct EpiS5L {
    static constexpr bool PERM = true, AFTER_DRAIN = false;
    bf16_t* AX;
    __device__ __forceinline__ void operator()(const f32x4 (&acc)[2][2][4][2], const Unit& u, int wr, int wc, int fr, int fq) const {
        const int g = u.pm / S5_PMG, rg0 = (u.pm % S5_PMG) * 256 + wr * 64 + fr, col0 = wc * 32 + 8 * fq;
#pragma unroll
        for (int ai = 0; ai < 2; ++ai)
#pragma unroll
            for (int m = 0; m < 4; ++m) {
                const int rg = rg0 + ai * 128 + m * 16;
                if (rg < S5_NCH) {
                    bf16_t* rp = AX + ((size_t)g * S5_RG + rg) * 512 + 256 + col0;
#pragma unroll
                    for (int bj = 0; bj < 2; ++bj) { const f32x4 v0 = acc[ai][bj][m][0], v1 = acc[ai][bj][m][1];
                        u32x4 w; w.x = pg8::cvt_pk_bf16(v0[0], v0[1]); w.y = pg8::cvt_pk_bf16(v0[2], v0[3]); w.z = pg8::cvt_pk_bf16(v1[0], v1[1]); w.w = pg8::cvt_pk_bf16(v1[2], v1[3]);
                        *(u32x4*)(rp + bj * 128) = w; }
                }
            }
    }
};
struct EpiS5Y {
    static constexpr bool PERM = true, AFTER_DRAIN = false;
    const bf16_t* AX; bf16_t* GLUA; const float* dsk;
    __device__ __forceinline__ void operator()(const f32x4 (&acc)[2][2][4][2], const Unit& u, int wr, int wc, int fr, int fq) const {
        const int g = u.pm / S5_PMG, rg0 = (u.pm % S5_PMG) * 256 + wr * 64 + fr, col0 = wc * 32 + 8 * fq;
        const int h0 = col0 & 15;
        const f32x4 d0 = *(const f32x4*)(dsk + g * 16 + h0), d1 = *(const f32x4*)(dsk + g * 16 + h0 + 4);
#pragma unroll
        for (int ai = 0; ai < 2; ++ai)
#pragma unroll
            for (int m = 0; m < 4; ++m) {
                const int rg = rg0 + ai * 128 + m * 16;
                if (rg < S5_NCH) {
#pragma unroll
                    for (int bj = 0; bj < 2; ++bj) {
                        const int c = col0 + bj * 128, t = c >> 4;
                        float uu[8]; unpack8(*(const u32x4*)(AX + ((size_t)g * S5_RG + rg) * 512 + c), uu);
                        const f32x4 v0 = acc[ai][bj][m][0], v1 = acc[ai][bj][m][1];
                        float o[8];
#pragma unroll
                        for (int j = 0; j < 4; ++j) { o[j] = gelu_tanh_(v0[j] + d0[j] * uu[j]); o[4 + j] = gelu_tanh_(v1[j] + d1[j] * uu[4 + j]); }
                        u32x4 w; w.x = pg8::cvt_pk_bf16(o[0], o[1]); w.y = pg8::cvt_pk_bf16(o[2], o[3]); w.z = pg8::cvt_pk_bf16(o[4], o[5]); w.w = pg8::cvt_pk_bf16(o[6], o[7]);
                        *(u32x4*)(GLUA + (size_t)(rg * 16 + t) * 1024 + g * 16 + h0) = w;
                    }
                }
            }
    }
};
DI void ph_s5_consts(const Args& a, int l, bf16_t* CW1, bf16_t* CW2, LAS unsigned char* lds) {
    LAS float* POW = (LAS float*)lds;
    LAS float* BB = POW + 2 * 17 * 64 * 2;
    LAS float* CC = BB + 2 * 64 * 16 * 2;
    LAS float* KT = CC + 16 * 64 * 2;
    const int tid = ltid(a);
    for (int g = blockIdx.x; g < 64; g += gridDim.x) {
        __syncthreads();
        for (int i = tid; i < 2 * 17 * 64; i += NT) {
            const int p = i & 63, j = (i >> 6) % 17, d = i / (17 * 64);
            const float stp = expf(a.in[I_SLOG][(l * 2 + d) * 64 + g]);
            const float lre = a.in[I_SLRE][((size_t)(l * 2 + d) * 64 + g) * 64 + p], lim = a.in[I_SLIM][((size_t)(l * 2 + d) * 64 + g) * 64 + p];
            const float mag = expf((float)j * lre * stp), ang = (float)j * (lim * stp);
            POW[i * 2] = mag * cosf(ang); POW[i * 2 + 1] = mag * sinf(ang);
        }
        for (int i = tid; i < 16 * 64; i += NT) { const int p = i & 63, h = i >> 6;
            CC[i * 2] = a.in[I_SCRE][(((size_t)l * 64 + g) * 16 + h) * 64 + p]; CC[i * 2 + 1] = a.in[I_SCIM][(((size_t)l * 64 + g) * 16 + h) * 64 + p]; }
        __syncthreads();
        for (int i = tid; i < 2 * 64 * 16; i += NT) {
            const int h = i & 15, p = (i >> 4) & 63, d = i >> 10;
            const float stp = expf(a.in[I_SLOG][(l * 2 + d) * 64 + g]);
            const float lre = a.in[I_SLRE][((size_t)(l * 2 + d) * 64 + g) * 64 + p], lim = a.in[I_SLIM][((size_t)(l * 2 + d) * 64 + g) * 64 + p];
            const float lbr = POW[((d * 17 + 1) * 64 + p) * 2], lbi = POW[((d * 17 + 1) * 64 + p) * 2 + 1];
            const float dnm = lre * lre + lim * lim;
            const float fre = ((lbr - 1.0f) * lre + lbi * lim) / dnm, fim = (lbi * lre - (lbr - 1.0f) * lim) / dnm;
            const float br = a.in[I_SBRE][(((size_t)l * 64 + g) * 64 + p) * 16 + h], bi = a.in[I_SBIM][(((size_t)l * 64 + g) * 64 + p) * 16 + h];
            BB[i * 2] = fre * br - fim * bi; BB[i * 2 + 1] = fre * bi + fim * br;
        }
        __syncthreads();
        for (int i = tid; i < 2 * 16 * 256; i += NT) {
            const int hp = i & 15, h = (i >> 4) & 15, tau = (i >> 8) & 15, d = i >> 12;
            float s = 0.f;
            for (int p = 0; p < 64; ++p) {
                const float cr = CC[(h * 64 + p) * 2], ci = CC[(h * 64 + p) * 2 + 1];
                const float pr = POW[((d * 17 + tau) * 64 + p) * 2], pi = POW[((d * 17 + tau) * 64 + p) * 2 + 1];
                const float br = BB[((d * 64 + p) * 16 + hp) * 2], bi = BB[((d * 64 + p) * 16 + hp) * 2 + 1];
                const float gr = cr * pr - ci * pi, gi = cr * pi + ci * pr;
                s += gr * br - gi * bi;
            }
            KT[i] = s;
        }
        __syncthreads();
        bf16_t* c1 = CW1 + (size_t)g * 65536;
        for (int i = tid; i < 65536 / 2; i += NT) {
            const int k = (i * 2) & 255, n = (i * 2) >> 8; const int p = n & 63, ri = (n >> 6) & 1, d = n >> 7, s = k >> 4, hp = k & 15;
            const int j = d ? s : 15 - s;
            const float pr = POW[((d * 17 + j) * 64 + p) * 2], pi = POW[((d * 17 + j) * 64 + p) * 2 + 1];
            float o[2];
#pragma unroll
            for (int q = 0; q < 2; ++q) { const float br = BB[((d * 64 + p) * 16 + hp + q) * 2], bi = BB[((d * 64 + p) * 16 + hp + q) * 2 + 1]; o[q] = ri ? (pr * bi + pi * br) : (pr * br - pi * bi); }
            *(unsigned*)(c1 + (size_t)n * 256 + k) = pg8::cvt_pk_bf16(o[0], o[1]);
        }
        bf16_t* c2 = CW2 + (size_t)g * 131072;
        for (int i = tid; i < 131072 / 2; i += NT) {
            const int k = (i * 2) & 511, n = (i * 2) >> 9; const int t = n >> 4, h = n & 15;
            float o[2];
            if (k < 256) { const int s = k >> 4, hp = k & 15;
#pragma unroll
                for (int q = 0; q < 2; ++q) { float v = 0.f; if (s <= t) v += KT[((0 * 16 + (t - s)) * 16 + h) * 16 + hp + q]; if (s >= t) v += KT[((1 * 16 + (s - t)) * 16 + h) * 16 + hp + q]; o[q] = v; } }
            else { const int kk = k - 256, d = kk >> 7, ri = (kk >> 6) & 1; const int j = d ? 16 - t : t + 1;
#pragma unroll
                for (int q = 0; q < 2; ++q) { const int p = (kk & 63) + q; const float cr = CC[(h * 64 + p) * 2], ci = CC[(h * 64 + p) * 2 + 1];
                    const float pr = POW[((d * 17 + j) * 64 + p) * 2], pi = POW[((d * 17 + j) * 64 + p) * 2 + 1];
                    o[q] = ri ? -(cr * pi + ci * pr) : (cr * pr - ci * pi); } }
            *(unsigned*)(c2 + (size_t)n * 512 + k) = pg8::cvt_pk_bf16(o[0], o[1]);
        }
    }
    __syncthreads();
}
DI void ph_s5_carry(const Args& a, int l, bf16_t* AX) {
    const int tid = ltid(a), w = tid >> 6, p = tid & 63;
    for (int unit = blockIdx.x * 8 + w; unit < 1024; unit += gridDim.x * 8) {
        const int d = unit & 1, g = (unit >> 1) & 63, b = unit >> 7;
        const float stp = expf(a.in[I_SLOG][(l * 2 + d) * 64 + g]);
        const float lre = a.in[I_SLRE][((size_t)(l * 2 + d) * 64 + g) * 64 + p], lim = a.in[I_SLIM][((size_t)(l * 2 + d) * 64 + g) * 64 + p];
        const float mag = expf(16.0f * lre * stp), ang = 16.0f * (lim * stp);
        const float ar = mag * cosf(ang), ai = mag * sinf(ang);
        bf16_t* base = AX + (size_t)g * S5_RG * 512 + 256 + d * 128 + p;
        float xr = 0.f, xi = 0.f;
        for (int c0 = 0; c0 < 272; c0 += 16) {
            float lr[16], li[16];
#pragma unroll
            for (int q = 0; q < 16; ++q) { const int st = c0 + q; const int cc = (st < 16) ? (d ? 15 - st : st) : (d ? 271 - st : st - 16);
                const int row = (st < 16) ? b * 16 + cc : 128 + b * 256 + cc;
                lr[q] = bf2f(base[(size_t)row * 512]); li[q] = bf2f(base[(size_t)row * 512 + 64]); }
#pragma unroll
            for (int q = 0; q < 16; ++q) { const int st = c0 + q; const int cc = (st < 16) ? (d ? 15 - st : st) : (d ? 271 - st : st - 16);
                const int row = (st < 16) ? b * 16 + cc : 128 + b * 256 + cc;
                base[(size_t)row * 512] = f2bf(xr); base[(size_t)row * 512 + 64] = f2bf(xi);
                const float nr = ar * xr - ai * xi + lr[q], ni = ar * xi + ai * xr + li[q]; xr = nr; xi = ni; }
        }
    }
}

typedef short bf16x8v __attribute__((ext_vector_type(8)));
typedef short s16x4v __attribute__((ext_vector_type(4)));
typedef __bf16 bfx2_t __attribute__((ext_vector_type(2)));
typedef float f32x2_t __attribute__((ext_vector_type(2)));
#define MFMA16(a_, b_, c_) __builtin_amdgcn_mfma_f32_16x16x32_bf16((a_), (b_), (c_), 0, 0, 0)
DI unsigned pk2(float lo, float hi) { const bfx2_t v = __builtin_convertvector((f32x2_t){lo, hi}, bfx2_t); return __builtin_bit_cast(unsigned, v); }
DI int sw512(int r, int cb) { return r * 512 + (cb ^ ((r & 15) << 4)); }
DI int sw128(int r, int cb) { return r * 128 + (cb ^ ((r & 7) << 4)); }
DI bf16x8v ldsfrag(LAS unsigned char* base, int off) { return *(const LAS bf16x8v*)(base + off); }
DI bf16x8v ldsfrag2(LAS unsigned char* base, int off0, int off1) { const s16x4v lo = *(const LAS s16x4v*)(base + off0), hi = *(const LAS s16x4v*)(base + off1); return __builtin_shufflevector(lo, hi, 0, 1, 2, 3, 4, 5, 6, 7); }
constexpr int ML_GSET = 448;
DI void ml_gates(float igr, float fgr, float ibias, float fbias, int d, float& ms, LAS float* gs, int L) {
    const int t = d ? 63 - L : L;
    const float ipv = igr + ibias, lfv = -softplusf_(-(fgr + fbias));
    float bc = lfv;
#pragma unroll
    for (int o = 1; o < 64; o <<= 1) { const float x = shup(bc, o, L); if (L >= o) bc += x; }
    const float aj = ipv - bc;
    float cm = aj;
#pragma unroll
    for (int o = 1; o < 64; o <<= 1) { const float x = shup(cm, o, L); if (L >= o) cm = fmaxf(cm, x); }
    const float mt = fmaxf(bc + ms, bc + cm);
    const float bend = shidx(bc, 63);
    const float le = bend - bc + ipv;
    float mle = le;
#pragma unroll
    for (int o = 32; o >= 1; o >>= 1) mle = fmaxf(mle, shx(mle, o, L));
    const float mnew = fmaxf(bend + ms, mle);
    gs[t] = bc; gs[64 + t] = aj; gs[128 + t] = mt; gs[192 + t] = __expf(bc + ms - mt); gs[256 + t] = __expf(-mt); gs[320 + t] = __expf(le - mnew) * 0.0625f;
    if (L == 0) gs[384] = __expf(bend + ms - mnew);
    ms = mnew;
}
DI bf16x8v ldstr2(LAS unsigned char* p0, LAS unsigned char* p1) {
    const s16x4v lo = __builtin_amdgcn_ds_read_tr16_b64_v4i16((LAS s16x4v*)p0), hi = __builtin_amdgcn_ds_read_tr16_b64_v4i16((LAS s16x4v*)p1);
    return __builtin_shufflevector(lo, hi, 0, 1, 2, 3, 4, 5, 6, 7); }
DI void ph_ml_scan_mfma(const Args& a, int l, const bf16_t* Q, const bf16_t* K, const bf16_t* V, const float* GATE, bf16_t* HF, bf16_t* HB, LAS unsigned char* lds) {
    constexpr int PQ = 528, PK = 544, PV = 288, PW = 144;
    LAS unsigned char* qs = lds;
    LAS unsigned char* kn = lds + 33792;
    LAS unsigned char* vn = lds + 68608;
    LAS unsigned char* vs = lds + 87040;
    LAS unsigned char* Wm = lds + 105472;
    LAS float* sm = (LAS float*)(lds + 114688);
    LAS float* rsW = sm + 2 * ML_GSET; LAS float* qn = rsW + 128; LAS float* nvec = qn + 64;
    const int tid = ltid(a), w = tid >> 6, ln = tid & 63, l16 = ln & 15, h4 = ln >> 4, tq = (ln & 15) >> 2, tp = ln & 3;
    for (int unit = blockIdx.x; unit < 128; unit += gridDim.x) {
        const int eh = unit & 1, d = (unit >> 1) & 1, hd = (unit >> 2) & 3, b = unit >> 4;
        const float ibias = a.in[I_MIB][(l * 2 + d) * 4 + hd], fbias = a.in[I_MFB][(l * 2 + d) * 4 + hd];
        bf16_t* HO = d ? HB : HF;
        f32x4 Cacc[16];
#pragma unroll
        for (int i = 0; i < 16; ++i) Cacc[i] = (f32x4){0.f, 0.f, 0.f, 0.f};
        float ms = 0.f;
        __syncthreads();
        if (tid < 256) nvec[tid] = 0.f;
#define ML_ROW0(step) (((step) < 4) ? b * 256 + (d ? 3 - (step) : (step)) * 64 : CTXROWS + b * 4096 + (d ? 67 - (step) : (step) - 4) * 64)
        u32x4 pq[4], pk[4], pv[2]; float gi = 0.f, gf = 0.f;
        { const int row0 = ML_ROW0(0);
#pragma unroll
          for (int q = 0; q < 4; ++q) { const int p = tid + 512 * q, r = p >> 5, c8 = p & 31; pq[q] = *(const u32x4*)(Q + (size_t)(row0 + r) * 1024 + hd * 256 + c8 * 8); pk[q] = *(const u32x4*)(K + (size_t)(row0 + r) * 1024 + hd * 256 + c8 * 8); }
#pragma unroll
          for (int q = 0; q < 2; ++q) { const int p = tid + 512 * q, r = p >> 4, c8 = p & 15; pv[q] = *(const u32x4*)(V + (size_t)(row0 + r) * 1024 + hd * 256 + eh * 128 + c8 * 8); }
          if (w == 0) { const int t = d ? 63 - ln : ln; const float* gp = GATE + (size_t)(row0 + t) * 32; gi = gp[d * 4 + hd]; gf = gp[8 + d * 4 + hd]; ml_gates(gi, gf, ibias, fbias, d, ms, sm, ln); } }
        __syncthreads();
        for (int step = 0; step < 68; ++step) {
            const int par = step & 1; LAS float* gs = sm + par * ML_GSET;
            const int row0 = ML_ROW0(step);
#pragma unroll
            for (int q = 0; q < 4; ++q) { const int p = tid + 512 * q, r = p >> 5, c8 = p & 31;
                *(LAS u32x4*)(qs + r * PQ + c8 * 16) = pq[q]; *(LAS u32x4*)(kn + r * PK + c8 * 16) = pk[q]; }
#pragma unroll
            for (int q = 0; q < 2; ++q) { const int p = tid + 512 * q, r = p >> 4, c8 = p & 15;
                *(LAS u32x4*)(vn + r * PV + c8 * 16) = pv[q];
                float f[8]; unpack8(pv[q], f); const float ws = gs[320 + r];
                u32x4 o; o.x = pk2(f[0] * ws, f[1] * ws); o.y = pk2(f[2] * ws, f[3] * ws); o.z = pk2(f[4] * ws, f[5] * ws); o.w = pk2(f[6] * ws, f[7] * ws);
                *(LAS u32x4*)(vs + r * PV + c8 * 16) = o; }
            if (step + 1 < 68) { const int rown = ML_ROW0(step + 1);
#pragma unroll
                for (int q = 0; q < 4; ++q) { const int p = tid + 512 * q, r = p >> 5, c8 = p & 31; pq[q] = *(const u32x4*)(Q + (size_t)(rown + r) * 1024 + hd * 256 + c8 * 8); pk[q] = *(const u32x4*)(K + (size_t)(rown + r) * 1024 + hd * 256 + c8 * 8); }
#pragma unroll
                for (int q = 0; q < 2; ++q) { const int p = tid + 512 * q, r = p >> 4, c8 = p & 15; pv[q] = *(const u32x4*)(V + (size_t)(rown + r) * 1024 + hd * 256 + eh * 128 + c8 * 8); }
                if (w == 0) { const int t = d ? 63 - ln : ln; const float* gp = GATE + (size_t)(rown + t) * 32; gi = gp[d * 4 + hd]; gf = gp[8 + d * 4 + hd]; } }
            __syncthreads();
            { const int it = w >> 1, jp = w & 1, i = it * 16 + l16;
              f32x4 a0 = (f32x4){0.f, 0.f, 0.f, 0.f}, a1 = a0;
              LAS unsigned char* qb = qs + (it * 16 + l16) * PQ + h4 * 16; LAS unsigned char* kb = kn + ((2 * jp) * 16 + l16) * PK + h4 * 16;
#pragma unroll
              for (int ks = 0; ks < 8; ++ks) {
                  const bf16x8v bq = ldsfrag(qb, ks * 64);
                  const bf16x8v k0 = ldsfrag(kb, ks * 64), k1 = ldsfrag(kb, 16 * PK + ks * 64);
                  a0 = MFMA16(k0, bq, a0); a1 = MFMA16(k1, bq, a1); }
              const float bci = gs[i], mti = gs[128 + i];
              float rs = 0.f;
#pragma unroll
              for (int t2 = 0; t2 < 2; ++t2) { const int j0 = (2 * jp + t2) * 16 + 4 * h4; const f32x4 ajv = *(const LAS f32x4*)(gs + 64 + j0); const f32x4 av = t2 ? a1 : a0;
                  float wv[4];
#pragma unroll
                  for (int r = 0; r < 4; ++r) { const int j = j0 + r; const bool valid = d ? (j >= i) : (j <= i); const float e = __expf(bci + ajv[r] - mti) * av[r] * 0.0625f; wv[r] = valid ? e : 0.f; rs += wv[r]; }
                  u32x2 pw; pw.x = pk2(wv[0], wv[1]); pw.y = pk2(wv[2], wv[3]);
                  *(LAS u32x2*)(Wm + i * PW + j0 * 2) = pw; }
              rs += shx(rs, 16, ln); rs += shx(rs, 32, ln);
              if (h4 == 0) rsW[jp * 64 + i] = rs;
              const f32x4 nv = *(const LAS f32x4*)(nvec + 4 * ln);
#pragma unroll
              for (int rr = 0; rr < 8; ++rr) { const int ir = 8 * w + rr; const u32x2 qw = *(const LAS u32x2*)(qs + ir * PQ + 8 * ln);
                  float s = bflo(qw.x) * nv[0] + bfhi(qw.x) * nv[1] + bflo(qw.y) * nv[2] + bfhi(qw.y) * nv[3];
                  s = wave_sum(s, ln); if (ln == 0) qn[ir] = s; } }
            __syncthreads();
            { f32x4 num[4];
#pragma unroll
              for (int it = 0; it < 4; ++it) num[it] = (f32x4){0.f, 0.f, 0.f, 0.f};
              LAS unsigned char* qb2 = qs + l16 * PQ + 8 * h4;
#pragma unroll
              for (int ks = 0; ks < 8; ++ks) {
                  u32x4 bw; bw.x = pk2(Cacc[2 * ks][0], Cacc[2 * ks][1]); bw.y = pk2(Cacc[2 * ks][2], Cacc[2 * ks][3]); bw.z = pk2(Cacc[2 * ks + 1][0], Cacc[2 * ks + 1][1]); bw.w = pk2(Cacc[2 * ks + 1][2], Cacc[2 * ks + 1][3]);
                  const bf16x8v bfr = __builtin_bit_cast(bf16x8v, bw);
#pragma unroll
                  for (int it = 0; it < 4; ++it) { const bf16x8v af = ldsfrag2(qb2, it * 16 * PQ + 64 * ks, it * 16 * PQ + 64 * ks + 32); num[it] = MFMA16(af, bfr, num[it]); } asm volatile("" ::: "memory"); }
#pragma unroll
              for (int it = 0; it < 4; ++it) { const f32x4 wi = *(const LAS f32x4*)(gs + 192 + it * 16 + 4 * h4); num[it] = num[it] * wi; }
              LAS unsigned char* trb = (LAS unsigned char*)0 + (8 * h4 + tq) * PV + 8 * tp + 32 * w;
              bf16x8v bv[2];
#pragma unroll
              for (int kk = 0; kk < 2; ++kk) bv[kk] = ldstr2(vn + (size_t)trb + (32 * kk) * PV, vn + (size_t)trb + (32 * kk + 4) * PV);
              LAS unsigned char* wb = Wm + l16 * PW + 16 * h4;
#pragma unroll
              for (int kk = 0; kk < 2; ++kk)
#pragma unroll
                  for (int it = 0; it < 4; ++it) { const bf16x8v aw = ldsfrag(wb, it * 16 * PW + 64 * kk); num[it] = MFMA16(aw, bv[kk], num[it]); }
              asm volatile("" ::: "memory");
#pragma unroll
              for (int it = 0; it < 4; ++it) { const int i0 = it * 16 + 4 * h4;
                  const f32x4 r0 = *(const LAS f32x4*)(rsW + i0), r1 = *(const LAS f32x4*)(rsW + 64 + i0), wi = *(const LAS f32x4*)(gs + 192 + i0), qv = *(const LAS f32x4*)(qn + i0), nr = *(const LAS f32x4*)(gs + 256 + i0);
#pragma unroll
                  for (int r = 0; r < 4; ++r) { const float den = r0[r] + r1[r] + wi[r] * qv[r]; const float hv = num[it][r] / fmaxf(fabsf(den), nr[r]);
                      HO[(size_t)(row0 + i0 + r) * 1024 + hd * 256 + eh * 128 + 16 * w + l16] = (bf16_t)(pk2(hv, 0.f) & 0xffffu); } asm volatile("" ::: "memory"); }
              const float decay = gs[384];
              bf16x8v bs[2];
#pragma unroll
              for (int kk = 0; kk < 2; ++kk) bs[kk] = ldstr2(vs + (size_t)trb + (32 * kk) * PV, vs + (size_t)trb + (32 * kk + 4) * PV);
#pragma unroll
              for (int dt = 0; dt < 16; ++dt) Cacc[dt] = Cacc[dt] * decay;
              LAS unsigned char* ktb = kn + (8 * h4 + tq) * PK + 8 * tp;
#pragma unroll
              for (int kk = 0; kk < 2; ++kk)
#pragma unroll
                  for (int dt = 0; dt < 16; ++dt) { const bf16x8v ak = ldstr2(ktb + (32 * kk) * PK + 32 * dt, ktb + (32 * kk + 4) * PK + 32 * dt); Cacc[dt] = MFMA16(ak, bs[kk], Cacc[dt]); if ((dt & 1) == 1) asm volatile("" ::: "memory"); }
              if (tid < 256) { float s = 0.f;
#pragma unroll 8
                  for (int j = 0; j < 64; ++j) s += gs[320 + j] * bf2f(*(const LAS bf16_t*)(kn + j * PK + 2 * tid));
                  nvec[tid] = decay * nvec[tid] + s; }
              if (w == 0 && step + 1 < 68) ml_gates(gi, gf, ibias, fbias, d, ms, sm + (par ^ 1) * ML_GSET, ln); }
            __syncthreads();
        }
#undef ML_ROW0
    }
}

#define MFMA16K16(a_, b_, c_) __builtin_amdgcn_mfma_f32_16x16x16bf16_1k((a_), (b_), (c_), 0, 0, 0)
DI s16x4v pack4(const f32x4 v) { u32x2 w; w.x = pk2(v[0], v[1]); w.y = pk2(v[2], v[3]); return __builtin_bit_cast(s16x4v, w); }
DI s16x4v lds8(LAS unsigned char* p) { return *(const LAS s16x4v*)p; }
DI s16x4v ldstr1(LAS unsigned char* p) { return __builtin_amdgcn_ds_read_tr16_b64_v4i16((LAS s16x4v*)p); }
constexpr int GD_GSET = 384;
DI void gdn_gates(float araw, float braw, float nea, float dtb, LAS float* gs, int L, int d) {
    const int t = d ? 63 - L : L;
    float gc = nea * softplusf_(araw + dtb);
#pragma unroll
    for (int o = 1; o < 64; o <<= 1) { const float x = shup(gc, o, L); if (L >= o) gc += x; }
    const float gl = shidx(gc, 63);
    gs[t] = gc; gs[64 + t] = sigmoidf_(braw); gs[128 + t] = __expf(gc); gs[192 + t] = __expf(gl - gc);
    if (L == 0) gs[256] = __expf(gl);
}
DI void ph_gdn_scan_mfma(const Args& a, int l, const bf16_t* Q, const bf16_t* K, const bf16_t* V, const float* GATE, bf16_t* OF, bf16_t* OB, LAS unsigned char* lds) {
    constexpr int PQ = 272, PK = 288, PV = 288, PA = 144, PD = 48;
    LAS unsigned char* qh = lds;
    LAS unsigned char* kh = lds + 17408;
    LAS unsigned char* vv = lds + 35840;
    LAS unsigned char* AM = lds + 54272;
    LAS unsigned char* QM = lds + 63488;
    LAS unsigned char* DINV = lds + 72704;
    LAS float* sm = (LAS float*)(lds + 75776);
    const int tid = ltid(a), w = tid >> 6, ln = tid & 63, l16 = ln & 15, h4 = ln >> 4, tq = (ln & 15) >> 2, tp = ln & 3;
    for (int unit = blockIdx.x; unit < 128; unit += gridDim.x) {
        const int d = unit & 1, h = (unit >> 1) & 7, b = unit >> 4;
        const float nea = -__expf(a.in[I_GALOG][(l * 2 + d) * 8 + h]), dtb = a.in[I_GDTB][(l * 2 + d) * 8 + h];
        bf16_t* O = d ? OB : OF;
        f32x4 S[8];
#pragma unroll
        for (int i = 0; i < 8; ++i) S[i] = (f32x4){0.f, 0.f, 0.f, 0.f};
#define GD_ROW0(step) (((step) < 4) ? b * 256 + (d ? 3 - (step) : (step)) * 64 : CTXROWS + b * 4096 + (d ? 67 - (step) : (step) - 4) * 64)
        u32x4 pq[2], pk[2], pv[2]; float ga = 0.f, gb = 0.f;
        __syncthreads();
        { const int row0 = GD_ROW0(0);
#pragma unroll
          for (int q = 0; q < 2; ++q) { const int p = tid + 512 * q, r = p >> 4, c8 = p & 15; const size_t go = (size_t)(row0 + r) * 1024 + h * 128 + c8 * 8;
              pq[q] = *(const u32x4*)(Q + go); pk[q] = *(const u32x4*)(K + go); pv[q] = *(const u32x4*)(V + go); }
          if (w == 0) { const int t = d ? 63 - ln : ln; const float* gp = GATE + (size_t)(row0 + t) * 32; ga = gp[d * 8 + h]; gb = gp[16 + d * 8 + h]; gdn_gates(ga, gb, nea, dtb, sm, ln, d); } }
        __syncthreads();
        for (int step = 0; step < 68; ++step) {
            const int par = step & 1; LAS float* gs = sm + par * GD_GSET;
            const int row0 = GD_ROW0(step);
#pragma unroll
            for (int q = 0; q < 2; ++q) { const int p = tid + 512 * q, r = p >> 4, c8 = p & 15;
                *(LAS u32x4*)(qh + r * PQ + c8 * 16) = pq[q]; *(LAS u32x4*)(kh + r * PK + c8 * 16) = pk[q]; *(LAS u32x4*)(vv + r * PV + c8 * 16) = pv[q]; }
            if (step + 1 < 68) { const int rown = GD_ROW0(step + 1);
#pragma unroll
                for (int q = 0; q < 2; ++q) { const int p = tid + 512 * q, r = p >> 4, c8 = p & 15; const size_t go = (size_t)(rown + r) * 1024 + h * 128 + c8 * 8;
                    pq[q] = *(const u32x4*)(Q + go); pk[q] = *(const u32x4*)(K + go); pv[q] = *(const u32x4*)(V + go); }
                if (w == 0) { const int t = d ? 63 - ln : ln; const float* gp = GATE + (size_t)(rown + t) * 32; ga = gp[d * 8 + h]; gb = gp[16 + d * 8 + h]; } }
            __syncthreads();
            { const int it = w >> 1, jp = w & 1, i = it * 16 + l16;
              f32x4 kk0 = (f32x4){0.f, 0.f, 0.f, 0.f}, kk1 = kk0, qk0 = kk0, qk1 = kk0;
              LAS unsigned char* kb = kh + ((2 * jp) * 16 + l16) * PK + h4 * 16; LAS unsigned char* xk = kh + i * PK + h4 * 16; LAS unsigned char* xq = qh + i * PQ + h4 * 16;
#pragma unroll
              for (int ks = 0; ks < 4; ++ks) { const bf16x8v a0 = ldsfrag(kb, ks * 64), a1 = ldsfrag(kb, 16 * PK + ks * 64), bk = ldsfrag(xk, ks * 64), bq = ldsfrag(xq, ks * 64);
                  kk0 = MFMA16(a0, bk, kk0); kk1 = MFMA16(a1, bk, kk1); qk0 = MFMA16(a0, bq, qk0); qk1 = MFMA16(a1, bq, qk1); }
              const float gci = gs[i], bi = gs[64 + i];
#pragma unroll
              for (int t2 = 0; t2 < 2; ++t2) { const int j0 = (2 * jp + t2) * 16 + 4 * h4; const f32x4 gcj = *(const LAS f32x4*)(gs + j0); const f32x4 kkv = t2 ? kk1 : kk0, qkv = t2 ? qk1 : qk0;
                  float am[4], qm[4];
#pragma unroll
                  for (int r = 0; r < 4; ++r) { const int j = j0 + r; const bool valid = d ? (j >= i) : (j <= i); const float e = __expf(gci - gcj[r]);
                      am[r] = (valid && j != i) ? -bi * kkv[r] * e : 0.f; qm[r] = valid ? qkv[r] * e : 0.f; }
                  u32x2 pa, pm; pa.x = pk2(am[0], am[1]); pa.y = pk2(am[2], am[3]); pm.x = pk2(qm[0], qm[1]); pm.y = pk2(qm[2], qm[3]);
                  *(LAS u32x2*)(AM + i * PA + j0 * 2) = pa; *(LAS u32x2*)(QM + i * PA + j0 * 2) = pm; } }
            __syncthreads();
            if (w == 0) { const int I = ln >> 4, c = ln & 15, cp = d ? 15 - c : c;
                float Dr[16];
                Dr[0] = (cp == 0) ? 1.f : 0.f;
#pragma unroll
                for (int ip = 1; ip < 16; ++ip) { const int r = d ? 15 - ip : ip;
                    LAS unsigned char* rp = AM + (16 * I + r) * PA + (16 * I) * 2;
                    float av[16]; { float f[8]; unpack8(*(const LAS u32x4*)rp, f);
#pragma unroll
                        for (int j = 0; j < 8; ++j) av[j] = f[j];
                        unpack8(*(const LAS u32x4*)(rp + 16), f);
#pragma unroll
                        for (int j = 0; j < 8; ++j) av[8 + j] = f[j]; }
                    float s = (cp == ip) ? 1.f : 0.f;
#pragma unroll
                    for (int jq = 0; jq < ip; ++jq) { const float aval = d ? av[15 - jq] : av[jq]; s += aval * Dr[jq]; }
                    Dr[ip] = s; }
#pragma unroll
                for (int ip = 0; ip < 16; ++ip) { const int r = d ? 15 - ip : ip; *(LAS bf16_t*)(DINV + (16 * I + r) * PD + 2 * c) = (bf16_t)(pk2(Dr[ip], 0.f) & 0xffffu); } }
            s16x4v sf[8];
#pragma unroll
            for (int dt = 0; dt < 8; ++dt) sf[dt] = pack4(S[dt]);
            f32x4 Rt[4], Qs[4];
#pragma unroll
            for (int Tp = 0; Tp < 4; ++Tp) { const int ro = 16 * (d ? 3 - Tp : Tp);
                f32x4 ksv = (f32x4){0.f, 0.f, 0.f, 0.f}, qsv = ksv;
                LAS unsigned char* ka = kh + (ro + l16) * PK + 8 * h4; LAS unsigned char* qa = qh + (ro + l16) * PQ + 8 * h4;
#pragma unroll
                for (int dt = 0; dt < 8; ++dt) { ksv = MFMA16K16(lds8(ka + 32 * dt), sf[dt], ksv); qsv = MFMA16K16(lds8(qa + 32 * dt), sf[dt], qsv); }
                const s16x4v v4 = ldstr1(vv + (ro + 4 * h4 + tq) * PV + (16 * w + 4 * tp) * 2);
                const f32x4 be = *(const LAS f32x4*)(gs + 64 + ro + 4 * h4), eg = *(const LAS f32x4*)(gs + 128 + ro + 4 * h4);
#pragma unroll
                for (int r = 0; r < 4; ++r) { Rt[Tp][r] = be[r] * (bf2f((bf16_t)v4[r]) - eg[r] * ksv[r]); Qs[Tp][r] = eg[r] * qsv[r]; }
                asm volatile("" ::: "memory"); }
            __syncthreads();
            { s16x4v vf[4]; f32x4 vn[4];
#pragma unroll
              for (int Tp = 0; Tp < 4; ++Tp) { const int ro = 16 * (d ? 3 - Tp : Tp);
                  f32x4 X = Rt[Tp];
#pragma unroll
                  for (int Jp = 0; Jp < Tp; ++Jp) { const int co = 16 * (d ? 3 - Jp : Jp); X = MFMA16K16(lds8(AM + (ro + l16) * PA + (co + 4 * h4) * 2), vf[Jp], X); }
                  const s16x4v xf = pack4(X);
                  vn[Tp] = MFMA16K16(lds8(DINV + (ro + l16) * PD + 8 * h4), xf, ((f32x4){0.f, 0.f, 0.f, 0.f}));
                  vf[Tp] = pack4(vn[Tp]); }
#pragma unroll
              for (int Tp = 0; Tp < 4; ++Tp) { const int ro = 16 * (d ? 3 - Tp : Tp);
                  f32x4 o = Qs[Tp];
#pragma unroll
                  for (int Jp = 0; Jp <= Tp; ++Jp) { const int co = 16 * (d ? 3 - Jp : Jp); o = MFMA16K16(lds8(QM + (ro + l16) * PA + (co + 4 * h4) * 2), vf[Jp], o); }
#pragma unroll
                  for (int r = 0; r < 4; ++r) O[(size_t)(row0 + ro + 4 * h4 + r) * 1024 + h * 128 + 16 * w + l16] = (bf16_t)(pk2(o[r], 0.f) & 0xffffu);
                  asm volatile("" ::: "memory"); }
              const float gend = gs[256];
              s16x4v vsf[4];
#pragma unroll
              for (int Jp = 0; Jp < 4; ++Jp) { const int co = 16 * (d ? 3 - Jp : Jp); const f32x4 ee = *(const LAS f32x4*)(gs + 192 + co + 4 * h4); vsf[Jp] = pack4(vn[Jp] * ee); }
#pragma unroll
              for (int dt = 0; dt < 8; ++dt) { S[dt] = S[dt] * gend;
#pragma unroll
                  for (int Jp = 0; Jp < 4; ++Jp) { const int co = 16 * (d ? 3 - Jp : Jp); S[dt] = MFMA16K16(ldstr1(kh + (co + 4 * h4 + tq) * PK + (16 * dt + 4 * tp) * 2), vsf[Jp], S[dt]); }
                  if (dt & 1) asm volatile("" ::: "memory"); } }
            if (w == 0 && step + 1 < 68) gdn_gates(ga, gb, nea, dtb, sm + (par ^ 1) * GD_GSET, ln, d);
            __syncthreads();
        }
#undef GD_ROW0
    }
}

#ifndef DUP_PHASE
#define DUP_PHASE -1
#endif
constexpr int NPH_LAYER = 20, PH_FINAL = 2 + DEPTH * NPH_LAYER, NPHASE = PH_FINAL + 1;
template <class Epi>
DI void run_gemm(int tid, LAS unsigned char* lds, const bf16_t* A, const bf16_t* Bt, int M, int N, const Epi& E) {
    pg8::Gemm g{A, Bt, M, N, 1024, 1024, 1 << 20, 0, tid}; pg8::StaticOrder S; S.init(M, N, (int)gridDim.x, (int)blockIdx.x);
    pg8::gemm_phase<Epi, pg8::StaticOrder, false>(lds, g, S, E, nullptr);
}
template <class Epi>
DI void run_gemm_g(int tid, LAS unsigned char* lds, const bf16_t* A, int lda, int K, const bf16_t* Bt, int M, int N, int pmg, size_t gstride, const Epi& E) {
    pg8::Gemm g{A, Bt, M, N, K, lda, pmg, gstride, tid}; pg8::StaticOrder S; S.init(M, N, (int)gridDim.x, (int)blockIdx.x);
    pg8::gemm_phase<Epi, pg8::StaticOrder, false>(lds, g, S, E, nullptr);
}
__global__ void __launch_bounds__(NT, 2) hy_fwd(Args ka) {
    extern __shared__ __attribute__((aligned(16))) unsigned char lds_raw[];
    LAS unsigned char* lds = (LAS unsigned char*)lds_raw;
    volatile LAS unsigned* xbw = (volatile LAS unsigned*)(lds + 131072);
    if (threadIdx.x < 4) xbw[threadIdx.x] = 0u;
    __syncthreads();
    const int lo = ka.ph_lo, hi = ka.ph_hi;
    const int s_wid = __builtin_amdgcn_readfirstlane((int)(threadIdx.x >> 6));
    XcdBarrier bar; bar.bar = (unsigned*)(ka.ws + WS_CTL); bar.x = 0u; bar.st = xbw; bar.wid = s_wid;
    if (hi - lo > 1) bar = xcd_barrier_post((unsigned*)(ka.ws + WS_CTL), xbw, s_wid);
#ifdef PH_ONLY
#define PHEN(p) ((p) == PH_ONLY)
#else
#define PHEN(p) 1
#endif
#define IN(k) (lo <= (k) && (k) < hi)
#define INL(p) (PHEN(p) && IN(pb + (p)))
#define SEAM(k) do { if (IN((k) + 1)) xcd_barrier(bar); } while (0)
#define PH_LOAD \
    Args a; __builtin_memcpy(&a, args_ptr(), sizeof(Args)); a.wid = s_wid; \
    unsigned char* ws = a.ws; \
    float* MOD = (float*)(ws + WS_MOD); float* XCTX = (float*)(ws + WS_XCTX); \
    bf16_t* H = (bf16_t*)(ws + WS_H); bf16_t* MERGED = (bf16_t*)(ws + WS_MERGED); \
    bf16_t* WB0 = (bf16_t*)(ws + WS_WB0); bf16_t* WB1 = (bf16_t*)(ws + WS_WB1); \
    unsigned char* R = ws + WS_R; \
    bf16_t* P0 = (bf16_t*)(R + R_P0); bf16_t* P1 = (bf16_t*)(R + R_P1); bf16_t* P2 = (bf16_t*)(R + R_P2); bf16_t* OF = (bf16_t*)(R + R_OF); bf16_t* OB = (bf16_t*)(R + R_OB); \
    float* GATE2 = (float*)(R + R_G2); \
    float* GATE1 = (float*)(ws + WS_MERGED); bf16_t* HALO = (bf16_t*)(ws + WS_MERGED + SZ_GATE);     \
    float* MODP = (float*)R; \
    bf16_t* AX = (bf16_t*)(R + R5_AX); bf16_t* SZ5 = (bf16_t*)(R + R5_SZ); bf16_t* G15 = (bf16_t*)(R + R5_G1); bf16_t* GLUA = (bf16_t*)(R + R5_GLUA); bf16_t* YBR = (bf16_t*)R; \
    bf16_t* CW1 = (bf16_t*)(ws + WS_H); bf16_t* CW2 = (bf16_t*)(ws + WS_H + SZ_CW1); \
    const float* xlat_src = l == 0 ? a.in[I_X] : a.out; const float* xctx_src = l == 0 ? a.in[I_CTX] : XCTX; const float* modl = MOD + (size_t)l * 9 * 3072; \
    (void)MOD; (void)XCTX; (void)H; (void)MERGED; (void)WB0; (void)WB1; (void)P0; (void)P1; (void)P2; (void)OF; (void)OB; (void)GATE2; (void)GATE1; (void)HALO; (void)MODP; (void)AX; (void)SZ5; (void)G15; (void)GLUA; (void)YBR; (void)CW1; (void)CW2; (void)xlat_src; (void)xctx_src; (void)modl;
    LAS float* ldsf = (LAS float*)lds;

    { const int l = 0;
    if (PHEN(100) && IN(0)) { PH_LOAD; ph_modp(a, MODP, ldsf); SEAM(0); }
    if (PHEN(101) && IN(1)) { PH_LOAD; ph_mod(a, MODP, MOD); SEAM(1); } }
    for (int l = 0; l < DEPTH; ++l) {
        const int pb = 2 + l * NPH_LAYER;
        if (INL(0)) { PH_LOAD; ph_norm(a, l, xlat_src, xctx_src, modl, H); ph_cvt(wdesc(a, l, 0), WB0, ldsf); SEAM(pb + 0); }
        if (INL(1)) { PH_LOAD; EpiProj E{P0, 0, GATE1, 12, HALO}; run_gemm(ltid(a), lds, H, WB0, MROWS, 3328, E); SEAM(pb + 1); }
        if (INL(2)) { PH_LOAD; ph_gdn_conv(a, l, P0, HALO, lds); ph_cvt(wdesc(a, l, 1), WB1, ldsf); SEAM(pb + 2); }
        if (INL(3)) { PH_LOAD; ph_gdn_scan_mfma(a, l, P0, P1, P2, GATE1, OF, OB, lds); if (DUP_PHASE == 3) ph_gdn_scan_mfma(a, l, P0, P1, P2, GATE1, OF, OB, lds); SEAM(pb + 3); }
        if (INL(4)) { PH_LOAD; EpiProj E{P0, 9, nullptr, -1, nullptr}; run_gemm(ltid(a), lds, H, WB1, MROWS, 2048, E); SEAM(pb + 4); }
        if (INL(5)) { PH_LOAD; ph_gdn_post(a, l, OF, OB, P0); ph_cvt(wdesc(a, l, 6), WB0, ldsf); SEAM(pb + 5); }
        if (INL(6)) { PH_LOAD; ph_cvt(wdesc(a, l, 2), WB1, ldsf); EpiBranch E{P1, MERGED, 1}; run_gemm(ltid(a), lds, OF, WB0, MROWS, 1024, E); SEAM(pb + 6); }
        if (INL(7)) { PH_LOAD; ph_cvt(wdesc(a, l, 3), WB0, ldsf); EpiProj E{P0, 0, GATE2, 12, nullptr}; run_gemm(ltid(a), lds, H, WB1, MROWS, 3328, E); SEAM(pb + 7); }
        if (INL(8)) { PH_LOAD; ph_ml_scan_mfma(a, l, P0, P1, P2, GATE2, OF, OB, lds); if (DUP_PHASE == 8) ph_ml_scan_mfma(a, l, P0, P1, P2, GATE2, OF, OB, lds); SEAM(pb + 8); }
        if (INL(9)) { PH_LOAD; ph_cvt(wdesc(a, l, 8), WB1, ldsf); EpiProj E{P0, 38, nullptr, -1, nullptr}; run_gemm(ltid(a), lds, H, WB0, MROWS, 3072, E); SEAM(pb + 9); }
        if (INL(10)) { PH_LOAD; ph_ml_post(a, l, OF, OB, P0, P1); SEAM(pb + 10); }
        if (INL(11)) { PH_LOAD; ph_cvt(wdesc(a, l, 4), WB0, ldsf); EpiBranch E{P2, MERGED, 0}; run_gemm(ltid(a), lds, OF, WB1, MROWS, 1024, E); SEAM(pb + 11); }
        if (INL(12)) { PH_LOAD; ph_cvt(wdesc(a, l, 5), WB1, ldsf); EpiS1 E{AX, SZ5, G15}; run_gemm(ltid(a), lds, H, WB0, MROWS, 3072, E); SEAM(pb + 12); }
        if (INL(13)) { PH_LOAD; ph_s5_consts(a, l, CW1, CW2, lds); ph_cvt(wdesc(a, l, 7), WB0, ldsf); SEAM(pb + 13); }
        if (INL(14)) { PH_LOAD; EpiS5L E{AX}; run_gemm_g(ltid(a), lds, AX, 512, 256, CW1, 64 * S5_RG, 256, S5_PMG, (size_t)256 * 256 * 2, E); SEAM(pb + 14); }
        if (INL(15)) { PH_LOAD; ph_s5_carry(a, l, AX); SEAM(pb + 15); }
        if (INL(16)) { PH_LOAD; EpiS5Y E{AX, GLUA, a.in[I_SD] + l * 1024}; run_gemm_g(ltid(a), lds, AX, 512, 512, CW2, 64 * S5_RG, 256, S5_PMG, (size_t)256 * 512 * 2, E); SEAM(pb + 16); }
        if (INL(17)) { PH_LOAD; EpiGlu E{SZ5, YBR, a.in[I_SBGLU] + l * 2048}; run_gemm(ltid(a), lds, GLUA, WB1, MROWS, 2048, E); SEAM(pb + 17); }
        if (INL(18)) { PH_LOAD; ph_cvt(wdesc(a, l, 9), WB1, ldsf); EpiBranch E{G15, MERGED, 0}; run_gemm(ltid(a), lds, YBR, WB0, MROWS, 1024, E); SEAM(pb + 18); }
        if (INL(19)) { PH_LOAD;
            const int ro = (l == DEPTH - 1) ? CTXROWS : 0;
            EpiOut E{xlat_src, a.out, xctx_src, XCTX, modl, l, ro};
            run_gemm(ltid(a), lds, MERGED + (size_t)ro * 1024, WB1, MROWS - ro, 1024, E);
            SEAM(pb + 19);
        }
    }
    if (PHEN(102) && IN(PH_FINAL)) { const int l = 0; PH_LOAD; ph_final(a, a.out); }
#undef IN
#undef SEAM
#undef PH_LOAD
}
}

#ifndef MK_LAUNCHES
#define MK_LAUNCHES 1
#endif
extern "C" void kernel_launch(void* const* d_in, const int* in_sizes, int n_in, void* d_out, int out_size, void* d_ws, size_t ws_size, hipStream_t stream) {
    static int grid = 0;
    if (grid == 0) {
        if (n_in != 28 || out_size != hy::NBATCH * hy::SEQ * hy::D || ws_size < hy::WS_END) { fprintf(stderr, "kernel_launch: unexpected shapes (n_in %d, out %d, ws %zu < %zu)\n", n_in, out_size, ws_size, (size_t)hy::WS_END); grid = -1; return; }
        int dev = 0, cus = 0, per_cu = 0;
        if (hipGetDevice(&dev) != hipSuccess || hipDeviceGetAttribute(&cus, hipDeviceAttributeMultiprocessorCount, dev) != hipSuccess) { grid = -1; return; }
        if (hipFuncSetAttribute((const void*)hy::hy_fwd, hipFuncAttributeMaxDynamicSharedMemorySize, hy::LDS_BYTES) != hipSuccess) { fprintf(stderr, "kernel_launch: hipFuncSetAttribute failed\n"); grid = -1; return; }
        if (hipOccupancyMaxActiveBlocksPerMultiprocessor(&per_cu, (const void*)hy::hy_fwd, hy::NT, hy::LDS_BYTES) != hipSuccess || per_cu < 1) { fprintf(stderr, "kernel_launch: occupancy query says %d\n", per_cu); (void)hipGetLastError(); }
        grid = cus;
    }
    if (grid < 0) return;
    (void)hipMemsetAsync((char*)d_ws + hy::WS_CTL, 0, 65536, stream);
    hy::Args a{};
    for (int i = 0; i < 28; ++i) a.in[i] = (const float*)d_in[i];
    a.out = (float*)d_out; a.ws = (unsigned char*)d_ws;
#if MK_LAUNCHES == 1
    a.ph_lo = 0; a.ph_hi = hy::NPHASE;
    hipLaunchKernelGGL(hy::hy_fwd, dim3(grid), dim3(hy::NT), hy::LDS_BYTES, stream, a);
#else
    for (int p = 0; p < hy::NPHASE; ++p) { a.ph_lo = p; a.ph_hi = p + 1; hipLaunchKernelGGL(hy::hy_fwd, dim3(grid), dim3(hy::NT), hy::LDS_BYTES, stream, a); }
#endif
}
```

```cpp
#include <hip/hip_runtime.h>
#include <cstdio>
#include <cstdint>
#define MK_LAUNCHES 1


#define XB_TMO      128
#define XB_XCNT(j)  (256  + 64 * (j))
#define XB_XSUB(j)  (1280 + 64 * (j))
#define XB_XGEN(j)  (2304 + 64 * (j))
#define XB_TOP      3328
#define XB_TOPGEN   3392
#define XCD_BAR_WORDS 3456
#define XB_SPIN_CAP (1u << 18)
#define LAS __attribute__((address_space(3)))

__device__ __forceinline__ unsigned xb_ld(unsigned* p)              { return __hip_atomic_load(p, __ATOMIC_RELAXED, __HIP_MEMORY_SCOPE_AGENT); }
__device__ __forceinline__ unsigned xb_add(unsigned* p, unsigned v) { return __hip_atomic_fetch_add(p, v, __ATOMIC_RELAXED, __HIP_MEMORY_SCOPE_AGENT); }
__device__ __forceinline__ unsigned xb_xcc_id() { return (unsigned)__builtin_amdgcn_s_getreg((3 << 11) | 20) & 0xFu; }
#define XB_SPIN(cond, bar) do { unsigned _sp = 0; while (cond) { __builtin_amdgcn_s_sleep(1); \
    if ((++_sp & 255u) == 0u) { if (xb_ld(&(bar)[XB_TMO])) break; if (_sp > XB_SPIN_CAP) { atomicAdd(&(bar)[XB_TMO], 1u); break; } } } } while (0)

struct XcdBarrier {
    unsigned* bar; unsigned x;
    int wid;
    volatile LAS unsigned* st;
};

__device__ __forceinline__ bool xb_lead(int wid) { int l; asm volatile("v_mbcnt_lo_u32_b32 %0, -1, 0\n\tv_mbcnt_hi_u32_b32 %0, -1, %0" : "=v"(l)); return wid == 0 && l == 0; }
__device__ __forceinline__ XcdBarrier xcd_barrier_post(unsigned* bar, volatile LAS unsigned* st, int wid) {
    XcdBarrier b; b.bar = bar; b.x = xb_xcc_id(); b.st = st; b.wid = wid;
    if (xb_lead(wid)) (void)xb_add(&bar[XB_XCNT(b.x)], 1u);
    return b;
}
__device__ __forceinline__ void xcd_barrier_complete(unsigned* bar, unsigned x, unsigned& nloc, unsigned& nx) {
    const unsigned G = gridDim.x * gridDim.y * gridDim.z;
    unsigned sum, cnt, mine, sp = 0u;
    for (;;) {
        sum = 0u; cnt = 0u; mine = 0u;
#pragma unroll
        for (unsigned j = 0; j < 16; ++j) { const unsigned c = xb_ld(&bar[XB_XCNT(j)]); sum += c; cnt += (c > 0u) ? 1u : 0u; mine = (j == x) ? c : mine; }
        if (sum == G) break;
        __builtin_amdgcn_s_sleep(1);
        if ((++sp & 255u) == 0u) { if (xb_ld(&bar[XB_TMO])) break; if (sp > XB_SPIN_CAP) { atomicAdd(&bar[XB_TMO], 1u); break; } }
    }
    nloc = mine > 0u ? mine : 1u; nx = cnt > 0u ? cnt : 1u;
}

__device__ __forceinline__ void xcd_barrier(const XcdBarrier& b) {
    asm volatile("s_waitcnt vmcnt(0)" ::: "memory");
    __syncthreads();
    if (xb_lead(b.wid)) {
        unsigned* bar = b.bar;
        __builtin_amdgcn_s_waitcnt(0);
        unsigned nloc = b.st[0], nx = b.st[1];
        if (nloc == 0u) { xcd_barrier_complete(bar, b.x, nloc, nx); b.st[0] = nloc; b.st[1] = nx; }
        const unsigned old = xb_add(&bar[XB_XSUB(b.x)], 1u);
        const unsigned gen = old / nloc;
        if (old + 1u == (gen + 1u) * nloc) {
            __builtin_amdgcn_fence(__ATOMIC_RELEASE, "agent");
            asm volatile("s_waitcnt vmcnt(0)" ::: "memory");
            const unsigned og = xb_add(&bar[XB_TOP], 1u);
            const unsigned tg = og / nx;
            if (og + 1u == (tg + 1u) * nx) xb_add(&bar[XB_TOPGEN], 1u);
            else XB_SPIN(xb_ld(&bar[XB_TOPGEN]) == tg, bar);
            __builtin_amdgcn_fence(__ATOMIC_ACQUIRE, "agent");
            xb_add(&bar[XB_XGEN(b.x)], 1u);
            asm volatile("s_waitcnt vmcnt(0)" ::: "memory");
        } else {
            XB_SPIN(xb_ld(&bar[XB_XGEN(b.x)]) == gen, bar);
            __builtin_amdgcn_fence(__ATOMIC_ACQUIRE, "agent");
            asm volatile("s_waitcnt vmcnt(0)" ::: "memory");
        }
    }
    __syncthreads();
}


namespace pg8 {
#define PG8_LAS __attribute__((address_space(3)))
typedef unsigned short bf16_t;
typedef short bf16x8 __attribute__((ext_vector_type(8)));
typedef float f32x4 __attribute__((ext_vector_type(4)));
typedef unsigned u32x4 __attribute__((ext_vector_type(4)));
constexpr int BM = 256, BK = 64, HALF = 128, HTB = HALF * BK * 2  , STAGE_BYTES = 8 * HTB, NXCD = 8, WGM = 8;

__host__ __device__ __forceinline__ int lds_byte(int r, int c) { const int st = (r >> 4) * 2 + (c >> 5), rr = r & 15, cc = c & 31, ob = rr * 64 + cc * 2; return st * 1024 + (ob ^ (((ob >> 9) & 1) << 5)); }
__host__ __device__ __forceinline__ void stage_rc(int b, int& R, int& C) { const int st = b / 1024, sb = b % 1024, swz = sb ^ (((sb >> 9) & 1) << 5); R = (st >> 1) * 16 + swz / 64; C = (st & 1) * 32 + (swz % 64) / 2; }
__host__ __device__ __forceinline__ int perm32(int rho) { const int n = rho >> 4, i = rho & 15; return 8 * (i >> 2) + 4 * n + (i & 3); }

struct Unit { int pm, pn; };
struct Gemm { const bf16_t* A; const bf16_t* Bt; int M, N, K, lda, pmg; size_t gstride; int tid; };

struct StaticOrder {
    int nM, nN, nwg, G, c;
    __host__ __device__ void init(int M, int N, int G_, int c_) { nM = M / BM; nN = N / BM; nwg = nM * nN; G = G_; c = c_; }
    __host__ __device__ bool next(int i, Unit& u) const {
        const long L = (long)i * G + c; if (L >= nwg) return false;
        int wgid = (int)L; { const int q = nwg / NXCD, r = nwg % NXCD, xcd = wgid % NXCD, off = wgid / NXCD; wgid = (xcd < r ? xcd * (q + 1) : r * (q + 1) + (xcd - r) * q) + off; }
        const int nig = WGM * nN, gid = wgid / nig, fm = gid * WGM, gsz = (nM - fm) < WGM ? (nM - fm) : WGM;
        u.pm = fm + ((wgid % nig) % gsz); u.pn = (wgid % nig) / gsz; return true;
    }
    __device__ __forceinline__ void a_ready(const Unit&) const {}
    __device__ __forceinline__ void done(const Unit&) const {}
};
__device__ __forceinline__ unsigned cvt_pk_bf16(float lo, float hi) { unsigned r; asm volatile("v_cvt_pk_bf16_f32 %0, %1, %2" : "=v"(r) : "v"(lo), "v"(hi)); return r; }
typedef float f32x2 __attribute__((ext_vector_type(2)));
template <class Epi, class Sched, bool STAMP = false>
__device__ __forceinline__ void gemm_phase(PG8_LAS unsigned char* lds, const Gemm g, const Sched& S, const Epi& E, unsigned long long* stamps) {
    const int tid = g.tid, wid = __builtin_amdgcn_readfirstlane(tid >> 6), lane = tid & 63, wr = wid >> 2, wc = wid & 3, fr = lane & 15, fq = lane >> 4;
    const int K = g.K, nt = K / BK;
    int ts_lo = 0, ts_hi = 0, nts = 0; const unsigned long long rt_entry = STAMP ? (unsigned long long)wall_clock64() : 0ull;
#define PG8_STAMP() do { if (STAMP && wid == 0 && nts < 64) { const unsigned long long _c = (unsigned long long)clock64(); \
        ts_lo = (lane == nts) ? (int)(unsigned)_c : ts_lo; ts_hi = (lane == nts) ? (int)(unsigned)(_c >> 32) : ts_hi; ++nts; } } while (0)
    PG8_STAMP();
    unsigned voffA[2], voffB[2];
#pragma unroll
    for (int i = 0; i < 2; ++i) { int R, C; stage_rc(tid * 16 + i * 8192, R, C); const int Rb = Epi::PERM ? ((R & ~31) + perm32(R & 31)) : R;
        voffA[i] = (unsigned)(R * g.lda + C) * 2u; voffB[i] = (unsigned)(Rb * K + C) * 2u; }
    const size_t kstep = (size_t)(BK * 2);
    const size_t hstepA = (size_t)HALF * g.lda * 2, hstepB = (size_t)HALF * K * 2;
    const size_t tstepA = 2 * hstepA, tstepB = 2 * hstepB;
    const unsigned ldsw = (unsigned)wid * 1024u;
    const int aoff = lds_byte(wr * 64 + fr, fq * 8), boff = lds_byte(wc * 32 + fr, fq * 8);
#define PG8_SA(b, h) (((b) * 2 + (h)) * HTB)
#define PG8_SB(b, h) ((4 + (b) * 2 + (h)) * HTB)
#define PG8_STAGE(bufoff, gbase, voff) do { _Pragma("unroll") for (int _i = 0; _i < 2; ++_i) \
        __builtin_amdgcn_global_load_lds((const unsigned*)((const char*)(gbase) + (voff)[_i]), (PG8_LAS unsigned*)(lds + (bufoff) + ldsw + _i * 8192), 16, 0, 0); } while (0)
#define PG8_LDA(dst, b, h) do { _Pragma("unroll") for (int m = 0; m < 4; ++m) _Pragma("unroll") for (int k = 0; k < 2; ++k) dst[m][k] = *(const PG8_LAS bf16x8*)(lds + PG8_SA(b, h) + aoff + m * 2048 + k * 1024); } while (0)
#define PG8_LDB(dst, b, h) do { _Pragma("unroll") for (int n = 0; n < 2; ++n) _Pragma("unroll") for (int k = 0; k < 2; ++k) dst[n][k] = *(const PG8_LAS bf16x8*)(lds + PG8_SB(b, h) + boff + n * 2048 + k * 1024); } while (0)
#define PG8_MMA(ai, bj, At, Bt) do { __builtin_amdgcn_s_setprio(1); _Pragma("unroll") for (int m = 0; m < 4; ++m) _Pragma("unroll") for (int n = 0; n < 2; ++n) _Pragma("unroll") for (int k = 0; k < 2; ++k) \
        acc[ai][bj][m][n] = __builtin_amdgcn_mfma_f32_16x16x32_bf16(Bt[n][k], At[m][k], acc[ai][bj][m][n], 0, 0, 0); __builtin_amdgcn_s_setprio(0); } while (0)
#define PG8_WAIT_V(n) asm volatile("s_waitcnt vmcnt(" #n ")" ::: "memory")
#define PG8_WAIT_L(n) asm volatile("s_waitcnt lgkmcnt(" #n ")" ::: "memory")
#define PG8_BAR __builtin_amdgcn_s_barrier()
#define PG8_SCHED __builtin_amdgcn_sched_barrier(0)
    Unit cur, nxt; int ui = 0;
    if (!S.next(0, cur)) return;
    f32x4 acc[2][2][4][2];
#pragma unroll
    for (int a = 0; a < 2; ++a)
#pragma unroll
        for (int b = 0; b < 2; ++b)
#pragma unroll
            for (int m = 0; m < 4; ++m)
#pragma unroll
                for (int n = 0; n < 2; ++n) acc[a][b][m][n] = (f32x4){0.f, 0.f, 0.f, 0.f};
    bf16x8 At[4][2], B0[2][2], B1[2][2];
    const char* cA = (const char*)g.A + (size_t)cur.pm * tstepA; const char* cB = (const char*)g.Bt + (size_t)(cur.pm / g.pmg) * g.gstride + (size_t)cur.pn * tstepB;
    S.a_ready(cur);
    PG8_STAGE(PG8_SB(0, 0), cB, voffB); PG8_STAGE(PG8_SA(0, 0), cA, voffA); PG8_STAGE(PG8_SB(0, 1), cB + hstepB, voffB); PG8_STAGE(PG8_SA(0, 1), cA + hstepA, voffA);
    if (wr == 1) PG8_BAR;
    PG8_WAIT_V(4); PG8_BAR;
    PG8_STAGE(PG8_SB(1, 0), cB + kstep, voffB); PG8_STAGE(PG8_SA(1, 0), cA + kstep, voffA); PG8_STAGE(PG8_SB(1, 1), cB + hstepB + kstep, voffB);
    PG8_WAIT_V(6); PG8_BAR;
    PG8_STAMP();
    for (;;) {
        const bool has_next = S.next(ui + 1, nxt);
        const char* nA = has_next ? (const char*)g.A + (size_t)nxt.pm * tstepA : cA; const char* nB = has_next ? (const char*)g.Bt + (size_t)(nxt.pm / g.pmg) * g.gstride + (size_t)nxt.pn * tstepB : cB;
#pragma unroll 1
        for (int t = 0; t < nt; t += 2) {
            const bool last = (t == nt - 2);
            const char* a1 = cA + (size_t)(t + 1) * kstep;
            const char* a2 = last ? nA : cA + (size_t)(t + 2) * kstep; const char* b2 = last ? nB : cB + (size_t)(t + 2) * kstep;
            const char* a3 = a2 + kstep; const char* b3 = b2 + kstep;
            if (last && has_next) S.a_ready(nxt);
            PG8_LDB(B0, 0, 0); PG8_SCHED; PG8_LDA(At, 0, 0); PG8_STAGE(PG8_SA(1, 1), a1 + hstepA, voffA);
            PG8_WAIT_L(8); PG8_BAR; PG8_WAIT_L(0); PG8_MMA(0, 0, At, B0); PG8_BAR; PG8_SCHED;
            PG8_LDB(B1, 0, 1); PG8_STAGE(PG8_SB(0, 0), b2, voffB);
            PG8_BAR; PG8_WAIT_L(0); PG8_MMA(0, 1, At, B1); PG8_BAR;
            PG8_LDA(At, 0, 1); PG8_STAGE(PG8_SA(0, 0), a2, voffA);
            PG8_BAR; PG8_WAIT_L(0); PG8_MMA(1, 0, At, B0); PG8_BAR; PG8_SCHED;
            PG8_STAGE(PG8_SB(0, 1), b2 + hstepB, voffB);
            PG8_WAIT_V(6); PG8_BAR; PG8_MMA(1, 1, At, B1); PG8_BAR;
            PG8_LDB(B0, 1, 0); PG8_SCHED; PG8_LDA(At, 1, 0); PG8_STAGE(PG8_SA(0, 1), a2 + hstepA, voffA);
            PG8_WAIT_L(8); PG8_BAR; PG8_WAIT_L(0); PG8_MMA(0, 0, At, B0); PG8_BAR; PG8_SCHED;
            PG8_LDB(B1, 1, 1); PG8_STAGE(PG8_SB(1, 0), b3, voffB);
            PG8_BAR; PG8_WAIT_L(0); PG8_MMA(0, 1, At, B1); PG8_BAR;
            PG8_LDA(At, 1, 1); PG8_STAGE(PG8_SA(1, 0), a3, voffA);
            PG8_BAR; PG8_WAIT_L(0); PG8_MMA(1, 0, At, B0); PG8_BAR; PG8_SCHED;
            PG8_STAGE(PG8_SB(1, 1), b3 + hstepB, voffB);
            PG8_WAIT_V(6); PG8_BAR; PG8_MMA(1, 1, At, B1); PG8_BAR;
        }
        PG8_STAMP();
        if constexpr (!Epi::AFTER_DRAIN) { E(acc, cur, wr, wc, fr, fq); S.done(cur); }
        PG8_STAMP();
        if (!has_next) break;
#pragma unroll
        for (int a = 0; a < 2; ++a)
#pragma unroll
            for (int b = 0; b < 2; ++b)
#pragma unroll
                for (int m = 0; m < 4; ++m)
#pragma unroll
                    for (int n = 0; n < 2; ++n) acc[a][b][m][n] = (f32x4){0.f, 0.f, 0.f, 0.f};
        cur = nxt; cA = nA; cB = nB; ++ui;
    }
    PG8_WAIT_V(0);
    if (wr == 0) PG8_BAR;
    PG8_BAR;
    if constexpr (Epi::AFTER_DRAIN) { E.fused(acc, cur, wr, wc, fr, fq, lds, wid, lane); S.done(cur); }
    PG8_STAMP();
    if (STAMP && wid == 0) { stamps[lane] = lane < nts ? (((unsigned long long)(unsigned)ts_hi << 32) | (unsigned)ts_lo) : 0ull;
        if (lane == 62) stamps[62] = rt_entry; if (lane == 63) stamps[63] = (unsigned long long)wall_clock64(); }
#undef PG8_STAMP
#undef PG8_SA
#undef PG8_SB
#undef PG8_STAGE
#undef PG8_LDA
#undef PG8_LDB
#undef PG8_MMA
#undef PG8_WAIT_V
#undef PG8_WAIT_L
#undef PG8_BAR
#undef PG8_SCHED
}
}


namespace hy {
using pg8::bf16_t; using pg8::f32x4; using pg8::u32x4; using pg8::Unit;
typedef unsigned u32x2 __attribute__((ext_vector_type(2)));
#define DI __device__ __forceinline__
constexpr int D = 1024, NBATCH = 8, SEQ = 4096, CTXL = 256, DEPTH = 4;
constexpr int CTXROWS = NBATCH * CTXL;
constexpr int MROWS = CTXROWS + NBATCH * SEQ;
constexpr int NCHUNK = MROWS / 64;
constexpr int NIN = 14384;
constexpr int NT = 512;
constexpr int LDS_BYTES = 131072 + 256;
constexpr int C_GQ = 0, C_GZ = 3072, C_GA = 4096, C_SU = 4128, C_MQ = 6176, C_MO = 9248, C_MI = 11296, C_GATE = 11312;

constexpr size_t al256(size_t x) { return (x + 255) & ~(size_t)255; }
constexpr size_t SZ_ACT = (size_t)MROWS * 1024 * 2;
constexpr size_t SZ_GATE = (size_t)MROWS * 32 * 4;
constexpr size_t SZ_HALO = (size_t)3 * NCHUNK * 4 * 1024 * 2;
constexpr size_t WS_CTL = 0;
constexpr size_t WS_MOD = 65536, SZ_MOD = (size_t)DEPTH * 9 * 3072 * 4;
constexpr size_t WS_XCTX = al256(WS_MOD + SZ_MOD);
constexpr size_t WS_H = WS_XCTX + (size_t)CTXROWS * 1024 * 4;
constexpr size_t WS_MERGED = WS_H + SZ_ACT;
constexpr size_t SZ_WB = (size_t)3328 * 1024 * 2;
constexpr size_t WS_WB0 = WS_MERGED + SZ_ACT;
constexpr size_t WS_WB1 = WS_WB0 + SZ_WB;
constexpr size_t WS_R = WS_WB1 + SZ_WB;
constexpr size_t R_P0 = 0, R_P1 = SZ_ACT, R_P2 = 2 * SZ_ACT, R_OF = 3 * SZ_ACT, R_OB = 4 * SZ_ACT, R_G2 = 5 * SZ_ACT;
constexpr size_t WS_END = WS_R + R_G2 + SZ_GATE + (size_t)4 * 1024 * 1024;
static_assert(SZ_GATE + SZ_HALO <= SZ_ACT, "GDN gate + halo buffers live in the (not yet written) MERGED region");
static_assert((size_t)16 * DEPTH * 9 * 3072 * 4 <= SZ_ACT, "mod partials live in the R region");

struct Args { const float* in[28]; float* out; unsigned char* ws; int ph_lo, ph_hi, wid, pad; };
enum { I_X = 0, I_C, I_CTX, I_CCTX, I_WADA, I_BADA, I_NORMG, I_WIN, I_GCONV, I_GALOG, I_GDTB, I_GNORM, I_SLRE, I_SLIM, I_SLOG, I_SBRE, I_SBIM, I_SCRE, I_SCIM, I_SD, I_SWGLU, I_SBGLU, I_MIB, I_MFB, I_MNORM, I_WBR, I_WOUT, I_FNORM };

typedef const Args __attribute__((address_space(4)))* ArgsP;
DI ArgsP args_ptr() { ArgsP p = (ArgsP)__builtin_amdgcn_kernarg_segment_ptr(); asm volatile("" : "+s"(p)); return p; }
DI int lane_id() { int l; asm volatile("v_mbcnt_lo_u32_b32 %0, -1, 0\n\tv_mbcnt_hi_u32_b32 %0, -1, %0" : "=v"(l)); return l; }
DI int ltid(const Args& a) { return (a.wid << 6) | lane_id(); }
DI void lds_barrier() { asm volatile("s_waitcnt lgkmcnt(0)" ::: "memory"); __builtin_amdgcn_s_barrier(); asm volatile("" ::: "memory"); }
DI float bf2f(bf16_t v) { return __uint_as_float(((unsigned)v) << 16); }
DI float bflo(unsigned w) { return __uint_as_float(w << 16); }
DI float bfhi(unsigned w) { return __uint_as_float(w & 0xffff0000u); }
DI bf16_t f2bf(float f) { return (bf16_t)(pg8::cvt_pk_bf16(f, 0.f) & 0xffffu); }
DI float sigmoidf_(float x) { return __builtin_amdgcn_rcpf(1.0f + __expf(-x)); }
DI float siluf_(float x) { return x * __builtin_amdgcn_rcpf(1.0f + __expf(-x)); }
DI float softplusf_(float x) { return x > 20.f ? x : log1pf(__expf(x)); }
DI float gelu_tanh_(float x) { const float u = 0.7978845608028654f * (x + 0.044715f * x * x * x); return x * __builtin_amdgcn_rcpf(1.0f + __expf(-2.0f * u)); }
DI float shx(float v, int o, int lane) { return __int_as_float(__builtin_amdgcn_ds_bpermute((lane ^ o) << 2, __float_as_int(v))); }
DI float shup(float v, int o, int lane) { return __int_as_float(__builtin_amdgcn_ds_bpermute((lane - o) << 2, __float_as_int(v))); }
DI float shidx(float v, int src) { return __int_as_float(__builtin_amdgcn_ds_bpermute(src << 2, __float_as_int(v))); }
DI float wave_sum(float v, int lane) {
#pragma unroll
    for (int o = 32; o >= 1; o >>= 1) v += shx(v, o, lane);
    return v; }
DI void unpack8(const u32x4 w, float (&f)[8]) { f[0] = bflo(w.x); f[1] = bfhi(w.x); f[2] = bflo(w.y); f[3] = bfhi(w.y); f[4] = bflo(w.z); f[5] = bfhi(w.z); f[6] = bflo(w.w); f[7] = bfhi(w.w); }
DI int lat_pos(int l, int s) { return (l & 1) ? (((s & 63) << 6) | (s >> 6)) : s; }

struct EpiProj {
    static constexpr bool PERM = true, AFTER_DRAIN = false;
    bf16_t* d0; int modes; float* gdst; int gtile; bf16_t* halo;
    __device__ __forceinline__ void operator()(const f32x4 (&acc)[2][2][4][2], const Unit& u, int wr, int wc, int fr, int fq) const {
        const int row0 = u.pm * 256 + wr * 64 + fr;
        if (u.pn == gtile) {
            if (wc == 0) {
#pragma unroll
                for (int ai = 0; ai < 2; ++ai)
#pragma unroll
                    for (int m = 0; m < 4; ++m) { float* rp = gdst + (size_t)(row0 + ai * 128 + m * 16) * 32 + 8 * fq; *(f32x4*)rp = acc[ai][0][m][0]; *(f32x4*)(rp + 4) = acc[ai][0][m][1]; }
            }
            return;
        }
        const int seg = u.pn >> 2; bf16_t* base = d0 + (size_t)seg * (SZ_ACT / 2); const int md = (modes >> (2 * seg)) & 3;
        const int col0 = (u.pn & 3) * 256 + wc * 32 + 8 * fq;
#pragma unroll
        for (int ai = 0; ai < 2; ++ai)
#pragma unroll
            for (int m = 0; m < 4; ++m) {
                const int r = row0 + ai * 128 + m * 16;
                bf16_t* rowp = base + (size_t)r * 1024 + col0;
                int hidx = -1;
                if (halo) { if (m == 0 && fr < 2) hidx = fr; if (m == 3 && fr >= 14) hidx = fr - 12; }
#pragma unroll
                for (int bj = 0; bj < 2; ++bj) {
                    f32x4 v0 = acc[ai][bj][m][0], v1 = acc[ai][bj][m][1];
                    if (md == 1) {
#pragma unroll
                        for (int j = 0; j < 4; ++j) { v0[j] = siluf_(v0[j]); v1[j] = siluf_(v1[j]); } }
                    else if (md == 2) {
#pragma unroll
                        for (int j = 0; j < 4; ++j) { v0[j] = sigmoidf_(v0[j]); v1[j] = sigmoidf_(v1[j]); } }
                    u32x4 w; w.x = pg8::cvt_pk_bf16(v0[0], v0[1]); w.y = pg8::cvt_pk_bf16(v0[2], v0[3]); w.z = pg8::cvt_pk_bf16(v1[0], v1[1]); w.w = pg8::cvt_pk_bf16(v1[2], v1[3]);
                    *(u32x4*)(rowp + bj * 128) = w;
                    if (hidx >= 0) *(u32x4*)(halo + ((size_t)seg * (NCHUNK * 4) + (size_t)(r >> 6) * 4 + hidx) * 1024 + col0 + bj * 128) = w;
                }
            }
    }
};
struct EpiBranch {
    static constexpr bool PERM = true, AFTER_DRAIN = false;
    const bf16_t* G; bf16_t* MG; int first;
    __device__ __forceinline__ void operator()(const f32x4 (&acc)[2][2][4][2], const Unit& u, int wr, int wc, int fr, int fq) const {
        const int row0 = u.pm * 256 + wr * 64 + fr, col0 = u.pn * 256 + wc * 32 + 8 * fq;
#pragma unroll
        for (int ai = 0; ai < 2; ++ai)
#pragma unroll
            for (int m = 0; m < 4; ++m) {
                const size_t off = (size_t)(row0 + ai * 128 + m * 16) * 1024 + col0;
#pragma unroll
                for (int bj = 0; bj < 2; ++bj) {
                    const u32x4 gw = *(const u32x4*)(G + off + bj * 128);
                    float g[8], o[8]; unpack8(gw, g);
                    if (first) {
#pragma unroll
                        for (int j = 0; j < 8; ++j) o[j] = 0.f; }
                    else { const u32x4 ow = *(const u32x4*)(MG + off + bj * 128); unpack8(ow, o); }
                    const f32x4 v0 = acc[ai][bj][m][0], v1 = acc[ai][bj][m][1];
#pragma unroll
                    for (int j = 0; j < 4; ++j) { o[j] += g[j] * v0[j]; o[4 + j] += g[4 + j] * v1[j]; }
                    u32x4 w; w.x = pg8::cvt_pk_bf16(o[0], o[1]); w.y = pg8::cvt_pk_bf16(o[2], o[3]); w.z = pg8::cvt_pk_bf16(o[4], o[5]); w.w = pg8::cvt_pk_bf16(o[6], o[7]);
                    *(u32x4*)(MG + off + bj * 128) = w;
                }
                asm volatile("" ::: "memory");
            }
    }
};
struct EpiGlu {
    static constexpr bool PERM = true, AFTER_DRAIN = false;
    const bf16_t* SZ; bf16_t* O; const float* bias;
    __device__ __forceinline__ void operator()(const f32x4 (&acc)[2][2][4][2], const Unit& u, int wr, int wc, int fr, int fq) const {
        const int row0 = u.pm * 256 + wr * 64 + fr, col0 = u.pn * 128 + wc * 32 + 8 * fq;
        float ba[8], bg[8];
#pragma unroll
        for (int j = 0; j < 8; ++j) { ba[j] = bias[col0 + j]; bg[j] = bias[1024 + col0 + j]; }
#pragma unroll
        for (int ai = 0; ai < 2; ++ai)
#pragma unroll
            for (int m = 0; m < 4; ++m) {
                const size_t off = (size_t)(row0 + ai * 128 + m * 16) * 1024 + col0;
                const u32x4 zw = *(const u32x4*)(SZ + off); float z[8], o[8]; unpack8(zw, z);
#pragma unroll
                for (int n = 0; n < 2; ++n)
#pragma unroll
                    for (int j = 0; j < 4; ++j) { const int c = 4 * n + j; o[c] = (acc[ai][0][m][n][j] + ba[c]) * sigmoidf_(acc[ai][1][m][n][j] + bg[c]) * z[c]; }
                u32x4 w; w.x = pg8::cvt_pk_bf16(o[0], o[1]); w.y = pg8::cvt_pk_bf16(o[2], o[3]); w.z = pg8::cvt_pk_bf16(o[4], o[5]); w.w = pg8::cvt_pk_bf16(o[6], o[7]);
                *(u32x4*)(O + off) = w;
            }
    }
};
struct EpiOut {
    static constexpr bool PERM = false, AFTER_DRAIN = false;
    const float* xlat_src; float* xlat_dst; const float* xctx_src; float* xctx_dst; const float* mod; int l; int row_off;
    __device__ __forceinline__ void operator()(const f32x4 (&acc)[2][2][4][2], const Unit& u, int wr, int wc, int fr, int fq) const {
        const int row0 = row_off + u.pm * 256 + wr * 64 + fr, col0 = u.pn * 256 + wc * 32 + 4 * fq;
#pragma unroll
        for (int ai = 0; ai < 2; ++ai)
#pragma unroll
            for (int m = 0; m < 4; ++m) {
                const int r = row0 + ai * 128 + m * 16;
                const float* xs; float* xd; const float* gp;
                if (r < CTXROWS) { xs = xctx_src + (size_t)r * 1024; xd = xctx_dst + (size_t)r * 1024; gp = mod + 8 * 3072 + 2048; }
                else { const int q = r - CTXROWS, b = q >> 12, p = lat_pos(l, q & 4095); const size_t o = ((size_t)b * 4096 + p) * 1024; xs = xlat_src + o; xd = xlat_dst + o; gp = mod + b * 3072 + 2048; }
#pragma unroll
                for (int bj = 0; bj < 2; ++bj)
#pragma unroll
                    for (int n = 0; n < 2; ++n) { const int c = col0 + bj * 128 + n * 16; const f32x4 x = *(const f32x4*)(xs + c), g = *(const f32x4*)(gp + c); *(f32x4*)(xd + c) = x + g * acc[ai][bj][m][n]; }
                asm volatile("" ::: "memory");
            }
    }
};

DI void ph_modp(const Args& a, float* modp, LAS float* sl) {
    for (int it = blockIdx.x; it < 384; it += gridDim.x) {
        const int l = it / 96, kq = (it / 6) % 16, nt = it % 6;
        __syncthreads();
        for (int i = ltid(a); i < 576; i += NT) { const int j = i >> 6, k = kq * 64 + (i & 63); const float cv = (j < 8) ? a.in[I_C][j * 1024 + k] : a.in[I_CCTX][k]; sl[i] = siluf_(cv); }
        __syncthreads();
        const int n = nt * 512 + ltid(a);
        float acc[9];
#pragma unroll
        for (int j = 0; j < 9; ++j) acc[j] = 0.f;
        const float* w = a.in[I_WADA] + ((size_t)l * 1024 + kq * 64) * 3072 + n;
#pragma unroll 4
        for (int k = 0; k < 64; ++k) { const float wv = w[(size_t)k * 3072];
#pragma unroll
            for (int j = 0; j < 9; ++j) acc[j] += sl[j * 64 + k] * wv; }
#pragma unroll
        for (int j = 0; j < 9; ++j) modp[(((size_t)kq * 4 + l) * 9 + j) * 3072 + n] = acc[j];
    }
}
DI void ph_mod(const Args& a, const float* modp, float* mod) {
    for (int i = blockIdx.x * NT + ltid(a); i < DEPTH * 9 * 3072; i += gridDim.x * NT) {
        const int l = i / (9 * 3072), n = i % 3072; float s = a.in[I_BADA][l * 3072 + n];
#pragma unroll
        for (int kq = 0; kq < 16; ++kq) s += modp[(size_t)kq * (DEPTH * 9 * 3072) + i];
        mod[i] = s;
    }
}
DI void ph_norm(const Args& a, int l, const float* xlat, const float* xctx, const float* mod, bf16_t* H) {
    const int wave = ltid(a) >> 6, lane = ltid(a) & 63;
    const float* g = a.in[I_NORMG] + l * 1024;
    for (int r = blockIdx.x * 8 + wave; r < MROWS; r += gridDim.x * 8) {
        const float* src; const float* md;
        if (r < CTXROWS) { src = xctx + (size_t)r * 1024; md = mod + 8 * 3072; }
        else { const int q = r - CTXROWS, b = q >> 12, p = lat_pos(l, q & 4095); src = xlat + ((size_t)b * 4096 + p) * 1024; md = mod + b * 3072; }
        f32x4 v[4]; float ss = 0.f;
#pragma unroll
        for (int i = 0; i < 4; ++i) { v[i] = *(const f32x4*)(src + i * 256 + lane * 4); ss += v[i][0] * v[i][0] + v[i][1] * v[i][1] + v[i][2] * v[i][2] + v[i][3] * v[i][3]; }
        ss = wave_sum(ss, lane);
        const float rs = rsqrtf(ss * (1.0f / 1024.0f) + 1e-6f);
#pragma unroll
        for (int i = 0; i < 4; ++i) { const int c = i * 256 + lane * 4;
            const f32x4 gv = *(const f32x4*)(g + c), sh = *(const f32x4*)(md + c), sc = *(const f32x4*)(md + 1024 + c);
            const f32x4 y = (v[i] * rs) * gv * (sc + 1.0f) + sh;
            u32x2 w; w.x = pg8::cvt_pk_bf16(y[0], y[1]); w.y = pg8::cvt_pk_bf16(y[2], y[3]);
            *(u32x2*)(H + (size_t)r * 1024 + c) = w; }
    }
}
DI void ph_final(const Args& a, float* x) {
    const int wave = ltid(a) >> 6, lane = ltid(a) & 63;
    const float* g = a.in[I_FNORM];
    for (int r = blockIdx.x * 8 + wave; r < NBATCH * SEQ; r += gridDim.x * 8) {
        float* src = x + (size_t)r * 1024;
        f32x4 v[4]; float ss = 0.f;
#pragma unroll
        for (int i = 0; i < 4; ++i) { v[i] = *(const f32x4*)(src + i * 256 + lane * 4); ss += v[i][0] * v[i][0] + v[i][1] * v[i][1] + v[i][2] * v[i][2] + v[i][3] * v[i][3]; }
        ss = wave_sum(ss, lane);
        const float rs = rsqrtf(ss * (1.0f / 1024.0f) + 1e-6f);
#pragma unroll
        for (int i = 0; i < 4; ++i) { const int c = i * 256 + lane * 4; const f32x4 gv = *(const f32x4*)(g + c); *(f32x4*)(src + c) = (v[i] * rs) * gv; }
    }
}
struct WDesc { const float* src; int ld, id, n64, tid; };
DI void wmap(int id, int nb, int& col, int& valid) {
    valid = 64;
    switch (id) {
        case 0: if (nb < 48) col = C_GQ + 64 * nb; else if (nb == 48) { col = C_GA; valid = 32; } else { col = 0; valid = 0; } break;
        case 1: col = (nb < 16) ? C_GZ + 64 * nb : C_GATE + 64 * (nb - 16); break;
        case 2: if (nb < 48) col = C_MQ + 64 * nb; else if (nb == 48) { col = C_MI; valid = 16; } else { col = 0; valid = 0; } break;
        case 3: col = (nb < 32) ? C_MO + 64 * nb : C_GATE + 2048 + 64 * (nb - 32); break;
        case 4: col = (nb < 32) ? C_SU + 64 * nb : C_GATE + 1024 + 64 * (nb - 32); break;
        case 5: { const int pn = nb >> 2, q = nb & 3; col = (q >> 1) * 1024 + 128 * pn + (q & 1) * 64; } break;
        default: col = 64 * nb; break;
    }
}
DI WDesc wdesc(const Args& a, int l, int id) {
    WDesc w; w.id = id; w.tid = ltid(a);
    if (id <= 4) { w.src = a.in[I_WIN] + (size_t)l * 1024 * NIN; w.ld = NIN; w.n64 = (id == 0 || id == 2) ? 52 : (id == 1 ? 32 : 48); }
    else if (id == 5) { w.src = a.in[I_SWGLU] + (size_t)l * 1024 * 2048; w.ld = 2048; w.n64 = 32; }
    else if (id <= 8) { w.src = a.in[I_WBR] + ((size_t)l * 3 + (id - 6)) * 1024 * 1024; w.ld = 1024; w.n64 = 16; }
    else { w.src = a.in[I_WOUT] + (size_t)l * 1024 * 1024; w.ld = 1024; w.n64 = 16; }
    return w;
}
DI void ph_cvt(const WDesc w, bf16_t* dst, LAS float* tile) {
    const int tid = w.tid, ntile = w.n64 * 16;
    for (int t = blockIdx.x; t < ntile; t += gridDim.x) {
        const int nb = t >> 4, kb = t & 15; int col, valid; wmap(w.id, nb, col, valid);
        __syncthreads();
        { const int c = tid & 63, k0 = tid >> 6;
#pragma unroll
          for (int i = 0; i < 8; ++i) { const int k = k0 + 8 * i; tile[k * 65 + c] = (c < valid) ? w.src[(size_t)(kb * 64 + k) * w.ld + col + c] : 0.f; } }
        __syncthreads();
        { const int n = tid >> 3, kk = (tid & 7) * 8; u32x4 o;
          o.x = pg8::cvt_pk_bf16(tile[(kk + 0) * 65 + n], tile[(kk + 1) * 65 + n]); o.y = pg8::cvt_pk_bf16(tile[(kk + 2) * 65 + n], tile[(kk + 3) * 65 + n]);
          o.z = pg8::cvt_pk_bf16(tile[(kk + 4) * 65 + n], tile[(kk + 5) * 65 + n]); o.w = pg8::cvt_pk_bf16(tile[(kk + 6) * 65 + n], tile[(kk + 7) * 65 + n]);
          *(u32x4*)(dst + (size_t)(nb * 64 + n) * 1024 + kb * 64 + kk) = o; }
    }
    __syncthreads();
}

DI void gdn_conv_decode(int unit, int& cb, int& seg, int& h) { cb = unit / 24; seg = (unit % 24) >> 3; h = unit & 7; }
DI void ph_gdn_conv(const Args& a, int l, bf16_t* QKV  , const bf16_t* halo, LAS unsigned char* lds, bf16_t* junk = nullptr) {
    constexpr int P = 136, IMG = 68 * P * 2 + 5 * 128 * 4;
    const int tid = ltid(a);
    const float* cw = a.in[I_GCONV] + (size_t)l * 5 * 3072;
    const int nunit = NCHUNK * 24;
    u32x4 rp[3]; f32x4 wreg = (f32x4){0.f, 0.f, 0.f, 0.f};
    int unit = blockIdx.x, buf = 0;
#define CONV_FETCH(un) do { int cb_, seg_, h_; gdn_conv_decode(un, cb_, seg_, h_); const bf16_t* T_ = QKV + (size_t)seg_ * (SZ_ACT / 2); \
        const bool first_ = (cb_ < 32) ? ((cb_ & 3) == 0) : (((cb_ - 32) & 63) == 0), last_ = (cb_ < 32) ? ((cb_ & 3) == 3) : (((cb_ - 32) & 63) == 63); \
        _Pragma("unroll") for (int q_ = 0; q_ < 3; ++q_) { const int i_ = tid + 512 * q_, rr_ = i_ >> 4, c8_ = (i_ & 15) * 8; u32x4 w_ = (u32x4){0u, 0u, 0u, 0u}; \
            if (i_ < 68 * 16) { if (rr_ >= 2 && rr_ < 66) w_ = *(const u32x4*)(T_ + (size_t)(cb_ * 64 + rr_ - 2) * 1024 + h_ * 128 + c8_); \
                else if (rr_ < 2) { if (!first_) w_ = *(const u32x4*)(halo + ((size_t)seg_ * (NCHUNK * 4) + (size_t)(cb_ - 1) * 4 + 2 + rr_) * 1024 + h_ * 128 + c8_); } \
                else { if (!last_) w_ = *(const u32x4*)(halo + ((size_t)seg_ * (NCHUNK * 4) + (size_t)(cb_ + 1) * 4 + (rr_ - 66)) * 1024 + h_ * 128 + c8_); } } \
            rp[q_] = w_; } \
        if (tid < 160) wreg = *(const f32x4*)(cw + (size_t)(tid >> 5) * 3072 + seg_ * 1024 + h_ * 128 + (tid & 31) * 4); } while (0)
    if (unit < nunit) CONV_FETCH(unit);
    for (; unit < nunit; unit += gridDim.x) {
        int cb, seg, h; gdn_conv_decode(unit, cb, seg, h);
        LAS bf16_t* raw = (LAS bf16_t*)(lds + buf * IMG); LAS float* wl = (LAS float*)(lds + buf * IMG + 68 * P * 2);
#pragma unroll
        for (int q = 0; q < 3; ++q) { const int i = tid + 512 * q, rr = i >> 4, c8 = (i & 15) * 8; if (i < 68 * 16) *(LAS u32x4*)(raw + rr * P + c8) = rp[q]; }
        if (tid < 160) *(LAS f32x4*)(wl + tid * 4) = wreg;
        if (unit + (int)gridDim.x < nunit) CONV_FETCH(unit + (int)gridDim.x);
        lds_barrier();
        bf16_t* T = QKV + (size_t)seg * (SZ_ACT / 2);
        const int t = tid >> 3, c0 = (tid & 7) * 16;
        float o[16]; float ss = 0.f;
#pragma unroll
        for (int half = 0; half < 2; ++half) {
            float acc[8];
#pragma unroll
            for (int j = 0; j < 8; ++j) acc[j] = 0.f;
#pragma unroll
            for (int k = 0; k < 5; ++k) {
                const u32x4 w = *(const LAS u32x4*)(raw + (t + k) * P + c0 + half * 8); float x[8]; unpack8(w, x);
                const f32x4 w0 = *(const LAS f32x4*)(wl + k * 128 + c0 + half * 8), w1 = *(const LAS f32x4*)(wl + k * 128 + c0 + half * 8 + 4);
#pragma unroll
                for (int j = 0; j < 4; ++j) { acc[j] += w0[j] * x[j]; acc[4 + j] += w1[j] * x[4 + j]; }
            }
#pragma unroll
            for (int j = 0; j < 8; ++j) { const float sv = siluf_(acc[j]); o[half * 8 + j] = sv; ss += sv * sv; }
        }
        ss += shx(ss, 1, tid & 63); ss += shx(ss, 2, tid & 63); ss += shx(ss, 4, tid & 63);
        float scale = 1.0f;
        if (seg == 0) scale = rsqrtf(ss + 1e-6f) * 0.08838834764831845f;
        else if (seg == 1) scale = rsqrtf(ss + 1e-6f);
        u32x4 w0, w1;
        w0.x = pg8::cvt_pk_bf16(o[0] * scale, o[1] * scale); w0.y = pg8::cvt_pk_bf16(o[2] * scale, o[3] * scale); w0.z = pg8::cvt_pk_bf16(o[4] * scale, o[5] * scale); w0.w = pg8::cvt_pk_bf16(o[6] * scale, o[7] * scale);
        w1.x = pg8::cvt_pk_bf16(o[8] * scale, o[9] * scale); w1.y = pg8::cvt_pk_bf16(o[10] * scale, o[11] * scale); w1.z = pg8::cvt_pk_bf16(o[12] * scale, o[13] * scale); w1.w = pg8::cvt_pk_bf16(o[14] * scale, o[15] * scale);
        bf16_t* op = (junk ? junk : T) + (size_t)(cb * 64 + t) * 1024 + h * 128 + c0;
        *(u32x4*)op = w0; *(u32x4*)(op + 8) = w1;
        buf ^= 1;
    }
#undef CONV_FETCH
    __syncthreads();
}
DI void ph_gdn_scan(const Args& a, int l, const bf16_t* Q, const bf16_t* K, const bf16_t* V, const float* GATE, bf16_t* OF, bf16_t* OB, LAS unsigned char* lds) {
    LAS float* qf = (LAS float*)lds;
    LAS float* kf = qf + 64 * 128;
    LAS float* vf = kf + 64 * 128;
    LAS float* av = vf + 64 * 64;
    LAS float* bt = av + 64;
    LAS float* part = bt + 64;
    LAS float* po = part + 1024;
    const int tid = ltid(a), e = tid & 63, dq = tid >> 6;
    for (int unit = blockIdx.x; unit < 256; unit += gridDim.x) {
        const int eh = unit & 1, d = (unit >> 1) & 1, h = (unit >> 2) & 7, b = unit >> 5;
        const float nea = -__expf(a.in[I_GALOG][(l * 2 + d) * 8 + h]), dtb = a.in[I_GDTB][(l * 2 + d) * 8 + h];
        bf16_t* O = d ? OB : OF;
        float S[16];
#pragma unroll
        for (int j = 0; j < 16; ++j) S[j] = 0.f;
        float opart = 0.f; int prow = -1, par = 0;
        for (int step = 0; step < 68; ++step) {
            const int cc = (step < 4) ? (d ? 3 - step : step) : (d ? 67 - step : step - 4);
            const int row0 = (step < 4) ? b * 256 + cc * 64 : CTXROWS + b * 4096 + cc * 64;
            __syncthreads();
            for (int i = tid; i < 1024; i += NT) { const int r = i >> 4, c8 = (i & 15) * 8; float f[8];
                unpack8(*(const u32x4*)(Q + (size_t)(row0 + r) * 1024 + h * 128 + c8), f);
#pragma unroll
                for (int j = 0; j < 8; ++j) qf[r * 128 + c8 + j] = f[j];
                unpack8(*(const u32x4*)(K + (size_t)(row0 + r) * 1024 + h * 128 + c8), f);
#pragma unroll
                for (int j = 0; j < 8; ++j) kf[r * 128 + c8 + j] = f[j]; }
            { const int r = tid >> 3, c8 = (tid & 7) * 8; float f[8]; unpack8(*(const u32x4*)(V + (size_t)(row0 + r) * 1024 + h * 128 + eh * 64 + c8), f);
#pragma unroll
              for (int j = 0; j < 8; ++j) vf[r * 64 + c8 + j] = f[j]; }
            if (tid < 64) { const float* gp = GATE + (size_t)(row0 + tid) * 32; av[tid] = __expf(nea * softplusf_(gp[d * 8 + h] + dtb)); bt[tid] = sigmoidf_(gp[16 + d * 8 + h]); }
            __syncthreads();
            for (int tt = 0; tt < 64; ++tt) {
                const int t = d ? 63 - tt : tt;
                float kk[16];
#pragma unroll
                for (int j4 = 0; j4 < 4; ++j4) { const f32x4 x = *(const LAS f32x4*)(kf + t * 128 + dq * 16 + j4 * 4); kk[j4 * 4] = x[0]; kk[j4 * 4 + 1] = x[1]; kk[j4 * 4 + 2] = x[2]; kk[j4 * 4 + 3] = x[3]; }
                float p = 0.f;
#pragma unroll
                for (int j = 0; j < 16; ++j) p += kk[j] * S[j];
                part[(par * 8 + dq) * 64 + e] = p; po[(par * 8 + dq) * 64 + e] = opart;
                __syncthreads();
                if (dq == 0 && prow >= 0) { float o = 0.f;
#pragma unroll
                    for (int q = 0; q < 8; ++q) o += po[(par * 8 + q) * 64 + e];
                    O[(size_t)prow * 1024 + h * 128 + eh * 64 + e] = f2bf(o); }
                float ks = 0.f;
#pragma unroll
                for (int q = 0; q < 8; ++q) ks += part[(par * 8 + q) * 64 + e];
                const float at = av[t], vn = bt[t] * (vf[t * 64 + e] - at * ks);
#pragma unroll
                for (int j = 0; j < 16; ++j) S[j] = at * S[j] + kk[j] * vn;
                float qo = 0.f;
#pragma unroll
                for (int j4 = 0; j4 < 4; ++j4) { const f32x4 x = *(const LAS f32x4*)(qf + t * 128 + dq * 16 + j4 * 4); qo += x[0] * S[j4 * 4] + x[1] * S[j4 * 4 + 1] + x[2] * S[j4 * 4 + 2] + x[3] * S[j4 * 4 + 3]; }
                opart = qo; prow = row0 + t; par ^= 1;
            }
        }
        po[(par * 8 + dq) * 64 + e] = opart;
        __syncthreads();
        if (dq == 0) { float o = 0.f;
#pragma unroll
            for (int q = 0; q < 8; ++q) o += po[(par * 8 + q) * 64 + e];
            O[(size_t)prow * 1024 + h * 128 + eh * 64 + e] = f2bf(o); }
        __syncthreads();
    }
}
template <int O> DI float swz_xor(float v) { return __int_as_float(__builtin_amdgcn_ds_swizzle(__float_as_int(v), 0x1F | (O << 10))); }
DI void ph_gdn_post(const Args& a, int l, bf16_t* OF, const bf16_t* OB, const bf16_t* SZ, bf16_t* junk = nullptr) {
    const int tid = ltid(a), wave = tid >> 6, lane = tid & 63;
    const float* g = a.in[I_GNORM] + l * 128 + (lane & 15) * 8;
    const f32x4 g0 = *(const f32x4*)g, g1 = *(const f32x4*)(g + 4);
    const int nit = MROWS * 2, stride = gridDim.x * 8;
    for (int it = blockIdx.x * 8 + wave; it < nit; it += 2 * stride) {
        const int it1 = it + stride; const bool two = it1 < nit;
        const size_t off0 = (size_t)it * 512 + lane * 8, off1 = (size_t)(two ? it1 : it) * 512 + lane * 8;
        const u32x4 f0 = *(const u32x4*)(OF + off0), b0 = *(const u32x4*)(OB + off0), z0 = *(const u32x4*)(SZ + off0);
        const u32x4 f1 = *(const u32x4*)(OF + off1), b1 = *(const u32x4*)(OB + off1), z1 = *(const u32x4*)(SZ + off1);
        float x0[8], x1[8], t0[8], t1[8];
        unpack8(f0, x0); unpack8(b0, t0); unpack8(f1, x1); unpack8(b1, t1);
        float s0 = 0.f, s1 = 0.f;
#pragma unroll
        for (int j = 0; j < 8; ++j) { x0[j] += t0[j]; x1[j] += t1[j]; s0 += x0[j] * x0[j]; s1 += x1[j] * x1[j]; }
        s0 += swz_xor<1>(s0); s1 += swz_xor<1>(s1); s0 += swz_xor<2>(s0); s1 += swz_xor<2>(s1); s0 += swz_xor<4>(s0); s1 += swz_xor<4>(s1); s0 += swz_xor<8>(s0); s1 += swz_xor<8>(s1);
        const float r0 = rsqrtf(s0 * (1.0f / 128.0f) + 1e-6f), r1 = rsqrtf(s1 * (1.0f / 128.0f) + 1e-6f);
        unpack8(z0, t0); unpack8(z1, t1);
        u32x4 w0, w1;
        w0.x = pg8::cvt_pk_bf16(x0[0] * r0 * g0[0] * t0[0], x0[1] * r0 * g0[1] * t0[1]); w0.y = pg8::cvt_pk_bf16(x0[2] * r0 * g0[2] * t0[2], x0[3] * r0 * g0[3] * t0[3]);
        w0.z = pg8::cvt_pk_bf16(x0[4] * r0 * g1[0] * t0[4], x0[5] * r0 * g1[1] * t0[5]); w0.w = pg8::cvt_pk_bf16(x0[6] * r0 * g1[2] * t0[6], x0[7] * r0 * g1[3] * t0[7]);
        w1.x = pg8::cvt_pk_bf16(x1[0] * r1 * g0[0] * t1[0], x1[1] * r1 * g0[1] * t1[1]); w1.y = pg8::cvt_pk_bf16(x1[2] * r1 * g0[2] * t1[2], x1[3] * r1 * g0[3] * t1[3]);
        w1.z = pg8::cvt_pk_bf16(x1[4] * r1 * g1[0] * t1[4], x1[5] * r1 * g1[1] * t1[5]); w1.w = pg8::cvt_pk_bf16(x1[6] * r1 * g1[2] * t1[6], x1[7] * r1 * g1[3] * t1[7]);
        bf16_t* dst = junk ? junk : OF;
        *(u32x4*)(dst + off0) = w0; if (two) *(u32x4*)(dst + off1) = w1;
    }
}

DI void ph_ml_scan(const Args& a, int l, const bf16_t* Q, const bf16_t* K, const bf16_t* V, const float* GATE, bf16_t* HF, bf16_t* HB, LAS unsigned char* lds) {
    LAS bf16_t* qs = (LAS bf16_t*)lds;
    LAS bf16_t* ks = qs + 64 * 256;
    LAS float* vf = (LAS float*)(ks + 64 * 256);
    LAS float* ip = vf + 64 * 64;
    LAS float* lf = ip + 64;
    LAS float* part = lf + 64;
    LAS float* dpart = part + 1024;
    const int tid = ltid(a), e = tid & 63, dq = tid >> 6;
    for (int unit = blockIdx.x; unit < 256; unit += gridDim.x) {
        const int eq = unit & 3, d = (unit >> 2) & 1, hd = (unit >> 3) & 3, b = unit >> 5;
        const float ibias = a.in[I_MIB][(l * 2 + d) * 4 + hd], fbias = a.in[I_MFB][(l * 2 + d) * 4 + hd];
        bf16_t* HO = d ? HB : HF;
        float C[32];
#pragma unroll
        for (int j = 0; j < 32; ++j) C[j] = 0.f;
        float nn = 0.f, m = 0.f; int par = 0;
        for (int step = 0; step < 68; ++step) {
            const int cc = (step < 4) ? (d ? 3 - step : step) : (d ? 67 - step : step - 4);
            const int row0 = (step < 4) ? b * 256 + cc * 64 : CTXROWS + b * 4096 + cc * 64;
            __syncthreads();
            for (int i = tid; i < 2048; i += NT) { const int r = i >> 5, c8 = (i & 31) * 8;
                *(LAS u32x4*)(qs + r * 256 + c8) = *(const u32x4*)(Q + (size_t)(row0 + r) * 1024 + hd * 256 + c8);
                *(LAS u32x4*)(ks + r * 256 + c8) = *(const u32x4*)(K + (size_t)(row0 + r) * 1024 + hd * 256 + c8); }
            { const int r = tid >> 3, c8 = (tid & 7) * 8; float f[8]; unpack8(*(const u32x4*)(V + (size_t)(row0 + r) * 1024 + hd * 256 + eq * 64 + c8), f);
#pragma unroll
              for (int j = 0; j < 8; ++j) vf[r * 64 + c8 + j] = f[j]; }
            if (tid < 64) { const float* gp = GATE + (size_t)(row0 + tid) * 32; ip[tid] = gp[d * 4 + hd] + ibias; lf[tid] = -softplusf_(-(gp[8 + d * 4 + hd] + fbias)); }
            __syncthreads();
            for (int tt = 0; tt < 64; ++tt) {
                const int t = d ? 63 - tt : tt;
                const float it = ip[t], ft = lf[t];
                const float mn = fmaxf(ft + m, it);
                const float fdec = __expf(ft + m - mn), iw = __expf(it - mn) * 0.0625f, nrm = __expf(-mn);
                m = mn;
                const float vv = iw * vf[t * 64 + e];
                float pn = 0.f;
#pragma unroll
                for (int j8 = 0; j8 < 4; ++j8) {
                    float kk[8], qq[8];
                    unpack8(*(const LAS u32x4*)(ks + t * 256 + dq * 32 + j8 * 8), kk);
                    unpack8(*(const LAS u32x4*)(qs + t * 256 + dq * 32 + j8 * 8), qq);
#pragma unroll
                    for (int j = 0; j < 8; ++j) { const float c = fdec * C[j8 * 8 + j] + vv * kk[j]; C[j8 * 8 + j] = c; pn += c * qq[j]; }
                }
                const int dn = dq * 32 + (e & 31);
                nn = fdec * nn + iw * bf2f(ks[t * 256 + dn]);
                float pd = (e < 32) ? nn * bf2f(qs[t * 256 + dn]) : 0.f;
                pd = wave_sum(pd, e);
                part[(par * 8 + dq) * 64 + e] = pn; if (e == 0) dpart[par * 8 + dq] = pd;
                __syncthreads();
                if (dq == 0) { float num = 0.f, den = 0.f;
#pragma unroll
                    for (int q = 0; q < 8; ++q) { num += part[(par * 8 + q) * 64 + e]; den += dpart[par * 8 + q]; }
                    HO[(size_t)(row0 + t) * 1024 + hd * 256 + eq * 64 + e] = f2bf(num / fmaxf(fabsf(den), nrm)); }
                par ^= 1;
            }
        }
        __syncthreads();
    }
}
DI void ph_ml_post(const Args& a, int l, bf16_t* HF, const bf16_t* HB, const bf16_t* SO, const bf16_t* SZ) {
    const int tid = ltid(a), wave = tid >> 6, lane = tid & 63;
    const float* g = a.in[I_MNORM] + l * 256 + (lane & 31) * 8;
    const f32x4 g0 = *(const f32x4*)g, g1 = *(const f32x4*)(g + 4);
    const int nit = MROWS * 2, stride = gridDim.x * 8;
    for (int it = blockIdx.x * 8 + wave; it < nit; it += stride) {
        const size_t off = (size_t)it * 512 + lane * 8;
        const u32x4 f0 = *(const u32x4*)(HF + off), b0 = *(const u32x4*)(HB + off), o0 = *(const u32x4*)(SO + off), z0 = *(const u32x4*)(SZ + off);
        float x[8], t0[8];
        unpack8(f0, x); unpack8(b0, t0);
#pragma unroll
        for (int j = 0; j < 8; ++j) x[j] += t0[j];
        unpack8(o0, t0);
        float s0 = 0.f;
#pragma unroll
        for (int j = 0; j < 8; ++j) { x[j] *= t0[j]; s0 += x[j] * x[j]; }
        s0 += swz_xor<1>(s0); s0 += swz_xor<2>(s0); s0 += swz_xor<4>(s0); s0 += swz_xor<8>(s0); s0 += swz_xor<16>(s0);
        const float r0 = rsqrtf(s0 * (1.0f / 256.0f) + 1e-6f);
        unpack8(z0, t0);
        u32x4 w0;
        w0.x = pg8::cvt_pk_bf16(x[0] * r0 * g0[0] * t0[0], x[1] * r0 * g0[1] * t0[1]); w0.y = pg8::cvt_pk_bf16(x[2] * r0 * g0[2] * t0[2], x[3] * r0 * g0[3] * t0[3]);
        w0.z = pg8::cvt_pk_bf16(x[4] * r0 * g1[0] * t0[4], x[5] * r0 * g1[1] * t0[5]); w0.w = pg8::cvt_pk_bf16(x[6] * r0 * g1[2] * t0[6], x[7] * r0 * g1[3] * t0[7]);
        *(u32x4*)(HF + off) = w0;
    }
}

DI void ph_s5_scan(const Args& a, int l, const bf16_t* U, bf16_t* YF, bf16_t* YB, LAS unsigned char* lds) {
    const int tid = ltid(a), w = tid >> 6, p = tid & 63;
    LAS float* ub = (LAS float*)lds + w * 2304;
    LAS float* yb = ub + 1024;
    LAS float* xb = yb + 1024;
    for (int unit = blockIdx.x; unit < 128; unit += gridDim.x) {
        const int gb = unit & 7, d = (unit >> 3) & 1, b = unit >> 4, g = gb * 8 + w;
        const float stp = expf(a.in[I_SLOG][(l * 2 + d) * 64 + g]);
        const float lre = a.in[I_SLRE][((size_t)(l * 2 + d) * 64 + g) * 64 + p], lim = a.in[I_SLIM][((size_t)(l * 2 + d) * 64 + g) * 64 + p];
        const float mag = expf(lre * stp), lbr = mag * cosf(lim * stp), lbi = mag * sinf(lim * stp);
        const float dnm = lre * lre + lim * lim;
        const float fre = ((lbr - 1.0f) * lre + lbi * lim) / dnm, fim = (lbi * lre - (lbr - 1.0f) * lim) / dnm;
        float bbr[16], bbi[16];
        { const float* br = a.in[I_SBRE] + (((size_t)l * 64 + g) * 64 + p) * 16; const float* bi = a.in[I_SBIM] + (((size_t)l * 64 + g) * 64 + p) * 16;
#pragma unroll
          for (int h = 0; h < 16; ++h) { bbr[h] = fre * br[h] - fim * bi[h]; bbi[h] = fre * bi[h] + fim * br[h]; } }
        const int hh = p & 15, pt = p >> 4;
        float cr[16], ci[16];
        { const float* c0 = a.in[I_SCRE] + (((size_t)l * 64 + g) * 16 + hh) * 64 + pt * 16; const float* c1 = a.in[I_SCIM] + (((size_t)l * 64 + g) * 16 + hh) * 64 + pt * 16;
#pragma unroll
          for (int j = 0; j < 16; ++j) { cr[j] = c0[j]; ci[j] = c1[j]; } }
        bf16_t* Y = d ? YB : YF;
        float xr = 0.f, xi = 0.f; int par = 0;
        for (int step = 0; step < 68; ++step) {
            const int cc = (step < 4) ? (d ? 3 - step : step) : (d ? 67 - step : step - 4);
            const int row0 = (step < 4) ? b * 256 + cc * 64 : CTXROWS + b * 4096 + cc * 64;
            __syncthreads();
            { const bf16_t* up = U + (size_t)(row0 + p) * 1024 + g * 16; float f[8];
              unpack8(*(const u32x4*)up, f);
#pragma unroll
              for (int j = 0; j < 8; ++j) ub[p * 16 + j] = f[j];
              unpack8(*(const u32x4*)(up + 8), f);
#pragma unroll
              for (int j = 0; j < 8; ++j) ub[p * 16 + 8 + j] = f[j]; }
            __syncthreads();
            for (int tt = 0; tt < 64; ++tt) {
                const int t = d ? 63 - tt : tt;
                float bur = 0.f, bui = 0.f;
#pragma unroll
                for (int h4 = 0; h4 < 4; ++h4) { const f32x4 u = *(const LAS f32x4*)(ub + t * 16 + h4 * 4);
#pragma unroll
                    for (int j = 0; j < 4; ++j) { bur += bbr[h4 * 4 + j] * u[j]; bui += bbi[h4 * 4 + j] * u[j]; } }
                const float nxr = lbr * xr - lbi * xi + bur, nxi = lbr * xi + lbi * xr + bui;
                xr = nxr; xi = nxi;
                xb[par * 128 + p] = xr; xb[par * 128 + 64 + p] = xi;
                __syncthreads();
                float y = 0.f;
#pragma unroll
                for (int j4 = 0; j4 < 4; ++j4) { const f32x4 vr = *(const LAS f32x4*)(xb + par * 128 + pt * 16 + j4 * 4), vi = *(const LAS f32x4*)(xb + par * 128 + 64 + pt * 16 + j4 * 4);
#pragma unroll
                    for (int j = 0; j < 4; ++j) y += cr[j4 * 4 + j] * vr[j] - ci[j4 * 4 + j] * vi[j]; }
                y += shx(y, 16, p); y += shx(y, 32, p);
                if (p < 16) yb[t * 16 + p] = y;
                par ^= 1;
            }
            __syncthreads();
            { u32x4 w0, w1; const LAS float* ys = yb + p * 16;
              w0.x = pg8::cvt_pk_bf16(ys[0], ys[1]); w0.y = pg8::cvt_pk_bf16(ys[2], ys[3]); w0.z = pg8::cvt_pk_bf16(ys[4], ys[5]); w0.w = pg8::cvt_pk_bf16(ys[6], ys[7]);
              w1.x = pg8::cvt_pk_bf16(ys[8], ys[9]); w1.y = pg8::cvt_pk_bf16(ys[10], ys[11]); w1.z = pg8::cvt_pk_bf16(ys[12], ys[13]); w1.w = pg8::cvt_pk_bf16(ys[14], ys[15]);
              bf16_t* yp = Y + (size_t)(row0 + p) * 1024 + g * 16; *(u32x4*)yp = w0; *(u32x4*)(yp + 8) = w1; }
        }
        __syncthreads();
    }
}
DI void ph_s5_post(const Args& a, int l, bf16_t* YF, const bf16_t* YB, const bf16_t* U) {
    const float* dsk = a.in[I_SD] + l * 1024;
    for (size_t i = (size_t)blockIdx.x * NT + ltid(a); i < (size_t)MROWS * 128; i += (size_t)gridDim.x * NT) {
        const size_t off = i * 8; const int c = (int)(off & 1023);
        float f[8], bq[8], u[8]; unpack8(*(const u32x4*)(YF + off), f); unpack8(*(const u32x4*)(YB + off), bq); unpack8(*(const u32x4*)(U + off), u);
        const f32x4 d0 = *(const f32x4*)(dsk + c), d1 = *(const f32x4*)(dsk + c + 4);
        float o[8];
#pragma unroll
        for (int j = 0; j < 4; ++j) { o[j] = gelu_tanh_(f[j] + bq[j] + d0[j] * u[j]); o[4 + j] = gelu_tanh_(f[4 + j] + bq[4 + j] + d1[j] * u[4 + j]); }
        u32x4 w; w.x = pg8::cvt_pk_bf16(o[0], o[1]); w.y = pg8::cvt_pk_bf16(o[2], o[3]); w.z = pg8::cvt_pk_bf16(o[4], o[5]); w.w = pg8::cvt_pk_bf16(o[6], o[7]);
        *(u32x4*)(YF + off) = w;
    }
}

constexpr int S5_T = 16, S5_NCH = MROWS / S5_T  , S5_RG = 2304, S5_PMG = S5_RG / 256;
constexpr size_t SZ_AX = (size_t)64 * S5_RG * 512 * 2, SZ_CW1 = (size_t)64 * 256 * 256 * 2, SZ_CW2 = (size_t)64 * 256 * 512 * 2;
constexpr size_t R5_AX = 0, R5_SZ = SZ_AX, R5_G1 = R5_SZ + SZ_ACT, R5_GLUA = R5_G1 + SZ_ACT, R5_END = R5_GLUA + SZ_ACT;
static_assert(WS_R + R5_END <= WS_END, "S5 stage layout fits the workspace"); static_assert(WS_END <= (size_t)512 * 1024 * 1024, "workspace budget");
static_assert(SZ_CW1 + SZ_CW2 + (size_t)17 * 1024 * 128 * 4 <= SZ_ACT, "S5 constants live in the H region once the last projection from H is done");

struct EpiS1 {
    static constexpr bool PERM = true, AFTER_DRAIN = false;
    bf16_t* AX; bf16_t* SZ; bf16_t* G1;
    __device__ __forceinline__ void operator()(const f32x4 (&acc)[2][2][4][2], const Unit& u, int wr, int wc, int fr, int fq) const {
        const int row0 = u.pm * 256 + wr * 64 + fr, seg = u.pn >> 2;
        const int col0 = (u.pn & 3) * 256 + wc * 32 + 8 * fq;
#pragma unroll
        for (int ai = 0; ai < 2; ++ai)
#pragma unroll
            for (int m = 0; m < 4; ++m) {
                const int r = row0 + ai * 128 + m * 16;
#pragma unroll
                for (int bj = 0; bj < 2; ++bj) {
                    f32x4 v0 = acc[ai][bj][m][0], v1 = acc[ai][bj][m][1];
                    const int c = col0 + bj * 128;
                    bf16_t* dp;
                    if (seg == 0) dp = AX + ((size_t)(c >> 4) * S5_RG + (r >> 4)) * 512 + (r & 15) * 16 + (c & 15);
                    else if (seg == 1) { dp = SZ + (size_t)r * 1024 + c;
#pragma unroll
                        for (int j = 0; j < 4; ++j) { v0[j] = siluf_(v0[j]); v1[j] = siluf_(v1[j]); } }
                    else { dp = G1 + (size_t)r * 1024 + c;
#pragma unroll
                        for (int j = 0; j < 4; ++j) { v0[j] = sigmoidf_(v0[j]); v1[j] = sigmoidf_(v1[j]); } }
                    u32x4 w; w.x = pg8::cvt_pk_bf16(v0[0], v0[1]); w.y = pg8::cvt_pk_bf16(v0[2], v0[3]); w.z = pg8::cvt_pk_bf16(v1[0], v1[1]); w.w = pg8::cvt_pk_bf16(v1[2], v1[3]);
                    *(u32x4*)dp = w;
                }
            }
    }
};
struct EpiS5L {
    static constexpr bool PERM = true, AFTER_DRAIN = false;
    bf16_t* AX;
    __device__ __forceinline__ void operator()(const f32x4 (&acc)[2][2][4][2], const Unit& u, int wr, int wc, int fr, int fq) const {
        const int g = u.pm / S5_PMG, rg0 = (u.pm % S5_PMG) * 256 + wr * 64 + fr, col0 = wc * 32 + 8 * fq;
#pragma unroll
        for (int ai = 0; ai < 2; ++ai)
#pragma unroll
            for (int m = 0; m < 4; ++m) {
                const int rg = rg0 + ai * 128 + m * 16;
                if (rg < S5_NCH) {
                    bf16_t* rp = AX + ((size_t)g * S5_RG + rg) * 512 + 256 + col0;
#pragma unroll
                    for (int bj = 0; bj < 2; ++bj) { const f32x4 v0 = acc[ai][bj][m][0], v1 = acc[ai][bj][m][1];
                        u32x4 w; w.x = pg8::cvt_pk_bf16(v0[0], v0[1]); w.y = pg8::cvt_pk_bf16(v0[2], v0[3]); w.z = pg8::cvt_pk_bf16(v1[0], v1[1]); w.w = pg8::cvt_pk_bf16(v1[2], v1[3]);
                        *(u32x4*)(rp + bj * 128) = w; }
                }
            }
    }
};
struct EpiS5Y {
    static constexpr bool PERM = true, AFTER_DRAIN = false;
    const bf16_t* AX; bf16_t* GLUA; const float* dsk;
    __device__ __forceinline__ void operator()(const f32x4 (&acc)[2][2][4][2], const Unit& u, int wr, int wc, int fr, int fq) const {
        const int g = u.pm / S5_PMG, rg0 = (u.pm % S5_PMG) * 256 + wr * 64 + fr, col0 = wc * 32 + 8 * fq;
        const int h0 = col0 & 15;
        const f32x4 d0 = *(const f32x4*)(dsk + g * 16 + h0), d1 = *(const f32x4*)(dsk + g * 16 + h0 + 4);
#pragma unroll
        for (int ai = 0; ai < 2; ++ai)
#pragma unroll
            for (int m = 0; m < 4; ++m) {
                const int rg = rg0 + ai * 128 + m * 16;
                if (rg < S5_NCH) {
#pragma unroll
                    for (int bj = 0; bj < 2; ++bj) {
                        const int c = col0 + bj * 128, t = c >> 4;
                        float uu[8]; unpack8(*(const u32x4*)(AX + ((size_t)g * S5_RG + rg) * 512 + c), uu);
                        const f32x4 v0 = acc[ai][bj][m][0], v1 = acc[ai][bj][m][1];
                        float o[8];
#pragma unroll
                        for (int j = 0; j < 4; ++j) { o[j] = gelu_tanh_(v0[j] + d0[j] * uu[j]); o[4 + j] = gelu_tanh_(v1[j] + d1[j] * uu[4 + j]); }
                        u32x4 w; w.x = pg8::cvt_pk_bf16(o[0], o[1]); w.y = pg8::cvt_pk_bf16(o[2], o[3]); w.z = pg8::cvt_pk_bf16(o[4], o[5]); w.w = pg8::cvt_pk_bf16(o[6], o[7]);
                        *(u32x4*)(GLUA + (size_t)(rg * 16 + t) * 1024 + g * 16 + h0) = w;
                    }
                }
            }
    }
};
DI void ph_s5_consts(const Args& a, int l, bf16_t* CW1, bf16_t* CW2, LAS unsigned char* lds) {
    LAS float* POW = (LAS float*)lds;
    LAS float* BB = POW + 2 * 17 * 64 * 2;
    LAS float* CC = BB + 2 * 64 * 16 * 2;
    LAS float* KT = CC + 16 * 64 * 2;
    const int tid = ltid(a);
    for (int g = blockIdx.x; g < 64; g += gridDim.x) {
        __syncthreads();
        for (int i = tid; i < 2 * 17 * 64; i += NT) {
            const int p = i & 63, j = (i >> 6) % 17, d = i / (17 * 64);
            const float stp = expf(a.in[I_SLOG][(l * 2 + d) * 64 + g]);
            const float lre = a.in[I_SLRE][((size_t)(l * 2 + d) * 64 + g) * 64 + p], lim = a.in[I_SLIM][((size_t)(l * 2 + d) * 64 + g) * 64 + p];
            const float mag = expf((float)j * lre * stp), ang = (float)j * (lim * stp);
            POW[i * 2] = mag * cosf(ang); POW[i * 2 + 1] = mag * sinf(ang);
        }
        for (int i = tid; i < 16 * 64; i += NT) { const int p = i & 63, h = i >> 6;
            CC[i * 2] = a.in[I_SCRE][(((size_t)l * 64 + g) * 16 + h) * 64 + p]; CC[i * 2 + 1] = a.in[I_SCIM][(((size_t)l * 64 + g) * 16 + h) * 64 + p]; }
        __syncthreads();
        for (int i = tid; i < 2 * 64 * 16; i += NT) {
            const int h = i & 15, p = (i >> 4) & 63, d = i >> 10;
            const float stp = expf(a.in[I_SLOG][(l * 2 + d) * 64 + g]);
            const float lre = a.in[I_SLRE][((size_t)(l * 2 + d) * 64 + g) * 64 + p], lim = a.in[I_SLIM][((size_t)(l * 2 + d) * 64 + g) * 64 + p];
            const float lbr = POW[((d * 17 + 1) * 64 + p) * 2], lbi = POW[((d * 17 + 1) * 64 + p) * 2 + 1];
            const float dnm = lre * lre + lim * lim;
            const float fre = ((lbr - 1.0f) * lre + lbi * lim) / dnm, fim = (lbi * lre - (lbr - 1.0f) * lim) / dnm;
            const float br = a.in[I_SBRE][(((size_t)l * 64 + g) * 64 + p) * 16 + h], bi = a.in[I_SBIM][(((size_t)l * 64 + g) * 64 + p) * 16 + h];
            BB[i * 2] = fre * br - fim * bi; BB[i * 2 + 1] = fre * bi + fim * br;
        }
        __syncthreads();
        { const int hp = tid & 15, h = (tid >> 4) & 15, d = tid >> 8;
          float kt[16];
#pragma unroll
          for (int tau = 0; tau < 16; ++tau) kt[tau] = 0.f;
          for (int p = 0; p < 64; ++p) {
              const float cr = CC[(h * 64 + p) * 2], ci = CC[(h * 64 + p) * 2 + 1];
              const float br = BB[((d * 64 + p) * 16 + hp) * 2], bi = BB[((d * 64 + p) * 16 + hp) * 2 + 1];
              const float gr = cr * br - ci * bi, gi = cr * bi + ci * br;
#pragma unroll
              for (int tau = 0; tau < 16; ++tau) { const float pr = POW[((d * 17 + tau) * 64 + p) * 2], pi = POW[((d * 17 + tau) * 64 + p) * 2 + 1]; kt[tau] += gr * pr - gi * pi; } }
#pragma unroll
          for (int tau = 0; tau < 16; ++tau) KT[((d * 16 + tau) * 16 + h) * 16 + hp] = kt[tau]; }
        __syncthreads();
        bf16_t* c1 = CW1 + (size_t)g * 65536;
        for (int i = tid; i < 65536 / 2; i += NT) {
            const int k = (i * 2) & 255, n = (i * 2) >> 8; const int p = n & 63, ri = (n >> 6) & 1, d = n >> 7, s = k >> 4, hp = k & 15;
            const int j = d ? s : 15 - s;
            const float pr = POW[((d * 17 + j) * 64 + p) * 2], pi = POW[((d * 17 + j) * 64 + p) * 2 + 1];
            float o[2];
#pragma unroll
            for (int q = 0; q < 2; ++q) { const float br = BB[((d * 64 + p) * 16 + hp + q) * 2], bi = BB[((d * 64 + p) * 16 + hp + q) * 2 + 1]; o[q] = ri ? (pr * bi + pi * br) : (pr * br - pi * bi); }
            *(unsigned*)(c1 + (size_t)n * 256 + k) = pg8::cvt_pk_bf16(o[0], o[1]);
        }
        bf16_t* c2 = CW2 + (size_t)g * 131072;
        for (int i = tid; i < 131072 / 2; i += NT) {
            const int k = (i * 2) & 511, n = (i * 2) >> 9; const int t = n >> 4, h = n & 15;
            float o[2];
            if (k < 256) { const int s = k >> 4, hp = k & 15;
#pragma unroll
                for (int q = 0; q < 2; ++q) { float v = 0.f; if (s <= t) v += KT[((0 * 16 + (t - s)) * 16 + h) * 16 + hp + q]; if (s >= t) v += KT[((1 * 16 + (s - t)) * 16 + h) * 16 + hp + q]; o[q] = v; } }
            else { const int kk = k - 256, d = kk >> 7, ri = (kk >> 6) & 1; const int j = d ? 16 - t : t + 1;
#pragma unroll
                for (int q = 0; q < 2; ++q) { const int p = (kk & 63) + q; const float cr = CC[(h * 64 + p) * 2], ci = CC[(h * 64 + p) * 2 + 1];
                    const float pr = POW[((d * 17 + j) * 64 + p) * 2], pi = POW[((d * 17 + j) * 64 + p) * 2 + 1];
                    o[q] = ri ? -(cr * pi + ci * pr) : (cr * pr - ci * pi); } }
            *(unsigned*)(c2 + (size_t)n * 512 + k) = pg8::cvt_pk_bf16(o[0], o[1]);
        }
    }
    __syncthreads();
}
DI int s5_row(int b, int d, int st) { const int cc = (st < 16) ? (d ? 15 - st : st) : (d ? 271 - st : st - 16); return (st < 16) ? b * 16 + cc : 128 + b * 256 + cc; }
DI void s5_lane_consts(const Args& a, int l, int d, int g, int p, float& ar, float& ai) {
    const float stp = expf(a.in[I_SLOG][(l * 2 + d) * 64 + g]);
    const float lre = a.in[I_SLRE][((size_t)(l * 2 + d) * 64 + g) * 64 + p], lim = a.in[I_SLIM][((size_t)(l * 2 + d) * 64 + g) * 64 + p];
    const float mag = expf(16.0f * lre * stp), ang = 16.0f * (lim * stp);
    ar = mag * cosf(ang); ai = mag * sinf(ang);
}
DI void ph_s5_carry1(const Args& a, int l, bf16_t* AX, float* SEG) {
    const int tid = ltid(a), w = tid >> 6, p = tid & 63;
    for (int item = blockIdx.x * 8 + w; item < 17 * 1024; item += gridDim.x * 8) {
        const int unit = item & 1023, seg = item >> 10, d = unit & 1, g = (unit >> 1) & 63, b = unit >> 7;
        float ar, ai; s5_lane_consts(a, l, d, g, p, ar, ai);
        bf16_t* base = AX + (size_t)g * S5_RG * 512 + 256 + d * 128 + p;
        float lr[16], li[16];
#pragma unroll
        for (int q = 0; q < 16; ++q) { const size_t o = (size_t)s5_row(b, d, seg * 16 + q) * 512; lr[q] = bf2f(base[o]); li[q] = bf2f(base[o + 64]); }
        float xr = 0.f, xi = 0.f;
#pragma unroll
        for (int q = 0; q < 16; ++q) { const size_t o = (size_t)s5_row(b, d, seg * 16 + q) * 512;
            base[o] = f2bf(xr); base[o + 64] = f2bf(xi);
            const float nr = ar * xr - ai * xi + lr[q], ni = ar * xi + ai * xr + li[q]; xr = nr; xi = ni; }
        SEG[((size_t)seg * 1024 + unit) * 128 + p] = xr; SEG[((size_t)seg * 1024 + unit) * 128 + 64 + p] = xi;
    }
}
DI void ph_s5_carry2(const Args& a, int l, bf16_t* AX, const float* SEG) {
    const int tid = ltid(a), w = tid >> 6, p = tid & 63;
    for (int item = blockIdx.x * 8 + w; item < 16 * 1024; item += gridDim.x * 8) {
        const int unit = item & 1023, seg = 1 + (item >> 10), d = unit & 1, g = (unit >> 1) & 63, b = unit >> 7;
        float ar, ai; s5_lane_consts(a, l, d, g, p, ar, ai);
        float sr = ar, si = ai;
#pragma unroll
        for (int q = 0; q < 4; ++q) { const float nr = sr * sr - si * si, ni = 2.0f * sr * si; sr = nr; si = ni; }
        float xr = 0.f, xi = 0.f;
        { float er[16], ei[16];
#pragma unroll
          for (int s2 = 0; s2 < 16; ++s2) { const bool on = s2 < seg; er[s2] = on ? SEG[((size_t)s2 * 1024 + unit) * 128 + p] : 0.f; ei[s2] = on ? SEG[((size_t)s2 * 1024 + unit) * 128 + 64 + p] : 0.f; }
#pragma unroll
          for (int s2 = 0; s2 < 16; ++s2) if (s2 < seg) { const float nr = sr * xr - si * xi + er[s2], ni = sr * xi + si * xr + ei[s2]; xr = nr; xi = ni; } }
        bf16_t* base = AX + (size_t)g * S5_RG * 512 + 256 + d * 128 + p;
        float lr[16], li[16];
#pragma unroll
        for (int q = 0; q < 16; ++q) { const size_t o = (size_t)s5_row(b, d, seg * 16 + q) * 512; lr[q] = bf2f(base[o]); li[q] = bf2f(base[o + 64]); }
#pragma unroll
        for (int q = 0; q < 16; ++q) { const size_t o = (size_t)s5_row(b, d, seg * 16 + q) * 512;
            base[o] = f2bf(lr[q] + xr); base[o + 64] = f2bf(li[q] + xi);
            const float nr = ar * xr - ai * xi, ni = ar * xi + ai * xr; xr = nr; xi = ni; }
    }
}

typedef short bf16x8v __attribute__((ext_vector_type(8)));
typedef short s16x4v __attribute__((ext_vector_type(4)));
typedef __bf16 bfx2_t __attribute__((ext_vector_type(2)));
typedef float f32x2_t __attribute__((ext_vector_type(2)));
#define MFMA16(a_, b_, c_) __builtin_amdgcn_mfma_f32_16x16x32_bf16((a_), (b_), (c_), 0, 0, 0)
DI unsigned pk2(float lo, float hi) { const bfx2_t v = __builtin_convertvector((f32x2_t){lo, hi}, bfx2_t); return __builtin_bit_cast(unsigned, v); }
DI int sw512(int r, int cb) { return r * 512 + (cb ^ ((r & 15) << 4)); }
DI int sw128(int r, int cb) { return r * 128 + (cb ^ ((r & 7) << 4)); }
DI bf16x8v ldsfrag(LAS unsigned char* base, int off) { return *(const LAS bf16x8v*)(base + off); }
DI bf16x8v ldsfrag2(LAS unsigned char* base, int off0, int off1) { const s16x4v lo = *(const LAS s16x4v*)(base + off0), hi = *(const LAS s16x4v*)(base + off1); return __builtin_shufflevector(lo, hi, 0, 1, 2, 3, 4, 5, 6, 7); }
constexpr int ML_GSET = 448;
DI void ml_gates(float igr, float fgr, float ibias, float fbias, int d, float& ms, LAS float* gs, int L) {
    asm volatile("" : "+v"(L));
    const int t = d ? 63 - L : L;
    const float ipv = igr + ibias, lfv = -softplusf_(-(fgr + fbias));
    float bc = lfv;
#pragma unroll
    for (int o = 1; o < 64; o <<= 1) { const float x = shup(bc, o, L); if (L >= o) bc += x; }
    const float aj = ipv - bc;
    float cm = aj;
#pragma unroll
    for (int o = 1; o < 64; o <<= 1) { const float x = shup(cm, o, L); if (L >= o) cm = fmaxf(cm, x); }
    const float mt = fmaxf(bc + ms, bc + cm);
    const float bend = shidx(bc, 63);
    const float le = bend - bc + ipv;
    float mle = le;
#pragma unroll
    for (int o = 32; o >= 1; o >>= 1) mle = fmaxf(mle, shx(mle, o, L));
    const float mnew = fmaxf(bend + ms, mle);
    gs[t] = bc; gs[64 + t] = aj; gs[128 + t] = mt; gs[192 + t] = __expf(bc + ms - mt); gs[256 + t] = __expf(-mt); gs[320 + t] = __expf(le - mnew) * 0.0625f;
    if (L == 0) gs[384] = __expf(bend + ms - mnew);
    ms = mnew;
}
DI bf16x8v ldstr2(LAS unsigned char* p0, LAS unsigned char* p1) {
    const s16x4v lo = __builtin_amdgcn_ds_read_tr16_b64_v4i16((LAS s16x4v*)p0), hi = __builtin_amdgcn_ds_read_tr16_b64_v4i16((LAS s16x4v*)p1);
    return __builtin_shufflevector(lo, hi, 0, 1, 2, 3, 4, 5, 6, 7); }
DI void ph_ml_scan_mfma(const Args& a, int l, const bf16_t* Q, const bf16_t* K, const bf16_t* V, const float* GATE, bf16_t* HF, bf16_t* HB, LAS unsigned char* lds) {
    constexpr int PQ = 528, PK = 544, PV = 288, PW = 144;
    LAS unsigned char* qs = lds;
    LAS unsigned char* kn = lds + 33792;
    LAS unsigned char* vn = lds + 68608;
    LAS unsigned char* vs = lds + 87040;
    LAS unsigned char* Wm = lds + 105472;
    LAS float* sm = (LAS float*)(lds + 114688);
    LAS float* rsW = sm + 2 * ML_GSET; LAS float* qn = rsW + 128; LAS float* nvec = qn + 64;
    const int tid = ltid(a), w = tid >> 6, ln = tid & 63, l16 = ln & 15, h4 = ln >> 4, tq = (ln & 15) >> 2, tp = ln & 3;
    for (int unit = blockIdx.x; unit < 128; unit += gridDim.x) {
        const int eh = unit & 1, d = (unit >> 1) & 1, hd = (unit >> 2) & 3, b = unit >> 4;
        const float ibias = a.in[I_MIB][(l * 2 + d) * 4 + hd], fbias = a.in[I_MFB][(l * 2 + d) * 4 + hd];
        bf16_t* HO = d ? HB : HF;
        f32x4 Cacc[16];
#pragma unroll
        for (int i = 0; i < 16; ++i) Cacc[i] = (f32x4){0.f, 0.f, 0.f, 0.f};
        float ms = 0.f;
        __syncthreads();
        if (tid < 256) nvec[tid] = 0.f;
#define ML_ROW0(step) (((step) < 4) ? b * 256 + (d ? 3 - (step) : (step)) * 64 : CTXROWS + b * 4096 + (d ? 67 - (step) : (step) - 4) * 64)
        u32x4 pq[4], pk[4], pv[2]; float gi = 0.f, gf = 0.f;
        { const int row0 = ML_ROW0(0);
#pragma unroll
          for (int q = 0; q < 4; ++q) { const int p = tid + 512 * q, r = p >> 5, c8 = p & 31; pq[q] = *(const u32x4*)(Q + (size_t)(row0 + r) * 1024 + hd * 256 + c8 * 8); pk[q] = *(const u32x4*)(K + (size_t)(row0 + r) * 1024 + hd * 256 + c8 * 8); }
#pragma unroll
          for (int q = 0; q < 2; ++q) { const int p = tid + 512 * q, r = p >> 4, c8 = p & 15; pv[q] = *(const u32x4*)(V + (size_t)(row0 + r) * 1024 + hd * 256 + eh * 128 + c8 * 8); }
          if (w == 0) { const int t = d ? 63 - ln : ln; const float* gp = GATE + (size_t)(row0 + t) * 32; gi = gp[d * 4 + hd]; gf = gp[8 + d * 4 + hd]; ml_gates(gi, gf, ibias, fbias, d, ms, sm, ln); } }
        __syncthreads();
        for (int step = 0; step < 68; ++step) {
            const int par = step & 1; LAS float* gs = sm + par * ML_GSET;
            const int row0 = ML_ROW0(step);
#pragma unroll
            for (int q = 0; q < 4; ++q) { const int p = tid + 512 * q, r = p >> 5, c8 = p & 31;
                *(LAS u32x4*)(qs + r * PQ + c8 * 16) = pq[q]; *(LAS u32x4*)(kn + r * PK + c8 * 16) = pk[q]; }
#pragma unroll
            for (int q = 0; q < 2; ++q) { const int p = tid + 512 * q, r = p >> 4, c8 = p & 15;
                *(LAS u32x4*)(vn + r * PV + c8 * 16) = pv[q];
                float f[8]; unpack8(pv[q], f); const float ws = gs[320 + r];
                u32x4 o; o.x = pk2(f[0] * ws, f[1] * ws); o.y = pk2(f[2] * ws, f[3] * ws); o.z = pk2(f[4] * ws, f[5] * ws); o.w = pk2(f[6] * ws, f[7] * ws);
                *(LAS u32x4*)(vs + r * PV + c8 * 16) = o; }
            if (step + 1 < 68) { const int rown = ML_ROW0(step + 1);
#pragma unroll
                for (int q = 0; q < 4; ++q) { const int p = tid + 512 * q, r = p >> 5, c8 = p & 31; pq[q] = *(const u32x4*)(Q + (size_t)(rown + r) * 1024 + hd * 256 + c8 * 8); pk[q] = *(const u32x4*)(K + (size_t)(rown + r) * 1024 + hd * 256 + c8 * 8); }
#pragma unroll
                for (int q = 0; q < 2; ++q) { const int p = tid + 512 * q, r = p >> 4, c8 = p & 15; pv[q] = *(const u32x4*)(V + (size_t)(rown + r) * 1024 + hd * 256 + eh * 128 + c8 * 8); }
                if (w == 0) { const int t = d ? 63 - ln : ln; const float* gp = GATE + (size_t)(rown + t) * 32; gi = gp[d * 4 + hd]; gf = gp[8 + d * 4 + hd]; } }
            lds_barrier();
            { const int it = w >> 1, jp = w & 1, i = it * 16 + l16;
              f32x4 a0 = (f32x4){0.f, 0.f, 0.f, 0.f}, a1 = a0;
              LAS unsigned char* qb = qs + (it * 16 + l16) * PQ + h4 * 16; LAS unsigned char* kb = kn + ((2 * jp) * 16 + l16) * PK + h4 * 16;
#pragma unroll
              for (int ks = 0; ks < 8; ++ks) {
                  const bf16x8v bq = ldsfrag(qb, ks * 64);
                  const bf16x8v k0 = ldsfrag(kb, ks * 64), k1 = ldsfrag(kb, 16 * PK + ks * 64);
                  a0 = MFMA16(k0, bq, a0); a1 = MFMA16(k1, bq, a1); }
              const float bci = gs[i], mti = gs[128 + i];
              float rs = 0.f;
#pragma unroll
              for (int t2 = 0; t2 < 2; ++t2) { const int j0 = (2 * jp + t2) * 16 + 4 * h4; const f32x4 ajv = *(const LAS f32x4*)(gs + 64 + j0); const f32x4 av = t2 ? a1 : a0;
                  float wv[4];
#pragma unroll
                  for (int r = 0; r < 4; ++r) { const int j = j0 + r; const bool valid = d ? (j >= i) : (j <= i); const float e = __expf(bci + ajv[r] - mti) * av[r] * 0.0625f; wv[r] = valid ? e : 0.f; rs += wv[r]; }
                  u32x2 pw; pw.x = pk2(wv[0], wv[1]); pw.y = pk2(wv[2], wv[3]);
                  *(LAS u32x2*)(Wm + i * PW + j0 * 2) = pw; }
              int lnl = ln; asm volatile("" : "+v"(lnl)); rs += shx(rs, 16, lnl); rs += shx(rs, 32, lnl);
              if (h4 == 0) rsW[jp * 64 + i] = rs;
              const f32x4 nv = *(const LAS f32x4*)(nvec + 4 * ln);
#pragma unroll
              for (int rr = 0; rr < 8; ++rr) { const int ir = 8 * w + rr; const u32x2 qw = *(const LAS u32x2*)(qs + ir * PQ + 8 * ln);
                  float s = bflo(qw.x) * nv[0] + bfhi(qw.x) * nv[1] + bflo(qw.y) * nv[2] + bfhi(qw.y) * nv[3];
                  s = wave_sum(s, lnl); if (ln == 0) qn[ir] = s; } }
            lds_barrier();
            { f32x4 num[4];
#pragma unroll
              for (int it = 0; it < 4; ++it) num[it] = (f32x4){0.f, 0.f, 0.f, 0.f};
              LAS unsigned char* qb2 = qs + l16 * PQ + 8 * h4;
#pragma unroll
              for (int ks = 0; ks < 8; ++ks) {
                  u32x4 bw; bw.x = pk2(Cacc[2 * ks][0], Cacc[2 * ks][1]); bw.y = pk2(Cacc[2 * ks][2], Cacc[2 * ks][3]); bw.z = pk2(Cacc[2 * ks + 1][0], Cacc[2 * ks + 1][1]); bw.w = pk2(Cacc[2 * ks + 1][2], Cacc[2 * ks + 1][3]);
                  const bf16x8v bfr = __builtin_bit_cast(bf16x8v, bw);
#pragma unroll
                  for (int it = 0; it < 4; ++it) { const bf16x8v af = ldsfrag2(qb2, it * 16 * PQ + 64 * ks, it * 16 * PQ + 64 * ks + 32); num[it] = MFMA16(af, bfr, num[it]); } asm volatile("" ::: "memory"); }
#pragma unroll
              for (int it = 0; it < 4; ++it) { const f32x4 wi = *(const LAS f32x4*)(gs + 192 + it * 16 + 4 * h4); num[it] = num[it] * wi; }
              LAS unsigned char* trb = (LAS unsigned char*)0 + (8 * h4 + tq) * PV + 8 * tp + 32 * w;
              bf16x8v bv[2];
#pragma unroll
              for (int kk = 0; kk < 2; ++kk) bv[kk] = ldstr2(vn + (size_t)trb + (32 * kk) * PV, vn + (size_t)trb + (32 * kk + 4) * PV);
              LAS unsigned char* wb = Wm + l16 * PW + 16 * h4;
#pragma unroll
              for (int kk = 0; kk < 2; ++kk)
#pragma unroll
                  for (int it = 0; it < 4; ++it) { const bf16x8v aw = ldsfrag(wb, it * 16 * PW + 64 * kk); num[it] = MFMA16(aw, bv[kk], num[it]); }
              asm volatile("" ::: "memory");
#pragma unroll
              for (int it = 0; it < 4; ++it) { const int i0 = it * 16 + 4 * h4;
                  const f32x4 r0 = *(const LAS f32x4*)(rsW + i0), r1 = *(const LAS f32x4*)(rsW + 64 + i0), wi = *(const LAS f32x4*)(gs + 192 + i0), qv = *(const LAS f32x4*)(qn + i0), nr = *(const LAS f32x4*)(gs + 256 + i0);
#pragma unroll
                  for (int r = 0; r < 4; ++r) { const float den = r0[r] + r1[r] + wi[r] * qv[r]; const float hv = num[it][r] / fmaxf(fabsf(den), nr[r]);
                      HO[(size_t)(row0 + i0 + r) * 1024 + hd * 256 + eh * 128 + 16 * w + l16] = (bf16_t)(pk2(hv, 0.f) & 0xffffu); } asm volatile("" ::: "memory"); }
              const float decay = gs[384];
              bf16x8v bs[2];
#pragma unroll
              for (int kk = 0; kk < 2; ++kk) bs[kk] = ldstr2(vs + (size_t)trb + (32 * kk) * PV, vs + (size_t)trb + (32 * kk + 4) * PV);
#pragma unroll
              for (int dt = 0; dt < 16; ++dt) Cacc[dt] = Cacc[dt] * decay;
              LAS unsigned char* ktb = kn + (8 * h4 + tq) * PK + 8 * tp;
#pragma unroll
              for (int kk = 0; kk < 2; ++kk)
#pragma unroll
                  for (int dt = 0; dt < 16; ++dt) { const bf16x8v ak = ldstr2(ktb + (32 * kk) * PK + 32 * dt, ktb + (32 * kk + 4) * PK + 32 * dt); Cacc[dt] = MFMA16(ak, bs[kk], Cacc[dt]); if ((dt & 1) == 1) asm volatile("" ::: "memory"); }
              if (tid < 256) { float s = 0.f;
#pragma unroll 8
                  for (int j = 0; j < 64; ++j) s += gs[320 + j] * bf2f(*(const LAS bf16_t*)(kn + j * PK + 2 * tid));
                  nvec[tid] = decay * nvec[tid] + s; }
              if (w == 0 && step + 1 < 68) ml_gates(gi, gf, ibias, fbias, d, ms, sm + (par ^ 1) * ML_GSET, ln); }
            lds_barrier();
        }
#undef ML_ROW0
    }
}

#ifndef SUBDUP
#define SUBDUP 0
#endif
#define MFMA16K16(a_, b_, c_) __builtin_amdgcn_mfma_f32_16x16x16bf16_1k((a_), (b_), (c_), 0, 0, 0)
DI s16x4v pack4(const f32x4 v) { u32x2 w; w.x = pk2(v[0], v[1]); w.y = pk2(v[2], v[3]); return __builtin_bit_cast(s16x4v, w); }
DI s16x4v lds8(LAS unsigned char* p) { return *(const LAS s16x4v*)p; }
DI s16x4v ldstr1(LAS unsigned char* p) { return __builtin_amdgcn_ds_read_tr16_b64_v4i16((LAS s16x4v*)p); }
constexpr int GD_GSET = 384;
DI void gdn_gates(float araw, float braw, float nea, float dtb, LAS float* gs, int L, int d) {
    asm volatile("" : "+v"(L));
    const int t = d ? 63 - L : L;
    float gc = nea * softplusf_(araw + dtb);
#pragma unroll
    for (int o = 1; o < 64; o <<= 1) { const float x = shup(gc, o, L); if (L >= o) gc += x; }
    const float gl = shidx(gc, 63);
    gs[t] = gc; gs[64 + t] = sigmoidf_(braw); gs[128 + t] = __expf(gc); gs[192 + t] = __expf(gl - gc);
    if (L == 0) gs[256] = __expf(gl);
}
DI void ph_gdn_scan_mfma(const Args& a, int l, const bf16_t* Q, const bf16_t* K, const bf16_t* V, const float* GATE, bf16_t* OF, bf16_t* OB, LAS unsigned char* lds) {
    constexpr int PQ = 272, PK = 288, PV = 288, PA = 144, PD = 48;
    LAS unsigned char* qh = lds;
    LAS unsigned char* kh = lds + 17408;
    LAS unsigned char* vv = lds + 35840;
    LAS unsigned char* AM = lds + 54272;
    LAS unsigned char* QM = lds + 63488;
    LAS unsigned char* DINV = lds + 72704;
    LAS float* sm = (LAS float*)(lds + 75776);
    const int tid = ltid(a), w = tid >> 6, ln = tid & 63, l16 = ln & 15, h4 = ln >> 4, tq = (ln & 15) >> 2, tp = ln & 3;
    for (int unit = blockIdx.x; unit < 128; unit += gridDim.x) {
        const int d = unit & 1, h = (unit >> 1) & 7, b = unit >> 4;
        const float nea = -__expf(a.in[I_GALOG][(l * 2 + d) * 8 + h]), dtb = a.in[I_GDTB][(l * 2 + d) * 8 + h];
        bf16_t* O = d ? OB : OF;
        f32x4 S[8];
#pragma unroll
        for (int i = 0; i < 8; ++i) S[i] = (f32x4){0.f, 0.f, 0.f, 0.f};
#define GD_ROW0(step) (((step) < 4) ? b * 256 + (d ? 3 - (step) : (step)) * 64 : CTXROWS + b * 4096 + (d ? 67 - (step) : (step) - 4) * 64)
        u32x4 pq[2], pk[2], pv[2]; float ga = 0.f, gb = 0.f;
        __syncthreads();
        { const int row0 = GD_ROW0(0);
#pragma unroll
          for (int q = 0; q < 2; ++q) { const int p = tid + 512 * q, r = p >> 4, c8 = p & 15; const size_t go = (size_t)(row0 + r) * 1024 + h * 128 + c8 * 8;
              pq[q] = *(const u32x4*)(Q + go); pk[q] = *(const u32x4*)(K + go); pv[q] = *(const u32x4*)(V + go); }
          if (w == 0) { const int t = d ? 63 - ln : ln; const float* gp = GATE + (size_t)(row0 + t) * 32; ga = gp[d * 8 + h]; gb = gp[16 + d * 8 + h]; gdn_gates(ga, gb, nea, dtb, sm, ln, d); } }
        __syncthreads();
        for (int step = 0; step < 68; ++step) {
            const int par = step & 1; LAS float* gs = sm + par * GD_GSET;
            const int row0 = GD_ROW0(step);
#pragma unroll
            for (int q = 0; q < 2; ++q) { const int p = tid + 512 * q, r = p >> 4, c8 = p & 15;
                *(LAS u32x4*)(qh + r * PQ + c8 * 16) = pq[q]; *(LAS u32x4*)(kh + r * PK + c8 * 16) = pk[q]; *(LAS u32x4*)(vv + r * PV + c8 * 16) = pv[q]; }
            if (step + 1 < 68) { const int rown = GD_ROW0(step + 1);
#pragma unroll
                for (int q = 0; q < 2; ++q) { const int p = tid + 512 * q, r = p >> 4, c8 = p & 15; const size_t go = (size_t)(rown + r) * 1024 + h * 128 + c8 * 8;
                    pq[q] = *(const u32x4*)(Q + go); pk[q] = *(const u32x4*)(K + go); pv[q] = *(const u32x4*)(V + go); }
                if (w == 0) { const int t = d ? 63 - ln : ln; const float* gp = GATE + (size_t)(rown + t) * 32; ga = gp[d * 8 + h]; gb = gp[16 + d * 8 + h]; } }
            lds_barrier(); if (SUBDUP == 5) lds_barrier();
            for (int sr_ = 0; sr_ < (SUBDUP == 1 ? 2 : 1); ++sr_) { const int it = w >> 1, jp = w & 1, i = it * 16 + l16;
              f32x4 kk0 = (f32x4){0.f, 0.f, 0.f, 0.f}, kk1 = kk0, qk0 = kk0, qk1 = kk0;
              LAS unsigned char* kb = kh + ((2 * jp) * 16 + l16) * PK + h4 * 16; LAS unsigned char* xk = kh + i * PK + h4 * 16; LAS unsigned char* xq = qh + i * PQ + h4 * 16;
#pragma unroll
              for (int ks = 0; ks < 4; ++ks) { const bf16x8v a0 = ldsfrag(kb, ks * 64), a1 = ldsfrag(kb, 16 * PK + ks * 64), bk = ldsfrag(xk, ks * 64), bq = ldsfrag(xq, ks * 64);
                  kk0 = MFMA16(a0, bk, kk0); kk1 = MFMA16(a1, bk, kk1); qk0 = MFMA16(a0, bq, qk0); qk1 = MFMA16(a1, bq, qk1); }
              const float gci = gs[i], bi = gs[64 + i];
#pragma unroll
              for (int t2 = 0; t2 < 2; ++t2) { const int j0 = (2 * jp + t2) * 16 + 4 * h4; const f32x4 gcj = *(const LAS f32x4*)(gs + j0); const f32x4 kkv = t2 ? kk1 : kk0, qkv = t2 ? qk1 : qk0;
                  float am[4], qm[4];
#pragma unroll
                  for (int r = 0; r < 4; ++r) { const int j = j0 + r; const bool valid = d ? (j >= i) : (j <= i); const float e = __expf(gci - gcj[r]);
                      am[r] = (valid && j != i) ? -bi * kkv[r] * e : 0.f; qm[r] = valid ? qkv[r] * e : 0.f; }
                  u32x2 pa, pm; pa.x = pk2(am[0], am[1]); pa.y = pk2(am[2], am[3]); pm.x = pk2(qm[0], qm[1]); pm.y = pk2(qm[2], qm[3]);
                  *(LAS u32x2*)(AM + i * PA + j0 * 2) = pa; *(LAS u32x2*)(QM + i * PA + j0 * 2) = pm; } }
            lds_barrier(); if (SUBDUP == 5) lds_barrier();
            for (int sr_ = 0; sr_ < (SUBDUP == 2 ? 2 : 1); ++sr_) if (w == 0) { const int I = ln >> 4, c = ln & 15, cp = d ? 15 - c : c;
                float Dr[16];
                Dr[0] = (cp == 0) ? 1.f : 0.f;
#pragma unroll
                for (int ip = 1; ip < 16; ++ip) { const int r = d ? 15 - ip : ip;
                    LAS unsigned char* rp = AM + (16 * I + r) * PA + (16 * I) * 2;
                    float av[16]; { float f[8]; unpack8(*(const LAS u32x4*)rp, f);
#pragma unroll
                        for (int j = 0; j < 8; ++j) av[j] = f[j];
                        unpack8(*(const LAS u32x4*)(rp + 16), f);
#pragma unroll
                        for (int j = 0; j < 8; ++j) av[8 + j] = f[j]; }
                    float s = (cp == ip) ? 1.f : 0.f;
#pragma unroll
                    for (int jq = 0; jq < ip; ++jq) { const float aval = d ? av[15 - jq] : av[jq]; s += aval * Dr[jq]; }
                    Dr[ip] = s; }
#pragma unroll
                for (int ip = 0; ip < 16; ++ip) { const int r = d ? 15 - ip : ip; *(LAS bf16_t*)(DINV + (16 * I + r) * PD + 2 * c) = (bf16_t)(pk2(Dr[ip], 0.f) & 0xffffu); } }
            s16x4v sf[8];
#pragma unroll
            for (int dt = 0; dt < 8; ++dt) sf[dt] = pack4(S[dt]);
            f32x4 Rt[4], Qs[4];
#pragma unroll
            for (int Tp = 0; Tp < 4; ++Tp) { const int ro = 16 * (d ? 3 - Tp : Tp);
                f32x4 ksv = (f32x4){0.f, 0.f, 0.f, 0.f}, qsv = ksv;
                LAS unsigned char* ka = kh + (ro + l16) * PK + 8 * h4; LAS unsigned char* qa = qh + (ro + l16) * PQ + 8 * h4;
#pragma unroll
                for (int dt = 0; dt < 8; ++dt) { ksv = MFMA16K16(lds8(ka + 32 * dt), sf[dt], ksv); qsv = MFMA16K16(lds8(qa + 32 * dt), sf[dt], qsv); }
                const s16x4v v4 = ldstr1(vv + (ro + 4 * h4 + tq) * PV + (16 * w + 4 * tp) * 2);
                const f32x4 be = *(const LAS f32x4*)(gs + 64 + ro + 4 * h4), eg = *(const LAS f32x4*)(gs + 128 + ro + 4 * h4);
#pragma unroll
                for (int r = 0; r < 4; ++r) { Rt[Tp][r] = be[r] * (bf2f((bf16_t)v4[r]) - eg[r] * ksv[r]); Qs[Tp][r] = eg[r] * qsv[r]; }
                asm volatile("" ::: "memory"); }
            lds_barrier(); if (SUBDUP == 5) lds_barrier();
            { s16x4v vf[4]; f32x4 vn[4];
#pragma unroll
              for (int Tp = 0; Tp < 4; ++Tp) { const int ro = 16 * (d ? 3 - Tp : Tp);
                  f32x4 X = Rt[Tp];
#pragma unroll
                  for (int Jp = 0; Jp < Tp; ++Jp) { const int co = 16 * (d ? 3 - Jp : Jp); X = MFMA16K16(lds8(AM + (ro + l16) * PA + (co + 4 * h4) * 2), vf[Jp], X); }
                  const s16x4v xf = pack4(X);
                  vn[Tp] = MFMA16K16(lds8(DINV + (ro + l16) * PD + 8 * h4), xf, ((f32x4){0.f, 0.f, 0.f, 0.f}));
                  vf[Tp] = pack4(vn[Tp]); }
#pragma unroll
              for (int Tp = 0; Tp < 4; ++Tp) { const int ro = 16 * (d ? 3 - Tp : Tp);
                  f32x4 o = Qs[Tp];
#pragma unroll
                  for (int Jp = 0; Jp <= Tp; ++Jp) { const int co = 16 * (d ? 3 - Jp : Jp); o = MFMA16K16(lds8(QM + (ro + l16) * PA + (co + 4 * h4) * 2), vf[Jp], o); }
#pragma unroll
                  for (int r = 0; r < 4; ++r) O[(size_t)(row0 + ro + 4 * h4 + r) * 1024 + h * 128 + 16 * w + l16] = (bf16_t)(pk2(o[r], 0.f) & 0xffffu);
                  asm volatile("" ::: "memory"); }
              const float gend = gs[256];
              s16x4v vsf[4];
#pragma unroll
              for (int Jp = 0; Jp < 4; ++Jp) { const int co = 16 * (d ? 3 - Jp : Jp); const f32x4 ee = *(const LAS f32x4*)(gs + 192 + co + 4 * h4); vsf[Jp] = pack4(vn[Jp] * ee); }
#pragma unroll
              for (int dt = 0; dt < 8; ++dt) { S[dt] = S[dt] * gend;
#pragma unroll
                  for (int Jp = 0; Jp < 4; ++Jp) { const int co = 16 * (d ? 3 - Jp : Jp); S[dt] = MFMA16K16(ldstr1(kh + (co + 4 * h4 + tq) * PK + (16 * dt + 4 * tp) * 2), vsf[Jp], S[dt]); }
                  if (dt & 1) asm volatile("" ::: "memory"); } }
            for (int sr_ = 0; sr_ < (SUBDUP == 3 ? 2 : 1); ++sr_) if (w == 0 && step + 1 < 68) gdn_gates(ga, gb, nea, dtb, sm + (par ^ 1) * GD_GSET, ln, d);
            lds_barrier(); if (SUBDUP == 5) lds_barrier();
        }
#undef GD_ROW0
    }
}

#ifndef DUP_PHASE
#define DUP_PHASE -1
#endif
constexpr int NPH_LAYER = 21, PH_FINAL = 2 + DEPTH * NPH_LAYER, NPHASE = PH_FINAL + 1;
template <class Epi>
DI void run_gemm(int tid, LAS unsigned char* lds, const bf16_t* A, const bf16_t* Bt, int M, int N, const Epi& E) {
    pg8::Gemm g{A, Bt, M, N, 1024, 1024, 1 << 20, 0, tid}; pg8::StaticOrder S; S.init(M, N, (int)gridDim.x, (int)blockIdx.x);
    pg8::gemm_phase<Epi, pg8::StaticOrder, false>(lds, g, S, E, nullptr);
}
template <class Epi>
DI void run_gemm_g(int tid, LAS unsigned char* lds, const bf16_t* A, int lda, int K, const bf16_t* Bt, int M, int N, int pmg, size_t gstride, const Epi& E) {
    pg8::Gemm g{A, Bt, M, N, K, lda, pmg, gstride, tid}; pg8::StaticOrder S; S.init(M, N, (int)gridDim.x, (int)blockIdx.x);
    pg8::gemm_phase<Epi, pg8::StaticOrder, false>(lds, g, S, E, nullptr);
}
__global__ void __launch_bounds__(NT, 2) hy_fwd(Args ka) {
    extern __shared__ __attribute__((aligned(16))) unsigned char lds_raw[];
    LAS unsigned char* lds = (LAS unsigned char*)lds_raw;
    volatile LAS unsigned* xbw = (volatile LAS unsigned*)(lds + 131072);
    if (threadIdx.x < 4) xbw[threadIdx.x] = 0u;
    __syncthreads();
    const int lo = ka.ph_lo, hi = ka.ph_hi;
    const int s_wid = __builtin_amdgcn_readfirstlane((int)(threadIdx.x >> 6));
    XcdBarrier bar; bar.bar = (unsigned*)(ka.ws + WS_CTL); bar.x = 0u; bar.st = xbw; bar.wid = s_wid;
    if (hi - lo > 1) bar = xcd_barrier_post((unsigned*)(ka.ws + WS_CTL), xbw, s_wid);
#ifdef PH_ONLY
#define PHEN(p) ((p) == PH_ONLY)
#else
#define PHEN(p) 1
#endif
#define IN(k) (lo <= (k) && (k) < hi)
#define INL(p) (PHEN(p) && IN(pb + (p)))
#define REPS(p) ((DUP_PHASE == (p)) ? 2 : 1)
#define SEAM(k) do { if (IN((k) + 1)) xcd_barrier(bar); } while (0)
#define PH_LOAD \
    Args a; __builtin_memcpy(&a, args_ptr(), sizeof(Args)); a.wid = s_wid; \
    unsigned char* ws = a.ws; \
    float* MOD = (float*)(ws + WS_MOD); float* XCTX = (float*)(ws + WS_XCTX); \
    bf16_t* H = (bf16_t*)(ws + WS_H); bf16_t* MERGED = (bf16_t*)(ws + WS_MERGED); \
    bf16_t* WB0 = (bf16_t*)(ws + WS_WB0); bf16_t* WB1 = (bf16_t*)(ws + WS_WB1); \
    unsigned char* R = ws + WS_R; \
    bf16_t* P0 = (bf16_t*)(R + R_P0); bf16_t* P1 = (bf16_t*)(R + R_P1); bf16_t* P2 = (bf16_t*)(R + R_P2); bf16_t* OF = (bf16_t*)(R + R_OF); bf16_t* OB = (bf16_t*)(R + R_OB); \
    float* GATE2 = (float*)(R + R_G2); \
    float* GATE1 = (float*)(ws + WS_MERGED); bf16_t* HALO = (bf16_t*)(ws + WS_MERGED + SZ_GATE);     \
    float* MODP = (float*)R; \
    bf16_t* AX = (bf16_t*)(R + R5_AX); bf16_t* SZ5 = (bf16_t*)(R + R5_SZ); bf16_t* G15 = (bf16_t*)(R + R5_G1); bf16_t* GLUA = (bf16_t*)(R + R5_GLUA); bf16_t* YBR = (bf16_t*)R; \
    bf16_t* CW1 = (bf16_t*)(ws + WS_H); bf16_t* CW2 = (bf16_t*)(ws + WS_H + SZ_CW1); float* SEG5 = (float*)(ws + WS_H + SZ_CW1 + SZ_CW2); \
    const float* xlat_src = l == 0 ? a.in[I_X] : a.out; const float* xctx_src = l == 0 ? a.in[I_CTX] : XCTX; const float* modl = MOD + (size_t)l * 9 * 3072; \
    (void)MOD; (void)XCTX; (void)H; (void)MERGED; (void)WB0; (void)WB1; (void)P0; (void)P1; (void)P2; (void)OF; (void)OB; (void)GATE2; (void)GATE1; (void)HALO; (void)MODP; (void)AX; (void)SZ5; (void)G15; (void)GLUA; (void)YBR; (void)CW1; (void)CW2; (void)SEG5; (void)xlat_src; (void)xctx_src; (void)modl;
    LAS float* ldsf = (LAS float*)lds;

    { const int l = 0;
    if (PHEN(100) && IN(0)) { PH_LOAD; ph_modp(a, MODP, ldsf); SEAM(0); }
    if (PHEN(101) && IN(1)) { PH_LOAD; ph_mod(a, MODP, MOD); SEAM(1); } }
    for (int l = 0; l < DEPTH; ++l) {
        const int pb = 2 + l * NPH_LAYER;
        if (INL(0)) { PH_LOAD; for (int rep_ = 0; rep_ < REPS(0); ++rep_) { ph_norm(a, l, xlat_src, xctx_src, modl, H); ph_cvt(wdesc(a, l, 0), WB0, ldsf); } SEAM(pb + 0); }
        if (INL(1)) { PH_LOAD; for (int rep_ = 0; rep_ < REPS(1); ++rep_) { EpiProj E{P0, 0, GATE1, 12, HALO}; run_gemm(ltid(a), lds, H, WB0, MROWS, 3328, E); } SEAM(pb + 1); }
        if (INL(2)) { PH_LOAD; for (int rep_ = 0; rep_ < REPS(2); ++rep_) { if (DUP_PHASE == 102) ph_gdn_conv(a, l, P0, HALO, lds, OF); ph_gdn_conv(a, l, P0, HALO, lds); ph_cvt(wdesc(a, l, 1), WB1, ldsf); } SEAM(pb + 2); }
        if (INL(3)) { PH_LOAD; for (int rep_ = 0; rep_ < REPS(3); ++rep_) { ph_gdn_scan_mfma(a, l, P0, P1, P2, GATE1, OF, OB, lds); } SEAM(pb + 3); }
        if (INL(4)) { PH_LOAD; for (int rep_ = 0; rep_ < REPS(4); ++rep_) { EpiProj E{P0, 9, nullptr, -1, nullptr}; run_gemm(ltid(a), lds, H, WB1, MROWS, 2048, E); } SEAM(pb + 4); }
        if (INL(5)) { PH_LOAD; for (int rep_ = 0; rep_ < REPS(5); ++rep_) { if (DUP_PHASE == 105) ph_gdn_post(a, l, OF, OB, P0, P2); ph_gdn_post(a, l, OF, OB, P0); ph_cvt(wdesc(a, l, 6), WB0, ldsf); } SEAM(pb + 5); }
        if (INL(6)) { PH_LOAD; for (int rep_ = 0; rep_ < REPS(6); ++rep_) { ph_cvt(wdesc(a, l, 2), WB1, ldsf); EpiBranch E{P1, MERGED, 1}; run_gemm(ltid(a), lds, OF, WB0, MROWS, 1024, E); } SEAM(pb + 6); }
        if (INL(7)) { PH_LOAD; for (int rep_ = 0; rep_ < REPS(7); ++rep_) { ph_cvt(wdesc(a, l, 3), WB0, ldsf); EpiProj E{P0, 0, GATE2, 12, nullptr}; run_gemm(ltid(a), lds, H, WB1, MROWS, 3328, E); } SEAM(pb + 7); }
        if (INL(8)) { PH_LOAD; for (int rep_ = 0; rep_ < REPS(8); ++rep_) { ph_ml_scan_mfma(a, l, P0, P1, P2, GATE2, OF, OB, lds); } SEAM(pb + 8); }
        if (INL(9)) { PH_LOAD; for (int rep_ = 0; rep_ < REPS(9); ++rep_) { ph_cvt(wdesc(a, l, 8), WB1, ldsf); EpiProj E{P0, 38, nullptr, -1, nullptr}; run_gemm(ltid(a), lds, H, WB0, MROWS, 3072, E); } SEAM(pb + 9); }
        if (INL(10)) { PH_LOAD; for (int rep_ = 0; rep_ < REPS(10); ++rep_) { ph_ml_post(a, l, OF, OB, P0, P1); } SEAM(pb + 10); }
        if (INL(11)) { PH_LOAD; for (int rep_ = 0; rep_ < REPS(11); ++rep_) { ph_cvt(wdesc(a, l, 4), WB0, ldsf); EpiBranch E{P2, MERGED, 0}; run_gemm(ltid(a), lds, OF, WB1, MROWS, 1024, E); } SEAM(pb + 11); }
        if (INL(12)) { PH_LOAD; for (int rep_ = 0; rep_ < REPS(12); ++rep_) { ph_cvt(wdesc(a, l, 5), WB1, ldsf); EpiS1 E{AX, SZ5, G15}; run_gemm(ltid(a), lds, H, WB0, MROWS, 3072, E); } SEAM(pb + 12); }
        if (INL(13)) { PH_LOAD; for (int rep_ = 0; rep_ < REPS(13); ++rep_) { ph_s5_consts(a, l, CW1, CW2, lds); ph_cvt(wdesc(a, l, 7), WB0, ldsf); } SEAM(pb + 13); }
        if (INL(14)) { PH_LOAD; for (int rep_ = 0; rep_ < REPS(14); ++rep_) { EpiS5L E{AX}; run_gemm_g(ltid(a), lds, AX, 512, 256, CW1, 64 * S5_RG, 256, S5_PMG, (size_t)256 * 256 * 2, E); } SEAM(pb + 14); }
        if (INL(15)) { PH_LOAD; for (int rep_ = 0; rep_ < REPS(15); ++rep_) { ph_s5_carry1(a, l, AX, SEG5); } SEAM(pb + 15); }
        if (INL(16)) { PH_LOAD; ph_s5_carry2(a, l, AX, SEG5); SEAM(pb + 16); }
        if (INL(17)) { PH_LOAD; for (int rep_ = 0; rep_ < REPS(17); ++rep_) { EpiS5Y E{AX, GLUA, a.in[I_SD] + l * 1024}; run_gemm_g(ltid(a), lds, AX, 512, 512, CW2, 64 * S5_RG, 256, S5_PMG, (size_t)256 * 512 * 2, E); } SEAM(pb + 17); }
        if (INL(18)) { PH_LOAD; for (int rep_ = 0; rep_ < REPS(18); ++rep_) { EpiGlu E{SZ5, YBR, a.in[I_SBGLU] + l * 2048}; run_gemm(ltid(a), lds, GLUA, WB1, MROWS, 2048, E); } SEAM(pb + 18); }
        if (INL(19)) { PH_LOAD; for (int rep_ = 0; rep_ < REPS(19); ++rep_) { ph_cvt(wdesc(a, l, 9), WB1, ldsf); EpiBranch E{G15, MERGED, 0}; run_gemm(ltid(a), lds, YBR, WB0, MROWS, 1024, E); } SEAM(pb + 19); }
        if (INL(20)) { PH_LOAD; for (int rep_ = 0; rep_ < REPS(20); ++rep_) {
            const int ro = (l == DEPTH - 1) ? CTXROWS : 0;
            EpiOut E{xlat_src, a.out, xctx_src, XCTX, modl, l, ro};
            run_gemm(ltid(a), lds, MERGED + (size_t)ro * 1024, WB1, MROWS - ro, 1024, E);
            } SEAM(pb + 20);
        }
    }
    if (PHEN(102) && IN(PH_FINAL)) { const int l = 0; PH_LOAD; ph_final(a, a.out); }
#undef IN
#undef SEAM
#undef PH_LOAD
}
}

#ifndef MK_LAUNCHES
#define MK_LAUNCHES 1
#endif
extern "C" void kernel_launch(void* const* d_in, const int* in_sizes, int n_in, void* d_out, int out_size, void* d_ws, size_t ws_size, hipStream_t stream) {
    static int grid = 0;
    if (grid == 0) {
        if (n_in != 28 || out_size != hy::NBATCH * hy::SEQ * hy::D || ws_size < hy::WS_END) { fprintf(stderr, "kernel_launch: unexpected shapes (n_in %d, out %d, ws %zu < %zu)\n", n_in, out_size, ws_size, (size_t)hy::WS_END); grid = -1; return; }
        int dev = 0, cus = 0, per_cu = 0;
        if (hipGetDevice(&dev) != hipSuccess || hipDeviceGetAttribute(&cus, hipDeviceAttributeMultiprocessorCount, dev) != hipSuccess) { grid = -1; return; }
        if (hipFuncSetAttribute((const void*)hy::hy_fwd, hipFuncAttributeMaxDynamicSharedMemorySize, hy::LDS_BYTES) != hipSuccess) { fprintf(stderr, "kernel_launch: hipFuncSetAttribute failed\n"); grid = -1; return; }
        if (hipOccupancyMaxActiveBlocksPerMultiprocessor(&per_cu, (const void*)hy::hy_fwd, hy::NT, hy::LDS_BYTES) != hipSuccess || per_cu < 1) { fprintf(stderr, "kernel_launch: occupancy query says %d\n", per_cu); (void)hipGetLastError(); }
        grid = cus;
    }
    if (grid < 0) return;
    (void)hipMemsetAsync((char*)d_ws + hy::WS_CTL, 0, 65536, stream);
    hy::Args a{};
    for (int i = 0; i < 28; ++i) a.in[i] = (const float*)d_in[i];
    a.out = (float*)d_out; a.ws = (unsigned char*)d_ws;
#if MK_LAUNCHES == 1
    a.ph_lo = 0; a.ph_hi = hy::NPHASE;
    hipLaunchKernelGGL(hy::hy_fwd, dim3(grid), dim3(hy::NT), hy::LDS_BYTES, stream, a);
#else
    for (int p = 0; p < hy::NPHASE; ++p) { a.ph_lo = p; a.ph_hi = p + 1; hipLaunchKernelGGL(hy::hy_fwd, dim3(grid), dim3(hy::NT), hy::LDS_BYTES, stream, a); }
#endif
}
```

```cpp
#include <hip/hip_runtime.h>
#include <cstdio>
#include <cstdint>
#define MK_LAUNCHES 1


#define XB_TMO      128
#define XB_XCNT(j)  (256  + 64 * (j))
#define XB_XSUB(j)  (1280 + 64 * (j))
#define XB_XGEN(j)  (2304 + 64 * (j))
#define XB_TOP      3328
#define XB_TOPGEN   3392
#define XCD_BAR_WORDS 3456
#define XB_SPIN_CAP (1u << 18)
#define LAS __attribute__((address_space(3)))

__device__ __forceinline__ unsigned xb_ld(unsigned* p)              { return __hip_atomic_load(p, __ATOMIC_RELAXED, __HIP_MEMORY_SCOPE_AGENT); }
__device__ __forceinline__ unsigned xb_add(unsigned* p, unsigned v) { return __hip_atomic_fetch_add(p, v, __ATOMIC_RELAXED, __HIP_MEMORY_SCOPE_AGENT); }
__device__ __forceinline__ unsigned xb_xcc_id() { return (unsigned)__builtin_amdgcn_s_getreg((3 << 11) | 20) & 0xFu; }
#define XB_SPIN(cond, bar) do { unsigned _sp = 0; while (cond) { __builtin_amdgcn_s_sleep(1); \
    if ((++_sp & 255u) == 0u) { if (xb_ld(&(bar)[XB_TMO])) break; if (_sp > XB_SPIN_CAP) { atomicAdd(&(bar)[XB_TMO], 1u); break; } } } } while (0)

struct XcdBarrier {
    unsigned* bar; unsigned x;
    int wid;
    volatile LAS unsigned* st;
};

__device__ __forceinline__ bool xb_lead(int wid) { int l; asm volatile("v_mbcnt_lo_u32_b32 %0, -1, 0\n\tv_mbcnt_hi_u32_b32 %0, -1, %0" : "=v"(l)); return wid == 0 && l == 0; }
__device__ __forceinline__ XcdBarrier xcd_barrier_post(unsigned* bar, volatile LAS unsigned* st, int wid) {
    XcdBarrier b; b.bar = bar; b.x = xb_xcc_id(); b.st = st; b.wid = wid;
    if (xb_lead(wid)) (void)xb_add(&bar[XB_XCNT(b.x)], 1u);
    return b;
}
__device__ __forceinline__ void xcd_barrier_complete(unsigned* bar, unsigned x, unsigned& nloc, unsigned& nx) {
    const unsigned G = gridDim.x * gridDim.y * gridDim.z;
    unsigned sum, cnt, mine, sp = 0u;
    for (;;) {
        sum = 0u; cnt = 0u; mine = 0u;
#pragma unroll
        for (unsigned j = 0; j < 16; ++j) { const unsigned c = xb_ld(&bar[XB_XCNT(j)]); sum += c; cnt += (c > 0u) ? 1u : 0u; mine = (j == x) ? c : mine; }
        if (sum == G) break;
        __builtin_amdgcn_s_sleep(1);
        if ((++sp & 255u) == 0u) { if (xb_ld(&bar[XB_TMO])) break; if (sp > XB_SPIN_CAP) { atomicAdd(&bar[XB_TMO], 1u); break; } }
    }
    nloc = mine > 0u ? mine : 1u; nx = cnt > 0u ? cnt : 1u;
}

__device__ __forceinline__ void xcd_barrier(const XcdBarrier& b) {
    asm volatile("s_waitcnt vmcnt(0)" ::: "memory");
    __syncthreads();
    if (xb_lead(b.wid)) {
        unsigned* bar = b.bar;
        __builtin_amdgcn_s_waitcnt(0);
        unsigned nloc = b.st[0], nx = b.st[1];
        if (nloc == 0u) { xcd_barrier_complete(bar, b.x, nloc, nx); b.st[0] = nloc; b.st[1] = nx; }
        const unsigned old = xb_add(&bar[XB_XSUB(b.x)], 1u);
        const unsigned gen = old / nloc;
        if (old + 1u == (gen + 1u) * nloc) {
            __builtin_amdgcn_fence(__ATOMIC_RELEASE, "agent");
            asm volatile("s_waitcnt vmcnt(0)" ::: "memory");
            const unsigned og = xb_add(&bar[XB_TOP], 1u);
            const unsigned tg = og / nx;
            if (og + 1u == (tg + 1u) * nx) xb_add(&bar[XB_TOPGEN], 1u);
            else XB_SPIN(xb_ld(&bar[XB_TOPGEN]) == tg, bar);
            __builtin_amdgcn_fence(__ATOMIC_ACQUIRE, "agent");
            xb_add(&bar[XB_XGEN(b.x)], 1u);
            asm volatile("s_waitcnt vmcnt(0)" ::: "memory");
        } else {
            XB_SPIN(xb_ld(&bar[XB_XGEN(b.x)]) == gen, bar);
            __builtin_amdgcn_fence(__ATOMIC_ACQUIRE, "agent");
            asm volatile("s_waitcnt vmcnt(0)" ::: "memory");
        }
    }
    __syncthreads();
}


namespace pg8 {
#define PG8_LAS __attribute__((address_space(3)))
typedef unsigned short bf16_t;
typedef short bf16x8 __attribute__((ext_vector_type(8)));
typedef float f32x4 __attribute__((ext_vector_type(4)));
typedef unsigned u32x4 __attribute__((ext_vector_type(4)));
constexpr int BM = 256, BK = 64, HALF = 128, HTB = HALF * BK * 2  , STAGE_BYTES = 8 * HTB, NXCD = 8, WGM = 8;

__host__ __device__ __forceinline__ int lds_byte(int r, int c) { const int st = (r >> 4) * 2 + (c >> 5), rr = r & 15, cc = c & 31, ob = rr * 64 + cc * 2; return st * 1024 + (ob ^ (((ob >> 9) & 1) << 5)); }
__host__ __device__ __forceinline__ void stage_rc(int b, int& R, int& C) { const int st = b / 1024, sb = b % 1024, swz = sb ^ (((sb >> 9) & 1) << 5); R = (st >> 1) * 16 + swz / 64; C = (st & 1) * 32 + (swz % 64) / 2; }
__host__ __device__ __forceinline__ int perm32(int rho) { const int n = rho >> 4, i = rho & 15; return 8 * (i >> 2) + 4 * n + (i & 3); }

struct Unit { int pm, pn; };
struct Gemm { const bf16_t* A; const bf16_t* Bt; int M, N, K, lda, pmg; size_t gstride; int tid; };

struct StaticOrder {
    int nM, nN, nwg, G, c;
    __host__ __device__ void init(int M, int N, int G_, int c_) { nM = M / BM; nN = N / BM; nwg = nM * nN; G = G_; c = c_; }
    __host__ __device__ bool next(int i, Unit& u) const {
        const long L = (long)i * G + c; if (L >= nwg) return false;
        int wgid = (int)L; { const int q = nwg / NXCD, r = nwg % NXCD, xcd = wgid % NXCD, off = wgid / NXCD; wgid = (xcd < r ? xcd * (q + 1) : r * (q + 1) + (xcd - r) * q) + off; }
        const int nig = WGM * nN, gid = wgid / nig, fm = gid * WGM, gsz = (nM - fm) < WGM ? (nM - fm) : WGM;
        u.pm = fm + ((wgid % nig) % gsz); u.pn = (wgid % nig) / gsz; return true;
    }
    __device__ __forceinline__ void a_ready(const Unit&) const {}
    __device__ __forceinline__ void done(const Unit&) const {}
};
__device__ __forceinline__ unsigned cvt_pk_bf16(float lo, float hi) { unsigned r; asm volatile("v_cvt_pk_bf16_f32 %0, %1, %2" : "=v"(r) : "v"(lo), "v"(hi)); return r; }
typedef float f32x2 __attribute__((ext_vector_type(2)));
template <class Epi, class Sched, bool STAMP = false>
__device__ __forceinline__ void gemm_phase(PG8_LAS unsigned char* lds, const Gemm g, const Sched& S, const Epi& E, unsigned long long* stamps) {
    const int tid = g.tid, wid = __builtin_amdgcn_readfirstlane(tid >> 6), lane = tid & 63, wr = wid >> 2, wc = wid & 3, fr = lane & 15, fq = lane >> 4;
    const int K = g.K, nt = K / BK;
    int ts_lo = 0, ts_hi = 0, nts = 0; const unsigned long long rt_entry = STAMP ? (unsigned long long)wall_clock64() : 0ull;
#define PG8_STAMP() do { if (STAMP && wid == 0 && nts < 64) { const unsigned long long _c = (unsigned long long)clock64(); \
        ts_lo = (lane == nts) ? (int)(unsigned)_c : ts_lo; ts_hi = (lane == nts) ? (int)(unsigned)(_c >> 32) : ts_hi; ++nts; } } while (0)
    PG8_STAMP();
    unsigned voffA[2], voffB[2];
#pragma unroll
    for (int i = 0; i < 2; ++i) { int R, C; stage_rc(tid * 16 + i * 8192, R, C); const int Rb = Epi::PERM ? ((R & ~31) + perm32(R & 31)) : R;
        voffA[i] = (unsigned)(R * g.lda + C) * 2u; voffB[i] = (unsigned)(Rb * K + C) * 2u; }
    const size_t kstep = (size_t)(BK * 2);
    const size_t hstepA = (size_t)HALF * g.lda * 2, hstepB = (size_t)HALF * K * 2;
    const size_t tstepA = 2 * hstepA, tstepB = 2 * hstepB;
    const unsigned ldsw = (unsigned)wid * 1024u;
    const int aoff = lds_byte(wr * 64 + fr, fq * 8), boff = lds_byte(wc * 32 + fr, fq * 8);
#define PG8_SA(b, h) (((b) * 2 + (h)) * HTB)
#define PG8_SB(b, h) ((4 + (b) * 2 + (h)) * HTB)
#define PG8_STAGE(bufoff, gbase, voff) do { _Pragma("unroll") for (int _i = 0; _i < 2; ++_i) \
        __builtin_amdgcn_global_load_lds((const unsigned*)((const char*)(gbase) + (voff)[_i]), (PG8_LAS unsigned*)(lds + (bufoff) + ldsw + _i * 8192), 16, 0, 0); } while (0)
#define PG8_LDA(dst, b, h) do { _Pragma("unroll") for (int m = 0; m < 4; ++m) _Pragma("unroll") for (int k = 0; k < 2; ++k) dst[m][k] = *(const PG8_LAS bf16x8*)(lds + PG8_SA(b, h) + aoff + m * 2048 + k * 1024); } while (0)
#define PG8_LDB(dst, b, h) do { _Pragma("unroll") for (int n = 0; n < 2; ++n) _Pragma("unroll") for (int k = 0; k < 2; ++k) dst[n][k] = *(const PG8_LAS bf16x8*)(lds + PG8_SB(b, h) + boff + n * 2048 + k * 1024); } while (0)
#define PG8_MMA(ai, bj, At, Bt) do { __builtin_amdgcn_s_setprio(1); _Pragma("unroll") for (int m = 0; m < 4; ++m) _Pragma("unroll") for (int n = 0; n < 2; ++n) _Pragma("unroll") for (int k = 0; k < 2; ++k) \
        acc[ai][bj][m][n] = __builtin_amdgcn_mfma_f32_16x16x32_bf16(Bt[n][k], At[m][k], acc[ai][bj][m][n], 0, 0, 0); __builtin_amdgcn_s_setprio(0); } while (0)
#define PG8_WAIT_V(n) asm volatile("s_waitcnt vmcnt(" #n ")" ::: "memory")
#define PG8_WAIT_L(n) asm volatile("s_waitcnt lgkmcnt(" #n ")" ::: "memory")
#define PG8_BAR __builtin_amdgcn_s_barrier()
#define PG8_SCHED __builtin_amdgcn_sched_barrier(0)
    Unit cur, nxt; int ui = 0;
    if (!S.next(0, cur)) return;
    f32x4 acc[2][2][4][2];
#pragma unroll
    for (int a = 0; a < 2; ++a)
#pragma unroll
        for (int b = 0; b < 2; ++b)
#pragma unroll
            for (int m = 0; m < 4; ++m)
#pragma unroll
                for (int n = 0; n < 2; ++n) acc[a][b][m][n] = (f32x4){0.f, 0.f, 0.f, 0.f};
    bf16x8 At[4][2], B0[2][2], B1[2][2];
    const char* cA = (const char*)g.A + (size_t)cur.pm * tstepA; const char* cB = (const char*)g.Bt + (size_t)(cur.pm / g.pmg) * g.gstride + (size_t)cur.pn * tstepB;
    S.a_ready(cur);
    PG8_STAGE(PG8_SB(0, 0), cB, voffB); PG8_STAGE(PG8_SA(0, 0), cA, voffA); PG8_STAGE(PG8_SB(0, 1), cB + hstepB, voffB); PG8_STAGE(PG8_SA(0, 1), cA + hstepA, voffA);
    if (wr == 1) PG8_BAR;
    PG8_WAIT_V(4); PG8_BAR;
    PG8_STAGE(PG8_SB(1, 0), cB + kstep, voffB); PG8_STAGE(PG8_SA(1, 0), cA + kstep, voffA); PG8_STAGE(PG8_SB(1, 1), cB + hstepB + kstep, voffB);
    PG8_WAIT_V(6); PG8_BAR;
    PG8_STAMP();
    for (;;) {
        const bool has_next = S.next(ui + 1, nxt);
        const char* nA = has_next ? (const char*)g.A + (size_t)nxt.pm * tstepA : cA; const char* nB = has_next ? (const char*)g.Bt + (size_t)(nxt.pm / g.pmg) * g.gstride + (size_t)nxt.pn * tstepB : cB;
#pragma unroll 1
        for (int t = 0; t < nt; t += 2) {
            const bool last = (t == nt - 2);
            const char* a1 = cA + (size_t)(t + 1) * kstep;
            const char* a2 = last ? nA : cA + (size_t)(t + 2) * kstep; const char* b2 = last ? nB : cB + (size_t)(t + 2) * kstep;
            const char* a3 = a2 + kstep; const char* b3 = b2 + kstep;
            if (last && has_next) S.a_ready(nxt);
            PG8_LDB(B0, 0, 0); PG8_SCHED; PG8_LDA(At, 0, 0); PG8_STAGE(PG8_SA(1, 1), a1 + hstepA, voffA);
            PG8_WAIT_L(8); PG8_BAR; PG8_WAIT_L(0); PG8_MMA(0, 0, At, B0); PG8_BAR; PG8_SCHED;
            PG8_LDB(B1, 0, 1); PG8_STAGE(PG8_SB(0, 0), b2, voffB);
            PG8_BAR; PG8_WAIT_L(0); PG8_MMA(0, 1, At, B1); PG8_BAR;
            PG8_LDA(At, 0, 1); PG8_STAGE(PG8_SA(0, 0), a2, voffA);
            PG8_BAR; PG8_WAIT_L(0); PG8_MMA(1, 0, At, B0); PG8_BAR; PG8_SCHED;
            PG8_STAGE(PG8_SB(0, 1), b2 + hstepB, voffB);
            PG8_WAIT_V(6); PG8_BAR; PG8_MMA(1, 1, At, B1); PG8_BAR;
            PG8_LDB(B0, 1, 0); PG8_SCHED; PG8_LDA(At, 1, 0); PG8_STAGE(PG8_SA(0, 1), a2 + hstepA, voffA);
            PG8_WAIT_L(8); PG8_BAR; PG8_WAIT_L(0); PG8_MMA(0, 0, At, B0); PG8_BAR; PG8_SCHED;
            PG8_LDB(B1, 1, 1); PG8_STAGE(PG8_SB(1, 0), b3, voffB);
            PG8_BAR; PG8_WAIT_L(0); PG8_MMA(0, 1, At, B1); PG8_BAR;
            PG8_LDA(At, 1, 1); PG8_STAGE(PG8_SA(1, 0), a3, voffA);
            PG8_BAR; PG8_WAIT_L(0); PG8_MMA(1, 0, At, B0); PG8_BAR; PG8_SCHED;
            PG8_STAGE(PG8_SB(1, 1), b3 + hstepB, voffB);
            PG8_WAIT_V(6); PG8_BAR; PG8_MMA(1, 1, At, B1); PG8_BAR;
        }
        PG8_STAMP();
        if constexpr (!Epi::AFTER_DRAIN) { E(acc, cur, wr, wc, fr, fq); S.done(cur); }
        PG8_STAMP();
        if (!has_next) break;
#pragma unroll
        for (int a = 0; a < 2; ++a)
#pragma unroll
            for (int b = 0; b < 2; ++b)
#pragma unroll
                for (int m = 0; m < 4; ++m)
#pragma unroll
                    for (int n = 0; n < 2; ++n) acc[a][b][m][n] = (f32x4){0.f, 0.f, 0.f, 0.f};
        cur = nxt; cA = nA; cB = nB; ++ui;
    }
    PG8_WAIT_V(0);
    if (wr == 0) PG8_BAR;
    PG8_BAR;
    if constexpr (Epi::AFTER_DRAIN) { E.fused(acc, cur, wr, wc, fr, fq, lds, wid, lane); S.done(cur); }
    PG8_STAMP();
    if (STAMP && wid == 0) { stamps[lane] = lane < nts ? (((unsigned long long)(unsigned)ts_hi << 32) | (unsigned)ts_lo) : 0ull;
        if (lane == 62) stamps[62] = rt_entry; if (lane == 63) stamps[63] = (unsigned long long)wall_clock64(); }
#undef PG8_STAMP
#undef PG8_SA
#undef PG8_SB
#undef PG8_STAGE
#undef PG8_LDA
#undef PG8_LDB
#undef PG8_MMA
#undef PG8_WAIT_V
#undef PG8_WAIT_L
#undef PG8_BAR
#undef PG8_SCHED
}
}


namespace hy {
using pg8::bf16_t; using pg8::f32x4; using pg8::u32x4; using pg8::Unit;
typedef unsigned u32x2 __attribute__((ext_vector_type(2)));
#define DI __device__ __forceinline__
constexpr int D = 1024, NBATCH = 8, SEQ = 4096, CTXL = 256, DEPTH = 4;
constexpr int CTXROWS = NBATCH * CTXL;
constexpr int MROWS = CTXROWS + NBATCH * SEQ;
constexpr int NCHUNK = MROWS / 64;
constexpr int NIN = 14384;
constexpr int NT = 512;
constexpr int LDS_BYTES = 131072 + 256;
constexpr int C_GQ = 0, C_GZ = 3072, C_GA = 4096, C_SU = 4128, C_MQ = 6176, C_MO = 9248, C_MI = 11296, C_GATE = 11312;

constexpr size_t al256(size_t x) { return (x + 255) & ~(size_t)255; }
constexpr size_t SZ_ACT = (size_t)MROWS * 1024 * 2;
constexpr size_t SZ_GATE = (size_t)MROWS * 32 * 4;
constexpr size_t SZ_HALO = (size_t)3 * NCHUNK * 4 * 1024 * 2;
constexpr size_t WS_CTL = 0;
constexpr size_t WS_MOD = 65536, SZ_MOD = (size_t)DEPTH * 9 * 3072 * 4;
constexpr size_t WS_XCTX = al256(WS_MOD + SZ_MOD);
constexpr size_t WS_H = WS_XCTX + (size_t)CTXROWS * 1024 * 4;
constexpr size_t WS_MERGED = WS_H + SZ_ACT;
constexpr size_t SZ_WB = (size_t)3328 * 1024 * 2;
constexpr size_t WS_WB0 = WS_MERGED + SZ_ACT;
constexpr size_t WS_WB1 = WS_WB0 + SZ_WB;
constexpr size_t WS_R = WS_WB1 + SZ_WB;
constexpr size_t R_P0 = 0, R_P1 = SZ_ACT, R_P2 = 2 * SZ_ACT, R_OF = 3 * SZ_ACT, R_OB = 4 * SZ_ACT, R_G2 = 5 * SZ_ACT;
constexpr size_t WS_END = WS_R + R_G2 + SZ_GATE + (size_t)4 * 1024 * 1024;
static_assert(SZ_GATE + SZ_HALO <= SZ_ACT, "GDN gate + halo buffers live in the (not yet written) MERGED region");
static_assert((size_t)16 * DEPTH * 9 * 3072 * 4 <= SZ_ACT, "mod partials live in the R region");

struct Args { const float* in[28]; float* out; unsigned char* ws; int ph_lo, ph_hi, wid, pad; };
enum { I_X = 0, I_C, I_CTX, I_CCTX, I_WADA, I_BADA, I_NORMG, I_WIN, I_GCONV, I_GALOG, I_GDTB, I_GNORM, I_SLRE, I_SLIM, I_SLOG, I_SBRE, I_SBIM, I_SCRE, I_SCIM, I_SD, I_SWGLU, I_SBGLU, I_MIB, I_MFB, I_MNORM, I_WBR, I_WOUT, I_FNORM };

typedef const Args __attribute__((address_space(4)))* ArgsP;
DI ArgsP args_ptr() { ArgsP p = (ArgsP)__builtin_amdgcn_kernarg_segment_ptr(); asm volatile("" : "+s"(p)); return p; }
DI int lane_id() { int l; asm volatile("v_mbcnt_lo_u32_b32 %0, -1, 0\n\tv_mbcnt_hi_u32_b32 %0, -1, %0" : "=v"(l)); return l; }
DI int ltid(const Args& a) { return (a.wid << 6) | lane_id(); }
DI void lds_barrier() { asm volatile("s_waitcnt lgkmcnt(0)" ::: "memory"); __builtin_amdgcn_s_barrier(); asm volatile("" ::: "memory"); }
DI float bf2f(bf16_t v) { return __uint_as_float(((unsigned)v) << 16); }
DI float bflo(unsigned w) { return __uint_as_float(w << 16); }
DI float bfhi(unsigned w) { return __uint_as_float(w & 0xffff0000u); }
DI bf16_t f2bf(float f) { return (bf16_t)(pg8::cvt_pk_bf16(f, 0.f) & 0xffffu); }
DI float sigmoidf_(float x) { return __builtin_amdgcn_rcpf(1.0f + __expf(-x)); }
DI float siluf_(float x) { return x * __builtin_amdgcn_rcpf(1.0f + __expf(-x)); }
DI float softplusf_(float x) { return x > 20.f ? x : log1pf(__expf(x)); }
DI float gelu_tanh_(float x) { const float u = 0.7978845608028654f * (x + 0.044715f * x * x * x); return x * __builtin_amdgcn_rcpf(1.0f + __expf(-2.0f * u)); }
DI float shx(float v, int o, int lane) { return __int_as_float(__builtin_amdgcn_ds_bpermute((lane ^ o) << 2, __float_as_int(v))); }
DI float shup(float v, int o, int lane) { return __int_as_float(__builtin_amdgcn_ds_bpermute((lane - o) << 2, __float_as_int(v))); }
DI float shidx(float v, int src) { return __int_as_float(__builtin_amdgcn_ds_bpermute(src << 2, __float_as_int(v))); }
#define DPP_F(old_, src_, ctrl_, rmask_) __int_as_float(__builtin_amdgcn_update_dpp(__float_as_int(old_), __float_as_int(src_), (ctrl_), (rmask_), 0xF, false))
DI float dpp_scan_sum(float v) {
    v += DPP_F(0.f, v, 0x111, 0xF); v += DPP_F(0.f, v, 0x112, 0xF); v += DPP_F(0.f, v, 0x114, 0xF); v += DPP_F(0.f, v, 0x118, 0xF);
    v += DPP_F(0.f, v, 0x142, 0xA); v += DPP_F(0.f, v, 0x143, 0xC); return v; }
DI float dpp_scan_max(float v) {
    const float ninf = -__builtin_inff();
    v = fmaxf(v, DPP_F(ninf, v, 0x111, 0xF)); v = fmaxf(v, DPP_F(ninf, v, 0x112, 0xF)); v = fmaxf(v, DPP_F(ninf, v, 0x114, 0xF)); v = fmaxf(v, DPP_F(ninf, v, 0x118, 0xF));
    v = fmaxf(v, DPP_F(ninf, v, 0x142, 0xA)); v = fmaxf(v, DPP_F(ninf, v, 0x143, 0xC)); return v; }
DI float lane63(float v) { return __int_as_float(__builtin_amdgcn_readlane(__float_as_int(v), 63)); }
DI float wave_sum(float v, int lane) {
#pragma unroll
    for (int o = 32; o >= 1; o >>= 1) v += shx(v, o, lane);
    return v; }
DI void unpack8(const u32x4 w, float (&f)[8]) { f[0] = bflo(w.x); f[1] = bfhi(w.x); f[2] = bflo(w.y); f[3] = bfhi(w.y); f[4] = bflo(w.z); f[5] = bfhi(w.z); f[6] = bflo(w.w); f[7] = bfhi(w.w); }
DI int lat_pos(int l, int s) { return (l & 1) ? (((s & 63) << 6) | (s >> 6)) : s; }

struct EpiProj {
    static constexpr bool PERM = true, AFTER_DRAIN = false;
    bf16_t* d0; int modes; float* gdst; int gtile; bf16_t* halo;
    __device__ __forceinline__ void operator()(const f32x4 (&acc)[2][2][4][2], const Unit& u, int wr, int wc, int fr, int fq) const {
        const int row0 = u.pm * 256 + wr * 64 + fr;
        if (u.pn == gtile) {
            if (wc == 0) {
#pragma unroll
                for (int ai = 0; ai < 2; ++ai)
#pragma unroll
                    for (int m = 0; m < 4; ++m) { float* rp = gdst + (size_t)(row0 + ai * 128 + m * 16) * 32 + 8 * fq; *(f32x4*)rp = acc[ai][0][m][0]; *(f32x4*)(rp + 4) = acc[ai][0][m][1]; }
            }
            return;
        }
        const int seg = u.pn >> 2; bf16_t* base = d0 + (size_t)seg * (SZ_ACT / 2); const int md = (modes >> (2 * seg)) & 3;
        const int col0 = (u.pn & 3) * 256 + wc * 32 + 8 * fq;
#pragma unroll
        for (int ai = 0; ai < 2; ++ai)
#pragma unroll
            for (int m = 0; m < 4; ++m) {
                const int r = row0 + ai * 128 + m * 16;
                bf16_t* rowp = base + (size_t)r * 1024 + col0;
                int hidx = -1;
                if (halo) { if (m == 0 && fr < 2) hidx = fr; if (m == 3 && fr >= 14) hidx = fr - 12; }
#pragma unroll
                for (int bj = 0; bj < 2; ++bj) {
                    f32x4 v0 = acc[ai][bj][m][0], v1 = acc[ai][bj][m][1];
                    if (md == 1) {
#pragma unroll
                        for (int j = 0; j < 4; ++j) { v0[j] = siluf_(v0[j]); v1[j] = siluf_(v1[j]); } }
                    else if (md == 2) {
#pragma unroll
                        for (int j = 0; j < 4; ++j) { v0[j] = sigmoidf_(v0[j]); v1[j] = sigmoidf_(v1[j]); } }
                    u32x4 w; w.x = pg8::cvt_pk_bf16(v0[0], v0[1]); w.y = pg8::cvt_pk_bf16(v0[2], v0[3]); w.z = pg8::cvt_pk_bf16(v1[0], v1[1]); w.w = pg8::cvt_pk_bf16(v1[2], v1[3]);
                    *(u32x4*)(rowp + bj * 128) = w;
                    if (hidx >= 0) *(u32x4*)(halo + ((size_t)seg * (NCHUNK * 4) + (size_t)(r >> 6) * 4 + hidx) * 1024 + col0 + bj * 128) = w;
                }
            }
    }
};
struct EpiBranch {
    static constexpr bool PERM = true, AFTER_DRAIN = false;
    const bf16_t* G; bf16_t* MG; int first;
    __device__ __forceinline__ void operator()(const f32x4 (&acc)[2][2][4][2], const Unit& u, int wr, int wc, int fr, int fq) const {
        const int row0 = u.pm * 256 + wr * 64 + fr, col0 = u.pn * 256 + wc * 32 + 8 * fq;
#pragma unroll
        for (int ai = 0; ai < 2; ++ai)
#pragma unroll
            for (int m = 0; m < 4; ++m) {
                const size_t off = (size_t)(row0 + ai * 128 + m * 16) * 1024 + col0;
#pragma unroll
                for (int bj = 0; bj < 2; ++bj) {
                    const u32x4 gw = *(const u32x4*)(G + off + bj * 128);
                    float g[8], o[8]; unpack8(gw, g);
                    if (first) {
#pragma unroll
                        for (int j = 0; j < 8; ++j) o[j] = 0.f; }
                    else { const u32x4 ow = *(const u32x4*)(MG + off + bj * 128); unpack8(ow, o); }
                    const f32x4 v0 = acc[ai][bj][m][0], v1 = acc[ai][bj][m][1];
#pragma unroll
                    for (int j = 0; j < 4; ++j) { o[j] += g[j] * v0[j]; o[4 + j] += g[4 + j] * v1[j]; }
                    u32x4 w; w.x = pg8::cvt_pk_bf16(o[0], o[1]); w.y = pg8::cvt_pk_bf16(o[2], o[3]); w.z = pg8::cvt_pk_bf16(o[4], o[5]); w.w = pg8::cvt_pk_bf16(o[6], o[7]);
                    *(u32x4*)(MG + off + bj * 128) = w;
                }
                asm volatile("" ::: "memory");
            }
    }
};
struct EpiGlu {
    static constexpr bool PERM = true, AFTER_DRAIN = false;
    const bf16_t* SZ; bf16_t* O; const float* bias;
    __device__ __forceinline__ void operator()(const f32x4 (&acc)[2][2][4][2], const Unit& u, int wr, int wc, int fr, int fq) const {
        const int row0 = u.pm * 256 + wr * 64 + fr, col0 = u.pn * 128 + wc * 32 + 8 * fq;
        float ba[8], bg[8];
#pragma unroll
        for (int j = 0; j < 8; ++j) { ba[j] = bias[col0 + j]; bg[j] = bias[1024 + col0 + j]; }
#pragma unroll
        for (int ai = 0; ai < 2; ++ai)
#pragma unroll
            for (int m = 0; m < 4; ++m) {
                const size_t off = (size_t)(row0 + ai * 128 + m * 16) * 1024 + col0;
                const u32x4 zw = *(const u32x4*)(SZ + off); float z[8], o[8]; unpack8(zw, z);
#pragma unroll
                for (int n = 0; n < 2; ++n)
#pragma unroll
                    for (int j = 0; j < 4; ++j) { const int c = 4 * n + j; o[c] = (acc[ai][0][m][n][j] + ba[c]) * sigmoidf_(acc[ai][1][m][n][j] + bg[c]) * z[c]; }
                u32x4 w; w.x = pg8::cvt_pk_bf16(o[0], o[1]); w.y = pg8::cvt_pk_bf16(o[2], o[3]); w.z = pg8::cvt_pk_bf16(o[4], o[5]); w.w = pg8::cvt_pk_bf16(o[6], o[7]);
                *(u32x4*)(O + off) = w;
            }
    }
};
struct EpiOut {
    static constexpr bool PERM = false, AFTER_DRAIN = false;
    const float* xlat_src; float* xlat_dst; const float* xctx_src; float* xctx_dst; const float* mod; int l; int row_off;
    __device__ __forceinline__ void operator()(const f32x4 (&acc)[2][2][4][2], const Unit& u, int wr, int wc, int fr, int fq) const {
        const int row0 = row_off + u.pm * 256 + wr * 64 + fr, col0 = u.pn * 256 + wc * 32 + 4 * fq;
#pragma unroll
        for (int ai = 0; ai < 2; ++ai)
#pragma unroll
            for (int m = 0; m < 4; ++m) {
                const int r = row0 + ai * 128 + m * 16;
                const float* xs; float* xd; const float* gp;
                if (r < CTXROWS) { xs = xctx_src + (size_t)r * 1024; xd = xctx_dst + (size_t)r * 1024; gp = mod + 8 * 3072 + 2048; }
                else { const int q = r - CTXROWS, b = q >> 12, p = lat_pos(l, q & 4095); const size_t o = ((size_t)b * 4096 + p) * 1024; xs = xlat_src + o; xd = xlat_dst + o; gp = mod + b * 3072 + 2048; }
#pragma unroll
                for (int bj = 0; bj < 2; ++bj)
#pragma unroll
                    for (int n = 0; n < 2; ++n) { const int c = col0 + bj * 128 + n * 16; const f32x4 x = *(const f32x4*)(xs + c), g = *(const f32x4*)(gp + c); *(f32x4*)(xd + c) = x + g * acc[ai][bj][m][n]; }
                asm volatile("" ::: "memory");
            }
    }
};

DI void ph_modp(const Args& a, float* modp, LAS float* sl) {
    for (int it = blockIdx.x; it < 384; it += gridDim.x) {
        const int l = it / 96, kq = (it / 6) % 16, nt = it % 6;
        __syncthreads();
        for (int i = ltid(a); i < 576; i += NT) { const int j = i >> 6, k = kq * 64 + (i & 63); const float cv = (j < 8) ? a.in[I_C][j * 1024 + k] : a.in[I_CCTX][k]; sl[i] = siluf_(cv); }
        __syncthreads();
        const int n = nt * 512 + ltid(a);
        float acc[9];
#pragma unroll
        for (int j = 0; j < 9; ++j) acc[j] = 0.f;
        const float* w = a.in[I_WADA] + ((size_t)l * 1024 + kq * 64) * 3072 + n;
#pragma unroll 4
        for (int k = 0; k < 64; ++k) { const float wv = w[(size_t)k * 3072];
#pragma unroll
            for (int j = 0; j < 9; ++j) acc[j] += sl[j * 64 + k] * wv; }
#pragma unroll
        for (int j = 0; j < 9; ++j) modp[(((size_t)kq * 4 + l) * 9 + j) * 3072 + n] = acc[j];
    }
}
DI void ph_mod(const Args& a, const float* modp, float* mod) {
    for (int i = blockIdx.x * NT + ltid(a); i < DEPTH * 9 * 3072; i += gridDim.x * NT) {
        const int l = i / (9 * 3072), n = i % 3072; float s = a.in[I_BADA][l * 3072 + n];
#pragma unroll
        for (int kq = 0; kq < 16; ++kq) s += modp[(size_t)kq * (DEPTH * 9 * 3072) + i];
        mod[i] = s;
    }
}
DI void ph_norm(const Args& a, int l, const float* xlat, const float* xctx, const float* mod, bf16_t* H) {
    const int wave = ltid(a) >> 6, lane = ltid(a) & 63;
    const float* g = a.in[I_NORMG] + l * 1024;
    for (int r = blockIdx.x * 8 + wave; r < MROWS; r += gridDim.x * 8) {
        const float* src; const float* md;
        if (r < CTXROWS) { src = xctx + (size_t)r * 1024; md = mod + 8 * 3072; }
        else { const int q = r - CTXROWS, b = q >> 12, p = lat_pos(l, q & 4095); src = xlat + ((size_t)b * 4096 + p) * 1024; md = mod + b * 3072; }
        f32x4 v[4]; float ss = 0.f;
#pragma unroll
        for (int i = 0; i < 4; ++i) { v[i] = *(const f32x4*)(src + i * 256 + lane * 4); ss += v[i][0] * v[i][0] + v[i][1] * v[i][1] + v[i][2] * v[i][2] + v[i][3] * v[i][3]; }
        ss = wave_sum(ss, lane);
        const float rs = rsqrtf(ss * (1.0f / 1024.0f) + 1e-6f);
#pragma unroll
        for (int i = 0; i < 4; ++i) { const int c = i * 256 + lane * 4;
            const f32x4 gv = *(const f32x4*)(g + c), sh = *(const f32x4*)(md + c), sc = *(const f32x4*)(md + 1024 + c);
            const f32x4 y = (v[i] * rs) * gv * (sc + 1.0f) + sh;
            u32x2 w; w.x = pg8::cvt_pk_bf16(y[0], y[1]); w.y = pg8::cvt_pk_bf16(y[2], y[3]);
            *(u32x2*)(H + (size_t)r * 1024 + c) = w; }
    }
}
DI void ph_final(const Args& a, float* x) {
    const int wave = ltid(a) >> 6, lane = ltid(a) & 63;
    const float* g = a.in[I_FNORM];
    for (int r = blockIdx.x * 8 + wave; r < NBATCH * SEQ; r += gridDim.x * 8) {
        float* src = x + (size_t)r * 1024;
        f32x4 v[4]; float ss = 0.f;
#pragma unroll
        for (int i = 0; i < 4; ++i) { v[i] = *(const f32x4*)(src + i * 256 + lane * 4); ss += v[i][0] * v[i][0] + v[i][1] * v[i][1] + v[i][2] * v[i][2] + v[i][3] * v[i][3]; }
        ss = wave_sum(ss, lane);
        const float rs = rsqrtf(ss * (1.0f / 1024.0f) + 1e-6f);
#pragma unroll
        for (int i = 0; i < 4; ++i) { const int c = i * 256 + lane * 4; const f32x4 gv = *(const f32x4*)(g + c); *(f32x4*)(src + c) = (v[i] * rs) * gv; }
    }
}
struct WDesc { const float* src; int ld, id, n64, tid; };
DI void wmap(int id, int nb, int& col, int& valid) {
    valid = 64;
    switch (id) {
        case 0: if (nb < 48) col = C_GQ + 64 * nb; else if (nb == 48) { col = C_GA; valid = 32; } else { col = 0; valid = 0; } break;
        case 1: col = (nb < 16) ? C_GZ + 64 * nb : C_GATE + 64 * (nb - 16); break;
        case 2: if (nb < 48) col = C_MQ + 64 * nb; else if (nb == 48) { col = C_MI; valid = 16; } else { col = 0; valid = 0; } break;
        case 3: col = (nb < 32) ? C_MO + 64 * nb : C_GATE + 2048 + 64 * (nb - 32); break;
        case 4: col = (nb < 32) ? C_SU + 64 * nb : C_GATE + 1024 + 64 * (nb - 32); break;
        case 5: { const int pn = nb >> 2, q = nb & 3; col = (q >> 1) * 1024 + 128 * pn + (q & 1) * 64; } break;
        default: col = 64 * nb; break;
    }
}
DI WDesc wdesc(const Args& a, int l, int id) {
    WDesc w; w.id = id; w.tid = ltid(a);
    if (id <= 4) { w.src = a.in[I_WIN] + (size_t)l * 1024 * NIN; w.ld = NIN; w.n64 = (id == 0 || id == 2) ? 52 : (id == 1 ? 32 : 48); }
    else if (id == 5) { w.src = a.in[I_SWGLU] + (size_t)l * 1024 * 2048; w.ld = 2048; w.n64 = 32; }
    else if (id <= 8) { w.src = a.in[I_WBR] + ((size_t)l * 3 + (id - 6)) * 1024 * 1024; w.ld = 1024; w.n64 = 16; }
    else { w.src = a.in[I_WOUT] + (size_t)l * 1024 * 1024; w.ld = 1024; w.n64 = 16; }
    return w;
}
DI void ph_cvt(const WDesc w, bf16_t* dst, LAS float* tile) {
    const int tid = w.tid, ntile = w.n64 * 16;
    for (int t = blockIdx.x; t < ntile; t += gridDim.x) {
        const int nb = t >> 4, kb = t & 15; int col, valid; wmap(w.id, nb, col, valid);
        __syncthreads();
        { const int c = tid & 63, k0 = tid >> 6;
#pragma unroll
          for (int i = 0; i < 8; ++i) { const int k = k0 + 8 * i; tile[k * 65 + c] = (c < valid) ? w.src[(size_t)(kb * 64 + k) * w.ld + col + c] : 0.f; } }
        __syncthreads();
        { const int n = tid >> 3, kk = (tid & 7) * 8; u32x4 o;
          o.x = pg8::cvt_pk_bf16(tile[(kk + 0) * 65 + n], tile[(kk + 1) * 65 + n]); o.y = pg8::cvt_pk_bf16(tile[(kk + 2) * 65 + n], tile[(kk + 3) * 65 + n]);
          o.z = pg8::cvt_pk_bf16(tile[(kk + 4) * 65 + n], tile[(kk + 5) * 65 + n]); o.w = pg8::cvt_pk_bf16(tile[(kk + 6) * 65 + n], tile[(kk + 7) * 65 + n]);
          *(u32x4*)(dst + (size_t)(nb * 64 + n) * 1024 + kb * 64 + kk) = o; }
    }
    __syncthreads();
}

DI void gdn_conv_decode(int unit, int& cb, int& seg, int& h) { cb = unit / 24; seg = (unit % 24) >> 3; h = unit & 7; }
DI void ph_gdn_conv(const Args& a, int l, bf16_t* QKV  , const bf16_t* halo, LAS unsigned char* lds, bf16_t* junk = nullptr) {
    constexpr int P = 136, IMG = 68 * P * 2 + 5 * 128 * 4;
    const int tid = ltid(a);
    const float* cw = a.in[I_GCONV] + (size_t)l * 5 * 3072;
    const int nunit = NCHUNK * 24;
    u32x4 rp[3]; f32x4 wreg = (f32x4){0.f, 0.f, 0.f, 0.f};
    int unit = blockIdx.x, buf = 0;
#define CONV_FETCH(un) do { int cb_, seg_, h_; gdn_conv_decode(un, cb_, seg_, h_); const bf16_t* T_ = QKV + (size_t)seg_ * (SZ_ACT / 2); \
        const bool first_ = (cb_ < 32) ? ((cb_ & 3) == 0) : (((cb_ - 32) & 63) == 0), last_ = (cb_ < 32) ? ((cb_ & 3) == 3) : (((cb_ - 32) & 63) == 63); \
        _Pragma("unroll") for (int q_ = 0; q_ < 3; ++q_) { const int i_ = tid + 512 * q_, rr_ = i_ >> 4, c8_ = (i_ & 15) * 8; u32x4 w_ = (u32x4){0u, 0u, 0u, 0u}; \
            if (i_ < 68 * 16) { if (rr_ >= 2 && rr_ < 66) w_ = *(const u32x4*)(T_ + (size_t)(cb_ * 64 + rr_ - 2) * 1024 + h_ * 128 + c8_); \
                else if (rr_ < 2) { if (!first_) w_ = *(const u32x4*)(halo + ((size_t)seg_ * (NCHUNK * 4) + (size_t)(cb_ - 1) * 4 + 2 + rr_) * 1024 + h_ * 128 + c8_); } \
                else { if (!last_) w_ = *(const u32x4*)(halo + ((size_t)seg_ * (NCHUNK * 4) + (size_t)(cb_ + 1) * 4 + (rr_ - 66)) * 1024 + h_ * 128 + c8_); } } \
            rp[q_] = w_; } \
        if (tid < 160) wreg = *(const f32x4*)(cw + (size_t)(tid >> 5) * 3072 + seg_ * 1024 + h_ * 128 + (tid & 31) * 4); } while (0)
    if (unit < nunit) CONV_FETCH(unit);
    for (; unit < nunit; unit += gridDim.x) {
        int cb, seg, h; gdn_conv_decode(unit, cb, seg, h);
        LAS bf16_t* raw = (LAS bf16_t*)(lds + buf * IMG); LAS float* wl = (LAS float*)(lds + buf * IMG + 68 * P * 2);
#pragma unroll
        for (int q = 0; q < 3; ++q) { const int i = tid + 512 * q, rr = i >> 4, c8 = (i & 15) * 8; if (i < 68 * 16) *(LAS u32x4*)(raw + rr * P + c8) = rp[q]; }
        if (tid < 160) *(LAS f32x4*)(wl + tid * 4) = wreg;
        if (unit + (int)gridDim.x < nunit) CONV_FETCH(unit + (int)gridDim.x);
        lds_barrier();
        bf16_t* T = QKV + (size_t)seg * (SZ_ACT / 2);
        const int t = tid >> 3, c0 = (tid & 7) * 16;
        float o[16]; float ss = 0.f;
#pragma unroll
        for (int half = 0; half < 2; ++half) {
            float acc[8];
#pragma unroll
            for (int j = 0; j < 8; ++j) acc[j] = 0.f;
#pragma unroll
            for (int k = 0; k < 5; ++k) {
                const u32x4 w = *(const LAS u32x4*)(raw + (t + k) * P + c0 + half * 8); float x[8]; unpack8(w, x);
                const f32x4 w0 = *(const LAS f32x4*)(wl + k * 128 + c0 + half * 8), w1 = *(const LAS f32x4*)(wl + k * 128 + c0 + half * 8 + 4);
#pragma unroll
                for (int j = 0; j < 4; ++j) { acc[j] += w0[j] * x[j]; acc[4 + j] += w1[j] * x[4 + j]; }
            }
#pragma unroll
            for (int j = 0; j < 8; ++j) { const float sv = siluf_(acc[j]); o[half * 8 + j] = sv; ss += sv * sv; }
        }
        ss += shx(ss, 1, tid & 63); ss += shx(ss, 2, tid & 63); ss += shx(ss, 4, tid & 63);
        float scale = 1.0f;
        if (seg == 0) scale = rsqrtf(ss + 1e-6f) * 0.08838834764831845f;
        else if (seg == 1) scale = rsqrtf(ss + 1e-6f);
        u32x4 w0, w1;
        w0.x = pg8::cvt_pk_bf16(o[0] * scale, o[1] * scale); w0.y = pg8::cvt_pk_bf16(o[2] * scale, o[3] * scale); w0.z = pg8::cvt_pk_bf16(o[4] * scale, o[5] * scale); w0.w = pg8::cvt_pk_bf16(o[6] * scale, o[7] * scale);
        w1.x = pg8::cvt_pk_bf16(o[8] * scale, o[9] * scale); w1.y = pg8::cvt_pk_bf16(o[10] * scale, o[11] * scale); w1.z = pg8::cvt_pk_bf16(o[12] * scale, o[13] * scale); w1.w = pg8::cvt_pk_bf16(o[14] * scale, o[15] * scale);
        bf16_t* op = (junk ? junk : T) + (size_t)(cb * 64 + t) * 1024 + h * 128 + c0;
        *(u32x4*)op = w0; *(u32x4*)(op + 8) = w1;
        buf ^= 1;
    }
#undef CONV_FETCH
    __syncthreads();
}
DI void ph_gdn_scan(const Args& a, int l, const bf16_t* Q, const bf16_t* K, const bf16_t* V, const float* GATE, bf16_t* OF, bf16_t* OB, LAS unsigned char* lds) {
    LAS float* qf = (LAS float*)lds;
    LAS float* kf = qf + 64 * 128;
    LAS float* vf = kf + 64 * 128;
    LAS float* av = vf + 64 * 64;
    LAS float* bt = av + 64;
    LAS float* part = bt + 64;
    LAS float* po = part + 1024;
    const int tid = ltid(a), e = tid & 63, dq = tid >> 6;
    for (int unit = blockIdx.x; unit < 256; unit += gridDim.x) {
        const int eh = unit & 1, d = (unit >> 1) & 1, h = (unit >> 2) & 7, b = unit >> 5;
        const float nea = -__expf(a.in[I_GALOG][(l * 2 + d) * 8 + h]), dtb = a.in[I_GDTB][(l * 2 + d) * 8 + h];
        bf16_t* O = d ? OB : OF;
        float S[16];
#pragma unroll
        for (int j = 0; j < 16; ++j) S[j] = 0.f;
        float opart = 0.f; int prow = -1, par = 0;
        for (int step = 0; step < 68; ++step) {
            const int cc = (step < 4) ? (d ? 3 - step : step) : (d ? 67 - step : step - 4);
            const int row0 = (step < 4) ? b * 256 + cc * 64 : CTXROWS + b * 4096 + cc * 64;
            __syncthreads();
            for (int i = tid; i < 1024; i += NT) { const int r = i >> 4, c8 = (i & 15) * 8; float f[8];
                unpack8(*(const u32x4*)(Q + (size_t)(row0 + r) * 1024 + h * 128 + c8), f);
#pragma unroll
                for (int j = 0; j < 8; ++j) qf[r * 128 + c8 + j] = f[j];
                unpack8(*(const u32x4*)(K + (size_t)(row0 + r) * 1024 + h * 128 + c8), f);
#pragma unroll
                for (int j = 0; j < 8; ++j) kf[r * 128 + c8 + j] = f[j]; }
            { const int r = tid >> 3, c8 = (tid & 7) * 8; float f[8]; unpack8(*(const u32x4*)(V + (size_t)(row0 + r) * 1024 + h * 128 + eh * 64 + c8), f);
#pragma unroll
              for (int j = 0; j < 8; ++j) vf[r * 64 + c8 + j] = f[j]; }
            if (tid < 64) { const float* gp = GATE + (size_t)(row0 + tid) * 32; av[tid] = __expf(nea * softplusf_(gp[d * 8 + h] + dtb)); bt[tid] = sigmoidf_(gp[16 + d * 8 + h]); }
            __syncthreads();
            for (int tt = 0; tt < 64; ++tt) {
                const int t = d ? 63 - tt : tt;
                float kk[16];
#pragma unroll
                for (int j4 = 0; j4 < 4; ++j4) { const f32x4 x = *(const LAS f32x4*)(kf + t * 128 + dq * 16 + j4 * 4); kk[j4 * 4] = x[0]; kk[j4 * 4 + 1] = x[1]; kk[j4 * 4 + 2] = x[2]; kk[j4 * 4 + 3] = x[3]; }
                float p = 0.f;
#pragma unroll
                for (int j = 0; j < 16; ++j) p += kk[j] * S[j];
                part[(par * 8 + dq) * 64 + e] = p; po[(par * 8 + dq) * 64 + e] = opart;
                __syncthreads();
                if (dq == 0 && prow >= 0) { float o = 0.f;
#pragma unroll
                    for (int q = 0; q < 8; ++q) o += po[(par * 8 + q) * 64 + e];
                    O[(size_t)prow * 1024 + h * 128 + eh * 64 + e] = f2bf(o); }
                float ks = 0.f;
#pragma unroll
                for (int q = 0; q < 8; ++q) ks += part[(par * 8 + q) * 64 + e];
                const float at = av[t], vn = bt[t] * (vf[t * 64 + e] - at * ks);
#pragma unroll
                for (int j = 0; j < 16; ++j) S[j] = at * S[j] + kk[j] * vn;
                float qo = 0.f;
#pragma unroll
                for (int j4 = 0; j4 < 4; ++j4) { const f32x4 x = *(const LAS f32x4*)(qf + t * 128 + dq * 16 + j4 * 4); qo += x[0] * S[j4 * 4] + x[1] * S[j4 * 4 + 1] + x[2] * S[j4 * 4 + 2] + x[3] * S[j4 * 4 + 3]; }
                opart = qo; prow = row0 + t; par ^= 1;
            }
        }
        po[(par * 8 + dq) * 64 + e] = opart;
        __syncthreads();
        if (dq == 0) { float o = 0.f;
#pragma unroll
            for (int q = 0; q < 8; ++q) o += po[(par * 8 + q) * 64 + e];
            O[(size_t)prow * 1024 + h * 128 + eh * 64 + e] = f2bf(o); }
        __syncthreads();
    }
}
template <int O> DI float swz_xor(float v) { return __int_as_float(__builtin_amdgcn_ds_swizzle(__float_as_int(v), 0x1F | (O << 10))); }
DI void ph_gdn_post(const Args& a, int l, bf16_t* OF, const bf16_t* OB, const bf16_t* SZ, bf16_t* junk = nullptr) {
    const int tid = ltid(a), wave = tid >> 6, lane = tid & 63;
    const float* g = a.in[I_GNORM] + l * 128 + (lane & 15) * 8;
    const f32x4 g0 = *(const f32x4*)g, g1 = *(const f32x4*)(g + 4);
    const int nit = MROWS * 2, stride = gridDim.x * 8;
    for (int it = blockIdx.x * 8 + wave; it < nit; it += 2 * stride) {
        const int it1 = it + stride; const bool two = it1 < nit;
        const size_t off0 = (size_t)it * 512 + lane * 8, off1 = (size_t)(two ? it1 : it) * 512 + lane * 8;
        const u32x4 f0 = *(const u32x4*)(OF + off0), b0 = *(const u32x4*)(OB + off0), z0 = *(const u32x4*)(SZ + off0);
        const u32x4 f1 = *(const u32x4*)(OF + off1), b1 = *(const u32x4*)(OB + off1), z1 = *(const u32x4*)(SZ + off1);
        float x0[8], x1[8], t0[8], t1[8];
        unpack8(f0, x0); unpack8(b0, t0); unpack8(f1, x1); unpack8(b1, t1);
        float s0 = 0.f, s1 = 0.f;
#pragma unroll
        for (int j = 0; j < 8; ++j) { x0[j] += t0[j]; x1[j] += t1[j]; s0 += x0[j] * x0[j]; s1 += x1[j] * x1[j]; }
        s0 += swz_xor<1>(s0); s1 += swz_xor<1>(s1); s0 += swz_xor<2>(s0); s1 += swz_xor<2>(s1); s0 += swz_xor<4>(s0); s1 += swz_xor<4>(s1); s0 += swz_xor<8>(s0); s1 += swz_xor<8>(s1);
        const float r0 = rsqrtf(s0 * (1.0f / 128.0f) + 1e-6f), r1 = rsqrtf(s1 * (1.0f / 128.0f) + 1e-6f);
        unpack8(z0, t0); unpack8(z1, t1);
        u32x4 w0, w1;
        w0.x = pg8::cvt_pk_bf16(x0[0] * r0 * g0[0] * t0[0], x0[1] * r0 * g0[1] * t0[1]); w0.y = pg8::cvt_pk_bf16(x0[2] * r0 * g0[2] * t0[2], x0[3] * r0 * g0[3] * t0[3]);
        w0.z = pg8::cvt_pk_bf16(x0[4] * r0 * g1[0] * t0[4], x0[5] * r0 * g1[1] * t0[5]); w0.w = pg8::cvt_pk_bf16(x0[6] * r0 * g1[2] * t0[6], x0[7] * r0 * g1[3] * t0[7]);
        w1.x = pg8::cvt_pk_bf16(x1[0] * r1 * g0[0] * t1[0], x1[1] * r1 * g0[1] * t1[1]); w1.y = pg8::cvt_pk_bf16(x1[2] * r1 * g0[2] * t1[2], x1[3] * r1 * g0[3] * t1[3]);
        w1.z = pg8::cvt_pk_bf16(x1[4] * r1 * g1[0] * t1[4], x1[5] * r1 * g1[1] * t1[5]); w1.w = pg8::cvt_pk_bf16(x1[6] * r1 * g1[2] * t1[6], x1[7] * r1 * g1[3] * t1[7]);
        bf16_t* dst = junk ? junk : OF;
        *(u32x4*)(dst + off0) = w0; if (two) *(u32x4*)(dst + off1) = w1;
    }
}

DI void ph_ml_scan(const Args& a, int l, const bf16_t* Q, const bf16_t* K, const bf16_t* V, const float* GATE, bf16_t* HF, bf16_t* HB, LAS unsigned char* lds) {
    LAS bf16_t* qs = (LAS bf16_t*)lds;
    LAS bf16_t* ks = qs + 64 * 256;
    LAS float* vf = (LAS float*)(ks + 64 * 256);
    LAS float* ip = vf + 64 * 64;
    LAS float* lf = ip + 64;
    LAS float* part = lf + 64;
    LAS float* dpart = part + 1024;
    const int tid = ltid(a), e = tid & 63, dq = tid >> 6;
    for (int unit = blockIdx.x; unit < 256; unit += gridDim.x) {
        const int eq = unit & 3, d = (unit >> 2) & 1, hd = (unit >> 3) & 3, b = unit >> 5;
        const float ibias = a.in[I_MIB][(l * 2 + d) * 4 + hd], fbias = a.in[I_MFB][(l * 2 + d) * 4 + hd];
        bf16_t* HO = d ? HB : HF;
        float C[32];
#pragma unroll
        for (int j = 0; j < 32; ++j) C[j] = 0.f;
        float nn = 0.f, m = 0.f; int par = 0;
        for (int step = 0; step < 68; ++step) {
            const int cc = (step < 4) ? (d ? 3 - step : step) : (d ? 67 - step : step - 4);
            const int row0 = (step < 4) ? b * 256 + cc * 64 : CTXROWS + b * 4096 + cc * 64;
            __syncthreads();
            for (int i = tid; i < 2048; i += NT) { const int r = i >> 5, c8 = (i & 31) * 8;
                *(LAS u32x4*)(qs + r * 256 + c8) = *(const u32x4*)(Q + (size_t)(row0 + r) * 1024 + hd * 256 + c8);
                *(LAS u32x4*)(ks + r * 256 + c8) = *(const u32x4*)(K + (size_t)(row0 + r) * 1024 + hd * 256 + c8); }
            { const int r = tid >> 3, c8 = (tid & 7) * 8; float f[8]; unpack8(*(const u32x4*)(V + (size_t)(row0 + r) * 1024 + hd * 256 + eq * 64 + c8), f);
#pragma unroll
              for (int j = 0; j < 8; ++j) vf[r * 64 + c8 + j] = f[j]; }
            if (tid < 64) { const float* gp = GATE + (size_t)(row0 + tid) * 32; ip[tid] = gp[d * 4 + hd] + ibias; lf[tid] = -softplusf_(-(gp[8 + d * 4 + hd] + fbias)); }
            __syncthreads();
            for (int tt = 0; tt < 64; ++tt) {
                const int t = d ? 63 - tt : tt;
                const float it = ip[t], ft = lf[t];
                const float mn = fmaxf(ft + m, it);
                const float fdec = __expf(ft + m - mn), iw = __expf(it - mn) * 0.0625f, nrm = __expf(-mn);
                m = mn;
                const float vv = iw * vf[t * 64 + e];
                float pn = 0.f;
#pragma unroll
                for (int j8 = 0; j8 < 4; ++j8) {
                    float kk[8], qq[8];
                    unpack8(*(const LAS u32x4*)(ks + t * 256 + dq * 32 + j8 * 8), kk);
                    unpack8(*(const LAS u32x4*)(qs + t * 256 + dq * 32 + j8 * 8), qq);
#pragma unroll
                    for (int j = 0; j < 8; ++j) { const float c = fdec * C[j8 * 8 + j] + vv * kk[j]; C[j8 * 8 + j] = c; pn += c * qq[j]; }
                }
                const int dn = dq * 32 + (e & 31);
                nn = fdec * nn + iw * bf2f(ks[t * 256 + dn]);
                float pd = (e < 32) ? nn * bf2f(qs[t * 256 + dn]) : 0.f;
                pd = wave_sum(pd, e);
                part[(par * 8 + dq) * 64 + e] = pn; if (e == 0) dpart[par * 8 + dq] = pd;
                __syncthreads();
                if (dq == 0) { float num = 0.f, den = 0.f;
#pragma unroll
                    for (int q = 0; q < 8; ++q) { num += part[(par * 8 + q) * 64 + e]; den += dpart[par * 8 + q]; }
                    HO[(size_t)(row0 + t) * 1024 + hd * 256 + eq * 64 + e] = f2bf(num / fmaxf(fabsf(den), nrm)); }
                par ^= 1;
            }
        }
        __syncthreads();
    }
}
DI void ph_ml_post(const Args& a, int l, bf16_t* HF, const bf16_t* HB, const bf16_t* SO, const bf16_t* SZ) {
    const int tid = ltid(a), wave = tid >> 6, lane = tid & 63;
    const float* g = a.in[I_MNORM] + l * 256 + (lane & 31) * 8;
    const f32x4 g0 = *(const f32x4*)g, g1 = *(const f32x4*)(g + 4);
    const int nit = MROWS * 2, stride = gridDim.x * 8;
    for (int it = blockIdx.x * 8 + wave; it < nit; it += stride) {
        const size_t off = (size_t)it * 512 + lane * 8;
        const u32x4 f0 = *(const u32x4*)(HF + off), b0 = *(const u32x4*)(HB + off), o0 = *(const u32x4*)(SO + off), z0 = *(const u32x4*)(SZ + off);
        float x[8], t0[8];
        unpack8(f0, x); unpack8(b0, t0);
#pragma unroll
        for (int j = 0; j < 8; ++j) x[j] += t0[j];
        unpack8(o0, t0);
        float s0 = 0.f;
#pragma unroll
        for (int j = 0; j < 8; ++j) { x[j] *= t0[j]; s0 += x[j] * x[j]; }
        s0 += swz_xor<1>(s0); s0 += swz_xor<2>(s0); s0 += swz_xor<4>(s0); s0 += swz_xor<8>(s0); s0 += swz_xor<16>(s0);
        const float r0 = rsqrtf(s0 * (1.0f / 256.0f) + 1e-6f);
        unpack8(z0, t0);
        u32x4 w0;
        w0.x = pg8::cvt_pk_bf16(x[0] * r0 * g0[0] * t0[0], x[1] * r0 * g0[1] * t0[1]); w0.y = pg8::cvt_pk_bf16(x[2] * r0 * g0[2] * t0[2], x[3] * r0 * g0[3] * t0[3]);
        w0.z = pg8::cvt_pk_bf16(x[4] * r0 * g1[0] * t0[4], x[5] * r0 * g1[1] * t0[5]); w0.w = pg8::cvt_pk_bf16(x[6] * r0 * g1[2] * t0[6], x[7] * r0 * g1[3] * t0[7]);
        *(u32x4*)(HF + off) = w0;
    }
}

DI void ph_s5_scan(const Args& a, int l, const bf16_t* U, bf16_t* YF, bf16_t* YB, LAS unsigned char* lds) {
    const int tid = ltid(a), w = tid >> 6, p = tid & 63;
    LAS float* ub = (LAS float*)lds + w * 2304;
    LAS float* yb = ub + 1024;
    LAS float* xb = yb + 1024;
    for (int unit = blockIdx.x; unit < 128; unit += gridDim.x) {
        const int gb = unit & 7, d = (unit >> 3) & 1, b = unit >> 4, g = gb * 8 + w;
        const float stp = expf(a.in[I_SLOG][(l * 2 + d) * 64 + g]);
        const float lre = a.in[I_SLRE][((size_t)(l * 2 + d) * 64 + g) * 64 + p], lim = a.in[I_SLIM][((size_t)(l * 2 + d) * 64 + g) * 64 + p];
        const float mag = expf(lre * stp), lbr = mag * cosf(lim * stp), lbi = mag * sinf(lim * stp);
        const float dnm = lre * lre + lim * lim;
        const float fre = ((lbr - 1.0f) * lre + lbi * lim) / dnm, fim = (lbi * lre - (lbr - 1.0f) * lim) / dnm;
        float bbr[16], bbi[16];
        { const float* br = a.in[I_SBRE] + (((size_t)l * 64 + g) * 64 + p) * 16; const float* bi = a.in[I_SBIM] + (((size_t)l * 64 + g) * 64 + p) * 16;
#pragma unroll
          for (int h = 0; h < 16; ++h) { bbr[h] = fre * br[h] - fim * bi[h]; bbi[h] = fre * bi[h] + fim * br[h]; } }
        const int hh = p & 15, pt = p >> 4;
        float cr[16], ci[16];
        { const float* c0 = a.in[I_SCRE] + (((size_t)l * 64 + g) * 16 + hh) * 64 + pt * 16; const float* c1 = a.in[I_SCIM] + (((size_t)l * 64 + g) * 16 + hh) * 64 + pt * 16;
#pragma unroll
          for (int j = 0; j < 16; ++j) { cr[j] = c0[j]; ci[j] = c1[j]; } }
        bf16_t* Y = d ? YB : YF;
        float xr = 0.f, xi = 0.f; int par = 0;
        for (int step = 0; step < 68; ++step) {
            const int cc = (step < 4) ? (d ? 3 - step : step) : (d ? 67 - step : step - 4);
            const int row0 = (step < 4) ? b * 256 + cc * 64 : CTXROWS + b * 4096 + cc * 64;
            __syncthreads();
            { const bf16_t* up = U + (size_t)(row0 + p) * 1024 + g * 16; float f[8];
              unpack8(*(const u32x4*)up, f);
#pragma unroll
              for (int j = 0; j < 8; ++j) ub[p * 16 + j] = f[j];
              unpack8(*(const u32x4*)(up + 8), f);
#pragma unroll
              for (int j = 0; j < 8; ++j) ub[p * 16 + 8 + j] = f[j]; }
            __syncthreads();
            for (int tt = 0; tt < 64; ++tt) {
                const int t = d ? 63 - tt : tt;
                float bur = 0.f, bui = 0.f;
#pragma unroll
                for (int h4 = 0; h4 < 4; ++h4) { const f32x4 u = *(const LAS f32x4*)(ub + t * 16 + h4 * 4);
#pragma unroll
                    for (int j = 0; j < 4; ++j) { bur += bbr[h4 * 4 + j] * u[j]; bui += bbi[h4 * 4 + j] * u[j]; } }
                const float nxr = lbr * xr - lbi * xi + bur, nxi = lbr * xi + lbi * xr + bui;
                xr = nxr; xi = nxi;
                xb[par * 128 + p] = xr; xb[par * 128 + 64 + p] = xi;
                __syncthreads();
                float y = 0.f;
#pragma unroll
                for (int j4 = 0; j4 < 4; ++j4) { const f32x4 vr = *(const LAS f32x4*)(xb + par * 128 + pt * 16 + j4 * 4), vi = *(const LAS f32x4*)(xb + par * 128 + 64 + pt * 16 + j4 * 4);
#pragma unroll
                    for (int j = 0; j < 4; ++j) y += cr[j4 * 4 + j] * vr[j] - ci[j4 * 4 + j] * vi[j]; }
                y += shx(y, 16, p); y += shx(y, 32, p);
                if (p < 16) yb[t * 16 + p] = y;
                par ^= 1;
            }
            __syncthreads();
            { u32x4 w0, w1; const LAS float* ys = yb + p * 16;
              w0.x = pg8::cvt_pk_bf16(ys[0], ys[1]); w0.y = pg8::cvt_pk_bf16(ys[2], ys[3]); w0.z = pg8::cvt_pk_bf16(ys[4], ys[5]); w0.w = pg8::cvt_pk_bf16(ys[6], ys[7]);
              w1.x = pg8::cvt_pk_bf16(ys[8], ys[9]); w1.y = pg8::cvt_pk_bf16(ys[10], ys[11]); w1.z = pg8::cvt_pk_bf16(ys[12], ys[13]); w1.w = pg8::cvt_pk_bf16(ys[14], ys[15]);
              bf16_t* yp = Y + (size_t)(row0 + p) * 1024 + g * 16; *(u32x4*)yp = w0; *(u32x4*)(yp + 8) = w1; }
        }
        __syncthreads();
    }
}
DI void ph_s5_post(const Args& a, int l, bf16_t* YF, const bf16_t* YB, const bf16_t* U) {
    const float* dsk = a.in[I_SD] + l * 1024;
    for (size_t i = (size_t)blockIdx.x * NT + ltid(a); i < (size_t)MROWS * 128; i += (size_t)gridDim.x * NT) {
        const size_t off = i * 8; const int c = (int)(off & 1023);
        float f[8], bq[8], u[8]; unpack8(*(const u32x4*)(YF + off), f); unpack8(*(const u32x4*)(YB + off), bq); unpack8(*(const u32x4*)(U + off), u);
        const f32x4 d0 = *(const f32x4*)(dsk + c), d1 = *(const f32x4*)(dsk + c + 4);
        float o[8];
#pragma unroll
        for (int j = 0; j < 4; ++j) { o[j] = gelu_tanh_(f[j] + bq[j] + d0[j] * u[j]); o[4 + j] = gelu_tanh_(f[4 + j] + bq[4 + j] + d1[j] * u[4 + j]); }
        u32x4 w; w.x = pg8::cvt_pk_bf16(o[0], o[1]); w.y = pg8::cvt_pk_bf16(o[2], o[3]); w.z = pg8::cvt_pk_bf16(o[4], o[5]); w.w = pg8::cvt_pk_bf16(o[6], o[7]);
        *(u32x4*)(YF + off) = w;
    }
}

constexpr int S5_T = 16, S5_NCH = MROWS / S5_T  , S5_RG = 2304, S5_PMG = S5_RG / 256;
constexpr size_t SZ_AX = (size_t)64 * S5_RG * 512 * 2, SZ_CW1 = (size_t)64 * 256 * 256 * 2, SZ_CW2 = (size_t)64 * 256 * 512 * 2;
constexpr size_t R5_AX = 0, R5_SZ = SZ_AX, R5_G1 = R5_SZ + SZ_ACT, R5_GLUA = R5_G1 + SZ_ACT, R5_END = R5_GLUA + SZ_ACT;
static_assert(WS_R + R5_END <= WS_END, "S5 stage layout fits the workspace"); static_assert(WS_END <= (size_t)512 * 1024 * 1024, "workspace budget");
static_assert(SZ_CW1 + SZ_CW2 + (size_t)17 * 1024 * 128 * 4 <= SZ_ACT, "S5 constants live in the H region once the last projection from H is done");

struct EpiS1 {
    static constexpr bool PERM = true, AFTER_DRAIN = false;
    bf16_t* AX; bf16_t* SZ; bf16_t* G1;
    __device__ __forceinline__ void operator()(const f32x4 (&acc)[2][2][4][2], const Unit& u, int wr, int wc, int fr, int fq) const {
        const int row0 = u.pm * 256 + wr * 64 + fr, seg = u.pn >> 2;
        const int col0 = (u.pn & 3) * 256 + wc * 32 + 8 * fq;
#pragma unroll
        for (int ai = 0; ai < 2; ++ai)
#pragma unroll
            for (int m = 0; m < 4; ++m) {
                const int r = row0 + ai * 128 + m * 16;
#pragma unroll
                for (int bj = 0; bj < 2; ++bj) {
                    f32x4 v0 = acc[ai][bj][m][0], v1 = acc[ai][bj][m][1];
                    const int c = col0 + bj * 128;
                    bf16_t* dp;
                    if (seg == 0) dp = AX + ((size_t)(c >> 4) * S5_RG + (r >> 4)) * 512 + (r & 15) * 16 + (c & 15);
                    else if (seg == 1) { dp = SZ + (size_t)r * 1024 + c;
#pragma unroll
                        for (int j = 0; j < 4; ++j) { v0[j] = siluf_(v0[j]); v1[j] = siluf_(v1[j]); } }
                    else { dp = G1 + (size_t)r * 1024 + c;
#pragma unroll
                        for (int j = 0; j < 4; ++j) { v0[j] = sigmoidf_(v0[j]); v1[j] = sigmoidf_(v1[j]); } }
                    u32x4 w; w.x = pg8::cvt_pk_bf16(v0[0], v0[1]); w.y = pg8::cvt_pk_bf16(v0[2], v0[3]); w.z = pg8::cvt_pk_bf16(v1[0], v1[1]); w.w = pg8::cvt_pk_bf16(v1[2], v1[3]);
                    *(u32x4*)dp = w;
                }
            }
    }
};
struct EpiS5L {
    static constexpr bool PERM = true, AFTER_DRAIN = false;
    bf16_t* AX;
    __device__ __forceinline__ void operator()(const f32x4 (&acc)[2][2][4][2], const Unit& u, int wr, int wc, int fr, int fq) const {
        const int g = u.pm / S5_PMG, rg0 = (u.pm % S5_PMG) * 256 + wr * 64 + fr, col0 = wc * 32 + 8 * fq;
#pragma unroll
        for (int ai = 0; ai < 2; ++ai)
#pragma unroll
            for (int m = 0; m < 4; ++m) {
                const int rg = rg0 + ai * 128 + m * 16;
                if (rg < S5_NCH) {
                    bf16_t* rp = AX + ((size_t)g * S5_RG + rg) * 512 + 256 + col0;
#pragma unroll
                    for (int bj = 0; bj < 2; ++bj) { const f32x4 v0 = acc[ai][bj][m][0], v1 = acc[ai][bj][m][1];
                        u32x4 w; w.x = pg8::cvt_pk_bf16(v0[0], v0[1]); w.y = pg8::cvt_pk_bf16(v0[2], v0[3]); w.z = pg8::cvt_pk_bf16(v1[0], v1[1]); w.w = pg8::cvt_pk_bf16(v1[2], v1[3]);
                        *(u32x4*)(rp + bj * 128) = w; }
                }
            }
    }
};
struct EpiS5Y {
    static constexpr bool PERM = true, AFTER_DRAIN = false;
    const bf16_t* AX; bf16_t* GLUA; const float* dsk;
    __device__ __forceinline__ void operator()(const f32x4 (&acc)[2][2][4][2], const Unit& u, int wr, int wc, int fr, int fq) const {
        const int g = u.pm / S5_PMG, rg0 = (u.pm % S5_PMG) * 256 + wr * 64 + fr, col0 = wc * 32 + 8 * fq;
        const int h0 = col0 & 15;
        const f32x4 d0 = *(const f32x4*)(dsk + g * 16 + h0), d1 = *(const f32x4*)(dsk + g * 16 + h0 + 4);
#pragma unroll
        for (int ai = 0; ai < 2; ++ai)
#pragma unroll
            for (int m = 0; m < 4; ++m) {
                const int rg = rg0 + ai * 128 + m * 16;
                if (rg < S5_NCH) {
#pragma unroll
                    for (int bj = 0; bj < 2; ++bj) {
                        const int c = col0 + bj * 128, t = c >> 4;
                        float uu[8]; unpack8(*(const u32x4*)(AX + ((size_t)g * S5_RG + rg) * 512 + c), uu);
                        const f32x4 v0 = acc[ai][bj][m][0], v1 = acc[ai][bj][m][1];
                        float o[8];
#pragma unroll
                        for (int j = 0; j < 4; ++j) { o[j] = gelu_tanh_(v0[j] + d0[j] * uu[j]); o[4 + j] = gelu_tanh_(v1[j] + d1[j] * uu[4 + j]); }
                        u32x4 w; w.x = pg8::cvt_pk_bf16(o[0], o[1]); w.y = pg8::cvt_pk_bf16(o[2], o[3]); w.z = pg8::cvt_pk_bf16(o[4], o[5]); w.w = pg8::cvt_pk_bf16(o[6], o[7]);
                        *(u32x4*)(GLUA + (size_t)(rg * 16 + t) * 1024 + g * 16 + h0) = w;
                    }
                }
            }
    }
};
DI void ph_s5_consts(const Args& a, int l, bf16_t* CW1, bf16_t* CW2, LAS unsigned char* lds) {
    LAS float* POW = (LAS float*)lds;
    LAS float* BB = POW + 2 * 17 * 64 * 2;
    LAS float* CC = BB + 2 * 64 * 16 * 2;
    LAS float* KT = CC + 16 * 64 * 2;
    const int tid = ltid(a);
    for (int g = blockIdx.x; g < 64; g += gridDim.x) {
        __syncthreads();
        for (int i = tid; i < 2 * 17 * 64; i += NT) {
            const int p = i & 63, j = (i >> 6) % 17, d = i / (17 * 64);
            const float stp = expf(a.in[I_SLOG][(l * 2 + d) * 64 + g]);
            const float lre = a.in[I_SLRE][((size_t)(l * 2 + d) * 64 + g) * 64 + p], lim = a.in[I_SLIM][((size_t)(l * 2 + d) * 64 + g) * 64 + p];
            const float mag = expf((float)j * lre * stp), ang = (float)j * (lim * stp);
            POW[i * 2] = mag * cosf(ang); POW[i * 2 + 1] = mag * sinf(ang);
        }
        for (int i = tid; i < 16 * 64; i += NT) { const int p = i & 63, h = i >> 6;
            CC[i * 2] = a.in[I_SCRE][(((size_t)l * 64 + g) * 16 + h) * 64 + p]; CC[i * 2 + 1] = a.in[I_SCIM][(((size_t)l * 64 + g) * 16 + h) * 64 + p]; }
        __syncthreads();
        for (int i = tid; i < 2 * 64 * 16; i += NT) {
            const int h = i & 15, p = (i >> 4) & 63, d = i >> 10;
            const float stp = expf(a.in[I_SLOG][(l * 2 + d) * 64 + g]);
            const float lre = a.in[I_SLRE][((size_t)(l * 2 + d) * 64 + g) * 64 + p], lim = a.in[I_SLIM][((size_t)(l * 2 + d) * 64 + g) * 64 + p];
            const float lbr = POW[((d * 17 + 1) * 64 + p) * 2], lbi = POW[((d * 17 + 1) * 64 + p) * 2 + 1];
            const float dnm = lre * lre + lim * lim;
            const float fre = ((lbr - 1.0f) * lre + lbi * lim) / dnm, fim = (lbi * lre - (lbr - 1.0f) * lim) / dnm;
            const float br = a.in[I_SBRE][(((size_t)l * 64 + g) * 64 + p) * 16 + h], bi = a.in[I_SBIM][(((size_t)l * 64 + g) * 64 + p) * 16 + h];
            BB[i * 2] = fre * br - fim * bi; BB[i * 2 + 1] = fre * bi + fim * br;
        }
        __syncthreads();
        { const int hp = tid & 15, h = (tid >> 4) & 15, d = tid >> 8;
          float kt[16];
#pragma unroll
          for (int tau = 0; tau < 16; ++tau) kt[tau] = 0.f;
          for (int p = 0; p < 64; ++p) {
              const float cr = CC[(h * 64 + p) * 2], ci = CC[(h * 64 + p) * 2 + 1];
              const float br = BB[((d * 64 + p) * 16 + hp) * 2], bi = BB[((d * 64 + p) * 16 + hp) * 2 + 1];
              const float gr = cr * br - ci * bi, gi = cr * bi + ci * br;
#pragma unroll
              for (int tau = 0; tau < 16; ++tau) { const float pr = POW[((d * 17 + tau) * 64 + p) * 2], pi = POW[((d * 17 + tau) * 64 + p) * 2 + 1]; kt[tau] += gr * pr - gi * pi; } }
#pragma unroll
          for (int tau = 0; tau < 16; ++tau) KT[((d * 16 + tau) * 16 + h) * 16 + hp] = kt[tau]; }
        __syncthreads();
        bf16_t* c1 = CW1 + (size_t)g * 65536;
        for (int i = tid; i < 65536 / 2; i += NT) {
            const int k = (i * 2) & 255, n = (i * 2) >> 8; const int p = n & 63, ri = (n >> 6) & 1, d = n >> 7, s = k >> 4, hp = k & 15;
            const int j = d ? s : 15 - s;
            const float pr = POW[((d * 17 + j) * 64 + p) * 2], pi = POW[((d * 17 + j) * 64 + p) * 2 + 1];
            float o[2];
#pragma unroll
            for (int q = 0; q < 2; ++q) { const float br = BB[((d * 64 + p) * 16 + hp + q) * 2], bi = BB[((d * 64 + p) * 16 + hp + q) * 2 + 1]; o[q] = ri ? (pr * bi + pi * br) : (pr * br - pi * bi); }
            *(unsigned*)(c1 + (size_t)n * 256 + k) = pg8::cvt_pk_bf16(o[0], o[1]);
        }
        bf16_t* c2 = CW2 + (size_t)g * 131072;
        for (int i = tid; i < 131072 / 2; i += NT) {
            const int k = (i * 2) & 511, n = (i * 2) >> 9; const int t = n >> 4, h = n & 15;
            float o[2];
            if (k < 256) { const int s = k >> 4, hp = k & 15;
#pragma unroll
                for (int q = 0; q < 2; ++q) { float v = 0.f; if (s <= t) v += KT[((0 * 16 + (t - s)) * 16 + h) * 16 + hp + q]; if (s >= t) v += KT[((1 * 16 + (s - t)) * 16 + h) * 16 + hp + q]; o[q] = v; } }
            else { const int kk = k - 256, d = kk >> 7, ri = (kk >> 6) & 1; const int j = d ? 16 - t : t + 1;
#pragma unroll
                for (int q = 0; q < 2; ++q) { const int p = (kk & 63) + q; const float cr = CC[(h * 64 + p) * 2], ci = CC[(h * 64 + p) * 2 + 1];
                    const float pr = POW[((d * 17 + j) * 64 + p) * 2], pi = POW[((d * 17 + j) * 64 + p) * 2 + 1];
                    o[q] = ri ? -(cr * pi + ci * pr) : (cr * pr - ci * pi); } }
            *(unsigned*)(c2 + (size_t)n * 512 + k) = pg8::cvt_pk_bf16(o[0], o[1]);
        }
    }
    __syncthreads();
}
DI int s5_row(int b, int d, int st) { const int cc = (st < 16) ? (d ? 15 - st : st) : (d ? 271 - st : st - 16); return (st < 16) ? b * 16 + cc : 128 + b * 256 + cc; }
DI void s5_lane_consts(const Args& a, int l, int d, int g, int p, float& ar, float& ai) {
    const float stp = expf(a.in[I_SLOG][(l * 2 + d) * 64 + g]);
    const float lre = a.in[I_SLRE][((size_t)(l * 2 + d) * 64 + g) * 64 + p], lim = a.in[I_SLIM][((size_t)(l * 2 + d) * 64 + g) * 64 + p];
    const float mag = expf(16.0f * lre * stp), ang = 16.0f * (lim * stp);
    ar = mag * cosf(ang); ai = mag * sinf(ang);
}
DI void ph_s5_carry1(const Args& a, int l, bf16_t* AX, float* SEG) {
    const int tid = ltid(a), w = tid >> 6, p = tid & 63;
    for (int item = blockIdx.x * 8 + w; item < 17 * 1024; item += gridDim.x * 8) {
        const int unit = item & 1023, seg = item >> 10, d = unit & 1, g = (unit >> 1) & 63, b = unit >> 7;
        float ar, ai; s5_lane_consts(a, l, d, g, p, ar, ai);
        bf16_t* base = AX + (size_t)g * S5_RG * 512 + 256 + d * 128 + p;
        float lr[16], li[16];
#pragma unroll
        for (int q = 0; q < 16; ++q) { const size_t o = (size_t)s5_row(b, d, seg * 16 + q) * 512; lr[q] = bf2f(base[o]); li[q] = bf2f(base[o + 64]); }
        float xr = 0.f, xi = 0.f;
#pragma unroll
        for (int q = 0; q < 16; ++q) { const size_t o = (size_t)s5_row(b, d, seg * 16 + q) * 512;
            base[o] = f2bf(xr); base[o + 64] = f2bf(xi);
            const float nr = ar * xr - ai * xi + lr[q], ni = ar * xi + ai * xr + li[q]; xr = nr; xi = ni; }
        SEG[((size_t)seg * 1024 + unit) * 128 + p] = xr; SEG[((size_t)seg * 1024 + unit) * 128 + 64 + p] = xi;
    }
}
DI void ph_s5_carry2(const Args& a, int l, bf16_t* AX, const float* SEG) {
    const int tid = ltid(a), w = tid >> 6, p = tid & 63;
    for (int item = blockIdx.x * 8 + w; item < 16 * 1024; item += gridDim.x * 8) {
        const int unit = item & 1023, seg = 1 + (item >> 10), d = unit & 1, g = (unit >> 1) & 63, b = unit >> 7;
        float ar, ai; s5_lane_consts(a, l, d, g, p, ar, ai);
        float sr = ar, si = ai;
#pragma unroll
        for (int q = 0; q < 4; ++q) { const float nr = sr * sr - si * si, ni = 2.0f * sr * si; sr = nr; si = ni; }
        float xr = 0.f, xi = 0.f;
        { float er[16], ei[16];
#pragma unroll
          for (int s2 = 0; s2 < 16; ++s2) { const bool on = s2 < seg; er[s2] = on ? SEG[((size_t)s2 * 1024 + unit) * 128 + p] : 0.f; ei[s2] = on ? SEG[((size_t)s2 * 1024 + unit) * 128 + 64 + p] : 0.f; }
#pragma unroll
          for (int s2 = 0; s2 < 16; ++s2) if (s2 < seg) { const float nr = sr * xr - si * xi + er[s2], ni = sr * xi + si * xr + ei[s2]; xr = nr; xi = ni; } }
        bf16_t* base = AX + (size_t)g * S5_RG * 512 + 256 + d * 128 + p;
        float lr[16], li[16];
#pragma unroll
        for (int q = 0; q < 16; ++q) { const size_t o = (size_t)s5_row(b, d, seg * 16 + q) * 512; lr[q] = bf2f(base[o]); li[q] = bf2f(base[o + 64]); }
#pragma unroll
        for (int q = 0; q < 16; ++q) { const size_t o = (size_t)s5_row(b, d, seg * 16 + q) * 512;
            base[o] = f2bf(lr[q] + xr); base[o + 64] = f2bf(li[q] + xi);
            const float nr = ar * xr - ai * xi, ni = ar * xi + ai * xr; xr = nr; xi = ni; }
    }
}

#ifndef SUBDUP
#define SUBDUP 0
#endif
typedef short bf16x8v __attribute__((ext_vector_type(8)));
typedef short s16x4v __attribute__((ext_vector_type(4)));
typedef __bf16 bfx2_t __attribute__((ext_vector_type(2)));
typedef float f32x2_t __attribute__((ext_vector_type(2)));
#define MFMA16(a_, b_, c_) __builtin_amdgcn_mfma_f32_16x16x32_bf16((a_), (b_), (c_), 0, 0, 0)
DI unsigned pk2(float lo, float hi) { const bfx2_t v = __builtin_convertvector((f32x2_t){lo, hi}, bfx2_t); return __builtin_bit_cast(unsigned, v); }
DI int sw512(int r, int cb) { return r * 512 + (cb ^ ((r & 15) << 4)); }
DI int sw128(int r, int cb) { return r * 128 + (cb ^ ((r & 7) << 4)); }
DI bf16x8v ldsfrag(LAS unsigned char* base, int off) { return *(const LAS bf16x8v*)(base + off); }
DI bf16x8v ldsfrag2(LAS unsigned char* base, int off0, int off1) { const s16x4v lo = *(const LAS s16x4v*)(base + off0), hi = *(const LAS s16x4v*)(base + off1); return __builtin_shufflevector(lo, hi, 0, 1, 2, 3, 4, 5, 6, 7); }
constexpr int ML_GSET = 448;
DI void ml_gates(float igr, float fgr, float ibias, float fbias, int d, float& ms, LAS float* gs, int L) {
    asm volatile("" : "+v"(L));
    const int t = d ? 63 - L : L;
    const float ipv = igr + ibias, lfv = -softplusf_(-(fgr + fbias));
    const float bc = dpp_scan_sum(lfv);
    const float aj = ipv - bc;
    const float cm = dpp_scan_max(aj);
    const float mt = fmaxf(bc + ms, bc + cm);
    const float bend = lane63(bc);
    const float le = bend - bc + ipv;
    const float mle = lane63(dpp_scan_max(le));
    const float mnew = fmaxf(bend + ms, mle);
    gs[t] = bc; gs[64 + t] = aj; gs[128 + t] = mt; gs[192 + t] = __expf(bc + ms - mt); gs[256 + t] = __expf(-mt); gs[320 + t] = __expf(le - mnew) * 0.0625f;
    if (L == 0) gs[384] = __expf(bend + ms - mnew);
    ms = mnew;
}
DI bf16x8v ldstr2(LAS unsigned char* p0, LAS unsigned char* p1) {
    const s16x4v lo = __builtin_amdgcn_ds_read_tr16_b64_v4i16((LAS s16x4v*)p0), hi = __builtin_amdgcn_ds_read_tr16_b64_v4i16((LAS s16x4v*)p1);
    return __builtin_shufflevector(lo, hi, 0, 1, 2, 3, 4, 5, 6, 7); }
DI void ph_ml_scan_mfma(const Args& a, int l, const bf16_t* Q, const bf16_t* K, const bf16_t* V, const float* GATE, bf16_t* HF, bf16_t* HB, LAS unsigned char* lds) {
    constexpr int PQ = 528, PK = 544, PV = 160, PW = 144;
    LAS unsigned char* qs = lds;
    LAS unsigned char* kn = lds + 33792;
    LAS unsigned char* vn = lds + 68608;
    LAS unsigned char* vs = lds + 78848;
    LAS unsigned char* Wm = lds + 89088;
    LAS float* sm = (LAS float*)(lds + 98304);
    LAS float* rsW = sm + 2 * ML_GSET; LAS float* qn = rsW + 128; LAS float* nvec = qn + 64;
    const int tid = ltid(a), w = tid >> 6, ln = tid & 63, l16 = ln & 15, h4 = ln >> 4, tq = (ln & 15) >> 2, tp = ln & 3;
    for (int unit = blockIdx.x; unit < 256; unit += gridDim.x) {
        const int eh = unit & 3, d = (unit >> 2) & 1, hd = (unit >> 3) & 3, b = unit >> 5;
        const float ibias = a.in[I_MIB][(l * 2 + d) * 4 + hd], fbias = a.in[I_MFB][(l * 2 + d) * 4 + hd];
        bf16_t* HO = d ? HB : HF;
        f32x4 Cacc[16];
#pragma unroll
        for (int i = 0; i < 16; ++i) Cacc[i] = (f32x4){0.f, 0.f, 0.f, 0.f};
        float ms = 0.f;
        __syncthreads();
        if (tid < 256) nvec[tid] = 0.f;
#define ML_ROW0(step) (((step) < 4) ? b * 256 + (d ? 3 - (step) : (step)) * 64 : CTXROWS + b * 4096 + (d ? 67 - (step) : (step) - 4) * 64)
        u32x4 pq[4], pk[4], pv[1]; float gi = 0.f, gf = 0.f;
        { const int row0 = ML_ROW0(0);
#pragma unroll
          for (int q = 0; q < 4; ++q) { const int p = tid + 512 * q, r = p >> 5, c8 = p & 31; pq[q] = *(const u32x4*)(Q + (size_t)(row0 + r) * 1024 + hd * 256 + c8 * 8); pk[q] = *(const u32x4*)(K + (size_t)(row0 + r) * 1024 + hd * 256 + c8 * 8); }
#pragma unroll
          for (int q = 0; q < 1; ++q) { const int r = tid >> 3, c8 = tid & 7; pv[q] = *(const u32x4*)(V + (size_t)(row0 + r) * 1024 + hd * 256 + eh * 64 + c8 * 8); }
          if (w == 7) { const int t = d ? 63 - ln : ln; const float* gp = GATE + (size_t)(row0 + t) * 32; gi = gp[d * 4 + hd]; gf = gp[8 + d * 4 + hd]; ml_gates(gi, gf, ibias, fbias, d, ms, sm, ln); } }
        __syncthreads();
        for (int step = 0; step < 68; ++step) {
            const int par = step & 1; LAS float* gs = sm + par * ML_GSET;
            const int row0 = ML_ROW0(step);
            for (int sr_ = 0; sr_ < (SUBDUP == 12 ? 2 : 1); ++sr_) {
#pragma unroll
            for (int q = 0; q < 4; ++q) { const int p = tid + 512 * q, r = p >> 5, c8 = p & 31;
                *(LAS u32x4*)(qs + r * PQ + c8 * 16) = pq[q]; *(LAS u32x4*)(kn + r * PK + c8 * 16) = pk[q]; }
#pragma unroll
            for (int q = 0; q < 1; ++q) { const int r = tid >> 3, c8 = tid & 7;
                *(LAS u32x4*)(vn + r * PV + c8 * 16) = pv[q];
                float f[8]; unpack8(pv[q], f); const float ws = gs[320 + r];
                u32x4 o; o.x = pk2(f[0] * ws, f[1] * ws); o.y = pk2(f[2] * ws, f[3] * ws); o.z = pk2(f[4] * ws, f[5] * ws); o.w = pk2(f[6] * ws, f[7] * ws);
                *(LAS u32x4*)(vs + r * PV + c8 * 16) = o; }
            }
            if (step + 1 < 68) { const int rown = ML_ROW0(step + 1);
#pragma unroll
                for (int q = 0; q < 4; ++q) { const int p = tid + 512 * q, r = p >> 5, c8 = p & 31; pq[q] = *(const u32x4*)(Q + (size_t)(rown + r) * 1024 + hd * 256 + c8 * 8); pk[q] = *(const u32x4*)(K + (size_t)(rown + r) * 1024 + hd * 256 + c8 * 8); }
#pragma unroll
                for (int q = 0; q < 1; ++q) { const int r = tid >> 3, c8 = tid & 7; pv[q] = *(const u32x4*)(V + (size_t)(rown + r) * 1024 + hd * 256 + eh * 64 + c8 * 8); }
                if (w == 7) { const int t = d ? 63 - ln : ln; const float* gp = GATE + (size_t)(rown + t) * 32; gi = gp[d * 4 + hd]; gf = gp[8 + d * 4 + hd]; } }
            lds_barrier();
            for (int sr_ = 0; sr_ < (SUBDUP == 11 ? 2 : 1); ++sr_) { const int it = w >> 1, jp = w & 1, i = it * 16 + l16;
              f32x4 a0 = (f32x4){0.f, 0.f, 0.f, 0.f}, a1 = a0;
              LAS unsigned char* qb = qs + (it * 16 + l16) * PQ + h4 * 16; LAS unsigned char* kb = kn + ((2 * jp) * 16 + l16) * PK + h4 * 16;
#pragma unroll
              for (int ks = 0; ks < 8; ++ks) {
                  const bf16x8v bq = ldsfrag(qb, ks * 64);
                  const bf16x8v k0 = ldsfrag(kb, ks * 64), k1 = ldsfrag(kb, 16 * PK + ks * 64);
                  a0 = MFMA16(k0, bq, a0); a1 = MFMA16(k1, bq, a1); }
              const float bci = gs[i], mti = gs[128 + i];
              float rs = 0.f;
#pragma unroll
              for (int t2 = 0; t2 < 2; ++t2) { const int j0 = (2 * jp + t2) * 16 + 4 * h4; const f32x4 ajv = *(const LAS f32x4*)(gs + 64 + j0); const f32x4 av = t2 ? a1 : a0;
                  float wv[4];
#pragma unroll
                  for (int r = 0; r < 4; ++r) { const int j = j0 + r; const bool valid = d ? (j >= i) : (j <= i); const float e = __expf(bci + ajv[r] - mti) * av[r] * 0.0625f; wv[r] = valid ? e : 0.f; rs += wv[r]; }
                  u32x2 pw; pw.x = pk2(wv[0], wv[1]); pw.y = pk2(wv[2], wv[3]);
                  *(LAS u32x2*)(Wm + i * PW + j0 * 2) = pw; }
              int lnl = ln; asm volatile("" : "+v"(lnl)); rs += shx(rs, 16, lnl); rs += shx(rs, 32, lnl);
              if (h4 == 0) rsW[jp * 64 + i] = rs;
              const f32x4 nv = *(const LAS f32x4*)(nvec + 4 * ln);
#pragma unroll
              for (int rr = 0; rr < 8; ++rr) { const int ir = 8 * w + rr; const u32x2 qw = *(const LAS u32x2*)(qs + ir * PQ + 8 * ln);
                  float s = bflo(qw.x) * nv[0] + bfhi(qw.x) * nv[1] + bflo(qw.y) * nv[2] + bfhi(qw.y) * nv[3];
                  s = lane63(dpp_scan_sum(s)); if (ln == 0) qn[ir] = s; } }
            lds_barrier();
            if (w < 4) { f32x4 num[4];
#pragma unroll
              for (int it = 0; it < 4; ++it) num[it] = (f32x4){0.f, 0.f, 0.f, 0.f};
              LAS unsigned char* qb2 = qs + l16 * PQ + 8 * h4;
              { bf16x8v af[4];
#pragma unroll
                for (int it = 0; it < 4; ++it) af[it] = ldsfrag2(qb2, it * 16 * PQ, it * 16 * PQ + 32);
#pragma unroll
                for (int ks = 0; ks < 8; ++ks) {
                    u32x4 bw; bw.x = pk2(Cacc[2 * ks][0], Cacc[2 * ks][1]); bw.y = pk2(Cacc[2 * ks][2], Cacc[2 * ks][3]); bw.z = pk2(Cacc[2 * ks + 1][0], Cacc[2 * ks + 1][1]); bw.w = pk2(Cacc[2 * ks + 1][2], Cacc[2 * ks + 1][3]);
                    const bf16x8v bfr = __builtin_bit_cast(bf16x8v, bw);
                    bf16x8v nf[4];
#pragma unroll
                    for (int it = 0; it < 4; ++it) nf[it] = (ks + 1 < 8) ? ldsfrag2(qb2, it * 16 * PQ + 64 * (ks + 1), it * 16 * PQ + 64 * (ks + 1) + 32) : af[it];
#pragma unroll
                    for (int it = 0; it < 4; ++it) num[it] = MFMA16(af[it], bfr, num[it]);
#pragma unroll
                    for (int it = 0; it < 4; ++it) af[it] = nf[it];
                    asm volatile("" ::: "memory"); } }
#pragma unroll
              for (int it = 0; it < 4; ++it) { const f32x4 wi = *(const LAS f32x4*)(gs + 192 + it * 16 + 4 * h4); num[it] = num[it] * wi; }
              LAS unsigned char* trb = (LAS unsigned char*)0 + (8 * h4 + tq) * PV + 8 * tp + 32 * w;
              bf16x8v bv[2];
#pragma unroll
              for (int kk = 0; kk < 2; ++kk) bv[kk] = ldstr2(vn + (size_t)trb + (32 * kk) * PV, vn + (size_t)trb + (32 * kk + 4) * PV);
              LAS unsigned char* wb = Wm + l16 * PW + 16 * h4;
#pragma unroll
              for (int kk = 0; kk < 2; ++kk)
#pragma unroll
                  for (int it = 0; it < 4; ++it) { const bf16x8v aw = ldsfrag(wb, it * 16 * PW + 64 * kk); num[it] = MFMA16(aw, bv[kk], num[it]); }
              asm volatile("" ::: "memory");
#pragma unroll
              for (int it = 0; it < 4; ++it) { const int i0 = it * 16 + 4 * h4;
                  const f32x4 r0 = *(const LAS f32x4*)(rsW + i0), r1 = *(const LAS f32x4*)(rsW + 64 + i0), wi = *(const LAS f32x4*)(gs + 192 + i0), qv = *(const LAS f32x4*)(qn + i0), nr = *(const LAS f32x4*)(gs + 256 + i0);
#pragma unroll
                  for (int r = 0; r < 4; ++r) { const float den = r0[r] + r1[r] + wi[r] * qv[r]; const float hv = num[it][r] * __builtin_amdgcn_rcpf(fmaxf(fabsf(den), nr[r]));
                      HO[(size_t)(row0 + i0 + r) * 1024 + hd * 256 + eh * 64 + 16 * w + l16] = (bf16_t)(pk2(hv, 0.f) & 0xffffu); } asm volatile("" ::: "memory"); }
              const float decay = gs[384];
              bf16x8v bs[2];
#pragma unroll
              for (int kk = 0; kk < 2; ++kk) bs[kk] = ldstr2(vs + (size_t)trb + (32 * kk) * PV, vs + (size_t)trb + (32 * kk + 4) * PV);
#pragma unroll
              for (int dt = 0; dt < 16; ++dt) Cacc[dt] = Cacc[dt] * decay;
              LAS unsigned char* ktb = kn + (8 * h4 + tq) * PK + 8 * tp;
              { bf16x8v ak0 = ldstr2(ktb, ktb + 4 * PK), ak1 = ldstr2(ktb + 32 * PK, ktb + 36 * PK);
#pragma unroll
                for (int dt = 0; dt < 16; ++dt) {
                    bf16x8v n0 = ak0, n1 = ak1;
                    if (dt + 1 < 16) { n0 = ldstr2(ktb + 32 * (dt + 1), ktb + 4 * PK + 32 * (dt + 1)); n1 = ldstr2(ktb + 32 * PK + 32 * (dt + 1), ktb + 36 * PK + 32 * (dt + 1)); }
                    Cacc[dt] = MFMA16(ak0, bs[0], Cacc[dt]); Cacc[dt] = MFMA16(ak1, bs[1], Cacc[dt]);
                    ak0 = n0; ak1 = n1; asm volatile("" ::: "memory"); } }
            } else { const float decay = gs[384]; const int dn = tid - 256; float s = 0.f;
#pragma unroll 8
                for (int j = 0; j < 64; ++j) s += gs[320 + j] * bf2f(*(const LAS bf16_t*)(kn + j * PK + 2 * dn));
                nvec[dn] = decay * nvec[dn] + s;
                if (w == 7 && step + 1 < 68) ml_gates(gi, gf, ibias, fbias, d, ms, sm + (par ^ 1) * ML_GSET, ln); }
            lds_barrier();
        }
#undef ML_ROW0
    }
}

#ifndef SUBDUP
#define SUBDUP 0
#endif
#define MFMA16K16(a_, b_, c_) __builtin_amdgcn_mfma_f32_16x16x16bf16_1k((a_), (b_), (c_), 0, 0, 0)
DI s16x4v pack4(const f32x4 v) { u32x2 w; w.x = pk2(v[0], v[1]); w.y = pk2(v[2], v[3]); return __builtin_bit_cast(s16x4v, w); }
DI s16x4v lds8(LAS unsigned char* p) { return *(const LAS s16x4v*)p; }
DI s16x4v ldstr1(LAS unsigned char* p) { return __builtin_amdgcn_ds_read_tr16_b64_v4i16((LAS s16x4v*)p); }
constexpr int GD_GSET = 384;
DI void gdn_gates(float araw, float braw, float nea, float dtb, LAS float* gs, int L, int d) {
    asm volatile("" : "+v"(L));
    const int t = d ? 63 - L : L;
    const float gc = dpp_scan_sum(nea * softplusf_(araw + dtb));
    const float gl = lane63(gc);
    gs[t] = gc; gs[64 + t] = sigmoidf_(braw); gs[128 + t] = __expf(gc); gs[192 + t] = __expf(gl - gc);
    if (L == 0) gs[256] = __expf(gl);
}
DI void ph_gdn_scan_mfma(const Args& a, int l, const bf16_t* Q, const bf16_t* K, const bf16_t* V, const float* GATE, bf16_t* OF, bf16_t* OB, LAS unsigned char* lds) {
    constexpr int PQ = 272, PK = 288, PV = 160, PA = 144, PD = 48;
    LAS unsigned char* qh = lds;
    LAS unsigned char* kh = lds + 17408;
    LAS unsigned char* vv = lds + 35840;
    LAS unsigned char* AM = lds + 54272;
    LAS unsigned char* QM = lds + 63488;
    LAS unsigned char* DINV = lds + 72704;
    LAS float* sm = (LAS float*)(lds + 75776);
    LAS float* nAd = (LAS float*)(lds + 78848);
    const int tid = ltid(a), w = tid >> 6, ln = tid & 63, l16 = ln & 15, h4 = ln >> 4, tq = (ln & 15) >> 2, tp = ln & 3;
    for (int unit = blockIdx.x; unit < 256; unit += gridDim.x) {
        const int eh = unit & 1, d = (unit >> 1) & 1, h = (unit >> 2) & 7, b = unit >> 5;
        const float nea = -__expf(a.in[I_GALOG][(l * 2 + d) * 8 + h]), dtb = a.in[I_GDTB][(l * 2 + d) * 8 + h];
        bf16_t* O = d ? OB : OF;
        f32x4 S[8];
#pragma unroll
        for (int i = 0; i < 8; ++i) S[i] = (f32x4){0.f, 0.f, 0.f, 0.f};
#define GD_ROW0(step) (((step) < 4) ? b * 256 + (d ? 3 - (step) : (step)) * 64 : CTXROWS + b * 4096 + (d ? 67 - (step) : (step) - 4) * 64)
        u32x4 pq[2], pk[2], pv[1]; float ga = 0.f, gb = 0.f;
        __syncthreads();
        { const int row0 = GD_ROW0(0);
#pragma unroll
          for (int q = 0; q < 2; ++q) { const int p = tid + 512 * q, r = p >> 4, c8 = p & 15; const size_t go = (size_t)(row0 + r) * 1024 + h * 128 + c8 * 8;
              pq[q] = *(const u32x4*)(Q + go); pk[q] = *(const u32x4*)(K + go); }
          pv[0] = *(const u32x4*)(V + (size_t)(row0 + (tid >> 3)) * 1024 + h * 128 + eh * 64 + (tid & 7) * 8);
          if (w == 5) { const int t = d ? 63 - ln : ln; const float* gp = GATE + (size_t)(row0 + t) * 32; ga = gp[d * 8 + h]; gb = gp[16 + d * 8 + h]; gdn_gates(ga, gb, nea, dtb, sm, ln, d); } }
        __syncthreads();
        for (int step = 0; step < 68; ++step) {
            const int par = step & 1; LAS float* gs = sm + par * GD_GSET;
            const int row0 = GD_ROW0(step);
#pragma unroll
            for (int q = 0; q < 2; ++q) { const int p = tid + 512 * q, r = p >> 4, c8 = p & 15;
                *(LAS u32x4*)(qh + r * PQ + c8 * 16) = pq[q]; *(LAS u32x4*)(kh + r * PK + c8 * 16) = pk[q]; }
            *(LAS u32x4*)(vv + (tid >> 3) * PV + (tid & 7) * 16) = pv[0];
            if (step + 1 < 68) { const int rown = GD_ROW0(step + 1);
#pragma unroll
                for (int q = 0; q < 2; ++q) { const int p = tid + 512 * q, r = p >> 4, c8 = p & 15; const size_t go = (size_t)(rown + r) * 1024 + h * 128 + c8 * 8;
                    pq[q] = *(const u32x4*)(Q + go); pk[q] = *(const u32x4*)(K + go); }
                pv[0] = *(const u32x4*)(V + (size_t)(rown + (tid >> 3)) * 1024 + h * 128 + eh * 64 + (tid & 7) * 8);
                if (w == 5) { const int t = d ? 63 - ln : ln; const float* gp = GATE + (size_t)(rown + t) * 32; ga = gp[d * 8 + h]; gb = gp[16 + d * 8 + h]; } }
            lds_barrier(); if (SUBDUP == 5) lds_barrier();
            for (int sr_ = 0; sr_ < (SUBDUP == 1 ? 2 : 1); ++sr_) { const int it = w >> 1, jp = w & 1, i = it * 16 + l16;
              f32x4 kk0 = (f32x4){0.f, 0.f, 0.f, 0.f}, kk1 = kk0, qk0 = kk0, qk1 = kk0;
              LAS unsigned char* kb = kh + ((2 * jp) * 16 + l16) * PK + h4 * 16; LAS unsigned char* xk = kh + i * PK + h4 * 16; LAS unsigned char* xq = qh + i * PQ + h4 * 16;
#pragma unroll
              for (int ks = 0; ks < 4; ++ks) { const bf16x8v a0 = ldsfrag(kb, ks * 64), a1 = ldsfrag(kb, 16 * PK + ks * 64), bk = ldsfrag(xk, ks * 64), bq = ldsfrag(xq, ks * 64);
                  kk0 = MFMA16(a0, bk, kk0); kk1 = MFMA16(a1, bk, kk1); qk0 = MFMA16(a0, bq, qk0); qk1 = MFMA16(a1, bq, qk1); }
              const float gci = gs[i], bi = gs[64 + i];
#pragma unroll
              for (int t2 = 0; t2 < 2; ++t2) { const int j0 = (2 * jp + t2) * 16 + 4 * h4; const f32x4 gcj = *(const LAS f32x4*)(gs + j0); const f32x4 kkv = t2 ? kk1 : kk0, qkv = t2 ? qk1 : qk0;
                  float am[4], qm[4];
#pragma unroll
                  for (int r = 0; r < 4; ++r) { const int j = j0 + r; const bool valid = d ? (j >= i) : (j <= i); const float e = __expf(gci - gcj[r]);
                      am[r] = (valid && j != i) ? -bi * kkv[r] * e : 0.f; qm[r] = valid ? qkv[r] * e : 0.f; }
                  u32x2 pa, pm; pa.x = pk2(am[0], am[1]); pa.y = pk2(am[2], am[3]); pm.x = pk2(qm[0], qm[1]); pm.y = pk2(qm[2], qm[3]);
                  *(LAS u32x2*)(AM + i * PA + j0 * 2) = pa; *(LAS u32x2*)(QM + i * PA + j0 * 2) = pm;
                  if (2 * jp + t2 == it) { const int ipos = d ? 15 - l16 : l16;
#pragma unroll
                      for (int r = 0; r < 4; ++r) { const int jpos = d ? 15 - (4 * h4 + r) : 4 * h4 + r; nAd[(it * 16 + ipos) * 16 + jpos] = am[r]; } } } }
            lds_barrier(); if (SUBDUP == 5) lds_barrier();
            for (int sr_ = 0; sr_ < (SUBDUP == 2 ? 2 : 1); ++sr_) if (w == 4) { const int I = ln >> 4, c = ln & 15, cp = d ? 15 - c : c;
                float Dr[16];
                Dr[0] = (cp == 0) ? 1.f : 0.f;
#pragma unroll
                for (int ip = 1; ip < 16; ++ip) {
                    float av[16];
#pragma unroll
                    for (int q4 = 0; q4 < 4; ++q4) { if (q4 * 4 < ip) { const f32x4 x = *(const LAS f32x4*)(nAd + (I * 16 + ip) * 16 + q4 * 4); av[q4 * 4] = x[0]; av[q4 * 4 + 1] = x[1]; av[q4 * 4 + 2] = x[2]; av[q4 * 4 + 3] = x[3]; } }
                    float s = (cp == ip) ? 1.f : 0.f;
#pragma unroll
                    for (int jq = 0; jq < ip; ++jq) s += av[jq] * Dr[jq];
                    Dr[ip] = s; }
#pragma unroll
                for (int ip = 0; ip < 16; ++ip) { const int r = d ? 15 - ip : ip; *(LAS bf16_t*)(DINV + (16 * I + r) * PD + 2 * c) = (bf16_t)(pk2(Dr[ip], 0.f) & 0xffffu); } }
            s16x4v sf[8];
            f32x4 Rt[4], Qs[4];
            if (w < 4) {
#pragma unroll
            for (int dt = 0; dt < 8; ++dt) sf[dt] = pack4(S[dt]);
#pragma unroll
            for (int Tp = 0; Tp < 4; ++Tp) { const int ro = 16 * (d ? 3 - Tp : Tp);
                f32x4 ksv = (f32x4){0.f, 0.f, 0.f, 0.f}, qsv = ksv;
                LAS unsigned char* ka = kh + (ro + l16) * PK + 8 * h4; LAS unsigned char* qa = qh + (ro + l16) * PQ + 8 * h4;
#pragma unroll
                for (int dt = 0; dt < 8; ++dt) { ksv = MFMA16K16(lds8(ka + 32 * dt), sf[dt], ksv); qsv = MFMA16K16(lds8(qa + 32 * dt), sf[dt], qsv); }
                const s16x4v v4 = ldstr1(vv + (ro + 4 * h4 + tq) * PV + (16 * w + 4 * tp) * 2);
                const f32x4 be = *(const LAS f32x4*)(gs + 64 + ro + 4 * h4), eg = *(const LAS f32x4*)(gs + 128 + ro + 4 * h4);
#pragma unroll
                for (int r = 0; r < 4; ++r) { Rt[Tp][r] = be[r] * (bf2f((bf16_t)v4[r]) - eg[r] * ksv[r]); Qs[Tp][r] = eg[r] * qsv[r]; }
                asm volatile("" ::: "memory"); } }
            lds_barrier(); if (SUBDUP == 5) lds_barrier();
            if (w < 4) { s16x4v vf[4]; f32x4 vn[4];
#pragma unroll
              for (int Tp = 0; Tp < 4; ++Tp) { const int ro = 16 * (d ? 3 - Tp : Tp);
                  f32x4 X = Rt[Tp];
#pragma unroll
                  for (int Jp = 0; Jp < Tp; ++Jp) { const int co = 16 * (d ? 3 - Jp : Jp); X = MFMA16K16(lds8(AM + (ro + l16) * PA + (co + 4 * h4) * 2), vf[Jp], X); }
                  const s16x4v xf = pack4(X);
                  vn[Tp] = MFMA16K16(lds8(DINV + (ro + l16) * PD + 8 * h4), xf, ((f32x4){0.f, 0.f, 0.f, 0.f}));
                  vf[Tp] = pack4(vn[Tp]); }
#pragma unroll
              for (int Tp = 0; Tp < 4; ++Tp) { const int ro = 16 * (d ? 3 - Tp : Tp);
                  f32x4 o = Qs[Tp];
#pragma unroll
                  for (int Jp = 0; Jp <= Tp; ++Jp) { const int co = 16 * (d ? 3 - Jp : Jp); o = MFMA16K16(lds8(QM + (ro + l16) * PA + (co + 4 * h4) * 2), vf[Jp], o); }
#pragma unroll
                  for (int r = 0; r < 4; ++r) O[(size_t)(row0 + ro + 4 * h4 + r) * 1024 + h * 128 + eh * 64 + 16 * w + l16] = (bf16_t)(pk2(o[r], 0.f) & 0xffffu);
                  asm volatile("" ::: "memory"); }
              const float gend = gs[256];
              s16x4v vsf[4];
#pragma unroll
              for (int Jp = 0; Jp < 4; ++Jp) { const int co = 16 * (d ? 3 - Jp : Jp); const f32x4 ee = *(const LAS f32x4*)(gs + 192 + co + 4 * h4); vsf[Jp] = pack4(vn[Jp] * ee); }
#pragma unroll
              for (int dt = 0; dt < 8; ++dt) { S[dt] = S[dt] * gend;
#pragma unroll
                  for (int Jp = 0; Jp < 4; ++Jp) { const int co = 16 * (d ? 3 - Jp : Jp); S[dt] = MFMA16K16(ldstr1(kh + (co + 4 * h4 + tq) * PK + (16 * dt + 4 * tp) * 2), vsf[Jp], S[dt]); }
                  if (dt & 1) asm volatile("" ::: "memory"); } }
            for (int sr_ = 0; sr_ < (SUBDUP == 3 ? 2 : 1); ++sr_) if (w == 5 && step + 1 < 68) gdn_gates(ga, gb, nea, dtb, sm + (par ^ 1) * GD_GSET, ln, d);
            lds_barrier(); if (SUBDUP == 5) lds_barrier();
        }
#undef GD_ROW0
    }
}

#ifndef DUP_PHASE
#define DUP_PHASE -1
#endif
constexpr int NPH_LAYER = 21, PH_FINAL = 2 + DEPTH * NPH_LAYER, NPHASE = PH_FINAL + 1;
template <class Epi>
DI void run_gemm(int tid, LAS unsigned char* lds, const bf16_t* A, const bf16_t* Bt, int M, int N, const Epi& E) {
    pg8::Gemm g{A, Bt, M, N, 1024, 1024, 1 << 20, 0, tid}; pg8::StaticOrder S; S.init(M, N, (int)gridDim.x, (int)blockIdx.x);
#if defined(GEMM_STAGGER)
    if (blockIdx.x & 8) { const unsigned long long t0 = __builtin_amdgcn_s_memrealtime(); while (__builtin_amdgcn_s_memrealtime() - t0 < GEMM_STAGGER) __builtin_amdgcn_s_sleep(8); }
#endif
    pg8::gemm_phase<Epi, pg8::StaticOrder, false>(lds, g, S, E, nullptr);
}
template <class Epi>
DI void run_gemm_g(int tid, LAS unsigned char* lds, const bf16_t* A, int lda, int K, const bf16_t* Bt, int M, int N, int pmg, size_t gstride, const Epi& E) {
    pg8::Gemm g{A, Bt, M, N, K, lda, pmg, gstride, tid}; pg8::StaticOrder S; S.init(M, N, (int)gridDim.x, (int)blockIdx.x);
    pg8::gemm_phase<Epi, pg8::StaticOrder, false>(lds, g, S, E, nullptr);
}
__global__ void __launch_bounds__(NT, 2) hy_fwd(Args ka) {
    extern __shared__ __attribute__((aligned(16))) unsigned char lds_raw[];
    LAS unsigned char* lds = (LAS unsigned char*)lds_raw;
    volatile LAS unsigned* xbw = (volatile LAS unsigned*)(lds + 131072);
    if (threadIdx.x < 4) xbw[threadIdx.x] = 0u;
    __syncthreads();
    const int lo = ka.ph_lo, hi = ka.ph_hi;
    const int s_wid = __builtin_amdgcn_readfirstlane((int)(threadIdx.x >> 6));
    XcdBarrier bar; bar.bar = (unsigned*)(ka.ws + WS_CTL); bar.x = 0u; bar.st = xbw; bar.wid = s_wid;
    if (hi - lo > 1) bar = xcd_barrier_post((unsigned*)(ka.ws + WS_CTL), xbw, s_wid);
#ifdef PH_ONLY
#define PHEN(p) ((p) == PH_ONLY)
#else
#define PHEN(p) 1
#endif
#define IN(k) (lo <= (k) && (k) < hi)
#define INL(p) (PHEN(p) && IN(pb + (p)))
#define REPS(p) ((DUP_PHASE == (p)) ? 2 : 1)
#define SEAM(k) do { if (IN((k) + 1)) { xcd_barrier(bar); if (DUP_PHASE == 200) xcd_barrier(bar); } } while (0)
#define PH_LOAD \
    Args a; __builtin_memcpy(&a, args_ptr(), sizeof(Args)); a.wid = s_wid; \
    unsigned char* ws = a.ws; \
    float* MOD = (float*)(ws + WS_MOD); float* XCTX = (float*)(ws + WS_XCTX); \
    bf16_t* H = (bf16_t*)(ws + WS_H); bf16_t* MERGED = (bf16_t*)(ws + WS_MERGED); \
    bf16_t* WB0 = (bf16_t*)(ws + WS_WB0); bf16_t* WB1 = (bf16_t*)(ws + WS_WB1); \
    unsigned char* R = ws + WS_R; \
    bf16_t* P0 = (bf16_t*)(R + R_P0); bf16_t* P1 = (bf16_t*)(R + R_P1); bf16_t* P2 = (bf16_t*)(R + R_P2); bf16_t* OF = (bf16_t*)(R + R_OF); bf16_t* OB = (bf16_t*)(R + R_OB); \
    float* GATE2 = (float*)(R + R_G2); \
    float* GATE1 = (float*)(ws + WS_MERGED); bf16_t* HALO = (bf16_t*)(ws + WS_MERGED + SZ_GATE);     \
    float* MODP = (float*)R; \
    bf16_t* AX = (bf16_t*)(R + R5_AX); bf16_t* SZ5 = (bf16_t*)(R + R5_SZ); bf16_t* G15 = (bf16_t*)(R + R5_G1); bf16_t* GLUA = (bf16_t*)(R + R5_GLUA); bf16_t* YBR = (bf16_t*)R; \
    bf16_t* CW1 = (bf16_t*)(ws + WS_H); bf16_t* CW2 = (bf16_t*)(ws + WS_H + SZ_CW1); float* SEG5 = (float*)(ws + WS_H + SZ_CW1 + SZ_CW2); \
    const float* xlat_src = l == 0 ? a.in[I_X] : a.out; const float* xctx_src = l == 0 ? a.in[I_CTX] : XCTX; const float* modl = MOD + (size_t)l * 9 * 3072; \
    (void)MOD; (void)XCTX; (void)H; (void)MERGED; (void)WB0; (void)WB1; (void)P0; (void)P1; (void)P2; (void)OF; (void)OB; (void)GATE2; (void)GATE1; (void)HALO; (void)MODP; (void)AX; (void)SZ5; (void)G15; (void)GLUA; (void)YBR; (void)CW1; (void)CW2; (void)SEG5; (void)xlat_src; (void)xctx_src; (void)modl;
    LAS float* ldsf = (LAS float*)lds;

    { const int l = 0;
    if (PHEN(100) && IN(0)) { PH_LOAD; ph_modp(a, MODP, ldsf); SEAM(0); }
    if (PHEN(101) && IN(1)) { PH_LOAD; ph_mod(a, MODP, MOD); SEAM(1); } }
    for (int l = 0; l < DEPTH; ++l) {
        const int pb = 2 + l * NPH_LAYER;
        if (INL(0)) { PH_LOAD; for (int rep_ = 0; rep_ < REPS(0); ++rep_) { ph_norm(a, l, xlat_src, xctx_src, modl, H); ph_cvt(wdesc(a, l, 0), WB0, ldsf); } SEAM(pb + 0); }
        if (INL(1)) { PH_LOAD; for (int rep_ = 0; rep_ < REPS(1); ++rep_) { EpiProj E{P0, 0, GATE1, 12, HALO}; run_gemm(ltid(a), lds, H, WB0, MROWS, 3328, E); } SEAM(pb + 1); }
        if (INL(2)) { PH_LOAD; for (int rep_ = 0; rep_ < REPS(2); ++rep_) { if (DUP_PHASE == 102) ph_gdn_conv(a, l, P0, HALO, lds, OF); ph_gdn_conv(a, l, P0, HALO, lds); ph_cvt(wdesc(a, l, 1), WB1, ldsf); } SEAM(pb + 2); }
        if (INL(3)) { PH_LOAD; for (int rep_ = 0; rep_ < REPS(3); ++rep_) { ph_gdn_scan_mfma(a, l, P0, P1, P2, GATE1, OF, OB, lds); } SEAM(pb + 3); }
        if (INL(4)) { PH_LOAD; for (int rep_ = 0; rep_ < REPS(4); ++rep_) { EpiProj E{P0, 9, nullptr, -1, nullptr}; run_gemm(ltid(a), lds, H, WB1, MROWS, 2048, E); } SEAM(pb + 4); }
        if (INL(5)) { PH_LOAD; for (int rep_ = 0; rep_ < REPS(5); ++rep_) { if (DUP_PHASE == 105) ph_gdn_post(a, l, OF, OB, P0, P2); ph_gdn_post(a, l, OF, OB, P0); ph_cvt(wdesc(a, l, 6), WB0, ldsf); } SEAM(pb + 5); }
        if (INL(6)) { PH_LOAD; for (int rep_ = 0; rep_ < REPS(6); ++rep_) { ph_cvt(wdesc(a, l, 2), WB1, ldsf); EpiBranch E{P1, MERGED, 1}; run_gemm(ltid(a), lds, OF, WB0, MROWS, 1024, E); } SEAM(pb + 6); }
        if (INL(7)) { PH_LOAD; for (int rep_ = 0; rep_ < REPS(7); ++rep_) { ph_cvt(wdesc(a, l, 3), WB0, ldsf); EpiProj E{P0, 0, GATE2, 12, nullptr}; run_gemm(ltid(a), lds, H, WB1, MROWS, 3328, E); } SEAM(pb + 7); }
        if (INL(8)) { PH_LOAD; for (int rep_ = 0; rep_ < REPS(8); ++rep_) { ph_ml_scan_mfma(a, l, P0, P1, P2, GATE2, OF, OB, lds); } SEAM(pb + 8); }
        if (INL(9)) { PH_LOAD; for (int rep_ = 0; rep_ < REPS(9); ++rep_) { ph_cvt(wdesc(a, l, 8), WB1, ldsf); EpiProj E{P0, 38, nullptr, -1, nullptr}; run_gemm(ltid(a), lds, H, WB0, MROWS, 3072, E); } SEAM(pb + 9); }
        if (INL(10)) { PH_LOAD; for (int rep_ = 0; rep_ < REPS(10); ++rep_) { ph_ml_post(a, l, OF, OB, P0, P1); } SEAM(pb + 10); }
        if (INL(11)) { PH_LOAD; for (int rep_ = 0; rep_ < REPS(11); ++rep_) { ph_cvt(wdesc(a, l, 4), WB0, ldsf); EpiBranch E{P2, MERGED, 0}; run_gemm(ltid(a), lds, OF, WB1, MROWS, 1024, E); } SEAM(pb + 11); }
        if (INL(12)) { PH_LOAD; for (int rep_ = 0; rep_ < REPS(12); ++rep_) { ph_cvt(wdesc(a, l, 5), WB1, ldsf); EpiS1 E{AX, SZ5, G15}; run_gemm(ltid(a), lds, H, WB0, MROWS, 3072, E); } SEAM(pb + 12); }
        if (INL(13)) { PH_LOAD; for (int rep_ = 0; rep_ < REPS(13); ++rep_) { ph_s5_consts(a, l, CW1, CW2, lds); ph_cvt(wdesc(a, l, 7), WB0, ldsf); } SEAM(pb + 13); }
        if (INL(14)) { PH_LOAD; for (int rep_ = 0; rep_ < REPS(14); ++rep_) { EpiS5L E{AX}; run_gemm_g(ltid(a), lds, AX, 512, 256, CW1, 64 * S5_RG, 256, S5_PMG, (size_t)256 * 256 * 2, E); } SEAM(pb + 14); }
        if (INL(15)) { PH_LOAD; for (int rep_ = 0; rep_ < REPS(15); ++rep_) { ph_s5_carry1(a, l, AX, SEG5); } SEAM(pb + 15); }
        if (INL(16)) { PH_LOAD; ph_s5_carry2(a, l, AX, SEG5); SEAM(pb + 16); }
        if (INL(17)) { PH_LOAD; for (int rep_ = 0; rep_ < REPS(17); ++rep_) { EpiS5Y E{AX, GLUA, a.in[I_SD] + l * 1024}; run_gemm_g(ltid(a), lds, AX, 512, 512, CW2, 64 * S5_RG, 256, S5_PMG, (size_t)256 * 512 * 2, E); } SEAM(pb + 17); }
        if (INL(18)) { PH_LOAD; for (int rep_ = 0; rep_ < REPS(18); ++rep_) { EpiGlu E{SZ5, YBR, a.in[I_SBGLU] + l * 2048}; run_gemm(ltid(a), lds, GLUA, WB1, MROWS, 2048, E); } SEAM(pb + 18); }
        if (INL(19)) { PH_LOAD; for (int rep_ = 0; rep_ < REPS(19); ++rep_) { ph_cvt(wdesc(a, l, 9), WB1, ldsf); EpiBranch E{G15, MERGED, 0}; run_gemm(ltid(a), lds, YBR, WB0, MROWS, 1024, E); } SEAM(pb + 19); }
        if (INL(20)) { PH_LOAD; for (int rep_ = 0; rep_ < REPS(20); ++rep_) {
            const int ro = (l == DEPTH - 1) ? CTXROWS : 0;
            EpiOut E{xlat_src, a.out, xctx_src, XCTX, modl, l, ro};
            run_gemm(ltid(a), lds, MERGED + (size_t)ro * 1024, WB1, MROWS - ro, 1024, E);
            } SEAM(pb + 20);
        }
    }
    if (PHEN(102) && IN(PH_FINAL)) { const int l = 0; PH_LOAD; ph_final(a, a.out); }
#undef IN
#undef SEAM
#undef PH_LOAD
}
}

#ifndef MK_LAUNCHES
#define MK_LAUNCHES 1
#endif
extern "C" void kernel_launch(void* const* d_in, const int* in_sizes, int n_in, void* d_out, int out_size, void* d_ws, size_t ws_size, hipStream_t stream) {
    static int grid = 0;
    if (grid == 0) {
        if (n_in != 28 || out_size != hy::NBATCH * hy::SEQ * hy::D || ws_size < hy::WS_END) { fprintf(stderr, "kernel_launch: unexpected shapes (n_in %d, out %d, ws %zu < %zu)\n", n_in, out_size, ws_size, (size_t)hy::WS_END); grid = -1; return; }
        int dev = 0, cus = 0, per_cu = 0;
        if (hipGetDevice(&dev) != hipSuccess || hipDeviceGetAttribute(&cus, hipDeviceAttributeMultiprocessorCount, dev) != hipSuccess) { grid = -1; return; }
        if (hipFuncSetAttribute((const void*)hy::hy_fwd, hipFuncAttributeMaxDynamicSharedMemorySize, hy::LDS_BYTES) != hipSuccess) { fprintf(stderr, "kernel_launch: hipFuncSetAttribute failed\n"); grid = -1; return; }
        if (hipOccupancyMaxActiveBlocksPerMultiprocessor(&per_cu, (const void*)hy::hy_fwd, hy::NT, hy::LDS_BYTES) != hipSuccess || per_cu < 1) { fprintf(stderr, "kernel_launch: occupancy query says %d\n", per_cu); (void)hipGetLastError(); }
        grid = cus;
    }
    if (grid < 0) return;
    (void)hipMemsetAsync((char*)d_ws + hy::WS_CTL, 0, 65536, stream);
    hy::Args a{};
    for (int i = 0; i < 28; ++i) a.in[i] = (const float*)d_in[i];
    a.out = (float*)d_out; a.ws = (unsigned char*)d_ws;
#if MK_LAUNCHES == 1
    a.ph_lo = 0; a.ph_hi = hy::NPHASE;
    hipLaunchKernelGGL(hy::hy_fwd, dim3(grid), dim3(hy::NT), hy::LDS_BYTES, stream, a);
#else
    for (int p = 0; p < hy::NPHASE; ++p) { a.ph_lo = p; a.ph_hi = p + 1; hipLaunchKernelGGL(hy::hy_fwd, dim3(grid), dim3(hy::NT), hy::LDS_BYTES, stream, a); }
#endif
}
```

```cpp
#include <hip/hip_runtime.h>
#include <cstdio>
#include <cstdint>
#define MK_LAUNCHES 1


#define XB_TMO      128
#define XB_XCNT(j)  (256  + 64 * (j))
#define XB_XSUB(j)  (1280 + 64 * (j))
#define XB_XGEN(j)  (2304 + 64 * (j))
#define XB_TOP      3328
#define XB_TOPGEN   3392
#define XCD_BAR_WORDS 3456
#define XB_SPIN_CAP (1u << 18)
#define LAS __attribute__((address_space(3)))

__device__ __forceinline__ unsigned xb_ld(unsigned* p)              { return __hip_atomic_load(p, __ATOMIC_RELAXED, __HIP_MEMORY_SCOPE_AGENT); }
__device__ __forceinline__ unsigned xb_add(unsigned* p, unsigned v) { return __hip_atomic_fetch_add(p, v, __ATOMIC_RELAXED, __HIP_MEMORY_SCOPE_AGENT); }
__device__ __forceinline__ unsigned xb_xcc_id() { return (unsigned)__builtin_amdgcn_s_getreg((3 << 11) | 20) & 0xFu; }
#define XB_SPIN(cond, bar) do { unsigned _sp = 0; while (cond) { __builtin_amdgcn_s_sleep(1); \
    if ((++_sp & 255u) == 0u) { if (xb_ld(&(bar)[XB_TMO])) break; if (_sp > XB_SPIN_CAP) { atomicAdd(&(bar)[XB_TMO], 1u); break; } } } } while (0)

struct XcdBarrier {
    unsigned* bar; unsigned x;
    int wid;
    volatile LAS unsigned* st;
};

__device__ __forceinline__ bool xb_lead(int wid) { int l; asm volatile("v_mbcnt_lo_u32_b32 %0, -1, 0\n\tv_mbcnt_hi_u32_b32 %0, -1, %0" : "=v"(l)); return wid == 0 && l == 0; }
__device__ __forceinline__ XcdBarrier xcd_barrier_post(unsigned* bar, volatile LAS unsigned* st, int wid) {
    XcdBarrier b; b.bar = bar; b.x = xb_xcc_id(); b.st = st; b.wid = wid;
    if (xb_lead(wid)) (void)xb_add(&bar[XB_XCNT(b.x)], 1u);
    return b;
}
__device__ __forceinline__ void xcd_barrier_complete(unsigned* bar, unsigned x, unsigned& nloc, unsigned& nx) {
    const unsigned G = gridDim.x * gridDim.y * gridDim.z;
    unsigned sum, cnt, mine, sp = 0u;
    for (;;) {
        sum = 0u; cnt = 0u; mine = 0u;
#pragma unroll
        for (unsigned j = 0; j < 16; ++j) { const unsigned c = xb_ld(&bar[XB_XCNT(j)]); sum += c; cnt += (c > 0u) ? 1u : 0u; mine = (j == x) ? c : mine; }
        if (sum == G) break;
        __builtin_amdgcn_s_sleep(1);
        if ((++sp & 255u) == 0u) { if (xb_ld(&bar[XB_TMO])) break; if (sp > XB_SPIN_CAP) { atomicAdd(&bar[XB_TMO], 1u); break; } }
    }
    nloc = mine > 0u ? mine : 1u; nx = cnt > 0u ? cnt : 1u;
}

__device__ __forceinline__ void xcd_barrier(const XcdBarrier& b) {
    asm volatile("s_waitcnt vmcnt(0)" ::: "memory");
    __syncthreads();
    if (xb_lead(b.wid)) {
        unsigned* bar = b.bar;
        __builtin_amdgcn_s_waitcnt(0);
        unsigned nloc = b.st[0], nx = b.st[1];
        if (nloc == 0u) { xcd_barrier_complete(bar, b.x, nloc, nx); b.st[0] = nloc; b.st[1] = nx; }
        const unsigned old = xb_add(&bar[XB_XSUB(b.x)], 1u);
        const unsigned gen = old / nloc;
        if (old + 1u == (gen + 1u) * nloc) {
            __builtin_amdgcn_fence(__ATOMIC_RELEASE, "agent");
            asm volatile("s_waitcnt vmcnt(0)" ::: "memory");
            const unsigned og = xb_add(&bar[XB_TOP], 1u);
            const unsigned tg = og / nx;
            if (og + 1u == (tg + 1u) * nx) xb_add(&bar[XB_TOPGEN], 1u);
            else XB_SPIN(xb_ld(&bar[XB_TOPGEN]) == tg, bar);
            __builtin_amdgcn_fence(__ATOMIC_ACQUIRE, "agent");
            xb_add(&bar[XB_XGEN(b.x)], 1u);
            asm volatile("s_waitcnt vmcnt(0)" ::: "memory");
        } else {
            XB_SPIN(xb_ld(&bar[XB_XGEN(b.x)]) == gen, bar);
            __builtin_amdgcn_fence(__ATOMIC_ACQUIRE, "agent");
            asm volatile("s_waitcnt vmcnt(0)" ::: "memory");
        }
    }
    __syncthreads();
}


namespace pg8 {
#define PG8_LAS __attribute__((address_space(3)))
typedef unsigned short bf16_t;
typedef short bf16x8 __attribute__((ext_vector_type(8)));
typedef float f32x4 __attribute__((ext_vector_type(4)));
typedef unsigned u32x4 __attribute__((ext_vector_type(4)));
constexpr int BM = 256, BK = 64, HALF = 128, HTB = HALF * BK * 2  , STAGE_BYTES = 8 * HTB, NXCD = 8, WGM = 8;

__host__ __device__ __forceinline__ int lds_byte(int r, int c) { const int st = (r >> 4) * 2 + (c >> 5), rr = r & 15, cc = c & 31, ob = rr * 64 + cc * 2; return st * 1024 + (ob ^ (((ob >> 9) & 1) << 5)); }
__host__ __device__ __forceinline__ void stage_rc(int b, int& R, int& C) { const int st = b / 1024, sb = b % 1024, swz = sb ^ (((sb >> 9) & 1) << 5); R = (st >> 1) * 16 + swz / 64; C = (st & 1) * 32 + (swz % 64) / 2; }
__host__ __device__ __forceinline__ int perm32(int rho) { const int n = rho >> 4, i = rho & 15; return 8 * (i >> 2) + 4 * n + (i & 3); }

struct Unit { int pm, pn; };
struct Gemm { const bf16_t* A; const bf16_t* Bt; int M, N, K, lda, pmg; size_t gstride; int tid; };

struct StaticOrder {
    int nM, nN, nwg, G, c;
    __host__ __device__ void init(int M, int N, int G_, int c_) { nM = M / BM; nN = N / BM; nwg = nM * nN; G = G_; c = c_; }
    __host__ __device__ bool next(int i, Unit& u) const {
        const long L = (long)i * G + c; if (L >= nwg) return false;
        int wgid = (int)L; { const int q = nwg / NXCD, r = nwg % NXCD, xcd = wgid % NXCD, off = wgid / NXCD; wgid = (xcd < r ? xcd * (q + 1) : r * (q + 1) + (xcd - r) * q) + off; }
        const int nig = WGM * nN, gid = wgid / nig, fm = gid * WGM, gsz = (nM - fm) < WGM ? (nM - fm) : WGM;
        u.pm = fm + ((wgid % nig) % gsz); u.pn = (wgid % nig) / gsz; return true;
    }
    __device__ __forceinline__ void a_ready(const Unit&) const {}
    __device__ __forceinline__ void done(const Unit&) const {}
};
__device__ __forceinline__ unsigned cvt_pk_bf16(float lo, float hi) { unsigned r; asm volatile("v_cvt_pk_bf16_f32 %0, %1, %2" : "=v"(r) : "v"(lo), "v"(hi)); return r; }
typedef float f32x2 __attribute__((ext_vector_type(2)));
template <class Epi, class Sched, bool STAMP = false>
__device__ __forceinline__ void gemm_phase(PG8_LAS unsigned char* lds, const Gemm g, const Sched& S, const Epi& E, unsigned long long* stamps) {
    const int tid = g.tid, wid = __builtin_amdgcn_readfirstlane(tid >> 6), lane = tid & 63, wr = wid >> 2, wc = wid & 3, fr = lane & 15, fq = lane >> 4;
    const int K = g.K, nt = K / BK;
    int ts_lo = 0, ts_hi = 0, nts = 0; const unsigned long long rt_entry = STAMP ? (unsigned long long)wall_clock64() : 0ull;
#define PG8_STAMP() do { if (STAMP && wid == 0 && nts < 64) { const unsigned long long _c = (unsigned long long)clock64(); \
        ts_lo = (lane == nts) ? (int)(unsigned)_c : ts_lo; ts_hi = (lane == nts) ? (int)(unsigned)(_c >> 32) : ts_hi; ++nts; } } while (0)
    PG8_STAMP();
    unsigned voffA[2], voffB[2];
#pragma unroll
    for (int i = 0; i < 2; ++i) { int R, C; stage_rc(tid * 16 + i * 8192, R, C); const int Rb = Epi::PERM ? ((R & ~31) + perm32(R & 31)) : R;
        voffA[i] = (unsigned)(R * g.lda + C) * 2u; voffB[i] = (unsigned)(Rb * K + C) * 2u; }
    const size_t kstep = (size_t)(BK * 2);
    const size_t hstepA = (size_t)HALF * g.lda * 2, hstepB = (size_t)HALF * K * 2;
    const size_t tstepA = 2 * hstepA, tstepB = 2 * hstepB;
    const unsigned ldsw = (unsigned)wid * 1024u;
    const int aoff = lds_byte(wr * 64 + fr, fq * 8), boff = lds_byte(wc * 32 + fr, fq * 8);
#define PG8_SA(b, h) (((b) * 2 + (h)) * HTB)
#define PG8_SB(b, h) ((4 + (b) * 2 + (h)) * HTB)
#define PG8_STAGE(bufoff, gbase, voff) do { _Pragma("unroll") for (int _i = 0; _i < 2; ++_i) \
        __builtin_amdgcn_global_load_lds((const unsigned*)((const char*)(gbase) + (voff)[_i]), (PG8_LAS unsigned*)(lds + (bufoff) + ldsw + _i * 8192), 16, 0, 0); } while (0)
#define PG8_LDA(dst, b, h) do { _Pragma("unroll") for (int m = 0; m < 4; ++m) _Pragma("unroll") for (int k = 0; k < 2; ++k) dst[m][k] = *(const PG8_LAS bf16x8*)(lds + PG8_SA(b, h) + aoff + m * 2048 + k * 1024); } while (0)
#define PG8_LDB(dst, b, h) do { _Pragma("unroll") for (int n = 0; n < 2; ++n) _Pragma("unroll") for (int k = 0; k < 2; ++k) dst[n][k] = *(const PG8_LAS bf16x8*)(lds + PG8_SB(b, h) + boff + n * 2048 + k * 1024); } while (0)
#define PG8_MMA(ai, bj, At, Bt) do { __builtin_amdgcn_s_setprio(1); _Pragma("unroll") for (int m = 0; m < 4; ++m) _Pragma("unroll") for (int n = 0; n < 2; ++n) _Pragma("unroll") for (int k = 0; k < 2; ++k) \
        acc[ai][bj][m][n] = __builtin_amdgcn_mfma_f32_16x16x32_bf16(Bt[n][k], At[m][k], acc[ai][bj][m][n], 0, 0, 0); __builtin_amdgcn_s_setprio(0); } while (0)
#define PG8_WAIT_V(n) asm volatile("s_waitcnt vmcnt(" #n ")" ::: "memory")
#define PG8_WAIT_L(n) asm volatile("s_waitcnt lgkmcnt(" #n ")" ::: "memory")
#define PG8_BAR __builtin_amdgcn_s_barrier()
#define PG8_SCHED __builtin_amdgcn_sched_barrier(0)
    Unit cur, nxt; int ui = 0;
    if (!S.next(0, cur)) return;
    f32x4 acc[2][2][4][2];
#pragma unroll
    for (int a = 0; a < 2; ++a)
#pragma unroll
        for (int b = 0; b < 2; ++b)
#pragma unroll
            for (int m = 0; m < 4; ++m)
#pragma unroll
                for (int n = 0; n < 2; ++n) acc[a][b][m][n] = (f32x4){0.f, 0.f, 0.f, 0.f};
    bf16x8 At[4][2], B0[2][2], B1[2][2];
    const char* cA = (const char*)g.A + (size_t)cur.pm * tstepA; const char* cB = (const char*)g.Bt + (size_t)(cur.pm / g.pmg) * g.gstride + (size_t)cur.pn * tstepB;
    S.a_ready(cur);
    PG8_STAGE(PG8_SB(0, 0), cB, voffB); PG8_STAGE(PG8_SA(0, 0), cA, voffA); PG8_STAGE(PG8_SB(0, 1), cB + hstepB, voffB); PG8_STAGE(PG8_SA(0, 1), cA + hstepA, voffA);
    if (wr == 1) PG8_BAR;
    PG8_WAIT_V(4); PG8_BAR;
    PG8_STAGE(PG8_SB(1, 0), cB + kstep, voffB); PG8_STAGE(PG8_SA(1, 0), cA + kstep, voffA); PG8_STAGE(PG8_SB(1, 1), cB + hstepB + kstep, voffB);
    PG8_WAIT_V(6); PG8_BAR;
    PG8_STAMP();
    for (;;) {
        const bool has_next = S.next(ui + 1, nxt);
        const char* nA = has_next ? (const char*)g.A + (size_t)nxt.pm * tstepA : cA; const char* nB = has_next ? (const char*)g.Bt + (size_t)(nxt.pm / g.pmg) * g.gstride + (size_t)nxt.pn * tstepB : cB;
#pragma unroll 1
        for (int t = 0; t < nt; t += 2) {
            const bool last = (t == nt - 2);
            const char* a1 = cA + (size_t)(t + 1) * kstep;
            const char* a2 = last ? nA : cA + (size_t)(t + 2) * kstep; const char* b2 = last ? nB : cB + (size_t)(t + 2) * kstep;
            const char* a3 = a2 + kstep; const char* b3 = b2 + kstep;
            if (last && has_next) S.a_ready(nxt);
            PG8_LDB(B0, 0, 0); PG8_SCHED; PG8_LDA(At, 0, 0); PG8_STAGE(PG8_SA(1, 1), a1 + hstepA, voffA);
            PG8_WAIT_L(8); PG8_BAR; PG8_WAIT_L(0); PG8_MMA(0, 0, At, B0); PG8_BAR; PG8_SCHED;
            PG8_LDB(B1, 0, 1); PG8_STAGE(PG8_SB(0, 0), b2, voffB);
            PG8_BAR; PG8_WAIT_L(0); PG8_MMA(0, 1, At, B1); PG8_BAR;
            PG8_LDA(At, 0, 1); PG8_STAGE(PG8_SA(0, 0), a2, voffA);
            PG8_BAR; PG8_WAIT_L(0); PG8_MMA(1, 0, At, B0); PG8_BAR; PG8_SCHED;
            PG8_STAGE(PG8_SB(0, 1), b2 + hstepB, voffB);
            PG8_WAIT_V(6); PG8_BAR; PG8_MMA(1, 1, At, B1); PG8_BAR;
            PG8_LDB(B0, 1, 0); PG8_SCHED; PG8_LDA(At, 1, 0); PG8_STAGE(PG8_SA(0, 1), a2 + hstepA, voffA);
            PG8_WAIT_L(8); PG8_BAR; PG8_WAIT_L(0); PG8_MMA(0, 0, At, B0); PG8_BAR; PG8_SCHED;
            PG8_LDB(B1, 1, 1); PG8_STAGE(PG8_SB(1, 0), b3, voffB);
            PG8_BAR; PG8_WAIT_L(0); PG8_MMA(0, 1, At, B1); PG8_BAR;
            PG8_LDA(At, 1, 1); PG8_STAGE(PG8_SA(1, 0), a3, voffA);
            PG8_BAR; PG8_WAIT_L(0); PG8_MMA(1, 0, At, B0); PG8_BAR; PG8_SCHED;
            PG8_STAGE(PG8_SB(1, 1), b3 + hstepB, voffB);
            PG8_WAIT_V(6); PG8_BAR; PG8_MMA(1, 1, At, B1); PG8_BAR;
        }
        PG8_STAMP();
        if constexpr (!Epi::AFTER_DRAIN) { E(acc, cur, wr, wc, fr, fq); S.done(cur); }
        PG8_STAMP();
        if (!has_next) break;
#pragma unroll
        for (int a = 0; a < 2; ++a)
#pragma unroll
            for (int b = 0; b < 2; ++b)
#pragma unroll
                for (int m = 0; m < 4; ++m)
#pragma unroll
                    for (int n = 0; n < 2; ++n) acc[a][b][m][n] = (f32x4){0.f, 0.f, 0.f, 0.f};
        cur = nxt; cA = nA; cB = nB; ++ui;
    }
    PG8_WAIT_V(0);
    if (wr == 0) PG8_BAR;
    PG8_BAR;
    if constexpr (Epi::AFTER_DRAIN) { E.fused(acc, cur, wr, wc, fr, fq, lds, wid, lane); S.done(cur); }
    PG8_STAMP();
    if (STAMP && wid == 0) { stamps[lane] = lane < nts ? (((unsigned long long)(unsigned)ts_hi << 32) | (unsigned)ts_lo) : 0ull;
        if (lane == 62) stamps[62] = rt_entry; if (lane == 63) stamps[63] = (unsigned long long)wall_clock64(); }
#undef PG8_STAMP
#undef PG8_SA
#undef PG8_SB
#undef PG8_STAGE
#undef PG8_LDA
#undef PG8_LDB
#undef PG8_MMA
#undef PG8_WAIT_V
#undef PG8_WAIT_L
#undef PG8_BAR
#undef PG8_SCHED
}
}


namespace hy {
using pg8::bf16_t; using pg8::f32x4; using pg8::u32x4; using pg8::Unit;
typedef unsigned u32x2 __attribute__((ext_vector_type(2)));
#define DI __device__ __forceinline__
constexpr int D = 1024, NBATCH = 8, SEQ = 4096, CTXL = 256, DEPTH = 4;
constexpr int CTXROWS = NBATCH * CTXL;
constexpr int MROWS = CTXROWS + NBATCH * SEQ;
constexpr int NCHUNK = MROWS / 64;
constexpr int NIN = 14384;
constexpr int NT = 512;
constexpr int LDS_BYTES = 147456 + 256;
constexpr int C_GQ = 0, C_GZ = 3072, C_GA = 4096, C_SU = 4128, C_MQ = 6176, C_MO = 9248, C_MI = 11296, C_GATE = 11312;

constexpr size_t al256(size_t x) { return (x + 255) & ~(size_t)255; }
constexpr size_t SZ_ACT = (size_t)MROWS * 1024 * 2;
constexpr size_t SZ_GATE = (size_t)MROWS * 32 * 4;
constexpr size_t SZ_HALO = (size_t)3 * NCHUNK * 4 * 1024 * 2;
constexpr size_t WS_CTL = 0;
constexpr size_t WS_MOD = 65536, SZ_MOD = (size_t)DEPTH * 9 * 3072 * 4;
constexpr size_t WS_XCTX = al256(WS_MOD + SZ_MOD);
constexpr size_t WS_H = WS_XCTX + (size_t)CTXROWS * 1024 * 4;
constexpr size_t WS_MERGED = WS_H + SZ_ACT;
constexpr size_t SZ_WB = (size_t)3328 * 1024 * 2;
constexpr size_t WS_WB0 = WS_MERGED + SZ_ACT;
constexpr size_t WS_WB1 = WS_WB0 + SZ_WB;
constexpr size_t WS_R = WS_WB1 + SZ_WB;
constexpr size_t R_P0 = 0, R_P1 = SZ_ACT, R_P2 = 2 * SZ_ACT, R_OF = 3 * SZ_ACT, R_OB = 4 * SZ_ACT, R_G2 = 5 * SZ_ACT;
constexpr size_t WS_END = WS_R + R_G2 + SZ_GATE + (size_t)4 * 1024 * 1024;
static_assert(SZ_GATE + SZ_HALO <= SZ_ACT, "GDN gate + halo buffers live in the (not yet written) MERGED region");
static_assert((size_t)16 * DEPTH * 9 * 3072 * 4 <= SZ_ACT, "mod partials live in the R region");

struct Args { const float* in[28]; float* out; unsigned char* ws; int ph_lo, ph_hi, wid, pad; };
enum { I_X = 0, I_C, I_CTX, I_CCTX, I_WADA, I_BADA, I_NORMG, I_WIN, I_GCONV, I_GALOG, I_GDTB, I_GNORM, I_SLRE, I_SLIM, I_SLOG, I_SBRE, I_SBIM, I_SCRE, I_SCIM, I_SD, I_SWGLU, I_SBGLU, I_MIB, I_MFB, I_MNORM, I_WBR, I_WOUT, I_FNORM };

typedef const Args __attribute__((address_space(4)))* ArgsP;
DI ArgsP args_ptr() { ArgsP p = (ArgsP)__builtin_amdgcn_kernarg_segment_ptr(); asm volatile("" : "+s"(p)); return p; }
DI int lane_id() { int l; asm volatile("v_mbcnt_lo_u32_b32 %0, -1, 0\n\tv_mbcnt_hi_u32_b32 %0, -1, %0" : "=v"(l)); return l; }
DI int ltid(const Args& a) { return (a.wid << 6) | lane_id(); }
DI void lds_barrier() { asm volatile("s_waitcnt lgkmcnt(0)" ::: "memory"); __builtin_amdgcn_s_barrier(); asm volatile("" ::: "memory"); }
DI float bf2f(bf16_t v) { return __uint_as_float(((unsigned)v) << 16); }
DI float bflo(unsigned w) { return __uint_as_float(w << 16); }
DI float bfhi(unsigned w) { return __uint_as_float(w & 0xffff0000u); }
DI bf16_t f2bf(float f) { return (bf16_t)(pg8::cvt_pk_bf16(f, 0.f) & 0xffffu); }
DI float sigmoidf_(float x) { return __builtin_amdgcn_rcpf(1.0f + __expf(-x)); }
DI float siluf_(float x) { return x * __builtin_amdgcn_rcpf(1.0f + __expf(-x)); }
DI float softplusf_(float x) { return x > 20.f ? x : log1pf(__expf(x)); }
DI float gelu_tanh_(float x) { const float u = 0.7978845608028654f * (x + 0.044715f * x * x * x); return x * __builtin_amdgcn_rcpf(1.0f + __expf(-2.0f * u)); }
DI float shx(float v, int o, int lane) { return __int_as_float(__builtin_amdgcn_ds_bpermute((lane ^ o) << 2, __float_as_int(v))); }
DI float shup(float v, int o, int lane) { return __int_as_float(__builtin_amdgcn_ds_bpermute((lane - o) << 2, __float_as_int(v))); }
DI float shidx(float v, int src) { return __int_as_float(__builtin_amdgcn_ds_bpermute(src << 2, __float_as_int(v))); }
#define DPP_F(old_, src_, ctrl_, rmask_) __int_as_float(__builtin_amdgcn_update_dpp(__float_as_int(old_), __float_as_int(src_), (ctrl_), (rmask_), 0xF, false))
DI float dpp_scan_sum(float v) {
    v += DPP_F(0.f, v, 0x111, 0xF); v += DPP_F(0.f, v, 0x112, 0xF); v += DPP_F(0.f, v, 0x114, 0xF); v += DPP_F(0.f, v, 0x118, 0xF);
    v += DPP_F(0.f, v, 0x142, 0xA); v += DPP_F(0.f, v, 0x143, 0xC); return v; }
DI float dpp_scan_max(float v) {
    const float ninf = -__builtin_inff();
    v = fmaxf(v, DPP_F(ninf, v, 0x111, 0xF)); v = fmaxf(v, DPP_F(ninf, v, 0x112, 0xF)); v = fmaxf(v, DPP_F(ninf, v, 0x114, 0xF)); v = fmaxf(v, DPP_F(ninf, v, 0x118, 0xF));
    v = fmaxf(v, DPP_F(ninf, v, 0x142, 0xA)); v = fmaxf(v, DPP_F(ninf, v, 0x143, 0xC)); return v; }
DI float lane63(float v) { return __int_as_float(__builtin_amdgcn_readlane(__float_as_int(v), 63)); }
DI float wave_sum(float v, int lane) {
#pragma unroll
    for (int o = 32; o >= 1; o >>= 1) v += shx(v, o, lane);
    return v; }
DI void unpack8(const u32x4 w, float (&f)[8]) { f[0] = bflo(w.x); f[1] = bfhi(w.x); f[2] = bflo(w.y); f[3] = bfhi(w.y); f[4] = bflo(w.z); f[5] = bfhi(w.z); f[6] = bflo(w.w); f[7] = bfhi(w.w); }
DI int lat_pos(int l, int s) { return (l & 1) ? (((s & 63) << 6) | (s >> 6)) : s; }

struct EpiProj {
    static constexpr bool PERM = true, AFTER_DRAIN = false;
    bf16_t* d0; int modes; float* gdst; int gtile; bf16_t* halo;
    __device__ __forceinline__ void operator()(const f32x4 (&acc)[2][2][4][2], const Unit& u, int wr, int wc, int fr, int fq) const {
        const int row0 = u.pm * 256 + wr * 64 + fr;
        if (u.pn == gtile) {
            if (wc == 0) {
#pragma unroll
                for (int ai = 0; ai < 2; ++ai)
#pragma unroll
                    for (int m = 0; m < 4; ++m) { float* rp = gdst + (size_t)(row0 + ai * 128 + m * 16) * 32 + 8 * fq; *(f32x4*)rp = acc[ai][0][m][0]; *(f32x4*)(rp + 4) = acc[ai][0][m][1]; }
            }
            return;
        }
        const int seg = u.pn >> 2; bf16_t* base = d0 + (size_t)seg * (SZ_ACT / 2); const int md = (modes >> (2 * seg)) & 3;
        const int col0 = (u.pn & 3) * 256 + wc * 32 + 8 * fq;
#pragma unroll
        for (int ai = 0; ai < 2; ++ai)
#pragma unroll
            for (int m = 0; m < 4; ++m) {
                const int r = row0 + ai * 128 + m * 16;
                bf16_t* rowp = base + (size_t)r * 1024 + col0;
                int hidx = -1;
                if (halo) { if (m == 0 && fr < 2) hidx = fr; if (m == 3 && fr >= 14) hidx = fr - 12; }
#pragma unroll
                for (int bj = 0; bj < 2; ++bj) {
                    f32x4 v0 = acc[ai][bj][m][0], v1 = acc[ai][bj][m][1];
                    if (md == 1) {
#pragma unroll
                        for (int j = 0; j < 4; ++j) { v0[j] = siluf_(v0[j]); v1[j] = siluf_(v1[j]); } }
                    else if (md == 2) {
#pragma unroll
                        for (int j = 0; j < 4; ++j) { v0[j] = sigmoidf_(v0[j]); v1[j] = sigmoidf_(v1[j]); } }
                    u32x4 w; w.x = pg8::cvt_pk_bf16(v0[0], v0[1]); w.y = pg8::cvt_pk_bf16(v0[2], v0[3]); w.z = pg8::cvt_pk_bf16(v1[0], v1[1]); w.w = pg8::cvt_pk_bf16(v1[2], v1[3]);
                    *(u32x4*)(rowp + bj * 128) = w;
                    if (hidx >= 0) *(u32x4*)(halo + ((size_t)seg * (NCHUNK * 4) + (size_t)(r >> 6) * 4 + hidx) * 1024 + col0 + bj * 128) = w;
                }
            }
    }
};
struct EpiBranch {
    static constexpr bool PERM = true, AFTER_DRAIN = false;
    const bf16_t* G; bf16_t* MG; int first;
    __device__ __forceinline__ void operator()(const f32x4 (&acc)[2][2][4][2], const Unit& u, int wr, int wc, int fr, int fq) const {
        const int row0 = u.pm * 256 + wr * 64 + fr, col0 = u.pn * 256 + wc * 32 + 8 * fq;
#pragma unroll
        for (int ai = 0; ai < 2; ++ai)
#pragma unroll
            for (int m = 0; m < 4; ++m) {
                const size_t off = (size_t)(row0 + ai * 128 + m * 16) * 1024 + col0;
#pragma unroll
                for (int bj = 0; bj < 2; ++bj) {
                    const u32x4 gw = *(const u32x4*)(G + off + bj * 128);
                    float g[8], o[8]; unpack8(gw, g);
                    if (first) {
#pragma unroll
                        for (int j = 0; j < 8; ++j) o[j] = 0.f; }
                    else { const u32x4 ow = *(const u32x4*)(MG + off + bj * 128); unpack8(ow, o); }
                    const f32x4 v0 = acc[ai][bj][m][0], v1 = acc[ai][bj][m][1];
#pragma unroll
                    for (int j = 0; j < 4; ++j) { o[j] += g[j] * v0[j]; o[4 + j] += g[4 + j] * v1[j]; }
                    u32x4 w; w.x = pg8::cvt_pk_bf16(o[0], o[1]); w.y = pg8::cvt_pk_bf16(o[2], o[3]); w.z = pg8::cvt_pk_bf16(o[4], o[5]); w.w = pg8::cvt_pk_bf16(o[6], o[7]);
                    *(u32x4*)(MG + off + bj * 128) = w;
                }
                asm volatile("" ::: "memory");
            }
    }
};
struct EpiGlu {
    static constexpr bool PERM = true, AFTER_DRAIN = false;
    const bf16_t* SZ; bf16_t* O; const float* bias;
    __device__ __forceinline__ void operator()(const f32x4 (&acc)[2][2][4][2], const Unit& u, int wr, int wc, int fr, int fq) const {
        const int row0 = u.pm * 256 + wr * 64 + fr, col0 = u.pn * 128 + wc * 32 + 8 * fq;
        float ba[8], bg[8];
#pragma unroll
        for (int j = 0; j < 8; ++j) { ba[j] = bias[col0 + j]; bg[j] = bias[1024 + col0 + j]; }
#pragma unroll
        for (int ai = 0; ai < 2; ++ai)
#pragma unroll
            for (int m = 0; m < 4; ++m) {
                const size_t off = (size_t)(row0 + ai * 128 + m * 16) * 1024 + col0;
                const u32x4 zw = *(const u32x4*)(SZ + off); float z[8], o[8]; unpack8(zw, z);
#pragma unroll
                for (int n = 0; n < 2; ++n)
#pragma unroll
                    for (int j = 0; j < 4; ++j) { const int c = 4 * n + j; o[c] = (acc[ai][0][m][n][j] + ba[c]) * sigmoidf_(acc[ai][1][m][n][j] + bg[c]) * z[c]; }
                u32x4 w; w.x = pg8::cvt_pk_bf16(o[0], o[1]); w.y = pg8::cvt_pk_bf16(o[2], o[3]); w.z = pg8::cvt_pk_bf16(o[4], o[5]); w.w = pg8::cvt_pk_bf16(o[6], o[7]);
                *(u32x4*)(O + off) = w;
            }
    }
};
struct EpiOut {
    static constexpr bool PERM = false, AFTER_DRAIN = false;
    const float* xlat_src; float* xlat_dst; const float* xctx_src; float* xctx_dst; const float* mod; int l; int row_off;
    __device__ __forceinline__ void operator()(const f32x4 (&acc)[2][2][4][2], const Unit& u, int wr, int wc, int fr, int fq) const {
        const int row0 = row_off + u.pm * 256 + wr * 64 + fr, col0 = u.pn * 256 + wc * 32 + 4 * fq;
#pragma unroll
        for (int ai = 0; ai < 2; ++ai)
#pragma unroll
            for (int m = 0; m < 4; ++m) {
                const int r = row0 + ai * 128 + m * 16;
                const float* xs; float* xd; const float* gp;
                if (r < CTXROWS) { xs = xctx_src + (size_t)r * 1024; xd = xctx_dst + (size_t)r * 1024; gp = mod + 8 * 3072 + 2048; }
                else { const int q = r - CTXROWS, b = q >> 12, p = lat_pos(l, q & 4095); const size_t o = ((size_t)b * 4096 + p) * 1024; xs = xlat_src + o; xd = xlat_dst + o; gp = mod + b * 3072 + 2048; }
#pragma unroll
                for (int bj = 0; bj < 2; ++bj)
#pragma unroll
                    for (int n = 0; n < 2; ++n) { const int c = col0 + bj * 128 + n * 16; const f32x4 x = *(const f32x4*)(xs + c), g = *(const f32x4*)(gp + c); *(f32x4*)(xd + c) = x + g * acc[ai][bj][m][n]; }
                asm volatile("" ::: "memory");
            }
    }
};

DI void ph_modp(const Args& a, float* modp, LAS float* sl) {
    for (int it = blockIdx.x; it < 384; it += gridDim.x) {
        const int l = it / 96, kq = (it / 6) % 16, nt = it % 6;
        __syncthreads();
        for (int i = ltid(a); i < 576; i += NT) { const int j = i >> 6, k = kq * 64 + (i & 63); const float cv = (j < 8) ? a.in[I_C][j * 1024 + k] : a.in[I_CCTX][k]; sl[i] = siluf_(cv); }
        __syncthreads();
        const int n = nt * 512 + ltid(a);
        float acc[9];
#pragma unroll
        for (int j = 0; j < 9; ++j) acc[j] = 0.f;
        const float* w = a.in[I_WADA] + ((size_t)l * 1024 + kq * 64) * 3072 + n;
#pragma unroll 4
        for (int k = 0; k < 64; ++k) { const float wv = w[(size_t)k * 3072];
#pragma unroll
            for (int j = 0; j < 9; ++j) acc[j] += sl[j * 64 + k] * wv; }
#pragma unroll
        for (int j = 0; j < 9; ++j) modp[(((size_t)kq * 4 + l) * 9 + j) * 3072 + n] = acc[j];
    }
}
DI void ph_mod(const Args& a, const float* modp, float* mod) {
    for (int i = blockIdx.x * NT + ltid(a); i < DEPTH * 9 * 3072; i += gridDim.x * NT) {
        const int l = i / (9 * 3072), n = i % 3072; float s = a.in[I_BADA][l * 3072 + n];
#pragma unroll
        for (int kq = 0; kq < 16; ++kq) s += modp[(size_t)kq * (DEPTH * 9 * 3072) + i];
        mod[i] = s;
    }
}
DI void ph_norm(const Args& a, int l, const float* xlat, const float* xctx, const float* mod, bf16_t* H) {
    const int wave = ltid(a) >> 6, lane = ltid(a) & 63;
    const float* g = a.in[I_NORMG] + l * 1024;
    for (int r = blockIdx.x * 8 + wave; r < MROWS; r += gridDim.x * 8) {
        const float* src; const float* md;
        if (r < CTXROWS) { src = xctx + (size_t)r * 1024; md = mod + 8 * 3072; }
        else { const int q = r - CTXROWS, b = q >> 12, p = lat_pos(l, q & 4095); src = xlat + ((size_t)b * 4096 + p) * 1024; md = mod + b * 3072; }
        f32x4 v[4]; float ss = 0.f;
#pragma unroll
        for (int i = 0; i < 4; ++i) { v[i] = *(const f32x4*)(src + i * 256 + lane * 4); ss += v[i][0] * v[i][0] + v[i][1] * v[i][1] + v[i][2] * v[i][2] + v[i][3] * v[i][3]; }
        ss = wave_sum(ss, lane);
        const float rs = rsqrtf(ss * (1.0f / 1024.0f) + 1e-6f);
#pragma unroll
        for (int i = 0; i < 4; ++i) { const int c = i * 256 + lane * 4;
            const f32x4 gv = *(const f32x4*)(g + c), sh = *(const f32x4*)(md + c), sc = *(const f32x4*)(md + 1024 + c);
            const f32x4 y = (v[i] * rs) * gv * (sc + 1.0f) + sh;
            u32x2 w; w.x = pg8::cvt_pk_bf16(y[0], y[1]); w.y = pg8::cvt_pk_bf16(y[2], y[3]);
            *(u32x2*)(H + (size_t)r * 1024 + c) = w; }
    }
}
DI void ph_final(const Args& a, float* x) {
    const int wave = ltid(a) >> 6, lane = ltid(a) & 63;
    const float* g = a.in[I_FNORM];
    for (int r = blockIdx.x * 8 + wave; r < NBATCH * SEQ; r += gridDim.x * 8) {
        float* src = x + (size_t)r * 1024;
        f32x4 v[4]; float ss = 0.f;
#pragma unroll
        for (int i = 0; i < 4; ++i) { v[i] = *(const f32x4*)(src + i * 256 + lane * 4); ss += v[i][0] * v[i][0] + v[i][1] * v[i][1] + v[i][2] * v[i][2] + v[i][3] * v[i][3]; }
        ss = wave_sum(ss, lane);
        const float rs = rsqrtf(ss * (1.0f / 1024.0f) + 1e-6f);
#pragma unroll
        for (int i = 0; i < 4; ++i) { const int c = i * 256 + lane * 4; const f32x4 gv = *(const f32x4*)(g + c); *(f32x4*)(src + c) = (v[i] * rs) * gv; }
    }
}
struct WDesc { const float* src; int ld, id, n64, tid; };
DI void wmap(int id, int nb, int& col, int& valid) {
    valid = 64;
    switch (id) {
        case 0: if (nb < 48) col = C_GQ + 64 * nb; else if (nb == 48) { col = C_GA; valid = 32; } else { col = 0; valid = 0; } break;
        case 1: col = (nb < 16) ? C_GZ + 64 * nb : C_GATE + 64 * (nb - 16); break;
        case 2: if (nb < 48) col = C_MQ + 64 * nb; else if (nb == 48) { col = C_MI; valid = 16; } else { col = 0; valid = 0; } break;
        case 3: col = (nb < 32) ? C_MO + 64 * nb : C_GATE + 2048 + 64 * (nb - 32); break;
        case 4: col = (nb < 32) ? C_SU + 64 * nb : C_GATE + 1024 + 64 * (nb - 32); break;
        case 5: { const int pn = nb >> 2, q = nb & 3; col = (q >> 1) * 1024 + 128 * pn + (q & 1) * 64; } break;
        default: col = 64 * nb; break;
    }
}
DI WDesc wdesc(const Args& a, int l, int id) {
    WDesc w; w.id = id; w.tid = ltid(a);
    if (id <= 4) { w.src = a.in[I_WIN] + (size_t)l * 1024 * NIN; w.ld = NIN; w.n64 = (id == 0 || id == 2) ? 52 : (id == 1 ? 32 : 48); }
    else if (id == 5) { w.src = a.in[I_SWGLU] + (size_t)l * 1024 * 2048; w.ld = 2048; w.n64 = 32; }
    else if (id <= 8) { w.src = a.in[I_WBR] + ((size_t)l * 3 + (id - 6)) * 1024 * 1024; w.ld = 1024; w.n64 = 16; }
    else { w.src = a.in[I_WOUT] + (size_t)l * 1024 * 1024; w.ld = 1024; w.n64 = 16; }
    return w;
}
DI void ph_cvt(const WDesc w, bf16_t* dst, LAS float* tile) {
    const int tid = w.tid, ntile = w.n64 * 16;
    for (int t = blockIdx.x; t < ntile; t += gridDim.x) {
        const int nb = t >> 4, kb = t & 15; int col, valid; wmap(w.id, nb, col, valid);
        __syncthreads();
        { const int c = tid & 63, k0 = tid >> 6;
#pragma unroll
          for (int i = 0; i < 8; ++i) { const int k = k0 + 8 * i; tile[k * 65 + c] = (c < valid) ? w.src[(size_t)(kb * 64 + k) * w.ld + col + c] : 0.f; } }
        __syncthreads();
        { const int n = tid >> 3, kk = (tid & 7) * 8; u32x4 o;
          o.x = pg8::cvt_pk_bf16(tile[(kk + 0) * 65 + n], tile[(kk + 1) * 65 + n]); o.y = pg8::cvt_pk_bf16(tile[(kk + 2) * 65 + n], tile[(kk + 3) * 65 + n]);
          o.z = pg8::cvt_pk_bf16(tile[(kk + 4) * 65 + n], tile[(kk + 5) * 65 + n]); o.w = pg8::cvt_pk_bf16(tile[(kk + 6) * 65 + n], tile[(kk + 7) * 65 + n]);
          *(u32x4*)(dst + (size_t)(nb * 64 + n) * 1024 + kb * 64 + kk) = o; }
    }
    __syncthreads();
}

DI void gdn_conv_decode(int unit, int& cb, int& seg, int& h) { cb = unit / 24; seg = (unit % 24) >> 3; h = unit & 7; }
DI void ph_gdn_conv(const Args& a, int l, bf16_t* QKV  , const bf16_t* halo, LAS unsigned char* lds, bf16_t* junk = nullptr) {
    constexpr int P = 136, IMG = 68 * P * 2 + 5 * 128 * 4;
    const int tid = ltid(a);
    const float* cw = a.in[I_GCONV] + (size_t)l * 5 * 3072;
    const int nunit = NCHUNK * 24;
    u32x4 rp[3]; f32x4 wreg = (f32x4){0.f, 0.f, 0.f, 0.f};
    int unit = blockIdx.x, buf = 0;
#define CONV_FETCH(un) do { int cb_, seg_, h_; gdn_conv_decode(un, cb_, seg_, h_); const bf16_t* T_ = QKV + (size_t)seg_ * (SZ_ACT / 2); \
        const bool first_ = (cb_ < 32) ? ((cb_ & 3) == 0) : (((cb_ - 32) & 63) == 0), last_ = (cb_ < 32) ? ((cb_ & 3) == 3) : (((cb_ - 32) & 63) == 63); \
        _Pragma("unroll") for (int q_ = 0; q_ < 3; ++q_) { const int i_ = tid + 512 * q_, rr_ = i_ >> 4, c8_ = (i_ & 15) * 8; u32x4 w_ = (u32x4){0u, 0u, 0u, 0u}; \
            if (i_ < 68 * 16) { if (rr_ >= 2 && rr_ < 66) w_ = *(const u32x4*)(T_ + (size_t)(cb_ * 64 + rr_ - 2) * 1024 + h_ * 128 + c8_); \
                else if (rr_ < 2) { if (!first_) w_ = *(const u32x4*)(halo + ((size_t)seg_ * (NCHUNK * 4) + (size_t)(cb_ - 1) * 4 + 2 + rr_) * 1024 + h_ * 128 + c8_); } \
                else { if (!last_) w_ = *(const u32x4*)(halo + ((size_t)seg_ * (NCHUNK * 4) + (size_t)(cb_ + 1) * 4 + (rr_ - 66)) * 1024 + h_ * 128 + c8_); } } \
            rp[q_] = w_; } \
        if (tid < 160) wreg = *(const f32x4*)(cw + (size_t)(tid >> 5) * 3072 + seg_ * 1024 + h_ * 128 + (tid & 31) * 4); } while (0)
    if (unit < nunit) CONV_FETCH(unit);
    for (; unit < nunit; unit += gridDim.x) {
        int cb, seg, h; gdn_conv_decode(unit, cb, seg, h);
        LAS bf16_t* raw = (LAS bf16_t*)(lds + buf * IMG); LAS float* wl = (LAS float*)(lds + buf * IMG + 68 * P * 2);
#pragma unroll
        for (int q = 0; q < 3; ++q) { const int i = tid + 512 * q, rr = i >> 4, c8 = (i & 15) * 8; if (i < 68 * 16) *(LAS u32x4*)(raw + rr * P + c8) = rp[q]; }
        if (tid < 160) *(LAS f32x4*)(wl + tid * 4) = wreg;
        if (unit + (int)gridDim.x < nunit) CONV_FETCH(unit + (int)gridDim.x);
        lds_barrier();
        bf16_t* T = QKV + (size_t)seg * (SZ_ACT / 2);
        const int t = tid >> 3, c0 = (tid & 7) * 16;
        float o[16]; float ss = 0.f;
#pragma unroll
        for (int half = 0; half < 2; ++half) {
            float acc[8];
#pragma unroll
            for (int j = 0; j < 8; ++j) acc[j] = 0.f;
#pragma unroll
            for (int k = 0; k < 5; ++k) {
                const u32x4 w = *(const LAS u32x4*)(raw + (t + k) * P + c0 + half * 8); float x[8]; unpack8(w, x);
                const f32x4 w0 = *(const LAS f32x4*)(wl + k * 128 + c0 + half * 8), w1 = *(const LAS f32x4*)(wl + k * 128 + c0 + half * 8 + 4);
#pragma unroll
                for (int j = 0; j < 4; ++j) { acc[j] += w0[j] * x[j]; acc[4 + j] += w1[j] * x[4 + j]; }
            }
#pragma unroll
            for (int j = 0; j < 8; ++j) { const float sv = siluf_(acc[j]); o[half * 8 + j] = sv; ss += sv * sv; }
        }
        ss += shx(ss, 1, tid & 63); ss += shx(ss, 2, tid & 63); ss += shx(ss, 4, tid & 63);
        float scale = 1.0f;
        if (seg == 0) scale = rsqrtf(ss + 1e-6f) * 0.08838834764831845f;
        else if (seg == 1) scale = rsqrtf(ss + 1e-6f);
        u32x4 w0, w1;
        w0.x = pg8::cvt_pk_bf16(o[0] * scale, o[1] * scale); w0.y = pg8::cvt_pk_bf16(o[2] * scale, o[3] * scale); w0.z = pg8::cvt_pk_bf16(o[4] * scale, o[5] * scale); w0.w = pg8::cvt_pk_bf16(o[6] * scale, o[7] * scale);
        w1.x = pg8::cvt_pk_bf16(o[8] * scale, o[9] * scale); w1.y = pg8::cvt_pk_bf16(o[10] * scale, o[11] * scale); w1.z = pg8::cvt_pk_bf16(o[12] * scale, o[13] * scale); w1.w = pg8::cvt_pk_bf16(o[14] * scale, o[15] * scale);
        bf16_t* op = (junk ? junk : T) + (size_t)(cb * 64 + t) * 1024 + h * 128 + c0;
        *(u32x4*)op = w0; *(u32x4*)(op + 8) = w1;
        buf ^= 1;
    }
#undef CONV_FETCH
    __syncthreads();
}
DI void ph_gdn_scan(const Args& a, int l, const bf16_t* Q, const bf16_t* K, const bf16_t* V, const float* GATE, bf16_t* OF, bf16_t* OB, LAS unsigned char* lds) {
    LAS float* qf = (LAS float*)lds;
    LAS float* kf = qf + 64 * 128;
    LAS float* vf = kf + 64 * 128;
    LAS float* av = vf + 64 * 64;
    LAS float* bt = av + 64;
    LAS float* part = bt + 64;
    LAS float* po = part + 1024;
    const int tid = ltid(a), e = tid & 63, dq = tid >> 6;
    for (int unit = blockIdx.x; unit < 256; unit += gridDim.x) {
        const int eh = unit & 1, d = (unit >> 1) & 1, h = (unit >> 2) & 7, b = unit >> 5;
        const float nea = -__expf(a.in[I_GALOG][(l * 2 + d) * 8 + h]), dtb = a.in[I_GDTB][(l * 2 + d) * 8 + h];
        bf16_t* O = d ? OB : OF;
        float S[16];
#pragma unroll
        for (int j = 0; j < 16; ++j) S[j] = 0.f;
        float opart = 0.f; int prow = -1, par = 0;
        for (int step = 0; step < 68; ++step) {
            const int cc = (step < 4) ? (d ? 3 - step : step) : (d ? 67 - step : step - 4);
            const int row0 = (step < 4) ? b * 256 + cc * 64 : CTXROWS + b * 4096 + cc * 64;
            __syncthreads();
            for (int i = tid; i < 1024; i += NT) { const int r = i >> 4, c8 = (i & 15) * 8; float f[8];
                unpack8(*(const u32x4*)(Q + (size_t)(row0 + r) * 1024 + h * 128 + c8), f);
#pragma unroll
                for (int j = 0; j < 8; ++j) qf[r * 128 + c8 + j] = f[j];
                unpack8(*(const u32x4*)(K + (size_t)(row0 + r) * 1024 + h * 128 + c8), f);
#pragma unroll
                for (int j = 0; j < 8; ++j) kf[r * 128 + c8 + j] = f[j]; }
            { const int r = tid >> 3, c8 = (tid & 7) * 8; float f[8]; unpack8(*(const u32x4*)(V + (size_t)(row0 + r) * 1024 + h * 128 + eh * 64 + c8), f);
#pragma unroll
              for (int j = 0; j < 8; ++j) vf[r * 64 + c8 + j] = f[j]; }
            if (tid < 64) { const float* gp = GATE + (size_t)(row0 + tid) * 32; av[tid] = __expf(nea * softplusf_(gp[d * 8 + h] + dtb)); bt[tid] = sigmoidf_(gp[16 + d * 8 + h]); }
            __syncthreads();
            for (int tt = 0; tt < 64; ++tt) {
                const int t = d ? 63 - tt : tt;
                float kk[16];
#pragma unroll
                for (int j4 = 0; j4 < 4; ++j4) { const f32x4 x = *(const LAS f32x4*)(kf + t * 128 + dq * 16 + j4 * 4); kk[j4 * 4] = x[0]; kk[j4 * 4 + 1] = x[1]; kk[j4 * 4 + 2] = x[2]; kk[j4 * 4 + 3] = x[3]; }
                float p = 0.f;
#pragma unroll
                for (int j = 0; j < 16; ++j) p += kk[j] * S[j];
                part[(par * 8 + dq) * 64 + e] = p; po[(par * 8 + dq) * 64 + e] = opart;
                __syncthreads();
                if (dq == 0 && prow >= 0) { float o = 0.f;
#pragma unroll
                    for (int q = 0; q < 8; ++q) o += po[(par * 8 + q) * 64 + e];
                    O[(size_t)prow * 1024 + h * 128 + eh * 64 + e] = f2bf(o); }
                float ks = 0.f;
#pragma unroll
                for (int q = 0; q < 8; ++q) ks += part[(par * 8 + q) * 64 + e];
                const float at = av[t], vn = bt[t] * (vf[t * 64 + e] - at * ks);
#pragma unroll
                for (int j = 0; j < 16; ++j) S[j] = at * S[j] + kk[j] * vn;
                float qo = 0.f;
#pragma unroll
                for (int j4 = 0; j4 < 4; ++j4) { const f32x4 x = *(const LAS f32x4*)(qf + t * 128 + dq * 16 + j4 * 4); qo += x[0] * S[j4 * 4] + x[1] * S[j4 * 4 + 1] + x[2] * S[j4 * 4 + 2] + x[3] * S[j4 * 4 + 3]; }
                opart = qo; prow = row0 + t; par ^= 1;
            }
        }
        po[(par * 8 + dq) * 64 + e] = opart;
        __syncthreads();
        if (dq == 0) { float o = 0.f;
#pragma unroll
            for (int q = 0; q < 8; ++q) o += po[(par * 8 + q) * 64 + e];
            O[(size_t)prow * 1024 + h * 128 + eh * 64 + e] = f2bf(o); }
        __syncthreads();
    }
}
template <int O> DI float swz_xor(float v) { return __int_as_float(__builtin_amdgcn_ds_swizzle(__float_as_int(v), 0x1F | (O << 10))); }
DI void ph_gdn_post(const Args& a, int l, bf16_t* OF, const bf16_t* OB, const bf16_t* SZ, bf16_t* junk = nullptr) {
    const int tid = ltid(a), wave = tid >> 6, lane = tid & 63;
    const float* g = a.in[I_GNORM] + l * 128 + (lane & 15) * 8;
    const f32x4 g0 = *(const f32x4*)g, g1 = *(const f32x4*)(g + 4);
    const int nit = MROWS * 2, stride = gridDim.x * 8;
    for (int it = blockIdx.x * 8 + wave; it < nit; it += 2 * stride) {
        const int it1 = it + stride; const bool two = it1 < nit;
        const size_t off0 = (size_t)it * 512 + lane * 8, off1 = (size_t)(two ? it1 : it) * 512 + lane * 8;
        const u32x4 f0 = *(const u32x4*)(OF + off0), b0 = *(const u32x4*)(OB + off0), z0 = *(const u32x4*)(SZ + off0);
        const u32x4 f1 = *(const u32x4*)(OF + off1), b1 = *(const u32x4*)(OB + off1), z1 = *(const u32x4*)(SZ + off1);
        float x0[8], x1[8], t0[8], t1[8];
        unpack8(f0, x0); unpack8(b0, t0); unpack8(f1, x1); unpack8(b1, t1);
        float s0 = 0.f, s1 = 0.f;
#pragma unroll
        for (int j = 0; j < 8; ++j) { x0[j] += t0[j]; x1[j] += t1[j]; s0 += x0[j] * x0[j]; s1 += x1[j] * x1[j]; }
        s0 += swz_xor<1>(s0); s1 += swz_xor<1>(s1); s0 += swz_xor<2>(s0); s1 += swz_xor<2>(s1); s0 += swz_xor<4>(s0); s1 += swz_xor<4>(s1); s0 += swz_xor<8>(s0); s1 += swz_xor<8>(s1);
        const float r0 = rsqrtf(s0 * (1.0f / 128.0f) + 1e-6f), r1 = rsqrtf(s1 * (1.0f / 128.0f) + 1e-6f);
        unpack8(z0, t0); unpack8(z1, t1);
        u32x4 w0, w1;
        w0.x = pg8::cvt_pk_bf16(x0[0] * r0 * g0[0] * t0[0], x0[1] * r0 * g0[1] * t0[1]); w0.y = pg8::cvt_pk_bf16(x0[2] * r0 * g0[2] * t0[2], x0[3] * r0 * g0[3] * t0[3]);
        w0.z = pg8::cvt_pk_bf16(x0[4] * r0 * g1[0] * t0[4], x0[5] * r0 * g1[1] * t0[5]); w0.w = pg8::cvt_pk_bf16(x0[6] * r0 * g1[2] * t0[6], x0[7] * r0 * g1[3] * t0[7]);
        w1.x = pg8::cvt_pk_bf16(x1[0] * r1 * g0[0] * t1[0], x1[1] * r1 * g0[1] * t1[1]); w1.y = pg8::cvt_pk_bf16(x1[2] * r1 * g0[2] * t1[2], x1[3] * r1 * g0[3] * t1[3]);
        w1.z = pg8::cvt_pk_bf16(x1[4] * r1 * g1[0] * t1[4], x1[5] * r1 * g1[1] * t1[5]); w1.w = pg8::cvt_pk_bf16(x1[6] * r1 * g1[2] * t1[6], x1[7] * r1 * g1[3] * t1[7]);
        bf16_t* dst = junk ? junk : OF;
        *(u32x4*)(dst + off0) = w0; if (two) *(u32x4*)(dst + off1) = w1;
    }
}

DI void ph_ml_scan(const Args& a, int l, const bf16_t* Q, const bf16_t* K, const bf16_t* V, const float* GATE, bf16_t* HF, bf16_t* HB, LAS unsigned char* lds) {
    LAS bf16_t* qs = (LAS bf16_t*)lds;
    LAS bf16_t* ks = qs + 64 * 256;
    LAS float* vf = (LAS float*)(ks + 64 * 256);
    LAS float* ip = vf + 64 * 64;
    LAS float* lf = ip + 64;
    LAS float* part = lf + 64;
    LAS float* dpart = part + 1024;
    const int tid = ltid(a), e = tid & 63, dq = tid >> 6;
    for (int unit = blockIdx.x; unit < 256; unit += gridDim.x) {
        const int eq = unit & 3, d = (unit >> 2) & 1, hd = (unit >> 3) & 3, b = unit >> 5;
        const float ibias = a.in[I_MIB][(l * 2 + d) * 4 + hd], fbias = a.in[I_MFB][(l * 2 + d) * 4 + hd];
        bf16_t* HO = d ? HB : HF;
        float C[32];
#pragma unroll
        for (int j = 0; j < 32; ++j) C[j] = 0.f;
        float nn = 0.f, m = 0.f; int par = 0;
        for (int step = 0; step < 68; ++step) {
            const int cc = (step < 4) ? (d ? 3 - step : step) : (d ? 67 - step : step - 4);
            const int row0 = (step < 4) ? b * 256 + cc * 64 : CTXROWS + b * 4096 + cc * 64;
            __syncthreads();
            for (int i = tid; i < 2048; i += NT) { const int r = i >> 5, c8 = (i & 31) * 8;
                *(LAS u32x4*)(qs + r * 256 + c8) = *(const u32x4*)(Q + (size_t)(row0 + r) * 1024 + hd * 256 + c8);
                *(LAS u32x4*)(ks + r * 256 + c8) = *(const u32x4*)(K + (size_t)(row0 + r) * 1024 + hd * 256 + c8); }
            { const int r = tid >> 3, c8 = (tid & 7) * 8; float f[8]; unpack8(*(const u32x4*)(V + (size_t)(row0 + r) * 1024 + hd * 256 + eq * 64 + c8), f);
#pragma unroll
              for (int j = 0; j < 8; ++j) vf[r * 64 + c8 + j] = f[j]; }
            if (tid < 64) { const float* gp = GATE + (size_t)(row0 + tid) * 32; ip[tid] = gp[d * 4 + hd] + ibias; lf[tid] = -softplusf_(-(gp[8 + d * 4 + hd] + fbias)); }
            __syncthreads();
            for (int tt = 0; tt < 64; ++tt) {
                const int t = d ? 63 - tt : tt;
                const float it = ip[t], ft = lf[t];
                const float mn = fmaxf(ft + m, it);
                const float fdec = __expf(ft + m - mn), iw = __expf(it - mn) * 0.0625f, nrm = __expf(-mn);
                m = mn;
                const float vv = iw * vf[t * 64 + e];
                float pn = 0.f;
#pragma unroll
                for (int j8 = 0; j8 < 4; ++j8) {
                    float kk[8], qq[8];
                    unpack8(*(const LAS u32x4*)(ks + t * 256 + dq * 32 + j8 * 8), kk);
                    unpack8(*(const LAS u32x4*)(qs + t * 256 + dq * 32 + j8 * 8), qq);
#pragma unroll
                    for (int j = 0; j < 8; ++j) { const float c = fdec * C[j8 * 8 + j] + vv * kk[j]; C[j8 * 8 + j] = c; pn += c * qq[j]; }
                }
                const int dn = dq * 32 + (e & 31);
                nn = fdec * nn + iw * bf2f(ks[t * 256 + dn]);
                float pd = (e < 32) ? nn * bf2f(qs[t * 256 + dn]) : 0.f;
                pd = wave_sum(pd, e);
                part[(par * 8 + dq) * 64 + e] = pn; if (e == 0) dpart[par * 8 + dq] = pd;
                __syncthreads();
                if (dq == 0) { float num = 0.f, den = 0.f;
#pragma unroll
                    for (int q = 0; q < 8; ++q) { num += part[(par * 8 + q) * 64 + e]; den += dpart[par * 8 + q]; }
                    HO[(size_t)(row0 + t) * 1024 + hd * 256 + eq * 64 + e] = f2bf(num / fmaxf(fabsf(den), nrm)); }
                par ^= 1;
            }
        }
        __syncthreads();
    }
}
DI void ph_ml_post(const Args& a, int l, bf16_t* HF, const bf16_t* HB, const bf16_t* SO, const bf16_t* SZ) {
    const int tid = ltid(a), wave = tid >> 6, lane = tid & 63;
    const float* g = a.in[I_MNORM] + l * 256 + (lane & 31) * 8;
    const f32x4 g0 = *(const f32x4*)g, g1 = *(const f32x4*)(g + 4);
    const int nit = MROWS * 2, stride = gridDim.x * 8;
    for (int it = blockIdx.x * 8 + wave; it < nit; it += stride) {
        const size_t off = (size_t)it * 512 + lane * 8;
        const u32x4 f0 = *(const u32x4*)(HF + off), b0 = *(const u32x4*)(HB + off), o0 = *(const u32x4*)(SO + off), z0 = *(const u32x4*)(SZ + off);
        float x[8], t0[8];
        unpack8(f0, x); unpack8(b0, t0);
#pragma unroll
        for (int j = 0; j < 8; ++j) x[j] += t0[j];
        unpack8(o0, t0);
        float s0 = 0.f;
#pragma unroll
        for (int j = 0; j < 8; ++j) { x[j] *= t0[j]; s0 += x[j] * x[j]; }
        s0 += swz_xor<1>(s0); s0 += swz_xor<2>(s0); s0 += swz_xor<4>(s0); s0 += swz_xor<8>(s0); s0 += swz_xor<16>(s0);
        const float r0 = rsqrtf(s0 * (1.0f / 256.0f) + 1e-6f);
        unpack8(z0, t0);
        u32x4 w0;
        w0.x = pg8::cvt_pk_bf16(x[0] * r0 * g0[0] * t0[0], x[1] * r0 * g0[1] * t0[1]); w0.y = pg8::cvt_pk_bf16(x[2] * r0 * g0[2] * t0[2], x[3] * r0 * g0[3] * t0[3]);
        w0.z = pg8::cvt_pk_bf16(x[4] * r0 * g1[0] * t0[4], x[5] * r0 * g1[1] * t0[5]); w0.w = pg8::cvt_pk_bf16(x[6] * r0 * g1[2] * t0[6], x[7] * r0 * g1[3] * t0[7]);
        *(u32x4*)(HF + off) = w0;
    }
}

DI void ph_s5_scan(const Args& a, int l, const bf16_t* U, bf16_t* YF, bf16_t* YB, LAS unsigned char* lds) {
    const int tid = ltid(a), w = tid >> 6, p = tid & 63;
    LAS float* ub = (LAS float*)lds + w * 2304;
    LAS float* yb = ub + 1024;
    LAS float* xb = yb + 1024;
    for (int unit = blockIdx.x; unit < 128; unit += gridDim.x) {
        const int gb = unit & 7, d = (unit >> 3) & 1, b = unit >> 4, g = gb * 8 + w;
        const float stp = expf(a.in[I_SLOG][(l * 2 + d) * 64 + g]);
        const float lre = a.in[I_SLRE][((size_t)(l * 2 + d) * 64 + g) * 64 + p], lim = a.in[I_SLIM][((size_t)(l * 2 + d) * 64 + g) * 64 + p];
        const float mag = expf(lre * stp), lbr = mag * cosf(lim * stp), lbi = mag * sinf(lim * stp);
        const float dnm = lre * lre + lim * lim;
        const float fre = ((lbr - 1.0f) * lre + lbi * lim) / dnm, fim = (lbi * lre - (lbr - 1.0f) * lim) / dnm;
        float bbr[16], bbi[16];
        { const float* br = a.in[I_SBRE] + (((size_t)l * 64 + g) * 64 + p) * 16; const float* bi = a.in[I_SBIM] + (((size_t)l * 64 + g) * 64 + p) * 16;
#pragma unroll
          for (int h = 0; h < 16; ++h) { bbr[h] = fre * br[h] - fim * bi[h]; bbi[h] = fre * bi[h] + fim * br[h]; } }
        const int hh = p & 15, pt = p >> 4;
        float cr[16], ci[16];
        { const float* c0 = a.in[I_SCRE] + (((size_t)l * 64 + g) * 16 + hh) * 64 + pt * 16; const float* c1 = a.in[I_SCIM] + (((size_t)l * 64 + g) * 16 + hh) * 64 + pt * 16;
#pragma unroll
          for (int j = 0; j < 16; ++j) { cr[j] = c0[j]; ci[j] = c1[j]; } }
        bf16_t* Y = d ? YB : YF;
        float xr = 0.f, xi = 0.f; int par = 0;
        for (int step = 0; step < 68; ++step) {
            const int cc = (step < 4) ? (d ? 3 - step : step) : (d ? 67 - step : step - 4);
            const int row0 = (step < 4) ? b * 256 + cc * 64 : CTXROWS + b * 4096 + cc * 64;
            __syncthreads();
            { const bf16_t* up = U + (size_t)(row0 + p) * 1024 + g * 16; float f[8];
              unpack8(*(const u32x4*)up, f);
#pragma unroll
              for (int j = 0; j < 8; ++j) ub[p * 16 + j] = f[j];
              unpack8(*(const u32x4*)(up + 8), f);
#pragma unroll
              for (int j = 0; j < 8; ++j) ub[p * 16 + 8 + j] = f[j]; }
            __syncthreads();
            for (int tt = 0; tt < 64; ++tt) {
                const int t = d ? 63 - tt : tt;
                float bur = 0.f, bui = 0.f;
#pragma unroll
                for (int h4 = 0; h4 < 4; ++h4) { const f32x4 u = *(const LAS f32x4*)(ub + t * 16 + h4 * 4);
#pragma unroll
                    for (int j = 0; j < 4; ++j) { bur += bbr[h4 * 4 + j] * u[j]; bui += bbi[h4 * 4 + j] * u[j]; } }
                const float nxr = lbr * xr - lbi * xi + bur, nxi = lbr * xi + lbi * xr + bui;
                xr = nxr; xi = nxi;
                xb[par * 128 + p] = xr; xb[par * 128 + 64 + p] = xi;
                __syncthreads();
                float y = 0.f;
#pragma unroll
                for (int j4 = 0; j4 < 4; ++j4) { const f32x4 vr = *(const LAS f32x4*)(xb + par * 128 + pt * 16 + j4 * 4), vi = *(const LAS f32x4*)(xb + par * 128 + 64 + pt * 16 + j4 * 4);
#pragma unroll
                    for (int j = 0; j < 4; ++j) y += cr[j4 * 4 + j] * vr[j] - ci[j4 * 4 + j] * vi[j]; }
                y += shx(y, 16, p); y += shx(y, 32, p);
                if (p < 16) yb[t * 16 + p] = y;
                par ^= 1;
            }
            __syncthreads();
            { u32x4 w0, w1; const LAS float* ys = yb + p * 16;
              w0.x = pg8::cvt_pk_bf16(ys[0], ys[1]); w0.y = pg8::cvt_pk_bf16(ys[2], ys[3]); w0.z = pg8::cvt_pk_bf16(ys[4], ys[5]); w0.w = pg8::cvt_pk_bf16(ys[6], ys[7]);
              w1.x = pg8::cvt_pk_bf16(ys[8], ys[9]); w1.y = pg8::cvt_pk_bf16(ys[10], ys[11]); w1.z = pg8::cvt_pk_bf16(ys[12], ys[13]); w1.w = pg8::cvt_pk_bf16(ys[14], ys[15]);
              bf16_t* yp = Y + (size_t)(row0 + p) * 1024 + g * 16; *(u32x4*)yp = w0; *(u32x4*)(yp + 8) = w1; }
        }
        __syncthreads();
    }
}
DI void ph_s5_post(const Args& a, int l, bf16_t* YF, const bf16_t* YB, const bf16_t* U) {
    const float* dsk = a.in[I_SD] + l * 1024;
    for (size_t i = (size_t)blockIdx.x * NT + ltid(a); i < (size_t)MROWS * 128; i += (size_t)gridDim.x * NT) {
        const size_t off = i * 8; const int c = (int)(off & 1023);
        float f[8], bq[8], u[8]; unpack8(*(const u32x4*)(YF + off), f); unpack8(*(const u32x4*)(YB + off), bq); unpack8(*(const u32x4*)(U + off), u);
        const f32x4 d0 = *(const f32x4*)(dsk + c), d1 = *(const f32x4*)(dsk + c + 4);
        float o[8];
#pragma unroll
        for (int j = 0; j < 4; ++j) { o[j] = gelu_tanh_(f[j] + bq[j] + d0[j] * u[j]); o[4 + j] = gelu_tanh_(f[4 + j] + bq[4 + j] + d1[j] * u[4 + j]); }
        u32x4 w; w.x = pg8::cvt_pk_bf16(o[0], o[1]); w.y = pg8::cvt_pk_bf16(o[2], o[3]); w.z = pg8::cvt_pk_bf16(o[4], o[5]); w.w = pg8::cvt_pk_bf16(o[6], o[7]);
        *(u32x4*)(YF + off) = w;
    }
}

constexpr int S5_T = 16, S5_NCH = MROWS / S5_T  , S5_RG = 2304, S5_PMG = S5_RG / 256;
constexpr size_t SZ_AX = (size_t)64 * S5_RG * 512 * 2, SZ_CW1 = (size_t)64 * 256 * 256 * 2, SZ_CW2 = (size_t)64 * 256 * 512 * 2;
constexpr size_t R5_AX = 0, R5_SZ = SZ_AX, R5_G1 = R5_SZ + SZ_ACT, R5_GLUA = R5_G1 + SZ_ACT, R5_END = R5_GLUA + SZ_ACT;
static_assert(WS_R + R5_END <= WS_END, "S5 stage layout fits the workspace"); static_assert(WS_END <= (size_t)512 * 1024 * 1024, "workspace budget");
static_assert(SZ_CW1 + SZ_CW2 + (size_t)17 * 1024 * 128 * 4 <= SZ_ACT, "S5 constants live in the H region once the last projection from H is done");

struct EpiS1 {
    static constexpr bool PERM = true, AFTER_DRAIN = false;
    bf16_t* AX; bf16_t* SZ; bf16_t* G1;
    __device__ __forceinline__ void operator()(const f32x4 (&acc)[2][2][4][2], const Unit& u, int wr, int wc, int fr, int fq) const {
        const int row0 = u.pm * 256 + wr * 64 + fr, seg = u.pn >> 2;
        const int col0 = (u.pn & 3) * 256 + wc * 32 + 8 * fq;
#pragma unroll
        for (int ai = 0; ai < 2; ++ai)
#pragma unroll
            for (int m = 0; m < 4; ++m) {
                const int r = row0 + ai * 128 + m * 16;
#pragma unroll
                for (int bj = 0; bj < 2; ++bj) {
                    f32x4 v0 = acc[ai][bj][m][0], v1 = acc[ai][bj][m][1];
                    const int c = col0 + bj * 128;
                    bf16_t* dp;
                    if (seg == 0) dp = AX + ((size_t)(c >> 4) * S5_RG + (r >> 4)) * 512 + (r & 15) * 16 + (c & 15);
                    else if (seg == 1) { dp = SZ + (size_t)r * 1024 + c;
#pragma unroll
                        for (int j = 0; j < 4; ++j) { v0[j] = siluf_(v0[j]); v1[j] = siluf_(v1[j]); } }
                    else { dp = G1 + (size_t)r * 1024 + c;
#pragma unroll
                        for (int j = 0; j < 4; ++j) { v0[j] = sigmoidf_(v0[j]); v1[j] = sigmoidf_(v1[j]); } }
                    u32x4 w; w.x = pg8::cvt_pk_bf16(v0[0], v0[1]); w.y = pg8::cvt_pk_bf16(v0[2], v0[3]); w.z = pg8::cvt_pk_bf16(v1[0], v1[1]); w.w = pg8::cvt_pk_bf16(v1[2], v1[3]);
                    *(u32x4*)dp = w;
                }
            }
    }
};
struct EpiS5L {
    static constexpr bool PERM = true, AFTER_DRAIN = false;
    bf16_t* AX;
    __device__ __forceinline__ void operator()(const f32x4 (&acc)[2][2][4][2], const Unit& u, int wr, int wc, int fr, int fq) const {
        const int g = u.pm / S5_PMG, rg0 = (u.pm % S5_PMG) * 256 + wr * 64 + fr, col0 = wc * 32 + 8 * fq;
#pragma unroll
        for (int ai = 0; ai < 2; ++ai)
#pragma unroll
            for (int m = 0; m < 4; ++m) {
                const int rg = rg0 + ai * 128 + m * 16;
                if (rg < S5_NCH) {
                    bf16_t* rp = AX + ((size_t)g * S5_RG + rg) * 512 + 256 + col0;
#pragma unroll
                    for (int bj = 0; bj < 2; ++bj) { const f32x4 v0 = acc[ai][bj][m][0], v1 = acc[ai][bj][m][1];
                        u32x4 w; w.x = pg8::cvt_pk_bf16(v0[0], v0[1]); w.y = pg8::cvt_pk_bf16(v0[2], v0[3]); w.z = pg8::cvt_pk_bf16(v1[0], v1[1]); w.w = pg8::cvt_pk_bf16(v1[2], v1[3]);
                        *(u32x4*)(rp + bj * 128) = w; }
                }
            }
    }
};
struct EpiS5Y {
    static constexpr bool PERM = true, AFTER_DRAIN = false;
    const bf16_t* AX; bf16_t* GLUA; const float* dsk;
    __device__ __forceinline__ void operator()(const f32x4 (&acc)[2][2][4][2], const Unit& u, int wr, int wc, int fr, int fq) const {
        const int g = u.pm / S5_PMG, rg0 = (u.pm % S5_PMG) * 256 + wr * 64 + fr, col0 = wc * 32 + 8 * fq;
        const int h0 = col0 & 15;
        const f32x4 d0 = *(const f32x4*)(dsk + g * 16 + h0), d1 = *(const f32x4*)(dsk + g * 16 + h0 + 4);
#pragma unroll
        for (int ai = 0; ai < 2; ++ai)
#pragma unroll
            for (int m = 0; m < 4; ++m) {
                const int rg = rg0 + ai * 128 + m * 16;
                if (rg < S5_NCH) {
#pragma unroll
                    for (int bj = 0; bj < 2; ++bj) {
                        const int c = col0 + bj * 128, t = c >> 4;
                        float uu[8]; unpack8(*(const u32x4*)(AX + ((size_t)g * S5_RG + rg) * 512 + c), uu);
                        const f32x4 v0 = acc[ai][bj][m][0], v1 = acc[ai][bj][m][1];
                        float o[8];
#pragma unroll
                        for (int j = 0; j < 4; ++j) { o[j] = gelu_tanh_(v0[j] + d0[j] * uu[j]); o[4 + j] = gelu_tanh_(v1[j] + d1[j] * uu[4 + j]); }
                        u32x4 w; w.x = pg8::cvt_pk_bf16(o[0], o[1]); w.y = pg8::cvt_pk_bf16(o[2], o[3]); w.z = pg8::cvt_pk_bf16(o[4], o[5]); w.w = pg8::cvt_pk_bf16(o[6], o[7]);
                        *(u32x4*)(GLUA + (size_t)(rg * 16 + t) * 1024 + g * 16 + h0) = w;
                    }
                }
            }
    }
};
DI void ph_s5_consts(const Args& a, int l, bf16_t* CW1, bf16_t* CW2, LAS unsigned char* lds) {
    LAS float* POW = (LAS float*)lds;
    LAS float* BB = POW + 2 * 17 * 64 * 2;
    LAS float* CC = BB + 2 * 64 * 16 * 2;
    LAS float* KT = CC + 16 * 64 * 2;
    const int tid = ltid(a);
    for (int g = blockIdx.x; g < 64; g += gridDim.x) {
        __syncthreads();
        for (int i = tid; i < 2 * 17 * 64; i += NT) {
            const int p = i & 63, j = (i >> 6) % 17, d = i / (17 * 64);
            const float stp = expf(a.in[I_SLOG][(l * 2 + d) * 64 + g]);
            const float lre = a.in[I_SLRE][((size_t)(l * 2 + d) * 64 + g) * 64 + p], lim = a.in[I_SLIM][((size_t)(l * 2 + d) * 64 + g) * 64 + p];
            const float mag = expf((float)j * lre * stp), ang = (float)j * (lim * stp);
            POW[i * 2] = mag * cosf(ang); POW[i * 2 + 1] = mag * sinf(ang);
        }
        for (int i = tid; i < 16 * 64; i += NT) { const int p = i & 63, h = i >> 6;
            CC[i * 2] = a.in[I_SCRE][(((size_t)l * 64 + g) * 16 + h) * 64 + p]; CC[i * 2 + 1] = a.in[I_SCIM][(((size_t)l * 64 + g) * 16 + h) * 64 + p]; }
        __syncthreads();
        for (int i = tid; i < 2 * 64 * 16; i += NT) {
            const int h = i & 15, p = (i >> 4) & 63, d = i >> 10;
            const float stp = expf(a.in[I_SLOG][(l * 2 + d) * 64 + g]);
            const float lre = a.in[I_SLRE][((size_t)(l * 2 + d) * 64 + g) * 64 + p], lim = a.in[I_SLIM][((size_t)(l * 2 + d) * 64 + g) * 64 + p];
            const float lbr = POW[((d * 17 + 1) * 64 + p) * 2], lbi = POW[((d * 17 + 1) * 64 + p) * 2 + 1];
            const float dnm = lre * lre + lim * lim;
            const float fre = ((lbr - 1.0f) * lre + lbi * lim) / dnm, fim = (lbi * lre - (lbr - 1.0f) * lim) / dnm;
            const float br = a.in[I_SBRE][(((size_t)l * 64 + g) * 64 + p) * 16 + h], bi = a.in[I_SBIM][(((size_t)l * 64 + g) * 64 + p) * 16 + h];
            BB[i * 2] = fre * br - fim * bi; BB[i * 2 + 1] = fre * bi + fim * br;
        }
        __syncthreads();
        { const int hp = tid & 15, h = (tid >> 4) & 15, d = tid >> 8;
          float kt[16];
#pragma unroll
          for (int tau = 0; tau < 16; ++tau) kt[tau] = 0.f;
          for (int p = 0; p < 64; ++p) {
              const float cr = CC[(h * 64 + p) * 2], ci = CC[(h * 64 + p) * 2 + 1];
              const float br = BB[((d * 64 + p) * 16 + hp) * 2], bi = BB[((d * 64 + p) * 16 + hp) * 2 + 1];
              const float gr = cr * br - ci * bi, gi = cr * bi + ci * br;
#pragma unroll
              for (int tau = 0; tau < 16; ++tau) { const float pr = POW[((d * 17 + tau) * 64 + p) * 2], pi = POW[((d * 17 + tau) * 64 + p) * 2 + 1]; kt[tau] += gr * pr - gi * pi; } }
#pragma unroll
          for (int tau = 0; tau < 16; ++tau) KT[((d * 16 + tau) * 16 + h) * 16 + hp] = kt[tau]; }
        __syncthreads();
        bf16_t* c1 = CW1 + (size_t)g * 65536;
        for (int i = tid; i < 65536 / 2; i += NT) {
            const int k = (i * 2) & 255, n = (i * 2) >> 8; const int p = n & 63, ri = (n >> 6) & 1, d = n >> 7, s = k >> 4, hp = k & 15;
            const int j = d ? s : 15 - s;
            const float pr = POW[((d * 17 + j) * 64 + p) * 2], pi = POW[((d * 17 + j) * 64 + p) * 2 + 1];
            float o[2];
#pragma unroll
            for (int q = 0; q < 2; ++q) { const float br = BB[((d * 64 + p) * 16 + hp + q) * 2], bi = BB[((d * 64 + p) * 16 + hp + q) * 2 + 1]; o[q] = ri ? (pr * bi + pi * br) : (pr * br - pi * bi); }
            *(unsigned*)(c1 + (size_t)n * 256 + k) = pg8::cvt_pk_bf16(o[0], o[1]);
        }
        bf16_t* c2 = CW2 + (size_t)g * 131072;
        for (int i = tid; i < 131072 / 2; i += NT) {
            const int k = (i * 2) & 511, n = (i * 2) >> 9; const int t = n >> 4, h = n & 15;
            float o[2];
            if (k < 256) { const int s = k >> 4, hp = k & 15;
#pragma unroll
                for (int q = 0; q < 2; ++q) { float v = 0.f; if (s <= t) v += KT[((0 * 16 + (t - s)) * 16 + h) * 16 + hp + q]; if (s >= t) v += KT[((1 * 16 + (s - t)) * 16 + h) * 16 + hp + q]; o[q] = v; } }
            else { const int kk = k - 256, d = kk >> 7, ri = (kk >> 6) & 1; const int j = d ? 16 - t : t + 1;
#pragma unroll
                for (int q = 0; q < 2; ++q) { const int p = (kk & 63) + q; const float cr = CC[(h * 64 + p) * 2], ci = CC[(h * 64 + p) * 2 + 1];
                    const float pr = POW[((d * 17 + j) * 64 + p) * 2], pi = POW[((d * 17 + j) * 64 + p) * 2 + 1];
                    o[q] = ri ? -(cr * pi + ci * pr) : (cr * pr - ci * pi); } }
            *(unsigned*)(c2 + (size_t)n * 512 + k) = pg8::cvt_pk_bf16(o[0], o[1]);
        }
    }
    __syncthreads();
}
DI int s5_row(int b, int d, int st) { const int cc = (st < 16) ? (d ? 15 - st : st) : (d ? 271 - st : st - 16); return (st < 16) ? b * 16 + cc : 128 + b * 256 + cc; }
DI void s5_lane_consts(const Args& a, int l, int d, int g, int p, float& ar, float& ai) {
    const float stp = expf(a.in[I_SLOG][(l * 2 + d) * 64 + g]);
    const float lre = a.in[I_SLRE][((size_t)(l * 2 + d) * 64 + g) * 64 + p], lim = a.in[I_SLIM][((size_t)(l * 2 + d) * 64 + g) * 64 + p];
    const float mag = expf(16.0f * lre * stp), ang = 16.0f * (lim * stp);
    ar = mag * cosf(ang); ai = mag * sinf(ang);
}
DI void ph_s5_carry1(const Args& a, int l, bf16_t* AX, float* SEG) {
    const int tid = ltid(a), w = tid >> 6, p = tid & 63;
    for (int item = blockIdx.x * 8 + w; item < 17 * 1024; item += gridDim.x * 8) {
        const int unit = item & 1023, seg = item >> 10, d = unit & 1, g = (unit >> 1) & 63, b = unit >> 7;
        float ar, ai; s5_lane_consts(a, l, d, g, p, ar, ai);
        bf16_t* base = AX + (size_t)g * S5_RG * 512 + 256 + d * 128 + p;
        float lr[16], li[16];
#pragma unroll
        for (int q = 0; q < 16; ++q) { const size_t o = (size_t)s5_row(b, d, seg * 16 + q) * 512; lr[q] = bf2f(base[o]); li[q] = bf2f(base[o + 64]); }
        float xr = 0.f, xi = 0.f;
#pragma unroll
        for (int q = 0; q < 16; ++q) { const size_t o = (size_t)s5_row(b, d, seg * 16 + q) * 512;
            base[o] = f2bf(xr); base[o + 64] = f2bf(xi);
            const float nr = ar * xr - ai * xi + lr[q], ni = ar * xi + ai * xr + li[q]; xr = nr; xi = ni; }
        SEG[((size_t)seg * 1024 + unit) * 128 + p] = xr; SEG[((size_t)seg * 1024 + unit) * 128 + 64 + p] = xi;
    }
}
DI void ph_s5_carry2(const Args& a, int l, bf16_t* AX, const float* SEG) {
    const int tid = ltid(a), w = tid >> 6, p = tid & 63;
    for (int item = blockIdx.x * 8 + w; item < 16 * 1024; item += gridDim.x * 8) {
        const int unit = item & 1023, seg = 1 + (item >> 10), d = unit & 1, g = (unit >> 1) & 63, b = unit >> 7;
        float ar, ai; s5_lane_consts(a, l, d, g, p, ar, ai);
        float sr = ar, si = ai;
#pragma unroll
        for (int q = 0; q < 4; ++q) { const float nr = sr * sr - si * si, ni = 2.0f * sr * si; sr = nr; si = ni; }
        float xr = 0.f, xi = 0.f;
        { float er[16], ei[16];
#pragma unroll
          for (int s2 = 0; s2 < 16; ++s2) { const bool on = s2 < seg; er[s2] = on ? SEG[((size_t)s2 * 1024 + unit) * 128 + p] : 0.f; ei[s2] = on ? SEG[((size_t)s2 * 1024 + unit) * 128 + 64 + p] : 0.f; }
#pragma unroll
          for (int s2 = 0; s2 < 16; ++s2) if (s2 < seg) { const float nr = sr * xr - si * xi + er[s2], ni = sr * xi + si * xr + ei[s2]; xr = nr; xi = ni; } }
        bf16_t* base = AX + (size_t)g * S5_RG * 512 + 256 + d * 128 + p;
        float lr[16], li[16];
#pragma unroll
        for (int q = 0; q < 16; ++q) { const size_t o = (size_t)s5_row(b, d, seg * 16 + q) * 512; lr[q] = bf2f(base[o]); li[q] = bf2f(base[o + 64]); }
#pragma unroll
        for (int q = 0; q < 16; ++q) { const size_t o = (size_t)s5_row(b, d, seg * 16 + q) * 512;
            base[o] = f2bf(lr[q] + xr); base[o + 64] = f2bf(li[q] + xi);
            const float nr = ar * xr - ai * xi, ni = ar * xi + ai * xr; xr = nr; xi = ni; }
    }
}

#ifndef SUBDUP
#define SUBDUP 0
#endif
typedef short bf16x8v __attribute__((ext_vector_type(8)));
typedef short s16x4v __attribute__((ext_vector_type(4)));
typedef __bf16 bfx2_t __attribute__((ext_vector_type(2)));
typedef float f32x2_t __attribute__((ext_vector_type(2)));
#define MFMA16(a_, b_, c_) __builtin_amdgcn_mfma_f32_16x16x32_bf16((a_), (b_), (c_), 0, 0, 0)
DI unsigned pk2(float lo, float hi) { const bfx2_t v = __builtin_convertvector((f32x2_t){lo, hi}, bfx2_t); return __builtin_bit_cast(unsigned, v); }
DI int sw512(int r, int cb) { return r * 512 + (cb ^ ((r & 15) << 4)); }
DI int sw128(int r, int cb) { return r * 128 + (cb ^ ((r & 7) << 4)); }
DI bf16x8v ldsfrag(LAS unsigned char* base, int off) { return *(const LAS bf16x8v*)(base + off); }
DI bf16x8v ldsfrag2(LAS unsigned char* base, int off0, int off1) { const s16x4v lo = *(const LAS s16x4v*)(base + off0), hi = *(const LAS s16x4v*)(base + off1); return __builtin_shufflevector(lo, hi, 0, 1, 2, 3, 4, 5, 6, 7); }
constexpr int ML_GSET = 448;
DI void ml_gates(float igr, float fgr, float ibias, float fbias, int d, float& ms, LAS float* gs, int L) {
    asm volatile("" : "+v"(L));
    const int t = d ? 63 - L : L;
    const float ipv = igr + ibias, lfv = -softplusf_(-(fgr + fbias));
    const float bc = dpp_scan_sum(lfv);
    const float aj = ipv - bc;
    const float cm = dpp_scan_max(aj);
    const float mt = fmaxf(bc + ms, bc + cm);
    const float bend = lane63(bc);
    const float le = bend - bc + ipv;
    const float mle = lane63(dpp_scan_max(le));
    const float mnew = fmaxf(bend + ms, mle);
    gs[t] = bc; gs[64 + t] = aj; gs[128 + t] = mt; gs[192 + t] = __expf(bc + ms - mt); gs[256 + t] = __expf(-mt); gs[320 + t] = __expf(le - mnew) * 0.0625f;
    if (L == 0) gs[384] = __expf(bend + ms - mnew);
    ms = mnew;
}
DI bf16x8v ldstr2(LAS unsigned char* p0, LAS unsigned char* p1) {
    const s16x4v lo = __builtin_amdgcn_ds_read_tr16_b64_v4i16((LAS s16x4v*)p0), hi = __builtin_amdgcn_ds_read_tr16_b64_v4i16((LAS s16x4v*)p1);
    return __builtin_shufflevector(lo, hi, 0, 1, 2, 3, 4, 5, 6, 7); }
DI void ph_ml_scan_mfma(const Args& a, int l, const bf16_t* Q, const bf16_t* K, const bf16_t* V, const float* GATE, bf16_t* HF, bf16_t* HB, LAS unsigned char* lds) {
    constexpr int PQ = 528, PK = 544, PV = 160, PW = 144;
    LAS unsigned char* qs = lds;
    LAS unsigned char* kn = lds + 33792;
    LAS unsigned char* vn = lds + 68608;
    LAS unsigned char* vs = lds + 78848;
    LAS unsigned char* Wm = lds + 89088;
    LAS float* sm = (LAS float*)(lds + 98304);
    LAS float* rsW = sm + 2 * ML_GSET; LAS float* qn = rsW + 128; LAS float* nvec = qn + 64;
    const int tid = ltid(a), w = tid >> 6, ln = tid & 63, l16 = ln & 15, h4 = ln >> 4, tq = (ln & 15) >> 2, tp = ln & 3;
    for (int unit = blockIdx.x; unit < 256; unit += gridDim.x) {
        const int eh = unit & 3, d = (unit >> 2) & 1, hd = (unit >> 3) & 3, b = unit >> 5;
        const float ibias = a.in[I_MIB][(l * 2 + d) * 4 + hd], fbias = a.in[I_MFB][(l * 2 + d) * 4 + hd];
        bf16_t* HO = d ? HB : HF;
        f32x4 Cacc[16];
#pragma unroll
        for (int i = 0; i < 16; ++i) Cacc[i] = (f32x4){0.f, 0.f, 0.f, 0.f};
        float ms = 0.f;
        __syncthreads();
        if (tid < 256) nvec[tid] = 0.f;
#define ML_ROW0(step) (((step) < 4) ? b * 256 + (d ? 3 - (step) : (step)) * 64 : CTXROWS + b * 4096 + (d ? 67 - (step) : (step) - 4) * 64)
        u32x4 pq[4], pk[4], pv[1]; float gi = 0.f, gf = 0.f;
        { const int row0 = ML_ROW0(0);
#pragma unroll
          for (int q = 0; q < 4; ++q) { const int p = tid + 512 * q, r = p >> 5, c8 = p & 31; pq[q] = *(const u32x4*)(Q + (size_t)(row0 + r) * 1024 + hd * 256 + c8 * 8); pk[q] = *(const u32x4*)(K + (size_t)(row0 + r) * 1024 + hd * 256 + c8 * 8); }
#pragma unroll
          for (int q = 0; q < 1; ++q) { const int r = tid >> 3, c8 = tid & 7; pv[q] = *(const u32x4*)(V + (size_t)(row0 + r) * 1024 + hd * 256 + eh * 64 + c8 * 8); }
          if (w == 7) { const int t = d ? 63 - ln : ln; const float* gp = GATE + (size_t)(row0 + t) * 32; gi = gp[d * 4 + hd]; gf = gp[8 + d * 4 + hd]; ml_gates(gi, gf, ibias, fbias, d, ms, sm, ln); } }
        __syncthreads();
        for (int step = 0; step < 68; ++step) {
            const int par = step & 1; LAS float* gs = sm + par * ML_GSET;
            const int row0 = ML_ROW0(step);
            for (int sr_ = 0; sr_ < (SUBDUP == 12 ? 2 : 1); ++sr_) {
#pragma unroll
            for (int q = 0; q < 4; ++q) { const int p = tid + 512 * q, r = p >> 5, c8 = p & 31;
                *(LAS u32x4*)(qs + r * PQ + c8 * 16) = pq[q]; *(LAS u32x4*)(kn + r * PK + c8 * 16) = pk[q]; }
#pragma unroll
            for (int q = 0; q < 1; ++q) { const int r = tid >> 3, c8 = tid & 7;
                *(LAS u32x4*)(vn + r * PV + c8 * 16) = pv[q];
                float f[8]; unpack8(pv[q], f); const float ws = gs[320 + r];
                u32x4 o; o.x = pk2(f[0] * ws, f[1] * ws); o.y = pk2(f[2] * ws, f[3] * ws); o.z = pk2(f[4] * ws, f[5] * ws); o.w = pk2(f[6] * ws, f[7] * ws);
                *(LAS u32x4*)(vs + r * PV + c8 * 16) = o; }
            }
            if (step + 1 < 68) { const int rown = ML_ROW0(step + 1);
#pragma unroll
                for (int q = 0; q < 4; ++q) { const int p = tid + 512 * q, r = p >> 5, c8 = p & 31; pq[q] = *(const u32x4*)(Q + (size_t)(rown + r) * 1024 + hd * 256 + c8 * 8); pk[q] = *(const u32x4*)(K + (size_t)(rown + r) * 1024 + hd * 256 + c8 * 8); }
#pragma unroll
                for (int q = 0; q < 1; ++q) { const int r = tid >> 3, c8 = tid & 7; pv[q] = *(const u32x4*)(V + (size_t)(rown + r) * 1024 + hd * 256 + eh * 64 + c8 * 8); }
                if (w == 7) { const int t = d ? 63 - ln : ln; const float* gp = GATE + (size_t)(rown + t) * 32; gi = gp[d * 4 + hd]; gf = gp[8 + d * 4 + hd]; } }
            lds_barrier();
            for (int sr_ = 0; sr_ < (SUBDUP == 11 ? 2 : 1); ++sr_) { const int it = w >> 1, jp = w & 1, i = it * 16 + l16;
              f32x4 a0 = (f32x4){0.f, 0.f, 0.f, 0.f}, a1 = a0;
              LAS unsigned char* qb = qs + (it * 16 + l16) * PQ + h4 * 16; LAS unsigned char* kb = kn + ((2 * jp) * 16 + l16) * PK + h4 * 16;
#pragma unroll
              for (int ks = 0; ks < 8; ++ks) {
                  const bf16x8v bq = ldsfrag(qb, ks * 64);
                  const bf16x8v k0 = ldsfrag(kb, ks * 64), k1 = ldsfrag(kb, 16 * PK + ks * 64);
                  a0 = MFMA16(k0, bq, a0); a1 = MFMA16(k1, bq, a1); }
              const float bci = gs[i], mti = gs[128 + i];
              float rs = 0.f;
#pragma unroll
              for (int t2 = 0; t2 < 2; ++t2) { const int j0 = (2 * jp + t2) * 16 + 4 * h4; const f32x4 ajv = *(const LAS f32x4*)(gs + 64 + j0); const f32x4 av = t2 ? a1 : a0;
                  float wv[4];
#pragma unroll
                  for (int r = 0; r < 4; ++r) { const int j = j0 + r; const bool valid = d ? (j >= i) : (j <= i); const float e = __expf(bci + ajv[r] - mti) * av[r] * 0.0625f; wv[r] = valid ? e : 0.f; rs += wv[r]; }
                  u32x2 pw; pw.x = pk2(wv[0], wv[1]); pw.y = pk2(wv[2], wv[3]);
                  *(LAS u32x2*)(Wm + i * PW + j0 * 2) = pw; }
              int lnl = ln; asm volatile("" : "+v"(lnl)); rs += shx(rs, 16, lnl); rs += shx(rs, 32, lnl);
              if (h4 == 0) rsW[jp * 64 + i] = rs;
              const f32x4 nv = *(const LAS f32x4*)(nvec + 4 * ln);
#pragma unroll
              for (int rr = 0; rr < 8; ++rr) { const int ir = 8 * w + rr; const u32x2 qw = *(const LAS u32x2*)(qs + ir * PQ + 8 * ln);
                  float s = bflo(qw.x) * nv[0] + bfhi(qw.x) * nv[1] + bflo(qw.y) * nv[2] + bfhi(qw.y) * nv[3];
                  s = lane63(dpp_scan_sum(s)); if (ln == 0) qn[ir] = s; } }
            lds_barrier();
            if (w < 4) { f32x4 num[4];
#pragma unroll
              for (int it = 0; it < 4; ++it) num[it] = (f32x4){0.f, 0.f, 0.f, 0.f};
              LAS unsigned char* qb2 = qs + l16 * PQ + 8 * h4;
              { bf16x8v af[4];
#pragma unroll
                for (int it = 0; it < 4; ++it) af[it] = ldsfrag2(qb2, it * 16 * PQ, it * 16 * PQ + 32);
#pragma unroll
                for (int ks = 0; ks < 8; ++ks) {
                    u32x4 bw; bw.x = pk2(Cacc[2 * ks][0], Cacc[2 * ks][1]); bw.y = pk2(Cacc[2 * ks][2], Cacc[2 * ks][3]); bw.z = pk2(Cacc[2 * ks + 1][0], Cacc[2 * ks + 1][1]); bw.w = pk2(Cacc[2 * ks + 1][2], Cacc[2 * ks + 1][3]);
                    const bf16x8v bfr = __builtin_bit_cast(bf16x8v, bw);
                    bf16x8v nf[4];
#pragma unroll
                    for (int it = 0; it < 4; ++it) nf[it] = (ks + 1 < 8) ? ldsfrag2(qb2, it * 16 * PQ + 64 * (ks + 1), it * 16 * PQ + 64 * (ks + 1) + 32) : af[it];
#pragma unroll
                    for (int it = 0; it < 4; ++it) num[it] = MFMA16(af[it], bfr, num[it]);
#pragma unroll
                    for (int it = 0; it < 4; ++it) af[it] = nf[it];
                    asm volatile("" ::: "memory"); } }
#pragma unroll
              for (int it = 0; it < 4; ++it) { const f32x4 wi = *(const LAS f32x4*)(gs + 192 + it * 16 + 4 * h4); num[it] = num[it] * wi; }
              LAS unsigned char* trb = (LAS unsigned char*)0 + (8 * h4 + tq) * PV + 8 * tp + 32 * w;
              bf16x8v bv[2];
#pragma unroll
              for (int kk = 0; kk < 2; ++kk) bv[kk] = ldstr2(vn + (size_t)trb + (32 * kk) * PV, vn + (size_t)trb + (32 * kk + 4) * PV);
              LAS unsigned char* wb = Wm + l16 * PW + 16 * h4;
#pragma unroll
              for (int kk = 0; kk < 2; ++kk)
#pragma unroll
                  for (int it = 0; it < 4; ++it) { const bf16x8v aw = ldsfrag(wb, it * 16 * PW + 64 * kk); num[it] = MFMA16(aw, bv[kk], num[it]); }
              asm volatile("" ::: "memory");
#pragma unroll
              for (int it = 0; it < 4; ++it) { const int i0 = it * 16 + 4 * h4;
                  const f32x4 r0 = *(const LAS f32x4*)(rsW + i0), r1 = *(const LAS f32x4*)(rsW + 64 + i0), wi = *(const LAS f32x4*)(gs + 192 + i0), qv = *(const LAS f32x4*)(qn + i0), nr = *(const LAS f32x4*)(gs + 256 + i0);
#pragma unroll
                  for (int r = 0; r < 4; ++r) { const float den = r0[r] + r1[r] + wi[r] * qv[r]; const float hv = num[it][r] * __builtin_amdgcn_rcpf(fmaxf(fabsf(den), nr[r]));
                      HO[(size_t)(row0 + i0 + r) * 1024 + hd * 256 + eh * 64 + 16 * w + l16] = (bf16_t)(pk2(hv, 0.f) & 0xffffu); } asm volatile("" ::: "memory"); }
              const float decay = gs[384];
              bf16x8v bs[2];
#pragma unroll
              for (int kk = 0; kk < 2; ++kk) bs[kk] = ldstr2(vs + (size_t)trb + (32 * kk) * PV, vs + (size_t)trb + (32 * kk + 4) * PV);
#pragma unroll
              for (int dt = 0; dt < 16; ++dt) Cacc[dt] = Cacc[dt] * decay;
              LAS unsigned char* ktb = kn + (8 * h4 + tq) * PK + 8 * tp;
              { bf16x8v ak0 = ldstr2(ktb, ktb + 4 * PK), ak1 = ldstr2(ktb + 32 * PK, ktb + 36 * PK);
#pragma unroll
                for (int dt = 0; dt < 16; ++dt) {
                    bf16x8v n0 = ak0, n1 = ak1;
                    if (dt + 1 < 16) { n0 = ldstr2(ktb + 32 * (dt + 1), ktb + 4 * PK + 32 * (dt + 1)); n1 = ldstr2(ktb + 32 * PK + 32 * (dt + 1), ktb + 36 * PK + 32 * (dt + 1)); }
                    Cacc[dt] = MFMA16(ak0, bs[0], Cacc[dt]); Cacc[dt] = MFMA16(ak1, bs[1], Cacc[dt]);
                    ak0 = n0; ak1 = n1; asm volatile("" ::: "memory"); } }
            } else { const float decay = gs[384]; const int dn = tid - 256; float s = 0.f;
#pragma unroll 8
                for (int j = 0; j < 64; ++j) s += gs[320 + j] * bf2f(*(const LAS bf16_t*)(kn + j * PK + 2 * dn));
                nvec[dn] = decay * nvec[dn] + s;
                if (w == 7 && step + 1 < 68) ml_gates(gi, gf, ibias, fbias, d, ms, sm + (par ^ 1) * ML_GSET, ln); }
            lds_barrier();
        }
#undef ML_ROW0
    }
}

#ifndef SUBDUP
#define SUBDUP 0
#endif
#define MFMA16K16(a_, b_, c_) __builtin_amdgcn_mfma_f32_16x16x16bf16_1k((a_), (b_), (c_), 0, 0, 0)
DI s16x4v pack4(const f32x4 v) { u32x2 w; w.x = pk2(v[0], v[1]); w.y = pk2(v[2], v[3]); return __builtin_bit_cast(s16x4v, w); }
DI s16x4v lds8(LAS unsigned char* p) { return *(const LAS s16x4v*)p; }
DI s16x4v ldstr1(LAS unsigned char* p) { return __builtin_amdgcn_ds_read_tr16_b64_v4i16((LAS s16x4v*)p); }
constexpr int GD_GSET = 384;
DI void gdn_gates(float araw, float braw, float nea, float dtb, LAS float* gs, int L, int d) {
    asm volatile("" : "+v"(L));
    const int t = d ? 63 - L : L;
    const float gc = dpp_scan_sum(nea * softplusf_(araw + dtb));
    const float gl = lane63(gc);
    gs[t] = gc; gs[64 + t] = sigmoidf_(braw); gs[128 + t] = __expf(gc); gs[192 + t] = __expf(gl - gc);
    if (L == 0) gs[256] = __expf(gl);
}
DI void ph_gdn_scan_mfma(const Args& a, int l, const bf16_t* Q, const bf16_t* K, const bf16_t* V, const float* GATE, bf16_t* OF, bf16_t* OB, LAS unsigned char* lds) {
    constexpr int PQ = 272, PK = 288, PV = 160, PA = 144, PD = 48;
    LAS unsigned char* qh = lds;
    LAS unsigned char* kh = lds + 17408;
    LAS unsigned char* vv = lds + 35840;
    LAS unsigned char* AM = lds + 54272;
    LAS unsigned char* QM = lds + 63488;
    LAS unsigned char* DINV = lds + 72704;
    LAS float* sm = (LAS float*)(lds + 75776);
    LAS float* nAd = (LAS float*)(lds + 78848);
    const int tid = ltid(a), w = tid >> 6, ln = tid & 63, l16 = ln & 15, h4 = ln >> 4, tq = (ln & 15) >> 2, tp = ln & 3;
    for (int unit = blockIdx.x; unit < 256; unit += gridDim.x) {
        const int eh = unit & 1, d = (unit >> 1) & 1, h = (unit >> 2) & 7, b = unit >> 5;
        const float nea = -__expf(a.in[I_GALOG][(l * 2 + d) * 8 + h]), dtb = a.in[I_GDTB][(l * 2 + d) * 8 + h];
        bf16_t* O = d ? OB : OF;
        f32x4 S[8];
#pragma unroll
        for (int i = 0; i < 8; ++i) S[i] = (f32x4){0.f, 0.f, 0.f, 0.f};
#define GD_ROW0(step) (((step) < 4) ? b * 256 + (d ? 3 - (step) : (step)) * 64 : CTXROWS + b * 4096 + (d ? 67 - (step) : (step) - 4) * 64)
        u32x4 pq[2], pk[2], pv[1]; float ga = 0.f, gb = 0.f;
        __syncthreads();
        { const int row0 = GD_ROW0(0);
#pragma unroll
          for (int q = 0; q < 2; ++q) { const int p = tid + 512 * q, r = p >> 4, c8 = p & 15; const size_t go = (size_t)(row0 + r) * 1024 + h * 128 + c8 * 8;
              pq[q] = *(const u32x4*)(Q + go); pk[q] = *(const u32x4*)(K + go); }
          pv[0] = *(const u32x4*)(V + (size_t)(row0 + (tid >> 3)) * 1024 + h * 128 + eh * 64 + (tid & 7) * 8);
          if (w == 5) { const int t = d ? 63 - ln : ln; const float* gp = GATE + (size_t)(row0 + t) * 32; ga = gp[d * 8 + h]; gb = gp[16 + d * 8 + h]; gdn_gates(ga, gb, nea, dtb, sm, ln, d); } }
        __syncthreads();
        for (int step = 0; step < 68; ++step) {
            const int par = step & 1; LAS float* gs = sm + par * GD_GSET;
            const int row0 = GD_ROW0(step);
#pragma unroll
            for (int q = 0; q < 2; ++q) { const int p = tid + 512 * q, r = p >> 4, c8 = p & 15;
                *(LAS u32x4*)(qh + r * PQ + c8 * 16) = pq[q]; *(LAS u32x4*)(kh + r * PK + c8 * 16) = pk[q]; }
            *(LAS u32x4*)(vv + (tid >> 3) * PV + (tid & 7) * 16) = pv[0];
            if (step + 1 < 68) { const int rown = GD_ROW0(step + 1);
#pragma unroll
                for (int q = 0; q < 2; ++q) { const int p = tid + 512 * q, r = p >> 4, c8 = p & 15; const size_t go = (size_t)(rown + r) * 1024 + h * 128 + c8 * 8;
                    pq[q] = *(const u32x4*)(Q + go); pk[q] = *(const u32x4*)(K + go); }
                pv[0] = *(const u32x4*)(V + (size_t)(rown + (tid >> 3)) * 1024 + h * 128 + eh * 64 + (tid & 7) * 8);
                if (w == 5) { const int t = d ? 63 - ln : ln; const float* gp = GATE + (size_t)(rown + t) * 32; ga = gp[d * 8 + h]; gb = gp[16 + d * 8 + h]; } }
            lds_barrier(); if (SUBDUP == 5) lds_barrier();
            for (int sr_ = 0; sr_ < (SUBDUP == 1 ? 2 : 1); ++sr_) { const int it = w >> 1, jp = w & 1, i = it * 16 + l16;
              f32x4 kk0 = (f32x4){0.f, 0.f, 0.f, 0.f}, kk1 = kk0, qk0 = kk0, qk1 = kk0;
              LAS unsigned char* kb = kh + ((2 * jp) * 16 + l16) * PK + h4 * 16; LAS unsigned char* xk = kh + i * PK + h4 * 16; LAS unsigned char* xq = qh + i * PQ + h4 * 16;
#pragma unroll
              for (int ks = 0; ks < 4; ++ks) { const bf16x8v a0 = ldsfrag(kb, ks * 64), a1 = ldsfrag(kb, 16 * PK + ks * 64), bk = ldsfrag(xk, ks * 64), bq = ldsfrag(xq, ks * 64);
                  kk0 = MFMA16(a0, bk, kk0); kk1 = MFMA16(a1, bk, kk1); qk0 = MFMA16(a0, bq, qk0); qk1 = MFMA16(a1, bq, qk1); }
              const float gci = gs[i], bi = gs[64 + i];
#pragma unroll
              for (int t2 = 0; t2 < 2; ++t2) { const int j0 = (2 * jp + t2) * 16 + 4 * h4; const f32x4 gcj = *(const LAS f32x4*)(gs + j0); const f32x4 kkv = t2 ? kk1 : kk0, qkv = t2 ? qk1 : qk0;
                  float am[4], qm[4];
#pragma unroll
                  for (int r = 0; r < 4; ++r) { const int j = j0 + r; const bool valid = d ? (j >= i) : (j <= i); const float e = __expf(gci - gcj[r]);
                      am[r] = (valid && j != i) ? -bi * kkv[r] * e : 0.f; qm[r] = valid ? qkv[r] * e : 0.f; }
                  u32x2 pa, pm; pa.x = pk2(am[0], am[1]); pa.y = pk2(am[2], am[3]); pm.x = pk2(qm[0], qm[1]); pm.y = pk2(qm[2], qm[3]);
                  *(LAS u32x2*)(AM + i * PA + j0 * 2) = pa; *(LAS u32x2*)(QM + i * PA + j0 * 2) = pm;
                  if (2 * jp + t2 == it) { const int ipos = d ? 15 - l16 : l16;
#pragma unroll
                      for (int r = 0; r < 4; ++r) { const int jpos = d ? 15 - (4 * h4 + r) : 4 * h4 + r; nAd[(it * 16 + ipos) * 16 + jpos] = am[r]; } } } }
            lds_barrier(); if (SUBDUP == 5) lds_barrier();
            for (int sr_ = 0; sr_ < (SUBDUP == 2 ? 2 : 1); ++sr_) if (w == 4) { const int I = ln >> 4, c = ln & 15, cp = d ? 15 - c : c;
                float Dr[16];
                Dr[0] = (cp == 0) ? 1.f : 0.f;
#pragma unroll
                for (int ip = 1; ip < 16; ++ip) {
                    float av[16];
#pragma unroll
                    for (int q4 = 0; q4 < 4; ++q4) { if (q4 * 4 < ip) { const f32x4 x = *(const LAS f32x4*)(nAd + (I * 16 + ip) * 16 + q4 * 4); av[q4 * 4] = x[0]; av[q4 * 4 + 1] = x[1]; av[q4 * 4 + 2] = x[2]; av[q4 * 4 + 3] = x[3]; } }
                    float s = (cp == ip) ? 1.f : 0.f;
#pragma unroll
                    for (int jq = 0; jq < ip; ++jq) s += av[jq] * Dr[jq];
                    Dr[ip] = s; }
#pragma unroll
                for (int ip = 0; ip < 16; ++ip) { const int r = d ? 15 - ip : ip; *(LAS bf16_t*)(DINV + (16 * I + r) * PD + 2 * c) = (bf16_t)(pk2(Dr[ip], 0.f) & 0xffffu); } }
            s16x4v sf[8];
            f32x4 Rt[4], Qs[4];
            if (w < 4) {
#pragma unroll
            for (int dt = 0; dt < 8; ++dt) sf[dt] = pack4(S[dt]);
#pragma unroll
            for (int Tp = 0; Tp < 4; ++Tp) { const int ro = 16 * (d ? 3 - Tp : Tp);
                f32x4 ksv = (f32x4){0.f, 0.f, 0.f, 0.f}, qsv = ksv;
                LAS unsigned char* ka = kh + (ro + l16) * PK + 8 * h4; LAS unsigned char* qa = qh + (ro + l16) * PQ + 8 * h4;
#pragma unroll
                for (int dt = 0; dt < 8; ++dt) { ksv = MFMA16K16(lds8(ka + 32 * dt), sf[dt], ksv); qsv = MFMA16K16(lds8(qa + 32 * dt), sf[dt], qsv); }
                const s16x4v v4 = ldstr1(vv + (ro + 4 * h4 + tq) * PV + (16 * w + 4 * tp) * 2);
                const f32x4 be = *(const LAS f32x4*)(gs + 64 + ro + 4 * h4), eg = *(const LAS f32x4*)(gs + 128 + ro + 4 * h4);
#pragma unroll
                for (int r = 0; r < 4; ++r) { Rt[Tp][r] = be[r] * (bf2f((bf16_t)v4[r]) - eg[r] * ksv[r]); Qs[Tp][r] = eg[r] * qsv[r]; }
                asm volatile("" ::: "memory"); } }
            lds_barrier(); if (SUBDUP == 5) lds_barrier();
            if (w < 4) { s16x4v vf[4]; f32x4 vn[4];
#pragma unroll
              for (int Tp = 0; Tp < 4; ++Tp) { const int ro = 16 * (d ? 3 - Tp : Tp);
                  f32x4 X = Rt[Tp];
#pragma unroll
                  for (int Jp = 0; Jp < Tp; ++Jp) { const int co = 16 * (d ? 3 - Jp : Jp); X = MFMA16K16(lds8(AM + (ro + l16) * PA + (co + 4 * h4) * 2), vf[Jp], X); }
                  const s16x4v xf = pack4(X);
                  vn[Tp] = MFMA16K16(lds8(DINV + (ro + l16) * PD + 8 * h4), xf, ((f32x4){0.f, 0.f, 0.f, 0.f}));
                  vf[Tp] = pack4(vn[Tp]); }
#pragma unroll
              for (int Tp = 0; Tp < 4; ++Tp) { const int ro = 16 * (d ? 3 - Tp : Tp);
                  f32x4 o = Qs[Tp];
#pragma unroll
                  for (int Jp = 0; Jp <= Tp; ++Jp) { const int co = 16 * (d ? 3 - Jp : Jp); o = MFMA16K16(lds8(QM + (ro + l16) * PA + (co + 4 * h4) * 2), vf[Jp], o); }
#pragma unroll
                  for (int r = 0; r < 4; ++r) O[(size_t)(row0 + ro + 4 * h4 + r) * 1024 + h * 128 + eh * 64 + 16 * w + l16] = (bf16_t)(pk2(o[r], 0.f) & 0xffffu);
                  asm volatile("" ::: "memory"); }
              const float gend = gs[256];
              s16x4v vsf[4];
#pragma unroll
              for (int Jp = 0; Jp < 4; ++Jp) { const int co = 16 * (d ? 3 - Jp : Jp); const f32x4 ee = *(const LAS f32x4*)(gs + 192 + co + 4 * h4); vsf[Jp] = pack4(vn[Jp] * ee); }
#pragma unroll
              for (int dt = 0; dt < 8; ++dt) { S[dt] = S[dt] * gend;
#pragma unroll
                  for (int Jp = 0; Jp < 4; ++Jp) { const int co = 16 * (d ? 3 - Jp : Jp); S[dt] = MFMA16K16(ldstr1(kh + (co + 4 * h4 + tq) * PK + (16 * dt + 4 * tp) * 2), vsf[Jp], S[dt]); }
                  if (dt & 1) asm volatile("" ::: "memory"); } }
            for (int sr_ = 0; sr_ < (SUBDUP == 3 ? 2 : 1); ++sr_) if (w == 5 && step + 1 < 68) gdn_gates(ga, gb, nea, dtb, sm + (par ^ 1) * GD_GSET, ln, d);
            lds_barrier(); if (SUBDUP == 5) lds_barrier();
        }
#undef GD_ROW0
    }
}

DI void ph_gdn_scan_pipe(const Args& a, int l, const bf16_t* Q, const bf16_t* K, const bf16_t* V, const float* GATE, bf16_t* OF, bf16_t* OB, LAS unsigned char* lds) {
    constexpr int PQ = 272, PK = 288, PV = 160, PA = 144, PD = 48, SETB = 71680;
    constexpr int O_Q = 0, O_K = 17408, O_V = 35840, O_AM = 46080, O_QM = 55296, O_DI = 64512, O_ND = 67584;
    LAS float* sm = (LAS float*)(lds + 2 * SETB);
    const int tid = ltid(a), w = tid >> 6, ln = tid & 63, l16 = ln & 15, h4 = ln >> 4, tq = (ln & 15) >> 2, tp = ln & 3;
    const bool helper = w >= 4; const int ht = tid - 256;
    for (int unit = blockIdx.x; unit < 256; unit += gridDim.x) {
        const int eh = unit & 1, d = (unit >> 1) & 1, h = (unit >> 2) & 7, b = unit >> 5;
        const float nea = -__expf(a.in[I_GALOG][(l * 2 + d) * 8 + h]), dtb = a.in[I_GDTB][(l * 2 + d) * 8 + h];
        bf16_t* O = d ? OB : OF;
        f32x4 S[8];
#pragma unroll
        for (int i = 0; i < 8; ++i) S[i] = (f32x4){0.f, 0.f, 0.f, 0.f};
#define GD_ROW0(step) (((step) < 4) ? b * 256 + (d ? 3 - (step) : (step)) * 64 : CTXROWS + b * 4096 + (d ? 67 - (step) : (step) - 4) * 64)
        f32x4 Rt[4], Qs[4]; float ga = 0.f, gb = 0.f;
#define GD_FETCH(stp) do { const int rw_ = GD_ROW0(stp); \
        _Pragma("unroll") for (int q_ = 0; q_ < 4; ++q_) { const int p_ = ht + 256 * q_, r_ = p_ >> 4, c8_ = p_ & 15; const size_t go_ = (size_t)(rw_ + r_) * 1024 + h * 128 + c8_ * 8; S[q_] = __builtin_bit_cast(f32x4, *(const u32x4*)(Q + go_)); S[4 + q_] = __builtin_bit_cast(f32x4, *(const u32x4*)(K + go_)); } \
        _Pragma("unroll") for (int q_ = 0; q_ < 2; ++q_) { const int p_ = ht + 256 * q_, r_ = p_ >> 3, c8_ = p_ & 7; Qs[q_] = __builtin_bit_cast(f32x4, *(const u32x4*)(V + (size_t)(rw_ + r_) * 1024 + h * 128 + eh * 64 + c8_ * 8)); } \
        if (w == 5) { const int t_ = d ? 63 - ln : ln; const float* gp_ = GATE + (size_t)(rw_ + t_) * 32; ga = gp_[d * 8 + h]; gb = gp_[16 + d * 8 + h]; } } while (0)
#define GD_STAGE(setb) do { \
        _Pragma("unroll") for (int q_ = 0; q_ < 4; ++q_) { const int p_ = ht + 256 * q_, r_ = p_ >> 4, c8_ = p_ & 15; *(LAS f32x4*)((setb) + O_Q + r_ * PQ + c8_ * 16) = S[q_]; *(LAS f32x4*)((setb) + O_K + r_ * PK + c8_ * 16) = S[4 + q_]; } \
        _Pragma("unroll") for (int q_ = 0; q_ < 2; ++q_) { const int p_ = ht + 256 * q_, r_ = p_ >> 3, c8_ = p_ & 7; *(LAS f32x4*)((setb) + O_V + r_ * PV + c8_ * 16) = Qs[q_]; } } while (0)
#define GD_STAGE_A(setb, gsp) do { LAS unsigned char* kh_ = (setb) + O_K; LAS unsigned char* qh_ = (setb) + O_Q; \
        for (int pi_ = w - 4; pi_ < 10; pi_ += 4) {                   \
            const int Tp_ = pi_ < 1 ? 0 : (pi_ < 3 ? 1 : (pi_ < 6 ? 2 : 3)), Jp_ = pi_ - (Tp_ * (Tp_ + 1)) / 2; \
            const int it_ = d ? 3 - Tp_ : Tp_, jt_ = d ? 3 - Jp_ : Jp_, i_ = it_ * 16 + l16; \
            LAS unsigned char* xk_ = kh_ + i_ * PK + h4 * 16; LAS unsigned char* xq_ = qh_ + i_ * PQ + h4 * 16; \
            const float gci_ = (gsp)[i_], bi_ = (gsp)[64 + i_]; \
            LAS unsigned char* kb_ = kh_ + (jt_ * 16 + l16) * PK + h4 * 16; f32x4 kk_ = (f32x4){0.f, 0.f, 0.f, 0.f}, qk_ = kk_; \
            _Pragma("unroll") for (int ks_ = 0; ks_ < 4; ++ks_) { const bf16x8v a0_ = ldsfrag(kb_, ks_ * 64); kk_ = MFMA16(a0_, ldsfrag(xk_, ks_ * 64), kk_); qk_ = MFMA16(a0_, ldsfrag(xq_, ks_ * 64), qk_); } \
            const int j0_ = jt_ * 16 + 4 * h4; const f32x4 gcj_ = *(const LAS f32x4*)((gsp) + j0_); float am_[4], qm_[4]; \
            _Pragma("unroll") for (int r_ = 0; r_ < 4; ++r_) { const int j_ = j0_ + r_; const bool valid_ = d ? (j_ >= i_) : (j_ <= i_); const float e_ = __expf(gci_ - gcj_[r_]); \
                am_[r_] = (valid_ && j_ != i_) ? -bi_ * kk_[r_] * e_ : 0.f; qm_[r_] = valid_ ? qk_[r_] * e_ : 0.f; } \
            u32x2 pa_, pm_; pa_.x = pk2(am_[0], am_[1]); pa_.y = pk2(am_[2], am_[3]); pm_.x = pk2(qm_[0], qm_[1]); pm_.y = pk2(qm_[2], qm_[3]); \
            *(LAS u32x2*)((setb) + O_AM + i_ * PA + j0_ * 2) = pa_; *(LAS u32x2*)((setb) + O_QM + i_ * PA + j0_ * 2) = pm_; \
            if (jt_ == it_) { LAS float* nd_ = (LAS float*)((setb) + O_ND); const int ipos_ = d ? 15 - l16 : l16; \
                _Pragma("unroll") for (int r_ = 0; r_ < 4; ++r_) { const int jpos_ = d ? 15 - (4 * h4 + r_) : 4 * h4 + r_; nd_[(it_ * 16 + ipos_) * 16 + jpos_] = am_[r_]; } } } } while (0)
        __syncthreads();
        if (helper) { GD_FETCH(0); if (w == 5) gdn_gates(ga, gb, nea, dtb, sm, ln, d); GD_STAGE(lds); GD_FETCH(1); }
        __syncthreads();
        if (helper) GD_STAGE_A(lds, sm);
        __syncthreads();
        for (int step = 0; step < 68; ++step) {
            const int X = step & 1; LAS unsigned char* cur = lds + X * SETB; LAS unsigned char* nxt = lds + (X ^ 1) * SETB;
            LAS float* gs = sm + X * GD_GSET; LAS float* gsn = sm + (X ^ 1) * GD_GSET;
            LAS unsigned char* qh = cur + O_Q; LAS unsigned char* kh = cur + O_K; LAS unsigned char* vv = cur + O_V; LAS unsigned char* AM = cur + O_AM; LAS unsigned char* QM = cur + O_QM; LAS unsigned char* DINV = cur + O_DI;
            const int row0 = GD_ROW0(step);
            s16x4v sf[8];
            if (!helper) {
#pragma unroll
                for (int dt = 0; dt < 8; ++dt) sf[dt] = pack4(S[dt]);
#pragma unroll
                for (int Tp = 0; Tp < 4; ++Tp) { const int ro = 16 * (d ? 3 - Tp : Tp);
                    f32x4 ksv = (f32x4){0.f, 0.f, 0.f, 0.f}, qsv = ksv;
                    LAS unsigned char* ka = kh + (ro + l16) * PK + 8 * h4; LAS unsigned char* qa = qh + (ro + l16) * PQ + 8 * h4;
#pragma unroll
                    for (int dt = 0; dt < 8; ++dt) { ksv = MFMA16K16(lds8(ka + 32 * dt), sf[dt], ksv); qsv = MFMA16K16(lds8(qa + 32 * dt), sf[dt], qsv); }
                    const s16x4v v4 = ldstr1(vv + (ro + 4 * h4 + tq) * PV + (16 * w + 4 * tp) * 2);
                    const f32x4 be = *(const LAS f32x4*)(gs + 64 + ro + 4 * h4), eg = *(const LAS f32x4*)(gs + 128 + ro + 4 * h4);
#pragma unroll
                    for (int r = 0; r < 4; ++r) { Rt[Tp][r] = be[r] * (bf2f((bf16_t)v4[r]) - eg[r] * ksv[r]); Qs[Tp][r] = eg[r] * qsv[r]; }
                    asm volatile("" ::: "memory"); }
            } else {
                if (step + 1 < 68) { GD_STAGE(nxt); if (w == 5) gdn_gates(ga, gb, nea, dtb, gsn, ln, d); if (step + 2 < 68) GD_FETCH(step + 2); }
                if (w == 4) { const int I = ln >> 4, c = ln & 15, cp = d ? 15 - c : c; LAS float* nAd = (LAS float*)(cur + O_ND);
                    float Dr[16];
                    Dr[0] = (cp == 0) ? 1.f : 0.f;
#pragma unroll
                    for (int ip = 1; ip < 16; ++ip) {
                        float av[16];
#pragma unroll
                        for (int q4 = 0; q4 < 4; ++q4) { if (q4 * 4 < ip) { const f32x4 x = *(const LAS f32x4*)(nAd + (I * 16 + ip) * 16 + q4 * 4); av[q4 * 4] = x[0]; av[q4 * 4 + 1] = x[1]; av[q4 * 4 + 2] = x[2]; av[q4 * 4 + 3] = x[3]; } }
                        float s = (cp == ip) ? 1.f : 0.f;
#pragma unroll
                        for (int jq = 0; jq < ip; ++jq) s += av[jq] * Dr[jq];
                        Dr[ip] = s; }
#pragma unroll
                    for (int ip = 0; ip < 16; ++ip) { const int r = d ? 15 - ip : ip; *(LAS bf16_t*)(DINV + (16 * I + r) * PD + 2 * c) = (bf16_t)(pk2(Dr[ip], 0.f) & 0xffffu); } }
            }
            lds_barrier();
            if (!helper) { s16x4v vf[4]; f32x4 vn[4];
#pragma unroll
                for (int Tp = 0; Tp < 4; ++Tp) { const int ro = 16 * (d ? 3 - Tp : Tp);
                    f32x4 Xv = Rt[Tp];
#pragma unroll
                    for (int Jp = 0; Jp < Tp; ++Jp) { const int co = 16 * (d ? 3 - Jp : Jp); Xv = MFMA16K16(lds8(AM + (ro + l16) * PA + (co + 4 * h4) * 2), vf[Jp], Xv); }
                    const s16x4v xf = pack4(Xv);
                    vn[Tp] = MFMA16K16(lds8(DINV + (ro + l16) * PD + 8 * h4), xf, ((f32x4){0.f, 0.f, 0.f, 0.f}));
                    vf[Tp] = pack4(vn[Tp]); }
#pragma unroll
                for (int Tp = 0; Tp < 4; ++Tp) { const int ro = 16 * (d ? 3 - Tp : Tp);
                    f32x4 o = Qs[Tp];
#pragma unroll
                    for (int Jp = 0; Jp <= Tp; ++Jp) { const int co = 16 * (d ? 3 - Jp : Jp); o = MFMA16K16(lds8(QM + (ro + l16) * PA + (co + 4 * h4) * 2), vf[Jp], o); }
#pragma unroll
                    for (int r = 0; r < 4; ++r) O[(size_t)(row0 + ro + 4 * h4 + r) * 1024 + h * 128 + eh * 64 + 16 * w + l16] = (bf16_t)(pk2(o[r], 0.f) & 0xffffu);
                    asm volatile("" ::: "memory"); }
                const float gend = gs[256];
                s16x4v vsf[4];
#pragma unroll
                for (int Jp = 0; Jp < 4; ++Jp) { const int co = 16 * (d ? 3 - Jp : Jp); const f32x4 ee = *(const LAS f32x4*)(gs + 192 + co + 4 * h4); vsf[Jp] = pack4(vn[Jp] * ee); }
#pragma unroll
                for (int dt = 0; dt < 8; ++dt) { S[dt] = S[dt] * gend;
#pragma unroll
                    for (int Jp = 0; Jp < 4; ++Jp) { const int co = 16 * (d ? 3 - Jp : Jp); S[dt] = MFMA16K16(ldstr1(kh + (co + 4 * h4 + tq) * PK + (16 * dt + 4 * tp) * 2), vsf[Jp], S[dt]); }
                    if (dt & 1) asm volatile("" ::: "memory"); }
            } else if (step + 1 < 68) GD_STAGE_A(nxt, gsn);
            lds_barrier();
        }
#undef GD_ROW0
#undef GD_FETCH
#undef GD_STAGE
#undef GD_STAGE_A
    }
}

#ifndef DUP_PHASE
#define DUP_PHASE -1
#endif
constexpr int NPH_LAYER = 21, PH_FINAL = 2 + DEPTH * NPH_LAYER, NPHASE = PH_FINAL + 1;
template <class Epi>
DI void run_gemm(int tid, LAS unsigned char* lds, const bf16_t* A, const bf16_t* Bt, int M, int N, const Epi& E) {
    pg8::Gemm g{A, Bt, M, N, 1024, 1024, 1 << 20, 0, tid}; pg8::StaticOrder S; S.init(M, N, (int)gridDim.x, (int)blockIdx.x);
#if defined(GEMM_STAGGER)
    if (blockIdx.x & 8) { const unsigned long long t0 = __builtin_amdgcn_s_memrealtime(); while (__builtin_amdgcn_s_memrealtime() - t0 < GEMM_STAGGER) __builtin_amdgcn_s_sleep(8); }
#endif
    pg8::gemm_phase<Epi, pg8::StaticOrder, false>(lds, g, S, E, nullptr);
}
template <class Epi>
DI void run_gemm_g(int tid, LAS unsigned char* lds, const bf16_t* A, int lda, int K, const bf16_t* Bt, int M, int N, int pmg, size_t gstride, const Epi& E) {
    pg8::Gemm g{A, Bt, M, N, K, lda, pmg, gstride, tid}; pg8::StaticOrder S; S.init(M, N, (int)gridDim.x, (int)blockIdx.x);
    pg8::gemm_phase<Epi, pg8::StaticOrder, false>(lds, g, S, E, nullptr);
}
__global__ void __launch_bounds__(NT, 2) hy_fwd(Args ka) {
    extern __shared__ __attribute__((aligned(16))) unsigned char lds_raw[];
    LAS unsigned char* lds = (LAS unsigned char*)lds_raw;
    volatile LAS unsigned* xbw = (volatile LAS unsigned*)(lds + LDS_BYTES - 256);
    if (threadIdx.x < 4) xbw[threadIdx.x] = 0u;
    __syncthreads();
    const int lo = ka.ph_lo, hi = ka.ph_hi;
    const int s_wid = __builtin_amdgcn_readfirstlane((int)(threadIdx.x >> 6));
    XcdBarrier bar; bar.bar = (unsigned*)(ka.ws + WS_CTL); bar.x = 0u; bar.st = xbw; bar.wid = s_wid;
    if (hi - lo > 1) bar = xcd_barrier_post((unsigned*)(ka.ws + WS_CTL), xbw, s_wid);
#ifdef PH_ONLY
#define PHEN(p) ((p) == PH_ONLY)
#else
#define PHEN(p) 1
#endif
#define IN(k) (lo <= (k) && (k) < hi)
#define INL(p) (PHEN(p) && IN(pb + (p)))
#define REPS(p) ((DUP_PHASE == (p)) ? 2 : 1)
#define SEAM(k) do { if (IN((k) + 1)) { xcd_barrier(bar); if (DUP_PHASE == 200) xcd_barrier(bar); } } while (0)
#define PH_LOAD \
    Args a; __builtin_memcpy(&a, args_ptr(), sizeof(Args)); a.wid = s_wid; \
    unsigned char* ws = a.ws; \
    float* MOD = (float*)(ws + WS_MOD); float* XCTX = (float*)(ws + WS_XCTX); \
    bf16_t* H = (bf16_t*)(ws + WS_H); bf16_t* MERGED = (bf16_t*)(ws + WS_MERGED); \
    bf16_t* WB0 = (bf16_t*)(ws + WS_WB0); bf16_t* WB1 = (bf16_t*)(ws + WS_WB1); \
    unsigned char* R = ws + WS_R; \
    bf16_t* P0 = (bf16_t*)(R + R_P0); bf16_t* P1 = (bf16_t*)(R + R_P1); bf16_t* P2 = (bf16_t*)(R + R_P2); bf16_t* OF = (bf16_t*)(R + R_OF); bf16_t* OB = (bf16_t*)(R + R_OB); \
    float* GATE2 = (float*)(R + R_G2); \
    float* GATE1 = (float*)(ws + WS_MERGED); bf16_t* HALO = (bf16_t*)(ws + WS_MERGED + SZ_GATE);     \
    float* MODP = (float*)R; \
    bf16_t* AX = (bf16_t*)(R + R5_AX); bf16_t* SZ5 = (bf16_t*)(R + R5_SZ); bf16_t* G15 = (bf16_t*)(R + R5_G1); bf16_t* GLUA = (bf16_t*)(R + R5_GLUA); bf16_t* YBR = (bf16_t*)R; \
    bf16_t* CW1 = (bf16_t*)(ws + WS_H); bf16_t* CW2 = (bf16_t*)(ws + WS_H + SZ_CW1); float* SEG5 = (float*)(ws + WS_H + SZ_CW1 + SZ_CW2); \
    const float* xlat_src = l == 0 ? a.in[I_X] : a.out; const float* xctx_src = l == 0 ? a.in[I_CTX] : XCTX; const float* modl = MOD + (size_t)l * 9 * 3072; \
    (void)MOD; (void)XCTX; (void)H; (void)MERGED; (void)WB0; (void)WB1; (void)P0; (void)P1; (void)P2; (void)OF; (void)OB; (void)GATE2; (void)GATE1; (void)HALO; (void)MODP; (void)AX; (void)SZ5; (void)G15; (void)GLUA; (void)YBR; (void)CW1; (void)CW2; (void)SEG5; (void)xlat_src; (void)xctx_src; (void)modl;
    LAS float* ldsf = (LAS float*)lds;

    { const int l = 0;
    if (PHEN(100) && IN(0)) { PH_LOAD; ph_modp(a, MODP, ldsf); SEAM(0); }
    if (PHEN(101) && IN(1)) { PH_LOAD; ph_mod(a, MODP, MOD); SEAM(1); } }
    for (int l = 0; l < DEPTH; ++l) {
        const int pb = 2 + l * NPH_LAYER;
        if (INL(0)) { PH_LOAD; for (int rep_ = 0; rep_ < REPS(0); ++rep_) { ph_norm(a, l, xlat_src, xctx_src, modl, H); ph_cvt(wdesc(a, l, 0), WB0, ldsf); } SEAM(pb + 0); }
        if (INL(1)) { PH_LOAD; for (int rep_ = 0; rep_ < REPS(1); ++rep_) { EpiProj E{P0, 0, GATE1, 12, HALO}; run_gemm(ltid(a), lds, H, WB0, MROWS, 3328, E); } SEAM(pb + 1); }
        if (INL(2)) { PH_LOAD; for (int rep_ = 0; rep_ < REPS(2); ++rep_) { if (DUP_PHASE == 102) ph_gdn_conv(a, l, P0, HALO, lds, OF); ph_gdn_conv(a, l, P0, HALO, lds); ph_cvt(wdesc(a, l, 1), WB1, ldsf); } SEAM(pb + 2); }
        if (INL(3)) { PH_LOAD; for (int rep_ = 0; rep_ < REPS(3); ++rep_) { ph_gdn_scan_pipe(a, l, P0, P1, P2, GATE1, OF, OB, lds); } SEAM(pb + 3); }
        if (INL(4)) { PH_LOAD; for (int rep_ = 0; rep_ < REPS(4); ++rep_) { EpiProj E{P0, 9, nullptr, -1, nullptr}; run_gemm(ltid(a), lds, H, WB1, MROWS, 2048, E); } SEAM(pb + 4); }
        if (INL(5)) { PH_LOAD; for (int rep_ = 0; rep_ < REPS(5); ++rep_) { if (DUP_PHASE == 105) ph_gdn_post(a, l, OF, OB, P0, P2); ph_gdn_post(a, l, OF, OB, P0); ph_cvt(wdesc(a, l, 6), WB0, ldsf); } SEAM(pb + 5); }
        if (INL(6)) { PH_LOAD; for (int rep_ = 0; rep_ < REPS(6); ++rep_) { ph_cvt(wdesc(a, l, 2), WB1, ldsf); EpiBranch E{P1, MERGED, 1}; run_gemm(ltid(a), lds, OF, WB0, MROWS, 1024, E); } SEAM(pb + 6); }
        if (INL(7)) { PH_LOAD; for (int rep_ = 0; rep_ < REPS(7); ++rep_) { ph_cvt(wdesc(a, l, 3), WB0, ldsf); EpiProj E{P0, 0, GATE2, 12, nullptr}; run_gemm(ltid(a), lds, H, WB1, MROWS, 3328, E); } SEAM(pb + 7); }
        if (INL(8)) { PH_LOAD; for (int rep_ = 0; rep_ < REPS(8); ++rep_) { ph_ml_scan_mfma(a, l, P0, P1, P2, GATE2, OF, OB, lds); } SEAM(pb + 8); }
        if (INL(9)) { PH_LOAD; for (int rep_ = 0; rep_ < REPS(9); ++rep_) { ph_cvt(wdesc(a, l, 8), WB1, ldsf); EpiProj E{P0, 38, nullptr, -1, nullptr}; run_gemm(ltid(a), lds, H, WB0, MROWS, 3072, E); } SEAM(pb + 9); }
        if (INL(10)) { PH_LOAD; for (int rep_ = 0; rep_ < REPS(10); ++rep_) { ph_ml_post(a, l, OF, OB, P0, P1); } SEAM(pb + 10); }
        if (INL(11)) { PH_LOAD; for (int rep_ = 0; rep_ < REPS(11); ++rep_) { ph_cvt(wdesc(a, l, 4), WB0, ldsf); EpiBranch E{P2, MERGED, 0}; run_gemm(ltid(a), lds, OF, WB1, MROWS, 1024, E); } SEAM(pb + 11); }
        if (INL(12)) { PH_LOAD; for (int rep_ = 0; rep_ < REPS(12); ++rep_) { ph_cvt(wdesc(a, l, 5), WB1, ldsf); EpiS1 E{AX, SZ5, G15}; run_gemm(ltid(a), lds, H, WB0, MROWS, 3072, E); } SEAM(pb + 12); }
        if (INL(13)) { PH_LOAD; for (int rep_ = 0; rep_ < REPS(13); ++rep_) { ph_s5_consts(a, l, CW1, CW2, lds); ph_cvt(wdesc(a, l, 7), WB0, ldsf); } SEAM(pb + 13); }
        if (INL(14)) { PH_LOAD; for (int rep_ = 0; rep_ < REPS(14); ++rep_) { EpiS5L E{AX}; run_gemm_g(ltid(a), lds, AX, 512, 256, CW1, 64 * S5_RG, 256, S5_PMG, (size_t)256 * 256 * 2, E); } SEAM(pb + 14); }
        if (INL(15)) { PH_LOAD; for (int rep_ = 0; rep_ < REPS(15); ++rep_) { ph_s5_carry1(a, l, AX, SEG5); } SEAM(pb + 15); }
        if (INL(16)) { PH_LOAD; ph_s5_carry2(a, l, AX, SEG5); SEAM(pb + 16); }
        if (INL(17)) { PH_LOAD; for (int rep_ = 0; rep_ < REPS(17); ++rep_) { EpiS5Y E{AX, GLUA, a.in[I_SD] + l * 1024}; run_gemm_g(ltid(a), lds, AX, 512, 512, CW2, 64 * S5_RG, 256, S5_PMG, (size_t)256 * 512 * 2, E); } SEAM(pb + 17); }
        if (INL(18)) { PH_LOAD; for (int rep_ = 0; rep_ < REPS(18); ++rep_) { EpiGlu E{SZ5, YBR, a.in[I_SBGLU] + l * 2048}; run_gemm(ltid(a), lds, GLUA, WB1, MROWS, 2048, E); } SEAM(pb + 18); }
        if (INL(19)) { PH_LOAD; for (int rep_ = 0; rep_ < REPS(19); ++rep_) { ph_cvt(wdesc(a, l, 9), WB1, ldsf); EpiBranch E{G15, MERGED, 0}; run_gemm(ltid(a), lds, YBR, WB0, MROWS, 1024, E); } SEAM(pb + 19); }
        if (INL(20)) { PH_LOAD; for (int rep_ = 0; rep_ < REPS(20); ++rep_) {
            const int ro = (l == DEPTH - 1) ? CTXROWS : 0;
            EpiOut E{xlat_src, a.out, xctx_src, XCTX, modl, l, ro};
            run_gemm(ltid(a), lds, MERGED + (size_t)ro * 1024, WB1, MROWS - ro, 1024, E);
            } SEAM(pb + 20);
        }
    }
    if (PHEN(102) && IN(PH_FINAL)) { const int l = 0; PH_LOAD; ph_final(a, a.out); }
#undef IN
#undef SEAM
#undef PH_LOAD
}
}

#ifndef MK_LAUNCHES
#define MK_LAUNCHES 1
#endif
extern "C" void kernel_launch(void* const* d_in, const int* in_sizes, int n_in, void* d_out, int out_size, void* d_ws, size_t ws_size, hipStream_t stream) {
    static int grid = 0;
    if (grid == 0) {
        if (n_in != 28 || out_size != hy::NBATCH * hy::SEQ * hy::D || ws_size < hy::WS_END) { fprintf(stderr, "kernel_launch: unexpected shapes (n_in %d, out %d, ws %zu < %zu)\n", n_in, out_size, ws_size, (size_t)hy::WS_END); grid = -1; return; }
        int dev = 0, cus = 0, per_cu = 0;
        if (hipGetDevice(&dev) != hipSuccess || hipDeviceGetAttribute(&cus, hipDeviceAttributeMultiprocessorCount, dev) != hipSuccess) { grid = -1; return; }
        if (hipFuncSetAttribute((const void*)hy::hy_fwd, hipFuncAttributeMaxDynamicSharedMemorySize, hy::LDS_BYTES) != hipSuccess) { fprintf(stderr, "kernel_launch: hipFuncSetAttribute failed\n"); grid = -1; return; }
        if (hipOccupancyMaxActiveBlocksPerMultiprocessor(&per_cu, (const void*)hy::hy_fwd, hy::NT, hy::LDS_BYTES) != hipSuccess || per_cu < 1) { fprintf(stderr, "kernel_launch: occupancy query says %d\n", per_cu); (void)hipGetLastError(); }
        grid = cus;
    }
    if (grid < 0) return;
    (void)hipMemsetAsync((char*)d_ws + hy::WS_CTL, 0, 65536, stream);
    hy::Args a{};
    for (int i = 0; i < 28; ++i) a.in[i] = (const float*)d_in[i];
    a.out = (float*)d_out; a.ws = (unsigned char*)d_ws;
#if MK_LAUNCHES == 1
    a.ph_lo = 0; a.ph_hi = hy::NPHASE;
    hipLaunchKernelGGL(hy::hy_fwd, dim3(grid), dim3(hy::NT), hy::LDS_BYTES, stream, a);
#else
    for (int p = 0; p < hy::NPHASE; ++p) { a.ph_lo = p; a.ph_hi = p + 1; hipLaunchKernelGGL(hy::hy_fwd, dim3(grid), dim3(hy::NT), hy::LDS_BYTES, stream, a); }
#endif
}
```

```cpp
#include <hip/hip_runtime.h>
#include <cstdio>
#include <cstdint>
#define MK_LAUNCHES 1


#define XB_TMO      128
#define XB_XCNT(j)  (256  + 64 * (j))
#define XB_XSUB(j)  (1280 + 64 * (j))
#define XB_XGEN(j)  (2304 + 64 * (j))
#define XB_TOP      3328
#define XB_TOPGEN   3392
#define XCD_BAR_WORDS 3456
#define XB_SPIN_CAP (1u << 18)
#define LAS __attribute__((address_space(3)))

__device__ __forceinline__ unsigned xb_ld(unsigned* p)              { return __hip_atomic_load(p, __ATOMIC_RELAXED, __HIP_MEMORY_SCOPE_AGENT); }
__device__ __forceinline__ unsigned xb_add(unsigned* p, unsigned v) { return __hip_atomic_fetch_add(p, v, __ATOMIC_RELAXED, __HIP_MEMORY_SCOPE_AGENT); }
__device__ __forceinline__ unsigned xb_xcc_id() { return (unsigned)__builtin_amdgcn_s_getreg((3 << 11) | 20) & 0xFu; }
#define XB_SPIN(cond, bar) do { unsigned _sp = 0; while (cond) { __builtin_amdgcn_s_sleep(1); \
    if ((++_sp & 255u) == 0u) { if (xb_ld(&(bar)[XB_TMO])) break; if (_sp > XB_SPIN_CAP) { atomicAdd(&(bar)[XB_TMO], 1u); break; } } } } while (0)

struct XcdBarrier {
    unsigned* bar; unsigned x;
    int wid;
    volatile LAS unsigned* st;
};

__device__ __forceinline__ bool xb_lead(int wid) { int l; asm volatile("v_mbcnt_lo_u32_b32 %0, -1, 0\n\tv_mbcnt_hi_u32_b32 %0, -1, %0" : "=v"(l)); return wid == 0 && l == 0; }
__device__ __forceinline__ XcdBarrier xcd_barrier_post(unsigned* bar, volatile LAS unsigned* st, int wid) {
    XcdBarrier b; b.bar = bar; b.x = xb_xcc_id(); b.st = st; b.wid = wid;
    if (xb_lead(wid)) (void)xb_add(&bar[XB_XCNT(b.x)], 1u);
    return b;
}
__device__ __forceinline__ void xcd_barrier_complete(unsigned* bar, unsigned x, unsigned& nloc, unsigned& nx) {
    const unsigned G = gridDim.x * gridDim.y * gridDim.z;
    unsigned sum, cnt, mine, sp = 0u;
    for (;;) {
        sum = 0u; cnt = 0u; mine = 0u;
#pragma unroll
        for (unsigned j = 0; j < 16; ++j) { const unsigned c = xb_ld(&bar[XB_XCNT(j)]); sum += c; cnt += (c > 0u) ? 1u : 0u; mine = (j == x) ? c : mine; }
        if (sum == G) break;
        __builtin_amdgcn_s_sleep(1);
        if ((++sp & 255u) == 0u) { if (xb_ld(&bar[XB_TMO])) break; if (sp > XB_SPIN_CAP) { atomicAdd(&bar[XB_TMO], 1u); break; } }
    }
    nloc = mine > 0u ? mine : 1u; nx = cnt > 0u ? cnt : 1u;
}

__device__ __forceinline__ void xcd_barrier(const XcdBarrier& b) {
    asm volatile("s_waitcnt vmcnt(0)" ::: "memory");
    __syncthreads();
    if (xb_lead(b.wid)) {
        unsigned* bar = b.bar;
        __builtin_amdgcn_s_waitcnt(0);
        unsigned nloc = b.st[0], nx = b.st[1];
        if (nloc == 0u) { xcd_barrier_complete(bar, b.x, nloc, nx); b.st[0] = nloc; b.st[1] = nx; }
        const unsigned old = xb_add(&bar[XB_XSUB(b.x)], 1u);
        const unsigned gen = old / nloc;
        if (old + 1u == (gen + 1u) * nloc) {
            __builtin_amdgcn_fence(__ATOMIC_RELEASE, "agent");
            asm volatile("s_waitcnt vmcnt(0)" ::: "memory");
            const unsigned og = xb_add(&bar[XB_TOP], 1u);
            const unsigned tg = og / nx;
            if (og + 1u == (tg + 1u) * nx) xb_add(&bar[XB_TOPGEN], 1u);
            else XB_SPIN(xb_ld(&bar[XB_TOPGEN]) == tg, bar);
            __builtin_amdgcn_fence(__ATOMIC_ACQUIRE, "agent");
            xb_add(&bar[XB_XGEN(b.x)], 1u);
            asm volatile("s_waitcnt vmcnt(0)" ::: "memory");
        } else {
            XB_SPIN(xb_ld(&bar[XB_XGEN(b.x)]) == gen, bar);
            __builtin_amdgcn_fence(__ATOMIC_ACQUIRE, "agent");
            asm volatile("s_waitcnt vmcnt(0)" ::: "memory");
        }
    }
    __syncthreads();
}


namespace pg8 {
#define PG8_LAS __attribute__((address_space(3)))
typedef unsigned short bf16_t;
typedef short bf16x8 __attribute__((ext_vector_type(8)));
typedef float f32x4 __attribute__((ext_vector_type(4)));
typedef unsigned u32x4 __attribute__((ext_vector_type(4)));
constexpr int BM = 256, BK = 64, HALF = 128, HTB = HALF * BK * 2  , STAGE_BYTES = 8 * HTB, NXCD = 8, WGM = 8;

__host__ __device__ __forceinline__ int lds_byte(int r, int c) { const int st = (r >> 4) * 2 + (c >> 5), rr = r & 15, cc = c & 31, ob = rr * 64 + cc * 2; return st * 1024 + (ob ^ (((ob >> 9) & 1) << 5)); }
__host__ __device__ __forceinline__ void stage_rc(int b, int& R, int& C) { const int st = b / 1024, sb = b % 1024, swz = sb ^ (((sb >> 9) & 1) << 5); R = (st >> 1) * 16 + swz / 64; C = (st & 1) * 32 + (swz % 64) / 2; }
__host__ __device__ __forceinline__ int perm32(int rho) { const int n = rho >> 4, i = rho & 15; return 8 * (i >> 2) + 4 * n + (i & 3); }

struct Unit { int pm, pn; };
struct Gemm { const bf16_t* A; const bf16_t* Bt; int M, N, K, lda, pmg; size_t gstride; int tid; };

struct StaticOrder {
    int nM, nN, nwg, G, c;
    __host__ __device__ void init(int M, int N, int G_, int c_) { nM = M / BM; nN = N / BM; nwg = nM * nN; G = G_; c = c_; }
    __host__ __device__ bool next(int i, Unit& u) const {
        const long L = (long)i * G + c; if (L >= nwg) return false;
        int wgid = (int)L; { const int q = nwg / NXCD, r = nwg % NXCD, xcd = wgid % NXCD, off = wgid / NXCD; wgid = (xcd < r ? xcd * (q + 1) : r * (q + 1) + (xcd - r) * q) + off; }
        const int nig = WGM * nN, gid = wgid / nig, fm = gid * WGM, gsz = (nM - fm) < WGM ? (nM - fm) : WGM;
        u.pm = fm + ((wgid % nig) % gsz); u.pn = (wgid % nig) / gsz; return true;
    }
    __device__ __forceinline__ void a_ready(const Unit&) const {}
    __device__ __forceinline__ void done(const Unit&) const {}
};
__device__ __forceinline__ unsigned cvt_pk_bf16(float lo, float hi) { unsigned r; asm volatile("v_cvt_pk_bf16_f32 %0, %1, %2" : "=v"(r) : "v"(lo), "v"(hi)); return r; }
typedef float f32x2 __attribute__((ext_vector_type(2)));
template <class Epi, class Sched, bool STAMP = false>
__device__ __forceinline__ void gemm_phase(PG8_LAS unsigned char* lds, const Gemm g, const Sched& S, const Epi& E, unsigned long long* stamps) {
    const int tid = g.tid, wid = __builtin_amdgcn_readfirstlane(tid >> 6), lane = tid & 63, wr = wid >> 2, wc = wid & 3, fr = lane & 15, fq = lane >> 4;
    const int K = g.K, nt = K / BK;
    int ts_lo = 0, ts_hi = 0, nts = 0; const unsigned long long rt_entry = STAMP ? (unsigned long long)wall_clock64() : 0ull;
#define PG8_STAMP() do { if (STAMP && wid == 0 && nts < 64) { const unsigned long long _c = (unsigned long long)clock64(); \
        ts_lo = (lane == nts) ? (int)(unsigned)_c : ts_lo; ts_hi = (lane == nts) ? (int)(unsigned)(_c >> 32) : ts_hi; ++nts; } } while (0)
    PG8_STAMP();
    unsigned voffA[2], voffB[2];
#pragma unroll
    for (int i = 0; i < 2; ++i) { int R, C; stage_rc(tid * 16 + i * 8192, R, C); const int Rb = Epi::PERM ? ((R & ~31) + perm32(R & 31)) : R;
        voffA[i] = (unsigned)(R * g.lda + C) * 2u; voffB[i] = (unsigned)(Rb * K + C) * 2u; }
    const size_t kstep = (size_t)(BK * 2);
    const size_t hstepA = (size_t)HALF * g.lda * 2, hstepB = (size_t)HALF * K * 2;
    const size_t tstepA = 2 * hstepA, tstepB = 2 * hstepB;
    const unsigned ldsw = (unsigned)wid * 1024u;
    const int aoff = lds_byte(wr * 64 + fr, fq * 8), boff = lds_byte(wc * 32 + fr, fq * 8);
#define PG8_SA(b, h) (((b) * 2 + (h)) * HTB)
#define PG8_SB(b, h) ((4 + (b) * 2 + (h)) * HTB)
#define PG8_STAGE(bufoff, gbase, voff) do { _Pragma("unroll") for (int _i = 0; _i < 2; ++_i) \
        __builtin_amdgcn_global_load_lds((const unsigned*)((const char*)(gbase) + (voff)[_i]), (PG8_LAS unsigned*)(lds + (bufoff) + ldsw + _i * 8192), 16, 0, 0); } while (0)
#define PG8_LDA(dst, b, h) do { _Pragma("unroll") for (int m = 0; m < 4; ++m) _Pragma("unroll") for (int k = 0; k < 2; ++k) dst[m][k] = *(const PG8_LAS bf16x8*)(lds + PG8_SA(b, h) + aoff + m * 2048 + k * 1024); } while (0)
#define PG8_LDB(dst, b, h) do { _Pragma("unroll") for (int n = 0; n < 2; ++n) _Pragma("unroll") for (int k = 0; k < 2; ++k) dst[n][k] = *(const PG8_LAS bf16x8*)(lds + PG8_SB(b, h) + boff + n * 2048 + k * 1024); } while (0)
#define PG8_MMA(ai, bj, At, Bt) do { __builtin_amdgcn_s_setprio(1); _Pragma("unroll") for (int m = 0; m < 4; ++m) _Pragma("unroll") for (int n = 0; n < 2; ++n) _Pragma("unroll") for (int k = 0; k < 2; ++k) \
        acc[ai][bj][m][n] = __builtin_amdgcn_mfma_f32_16x16x32_bf16(Bt[n][k], At[m][k], acc[ai][bj][m][n], 0, 0, 0); __builtin_amdgcn_s_setprio(0); } while (0)
#define PG8_WAIT_V(n) asm volatile("s_waitcnt vmcnt(" #n ")" ::: "memory")
#define PG8_WAIT_L(n) asm volatile("s_waitcnt lgkmcnt(" #n ")" ::: "memory")
#define PG8_BAR __builtin_amdgcn_s_barrier()
#define PG8_SCHED __builtin_amdgcn_sched_barrier(0)
    Unit cur, nxt; int ui = 0;
    if (!S.next(0, cur)) return;
    f32x4 acc[2][2][4][2];
#pragma unroll
    for (int a = 0; a < 2; ++a)
#pragma unroll
        for (int b = 0; b < 2; ++b)
#pragma unroll
            for (int m = 0; m < 4; ++m)
#pragma unroll
                for (int n = 0; n < 2; ++n) acc[a][b][m][n] = (f32x4){0.f, 0.f, 0.f, 0.f};
    bf16x8 At[4][2], B0[2][2], B1[2][2];
    const char* cA = (const char*)g.A + (size_t)cur.pm * tstepA; const char* cB = (const char*)g.Bt + (size_t)(cur.pm / g.pmg) * g.gstride + (size_t)cur.pn * tstepB;
    S.a_ready(cur);
    PG8_STAGE(PG8_SB(0, 0), cB, voffB); PG8_STAGE(PG8_SA(0, 0), cA, voffA); PG8_STAGE(PG8_SB(0, 1), cB + hstepB, voffB); PG8_STAGE(PG8_SA(0, 1), cA + hstepA, voffA);
    if (wr == 1) PG8_BAR;
    PG8_WAIT_V(4); PG8_BAR;
    PG8_STAGE(PG8_SB(1, 0), cB + kstep, voffB); PG8_STAGE(PG8_SA(1, 0), cA + kstep, voffA); PG8_STAGE(PG8_SB(1, 1), cB + hstepB + kstep, voffB);
    PG8_WAIT_V(6); PG8_BAR;
    PG8_STAMP();
    for (;;) {
        const bool has_next = S.next(ui + 1, nxt);
        const char* nA = has_next ? (const char*)g.A + (size_t)nxt.pm * tstepA : cA; const char* nB = has_next ? (const char*)g.Bt + (size_t)(nxt.pm / g.pmg) * g.gstride + (size_t)nxt.pn * tstepB : cB;
#pragma unroll 1
        for (int t = 0; t < nt; t += 2) {
            const bool last = (t == nt - 2);
            const char* a1 = cA + (size_t)(t + 1) * kstep;
            const char* a2 = last ? nA : cA + (size_t)(t + 2) * kstep; const char* b2 = last ? nB : cB + (size_t)(t + 2) * kstep;
            const char* a3 = a2 + kstep; const char* b3 = b2 + kstep;
            if (last && has_next) S.a_ready(nxt);
            PG8_LDB(B0, 0, 0); PG8_SCHED; PG8_LDA(At, 0, 0); PG8_STAGE(PG8_SA(1, 1), a1 + hstepA, voffA);
            PG8_WAIT_L(8); PG8_BAR; PG8_WAIT_L(0); PG8_MMA(0, 0, At, B0); PG8_BAR; PG8_SCHED;
            PG8_LDB(B1, 0, 1); PG8_STAGE(PG8_SB(0, 0), b2, voffB);
            PG8_BAR; PG8_WAIT_L(0); PG8_MMA(0, 1, At, B1); PG8_BAR;
            PG8_LDA(At, 0, 1); PG8_STAGE(PG8_SA(0, 0), a2, voffA);
            PG8_BAR; PG8_WAIT_L(0); PG8_MMA(1, 0, At, B0); PG8_BAR; PG8_SCHED;
            PG8_STAGE(PG8_SB(0, 1), b2 + hstepB, voffB);
            PG8_WAIT_V(6); PG8_BAR; PG8_MMA(1, 1, At, B1); PG8_BAR;
            PG8_LDB(B0, 1, 0); PG8_SCHED; PG8_LDA(At, 1, 0); PG8_STAGE(PG8_SA(0, 1), a2 + hstepA, voffA);
            PG8_WAIT_L(8); PG8_BAR; PG8_WAIT_L(0); PG8_MMA(0, 0, At, B0); PG8_BAR; PG8_SCHED;
            PG8_LDB(B1, 1, 1); PG8_STAGE(PG8_SB(1, 0), b3, voffB);
            PG8_BAR; PG8_WAIT_L(0); PG8_MMA(0, 1, At, B1); PG8_BAR;
            PG8_LDA(At, 1, 1); PG8_STAGE(PG8_SA(1, 0), a3, voffA);
            PG8_BAR; PG8_WAIT_L(0); PG8_MMA(1, 0, At, B0); PG8_BAR; PG8_SCHED;
            PG8_STAGE(PG8_SB(1, 1), b3 + hstepB, voffB);
            PG8_WAIT_V(6); PG8_BAR; PG8_MMA(1, 1, At, B1); PG8_BAR;
        }
        PG8_STAMP();
        if constexpr (!Epi::AFTER_DRAIN) { E(acc, cur, wr, wc, fr, fq); S.done(cur); }
        PG8_STAMP();
        if (!has_next) break;
#pragma unroll
        for (int a = 0; a < 2; ++a)
#pragma unroll
            for (int b = 0; b < 2; ++b)
#pragma unroll
                for (int m = 0; m < 4; ++m)
#pragma unroll
                    for (int n = 0; n < 2; ++n) acc[a][b][m][n] = (f32x4){0.f, 0.f, 0.f, 0.f};
        cur = nxt; cA = nA; cB = nB; ++ui;
    }
    PG8_WAIT_V(0);
    if (wr == 0) PG8_BAR;
    PG8_BAR;
    if constexpr (Epi::AFTER_DRAIN) { E.fused(acc, cur, wr, wc, fr, fq, lds, wid, lane); S.done(cur); }
    PG8_STAMP();
    if (STAMP && wid == 0) { stamps[lane] = lane < nts ? (((unsigned long long)(unsigned)ts_hi << 32) | (unsigned)ts_lo) : 0ull;
        if (lane == 62) stamps[62] = rt_entry; if (lane == 63) stamps[63] = (unsigned long long)wall_clock64(); }
#undef PG8_STAMP
#undef PG8_SA
#undef PG8_SB
#undef PG8_STAGE
#undef PG8_LDA
#undef PG8_LDB
#undef PG8_MMA
#undef PG8_WAIT_V
#undef PG8_WAIT_L
#undef PG8_BAR
#undef PG8_SCHED
}
}


namespace hy {
using pg8::bf16_t; using pg8::f32x4; using pg8::u32x4; using pg8::Unit;
typedef unsigned u32x2 __attribute__((ext_vector_type(2)));
#define DI __device__ __forceinline__
constexpr int D = 1024, NBATCH = 8, SEQ = 4096, CTXL = 256, DEPTH = 4;
constexpr int CTXROWS = NBATCH * CTXL;
constexpr int MROWS = CTXROWS + NBATCH * SEQ;
constexpr int NCHUNK = MROWS / 64;
constexpr int NIN = 14384;
constexpr int NT = 512;
constexpr int LDS_BYTES = 147456 + 256;
constexpr int C_GQ = 0, C_GZ = 3072, C_GA = 4096, C_SU = 4128, C_MQ = 6176, C_MO = 9248, C_MI = 11296, C_GATE = 11312;

constexpr size_t al256(size_t x) { return (x + 255) & ~(size_t)255; }
constexpr size_t SZ_ACT = (size_t)MROWS * 1024 * 2;
constexpr size_t SZ_GATE = (size_t)MROWS * 32 * 4;
constexpr size_t SZ_HALO = (size_t)3 * NCHUNK * 4 * 1024 * 2;
constexpr size_t WS_CTL = 0;
constexpr size_t WS_MOD = 65536, SZ_MOD = (size_t)DEPTH * 9 * 3072 * 4;
constexpr size_t WS_XCTX = al256(WS_MOD + SZ_MOD);
constexpr size_t WS_H = WS_XCTX + (size_t)CTXROWS * 1024 * 4;
constexpr size_t WS_MERGED = WS_H + SZ_ACT;
constexpr size_t SZ_WB = (size_t)3328 * 1024 * 2;
constexpr size_t WS_WB0 = WS_MERGED + SZ_ACT;
constexpr size_t WS_WB1 = WS_WB0 + SZ_WB;
constexpr size_t WS_R = WS_WB1 + SZ_WB;
constexpr size_t R_P0 = 0, R_P1 = SZ_ACT, R_P2 = 2 * SZ_ACT, R_OF = 3 * SZ_ACT, R_OB = 4 * SZ_ACT, R_G2 = 5 * SZ_ACT;
constexpr size_t WS_END = WS_R + R_G2 + SZ_GATE + (size_t)4 * 1024 * 1024;
static_assert(SZ_GATE + SZ_HALO <= SZ_ACT, "GDN gate + halo buffers live in the (not yet written) MERGED region");
static_assert((size_t)16 * DEPTH * 9 * 3072 * 4 <= SZ_ACT, "mod partials live in the R region");

struct Args { const float* in[28]; float* out; unsigned char* ws; int ph_lo, ph_hi, wid, pad; };
enum { I_X = 0, I_C, I_CTX, I_CCTX, I_WADA, I_BADA, I_NORMG, I_WIN, I_GCONV, I_GALOG, I_GDTB, I_GNORM, I_SLRE, I_SLIM, I_SLOG, I_SBRE, I_SBIM, I_SCRE, I_SCIM, I_SD, I_SWGLU, I_SBGLU, I_MIB, I_MFB, I_MNORM, I_WBR, I_WOUT, I_FNORM };

typedef const Args __attribute__((address_space(4)))* ArgsP;
DI ArgsP args_ptr() { ArgsP p = (ArgsP)__builtin_amdgcn_kernarg_segment_ptr(); asm volatile("" : "+s"(p)); return p; }
DI int lane_id() { int l; asm volatile("v_mbcnt_lo_u32_b32 %0, -1, 0\n\tv_mbcnt_hi_u32_b32 %0, -1, %0" : "=v"(l)); return l; }
DI int ltid(const Args& a) { return (a.wid << 6) | lane_id(); }
DI void lds_barrier() { asm volatile("s_waitcnt lgkmcnt(0)" ::: "memory"); __builtin_amdgcn_s_barrier(); asm volatile("" ::: "memory"); }
DI float bf2f(bf16_t v) { return __uint_as_float(((unsigned)v) << 16); }
DI float bflo(unsigned w) { return __uint_as_float(w << 16); }
DI float bfhi(unsigned w) { return __uint_as_float(w & 0xffff0000u); }
DI bf16_t f2bf(float f) { return (bf16_t)(pg8::cvt_pk_bf16(f, 0.f) & 0xffffu); }
DI float sigmoidf_(float x) { return __builtin_amdgcn_rcpf(1.0f + __expf(-x)); }
DI float siluf_(float x) { return x * __builtin_amdgcn_rcpf(1.0f + __expf(-x)); }
DI float softplusf_(float x) { return x > 20.f ? x : log1pf(__expf(x)); }
DI float gelu_tanh_(float x) { const float u = 0.7978845608028654f * (x + 0.044715f * x * x * x); return x * __builtin_amdgcn_rcpf(1.0f + __expf(-2.0f * u)); }
DI float shx(float v, int o, int lane) { return __int_as_float(__builtin_amdgcn_ds_bpermute((lane ^ o) << 2, __float_as_int(v))); }
DI float shup(float v, int o, int lane) { return __int_as_float(__builtin_amdgcn_ds_bpermute((lane - o) << 2, __float_as_int(v))); }
DI float shidx(float v, int src) { return __int_as_float(__builtin_amdgcn_ds_bpermute(src << 2, __float_as_int(v))); }
#define DPP_F(old_, src_, ctrl_, rmask_) __int_as_float(__builtin_amdgcn_update_dpp(__float_as_int(old_), __float_as_int(src_), (ctrl_), (rmask_), 0xF, false))
DI float dpp_scan_sum(float v) {
    v += DPP_F(0.f, v, 0x111, 0xF); v += DPP_F(0.f, v, 0x112, 0xF); v += DPP_F(0.f, v, 0x114, 0xF); v += DPP_F(0.f, v, 0x118, 0xF);
    v += DPP_F(0.f, v, 0x142, 0xA); v += DPP_F(0.f, v, 0x143, 0xC); return v; }
DI float dpp_scan_max(float v) {
    const float ninf = -__builtin_inff();
    v = fmaxf(v, DPP_F(ninf, v, 0x111, 0xF)); v = fmaxf(v, DPP_F(ninf, v, 0x112, 0xF)); v = fmaxf(v, DPP_F(ninf, v, 0x114, 0xF)); v = fmaxf(v, DPP_F(ninf, v, 0x118, 0xF));
    v = fmaxf(v, DPP_F(ninf, v, 0x142, 0xA)); v = fmaxf(v, DPP_F(ninf, v, 0x143, 0xC)); return v; }
DI float lane63(float v) { return __int_as_float(__builtin_amdgcn_readlane(__float_as_int(v), 63)); }
DI float wave_sum(float v, int lane) {
#pragma unroll
    for (int o = 32; o >= 1; o >>= 1) v += shx(v, o, lane);
    return v; }
DI void unpack8(const u32x4 w, float (&f)[8]) { f[0] = bflo(w.x); f[1] = bfhi(w.x); f[2] = bflo(w.y); f[3] = bfhi(w.y); f[4] = bflo(w.z); f[5] = bfhi(w.z); f[6] = bflo(w.w); f[7] = bfhi(w.w); }
DI int lat_pos(int l, int s) { return (l & 1) ? (((s & 63) << 6) | (s >> 6)) : s; }

struct EpiProj {
    static constexpr bool PERM = true, AFTER_DRAIN = false;
    bf16_t* d0; int modes; float* gdst; int gtile; bf16_t* halo; int row_off;
    __device__ __forceinline__ void operator()(const f32x4 (&acc)[2][2][4][2], const Unit& u, int wr, int wc, int fr, int fq) const {
        const int row0 = row_off + u.pm * 256 + wr * 64 + fr;
        if (u.pn == gtile) {
            if (wc == 0) {
#pragma unroll
                for (int ai = 0; ai < 2; ++ai)
#pragma unroll
                    for (int m = 0; m < 4; ++m) { float* rp = gdst + (size_t)(row0 + ai * 128 + m * 16) * 32 + 8 * fq; *(f32x4*)rp = acc[ai][0][m][0]; *(f32x4*)(rp + 4) = acc[ai][0][m][1]; }
            }
            return;
        }
        const int seg = u.pn >> 2; bf16_t* base = d0 + (size_t)seg * (SZ_ACT / 2); const int md = (modes >> (2 * seg)) & 3;
        const int col0 = (u.pn & 3) * 256 + wc * 32 + 8 * fq;
#pragma unroll
        for (int ai = 0; ai < 2; ++ai)
#pragma unroll
            for (int m = 0; m < 4; ++m) {
                const int r = row0 + ai * 128 + m * 16;
                bf16_t* rowp = base + (size_t)r * 1024 + col0;
                int hidx = -1;
                if (halo) { if (m == 0 && fr < 2) hidx = fr; if (m == 3 && fr >= 14) hidx = fr - 12; }
#pragma unroll
                for (int bj = 0; bj < 2; ++bj) {
                    f32x4 v0 = acc[ai][bj][m][0], v1 = acc[ai][bj][m][1];
                    if (md == 1) {
#pragma unroll
                        for (int j = 0; j < 4; ++j) { v0[j] = siluf_(v0[j]); v1[j] = siluf_(v1[j]); } }
                    else if (md == 2) {
#pragma unroll
                        for (int j = 0; j < 4; ++j) { v0[j] = sigmoidf_(v0[j]); v1[j] = sigmoidf_(v1[j]); } }
                    u32x4 w; w.x = pg8::cvt_pk_bf16(v0[0], v0[1]); w.y = pg8::cvt_pk_bf16(v0[2], v0[3]); w.z = pg8::cvt_pk_bf16(v1[0], v1[1]); w.w = pg8::cvt_pk_bf16(v1[2], v1[3]);
                    *(u32x4*)(rowp + bj * 128) = w;
                    if (hidx >= 0) *(u32x4*)(halo + ((size_t)seg * (NCHUNK * 4) + (size_t)(r >> 6) * 4 + hidx) * 1024 + col0 + bj * 128) = w;
                }
            }
    }
};
struct EpiBranch {
    static constexpr bool PERM = true, AFTER_DRAIN = false;
    const bf16_t* G; bf16_t* MG; int first, row_off;
    __device__ __forceinline__ void operator()(const f32x4 (&acc)[2][2][4][2], const Unit& u, int wr, int wc, int fr, int fq) const {
        const int row0 = row_off + u.pm * 256 + wr * 64 + fr, col0 = u.pn * 256 + wc * 32 + 8 * fq;
#pragma unroll
        for (int ai = 0; ai < 2; ++ai)
#pragma unroll
            for (int m = 0; m < 4; ++m) {
                const size_t off = (size_t)(row0 + ai * 128 + m * 16) * 1024 + col0;
#pragma unroll
                for (int bj = 0; bj < 2; ++bj) {
                    const u32x4 gw = *(const u32x4*)(G + off + bj * 128);
                    float g[8], o[8]; unpack8(gw, g);
                    if (first) {
#pragma unroll
                        for (int j = 0; j < 8; ++j) o[j] = 0.f; }
                    else { const u32x4 ow = *(const u32x4*)(MG + off + bj * 128); unpack8(ow, o); }
                    const f32x4 v0 = acc[ai][bj][m][0], v1 = acc[ai][bj][m][1];
#pragma unroll
                    for (int j = 0; j < 4; ++j) { o[j] += g[j] * v0[j]; o[4 + j] += g[4 + j] * v1[j]; }
                    u32x4 w; w.x = pg8::cvt_pk_bf16(o[0], o[1]); w.y = pg8::cvt_pk_bf16(o[2], o[3]); w.z = pg8::cvt_pk_bf16(o[4], o[5]); w.w = pg8::cvt_pk_bf16(o[6], o[7]);
                    *(u32x4*)(MG + off + bj * 128) = w;
                }
                asm volatile("" ::: "memory");
            }
    }
};
struct EpiGlu {
    static constexpr bool PERM = true, AFTER_DRAIN = false;
    const bf16_t* SZ; bf16_t* O; const float* bias; int row_off;
    __device__ __forceinline__ void operator()(const f32x4 (&acc)[2][2][4][2], const Unit& u, int wr, int wc, int fr, int fq) const {
        const int row0 = row_off + u.pm * 256 + wr * 64 + fr, col0 = u.pn * 128 + wc * 32 + 8 * fq;
        float ba[8], bg[8];
#pragma unroll
        for (int j = 0; j < 8; ++j) { ba[j] = bias[col0 + j]; bg[j] = bias[1024 + col0 + j]; }
#pragma unroll
        for (int ai = 0; ai < 2; ++ai)
#pragma unroll
            for (int m = 0; m < 4; ++m) {
                const size_t off = (size_t)(row0 + ai * 128 + m * 16) * 1024 + col0;
                const u32x4 zw = *(const u32x4*)(SZ + off); float z[8], o[8]; unpack8(zw, z);
#pragma unroll
                for (int n = 0; n < 2; ++n)
#pragma unroll
                    for (int j = 0; j < 4; ++j) { const int c = 4 * n + j; o[c] = (acc[ai][0][m][n][j] + ba[c]) * sigmoidf_(acc[ai][1][m][n][j] + bg[c]) * z[c]; }
                u32x4 w; w.x = pg8::cvt_pk_bf16(o[0], o[1]); w.y = pg8::cvt_pk_bf16(o[2], o[3]); w.z = pg8::cvt_pk_bf16(o[4], o[5]); w.w = pg8::cvt_pk_bf16(o[6], o[7]);
                *(u32x4*)(O + off) = w;
            }
    }
};
struct EpiOut {
    static constexpr bool PERM = false, AFTER_DRAIN = false;
    const float* xlat_src; float* xlat_dst; const float* xctx_src; float* xctx_dst; const float* mod; int l; int row_off;
    __device__ __forceinline__ void operator()(const f32x4 (&acc)[2][2][4][2], const Unit& u, int wr, int wc, int fr, int fq) const {
        const int row0 = row_off + u.pm * 256 + wr * 64 + fr, col0 = u.pn * 256 + wc * 32 + 4 * fq;
#pragma unroll
        for (int ai = 0; ai < 2; ++ai)
#pragma unroll
            for (int m = 0; m < 4; ++m) {
                const int r = row0 + ai * 128 + m * 16;
                const float* xs; float* xd; const float* gp;
                if (r < CTXROWS) { xs = xctx_src + (size_t)r * 1024; xd = xctx_dst + (size_t)r * 1024; gp = mod + 8 * 3072 + 2048; }
                else { const int q = r - CTXROWS, b = q >> 12, p = lat_pos(l, q & 4095); const size_t o = ((size_t)b * 4096 + p) * 1024; xs = xlat_src + o; xd = xlat_dst + o; gp = mod + b * 3072 + 2048; }
#pragma unroll
                for (int bj = 0; bj < 2; ++bj)
#pragma unroll
                    for (int n = 0; n < 2; ++n) { const int c = col0 + bj * 128 + n * 16; const f32x4 x = *(const f32x4*)(xs + c), g = *(const f32x4*)(gp + c); *(f32x4*)(xd + c) = x + g * acc[ai][bj][m][n]; }
                asm volatile("" ::: "memory");
            }
    }
};

DI void ph_modp(const Args& a, float* modp, LAS float* sl) {
    for (int it = blockIdx.x; it < 384; it += gridDim.x) {
        const int l = it / 96, kq = (it / 6) % 16, nt = it % 6;
        __syncthreads();
        for (int i = ltid(a); i < 576; i += NT) { const int j = i >> 6, k = kq * 64 + (i & 63); const float cv = (j < 8) ? a.in[I_C][j * 1024 + k] : a.in[I_CCTX][k]; sl[i] = siluf_(cv); }
        __syncthreads();
        const int n = nt * 512 + ltid(a);
        float acc[9];
#pragma unroll
        for (int j = 0; j < 9; ++j) acc[j] = 0.f;
        const float* w = a.in[I_WADA] + ((size_t)l * 1024 + kq * 64) * 3072 + n;
#pragma unroll 4
        for (int k = 0; k < 64; ++k) { const float wv = w[(size_t)k * 3072];
#pragma unroll
            for (int j = 0; j < 9; ++j) acc[j] += sl[j * 64 + k] * wv; }
#pragma unroll
        for (int j = 0; j < 9; ++j) modp[(((size_t)kq * 4 + l) * 9 + j) * 3072 + n] = acc[j];
    }
}
DI void ph_mod(const Args& a, const float* modp, float* mod) {
    for (int i = blockIdx.x * NT + ltid(a); i < DEPTH * 9 * 3072; i += gridDim.x * NT) {
        const int l = i / (9 * 3072), n = i % 3072; float s = a.in[I_BADA][l * 3072 + n];
#pragma unroll
        for (int kq = 0; kq < 16; ++kq) s += modp[(size_t)kq * (DEPTH * 9 * 3072) + i];
        mod[i] = s;
    }
}
DI void ph_norm(const Args& a, int l, const float* xlat, const float* xctx, const float* mod, bf16_t* H) {
    const int wave = ltid(a) >> 6, lane = ltid(a) & 63;
    const float* g = a.in[I_NORMG] + l * 1024;
    for (int r = blockIdx.x * 8 + wave; r < MROWS; r += gridDim.x * 8) {
        const float* src; const float* md;
        if (r < CTXROWS) { src = xctx + (size_t)r * 1024; md = mod + 8 * 3072; }
        else { const int q = r - CTXROWS, b = q >> 12, p = lat_pos(l, q & 4095); src = xlat + ((size_t)b * 4096 + p) * 1024; md = mod + b * 3072; }
        f32x4 v[4]; float ss = 0.f;
#pragma unroll
        for (int i = 0; i < 4; ++i) { v[i] = *(const f32x4*)(src + i * 256 + lane * 4); ss += v[i][0] * v[i][0] + v[i][1] * v[i][1] + v[i][2] * v[i][2] + v[i][3] * v[i][3]; }
        ss = wave_sum(ss, lane);
        const float rs = rsqrtf(ss * (1.0f / 1024.0f) + 1e-6f);
#pragma unroll
        for (int i = 0; i < 4; ++i) { const int c = i * 256 + lane * 4;
            const f32x4 gv = *(const f32x4*)(g + c), sh = *(const f32x4*)(md + c), sc = *(const f32x4*)(md + 1024 + c);
            const f32x4 y = (v[i] * rs) * gv * (sc + 1.0f) + sh;
            u32x2 w; w.x = pg8::cvt_pk_bf16(y[0], y[1]); w.y = pg8::cvt_pk_bf16(y[2], y[3]);
            *(u32x2*)(H + (size_t)r * 1024 + c) = w; }
    }
}
DI void ph_final(const Args& a, float* x) {
    const int wave = ltid(a) >> 6, lane = ltid(a) & 63;
    const float* g = a.in[I_FNORM];
    for (int r = blockIdx.x * 8 + wave; r < NBATCH * SEQ; r += gridDim.x * 8) {
        float* src = x + (size_t)r * 1024;
        f32x4 v[4]; float ss = 0.f;
#pragma unroll
        for (int i = 0; i < 4; ++i) { v[i] = *(const f32x4*)(src + i * 256 + lane * 4); ss += v[i][0] * v[i][0] + v[i][1] * v[i][1] + v[i][2] * v[i][2] + v[i][3] * v[i][3]; }
        ss = wave_sum(ss, lane);
        const float rs = rsqrtf(ss * (1.0f / 1024.0f) + 1e-6f);
#pragma unroll
        for (int i = 0; i < 4; ++i) { const int c = i * 256 + lane * 4; const f32x4 gv = *(const f32x4*)(g + c); *(f32x4*)(src + c) = (v[i] * rs) * gv; }
    }
}
struct WDesc { const float* src; int ld, id, n64, tid; };
DI void wmap(int id, int nb, int& col, int& valid) {
    valid = 64;
    switch (id) {
        case 0: if (nb < 48) col = C_GQ + 64 * nb; else if (nb == 48) { col = C_GA; valid = 32; } else { col = 0; valid = 0; } break;
        case 1: col = (nb < 16) ? C_GZ + 64 * nb : C_GATE + 64 * (nb - 16); break;
        case 2: if (nb < 48) col = C_MQ + 64 * nb; else if (nb == 48) { col = C_MI; valid = 16; } else { col = 0; valid = 0; } break;
        case 3: col = (nb < 32) ? C_MO + 64 * nb : C_GATE + 2048 + 64 * (nb - 32); break;
        case 4: col = (nb < 32) ? C_SU + 64 * nb : C_GATE + 1024 + 64 * (nb - 32); break;
        case 5: { const int pn = nb >> 2, q = nb & 3; col = (q >> 1) * 1024 + 128 * pn + (q & 1) * 64; } break;
        default: col = 64 * nb; break;
    }
}
DI WDesc wdesc(const Args& a, int l, int id) {
    WDesc w; w.id = id; w.tid = ltid(a);
    if (id <= 4) { w.src = a.in[I_WIN] + (size_t)l * 1024 * NIN; w.ld = NIN; w.n64 = (id == 0 || id == 2) ? 52 : (id == 1 ? 32 : 48); }
    else if (id == 5) { w.src = a.in[I_SWGLU] + (size_t)l * 1024 * 2048; w.ld = 2048; w.n64 = 32; }
    else if (id <= 8) { w.src = a.in[I_WBR] + ((size_t)l * 3 + (id - 6)) * 1024 * 1024; w.ld = 1024; w.n64 = 16; }
    else { w.src = a.in[I_WOUT] + (size_t)l * 1024 * 1024; w.ld = 1024; w.n64 = 16; }
    return w;
}
DI void ph_cvt(const WDesc w, bf16_t* dst, LAS float* tile) {
    const int tid = w.tid, ntile = w.n64 * 16;
    for (int t = blockIdx.x; t < ntile; t += gridDim.x) {
        const int nb = t >> 4, kb = t & 15; int col, valid; wmap(w.id, nb, col, valid);
        __syncthreads();
        { const int c = tid & 63, k0 = tid >> 6;
#pragma unroll
          for (int i = 0; i < 8; ++i) { const int k = k0 + 8 * i; tile[k * 65 + c] = (c < valid) ? w.src[(size_t)(kb * 64 + k) * w.ld + col + c] : 0.f; } }
        __syncthreads();
        { const int n = tid >> 3, kk = (tid & 7) * 8; u32x4 o;
          o.x = pg8::cvt_pk_bf16(tile[(kk + 0) * 65 + n], tile[(kk + 1) * 65 + n]); o.y = pg8::cvt_pk_bf16(tile[(kk + 2) * 65 + n], tile[(kk + 3) * 65 + n]);
          o.z = pg8::cvt_pk_bf16(tile[(kk + 4) * 65 + n], tile[(kk + 5) * 65 + n]); o.w = pg8::cvt_pk_bf16(tile[(kk + 6) * 65 + n], tile[(kk + 7) * 65 + n]);
          *(u32x4*)(dst + (size_t)(nb * 64 + n) * 1024 + kb * 64 + kk) = o; }
    }
    __syncthreads();
}

DI void gdn_conv_decode(int unit, int& cb, int& seg, int& h) { cb = unit / 24; seg = (unit % 24) >> 3; h = unit & 7; }
DI void ph_gdn_conv(const Args& a, int l, bf16_t* QKV  , const bf16_t* halo, LAS unsigned char* lds, bf16_t* junk = nullptr) {
    constexpr int P = 136, IMG = 68 * P * 2 + 5 * 128 * 4;
    const int tid = ltid(a);
    const float* cw = a.in[I_GCONV] + (size_t)l * 5 * 3072;
    const int nunit = NCHUNK * 24;
    u32x4 rp[3]; f32x4 wreg = (f32x4){0.f, 0.f, 0.f, 0.f};
    int unit = blockIdx.x, buf = 0;
#define CONV_FETCH(un) do { int cb_, seg_, h_; gdn_conv_decode(un, cb_, seg_, h_); const bf16_t* T_ = QKV + (size_t)seg_ * (SZ_ACT / 2); \
        const bool first_ = (cb_ < 32) ? ((cb_ & 3) == 0) : (((cb_ - 32) & 63) == 0), last_ = (cb_ < 32) ? ((cb_ & 3) == 3) : (((cb_ - 32) & 63) == 63); \
        _Pragma("unroll") for (int q_ = 0; q_ < 3; ++q_) { const int i_ = tid + 512 * q_, rr_ = i_ >> 4, c8_ = (i_ & 15) * 8; u32x4 w_ = (u32x4){0u, 0u, 0u, 0u}; \
            if (i_ < 68 * 16) { if (rr_ >= 2 && rr_ < 66) w_ = *(const u32x4*)(T_ + (size_t)(cb_ * 64 + rr_ - 2) * 1024 + h_ * 128 + c8_); \
                else if (rr_ < 2) { if (!first_) w_ = *(const u32x4*)(halo + ((size_t)seg_ * (NCHUNK * 4) + (size_t)(cb_ - 1) * 4 + 2 + rr_) * 1024 + h_ * 128 + c8_); } \
                else { if (!last_) w_ = *(const u32x4*)(halo + ((size_t)seg_ * (NCHUNK * 4) + (size_t)(cb_ + 1) * 4 + (rr_ - 66)) * 1024 + h_ * 128 + c8_); } } \
            rp[q_] = w_; } \
        if (tid < 160) wreg = *(const f32x4*)(cw + (size_t)(tid >> 5) * 3072 + seg_ * 1024 + h_ * 128 + (tid & 31) * 4); } while (0)
    if (unit < nunit) CONV_FETCH(unit);
    for (; unit < nunit; unit += gridDim.x) {
        int cb, seg, h; gdn_conv_decode(unit, cb, seg, h);
        LAS bf16_t* raw = (LAS bf16_t*)(lds + buf * IMG); LAS float* wl = (LAS float*)(lds + buf * IMG + 68 * P * 2);
#pragma unroll
        for (int q = 0; q < 3; ++q) { const int i = tid + 512 * q, rr = i >> 4, c8 = (i & 15) * 8; if (i < 68 * 16) *(LAS u32x4*)(raw + rr * P + c8) = rp[q]; }
        if (tid < 160) *(LAS f32x4*)(wl + tid * 4) = wreg;
        if (unit + (int)gridDim.x < nunit) CONV_FETCH(unit + (int)gridDim.x);
        lds_barrier();
        bf16_t* T = QKV + (size_t)seg * (SZ_ACT / 2);
        const int t = tid >> 3, c0 = (tid & 7) * 16;
        float o[16]; float ss = 0.f;
#pragma unroll
        for (int half = 0; half < 2; ++half) {
            float acc[8];
#pragma unroll
            for (int j = 0; j < 8; ++j) acc[j] = 0.f;
#pragma unroll
            for (int k = 0; k < 5; ++k) {
                const u32x4 w = *(const LAS u32x4*)(raw + (t + k) * P + c0 + half * 8); float x[8]; unpack8(w, x);
                const f32x4 w0 = *(const LAS f32x4*)(wl + k * 128 + c0 + half * 8), w1 = *(const LAS f32x4*)(wl + k * 128 + c0 + half * 8 + 4);
#pragma unroll
                for (int j = 0; j < 4; ++j) { acc[j] += w0[j] * x[j]; acc[4 + j] += w1[j] * x[4 + j]; }
            }
#pragma unroll
            for (int j = 0; j < 8; ++j) { const float sv = siluf_(acc[j]); o[half * 8 + j] = sv; ss += sv * sv; }
        }
        ss += shx(ss, 1, tid & 63); ss += shx(ss, 2, tid & 63); ss += shx(ss, 4, tid & 63);
        float scale = 1.0f;
        if (seg == 0) scale = rsqrtf(ss + 1e-6f) * 0.08838834764831845f;
        else if (seg == 1) scale = rsqrtf(ss + 1e-6f);
        u32x4 w0, w1;
        w0.x = pg8::cvt_pk_bf16(o[0] * scale, o[1] * scale); w0.y = pg8::cvt_pk_bf16(o[2] * scale, o[3] * scale); w0.z = pg8::cvt_pk_bf16(o[4] * scale, o[5] * scale); w0.w = pg8::cvt_pk_bf16(o[6] * scale, o[7] * scale);
        w1.x = pg8::cvt_pk_bf16(o[8] * scale, o[9] * scale); w1.y = pg8::cvt_pk_bf16(o[10] * scale, o[11] * scale); w1.z = pg8::cvt_pk_bf16(o[12] * scale, o[13] * scale); w1.w = pg8::cvt_pk_bf16(o[14] * scale, o[15] * scale);
        bf16_t* op = (junk ? junk : T) + (size_t)(cb * 64 + t) * 1024 + h * 128 + c0;
        *(u32x4*)op = w0; *(u32x4*)(op + 8) = w1;
        buf ^= 1;
    }
#undef CONV_FETCH
    __syncthreads();
}
DI void ph_gdn_scan(const Args& a, int l, const bf16_t* Q, const bf16_t* K, const bf16_t* V, const float* GATE, bf16_t* OF, bf16_t* OB, LAS unsigned char* lds) {
    LAS float* qf = (LAS float*)lds;
    LAS float* kf = qf + 64 * 128;
    LAS float* vf = kf + 64 * 128;
    LAS float* av = vf + 64 * 64;
    LAS float* bt = av + 64;
    LAS float* part = bt + 64;
    LAS float* po = part + 1024;
    const int tid = ltid(a), e = tid & 63, dq = tid >> 6;
    for (int unit = blockIdx.x; unit < 256; unit += gridDim.x) {
        const int eh = unit & 1, d = (unit >> 1) & 1, h = (unit >> 2) & 7, b = unit >> 5;
        const float nea = -__expf(a.in[I_GALOG][(l * 2 + d) * 8 + h]), dtb = a.in[I_GDTB][(l * 2 + d) * 8 + h];
        bf16_t* O = d ? OB : OF;
        float S[16];
#pragma unroll
        for (int j = 0; j < 16; ++j) S[j] = 0.f;
        float opart = 0.f; int prow = -1, par = 0;
        for (int step = 0; step < 68; ++step) {
            const int cc = (step < 4) ? (d ? 3 - step : step) : (d ? 67 - step : step - 4);
            const int row0 = (step < 4) ? b * 256 + cc * 64 : CTXROWS + b * 4096 + cc * 64;
            __syncthreads();
            for (int i = tid; i < 1024; i += NT) { const int r = i >> 4, c8 = (i & 15) * 8; float f[8];
                unpack8(*(const u32x4*)(Q + (size_t)(row0 + r) * 1024 + h * 128 + c8), f);
#pragma unroll
                for (int j = 0; j < 8; ++j) qf[r * 128 + c8 + j] = f[j];
                unpack8(*(const u32x4*)(K + (size_t)(row0 + r) * 1024 + h * 128 + c8), f);
#pragma unroll
                for (int j = 0; j < 8; ++j) kf[r * 128 + c8 + j] = f[j]; }
            { const int r = tid >> 3, c8 = (tid & 7) * 8; float f[8]; unpack8(*(const u32x4*)(V + (size_t)(row0 + r) * 1024 + h * 128 + eh * 64 + c8), f);
#pragma unroll
              for (int j = 0; j < 8; ++j) vf[r * 64 + c8 + j] = f[j]; }
            if (tid < 64) { const float* gp = GATE + (size_t)(row0 + tid) * 32; av[tid] = __expf(nea * softplusf_(gp[d * 8 + h] + dtb)); bt[tid] = sigmoidf_(gp[16 + d * 8 + h]); }
            __syncthreads();
            for (int tt = 0; tt < 64; ++tt) {
                const int t = d ? 63 - tt : tt;
                float kk[16];
#pragma unroll
                for (int j4 = 0; j4 < 4; ++j4) { const f32x4 x = *(const LAS f32x4*)(kf + t * 128 + dq * 16 + j4 * 4); kk[j4 * 4] = x[0]; kk[j4 * 4 + 1] = x[1]; kk[j4 * 4 + 2] = x[2]; kk[j4 * 4 + 3] = x[3]; }
                float p = 0.f;
#pragma unroll
                for (int j = 0; j < 16; ++j) p += kk[j] * S[j];
                part[(par * 8 + dq) * 64 + e] = p; po[(par * 8 + dq) * 64 + e] = opart;
                __syncthreads();
                if (dq == 0 && prow >= 0) { float o = 0.f;
#pragma unroll
                    for (int q = 0; q < 8; ++q) o += po[(par * 8 + q) * 64 + e];
                    O[(size_t)prow * 1024 + h * 128 + eh * 64 + e] = f2bf(o); }
                float ks = 0.f;
#pragma unroll
                for (int q = 0; q < 8; ++q) ks += part[(par * 8 + q) * 64 + e];
                const float at = av[t], vn = bt[t] * (vf[t * 64 + e] - at * ks);
#pragma unroll
                for (int j = 0; j < 16; ++j) S[j] = at * S[j] + kk[j] * vn;
                float qo = 0.f;
#pragma unroll
                for (int j4 = 0; j4 < 4; ++j4) { const f32x4 x = *(const LAS f32x4*)(qf + t * 128 + dq * 16 + j4 * 4); qo += x[0] * S[j4 * 4] + x[1] * S[j4 * 4 + 1] + x[2] * S[j4 * 4 + 2] + x[3] * S[j4 * 4 + 3]; }
                opart = qo; prow = row0 + t; par ^= 1;
            }
        }
        po[(par * 8 + dq) * 64 + e] = opart;
        __syncthreads();
        if (dq == 0) { float o = 0.f;
#pragma unroll
            for (int q = 0; q < 8; ++q) o += po[(par * 8 + q) * 64 + e];
            O[(size_t)prow * 1024 + h * 128 + eh * 64 + e] = f2bf(o); }
        __syncthreads();
    }
}
template <int O> DI float swz_xor(float v) { return __int_as_float(__builtin_amdgcn_ds_swizzle(__float_as_int(v), 0x1F | (O << 10))); }
DI void ph_gdn_post(const Args& a, int l, bf16_t* OF, const bf16_t* OB, const bf16_t* SZ, bf16_t* junk = nullptr) {
    const int tid = ltid(a), wave = tid >> 6, lane = tid & 63;
    const float* g = a.in[I_GNORM] + l * 128 + (lane & 15) * 8;
    const f32x4 g0 = *(const f32x4*)g, g1 = *(const f32x4*)(g + 4);
    const int nit = MROWS * 2, stride = gridDim.x * 8;
    for (int it = blockIdx.x * 8 + wave; it < nit; it += 2 * stride) {
        const int it1 = it + stride; const bool two = it1 < nit;
        const size_t off0 = (size_t)it * 512 + lane * 8, off1 = (size_t)(two ? it1 : it) * 512 + lane * 8;
        const u32x4 f0 = *(const u32x4*)(OF + off0), b0 = *(const u32x4*)(OB + off0), z0 = *(const u32x4*)(SZ + off0);
        const u32x4 f1 = *(const u32x4*)(OF + off1), b1 = *(const u32x4*)(OB + off1), z1 = *(const u32x4*)(SZ + off1);
        float x0[8], x1[8], t0[8], t1[8];
        unpack8(f0, x0); unpack8(b0, t0); unpack8(f1, x1); unpack8(b1, t1);
        float s0 = 0.f, s1 = 0.f;
#pragma unroll
        for (int j = 0; j < 8; ++j) { x0[j] += t0[j]; x1[j] += t1[j]; s0 += x0[j] * x0[j]; s1 += x1[j] * x1[j]; }
        s0 += swz_xor<1>(s0); s1 += swz_xor<1>(s1); s0 += swz_xor<2>(s0); s1 += swz_xor<2>(s1); s0 += swz_xor<4>(s0); s1 += swz_xor<4>(s1); s0 += swz_xor<8>(s0); s1 += swz_xor<8>(s1);
        const float r0 = rsqrtf(s0 * (1.0f / 128.0f) + 1e-6f), r1 = rsqrtf(s1 * (1.0f / 128.0f) + 1e-6f);
        unpack8(z0, t0); unpack8(z1, t1);
        u32x4 w0, w1;
        w0.x = pg8::cvt_pk_bf16(x0[0] * r0 * g0[0] * t0[0], x0[1] * r0 * g0[1] * t0[1]); w0.y = pg8::cvt_pk_bf16(x0[2] * r0 * g0[2] * t0[2], x0[3] * r0 * g0[3] * t0[3]);
        w0.z = pg8::cvt_pk_bf16(x0[4] * r0 * g1[0] * t0[4], x0[5] * r0 * g1[1] * t0[5]); w0.w = pg8::cvt_pk_bf16(x0[6] * r0 * g1[2] * t0[6], x0[7] * r0 * g1[3] * t0[7]);
        w1.x = pg8::cvt_pk_bf16(x1[0] * r1 * g0[0] * t1[0], x1[1] * r1 * g0[1] * t1[1]); w1.y = pg8::cvt_pk_bf16(x1[2] * r1 * g0[2] * t1[2], x1[3] * r1 * g0[3] * t1[3]);
        w1.z = pg8::cvt_pk_bf16(x1[4] * r1 * g1[0] * t1[4], x1[5] * r1 * g1[1] * t1[5]); w1.w = pg8::cvt_pk_bf16(x1[6] * r1 * g1[2] * t1[6], x1[7] * r1 * g1[3] * t1[7]);
        bf16_t* dst = junk ? junk : OF;
        *(u32x4*)(dst + off0) = w0; if (two) *(u32x4*)(dst + off1) = w1;
    }
}

DI void ph_ml_scan(const Args& a, int l, const bf16_t* Q, const bf16_t* K, const bf16_t* V, const float* GATE, bf16_t* HF, bf16_t* HB, LAS unsigned char* lds) {
    LAS bf16_t* qs = (LAS bf16_t*)lds;
    LAS bf16_t* ks = qs + 64 * 256;
    LAS float* vf = (LAS float*)(ks + 64 * 256);
    LAS float* ip = vf + 64 * 64;
    LAS float* lf = ip + 64;
    LAS float* part = lf + 64;
    LAS float* dpart = part + 1024;
    const int tid = ltid(a), e = tid & 63, dq = tid >> 6;
    for (int unit = blockIdx.x; unit < 256; unit += gridDim.x) {
        const int eq = unit & 3, d = (unit >> 2) & 1, hd = (unit >> 3) & 3, b = unit >> 5;
        const float ibias = a.in[I_MIB][(l * 2 + d) * 4 + hd], fbias = a.in[I_MFB][(l * 2 + d) * 4 + hd];
        bf16_t* HO = d ? HB : HF;
        float C[32];
#pragma unroll
        for (int j = 0; j < 32; ++j) C[j] = 0.f;
        float nn = 0.f, m = 0.f; int par = 0;
        for (int step = 0; step < 68; ++step) {
            const int cc = (step < 4) ? (d ? 3 - step : step) : (d ? 67 - step : step - 4);
            const int row0 = (step < 4) ? b * 256 + cc * 64 : CTXROWS + b * 4096 + cc * 64;
            __syncthreads();
            for (int i = tid; i < 2048; i += NT) { const int r = i >> 5, c8 = (i & 31) * 8;
                *(LAS u32x4*)(qs + r * 256 + c8) = *(const u32x4*)(Q + (size_t)(row0 + r) * 1024 + hd * 256 + c8);
                *(LAS u32x4*)(ks + r * 256 + c8) = *(const u32x4*)(K + (size_t)(row0 + r) * 1024 + hd * 256 + c8); }
            { const int r = tid >> 3, c8 = (tid & 7) * 8; float f[8]; unpack8(*(const u32x4*)(V + (size_t)(row0 + r) * 1024 + hd * 256 + eq * 64 + c8), f);
#pragma unroll
              for (int j = 0; j < 8; ++j) vf[r * 64 + c8 + j] = f[j]; }
            if (tid < 64) { const float* gp = GATE + (size_t)(row0 + tid) * 32; ip[tid] = gp[d * 4 + hd] + ibias; lf[tid] = -softplusf_(-(gp[8 + d * 4 + hd] + fbias)); }
            __syncthreads();
            for (int tt = 0; tt < 64; ++tt) {
                const int t = d ? 63 - tt : tt;
                const float it = ip[t], ft = lf[t];
                const float mn = fmaxf(ft + m, it);
                const float fdec = __expf(ft + m - mn), iw = __expf(it - mn) * 0.0625f, nrm = __expf(-mn);
                m = mn;
                const float vv = iw * vf[t * 64 + e];
                float pn = 0.f;
#pragma unroll
                for (int j8 = 0; j8 < 4; ++j8) {
                    float kk[8], qq[8];
                    unpack8(*(const LAS u32x4*)(ks + t * 256 + dq * 32 + j8 * 8), kk);
                    unpack8(*(const LAS u32x4*)(qs + t * 256 + dq * 32 + j8 * 8), qq);
#pragma unroll
                    for (int j = 0; j < 8; ++j) { const float c = fdec * C[j8 * 8 + j] + vv * kk[j]; C[j8 * 8 + j] = c; pn += c * qq[j]; }
                }
                const int dn = dq * 32 + (e & 31);
                nn = fdec * nn + iw * bf2f(ks[t * 256 + dn]);
                float pd = (e < 32) ? nn * bf2f(qs[t * 256 + dn]) : 0.f;
                pd = wave_sum(pd, e);
                part[(par * 8 + dq) * 64 + e] = pn; if (e == 0) dpart[par * 8 + dq] = pd;
                __syncthreads();
                if (dq == 0) { float num = 0.f, den = 0.f;
#pragma unroll
                    for (int q = 0; q < 8; ++q) { num += part[(par * 8 + q) * 64 + e]; den += dpart[par * 8 + q]; }
                    HO[(size_t)(row0 + t) * 1024 + hd * 256 + eq * 64 + e] = f2bf(num / fmaxf(fabsf(den), nrm)); }
                par ^= 1;
            }
        }
        __syncthreads();
    }
}
DI void ph_ml_post(const Args& a, int l, bf16_t* HF, const bf16_t* HB, const bf16_t* SO, const bf16_t* SZ) {
    const int tid = ltid(a), wave = tid >> 6, lane = tid & 63;
    const float* g = a.in[I_MNORM] + l * 256 + (lane & 31) * 8;
    const f32x4 g0 = *(const f32x4*)g, g1 = *(const f32x4*)(g + 4);
    const int nit = MROWS * 2, stride = gridDim.x * 8;
    for (int it = blockIdx.x * 8 + wave; it < nit; it += stride) {
        const size_t off = (size_t)it * 512 + lane * 8;
        const u32x4 f0 = *(const u32x4*)(HF + off), b0 = *(const u32x4*)(HB + off), o0 = *(const u32x4*)(SO + off), z0 = *(const u32x4*)(SZ + off);
        float x[8], t0[8];
        unpack8(f0, x); unpack8(b0, t0);
#pragma unroll
        for (int j = 0; j < 8; ++j) x[j] += t0[j];
        unpack8(o0, t0);
        float s0 = 0.f;
#pragma unroll
        for (int j = 0; j < 8; ++j) { x[j] *= t0[j]; s0 += x[j] * x[j]; }
        s0 += swz_xor<1>(s0); s0 += swz_xor<2>(s0); s0 += swz_xor<4>(s0); s0 += swz_xor<8>(s0); s0 += swz_xor<16>(s0);
        const float r0 = rsqrtf(s0 * (1.0f / 256.0f) + 1e-6f);
        unpack8(z0, t0);
        u32x4 w0;
        w0.x = pg8::cvt_pk_bf16(x[0] * r0 * g0[0] * t0[0], x[1] * r0 * g0[1] * t0[1]); w0.y = pg8::cvt_pk_bf16(x[2] * r0 * g0[2] * t0[2], x[3] * r0 * g0[3] * t0[3]);
        w0.z = pg8::cvt_pk_bf16(x[4] * r0 * g1[0] * t0[4], x[5] * r0 * g1[1] * t0[5]); w0.w = pg8::cvt_pk_bf16(x[6] * r0 * g1[2] * t0[6], x[7] * r0 * g1[3] * t0[7]);
        *(u32x4*)(HF + off) = w0;
    }
}

DI void ph_s5_scan(const Args& a, int l, const bf16_t* U, bf16_t* YF, bf16_t* YB, LAS unsigned char* lds) {
    const int tid = ltid(a), w = tid >> 6, p = tid & 63;
    LAS float* ub = (LAS float*)lds + w * 2304;
    LAS float* yb = ub + 1024;
    LAS float* xb = yb + 1024;
    for (int unit = blockIdx.x; unit < 128; unit += gridDim.x) {
        const int gb = unit & 7, d = (unit >> 3) & 1, b = unit >> 4, g = gb * 8 + w;
        const float stp = expf(a.in[I_SLOG][(l * 2 + d) * 64 + g]);
        const float lre = a.in[I_SLRE][((size_t)(l * 2 + d) * 64 + g) * 64 + p], lim = a.in[I_SLIM][((size_t)(l * 2 + d) * 64 + g) * 64 + p];
        const float mag = expf(lre * stp), lbr = mag * cosf(lim * stp), lbi = mag * sinf(lim * stp);
        const float dnm = lre * lre + lim * lim;
        const float fre = ((lbr - 1.0f) * lre + lbi * lim) / dnm, fim = (lbi * lre - (lbr - 1.0f) * lim) / dnm;
        float bbr[16], bbi[16];
        { const float* br = a.in[I_SBRE] + (((size_t)l * 64 + g) * 64 + p) * 16; const float* bi = a.in[I_SBIM] + (((size_t)l * 64 + g) * 64 + p) * 16;
#pragma unroll
          for (int h = 0; h < 16; ++h) { bbr[h] = fre * br[h] - fim * bi[h]; bbi[h] = fre * bi[h] + fim * br[h]; } }
        const int hh = p & 15, pt = p >> 4;
        float cr[16], ci[16];
        { const float* c0 = a.in[I_SCRE] + (((size_t)l * 64 + g) * 16 + hh) * 64 + pt * 16; const float* c1 = a.in[I_SCIM] + (((size_t)l * 64 + g) * 16 + hh) * 64 + pt * 16;
#pragma unroll
          for (int j = 0; j < 16; ++j) { cr[j] = c0[j]; ci[j] = c1[j]; } }
        bf16_t* Y = d ? YB : YF;
        float xr = 0.f, xi = 0.f; int par = 0;
        for (int step = 0; step < 68; ++step) {
            const int cc = (step < 4) ? (d ? 3 - step : step) : (d ? 67 - step : step - 4);
            const int row0 = (step < 4) ? b * 256 + cc * 64 : CTXROWS + b * 4096 + cc * 64;
            __syncthreads();
            { const bf16_t* up = U + (size_t)(row0 + p) * 1024 + g * 16; float f[8];
              unpack8(*(const u32x4*)up, f);
#pragma unroll
              for (int j = 0; j < 8; ++j) ub[p * 16 + j] = f[j];
              unpack8(*(const u32x4*)(up + 8), f);
#pragma unroll
              for (int j = 0; j < 8; ++j) ub[p * 16 + 8 + j] = f[j]; }
            __syncthreads();
            for (int tt = 0; tt < 64; ++tt) {
                const int t = d ? 63 - tt : tt;
                float bur = 0.f, bui = 0.f;
#pragma unroll
                for (int h4 = 0; h4 < 4; ++h4) { const f32x4 u = *(const LAS f32x4*)(ub + t * 16 + h4 * 4);
#pragma unroll
                    for (int j = 0; j < 4; ++j) { bur += bbr[h4 * 4 + j] * u[j]; bui += bbi[h4 * 4 + j] * u[j]; } }
                const float nxr = lbr * xr - lbi * xi + bur, nxi = lbr * xi + lbi * xr + bui;
                xr = nxr; xi = nxi;
                xb[par * 128 + p] = xr; xb[par * 128 + 64 + p] = xi;
                __syncthreads();
                float y = 0.f;
#pragma unroll
                for (int j4 = 0; j4 < 4; ++j4) { const f32x4 vr = *(const LAS f32x4*)(xb + par * 128 + pt * 16 + j4 * 4), vi = *(const LAS f32x4*)(xb + par * 128 + 64 + pt * 16 + j4 * 4);
#pragma unroll
                    for (int j = 0; j < 4; ++j) y += cr[j4 * 4 + j] * vr[j] - ci[j4 * 4 + j] * vi[j]; }
                y += shx(y, 16, p); y += shx(y, 32, p);
                if (p < 16) yb[t * 16 + p] = y;
                par ^= 1;
            }
            __syncthreads();
            { u32x4 w0, w1; const LAS float* ys = yb + p * 16;
              w0.x = pg8::cvt_pk_bf16(ys[0], ys[1]); w0.y = pg8::cvt_pk_bf16(ys[2], ys[3]); w0.z = pg8::cvt_pk_bf16(ys[4], ys[5]); w0.w = pg8::cvt_pk_bf16(ys[6], ys[7]);
              w1.x = pg8::cvt_pk_bf16(ys[8], ys[9]); w1.y = pg8::cvt_pk_bf16(ys[10], ys[11]); w1.z = pg8::cvt_pk_bf16(ys[12], ys[13]); w1.w = pg8::cvt_pk_bf16(ys[14], ys[15]);
              bf16_t* yp = Y + (size_t)(row0 + p) * 1024 + g * 16; *(u32x4*)yp = w0; *(u32x4*)(yp + 8) = w1; }
        }
        __syncthreads();
    }
}
DI void ph_s5_post(const Args& a, int l, bf16_t* YF, const bf16_t* YB, const bf16_t* U) {
    const float* dsk = a.in[I_SD] + l * 1024;
    for (size_t i = (size_t)blockIdx.x * NT + ltid(a); i < (size_t)MROWS * 128; i += (size_t)gridDim.x * NT) {
        const size_t off = i * 8; const int c = (int)(off & 1023);
        float f[8], bq[8], u[8]; unpack8(*(const u32x4*)(YF + off), f); unpack8(*(const u32x4*)(YB + off), bq); unpack8(*(const u32x4*)(U + off), u);
        const f32x4 d0 = *(const f32x4*)(dsk + c), d1 = *(const f32x4*)(dsk + c + 4);
        float o[8];
#pragma unroll
        for (int j = 0; j < 4; ++j) { o[j] = gelu_tanh_(f[j] + bq[j] + d0[j] * u[j]); o[4 + j] = gelu_tanh_(f[4 + j] + bq[4 + j] + d1[j] * u[4 + j]); }
        u32x4 w; w.x = pg8::cvt_pk_bf16(o[0], o[1]); w.y = pg8::cvt_pk_bf16(o[2], o[3]); w.z = pg8::cvt_pk_bf16(o[4], o[5]); w.w = pg8::cvt_pk_bf16(o[6], o[7]);
        *(u32x4*)(YF + off) = w;
    }
}

constexpr int S5_T = 16, S5_NCH = MROWS / S5_T  , S5_RG = 2304, S5_PMG = S5_RG / 256;
constexpr size_t SZ_AX = (size_t)64 * S5_RG * 512 * 2, SZ_CW1 = (size_t)64 * 256 * 256 * 2, SZ_CW2 = (size_t)64 * 256 * 512 * 2;
constexpr size_t R5_AX = 0, R5_SZ = SZ_AX, R5_G1 = R5_SZ + SZ_ACT, R5_GLUA = R5_G1 + SZ_ACT, R5_END = R5_GLUA + SZ_ACT;
static_assert(WS_R + R5_END <= WS_END, "S5 stage layout fits the workspace"); static_assert(WS_END <= (size_t)512 * 1024 * 1024, "workspace budget");
static_assert(SZ_CW1 + SZ_CW2 + (size_t)17 * 1024 * 128 * 4 <= SZ_ACT, "S5 constants live in the H region once the last projection from H is done");

struct EpiS1 {
    static constexpr bool PERM = true, AFTER_DRAIN = false;
    bf16_t* AX; bf16_t* SZ; bf16_t* G1;
    __device__ __forceinline__ void operator()(const f32x4 (&acc)[2][2][4][2], const Unit& u, int wr, int wc, int fr, int fq) const {
        const int row0 = u.pm * 256 + wr * 64 + fr, seg = u.pn >> 2;
        const int col0 = (u.pn & 3) * 256 + wc * 32 + 8 * fq;
#pragma unroll
        for (int ai = 0; ai < 2; ++ai)
#pragma unroll
            for (int m = 0; m < 4; ++m) {
                const int r = row0 + ai * 128 + m * 16;
#pragma unroll
                for (int bj = 0; bj < 2; ++bj) {
                    f32x4 v0 = acc[ai][bj][m][0], v1 = acc[ai][bj][m][1];
                    const int c = col0 + bj * 128;
                    bf16_t* dp;
                    if (seg == 0) dp = AX + ((size_t)(c >> 4) * S5_RG + (r >> 4)) * 512 + (r & 15) * 16 + (c & 15);
                    else if (seg == 1) { dp = SZ + (size_t)r * 1024 + c;
#pragma unroll
                        for (int j = 0; j < 4; ++j) { v0[j] = siluf_(v0[j]); v1[j] = siluf_(v1[j]); } }
                    else { dp = G1 + (size_t)r * 1024 + c;
#pragma unroll
                        for (int j = 0; j < 4; ++j) { v0[j] = sigmoidf_(v0[j]); v1[j] = sigmoidf_(v1[j]); } }
                    u32x4 w; w.x = pg8::cvt_pk_bf16(v0[0], v0[1]); w.y = pg8::cvt_pk_bf16(v0[2], v0[3]); w.z = pg8::cvt_pk_bf16(v1[0], v1[1]); w.w = pg8::cvt_pk_bf16(v1[2], v1[3]);
                    *(u32x4*)dp = w;
                }
            }
    }
};
struct EpiS5L {
    static constexpr bool PERM = true, AFTER_DRAIN = false;
    bf16_t* AX;
    __device__ __forceinline__ void operator()(const f32x4 (&acc)[2][2][4][2], const Unit& u, int wr, int wc, int fr, int fq) const {
        const int g = u.pm / S5_PMG, rg0 = (u.pm % S5_PMG) * 256 + wr * 64 + fr, col0 = wc * 32 + 8 * fq;
#pragma unroll
        for (int ai = 0; ai < 2; ++ai)
#pragma unroll
            for (int m = 0; m < 4; ++m) {
                const int rg = rg0 + ai * 128 + m * 16;
                if (rg < S5_NCH) {
                    bf16_t* rp = AX + ((size_t)g * S5_RG + rg) * 512 + 256 + col0;
#pragma unroll
                    for (int bj = 0; bj < 2; ++bj) { const f32x4 v0 = acc[ai][bj][m][0], v1 = acc[ai][bj][m][1];
                        u32x4 w; w.x = pg8::cvt_pk_bf16(v0[0], v0[1]); w.y = pg8::cvt_pk_bf16(v0[2], v0[3]); w.z = pg8::cvt_pk_bf16(v1[0], v1[1]); w.w = pg8::cvt_pk_bf16(v1[2], v1[3]);
                        *(u32x4*)(rp + bj * 128) = w; }
                }
            }
    }
};
struct EpiS5Y {
    static constexpr bool PERM = true, AFTER_DRAIN = false;
    const bf16_t* AX; bf16_t* GLUA; const float* dsk;
    __device__ __forceinline__ void operator()(const f32x4 (&acc)[2][2][4][2], const Unit& u, int wr, int wc, int fr, int fq) const {
        const int g = u.pm / S5_PMG, rg0 = (u.pm % S5_PMG) * 256 + wr * 64 + fr, col0 = wc * 32 + 8 * fq;
        const int h0 = col0 & 15;
        const f32x4 d0 = *(const f32x4*)(dsk + g * 16 + h0), d1 = *(const f32x4*)(dsk + g * 16 + h0 + 4);
#pragma unroll
        for (int ai = 0; ai < 2; ++ai)
#pragma unroll
            for (int m = 0; m < 4; ++m) {
                const int rg = rg0 + ai * 128 + m * 16;
                if (rg < S5_NCH) {
#pragma unroll
                    for (int bj = 0; bj < 2; ++bj) {
                        const int c = col0 + bj * 128, t = c >> 4;
                        float uu[8]; unpack8(*(const u32x4*)(AX + ((size_t)g * S5_RG + rg) * 512 + c), uu);
                        const f32x4 v0 = acc[ai][bj][m][0], v1 = acc[ai][bj][m][1];
                        float o[8];
#pragma unroll
                        for (int j = 0; j < 4; ++j) { o[j] = gelu_tanh_(v0[j] + d0[j] * uu[j]); o[4 + j] = gelu_tanh_(v1[j] + d1[j] * uu[4 + j]); }
                        u32x4 w; w.x = pg8::cvt_pk_bf16(o[0], o[1]); w.y = pg8::cvt_pk_bf16(o[2], o[3]); w.z = pg8::cvt_pk_bf16(o[4], o[5]); w.w = pg8::cvt_pk_bf16(o[6], o[7]);
                        *(u32x4*)(GLUA + (size_t)(rg * 16 + t) * 1024 + g * 16 + h0) = w;
                    }
                }
            }
    }
};
DI void ph_s5_consts(const Args& a, int l, bf16_t* CW1, bf16_t* CW2, LAS unsigned char* lds) {
    LAS float* POW = (LAS float*)lds;
    LAS float* BB = POW + 2 * 17 * 64 * 2;
    LAS float* CC = BB + 2 * 64 * 16 * 2;
    LAS float* KT = CC + 16 * 64 * 2;
    const int tid = ltid(a);
    for (int g = blockIdx.x; g < 64; g += gridDim.x) {
        __syncthreads();
        for (int i = tid; i < 2 * 17 * 64; i += NT) {
            const int p = i & 63, j = (i >> 6) % 17, d = i / (17 * 64);
            const float stp = expf(a.in[I_SLOG][(l * 2 + d) * 64 + g]);
            const float lre = a.in[I_SLRE][((size_t)(l * 2 + d) * 64 + g) * 64 + p], lim = a.in[I_SLIM][((size_t)(l * 2 + d) * 64 + g) * 64 + p];
            const float mag = expf((float)j * lre * stp), ang = (float)j * (lim * stp);
            POW[i * 2] = mag * cosf(ang); POW[i * 2 + 1] = mag * sinf(ang);
        }
        for (int i = tid; i < 16 * 64; i += NT) { const int p = i & 63, h = i >> 6;
            CC[i * 2] = a.in[I_SCRE][(((size_t)l * 64 + g) * 16 + h) * 64 + p]; CC[i * 2 + 1] = a.in[I_SCIM][(((size_t)l * 64 + g) * 16 + h) * 64 + p]; }
        __syncthreads();
        for (int i = tid; i < 2 * 64 * 16; i += NT) {
            const int h = i & 15, p = (i >> 4) & 63, d = i >> 10;
            const float stp = expf(a.in[I_SLOG][(l * 2 + d) * 64 + g]);
            const float lre = a.in[I_SLRE][((size_t)(l * 2 + d) * 64 + g) * 64 + p], lim = a.in[I_SLIM][((size_t)(l * 2 + d) * 64 + g) * 64 + p];
            const float lbr = POW[((d * 17 + 1) * 64 + p) * 2], lbi = POW[((d * 17 + 1) * 64 + p) * 2 + 1];
            const float dnm = lre * lre + lim * lim;
            const float fre = ((lbr - 1.0f) * lre + lbi * lim) / dnm, fim = (lbi * lre - (lbr - 1.0f) * lim) / dnm;
            const float br = a.in[I_SBRE][(((size_t)l * 64 + g) * 64 + p) * 16 + h], bi = a.in[I_SBIM][(((size_t)l * 64 + g) * 64 + p) * 16 + h];
            BB[i * 2] = fre * br - fim * bi; BB[i * 2 + 1] = fre * bi + fim * br;
        }
        __syncthreads();
        { const int hp = tid & 15, h = (tid >> 4) & 15, d = tid >> 8;
          float kt[16];
#pragma unroll
          for (int tau = 0; tau < 16; ++tau) kt[tau] = 0.f;
          for (int p = 0; p < 64; ++p) {
              const float cr = CC[(h * 64 + p) * 2], ci = CC[(h * 64 + p) * 2 + 1];
              const float br = BB[((d * 64 + p) * 16 + hp) * 2], bi = BB[((d * 64 + p) * 16 + hp) * 2 + 1];
              const float gr = cr * br - ci * bi, gi = cr * bi + ci * br;
#pragma unroll
              for (int tau = 0; tau < 16; ++tau) { const float pr = POW[((d * 17 + tau) * 64 + p) * 2], pi = POW[((d * 17 + tau) * 64 + p) * 2 + 1]; kt[tau] += gr * pr - gi * pi; } }
#pragma unroll
          for (int tau = 0; tau < 16; ++tau) KT[((d * 16 + tau) * 16 + h) * 16 + hp] = kt[tau]; }
        __syncthreads();
        bf16_t* c1 = CW1 + (size_t)g * 65536;
        for (int i = tid; i < 65536 / 2; i += NT) {
            const int k = (i * 2) & 255, n = (i * 2) >> 8; const int p = n & 63, ri = (n >> 6) & 1, d = n >> 7, s = k >> 4, hp = k & 15;
            const int j = d ? s : 15 - s;
            const float pr = POW[((d * 17 + j) * 64 + p) * 2], pi = POW[((d * 17 + j) * 64 + p) * 2 + 1];
            float o[2];
#pragma unroll
            for (int q = 0; q < 2; ++q) { const float br = BB[((d * 64 + p) * 16 + hp + q) * 2], bi = BB[((d * 64 + p) * 16 + hp + q) * 2 + 1]; o[q] = ri ? (pr * bi + pi * br) : (pr * br - pi * bi); }
            *(unsigned*)(c1 + (size_t)n * 256 + k) = pg8::cvt_pk_bf16(o[0], o[1]);
        }
        bf16_t* c2 = CW2 + (size_t)g * 131072;
        for (int i = tid; i < 131072 / 2; i += NT) {
            const int k = (i * 2) & 511, n = (i * 2) >> 9; const int t = n >> 4, h = n & 15;
            float o[2];
            if (k < 256) { const int s = k >> 4, hp = k & 15;
#pragma unroll
                for (int q = 0; q < 2; ++q) { float v = 0.f; if (s <= t) v += KT[((0 * 16 + (t - s)) * 16 + h) * 16 + hp + q]; if (s >= t) v += KT[((1 * 16 + (s - t)) * 16 + h) * 16 + hp + q]; o[q] = v; } }
            else { const int kk = k - 256, d = kk >> 7, ri = (kk >> 6) & 1; const int j = d ? 16 - t : t + 1;
#pragma unroll
                for (int q = 0; q < 2; ++q) { const int p = (kk & 63) + q; const float cr = CC[(h * 64 + p) * 2], ci = CC[(h * 64 + p) * 2 + 1];
                    const float pr = POW[((d * 17 + j) * 64 + p) * 2], pi = POW[((d * 17 + j) * 64 + p) * 2 + 1];
                    o[q] = ri ? -(cr * pi + ci * pr) : (cr * pr - ci * pi); } }
            *(unsigned*)(c2 + (size_t)n * 512 + k) = pg8::cvt_pk_bf16(o[0], o[1]);
        }
    }
    __syncthreads();
}
DI int s5_row(int b, int d, int st) { const int cc = (st < 16) ? (d ? 15 - st : st) : (d ? 271 - st : st - 16); return (st < 16) ? b * 16 + cc : 128 + b * 256 + cc; }
DI void s5_lane_consts(const Args& a, int l, int d, int g, int p, float& ar, float& ai) {
    const float stp = expf(a.in[I_SLOG][(l * 2 + d) * 64 + g]);
    const float lre = a.in[I_SLRE][((size_t)(l * 2 + d) * 64 + g) * 64 + p], lim = a.in[I_SLIM][((size_t)(l * 2 + d) * 64 + g) * 64 + p];
    const float mag = expf(16.0f * lre * stp), ang = 16.0f * (lim * stp);
    ar = mag * cosf(ang); ai = mag * sinf(ang);
}
DI void ph_s5_carry1(const Args& a, int l, bf16_t* AX, float* SEG) {
    const int tid = ltid(a), w = tid >> 6, p = tid & 63;
    for (int item = blockIdx.x * 8 + w; item < 17 * 1024; item += gridDim.x * 8) {
        const int unit = item & 1023, seg = item >> 10, d = unit & 1, g = (unit >> 1) & 63, b = unit >> 7;
        float ar, ai; s5_lane_consts(a, l, d, g, p, ar, ai);
        bf16_t* base = AX + (size_t)g * S5_RG * 512 + 256 + d * 128 + p;
        float lr[16], li[16];
#pragma unroll
        for (int q = 0; q < 16; ++q) { const size_t o = (size_t)s5_row(b, d, seg * 16 + q) * 512; lr[q] = bf2f(base[o]); li[q] = bf2f(base[o + 64]); }
        float xr = 0.f, xi = 0.f;
#pragma unroll
        for (int q = 0; q < 16; ++q) { const size_t o = (size_t)s5_row(b, d, seg * 16 + q) * 512;
            base[o] = f2bf(xr); base[o + 64] = f2bf(xi);
            const float nr = ar * xr - ai * xi + lr[q], ni = ar * xi + ai * xr + li[q]; xr = nr; xi = ni; }
        SEG[((size_t)seg * 1024 + unit) * 128 + p] = xr; SEG[((size_t)seg * 1024 + unit) * 128 + 64 + p] = xi;
    }
}
DI void ph_s5_carry2(const Args& a, int l, bf16_t* AX, const float* SEG) {
    const int tid = ltid(a), w = tid >> 6, p = tid & 63;
    for (int item = blockIdx.x * 8 + w; item < 16 * 1024; item += gridDim.x * 8) {
        const int unit = item & 1023, seg = 1 + (item >> 10), d = unit & 1, g = (unit >> 1) & 63, b = unit >> 7;
        float ar, ai; s5_lane_consts(a, l, d, g, p, ar, ai);
        float sr = ar, si = ai;
#pragma unroll
        for (int q = 0; q < 4; ++q) { const float nr = sr * sr - si * si, ni = 2.0f * sr * si; sr = nr; si = ni; }
        float xr = 0.f, xi = 0.f;
        { float er[16], ei[16];
#pragma unroll
          for (int s2 = 0; s2 < 16; ++s2) { const bool on = s2 < seg; er[s2] = on ? SEG[((size_t)s2 * 1024 + unit) * 128 + p] : 0.f; ei[s2] = on ? SEG[((size_t)s2 * 1024 + unit) * 128 + 64 + p] : 0.f; }
#pragma unroll
          for (int s2 = 0; s2 < 16; ++s2) if (s2 < seg) { const float nr = sr * xr - si * xi + er[s2], ni = sr * xi + si * xr + ei[s2]; xr = nr; xi = ni; } }
        bf16_t* base = AX + (size_t)g * S5_RG * 512 + 256 + d * 128 + p;
        float lr[16], li[16];
#pragma unroll
        for (int q = 0; q < 16; ++q) { const size_t o = (size_t)s5_row(b, d, seg * 16 + q) * 512; lr[q] = bf2f(base[o]); li[q] = bf2f(base[o + 64]); }
#pragma unroll
        for (int q = 0; q < 16; ++q) { const size_t o = (size_t)s5_row(b, d, seg * 16 + q) * 512;
            base[o] = f2bf(lr[q] + xr); base[o + 64] = f2bf(li[q] + xi);
            const float nr = ar * xr - ai * xi, ni = ar * xi + ai * xr; xr = nr; xi = ni; }
    }
}

#ifndef SUBDUP
#define SUBDUP 0
#endif
typedef short bf16x8v __attribute__((ext_vector_type(8)));
typedef short s16x4v __attribute__((ext_vector_type(4)));
typedef __bf16 bfx2_t __attribute__((ext_vector_type(2)));
typedef float f32x2_t __attribute__((ext_vector_type(2)));
#define MFMA16(a_, b_, c_) __builtin_amdgcn_mfma_f32_16x16x32_bf16((a_), (b_), (c_), 0, 0, 0)
DI unsigned pk2(float lo, float hi) { const bfx2_t v = __builtin_convertvector((f32x2_t){lo, hi}, bfx2_t); return __builtin_bit_cast(unsigned, v); }
DI int sw512(int r, int cb) { return r * 512 + (cb ^ ((r & 15) << 4)); }
DI int sw128(int r, int cb) { return r * 128 + (cb ^ ((r & 7) << 4)); }
DI bf16x8v ldsfrag(LAS unsigned char* base, int off) { return *(const LAS bf16x8v*)(base + off); }
DI bf16x8v ldsfrag2(LAS unsigned char* base, int off0, int off1) { const s16x4v lo = *(const LAS s16x4v*)(base + off0), hi = *(const LAS s16x4v*)(base + off1); return __builtin_shufflevector(lo, hi, 0, 1, 2, 3, 4, 5, 6, 7); }
constexpr int ML_GSET = 448;
DI void ml_gates(float igr, float fgr, float ibias, float fbias, int d, float& ms, LAS float* gs, int L) {
    asm volatile("" : "+v"(L));
    const int t = d ? 63 - L : L;
    const float ipv = igr + ibias, lfv = -softplusf_(-(fgr + fbias));
    const float bc = dpp_scan_sum(lfv);
    const float aj = ipv - bc;
    const float cm = dpp_scan_max(aj);
    const float mt = fmaxf(bc + ms, bc + cm);
    const float bend = lane63(bc);
    const float le = bend - bc + ipv;
    const float mle = lane63(dpp_scan_max(le));
    const float mnew = fmaxf(bend + ms, mle);
    gs[t] = bc; gs[64 + t] = aj; gs[128 + t] = mt; gs[192 + t] = __expf(bc + ms - mt); gs[256 + t] = __expf(-mt); gs[320 + t] = __expf(le - mnew) * 0.0625f;
    if (L == 0) gs[384] = __expf(bend + ms - mnew);
    ms = mnew;
}
DI bf16x8v ldstr2(LAS unsigned char* p0, LAS unsigned char* p1) {
    const s16x4v lo = __builtin_amdgcn_ds_read_tr16_b64_v4i16((LAS s16x4v*)p0), hi = __builtin_amdgcn_ds_read_tr16_b64_v4i16((LAS s16x4v*)p1);
    return __builtin_shufflevector(lo, hi, 0, 1, 2, 3, 4, 5, 6, 7); }
DI void ph_ml_scan_mfma(const Args& a, int l, const bf16_t* Q, const bf16_t* K, const bf16_t* V, const float* GATE, bf16_t* HF, bf16_t* HB, LAS unsigned char* lds) {
    constexpr int PQ = 528, PK = 544, PV = 160, PW = 144;
    LAS unsigned char* qs = lds;
    LAS unsigned char* kn = lds + 33792;
    LAS unsigned char* vn = lds + 68608;
    LAS unsigned char* vs = lds + 78848;
    LAS unsigned char* Wm = lds + 89088;
    LAS float* sm = (LAS float*)(lds + 98304);
    LAS float* rsW = sm + 2 * ML_GSET; LAS float* qn = rsW + 128; LAS float* nvec = qn + 128;
    const int tid = ltid(a), w = tid >> 6, ln = tid & 63, l16 = ln & 15, h4 = ln >> 4, tq = (ln & 15) >> 2, tp = ln & 3;
    for (int unit = blockIdx.x; unit < 256; unit += gridDim.x) {
        const int eh = unit & 3, d = (unit >> 2) & 1, hd = (unit >> 3) & 3, b = unit >> 5;
        const float ibias = a.in[I_MIB][(l * 2 + d) * 4 + hd], fbias = a.in[I_MFB][(l * 2 + d) * 4 + hd];
        bf16_t* HO = d ? HB : HF;
        f32x4 Cacc[16];
#pragma unroll
        for (int i = 0; i < 16; ++i) Cacc[i] = (f32x4){0.f, 0.f, 0.f, 0.f};
        float ms = 0.f;
        __syncthreads();
        if (tid < 256) nvec[tid] = 0.f;
#define ML_ROW0(step) (((step) < 4) ? b * 256 + (d ? 3 - (step) : (step)) * 64 : CTXROWS + b * 4096 + (d ? 67 - (step) : (step) - 4) * 64)
        u32x4 pq[4], pk[4], pv[1]; float gi = 0.f, gf = 0.f;
        { const int row0 = ML_ROW0(0);
#pragma unroll
          for (int q = 0; q < 4; ++q) { const int p = tid + 512 * q, r = p >> 5, c8 = p & 31; pq[q] = *(const u32x4*)(Q + (size_t)(row0 + r) * 1024 + hd * 256 + c8 * 8); pk[q] = *(const u32x4*)(K + (size_t)(row0 + r) * 1024 + hd * 256 + c8 * 8); }
#pragma unroll
          for (int q = 0; q < 1; ++q) { const int r = tid >> 3, c8 = tid & 7; pv[q] = *(const u32x4*)(V + (size_t)(row0 + r) * 1024 + hd * 256 + eh * 64 + c8 * 8); }
          if (w == 7) { const int t = d ? 63 - ln : ln; const float* gp = GATE + (size_t)(row0 + t) * 32; gi = gp[d * 4 + hd]; gf = gp[8 + d * 4 + hd]; ml_gates(gi, gf, ibias, fbias, d, ms, sm, ln); } }
        __syncthreads();
        for (int step = 0; step < 68; ++step) {
            const int par = step & 1; LAS float* gs = sm + par * ML_GSET;
            const int row0 = ML_ROW0(step);
            for (int sr_ = 0; sr_ < (SUBDUP == 12 ? 2 : 1); ++sr_) {
#pragma unroll
            for (int q = 0; q < 4; ++q) { const int p = tid + 512 * q, r = p >> 5, c8 = p & 31;
                *(LAS u32x4*)(qs + r * PQ + c8 * 16) = pq[q]; *(LAS u32x4*)(kn + r * PK + c8 * 16) = pk[q]; }
#pragma unroll
            for (int q = 0; q < 1; ++q) { const int r = tid >> 3, c8 = tid & 7;
                *(LAS u32x4*)(vn + r * PV + c8 * 16) = pv[q];
                float f[8]; unpack8(pv[q], f); const float ws = gs[320 + r];
                u32x4 o; o.x = pk2(f[0] * ws, f[1] * ws); o.y = pk2(f[2] * ws, f[3] * ws); o.z = pk2(f[4] * ws, f[5] * ws); o.w = pk2(f[6] * ws, f[7] * ws);
                *(LAS u32x4*)(vs + r * PV + c8 * 16) = o; }
            }
            if (step + 1 < 68) { const int rown = ML_ROW0(step + 1);
#pragma unroll
                for (int q = 0; q < 4; ++q) { const int p = tid + 512 * q, r = p >> 5, c8 = p & 31; pq[q] = *(const u32x4*)(Q + (size_t)(rown + r) * 1024 + hd * 256 + c8 * 8); pk[q] = *(const u32x4*)(K + (size_t)(rown + r) * 1024 + hd * 256 + c8 * 8); }
#pragma unroll
                for (int q = 0; q < 1; ++q) { const int r = tid >> 3, c8 = tid & 7; pv[q] = *(const u32x4*)(V + (size_t)(rown + r) * 1024 + hd * 256 + eh * 64 + c8 * 8); }
                if (w == 7) { const int t = d ? 63 - ln : ln; const float* gp = GATE + (size_t)(rown + t) * 32; gi = gp[d * 4 + hd]; gf = gp[8 + d * 4 + hd]; } }
            lds_barrier();
            for (int sr_ = 0; sr_ < (SUBDUP == 11 ? 2 : 1); ++sr_) { const int it = w >> 1, jp = w & 1, i = it * 16 + l16;
              f32x4 a0 = (f32x4){0.f, 0.f, 0.f, 0.f}, a1 = a0;
              LAS unsigned char* qb = qs + (it * 16 + l16) * PQ + h4 * 16; LAS unsigned char* kb = kn + ((2 * jp) * 16 + l16) * PK + h4 * 16;
              f32x4 qacc = (f32x4){0.f, 0.f, 0.f, 0.f};
#pragma unroll
              for (int ks = 0; ks < 8; ++ks) {
                  const bf16x8v bq = ldsfrag(qb, ks * 64);
                  const bf16x8v k0 = ldsfrag(kb, ks * 64), k1 = ldsfrag(kb, 16 * PK + ks * 64);
                  a0 = MFMA16(k0, bq, a0); a1 = MFMA16(k1, bq, a1);
                  if ((ks >> 2) == jp) {
                      const f32x4 n0 = *(const LAS f32x4*)(nvec + 32 * ks + 8 * h4), n1 = *(const LAS f32x4*)(nvec + 32 * ks + 8 * h4 + 4);
                      u32x4 nw; nw.x = pk2(n0[0], n0[1]); nw.y = pk2(n0[2], n0[3]); nw.z = pk2(n1[0], n1[1]); nw.w = pk2(n1[2], n1[3]);
                      qacc = MFMA16(bq, __builtin_bit_cast(bf16x8v, nw), qacc); } }
              if (l16 == 0) *(LAS f32x4*)(qn + jp * 64 + it * 16 + 4 * h4) = qacc;
              const float bci = gs[i], mti = gs[128 + i];
              float rs = 0.f;
#pragma unroll
              for (int t2 = 0; t2 < 2; ++t2) { const int j0 = (2 * jp + t2) * 16 + 4 * h4; const f32x4 ajv = *(const LAS f32x4*)(gs + 64 + j0); const f32x4 av = t2 ? a1 : a0;
                  float wv[4];
#pragma unroll
                  for (int r = 0; r < 4; ++r) { const int j = j0 + r; const bool valid = d ? (j >= i) : (j <= i); const float e = __expf(bci + ajv[r] - mti) * av[r] * 0.0625f; wv[r] = valid ? e : 0.f; rs += wv[r]; }
                  u32x2 pw; pw.x = pk2(wv[0], wv[1]); pw.y = pk2(wv[2], wv[3]);
                  *(LAS u32x2*)(Wm + i * PW + j0 * 2) = pw; }
              int lnl = ln; asm volatile("" : "+v"(lnl)); rs += shx(rs, 16, lnl); rs += shx(rs, 32, lnl);
              if (h4 == 0) rsW[jp * 64 + i] = rs;
            }
            lds_barrier();
            if (w < 4) { f32x4 num[4];
#pragma unroll
              for (int it = 0; it < 4; ++it) num[it] = (f32x4){0.f, 0.f, 0.f, 0.f};
              LAS unsigned char* qb2 = qs + l16 * PQ + 8 * h4;
              { bf16x8v af[4];
#pragma unroll
                for (int it = 0; it < 4; ++it) af[it] = ldsfrag2(qb2, it * 16 * PQ, it * 16 * PQ + 32);
#pragma unroll
                for (int ks = 0; ks < 8; ++ks) {
                    u32x4 bw; bw.x = pk2(Cacc[2 * ks][0], Cacc[2 * ks][1]); bw.y = pk2(Cacc[2 * ks][2], Cacc[2 * ks][3]); bw.z = pk2(Cacc[2 * ks + 1][0], Cacc[2 * ks + 1][1]); bw.w = pk2(Cacc[2 * ks + 1][2], Cacc[2 * ks + 1][3]);
                    const bf16x8v bfr = __builtin_bit_cast(bf16x8v, bw);
                    bf16x8v nf[4];
#pragma unroll
                    for (int it = 0; it < 4; ++it) nf[it] = (ks + 1 < 8) ? ldsfrag2(qb2, it * 16 * PQ + 64 * (ks + 1), it * 16 * PQ + 64 * (ks + 1) + 32) : af[it];
#pragma unroll
                    for (int it = 0; it < 4; ++it) num[it] = MFMA16(af[it], bfr, num[it]);
#pragma unroll
                    for (int it = 0; it < 4; ++it) af[it] = nf[it];
                    asm volatile("" ::: "memory"); } }
#pragma unroll
              for (int it = 0; it < 4; ++it) { const f32x4 wi = *(const LAS f32x4*)(gs + 192 + it * 16 + 4 * h4); num[it] = num[it] * wi; }
              LAS unsigned char* trb = (LAS unsigned char*)0 + (8 * h4 + tq) * PV + 8 * tp + 32 * w;
              bf16x8v bv[2];
#pragma unroll
              for (int kk = 0; kk < 2; ++kk) bv[kk] = ldstr2(vn + (size_t)trb + (32 * kk) * PV, vn + (size_t)trb + (32 * kk + 4) * PV);
              LAS unsigned char* wb = Wm + l16 * PW + 16 * h4;
#pragma unroll
              for (int kk = 0; kk < 2; ++kk)
#pragma unroll
                  for (int it = 0; it < 4; ++it) { const bf16x8v aw = ldsfrag(wb, it * 16 * PW + 64 * kk); num[it] = MFMA16(aw, bv[kk], num[it]); }
              asm volatile("" ::: "memory");
#pragma unroll
              for (int it = 0; it < 4; ++it) { const int i0 = it * 16 + 4 * h4;
                  const f32x4 r0 = *(const LAS f32x4*)(rsW + i0), r1 = *(const LAS f32x4*)(rsW + 64 + i0), wi = *(const LAS f32x4*)(gs + 192 + i0), qv = *(const LAS f32x4*)(qn + i0) + *(const LAS f32x4*)(qn + 64 + i0), nr = *(const LAS f32x4*)(gs + 256 + i0);
#pragma unroll
                  for (int r = 0; r < 4; ++r) { const float den = r0[r] + r1[r] + wi[r] * qv[r]; const float hv = num[it][r] * __builtin_amdgcn_rcpf(fmaxf(fabsf(den), nr[r]));
                      HO[(size_t)(row0 + i0 + r) * 1024 + hd * 256 + eh * 64 + 16 * w + l16] = (bf16_t)(pk2(hv, 0.f) & 0xffffu); } asm volatile("" ::: "memory"); }
              const float decay = gs[384];
              bf16x8v bs[2];
#pragma unroll
              for (int kk = 0; kk < 2; ++kk) bs[kk] = ldstr2(vs + (size_t)trb + (32 * kk) * PV, vs + (size_t)trb + (32 * kk + 4) * PV);
#pragma unroll
              for (int dt = 0; dt < 16; ++dt) Cacc[dt] = Cacc[dt] * decay;
              LAS unsigned char* ktb = kn + (8 * h4 + tq) * PK + 8 * tp;
              { bf16x8v ak0 = ldstr2(ktb, ktb + 4 * PK), ak1 = ldstr2(ktb + 32 * PK, ktb + 36 * PK);
#pragma unroll
                for (int dt = 0; dt < 16; ++dt) {
                    bf16x8v n0 = ak0, n1 = ak1;
                    if (dt + 1 < 16) { n0 = ldstr2(ktb + 32 * (dt + 1), ktb + 4 * PK + 32 * (dt + 1)); n1 = ldstr2(ktb + 32 * PK + 32 * (dt + 1), ktb + 36 * PK + 32 * (dt + 1)); }
                    Cacc[dt] = MFMA16(ak0, bs[0], Cacc[dt]); Cacc[dt] = MFMA16(ak1, bs[1], Cacc[dt]);
                    ak0 = n0; ak1 = n1; asm volatile("" ::: "memory"); } }
            } else { const float decay = gs[384]; const int dn = tid - 256; float s = 0.f;
#pragma unroll 8
                for (int j = 0; j < 64; ++j) s += gs[320 + j] * bf2f(*(const LAS bf16_t*)(kn + j * PK + 2 * dn));
                nvec[dn] = decay * nvec[dn] + s;
                if (w == 7 && step + 1 < 68) ml_gates(gi, gf, ibias, fbias, d, ms, sm + (par ^ 1) * ML_GSET, ln); }
            lds_barrier();
        }
#undef ML_ROW0
    }
}

#ifndef SUBDUP
#define SUBDUP 0
#endif
#define MFMA16K16(a_, b_, c_) __builtin_amdgcn_mfma_f32_16x16x16bf16_1k((a_), (b_), (c_), 0, 0, 0)
DI s16x4v pack4(const f32x4 v) { u32x2 w; w.x = pk2(v[0], v[1]); w.y = pk2(v[2], v[3]); return __builtin_bit_cast(s16x4v, w); }
DI s16x4v lds8(LAS unsigned char* p) { return *(const LAS s16x4v*)p; }
DI s16x4v ldstr1(LAS unsigned char* p) { return __builtin_amdgcn_ds_read_tr16_b64_v4i16((LAS s16x4v*)p); }
constexpr int GD_GSET = 384;
DI void gdn_gates(float araw, float braw, float nea, float dtb, LAS float* gs, int L, int d) {
    asm volatile("" : "+v"(L));
    const int t = d ? 63 - L : L;
    const float gc = dpp_scan_sum(nea * softplusf_(araw + dtb));
    const float gl = lane63(gc);
    gs[t] = gc; gs[64 + t] = sigmoidf_(braw); gs[128 + t] = __expf(gc); gs[192 + t] = __expf(gl - gc);
    if (L == 0) gs[256] = __expf(gl);
}
DI void ph_gdn_scan_mfma(const Args& a, int l, const bf16_t* Q, const bf16_t* K, const bf16_t* V, const float* GATE, bf16_t* OF, bf16_t* OB, LAS unsigned char* lds) {
    constexpr int PQ = 272, PK = 288, PV = 160, PA = 144, PD = 48;
    LAS unsigned char* qh = lds;
    LAS unsigned char* kh = lds + 17408;
    LAS unsigned char* vv = lds + 35840;
    LAS unsigned char* AM = lds + 54272;
    LAS unsigned char* QM = lds + 63488;
    LAS unsigned char* DINV = lds + 72704;
    LAS float* sm = (LAS float*)(lds + 75776);
    LAS float* nAd = (LAS float*)(lds + 78848);
    const int tid = ltid(a), w = tid >> 6, ln = tid & 63, l16 = ln & 15, h4 = ln >> 4, tq = (ln & 15) >> 2, tp = ln & 3;
    for (int unit = blockIdx.x; unit < 256; unit += gridDim.x) {
        const int eh = unit & 1, d = (unit >> 1) & 1, h = (unit >> 2) & 7, b = unit >> 5;
        const float nea = -__expf(a.in[I_GALOG][(l * 2 + d) * 8 + h]), dtb = a.in[I_GDTB][(l * 2 + d) * 8 + h];
        bf16_t* O = d ? OB : OF;
        f32x4 S[8];
#pragma unroll
        for (int i = 0; i < 8; ++i) S[i] = (f32x4){0.f, 0.f, 0.f, 0.f};
#define GD_ROW0(step) (((step) < 4) ? b * 256 + (d ? 3 - (step) : (step)) * 64 : CTXROWS + b * 4096 + (d ? 67 - (step) : (step) - 4) * 64)
        u32x4 pq[2], pk[2], pv[1]; float ga = 0.f, gb = 0.f;
        __syncthreads();
        { const int row0 = GD_ROW0(0);
#pragma unroll
          for (int q = 0; q < 2; ++q) { const int p = tid + 512 * q, r = p >> 4, c8 = p & 15; const size_t go = (size_t)(row0 + r) * 1024 + h * 128 + c8 * 8;
              pq[q] = *(const u32x4*)(Q + go); pk[q] = *(const u32x4*)(K + go); }
          pv[0] = *(const u32x4*)(V + (size_t)(row0 + (tid >> 3)) * 1024 + h * 128 + eh * 64 + (tid & 7) * 8);
          if (w == 5) { const int t = d ? 63 - ln : ln; const float* gp = GATE + (size_t)(row0 + t) * 32; ga = gp[d * 8 + h]; gb = gp[16 + d * 8 + h]; gdn_gates(ga, gb, nea, dtb, sm, ln, d); } }
        __syncthreads();
        for (int step = 0; step < 68; ++step) {
            const int par = step & 1; LAS float* gs = sm + par * GD_GSET;
            const int row0 = GD_ROW0(step);
#pragma unroll
            for (int q = 0; q < 2; ++q) { const int p = tid + 512 * q, r = p >> 4, c8 = p & 15;
                *(LAS u32x4*)(qh + r * PQ + c8 * 16) = pq[q]; *(LAS u32x4*)(kh + r * PK + c8 * 16) = pk[q]; }
            *(LAS u32x4*)(vv + (tid >> 3) * PV + (tid & 7) * 16) = pv[0];
            if (step + 1 < 68) { const int rown = GD_ROW0(step + 1);
#pragma unroll
                for (int q = 0; q < 2; ++q) { const int p = tid + 512 * q, r = p >> 4, c8 = p & 15; const size_t go = (size_t)(rown + r) * 1024 + h * 128 + c8 * 8;
                    pq[q] = *(const u32x4*)(Q + go); pk[q] = *(const u32x4*)(K + go); }
                pv[0] = *(const u32x4*)(V + (size_t)(rown + (tid >> 3)) * 1024 + h * 128 + eh * 64 + (tid & 7) * 8);
                if (w == 5) { const int t = d ? 63 - ln : ln; const float* gp = GATE + (size_t)(rown + t) * 32; ga = gp[d * 8 + h]; gb = gp[16 + d * 8 + h]; } }
            lds_barrier(); if (SUBDUP == 5) lds_barrier();
            for (int sr_ = 0; sr_ < (SUBDUP == 1 ? 2 : 1); ++sr_) { const int it = w >> 1, jp = w & 1, i = it * 16 + l16;
              f32x4 kk0 = (f32x4){0.f, 0.f, 0.f, 0.f}, kk1 = kk0, qk0 = kk0, qk1 = kk0;
              LAS unsigned char* kb = kh + ((2 * jp) * 16 + l16) * PK + h4 * 16; LAS unsigned char* xk = kh + i * PK + h4 * 16; LAS unsigned char* xq = qh + i * PQ + h4 * 16;
#pragma unroll
              for (int ks = 0; ks < 4; ++ks) { const bf16x8v a0 = ldsfrag(kb, ks * 64), a1 = ldsfrag(kb, 16 * PK + ks * 64), bk = ldsfrag(xk, ks * 64), bq = ldsfrag(xq, ks * 64);
                  kk0 = MFMA16(a0, bk, kk0); kk1 = MFMA16(a1, bk, kk1); qk0 = MFMA16(a0, bq, qk0); qk1 = MFMA16(a1, bq, qk1); }
              const float gci = gs[i], bi = gs[64 + i];
#pragma unroll
              for (int t2 = 0; t2 < 2; ++t2) { const int j0 = (2 * jp + t2) * 16 + 4 * h4; const f32x4 gcj = *(const LAS f32x4*)(gs + j0); const f32x4 kkv = t2 ? kk1 : kk0, qkv = t2 ? qk1 : qk0;
                  float am[4], qm[4];
#pragma unroll
                  for (int r = 0; r < 4; ++r) { const int j = j0 + r; const bool valid = d ? (j >= i) : (j <= i); const float e = __expf(gci - gcj[r]);
                      am[r] = (valid && j != i) ? -bi * kkv[r] * e : 0.f; qm[r] = valid ? qkv[r] * e : 0.f; }
                  u32x2 pa, pm; pa.x = pk2(am[0], am[1]); pa.y = pk2(am[2], am[3]); pm.x = pk2(qm[0], qm[1]); pm.y = pk2(qm[2], qm[3]);
                  *(LAS u32x2*)(AM + i * PA + j0 * 2) = pa; *(LAS u32x2*)(QM + i * PA + j0 * 2) = pm;
                  if (2 * jp + t2 == it) { const int ipos = d ? 15 - l16 : l16;
#pragma unroll
                      for (int r = 0; r < 4; ++r) { const int jpos = d ? 15 - (4 * h4 + r) : 4 * h4 + r; nAd[(it * 16 + ipos) * 16 + jpos] = am[r]; } } } }
            lds_barrier(); if (SUBDUP == 5) lds_barrier();
            for (int sr_ = 0; sr_ < (SUBDUP == 2 ? 2 : 1); ++sr_) if (w == 4) { const int I = ln >> 4, c = ln & 15, cp = d ? 15 - c : c;
                float Dr[16];
                Dr[0] = (cp == 0) ? 1.f : 0.f;
#pragma unroll
                for (int ip = 1; ip < 16; ++ip) {
                    float av[16];
#pragma unroll
                    for (int q4 = 0; q4 < 4; ++q4) { if (q4 * 4 < ip) { const f32x4 x = *(const LAS f32x4*)(nAd + (I * 16 + ip) * 16 + q4 * 4); av[q4 * 4] = x[0]; av[q4 * 4 + 1] = x[1]; av[q4 * 4 + 2] = x[2]; av[q4 * 4 + 3] = x[3]; } }
                    float s = (cp == ip) ? 1.f : 0.f;
#pragma unroll
                    for (int jq = 0; jq < ip; ++jq) s += av[jq] * Dr[jq];
                    Dr[ip] = s; }
#pragma unroll
                for (int ip = 0; ip < 16; ++ip) { const int r = d ? 15 - ip : ip; *(LAS bf16_t*)(DINV + (16 * I + r) * PD + 2 * c) = (bf16_t)(pk2(Dr[ip], 0.f) & 0xffffu); } }
            s16x4v sf[8];
            f32x4 Rt[4], Qs[4];
            if (w < 4) {
#pragma unroll
            for (int dt = 0; dt < 8; ++dt) sf[dt] = pack4(S[dt]);
#pragma unroll
            for (int Tp = 0; Tp < 4; ++Tp) { const int ro = 16 * (d ? 3 - Tp : Tp);
                f32x4 ksv = (f32x4){0.f, 0.f, 0.f, 0.f}, qsv = ksv;
                LAS unsigned char* ka = kh + (ro + l16) * PK + 8 * h4; LAS unsigned char* qa = qh + (ro + l16) * PQ + 8 * h4;
#pragma unroll
                for (int dt = 0; dt < 8; ++dt) { ksv = MFMA16K16(lds8(ka + 32 * dt), sf[dt], ksv); qsv = MFMA16K16(lds8(qa + 32 * dt), sf[dt], qsv); }
                const s16x4v v4 = ldstr1(vv + (ro + 4 * h4 + tq) * PV + (16 * w + 4 * tp) * 2);
                const f32x4 be = *(const LAS f32x4*)(gs + 64 + ro + 4 * h4), eg = *(const LAS f32x4*)(gs + 128 + ro + 4 * h4);
#pragma unroll
                for (int r = 0; r < 4; ++r) { Rt[Tp][r] = be[r] * (bf2f((bf16_t)v4[r]) - eg[r] * ksv[r]); Qs[Tp][r] = eg[r] * qsv[r]; }
                asm volatile("" ::: "memory"); } }
            lds_barrier(); if (SUBDUP == 5) lds_barrier();
            if (w < 4) { s16x4v vf[4]; f32x4 vn[4];
#pragma unroll
              for (int Tp = 0; Tp < 4; ++Tp) { const int ro = 16 * (d ? 3 - Tp : Tp);
                  f32x4 X = Rt[Tp];
#pragma unroll
                  for (int Jp = 0; Jp < Tp; ++Jp) { const int co = 16 * (d ? 3 - Jp : Jp); X = MFMA16K16(lds8(AM + (ro + l16) * PA + (co + 4 * h4) * 2), vf[Jp], X); }
                  const s16x4v xf = pack4(X);
                  vn[Tp] = MFMA16K16(lds8(DINV + (ro + l16) * PD + 8 * h4), xf, ((f32x4){0.f, 0.f, 0.f, 0.f}));
                  vf[Tp] = pack4(vn[Tp]); }
#pragma unroll
              for (int Tp = 0; Tp < 4; ++Tp) { const int ro = 16 * (d ? 3 - Tp : Tp);
                  f32x4 o = Qs[Tp];
#pragma unroll
                  for (int Jp = 0; Jp <= Tp; ++Jp) { const int co = 16 * (d ? 3 - Jp : Jp); o = MFMA16K16(lds8(QM + (ro + l16) * PA + (co + 4 * h4) * 2), vf[Jp], o); }
#pragma unroll
                  for (int r = 0; r < 4; ++r) O[(size_t)(row0 + ro + 4 * h4 + r) * 1024 + h * 128 + eh * 64 + 16 * w + l16] = (bf16_t)(pk2(o[r], 0.f) & 0xffffu);
                  asm volatile("" ::: "memory"); }
              const float gend = gs[256];
              s16x4v vsf[4];
#pragma unroll
              for (int Jp = 0; Jp < 4; ++Jp) { const int co = 16 * (d ? 3 - Jp : Jp); const f32x4 ee = *(const LAS f32x4*)(gs + 192 + co + 4 * h4); vsf[Jp] = pack4(vn[Jp] * ee); }
#pragma unroll
              for (int dt = 0; dt < 8; ++dt) { S[dt] = S[dt] * gend;
#pragma unroll
                  for (int Jp = 0; Jp < 4; ++Jp) { const int co = 16 * (d ? 3 - Jp : Jp); S[dt] = MFMA16K16(ldstr1(kh + (co + 4 * h4 + tq) * PK + (16 * dt + 4 * tp) * 2), vsf[Jp], S[dt]); }
                  if (dt & 1) asm volatile("" ::: "memory"); } }
            for (int sr_ = 0; sr_ < (SUBDUP == 3 ? 2 : 1); ++sr_) if (w == 5 && step + 1 < 68) gdn_gates(ga, gb, nea, dtb, sm + (par ^ 1) * GD_GSET, ln, d);
            lds_barrier(); if (SUBDUP == 5) lds_barrier();
        }
#undef GD_ROW0
    }
}

DI void ph_gdn_scan_pipe(const Args& a, int l, const bf16_t* Q, const bf16_t* K, const bf16_t* V, const float* GATE, bf16_t* OF, bf16_t* OB, LAS unsigned char* lds) {
    constexpr int PQ = 272, PK = 288, PV = 160, PA = 144, PD = 48, SETB = 71680;
    constexpr int O_Q = 0, O_K = 17408, O_V = 35840, O_AM = 46080, O_QM = 55296, O_DI = 64512, O_ND = 67584;
    LAS float* sm = (LAS float*)(lds + 2 * SETB);
    const int tid = ltid(a), w = tid >> 6, ln = tid & 63, l16 = ln & 15, h4 = ln >> 4, tq = (ln & 15) >> 2, tp = ln & 3;
    const bool helper = w >= 4; const int ht = tid - 256;
    for (int unit = blockIdx.x; unit < 256; unit += gridDim.x) {
        const int eh = unit & 1, d = (unit >> 1) & 1, h = (unit >> 2) & 7, b = unit >> 5;
        const float nea = -__expf(a.in[I_GALOG][(l * 2 + d) * 8 + h]), dtb = a.in[I_GDTB][(l * 2 + d) * 8 + h];
        bf16_t* O = d ? OB : OF;
        f32x4 S[8];
#pragma unroll
        for (int i = 0; i < 8; ++i) S[i] = (f32x4){0.f, 0.f, 0.f, 0.f};
#define GD_ROW0(step) (((step) < 4) ? b * 256 + (d ? 3 - (step) : (step)) * 64 : CTXROWS + b * 4096 + (d ? 67 - (step) : (step) - 4) * 64)
        f32x4 Rt[4], Qs[4]; float ga = 0.f, gb = 0.f;
#define GD_FETCH(stp) do { const int rw_ = GD_ROW0(stp); \
        _Pragma("unroll") for (int q_ = 0; q_ < 4; ++q_) { const int p_ = ht + 256 * q_, r_ = p_ >> 4, c8_ = p_ & 15; const size_t go_ = (size_t)(rw_ + r_) * 1024 + h * 128 + c8_ * 8; S[q_] = __builtin_bit_cast(f32x4, *(const u32x4*)(Q + go_)); S[4 + q_] = __builtin_bit_cast(f32x4, *(const u32x4*)(K + go_)); } \
        _Pragma("unroll") for (int q_ = 0; q_ < 2; ++q_) { const int p_ = ht + 256 * q_, r_ = p_ >> 3, c8_ = p_ & 7; Qs[q_] = __builtin_bit_cast(f32x4, *(const u32x4*)(V + (size_t)(rw_ + r_) * 1024 + h * 128 + eh * 64 + c8_ * 8)); } \
        if (w == 5) { const int t_ = d ? 63 - ln : ln; const float* gp_ = GATE + (size_t)(rw_ + t_) * 32; ga = gp_[d * 8 + h]; gb = gp_[16 + d * 8 + h]; } } while (0)
#define GD_STAGE(setb) do { \
        _Pragma("unroll") for (int q_ = 0; q_ < 4; ++q_) { const int p_ = ht + 256 * q_, r_ = p_ >> 4, c8_ = p_ & 15; *(LAS f32x4*)((setb) + O_Q + r_ * PQ + c8_ * 16) = S[q_]; *(LAS f32x4*)((setb) + O_K + r_ * PK + c8_ * 16) = S[4 + q_]; } \
        _Pragma("unroll") for (int q_ = 0; q_ < 2; ++q_) { const int p_ = ht + 256 * q_, r_ = p_ >> 3, c8_ = p_ & 7; *(LAS f32x4*)((setb) + O_V + r_ * PV + c8_ * 16) = Qs[q_]; } } while (0)
#define GD_STAGE_A(setb, gsp) do { LAS unsigned char* kh_ = (setb) + O_K; LAS unsigned char* qh_ = (setb) + O_Q; \
        for (int pi_ = w - 4; pi_ < 10; pi_ += 4) {                   \
            const int Tp_ = pi_ < 1 ? 0 : (pi_ < 3 ? 1 : (pi_ < 6 ? 2 : 3)), Jp_ = pi_ - (Tp_ * (Tp_ + 1)) / 2; \
            const int it_ = d ? 3 - Tp_ : Tp_, jt_ = d ? 3 - Jp_ : Jp_, i_ = it_ * 16 + l16; \
            LAS unsigned char* xk_ = kh_ + i_ * PK + h4 * 16; LAS unsigned char* xq_ = qh_ + i_ * PQ + h4 * 16; \
            const float gci_ = (gsp)[i_], bi_ = (gsp)[64 + i_]; \
            LAS unsigned char* kb_ = kh_ + (jt_ * 16 + l16) * PK + h4 * 16; f32x4 kk_ = (f32x4){0.f, 0.f, 0.f, 0.f}, qk_ = kk_; \
            _Pragma("unroll") for (int ks_ = 0; ks_ < 4; ++ks_) { const bf16x8v a0_ = ldsfrag(kb_, ks_ * 64); kk_ = MFMA16(a0_, ldsfrag(xk_, ks_ * 64), kk_); qk_ = MFMA16(a0_, ldsfrag(xq_, ks_ * 64), qk_); } \
            const int j0_ = jt_ * 16 + 4 * h4; const f32x4 gcj_ = *(const LAS f32x4*)((gsp) + j0_); float am_[4], qm_[4]; \
            _Pragma("unroll") for (int r_ = 0; r_ < 4; ++r_) { const int j_ = j0_ + r_; const bool valid_ = d ? (j_ >= i_) : (j_ <= i_); const float e_ = __expf(gci_ - gcj_[r_]); \
                am_[r_] = (valid_ && j_ != i_) ? -bi_ * kk_[r_] * e_ : 0.f; qm_[r_] = valid_ ? qk_[r_] * e_ : 0.f; } \
            u32x2 pa_, pm_; pa_.x = pk2(am_[0], am_[1]); pa_.y = pk2(am_[2], am_[3]); pm_.x = pk2(qm_[0], qm_[1]); pm_.y = pk2(qm_[2], qm_[3]); \
            *(LAS u32x2*)((setb) + O_AM + i_ * PA + j0_ * 2) = pa_; *(LAS u32x2*)((setb) + O_QM + i_ * PA + j0_ * 2) = pm_; \
            if (jt_ == it_) { LAS float* nd_ = (LAS float*)((setb) + O_ND); const int ipos_ = d ? 15 - l16 : l16; \
                _Pragma("unroll") for (int r_ = 0; r_ < 4; ++r_) { const int jpos_ = d ? 15 - (4 * h4 + r_) : 4 * h4 + r_; nd_[(it_ * 16 + ipos_) * 16 + jpos_] = am_[r_]; } } } } while (0)
        __syncthreads();
        if (helper) { GD_FETCH(0); if (w == 5) gdn_gates(ga, gb, nea, dtb, sm, ln, d); GD_STAGE(lds); GD_FETCH(1); }
        __syncthreads();
        if (helper) GD_STAGE_A(lds, sm);
        __syncthreads();
        for (int step = 0; step < 68; ++step) {
            const int X = step & 1; LAS unsigned char* cur = lds + X * SETB; LAS unsigned char* nxt = lds + (X ^ 1) * SETB;
            LAS float* gs = sm + X * GD_GSET; LAS float* gsn = sm + (X ^ 1) * GD_GSET;
            LAS unsigned char* qh = cur + O_Q; LAS unsigned char* kh = cur + O_K; LAS unsigned char* vv = cur + O_V; LAS unsigned char* AM = cur + O_AM; LAS unsigned char* QM = cur + O_QM; LAS unsigned char* DINV = cur + O_DI;
            const int row0 = GD_ROW0(step);
            s16x4v sf[8];
            if (!helper) {
#pragma unroll
                for (int dt = 0; dt < 8; ++dt) sf[dt] = pack4(S[dt]);
#pragma unroll
                for (int Tp = 0; Tp < 4; ++Tp) { const int ro = 16 * (d ? 3 - Tp : Tp);
                    f32x4 ksv = (f32x4){0.f, 0.f, 0.f, 0.f}, qsv = ksv;
                    LAS unsigned char* ka = kh + (ro + l16) * PK + 8 * h4; LAS unsigned char* qa = qh + (ro + l16) * PQ + 8 * h4;
#pragma unroll
                    for (int dt = 0; dt < 8; ++dt) { ksv = MFMA16K16(lds8(ka + 32 * dt), sf[dt], ksv); qsv = MFMA16K16(lds8(qa + 32 * dt), sf[dt], qsv); }
                    const s16x4v v4 = ldstr1(vv + (ro + 4 * h4 + tq) * PV + (16 * w + 4 * tp) * 2);
                    const f32x4 be = *(const LAS f32x4*)(gs + 64 + ro + 4 * h4), eg = *(const LAS f32x4*)(gs + 128 + ro + 4 * h4);
#pragma unroll
                    for (int r = 0; r < 4; ++r) { Rt[Tp][r] = be[r] * (bf2f((bf16_t)v4[r]) - eg[r] * ksv[r]); Qs[Tp][r] = eg[r] * qsv[r]; }
                    asm volatile("" ::: "memory"); }
            } else {
                if (step + 1 < 68) { GD_STAGE(nxt); if (w == 5) gdn_gates(ga, gb, nea, dtb, gsn, ln, d); if (step + 2 < 68) GD_FETCH(step + 2); }
                if (w == 4) { const int I = ln >> 4, c = ln & 15, cp = d ? 15 - c : c; LAS float* nAd = (LAS float*)(cur + O_ND);
                    float Dr[16];
                    Dr[0] = (cp == 0) ? 1.f : 0.f;
#pragma unroll
                    for (int ip = 1; ip < 16; ++ip) {
                        float av[16];
#pragma unroll
                        for (int q4 = 0; q4 < 4; ++q4) { if (q4 * 4 < ip) { const f32x4 x = *(const LAS f32x4*)(nAd + (I * 16 + ip) * 16 + q4 * 4); av[q4 * 4] = x[0]; av[q4 * 4 + 1] = x[1]; av[q4 * 4 + 2] = x[2]; av[q4 * 4 + 3] = x[3]; } }
                        float s = (cp == ip) ? 1.f : 0.f;
#pragma unroll
                        for (int jq = 0; jq < ip; ++jq) s += av[jq] * Dr[jq];
                        Dr[ip] = s; }
#pragma unroll
                    for (int ip = 0; ip < 16; ++ip) { const int r = d ? 15 - ip : ip; *(LAS bf16_t*)(DINV + (16 * I + r) * PD + 2 * c) = (bf16_t)(pk2(Dr[ip], 0.f) & 0xffffu); } }
            }
            lds_barrier();
            if (!helper) { s16x4v vf[4]; f32x4 vn[4];
#pragma unroll
                for (int Tp = 0; Tp < 4; ++Tp) { const int ro = 16 * (d ? 3 - Tp : Tp);
                    f32x4 Xv = Rt[Tp];
#pragma unroll
                    for (int Jp = 0; Jp < Tp; ++Jp) { const int co = 16 * (d ? 3 - Jp : Jp); Xv = MFMA16K16(lds8(AM + (ro + l16) * PA + (co + 4 * h4) * 2), vf[Jp], Xv); }
                    const s16x4v xf = pack4(Xv);
                    vn[Tp] = MFMA16K16(lds8(DINV + (ro + l16) * PD + 8 * h4), xf, ((f32x4){0.f, 0.f, 0.f, 0.f}));
                    vf[Tp] = pack4(vn[Tp]); }
#pragma unroll
                for (int Tp = 0; Tp < 4; ++Tp) { const int ro = 16 * (d ? 3 - Tp : Tp);
                    f32x4 o = Qs[Tp];
#pragma unroll
                    for (int Jp = 0; Jp <= Tp; ++Jp) { const int co = 16 * (d ? 3 - Jp : Jp); o = MFMA16K16(lds8(QM + (ro + l16) * PA + (co + 4 * h4) * 2), vf[Jp], o); }
#pragma unroll
                    for (int r = 0; r < 4; ++r) O[(size_t)(row0 + ro + 4 * h4 + r) * 1024 + h * 128 + eh * 64 + 16 * w + l16] = (bf16_t)(pk2(o[r], 0.f) & 0xffffu);
                    asm volatile("" ::: "memory"); }
                const float gend = gs[256];
                s16x4v vsf[4];
#pragma unroll
                for (int Jp = 0; Jp < 4; ++Jp) { const int co = 16 * (d ? 3 - Jp : Jp); const f32x4 ee = *(const LAS f32x4*)(gs + 192 + co + 4 * h4); vsf[Jp] = pack4(vn[Jp] * ee); }
#pragma unroll
                for (int dt = 0; dt < 8; ++dt) { S[dt] = S[dt] * gend;
#pragma unroll
                    for (int Jp = 0; Jp < 4; ++Jp) { const int co = 16 * (d ? 3 - Jp : Jp); S[dt] = MFMA16K16(ldstr1(kh + (co + 4 * h4 + tq) * PK + (16 * dt + 4 * tp) * 2), vsf[Jp], S[dt]); }
                    if (dt & 1) asm volatile("" ::: "memory"); }
            } else if (step + 1 < 68) GD_STAGE_A(nxt, gsn);
            lds_barrier();
        }
#undef GD_ROW0
#undef GD_FETCH
#undef GD_STAGE
#undef GD_STAGE_A
    }
}

#ifndef DUP_PHASE
#define DUP_PHASE -1
#endif
constexpr int NPH_LAYER = 21, PH_FINAL = 2 + DEPTH * NPH_LAYER, NPHASE = PH_FINAL + 1;
template <class Epi>
DI void run_gemm(int tid, LAS unsigned char* lds, const bf16_t* A, const bf16_t* Bt, int M, int N, const Epi& E) {
    pg8::Gemm g{A, Bt, M, N, 1024, 1024, 1 << 20, 0, tid}; pg8::StaticOrder S; S.init(M, N, (int)gridDim.x, (int)blockIdx.x);
#if defined(GEMM_STAGGER)
    if (blockIdx.x & 8) { const unsigned long long t0 = __builtin_amdgcn_s_memrealtime(); while (__builtin_amdgcn_s_memrealtime() - t0 < GEMM_STAGGER) __builtin_amdgcn_s_sleep(8); }
#endif
    pg8::gemm_phase<Epi, pg8::StaticOrder, false>(lds, g, S, E, nullptr);
}
template <class Epi>
DI void run_gemm_g(int tid, LAS unsigned char* lds, const bf16_t* A, int lda, int K, const bf16_t* Bt, int M, int N, int pmg, size_t gstride, const Epi& E) {
    pg8::Gemm g{A, Bt, M, N, K, lda, pmg, gstride, tid}; pg8::StaticOrder S; S.init(M, N, (int)gridDim.x, (int)blockIdx.x);
    pg8::gemm_phase<Epi, pg8::StaticOrder, false>(lds, g, S, E, nullptr);
}
__global__ void __launch_bounds__(NT, 2) hy_fwd(Args ka) {
    extern __shared__ __attribute__((aligned(16))) unsigned char lds_raw[];
    LAS unsigned char* lds = (LAS unsigned char*)lds_raw;
    volatile LAS unsigned* xbw = (volatile LAS unsigned*)(lds + LDS_BYTES - 256);
    if (threadIdx.x < 4) xbw[threadIdx.x] = 0u;
    __syncthreads();
    const int lo = ka.ph_lo, hi = ka.ph_hi;
    const int s_wid = __builtin_amdgcn_readfirstlane((int)(threadIdx.x >> 6));
    XcdBarrier bar; bar.bar = (unsigned*)(ka.ws + WS_CTL); bar.x = 0u; bar.st = xbw; bar.wid = s_wid;
    if (hi - lo > 1) bar = xcd_barrier_post((unsigned*)(ka.ws + WS_CTL), xbw, s_wid);
#ifdef PH_ONLY
#define PHEN(p) ((p) == PH_ONLY)
#else
#define PHEN(p) 1
#endif
#define IN(k) (lo <= (k) && (k) < hi)
#define INL(p) (PHEN(p) && IN(pb + (p)))
#define REPS(p) ((DUP_PHASE == (p)) ? 2 : 1)
#define SEAM(k) do { if (IN((k) + 1)) { xcd_barrier(bar); if (DUP_PHASE == 200) xcd_barrier(bar); } } while (0)
#define PH_LOAD \
    Args a; __builtin_memcpy(&a, args_ptr(), sizeof(Args)); a.wid = s_wid; \
    unsigned char* ws = a.ws; \
    float* MOD = (float*)(ws + WS_MOD); float* XCTX = (float*)(ws + WS_XCTX); \
    bf16_t* H = (bf16_t*)(ws + WS_H); bf16_t* MERGED = (bf16_t*)(ws + WS_MERGED); \
    bf16_t* WB0 = (bf16_t*)(ws + WS_WB0); bf16_t* WB1 = (bf16_t*)(ws + WS_WB1); \
    unsigned char* R = ws + WS_R; \
    bf16_t* P0 = (bf16_t*)(R + R_P0); bf16_t* P1 = (bf16_t*)(R + R_P1); bf16_t* P2 = (bf16_t*)(R + R_P2); bf16_t* OF = (bf16_t*)(R + R_OF); bf16_t* OB = (bf16_t*)(R + R_OB); \
    float* GATE2 = (float*)(R + R_G2); \
    float* GATE1 = (float*)(ws + WS_MERGED); bf16_t* HALO = (bf16_t*)(ws + WS_MERGED + SZ_GATE);     \
    float* MODP = (float*)R; \
    bf16_t* AX = (bf16_t*)(R + R5_AX); bf16_t* SZ5 = (bf16_t*)(R + R5_SZ); bf16_t* G15 = (bf16_t*)(R + R5_G1); bf16_t* GLUA = (bf16_t*)(R + R5_GLUA); bf16_t* YBR = (bf16_t*)R; \
    bf16_t* CW1 = (bf16_t*)(ws + WS_H); bf16_t* CW2 = (bf16_t*)(ws + WS_H + SZ_CW1); float* SEG5 = (float*)(ws + WS_H + SZ_CW1 + SZ_CW2); \
    const float* xlat_src = l == 0 ? a.in[I_X] : a.out; const float* xctx_src = l == 0 ? a.in[I_CTX] : XCTX; const float* modl = MOD + (size_t)l * 9 * 3072; \
    (void)MOD; (void)XCTX; (void)H; (void)MERGED; (void)WB0; (void)WB1; (void)P0; (void)P1; (void)P2; (void)OF; (void)OB; (void)GATE2; (void)GATE1; (void)HALO; (void)MODP; (void)AX; (void)SZ5; (void)G15; (void)GLUA; (void)YBR; (void)CW1; (void)CW2; (void)SEG5; (void)xlat_src; (void)xctx_src; (void)modl;
    LAS float* ldsf = (LAS float*)lds;

    { const int l = 0;
    if (PHEN(100) && IN(0)) { PH_LOAD; ph_modp(a, MODP, ldsf); SEAM(0); }
    if (PHEN(101) && IN(1)) { PH_LOAD; ph_mod(a, MODP, MOD); SEAM(1); } }
    for (int l = 0; l < DEPTH; ++l) {
        const int pb = 2 + l * NPH_LAYER;
        const int lro = (l == DEPTH - 1) ? CTXROWS : 0;
        if (INL(0)) { PH_LOAD; for (int rep_ = 0; rep_ < REPS(0); ++rep_) { ph_norm(a, l, xlat_src, xctx_src, modl, H); ph_cvt(wdesc(a, l, 0), WB0, ldsf); } SEAM(pb + 0); }
        if (INL(1)) { PH_LOAD; for (int rep_ = 0; rep_ < REPS(1); ++rep_) { EpiProj E{P0, 0, GATE1, 12, HALO, 0}; run_gemm(ltid(a), lds, H, WB0, MROWS, 3328, E); } SEAM(pb + 1); }
        if (INL(2)) { PH_LOAD; for (int rep_ = 0; rep_ < REPS(2); ++rep_) { if (DUP_PHASE == 102) ph_gdn_conv(a, l, P0, HALO, lds, OF); ph_gdn_conv(a, l, P0, HALO, lds); ph_cvt(wdesc(a, l, 1), WB1, ldsf); } SEAM(pb + 2); }
        if (INL(3)) { PH_LOAD; for (int rep_ = 0; rep_ < REPS(3); ++rep_) { ph_gdn_scan_pipe(a, l, P0, P1, P2, GATE1, OF, OB, lds); } SEAM(pb + 3); }
        if (INL(4)) { PH_LOAD; for (int rep_ = 0; rep_ < REPS(4); ++rep_) { EpiProj E{P0, 9, nullptr, -1, nullptr, lro}; run_gemm(ltid(a), lds, H + (size_t)lro * 1024, WB1, MROWS - lro, 2048, E); } SEAM(pb + 4); }
        if (INL(5)) { PH_LOAD; for (int rep_ = 0; rep_ < REPS(5); ++rep_) { if (DUP_PHASE == 105) ph_gdn_post(a, l, OF, OB, P0, P2); ph_gdn_post(a, l, OF, OB, P0); ph_cvt(wdesc(a, l, 6), WB0, ldsf); } SEAM(pb + 5); }
        if (INL(6)) { PH_LOAD; for (int rep_ = 0; rep_ < REPS(6); ++rep_) { ph_cvt(wdesc(a, l, 2), WB1, ldsf); EpiBranch E{P1, MERGED, 1, lro}; run_gemm(ltid(a), lds, OF + (size_t)lro * 1024, WB0, MROWS - lro, 1024, E); } SEAM(pb + 6); }
        if (INL(7)) { PH_LOAD; for (int rep_ = 0; rep_ < REPS(7); ++rep_) { ph_cvt(wdesc(a, l, 3), WB0, ldsf); EpiProj E{P0, 0, GATE2, 12, nullptr, 0}; run_gemm(ltid(a), lds, H, WB1, MROWS, 3328, E); } SEAM(pb + 7); }
        if (INL(8)) { PH_LOAD; for (int rep_ = 0; rep_ < REPS(8); ++rep_) { ph_ml_scan_mfma(a, l, P0, P1, P2, GATE2, OF, OB, lds); } SEAM(pb + 8); }
        if (INL(9)) { PH_LOAD; for (int rep_ = 0; rep_ < REPS(9); ++rep_) { ph_cvt(wdesc(a, l, 8), WB1, ldsf); EpiProj E{P0, 38, nullptr, -1, nullptr, lro}; run_gemm(ltid(a), lds, H + (size_t)lro * 1024, WB0, MROWS - lro, 3072, E); } SEAM(pb + 9); }
        if (INL(10)) { PH_LOAD; for (int rep_ = 0; rep_ < REPS(10); ++rep_) { ph_ml_post(a, l, OF, OB, P0, P1); } SEAM(pb + 10); }
        if (INL(11)) { PH_LOAD; for (int rep_ = 0; rep_ < REPS(11); ++rep_) { ph_cvt(wdesc(a, l, 4), WB0, ldsf); EpiBranch E{P2, MERGED, 0, lro}; run_gemm(ltid(a), lds, OF + (size_t)lro * 1024, WB1, MROWS - lro, 1024, E); } SEAM(pb + 11); }
        if (INL(12)) { PH_LOAD; for (int rep_ = 0; rep_ < REPS(12); ++rep_) { ph_cvt(wdesc(a, l, 5), WB1, ldsf); EpiS1 E{AX, SZ5, G15}; run_gemm(ltid(a), lds, H, WB0, MROWS, 3072, E); } SEAM(pb + 12); }
        if (INL(13)) { PH_LOAD; for (int rep_ = 0; rep_ < REPS(13); ++rep_) { ph_s5_consts(a, l, CW1, CW2, lds); ph_cvt(wdesc(a, l, 7), WB0, ldsf); } SEAM(pb + 13); }
        if (INL(14)) { PH_LOAD; for (int rep_ = 0; rep_ < REPS(14); ++rep_) { EpiS5L E{AX}; run_gemm_g(ltid(a), lds, AX, 512, 256, CW1, 64 * S5_RG, 256, S5_PMG, (size_t)256 * 256 * 2, E); } SEAM(pb + 14); }
        if (INL(15)) { PH_LOAD; for (int rep_ = 0; rep_ < REPS(15); ++rep_) { ph_s5_carry1(a, l, AX, SEG5); } SEAM(pb + 15); }
        if (INL(16)) { PH_LOAD; ph_s5_carry2(a, l, AX, SEG5); SEAM(pb + 16); }
        if (INL(17)) { PH_LOAD; for (int rep_ = 0; rep_ < REPS(17); ++rep_) { EpiS5Y E{AX, GLUA, a.in[I_SD] + l * 1024}; run_gemm_g(ltid(a), lds, AX, 512, 512, CW2, 64 * S5_RG, 256, S5_PMG, (size_t)256 * 512 * 2, E); } SEAM(pb + 17); }
        if (INL(18)) { PH_LOAD; for (int rep_ = 0; rep_ < REPS(18); ++rep_) { EpiGlu E{SZ5, YBR, a.in[I_SBGLU] + l * 2048, lro}; run_gemm(ltid(a), lds, GLUA + (size_t)lro * 1024, WB1, MROWS - lro, 2048, E); } SEAM(pb + 18); }
        if (INL(19)) { PH_LOAD; for (int rep_ = 0; rep_ < REPS(19); ++rep_) { ph_cvt(wdesc(a, l, 9), WB1, ldsf); EpiBranch E{G15, MERGED, 0, lro}; run_gemm(ltid(a), lds, YBR + (size_t)lro * 1024, WB0, MROWS - lro, 1024, E); } SEAM(pb + 19); }
        if (INL(20)) { PH_LOAD; for (int rep_ = 0; rep_ < REPS(20); ++rep_) {
            const int ro = (l == DEPTH - 1) ? CTXROWS : 0;
            EpiOut E{xlat_src, a.out, xctx_src, XCTX, modl, l, ro};
            run_gemm(ltid(a), lds, MERGED + (size_t)ro * 1024, WB1, MROWS - ro, 1024, E);
            } SEAM(pb + 20);
        }
    }
    if (PHEN(102) && IN(PH_FINAL)) { const int l = 0; PH_LOAD; ph_final(a, a.out); }
#undef IN
#undef SEAM
#undef PH_LOAD
}
}

#ifndef MK_LAUNCHES
#define MK_LAUNCHES 1
#endif
extern "C" void kernel_launch(void* const* d_in, const int* in_sizes, int n_in, void* d_out, int out_size, void* d_ws, size_t ws_size, hipStream_t stream) {
    static int grid = 0;
    if (grid == 0) {
        if (n_in != 28 || out_size != hy::NBATCH * hy::SEQ * hy::D || ws_size < hy::WS_END) { fprintf(stderr, "kernel_launch: unexpected shapes (n_in %d, out %d, ws %zu < %zu)\n", n_in, out_size, ws_size, (size_t)hy::WS_END); grid = -1; return; }
        int dev = 0, cus = 0, per_cu = 0;
        if (hipGetDevice(&dev) != hipSuccess || hipDeviceGetAttribute(&cus, hipDeviceAttributeMultiprocessorCount, dev) != hipSuccess) { grid = -1; return; }
        if (hipFuncSetAttribute((const void*)hy::hy_fwd, hipFuncAttributeMaxDynamicSharedMemorySize, hy::LDS_BYTES) != hipSuccess) { fprintf(stderr, "kernel_launch: hipFuncSetAttribute failed\n"); grid = -1; return; }
        if (hipOccupancyMaxActiveBlocksPerMultiprocessor(&per_cu, (const void*)hy::hy_fwd, hy::NT, hy::LDS_BYTES) != hipSuccess || per_cu < 1) { fprintf(stderr, "kernel_launch: occupancy query says %d\n", per_cu); (void)hipGetLastError(); }
        grid = cus;
    }
    if (grid < 0) return;
    (void)hipMemsetAsync((char*)d_ws + hy::WS_CTL, 0, 65536, stream);
    hy::Args a{};
    for (int i = 0; i < 28; ++i) a.in[i] = (const float*)d_in[i];
    a.out = (float*)d_out; a.ws = (unsigned char*)d_ws;
#if MK_LAUNCHES == 1
    a.ph_lo = 0; a.ph_hi = hy::NPHASE;
    hipLaunchKernelGGL(hy::hy_fwd, dim3(grid), dim3(hy::NT), hy::LDS_BYTES, stream, a);
#else
    for (int p = 0; p < hy::NPHASE; ++p) { a.ph_lo = p; a.ph_hi = p + 1; hipLaunchKernelGGL(hy::hy_fwd, dim3(grid), dim3(hy::NT), hy::LDS_BYTES, stream, a); }
#endif
}
```

```cpp
#include <hip/hip_runtime.h>
#include <cstdio>
#include <cstdint>
#define MK_LAUNCHES 1


#define XB_TMO      128
#define XB_XCNT(j)  (256  + 64 * (j))
#define XB_XSUB(j)  (1280 + 64 * (j))
#define XB_XGEN(j)  (2304 + 64 * (j))
#define XB_TOP      3328
#define XB_TOPGEN   3392
#define XCD_BAR_WORDS 3456
#define XB_SPIN_CAP (1u << 18)
#define LAS __attribute__((address_space(3)))

__device__ __forceinline__ unsigned xb_ld(unsigned* p)              { return __hip_atomic_load(p, __ATOMIC_RELAXED, __HIP_MEMORY_SCOPE_AGENT); }
__device__ __forceinline__ unsigned xb_add(unsigned* p, unsigned v) { return __hip_atomic_fetch_add(p, v, __ATOMIC_RELAXED, __HIP_MEMORY_SCOPE_AGENT); }
__device__ __forceinline__ unsigned xb_xcc_id() { return (unsigned)__builtin_amdgcn_s_getreg((3 << 11) | 20) & 0xFu; }
#define XB_SPIN(cond, bar) do { unsigned _sp = 0; while (cond) { __builtin_amdgcn_s_sleep(1); \
    if ((++_sp & 255u) == 0u) { if (xb_ld(&(bar)[XB_TMO])) break; if (_sp > XB_SPIN_CAP) { atomicAdd(&(bar)[XB_TMO], 1u); break; } } } } while (0)

struct XcdBarrier {
    unsigned* bar; unsigned x;
    int wid;
    volatile LAS unsigned* st;
};

__device__ __forceinline__ bool xb_lead(int wid) { int l; asm volatile("v_mbcnt_lo_u32_b32 %0, -1, 0\n\tv_mbcnt_hi_u32_b32 %0, -1, %0" : "=v"(l)); return wid == 0 && l == 0; }
__device__ __forceinline__ XcdBarrier xcd_barrier_post(unsigned* bar, volatile LAS unsigned* st, int wid) {
    XcdBarrier b; b.bar = bar; b.x = xb_xcc_id(); b.st = st; b.wid = wid;
    if (xb_lead(wid)) (void)xb_add(&bar[XB_XCNT(b.x)], 1u);
    return b;
}
__device__ __forceinline__ void xcd_barrier_complete(unsigned* bar, unsigned x, unsigned& nloc, unsigned& nx) {
    const unsigned G = gridDim.x * gridDim.y * gridDim.z;
    unsigned sum, cnt, mine, sp = 0u;
    for (;;) {
        sum = 0u; cnt = 0u; mine = 0u;
#pragma unroll
        for (unsigned j = 0; j < 16; ++j) { const unsigned c = xb_ld(&bar[XB_XCNT(j)]); sum += c; cnt += (c > 0u) ? 1u : 0u; mine = (j == x) ? c : mine; }
        if (sum == G) break;
        __builtin_amdgcn_s_sleep(1);
        if ((++sp & 255u) == 0u) { if (xb_ld(&bar[XB_TMO])) break; if (sp > XB_SPIN_CAP) { atomicAdd(&bar[XB_TMO], 1u); break; } }
    }
    nloc = mine > 0u ? mine : 1u; nx = cnt > 0u ? cnt : 1u;
}

__device__ __forceinline__ void xcd_barrier(const XcdBarrier& b) {
    asm volatile("s_waitcnt vmcnt(0)" ::: "memory");
    __syncthreads();
    if (xb_lead(b.wid)) {
        unsigned* bar = b.bar;
        __builtin_amdgcn_s_waitcnt(0);
        unsigned nloc = b.st[0], nx = b.st[1];
        if (nloc == 0u) { xcd_barrier_complete(bar, b.x, nloc, nx); b.st[0] = nloc; b.st[1] = nx; }
        const unsigned old = xb_add(&bar[XB_XSUB(b.x)], 1u);
        const unsigned gen = old / nloc;
        if (old + 1u == (gen + 1u) * nloc) {
            __builtin_amdgcn_fence(__ATOMIC_RELEASE, "agent");
            asm volatile("s_waitcnt vmcnt(0)" ::: "memory");
            const unsigned og = xb_add(&bar[XB_TOP], 1u);
            const unsigned tg = og / nx;
            if (og + 1u == (tg + 1u) * nx) xb_add(&bar[XB_TOPGEN], 1u);
            else XB_SPIN(xb_ld(&bar[XB_TOPGEN]) == tg, bar);
            __builtin_amdgcn_fence(__ATOMIC_ACQUIRE, "agent");
            xb_add(&bar[XB_XGEN(b.x)], 1u);
            asm volatile("s_waitcnt vmcnt(0)" ::: "memory");
        } else {
            XB_SPIN(xb_ld(&bar[XB_XGEN(b.x)]) == gen, bar);
            __builtin_amdgcn_fence(__ATOMIC_ACQUIRE, "agent");
            asm volatile("s_waitcnt vmcnt(0)" ::: "memory");
        }
    }
    __syncthreads();
}


namespace pg8 {
#define PG8_LAS __attribute__((address_space(3)))
typedef unsigned short bf16_t;
typedef short bf16x8 __attribute__((ext_vector_type(8)));
typedef float f32x4 __attribute__((ext_vector_type(4)));
typedef unsigned u32x4 __attribute__((ext_vector_type(4)));
constexpr int BM = 256, BK = 64, HALF = 128, HTB = HALF * BK * 2  , STAGE_BYTES = 8 * HTB, NXCD = 8, WGM = 8;

__host__ __device__ __forceinline__ int lds_byte(int r, int c) { const int st = (r >> 4) * 2 + (c >> 5), rr = r & 15, cc = c & 31, ob = rr * 64 + cc * 2; return st * 1024 + (ob ^ (((ob >> 9) & 1) << 5)); }
__host__ __device__ __forceinline__ void stage_rc(int b, int& R, int& C) { const int st = b / 1024, sb = b % 1024, swz = sb ^ (((sb >> 9) & 1) << 5); R = (st >> 1) * 16 + swz / 64; C = (st & 1) * 32 + (swz % 64) / 2; }
__host__ __device__ __forceinline__ int perm32(int rho) { const int n = rho >> 4, i = rho & 15; return 8 * (i >> 2) + 4 * n + (i & 3); }

struct Unit { int pm, pn; };
struct Gemm { const bf16_t* A; const bf16_t* Bt; int M, N, K, lda, pmg; size_t gstride; int tid; };

struct StaticOrder {
    int nM, nN, nwg, G, c;
    __host__ __device__ void init(int M, int N, int G_, int c_) { nM = M / BM; nN = N / BM; nwg = nM * nN; G = G_; c = c_; }
    __host__ __device__ bool next(int i, Unit& u) const {
        const long L = (long)i * G + c; if (L >= nwg) return false;
        int wgid = (int)L; { const int q = nwg / NXCD, r = nwg % NXCD, xcd = wgid % NXCD, off = wgid / NXCD; wgid = (xcd < r ? xcd * (q + 1) : r * (q + 1) + (xcd - r) * q) + off; }
        const int nig = WGM * nN, gid = wgid / nig, fm = gid * WGM, gsz = (nM - fm) < WGM ? (nM - fm) : WGM;
        u.pm = fm + ((wgid % nig) % gsz); u.pn = (wgid % nig) / gsz; return true;
    }
    __device__ __forceinline__ void a_ready(const Unit&) const {}
    __device__ __forceinline__ void done(const Unit&) const {}
};
__device__ __forceinline__ unsigned cvt_pk_bf16(float lo, float hi) { unsigned r; asm volatile("v_cvt_pk_bf16_f32 %0, %1, %2" : "=v"(r) : "v"(lo), "v"(hi)); return r; }
typedef float f32x2 __attribute__((ext_vector_type(2)));
template <class Epi, class Sched, bool STAMP = false>
__device__ __forceinline__ void gemm_phase(PG8_LAS unsigned char* lds, const Gemm g, const Sched& S, const Epi& E, unsigned long long* stamps) {
    const int tid = g.tid, wid = __builtin_amdgcn_readfirstlane(tid >> 6), lane = tid & 63, wr = wid >> 2, wc = wid & 3, fr = lane & 15, fq = lane >> 4;
    const int K = g.K, nt = K / BK;
    int ts_lo = 0, ts_hi = 0, nts = 0; const unsigned long long rt_entry = STAMP ? (unsigned long long)wall_clock64() : 0ull;
#define PG8_STAMP() do { if (STAMP && wid == 0 && nts < 64) { const unsigned long long _c = (unsigned long long)clock64(); \
        ts_lo = (lane == nts) ? (int)(unsigned)_c : ts_lo; ts_hi = (lane == nts) ? (int)(unsigned)(_c >> 32) : ts_hi; ++nts; } } while (0)
    PG8_STAMP();
    unsigned voffA[2], voffB[2];
#pragma unroll
    for (int i = 0; i < 2; ++i) { int R, C; stage_rc(tid * 16 + i * 8192, R, C); const int Rb = Epi::PERM ? ((R & ~31) + perm32(R & 31)) : R;
        voffA[i] = (unsigned)(R * g.lda + C) * 2u; voffB[i] = (unsigned)(Rb * K + C) * 2u; }
    const size_t kstep = (size_t)(BK * 2);
    const size_t hstepA = (size_t)HALF * g.lda * 2, hstepB = (size_t)HALF * K * 2;
    const size_t tstepA = 2 * hstepA, tstepB = 2 * hstepB;
    const unsigned ldsw = (unsigned)wid * 1024u;
    const int aoff = lds_byte(wr * 64 + fr, fq * 8), boff = lds_byte(wc * 32 + fr, fq * 8);
#define PG8_SA(b, h) (((b) * 2 + (h)) * HTB)
#define PG8_SB(b, h) ((4 + (b) * 2 + (h)) * HTB)
#define PG8_STAGE(bufoff, gbase, voff) do { _Pragma("unroll") for (int _i = 0; _i < 2; ++_i) \
        __builtin_amdgcn_global_load_lds((const unsigned*)((const char*)(gbase) + (voff)[_i]), (PG8_LAS unsigned*)(lds + (bufoff) + ldsw + _i * 8192), 16, 0, 0); } while (0)
#define PG8_LDA(dst, b, h) do { _Pragma("unroll") for (int m = 0; m < 4; ++m) _Pragma("unroll") for (int k = 0; k < 2; ++k) dst[m][k] = *(const PG8_LAS bf16x8*)(lds + PG8_SA(b, h) + aoff + m * 2048 + k * 1024); } while (0)
#define PG8_LDB(dst, b, h) do { _Pragma("unroll") for (int n = 0; n < 2; ++n) _Pragma("unroll") for (int k = 0; k < 2; ++k) dst[n][k] = *(const PG8_LAS bf16x8*)(lds + PG8_SB(b, h) + boff + n * 2048 + k * 1024); } while (0)
#define PG8_MMA(ai, bj, At, Bt) do { __builtin_amdgcn_s_setprio(1); _Pragma("unroll") for (int m = 0; m < 4; ++m) _Pragma("unroll") for (int n = 0; n < 2; ++n) _Pragma("unroll") for (int k = 0; k < 2; ++k) \
        acc[ai][bj][m][n] = __builtin_amdgcn_mfma_f32_16x16x32_bf16(Bt[n][k], At[m][k], acc[ai][bj][m][n], 0, 0, 0); __builtin_amdgcn_s_setprio(0); } while (0)
#define PG8_WAIT_V(n) asm volatile("s_waitcnt vmcnt(" #n ")" ::: "memory")
#define PG8_WAIT_L(n) asm volatile("s_waitcnt lgkmcnt(" #n ")" ::: "memory")
#define PG8_BAR __builtin_amdgcn_s_barrier()
#define PG8_SCHED __builtin_amdgcn_sched_barrier(0)
    Unit cur, nxt; int ui = 0;
    if (!S.next(0, cur)) return;
    f32x4 acc[2][2][4][2];
#pragma unroll
    for (int a = 0; a < 2; ++a)
#pragma unroll
        for (int b = 0; b < 2; ++b)
#pragma unroll
            for (int m = 0; m < 4; ++m)
#pragma unroll
                for (int n = 0; n < 2; ++n) acc[a][b][m][n] = (f32x4){0.f, 0.f, 0.f, 0.f};
    bf16x8 At[4][2], B0[2][2], B1[2][2];
    const char* cA = (const char*)g.A + (size_t)cur.pm * tstepA; const char* cB = (const char*)g.Bt + (size_t)(cur.pm / g.pmg) * g.gstride + (size_t)cur.pn * tstepB;
    S.a_ready(cur);
    PG8_STAGE(PG8_SB(0, 0), cB, voffB); PG8_STAGE(PG8_SA(0, 0), cA, voffA); PG8_STAGE(PG8_SB(0, 1), cB + hstepB, voffB); PG8_STAGE(PG8_SA(0, 1), cA + hstepA, voffA);
    if (wr == 1) PG8_BAR;
    PG8_WAIT_V(4); PG8_BAR;
    PG8_STAGE(PG8_SB(1, 0), cB + kstep, voffB); PG8_STAGE(PG8_SA(1, 0), cA + kstep, voffA); PG8_STAGE(PG8_SB(1, 1), cB + hstepB + kstep, voffB);
    PG8_WAIT_V(6); PG8_BAR;
    PG8_STAMP();
    for (;;) {
        const bool has_next = S.next(ui + 1, nxt);
        const char* nA = has_next ? (const char*)g.A + (size_t)nxt.pm * tstepA : cA; const char* nB = has_next ? (const char*)g.Bt + (size_t)(nxt.pm / g.pmg) * g.gstride + (size_t)nxt.pn * tstepB : cB;
#pragma unroll 1
        for (int t = 0; t < nt; t += 2) {
            const bool last = (t == nt - 2);
            const char* a1 = cA + (size_t)(t + 1) * kstep;
            const char* a2 = last ? nA : cA + (size_t)(t + 2) * kstep; const char* b2 = last ? nB : cB + (size_t)(t + 2) * kstep;
            const char* a3 = a2 + kstep; const char* b3 = b2 + kstep;
            if (last && has_next) S.a_ready(nxt);
            PG8_LDB(B0, 0, 0); PG8_SCHED; PG8_LDA(At, 0, 0); PG8_STAGE(PG8_SA(1, 1), a1 + hstepA, voffA);
            PG8_WAIT_L(8); PG8_BAR; PG8_WAIT_L(0); PG8_MMA(0, 0, At, B0); PG8_BAR; PG8_SCHED;
            PG8_LDB(B1, 0, 1); PG8_STAGE(PG8_SB(0, 0), b2, voffB);
            PG8_BAR; PG8_WAIT_L(0); PG8_MMA(0, 1, At, B1); PG8_BAR;
            PG8_LDA(At, 0, 1); PG8_STAGE(PG8_SA(0, 0), a2, voffA);
            PG8_BAR; PG8_WAIT_L(0); PG8_MMA(1, 0, At, B0); PG8_BAR; PG8_SCHED;
            PG8_STAGE(PG8_SB(0, 1), b2 + hstepB, voffB);
            PG8_WAIT_V(6); PG8_BAR; PG8_MMA(1, 1, At, B1); PG8_BAR;
            PG8_LDB(B0, 1, 0); PG8_SCHED; PG8_LDA(At, 1, 0); PG8_STAGE(PG8_SA(0, 1), a2 + hstepA, voffA);
            PG8_WAIT_L(8); PG8_BAR; PG8_WAIT_L(0); PG8_MMA(0, 0, At, B0); PG8_BAR; PG8_SCHED;
            PG8_LDB(B1, 1, 1); PG8_STAGE(PG8_SB(1, 0), b3, voffB);
            PG8_BAR; PG8_WAIT_L(0); PG8_MMA(0, 1, At, B1); PG8_BAR;
            PG8_LDA(At, 1, 1); PG8_STAGE(PG8_SA(1, 0), a3, voffA);
            PG8_BAR; PG8_WAIT_L(0); PG8_MMA(1, 0, At, B0); PG8_BAR; PG8_SCHED;
            PG8_STAGE(PG8_SB(1, 1), b3 + hstepB, voffB);
            PG8_WAIT_V(6); PG8_BAR; PG8_MMA(1, 1, At, B1); PG8_BAR;
        }
        PG8_STAMP();
        if constexpr (!Epi::AFTER_DRAIN) { E(acc, cur, wr, wc, fr, fq); S.done(cur); }
        PG8_STAMP();
        if (!has_next) break;
#pragma unroll
        for (int a = 0; a < 2; ++a)
#pragma unroll
            for (int b = 0; b < 2; ++b)
#pragma unroll
                for (int m = 0; m < 4; ++m)
#pragma unroll
                    for (int n = 0; n < 2; ++n) acc[a][b][m][n] = (f32x4){0.f, 0.f, 0.f, 0.f};
        cur = nxt; cA = nA; cB = nB; ++ui;
    }
    PG8_WAIT_V(0);
    if (wr == 0) PG8_BAR;
    PG8_BAR;
    if constexpr (Epi::AFTER_DRAIN) { E.fused(acc, cur, wr, wc, fr, fq, lds, wid, lane); S.done(cur); }
    PG8_STAMP();
    if (STAMP && wid == 0) { stamps[lane] = lane < nts ? (((unsigned long long)(unsigned)ts_hi << 32) | (unsigned)ts_lo) : 0ull;
        if (lane == 62) stamps[62] = rt_entry; if (lane == 63) stamps[63] = (unsigned long long)wall_clock64(); }
#undef PG8_STAMP
#undef PG8_SA
#undef PG8_SB
#undef PG8_STAGE
#undef PG8_LDA
#undef PG8_LDB
#undef PG8_MMA
#undef PG8_WAIT_V
#undef PG8_WAIT_L
#undef PG8_BAR
#undef PG8_SCHED
}
}


namespace hy {
using pg8::bf16_t; using pg8::f32x4; using pg8::u32x4; using pg8::Unit;
typedef unsigned u32x2 __attribute__((ext_vector_type(2)));
#define DI __device__ __forceinline__
constexpr int D = 1024, NBATCH = 8, SEQ = 4096, CTXL = 256, DEPTH = 4;
constexpr int CTXROWS = NBATCH * CTXL;
constexpr int MROWS = CTXROWS + NBATCH * SEQ;
constexpr int NCHUNK = MROWS / 64;
constexpr int NIN = 14384;
constexpr int NT = 512;
constexpr int LDS_BYTES = 147456 + 256;
constexpr int C_GQ = 0, C_GZ = 3072, C_GA = 4096, C_SU = 4128, C_MQ = 6176, C_MO = 9248, C_MI = 11296, C_GATE = 11312;

constexpr size_t al256(size_t x) { return (x + 255) & ~(size_t)255; }
constexpr size_t SZ_ACT = (size_t)MROWS * 1024 * 2;
constexpr size_t SZ_GATE = (size_t)MROWS * 32 * 4;
constexpr size_t SZ_HALO = (size_t)3 * NCHUNK * 4 * 1024 * 2;
constexpr size_t WS_CTL = 0;
constexpr size_t WS_MOD = 65536, SZ_MOD = (size_t)DEPTH * 9 * 3072 * 4;
constexpr size_t WS_XCTX = al256(WS_MOD + SZ_MOD);
constexpr size_t WS_H = WS_XCTX + (size_t)CTXROWS * 1024 * 4;
constexpr size_t WS_MERGED = WS_H + SZ_ACT;
constexpr size_t SZ_WB = (size_t)3328 * 1024 * 2;
constexpr size_t WS_WB0 = WS_MERGED + SZ_ACT;
constexpr size_t WS_WB1 = WS_WB0 + SZ_WB;
constexpr size_t WS_R = WS_WB1 + SZ_WB;
constexpr size_t R_P0 = 0, R_P1 = SZ_ACT, R_P2 = 2 * SZ_ACT, R_OF = 3 * SZ_ACT, R_OB = 4 * SZ_ACT, R_G2 = 5 * SZ_ACT;
constexpr size_t WS_END = WS_R + R_G2 + SZ_GATE + (size_t)4 * 1024 * 1024;
static_assert(SZ_GATE + SZ_HALO <= SZ_ACT, "GDN gate + halo buffers live in the (not yet written) MERGED region");
static_assert((size_t)16 * DEPTH * 9 * 3072 * 4 <= SZ_ACT, "mod partials live in the R region");

struct Args { const float* in[28]; float* out; unsigned char* ws; int ph_lo, ph_hi, wid, pad; };
enum { I_X = 0, I_C, I_CTX, I_CCTX, I_WADA, I_BADA, I_NORMG, I_WIN, I_GCONV, I_GALOG, I_GDTB, I_GNORM, I_SLRE, I_SLIM, I_SLOG, I_SBRE, I_SBIM, I_SCRE, I_SCIM, I_SD, I_SWGLU, I_SBGLU, I_MIB, I_MFB, I_MNORM, I_WBR, I_WOUT, I_FNORM };

typedef const Args __attribute__((address_space(4)))* ArgsP;
DI ArgsP args_ptr() { ArgsP p = (ArgsP)__builtin_amdgcn_kernarg_segment_ptr(); asm volatile("" : "+s"(p)); return p; }
DI int lane_id() { int l; asm volatile("v_mbcnt_lo_u32_b32 %0, -1, 0\n\tv_mbcnt_hi_u32_b32 %0, -1, %0" : "=v"(l)); return l; }
DI int ltid(const Args& a) { return (a.wid << 6) | lane_id(); }
DI void lds_barrier() { asm volatile("s_waitcnt lgkmcnt(0)" ::: "memory"); __builtin_amdgcn_s_barrier(); asm volatile("" ::: "memory"); }
DI float bf2f(bf16_t v) { return __uint_as_float(((unsigned)v) << 16); }
DI float bflo(unsigned w) { return __uint_as_float(w << 16); }
DI float bfhi(unsigned w) { return __uint_as_float(w & 0xffff0000u); }
DI bf16_t f2bf(float f) { return (bf16_t)(pg8::cvt_pk_bf16(f, 0.f) & 0xffffu); }
DI float sigmoidf_(float x) { return __builtin_amdgcn_rcpf(1.0f + __expf(-x)); }
DI float siluf_(float x) { return x * __builtin_amdgcn_rcpf(1.0f + __expf(-x)); }
DI float softplusf_(float x) { return x > 20.f ? x : log1pf(__expf(x)); }
DI float gelu_tanh_(float x) { const float u = 0.7978845608028654f * (x + 0.044715f * x * x * x); return x * __builtin_amdgcn_rcpf(1.0f + __expf(-2.0f * u)); }
DI float shx(float v, int o, int lane) { return __int_as_float(__builtin_amdgcn_ds_bpermute((lane ^ o) << 2, __float_as_int(v))); }
DI float shup(float v, int o, int lane) { return __int_as_float(__builtin_amdgcn_ds_bpermute((lane - o) << 2, __float_as_int(v))); }
DI float shidx(float v, int src) { return __int_as_float(__builtin_amdgcn_ds_bpermute(src << 2, __float_as_int(v))); }
#define DPP_F(old_, src_, ctrl_, rmask_) __int_as_float(__builtin_amdgcn_update_dpp(__float_as_int(old_), __float_as_int(src_), (ctrl_), (rmask_), 0xF, false))
DI float dpp_scan_sum(float v) {
    v += DPP_F(0.f, v, 0x111, 0xF); v += DPP_F(0.f, v, 0x112, 0xF); v += DPP_F(0.f, v, 0x114, 0xF); v += DPP_F(0.f, v, 0x118, 0xF);
    v += DPP_F(0.f, v, 0x142, 0xA); v += DPP_F(0.f, v, 0x143, 0xC); return v; }
DI float dpp_scan_max(float v) {
    const float ninf = -__builtin_inff();
    v = fmaxf(v, DPP_F(ninf, v, 0x111, 0xF)); v = fmaxf(v, DPP_F(ninf, v, 0x112, 0xF)); v = fmaxf(v, DPP_F(ninf, v, 0x114, 0xF)); v = fmaxf(v, DPP_F(ninf, v, 0x118, 0xF));
    v = fmaxf(v, DPP_F(ninf, v, 0x142, 0xA)); v = fmaxf(v, DPP_F(ninf, v, 0x143, 0xC)); return v; }
DI float lane63(float v) { return __int_as_float(__builtin_amdgcn_readlane(__float_as_int(v), 63)); }
DI float wave_sum(float v, int lane) {
#pragma unroll
    for (int o = 32; o >= 1; o >>= 1) v += shx(v, o, lane);
    return v; }
DI void unpack8(const u32x4 w, float (&f)[8]) { f[0] = bflo(w.x); f[1] = bfhi(w.x); f[2] = bflo(w.y); f[3] = bfhi(w.y); f[4] = bflo(w.z); f[5] = bfhi(w.z); f[6] = bflo(w.w); f[7] = bfhi(w.w); }
DI int lat_pos(int l, int s) { return (l & 1) ? (((s & 63) << 6) | (s >> 6)) : s; }

struct EpiProj {
    static constexpr bool PERM = true, AFTER_DRAIN = false;
    bf16_t* d0; int modes; float* gdst; int gtile; bf16_t* halo; int row_off;
    __device__ __forceinline__ void operator()(const f32x4 (&acc)[2][2][4][2], const Unit& u, int wr, int wc, int fr, int fq) const {
        const int row0 = row_off + u.pm * 256 + wr * 64 + fr;
        if (u.pn == gtile) {
            if (wc == 0) {
#pragma unroll
                for (int ai = 0; ai < 2; ++ai)
#pragma unroll
                    for (int m = 0; m < 4; ++m) { float* rp = gdst + (size_t)(row0 + ai * 128 + m * 16) * 32 + 8 * fq; *(f32x4*)rp = acc[ai][0][m][0]; *(f32x4*)(rp + 4) = acc[ai][0][m][1]; }
            }
            return;
        }
        const int seg = u.pn >> 2; bf16_t* base = d0 + (size_t)seg * (SZ_ACT / 2); const int md = (modes >> (2 * seg)) & 3;
        const int col0 = (u.pn & 3) * 256 + wc * 32 + 8 * fq;
#pragma unroll
        for (int ai = 0; ai < 2; ++ai)
#pragma unroll
            for (int m = 0; m < 4; ++m) {
                const int r = row0 + ai * 128 + m * 16;
                bf16_t* rowp = base + (size_t)r * 1024 + col0;
                int hidx = -1;
                if (halo) { if (m == 0 && fr < 2) hidx = fr; if (m == 3 && fr >= 14) hidx = fr - 12; }
#pragma unroll
                for (int bj = 0; bj < 2; ++bj) {
                    f32x4 v0 = acc[ai][bj][m][0], v1 = acc[ai][bj][m][1];
                    if (md == 1) {
#pragma unroll
                        for (int j = 0; j < 4; ++j) { v0[j] = siluf_(v0[j]); v1[j] = siluf_(v1[j]); } }
                    else if (md == 2) {
#pragma unroll
                        for (int j = 0; j < 4; ++j) { v0[j] = sigmoidf_(v0[j]); v1[j] = sigmoidf_(v1[j]); } }
                    u32x4 w; w.x = pg8::cvt_pk_bf16(v0[0], v0[1]); w.y = pg8::cvt_pk_bf16(v0[2], v0[3]); w.z = pg8::cvt_pk_bf16(v1[0], v1[1]); w.w = pg8::cvt_pk_bf16(v1[2], v1[3]);
                    *(u32x4*)(rowp + bj * 128) = w;
                    if (hidx >= 0) *(u32x4*)(halo + ((size_t)seg * (NCHUNK * 4) + (size_t)(r >> 6) * 4 + hidx) * 1024 + col0 + bj * 128) = w;
                }
            }
    }
};
struct EpiBranch {
    static constexpr bool PERM = true, AFTER_DRAIN = false;
    const bf16_t* G; bf16_t* MG; int first, row_off;
    __device__ __forceinline__ void operator()(const f32x4 (&acc)[2][2][4][2], const Unit& u, int wr, int wc, int fr, int fq) const {
        const int row0 = row_off + u.pm * 256 + wr * 64 + fr, col0 = u.pn * 256 + wc * 32 + 8 * fq;
#pragma unroll
        for (int ai = 0; ai < 2; ++ai)
#pragma unroll
            for (int m = 0; m < 4; ++m) {
                const size_t off = (size_t)(row0 + ai * 128 + m * 16) * 1024 + col0;
#pragma unroll
                for (int bj = 0; bj < 2; ++bj) {
                    const u32x4 gw = *(const u32x4*)(G + off + bj * 128);
                    float g[8], o[8]; unpack8(gw, g);
                    if (first) {
#pragma unroll
                        for (int j = 0; j < 8; ++j) o[j] = 0.f; }
                    else { const u32x4 ow = *(const u32x4*)(MG + off + bj * 128); unpack8(ow, o); }
                    const f32x4 v0 = acc[ai][bj][m][0], v1 = acc[ai][bj][m][1];
#pragma unroll
                    for (int j = 0; j < 4; ++j) { o[j] += g[j] * v0[j]; o[4 + j] += g[4 + j] * v1[j]; }
                    u32x4 w; w.x = pg8::cvt_pk_bf16(o[0], o[1]); w.y = pg8::cvt_pk_bf16(o[2], o[3]); w.z = pg8::cvt_pk_bf16(o[4], o[5]); w.w = pg8::cvt_pk_bf16(o[6], o[7]);
                    *(u32x4*)(MG + off + bj * 128) = w;
                }
                asm volatile("" ::: "memory");
            }
    }
};
struct EpiGlu {
    static constexpr bool PERM = true, AFTER_DRAIN = false;
    const bf16_t* SZ; bf16_t* O; const float* bias; int row_off;
    __device__ __forceinline__ void operator()(const f32x4 (&acc)[2][2][4][2], const Unit& u, int wr, int wc, int fr, int fq) const {
        const int row0 = row_off + u.pm * 256 + wr * 64 + fr, col0 = u.pn * 128 + wc * 32 + 8 * fq;
        float ba[8], bg[8];
#pragma unroll
        for (int j = 0; j < 8; ++j) { ba[j] = bias[col0 + j]; bg[j] = bias[1024 + col0 + j]; }
#pragma unroll
        for (int ai = 0; ai < 2; ++ai)
#pragma unroll
            for (int m = 0; m < 4; ++m) {
                const size_t off = (size_t)(row0 + ai * 128 + m * 16) * 1024 + col0;
                const u32x4 zw = *(const u32x4*)(SZ + off); float z[8], o[8]; unpack8(zw, z);
#pragma unroll
                for (int n = 0; n < 2; ++n)
#pragma unroll
                    for (int j = 0; j < 4; ++j) { const int c = 4 * n + j; o[c] = (acc[ai][0][m][n][j] + ba[c]) * sigmoidf_(acc[ai][1][m][n][j] + bg[c]) * z[c]; }
                u32x4 w; w.x = pg8::cvt_pk_bf16(o[0], o[1]); w.y = pg8::cvt_pk_bf16(o[2], o[3]); w.z = pg8::cvt_pk_bf16(o[4], o[5]); w.w = pg8::cvt_pk_bf16(o[6], o[7]);
                *(u32x4*)(O + off) = w;
            }
    }
};
struct EpiOut {
    static constexpr bool PERM = false, AFTER_DRAIN = false;
    const float* xlat_src; float* xlat_dst; const float* xctx_src; float* xctx_dst; const float* mod; int l; int row_off;
    __device__ __forceinline__ void operator()(const f32x4 (&acc)[2][2][4][2], const Unit& u, int wr, int wc, int fr, int fq) const {
        const int row0 = row_off + u.pm * 256 + wr * 64 + fr, col0 = u.pn * 256 + wc * 32 + 4 * fq;
#pragma unroll
        for (int ai = 0; ai < 2; ++ai)
#pragma unroll
            for (int m = 0; m < 4; ++m) {
                const int r = row0 + ai * 128 + m * 16;
                const float* xs; float* xd; const float* gp;
                if (r < CTXROWS) { xs = xctx_src + (size_t)r * 1024; xd = xctx_dst + (size_t)r * 1024; gp = mod + 8 * 3072 + 2048; }
                else { const int q = r - CTXROWS, b = q >> 12, p = lat_pos(l, q & 4095); const size_t o = ((size_t)b * 4096 + p) * 1024; xs = xlat_src + o; xd = xlat_dst + o; gp = mod + b * 3072 + 2048; }
#pragma unroll
                for (int bj = 0; bj < 2; ++bj)
#pragma unroll
                    for (int n = 0; n < 2; ++n) { const int c = col0 + bj * 128 + n * 16; const f32x4 x = *(const f32x4*)(xs + c), g = *(const f32x4*)(gp + c); *(f32x4*)(xd + c) = x + g * acc[ai][bj][m][n]; }
                asm volatile("" ::: "memory");
            }
    }
};

DI void ph_modp(const Args& a, float* modp, LAS float* sl) {
    for (int it = blockIdx.x; it < 384; it += gridDim.x) {
        const int l = it / 96, kq = (it / 6) % 16, nt = it % 6;
        __syncthreads();
        for (int i = ltid(a); i < 576; i += NT) { const int j = i >> 6, k = kq * 64 + (i & 63); const float cv = (j < 8) ? a.in[I_C][j * 1024 + k] : a.in[I_CCTX][k]; sl[i] = siluf_(cv); }
        __syncthreads();
        const int n = nt * 512 + ltid(a);
        float acc[9];
#pragma unroll
        for (int j = 0; j < 9; ++j) acc[j] = 0.f;
        const float* w = a.in[I_WADA] + ((size_t)l * 1024 + kq * 64) * 3072 + n;
#pragma unroll 4
        for (int k = 0; k < 64; ++k) { const float wv = w[(size_t)k * 3072];
#pragma unroll
            for (int j = 0; j < 9; ++j) acc[j] += sl[j * 64 + k] * wv; }
#pragma unroll
        for (int j = 0; j < 9; ++j) modp[(((size_t)kq * 4 + l) * 9 + j) * 3072 + n] = acc[j];
    }
}
DI void ph_mod(const Args& a, const float* modp, float* mod) {
    for (int i = blockIdx.x * NT + ltid(a); i < DEPTH * 9 * 3072; i += gridDim.x * NT) {
        const int l = i / (9 * 3072), n = i % 3072; float s = a.in[I_BADA][l * 3072 + n];
#pragma unroll
        for (int kq = 0; kq < 16; ++kq) s += modp[(size_t)kq * (DEPTH * 9 * 3072) + i];
        mod[i] = s;
    }
}
DI void ph_norm(const Args& a, int l, const float* xlat, const float* xctx, const float* mod, bf16_t* H) {
    const int wave = ltid(a) >> 6, lane = ltid(a) & 63;
    const float* g = a.in[I_NORMG] + l * 1024;
    for (int r = blockIdx.x * 8 + wave; r < MROWS; r += gridDim.x * 8) {
        const float* src; const float* md;
        if (r < CTXROWS) { src = xctx + (size_t)r * 1024; md = mod + 8 * 3072; }
        else { const int q = r - CTXROWS, b = q >> 12, p = lat_pos(l, q & 4095); src = xlat + ((size_t)b * 4096 + p) * 1024; md = mod + b * 3072; }
        f32x4 v[4]; float ss = 0.f;
#pragma unroll
        for (int i = 0; i < 4; ++i) { v[i] = *(const f32x4*)(src + i * 256 + lane * 4); ss += v[i][0] * v[i][0] + v[i][1] * v[i][1] + v[i][2] * v[i][2] + v[i][3] * v[i][3]; }
        ss = wave_sum(ss, lane);
        const float rs = rsqrtf(ss * (1.0f / 1024.0f) + 1e-6f);
#pragma unroll
        for (int i = 0; i < 4; ++i) { const int c = i * 256 + lane * 4;
            const f32x4 gv = *(const f32x4*)(g + c), sh = *(const f32x4*)(md + c), sc = *(const f32x4*)(md + 1024 + c);
            const f32x4 y = (v[i] * rs) * gv * (sc + 1.0f) + sh;
            u32x2 w; w.x = pg8::cvt_pk_bf16(y[0], y[1]); w.y = pg8::cvt_pk_bf16(y[2], y[3]);
            *(u32x2*)(H + (size_t)r * 1024 + c) = w; }
    }
}
DI void ph_final(const Args& a, float* x) {
    const int wave = ltid(a) >> 6, lane = ltid(a) & 63;
    const float* g = a.in[I_FNORM];
    for (int r = blockIdx.x * 8 + wave; r < NBATCH * SEQ; r += gridDim.x * 8) {
        float* src = x + (size_t)r * 1024;
        f32x4 v[4]; float ss = 0.f;
#pragma unroll
        for (int i = 0; i < 4; ++i) { v[i] = *(const f32x4*)(src + i * 256 + lane * 4); ss += v[i][0] * v[i][0] + v[i][1] * v[i][1] + v[i][2] * v[i][2] + v[i][3] * v[i][3]; }
        ss = wave_sum(ss, lane);
        const float rs = rsqrtf(ss * (1.0f / 1024.0f) + 1e-6f);
#pragma unroll
        for (int i = 0; i < 4; ++i) { const int c = i * 256 + lane * 4; const f32x4 gv = *(const f32x4*)(g + c); *(f32x4*)(src + c) = (v[i] * rs) * gv; }
    }
}
struct WDesc { const float* src; int ld, id, n64, tid; };
DI void wmap(int id, int nb, int& col, int& valid) {
    valid = 64;
    switch (id) {
        case 0: if (nb < 48) col = C_GQ + 64 * nb; else if (nb == 48) { col = C_GA; valid = 32; } else { col = 0; valid = 0; } break;
        case 1: col = (nb < 16) ? C_GZ + 64 * nb : C_GATE + 64 * (nb - 16); break;
        case 2: if (nb < 48) col = C_MQ + 64 * nb; else if (nb == 48) { col = C_MI; valid = 16; } else { col = 0; valid = 0; } break;
        case 3: col = (nb < 32) ? C_MO + 64 * nb : C_GATE + 2048 + 64 * (nb - 32); break;
        case 4: col = (nb < 32) ? C_SU + 64 * nb : C_GATE + 1024 + 64 * (nb - 32); break;
        case 5: { const int pn = nb >> 2, q = nb & 3; col = (q >> 1) * 1024 + 128 * pn + (q & 1) * 64; } break;
        default: col = 64 * nb; break;
    }
}
DI WDesc wdesc(const Args& a, int l, int id) {
    WDesc w; w.id = id; w.tid = ltid(a);
    if (id <= 4) { w.src = a.in[I_WIN] + (size_t)l * 1024 * NIN; w.ld = NIN; w.n64 = (id == 0 || id == 2) ? 52 : (id == 1 ? 32 : 48); }
    else if (id == 5) { w.src = a.in[I_SWGLU] + (size_t)l * 1024 * 2048; w.ld = 2048; w.n64 = 32; }
    else if (id <= 8) { w.src = a.in[I_WBR] + ((size_t)l * 3 + (id - 6)) * 1024 * 1024; w.ld = 1024; w.n64 = 16; }
    else { w.src = a.in[I_WOUT] + (size_t)l * 1024 * 1024; w.ld = 1024; w.n64 = 16; }
    return w;
}
DI void ph_cvt(const WDesc w, bf16_t* dst, LAS float* tile) {
    const int tid = w.tid, ntile = w.n64 * 16;
    const int r0 = tid >> 4, c4 = (tid & 15) * 4;
    f32x4 p0, p1; int buf = 0;
#define CVT_FETCH(t_) do { const int nb_ = (t_) >> 4, kb_ = (t_) & 15; int col_, valid_; wmap(w.id, nb_, col_, valid_); \
        const f32x4 z_ = (f32x4){0.f, 0.f, 0.f, 0.f}; const bool on_ = c4 < valid_; \
        p0 = on_ ? *(const f32x4*)(w.src + (size_t)(kb_ * 64 + r0) * w.ld + col_ + c4) : z_; p1 = on_ ? *(const f32x4*)(w.src + (size_t)(kb_ * 64 + r0 + 32) * w.ld + col_ + c4) : z_; } while (0)
    int t = blockIdx.x;
    if (t < ntile) CVT_FETCH(t);
    for (; t < ntile; t += gridDim.x) {
        LAS float* tl = tile + buf * (64 * 65);
        tl[r0 * 65 + c4] = p0[0]; tl[r0 * 65 + c4 + 1] = p0[1]; tl[r0 * 65 + c4 + 2] = p0[2]; tl[r0 * 65 + c4 + 3] = p0[3];
        tl[(r0 + 32) * 65 + c4] = p1[0]; tl[(r0 + 32) * 65 + c4 + 1] = p1[1]; tl[(r0 + 32) * 65 + c4 + 2] = p1[2]; tl[(r0 + 32) * 65 + c4 + 3] = p1[3];
        if (t + (int)gridDim.x < ntile) CVT_FETCH(t + (int)gridDim.x);
        lds_barrier();
        { const int nb = t >> 4, kb = t & 15, n = tid >> 3, kk = (tid & 7) * 8; u32x4 o;
          o.x = pg8::cvt_pk_bf16(tl[(kk + 0) * 65 + n], tl[(kk + 1) * 65 + n]); o.y = pg8::cvt_pk_bf16(tl[(kk + 2) * 65 + n], tl[(kk + 3) * 65 + n]);
          o.z = pg8::cvt_pk_bf16(tl[(kk + 4) * 65 + n], tl[(kk + 5) * 65 + n]); o.w = pg8::cvt_pk_bf16(tl[(kk + 6) * 65 + n], tl[(kk + 7) * 65 + n]);
          *(u32x4*)(dst + (size_t)(nb * 64 + n) * 1024 + kb * 64 + kk) = o; }
        buf ^= 1;
    }
#undef CVT_FETCH
    __syncthreads();
}

DI void gdn_conv_decode(int unit, int& cb, int& seg, int& h) { cb = unit / 24; seg = (unit % 24) >> 3; h = unit & 7; }
DI void ph_gdn_conv(const Args& a, int l, bf16_t* QKV  , const bf16_t* halo, LAS unsigned char* lds, bf16_t* junk = nullptr) {
    constexpr int P = 136, IMG = 68 * P * 2 + 5 * 128 * 4;
    const int tid = ltid(a);
    const float* cw = a.in[I_GCONV] + (size_t)l * 5 * 3072;
    const int nunit = NCHUNK * 24;
    u32x4 rp[3]; f32x4 wreg = (f32x4){0.f, 0.f, 0.f, 0.f};
    int unit = blockIdx.x, buf = 0;
#define CONV_FETCH(un) do { int cb_, seg_, h_; gdn_conv_decode(un, cb_, seg_, h_); const bf16_t* T_ = QKV + (size_t)seg_ * (SZ_ACT / 2); \
        const bool first_ = (cb_ < 32) ? ((cb_ & 3) == 0) : (((cb_ - 32) & 63) == 0), last_ = (cb_ < 32) ? ((cb_ & 3) == 3) : (((cb_ - 32) & 63) == 63); \
        _Pragma("unroll") for (int q_ = 0; q_ < 3; ++q_) { const int i_ = tid + 512 * q_, rr_ = i_ >> 4, c8_ = (i_ & 15) * 8; u32x4 w_ = (u32x4){0u, 0u, 0u, 0u}; \
            if (i_ < 68 * 16) { if (rr_ >= 2 && rr_ < 66) w_ = *(const u32x4*)(T_ + (size_t)(cb_ * 64 + rr_ - 2) * 1024 + h_ * 128 + c8_); \
                else if (rr_ < 2) { if (!first_) w_ = *(const u32x4*)(halo + ((size_t)seg_ * (NCHUNK * 4) + (size_t)(cb_ - 1) * 4 + 2 + rr_) * 1024 + h_ * 128 + c8_); } \
                else { if (!last_) w_ = *(const u32x4*)(halo + ((size_t)seg_ * (NCHUNK * 4) + (size_t)(cb_ + 1) * 4 + (rr_ - 66)) * 1024 + h_ * 128 + c8_); } } \
            rp[q_] = w_; } \
        if (tid < 160) wreg = *(const f32x4*)(cw + (size_t)(tid >> 5) * 3072 + seg_ * 1024 + h_ * 128 + (tid & 31) * 4); } while (0)
    if (unit < nunit) CONV_FETCH(unit);
    for (; unit < nunit; unit += gridDim.x) {
        int cb, seg, h; gdn_conv_decode(unit, cb, seg, h);
        LAS bf16_t* raw = (LAS bf16_t*)(lds + buf * IMG); LAS float* wl = (LAS float*)(lds + buf * IMG + 68 * P * 2);
#pragma unroll
        for (int q = 0; q < 3; ++q) { const int i = tid + 512 * q, rr = i >> 4, c8 = (i & 15) * 8; if (i < 68 * 16) *(LAS u32x4*)(raw + rr * P + c8) = rp[q]; }
        if (tid < 160) *(LAS f32x4*)(wl + tid * 4) = wreg;
        if (unit + (int)gridDim.x < nunit) CONV_FETCH(unit + (int)gridDim.x);
        lds_barrier();
        bf16_t* T = QKV + (size_t)seg * (SZ_ACT / 2);
        const int t = tid >> 3, c0 = (tid & 7) * 16;
        float o[16]; float ss = 0.f;
#pragma unroll
        for (int half = 0; half < 2; ++half) {
            float acc[8];
#pragma unroll
            for (int j = 0; j < 8; ++j) acc[j] = 0.f;
#pragma unroll
            for (int k = 0; k < 5; ++k) {
                const u32x4 w = *(const LAS u32x4*)(raw + (t + k) * P + c0 + half * 8); float x[8]; unpack8(w, x);
                const f32x4 w0 = *(const LAS f32x4*)(wl + k * 128 + c0 + half * 8), w1 = *(const LAS f32x4*)(wl + k * 128 + c0 + half * 8 + 4);
#pragma unroll
                for (int j = 0; j < 4; ++j) { acc[j] += w0[j] * x[j]; acc[4 + j] += w1[j] * x[4 + j]; }
            }
#pragma unroll
            for (int j = 0; j < 8; ++j) { const float sv = siluf_(acc[j]); o[half * 8 + j] = sv; ss += sv * sv; }
        }
        ss += shx(ss, 1, tid & 63); ss += shx(ss, 2, tid & 63); ss += shx(ss, 4, tid & 63);
        float scale = 1.0f;
        if (seg == 0) scale = rsqrtf(ss + 1e-6f) * 0.08838834764831845f;
        else if (seg == 1) scale = rsqrtf(ss + 1e-6f);
        u32x4 w0, w1;
        w0.x = pg8::cvt_pk_bf16(o[0] * scale, o[1] * scale); w0.y = pg8::cvt_pk_bf16(o[2] * scale, o[3] * scale); w0.z = pg8::cvt_pk_bf16(o[4] * scale, o[5] * scale); w0.w = pg8::cvt_pk_bf16(o[6] * scale, o[7] * scale);
        w1.x = pg8::cvt_pk_bf16(o[8] * scale, o[9] * scale); w1.y = pg8::cvt_pk_bf16(o[10] * scale, o[11] * scale); w1.z = pg8::cvt_pk_bf16(o[12] * scale, o[13] * scale); w1.w = pg8::cvt_pk_bf16(o[14] * scale, o[15] * scale);
        bf16_t* op = (junk ? junk : T) + (size_t)(cb * 64 + t) * 1024 + h * 128 + c0;
        *(u32x4*)op = w0; *(u32x4*)(op + 8) = w1;
        buf ^= 1;
    }
#undef CONV_FETCH
    __syncthreads();
}
DI void ph_gdn_scan(const Args& a, int l, const bf16_t* Q, const bf16_t* K, const bf16_t* V, const float* GATE, bf16_t* OF, bf16_t* OB, LAS unsigned char* lds) {
    LAS float* qf = (LAS float*)lds;
    LAS float* kf = qf + 64 * 128;
    LAS float* vf = kf + 64 * 128;
    LAS float* av = vf + 64 * 64;
    LAS float* bt = av + 64;
    LAS float* part = bt + 64;
    LAS float* po = part + 1024;
    const int tid = ltid(a), e = tid & 63, dq = tid >> 6;
    for (int unit = blockIdx.x; unit < 256; unit += gridDim.x) {
        const int eh = unit & 1, d = (unit >> 1) & 1, h = (unit >> 2) & 7, b = unit >> 5;
        const float nea = -__expf(a.in[I_GALOG][(l * 2 + d) * 8 + h]), dtb = a.in[I_GDTB][(l * 2 + d) * 8 + h];
        bf16_t* O = d ? OB : OF;
        float S[16];
#pragma unroll
        for (int j = 0; j < 16; ++j) S[j] = 0.f;
        float opart = 0.f; int prow = -1, par = 0;
        for (int step = 0; step < 68; ++step) {
            const int cc = (step < 4) ? (d ? 3 - step : step) : (d ? 67 - step : step - 4);
            const int row0 = (step < 4) ? b * 256 + cc * 64 : CTXROWS + b * 4096 + cc * 64;
            __syncthreads();
            for (int i = tid; i < 1024; i += NT) { const int r = i >> 4, c8 = (i & 15) * 8; float f[8];
                unpack8(*(const u32x4*)(Q + (size_t)(row0 + r) * 1024 + h * 128 + c8), f);
#pragma unroll
                for (int j = 0; j < 8; ++j) qf[r * 128 + c8 + j] = f[j];
                unpack8(*(const u32x4*)(K + (size_t)(row0 + r) * 1024 + h * 128 + c8), f);
#pragma unroll
                for (int j = 0; j < 8; ++j) kf[r * 128 + c8 + j] = f[j]; }
            { const int r = tid >> 3, c8 = (tid & 7) * 8; float f[8]; unpack8(*(const u32x4*)(V + (size_t)(row0 + r) * 1024 + h * 128 + eh * 64 + c8), f);
#pragma unroll
              for (int j = 0; j < 8; ++j) vf[r * 64 + c8 + j] = f[j]; }
            if (tid < 64) { const float* gp = GATE + (size_t)(row0 + tid) * 32; av[tid] = __expf(nea * softplusf_(gp[d * 8 + h] + dtb)); bt[tid] = sigmoidf_(gp[16 + d * 8 + h]); }
            __syncthreads();
            for (int tt = 0; tt < 64; ++tt) {
                const int t = d ? 63 - tt : tt;
                float kk[16];
#pragma unroll
                for (int j4 = 0; j4 < 4; ++j4) { const f32x4 x = *(const LAS f32x4*)(kf + t * 128 + dq * 16 + j4 * 4); kk[j4 * 4] = x[0]; kk[j4 * 4 + 1] = x[1]; kk[j4 * 4 + 2] = x[2]; kk[j4 * 4 + 3] = x[3]; }
                float p = 0.f;
#pragma unroll
                for (int j = 0; j < 16; ++j) p += kk[j] * S[j];
                part[(par * 8 + dq) * 64 + e] = p; po[(par * 8 + dq) * 64 + e] = opart;
                __syncthreads();
                if (dq == 0 && prow >= 0) { float o = 0.f;
#pragma unroll
                    for (int q = 0; q < 8; ++q) o += po[(par * 8 + q) * 64 + e];
                    O[(size_t)prow * 1024 + h * 128 + eh * 64 + e] = f2bf(o); }
                float ks = 0.f;
#pragma unroll
                for (int q = 0; q < 8; ++q) ks += part[(par * 8 + q) * 64 + e];
                const float at = av[t], vn = bt[t] * (vf[t * 64 + e] - at * ks);
#pragma unroll
                for (int j = 0; j < 16; ++j) S[j] = at * S[j] + kk[j] * vn;
                float qo = 0.f;
#pragma unroll
                for (int j4 = 0; j4 < 4; ++j4) { const f32x4 x = *(const LAS f32x4*)(qf + t * 128 + dq * 16 + j4 * 4); qo += x[0] * S[j4 * 4] + x[1] * S[j4 * 4 + 1] + x[2] * S[j4 * 4 + 2] + x[3] * S[j4 * 4 + 3]; }
                opart = qo; prow = row0 + t; par ^= 1;
            }
        }
        po[(par * 8 + dq) * 64 + e] = opart;
        __syncthreads();
        if (dq == 0) { float o = 0.f;
#pragma unroll
            for (int q = 0; q < 8; ++q) o += po[(par * 8 + q) * 64 + e];
            O[(size_t)prow * 1024 + h * 128 + eh * 64 + e] = f2bf(o); }
        __syncthreads();
    }
}
template <int O> DI float swz_xor(float v) { return __int_as_float(__builtin_amdgcn_ds_swizzle(__float_as_int(v), 0x1F | (O << 10))); }
DI void ph_gdn_post(const Args& a, int l, bf16_t* OF, const bf16_t* OB, const bf16_t* SZ, bf16_t* junk = nullptr) {
    const int tid = ltid(a), wave = tid >> 6, lane = tid & 63;
    const float* g = a.in[I_GNORM] + l * 128 + (lane & 15) * 8;
    const f32x4 g0 = *(const f32x4*)g, g1 = *(const f32x4*)(g + 4);
    const int nit = MROWS * 2, stride = gridDim.x * 8;
    for (int it = blockIdx.x * 8 + wave; it < nit; it += 2 * stride) {
        const int it1 = it + stride; const bool two = it1 < nit;
        const size_t off0 = (size_t)it * 512 + lane * 8, off1 = (size_t)(two ? it1 : it) * 512 + lane * 8;
        const u32x4 f0 = *(const u32x4*)(OF + off0), b0 = *(const u32x4*)(OB + off0), z0 = *(const u32x4*)(SZ + off0);
        const u32x4 f1 = *(const u32x4*)(OF + off1), b1 = *(const u32x4*)(OB + off1), z1 = *(const u32x4*)(SZ + off1);
        float x0[8], x1[8], t0[8], t1[8];
        unpack8(f0, x0); unpack8(b0, t0); unpack8(f1, x1); unpack8(b1, t1);
        float s0 = 0.f, s1 = 0.f;
#pragma unroll
        for (int j = 0; j < 8; ++j) { x0[j] += t0[j]; x1[j] += t1[j]; s0 += x0[j] * x0[j]; s1 += x1[j] * x1[j]; }
        s0 += swz_xor<1>(s0); s1 += swz_xor<1>(s1); s0 += swz_xor<2>(s0); s1 += swz_xor<2>(s1); s0 += swz_xor<4>(s0); s1 += swz_xor<4>(s1); s0 += swz_xor<8>(s0); s1 += swz_xor<8>(s1);
        const float r0 = rsqrtf(s0 * (1.0f / 128.0f) + 1e-6f), r1 = rsqrtf(s1 * (1.0f / 128.0f) + 1e-6f);
        unpack8(z0, t0); unpack8(z1, t1);
        u32x4 w0, w1;
        w0.x = pg8::cvt_pk_bf16(x0[0] * r0 * g0[0] * t0[0], x0[1] * r0 * g0[1] * t0[1]); w0.y = pg8::cvt_pk_bf16(x0[2] * r0 * g0[2] * t0[2], x0[3] * r0 * g0[3] * t0[3]);
        w0.z = pg8::cvt_pk_bf16(x0[4] * r0 * g1[0] * t0[4], x0[5] * r0 * g1[1] * t0[5]); w0.w = pg8::cvt_pk_bf16(x0[6] * r0 * g1[2] * t0[6], x0[7] * r0 * g1[3] * t0[7]);
        w1.x = pg8::cvt_pk_bf16(x1[0] * r1 * g0[0] * t1[0], x1[1] * r1 * g0[1] * t1[1]); w1.y = pg8::cvt_pk_bf16(x1[2] * r1 * g0[2] * t1[2], x1[3] * r1 * g0[3] * t1[3]);
        w1.z = pg8::cvt_pk_bf16(x1[4] * r1 * g1[0] * t1[4], x1[5] * r1 * g1[1] * t1[5]); w1.w = pg8::cvt_pk_bf16(x1[6] * r1 * g1[2] * t1[6], x1[7] * r1 * g1[3] * t1[7]);
        bf16_t* dst = junk ? junk : OF;
        *(u32x4*)(dst + off0) = w0; if (two) *(u32x4*)(dst + off1) = w1;
    }
}

DI void ph_ml_scan(const Args& a, int l, const bf16_t* Q, const bf16_t* K, const bf16_t* V, const float* GATE, bf16_t* HF, bf16_t* HB, LAS unsigned char* lds) {
    LAS bf16_t* qs = (LAS bf16_t*)lds;
    LAS bf16_t* ks = qs + 64 * 256;
    LAS float* vf = (LAS float*)(ks + 64 * 256);
    LAS float* ip = vf + 64 * 64;
    LAS float* lf = ip + 64;
    LAS float* part = lf + 64;
    LAS float* dpart = part + 1024;
    const int tid = ltid(a), e = tid & 63, dq = tid >> 6;
    for (int unit = blockIdx.x; unit < 256; unit += gridDim.x) {
        const int eq = unit & 3, d = (unit >> 2) & 1, hd = (unit >> 3) & 3, b = unit >> 5;
        const float ibias = a.in[I_MIB][(l * 2 + d) * 4 + hd], fbias = a.in[I_MFB][(l * 2 + d) * 4 + hd];
        bf16_t* HO = d ? HB : HF;
        float C[32];
#pragma unroll
        for (int j = 0; j < 32; ++j) C[j] = 0.f;
        float nn = 0.f, m = 0.f; int par = 0;
        for (int step = 0; step < 68; ++step) {
            const int cc = (step < 4) ? (d ? 3 - step : step) : (d ? 67 - step : step - 4);
            const int row0 = (step < 4) ? b * 256 + cc * 64 : CTXROWS + b * 4096 + cc * 64;
            __syncthreads();
            for (int i = tid; i < 2048; i += NT) { const int r = i >> 5, c8 = (i & 31) * 8;
                *(LAS u32x4*)(qs + r * 256 + c8) = *(const u32x4*)(Q + (size_t)(row0 + r) * 1024 + hd * 256 + c8);
                *(LAS u32x4*)(ks + r * 256 + c8) = *(const u32x4*)(K + (size_t)(row0 + r) * 1024 + hd * 256 + c8); }
            { const int r = tid >> 3, c8 = (tid & 7) * 8; float f[8]; unpack8(*(const u32x4*)(V + (size_t)(row0 + r) * 1024 + hd * 256 + eq * 64 + c8), f);
#pragma unroll
              for (int j = 0; j < 8; ++j) vf[r * 64 + c8 + j] = f[j]; }
            if (tid < 64) { const float* gp = GATE + (size_t)(row0 + tid) * 32; ip[tid] = gp[d * 4 + hd] + ibias; lf[tid] = -softplusf_(-(gp[8 + d * 4 + hd] + fbias)); }
            __syncthreads();
            for (int tt = 0; tt < 64; ++tt) {
                const int t = d ? 63 - tt : tt;
                const float it = ip[t], ft = lf[t];
                const float mn = fmaxf(ft + m, it);
                const float fdec = __expf(ft + m - mn), iw = __expf(it - mn) * 0.0625f, nrm = __expf(-mn);
                m = mn;
                const float vv = iw * vf[t * 64 + e];
                float pn = 0.f;
#pragma unroll
                for (int j8 = 0; j8 < 4; ++j8) {
                    float kk[8], qq[8];
                    unpack8(*(const LAS u32x4*)(ks + t * 256 + dq * 32 + j8 * 8), kk);
                    unpack8(*(const LAS u32x4*)(qs + t * 256 + dq * 32 + j8 * 8), qq);
#pragma unroll
                    for (int j = 0; j < 8; ++j) { const float c = fdec * C[j8 * 8 + j] + vv * kk[j]; C[j8 * 8 + j] = c; pn += c * qq[j]; }
                }
                const int dn = dq * 32 + (e & 31);
                nn = fdec * nn + iw * bf2f(ks[t * 256 + dn]);
                float pd = (e < 32) ? nn * bf2f(qs[t * 256 + dn]) : 0.f;
                pd = wave_sum(pd, e);
                part[(par * 8 + dq) * 64 + e] = pn; if (e == 0) dpart[par * 8 + dq] = pd;
                __syncthreads();
                if (dq == 0) { float num = 0.f, den = 0.f;
#pragma unroll
                    for (int q = 0; q < 8; ++q) { num += part[(par * 8 + q) * 64 + e]; den += dpart[par * 8 + q]; }
                    HO[(size_t)(row0 + t) * 1024 + hd * 256 + eq * 64 + e] = f2bf(num / fmaxf(fabsf(den), nrm)); }
                par ^= 1;
            }
        }
        __syncthreads();
    }
}
DI void ph_ml_post(const Args& a, int l, bf16_t* HF, const bf16_t* HB, const bf16_t* SO, const bf16_t* SZ) {
    const int tid = ltid(a), wave = tid >> 6, lane = tid & 63;
    const float* g = a.in[I_MNORM] + l * 256 + (lane & 31) * 8;
    const f32x4 g0 = *(const f32x4*)g, g1 = *(const f32x4*)(g + 4);
    const int nit = MROWS * 2, stride = gridDim.x * 8;
    for (int it = blockIdx.x * 8 + wave; it < nit; it += stride) {
        const size_t off = (size_t)it * 512 + lane * 8;
        const u32x4 f0 = *(const u32x4*)(HF + off), b0 = *(const u32x4*)(HB + off), o0 = *(const u32x4*)(SO + off), z0 = *(const u32x4*)(SZ + off);
        float x[8], t0[8];
        unpack8(f0, x); unpack8(b0, t0);
#pragma unroll
        for (int j = 0; j < 8; ++j) x[j] += t0[j];
        unpack8(o0, t0);
        float s0 = 0.f;
#pragma unroll
        for (int j = 0; j < 8; ++j) { x[j] *= t0[j]; s0 += x[j] * x[j]; }
        s0 += swz_xor<1>(s0); s0 += swz_xor<2>(s0); s0 += swz_xor<4>(s0); s0 += swz_xor<8>(s0); s0 += swz_xor<16>(s0);
        const float r0 = rsqrtf(s0 * (1.0f / 256.0f) + 1e-6f);
        unpack8(z0, t0);
        u32x4 w0;
        w0.x = pg8::cvt_pk_bf16(x[0] * r0 * g0[0] * t0[0], x[1] * r0 * g0[1] * t0[1]); w0.y = pg8::cvt_pk_bf16(x[2] * r0 * g0[2] * t0[2], x[3] * r0 * g0[3] * t0[3]);
        w0.z = pg8::cvt_pk_bf16(x[4] * r0 * g1[0] * t0[4], x[5] * r0 * g1[1] * t0[5]); w0.w = pg8::cvt_pk_bf16(x[6] * r0 * g1[2] * t0[6], x[7] * r0 * g1[3] * t0[7]);
        *(u32x4*)(HF + off) = w0;
    }
}

DI void ph_s5_scan(const Args& a, int l, const bf16_t* U, bf16_t* YF, bf16_t* YB, LAS unsigned char* lds) {
    const int tid = ltid(a), w = tid >> 6, p = tid & 63;
    LAS float* ub = (LAS float*)lds + w * 2304;
    LAS float* yb = ub + 1024;
    LAS float* xb = yb + 1024;
    for (int unit = blockIdx.x; unit < 128; unit += gridDim.x) {
        const int gb = unit & 7, d = (unit >> 3) & 1, b = unit >> 4, g = gb * 8 + w;
        const float stp = expf(a.in[I_SLOG][(l * 2 + d) * 64 + g]);
        const float lre = a.in[I_SLRE][((size_t)(l * 2 + d) * 64 + g) * 64 + p], lim = a.in[I_SLIM][((size_t)(l * 2 + d) * 64 + g) * 64 + p];
        const float mag = expf(lre * stp), lbr = mag * cosf(lim * stp), lbi = mag * sinf(lim * stp);
        const float dnm = lre * lre + lim * lim;
        const float fre = ((lbr - 1.0f) * lre + lbi * lim) / dnm, fim = (lbi * lre - (lbr - 1.0f) * lim) / dnm;
        float bbr[16], bbi[16];
        { const float* br = a.in[I_SBRE] + (((size_t)l * 64 + g) * 64 + p) * 16; const float* bi = a.in[I_SBIM] + (((size_t)l * 64 + g) * 64 + p) * 16;
#pragma unroll
          for (int h = 0; h < 16; ++h) { bbr[h] = fre * br[h] - fim * bi[h]; bbi[h] = fre * bi[h] + fim * br[h]; } }
        const int hh = p & 15, pt = p >> 4;
        float cr[16], ci[16];
        { const float* c0 = a.in[I_SCRE] + (((size_t)l * 64 + g) * 16 + hh) * 64 + pt * 16; const float* c1 = a.in[I_SCIM] + (((size_t)l * 64 + g) * 16 + hh) * 64 + pt * 16;
#pragma unroll
          for (int j = 0; j < 16; ++j) { cr[j] = c0[j]; ci[j] = c1[j]; } }
        bf16_t* Y = d ? YB : YF;
        float xr = 0.f, xi = 0.f; int par = 0;
        for (int step = 0; step < 68; ++step) {
            const int cc = (step < 4) ? (d ? 3 - step : step) : (d ? 67 - step : step - 4);
            const int row0 = (step < 4) ? b * 256 + cc * 64 : CTXROWS + b * 4096 + cc * 64;
            __syncthreads();
            { const bf16_t* up = U + (size_t)(row0 + p) * 1024 + g * 16; float f[8];
              unpack8(*(const u32x4*)up, f);
#pragma unroll
              for (int j = 0; j < 8; ++j) ub[p * 16 + j] = f[j];
              unpack8(*(const u32x4*)(up + 8), f);
#pragma unroll
              for (int j = 0; j < 8; ++j) ub[p * 16 + 8 + j] = f[j]; }
            __syncthreads();
            for (int tt = 0; tt < 64; ++tt) {
                const int t = d ? 63 - tt : tt;
                float bur = 0.f, bui = 0.f;
#pragma unroll
                for (int h4 = 0; h4 < 4; ++h4) { const f32x4 u = *(const LAS f32x4*)(ub + t * 16 + h4 * 4);
#pragma unroll
                    for (int j = 0; j < 4; ++j) { bur += bbr[h4 * 4 + j] * u[j]; bui += bbi[h4 * 4 + j] * u[j]; } }
                const float nxr = lbr * xr - lbi * xi + bur, nxi = lbr * xi + lbi * xr + bui;
                xr = nxr; xi = nxi;
                xb[par * 128 + p] = xr; xb[par * 128 + 64 + p] = xi;
                __syncthreads();
                float y = 0.f;
#pragma unroll
                for (int j4 = 0; j4 < 4; ++j4) { const f32x4 vr = *(const LAS f32x4*)(xb + par * 128 + pt * 16 + j4 * 4), vi = *(const LAS f32x4*)(xb + par * 128 + 64 + pt * 16 + j4 * 4);
#pragma unroll
                    for (int j = 0; j < 4; ++j) y += cr[j4 * 4 + j] * vr[j] - ci[j4 * 4 + j] * vi[j]; }
                y += shx(y, 16, p); y += shx(y, 32, p);
                if (p < 16) yb[t * 16 + p] = y;
                par ^= 1;
            }
            __syncthreads();
            { u32x4 w0, w1; const LAS float* ys = yb + p * 16;
              w0.x = pg8::cvt_pk_bf16(ys[0], ys[1]); w0.y = pg8::cvt_pk_bf16(ys[2], ys[3]); w0.z = pg8::cvt_pk_bf16(ys[4], ys[5]); w0.w = pg8::cvt_pk_bf16(ys[6], ys[7]);
              w1.x = pg8::cvt_pk_bf16(ys[8], ys[9]); w1.y = pg8::cvt_pk_bf16(ys[10], ys[11]); w1.z = pg8::cvt_pk_bf16(ys[12], ys[13]); w1.w = pg8::cvt_pk_bf16(ys[14], ys[15]);
              bf16_t* yp = Y + (size_t)(row0 + p) * 1024 + g * 16; *(u32x4*)yp = w0; *(u32x4*)(yp + 8) = w1; }
        }
        __syncthreads();
    }
}
DI void ph_s5_post(const Args& a, int l, bf16_t* YF, const bf16_t* YB, const bf16_t* U) {
    const float* dsk = a.in[I_SD] + l * 1024;
    for (size_t i = (size_t)blockIdx.x * NT + ltid(a); i < (size_t)MROWS * 128; i += (size_t)gridDim.x * NT) {
        const size_t off = i * 8; const int c = (int)(off & 1023);
        float f[8], bq[8], u[8]; unpack8(*(const u32x4*)(YF + off), f); unpack8(*(const u32x4*)(YB + off), bq); unpack8(*(const u32x4*)(U + off), u);
        const f32x4 d0 = *(const f32x4*)(dsk + c), d1 = *(const f32x4*)(dsk + c + 4);
        float o[8];
#pragma unroll
        for (int j = 0; j < 4; ++j) { o[j] = gelu_tanh_(f[j] + bq[j] + d0[j] * u[j]); o[4 + j] = gelu_tanh_(f[4 + j] + bq[4 + j] + d1[j] * u[4 + j]); }
        u32x4 w; w.x = pg8::cvt_pk_bf16(o[0], o[1]); w.y = pg8::cvt_pk_bf16(o[2], o[3]); w.z = pg8::cvt_pk_bf16(o[4], o[5]); w.w = pg8::cvt_pk_bf16(o[6], o[7]);
        *(u32x4*)(YF + off) = w;
    }
}

constexpr int S5_T = 16, S5_NCH = MROWS / S5_T  , S5_RG = 2304, S5_PMG = S5_RG / 256;
constexpr size_t SZ_AX = (size_t)64 * S5_RG * 512 * 2, SZ_CW1 = (size_t)64 * 256 * 256 * 2, SZ_CW2 = (size_t)64 * 256 * 512 * 2;
constexpr size_t R5_AX = 0, R5_SZ = SZ_AX, R5_G1 = R5_SZ + SZ_ACT, R5_GLUA = R5_G1 + SZ_ACT, R5_END = R5_GLUA + SZ_ACT;
static_assert(WS_R + R5_END <= WS_END, "S5 stage layout fits the workspace"); static_assert(WS_END <= (size_t)512 * 1024 * 1024, "workspace budget");
static_assert(SZ_CW1 + SZ_CW2 + (size_t)17 * 1024 * 128 * 4 <= SZ_ACT, "S5 constants live in the H region once the last projection from H is done");

struct EpiS1 {
    static constexpr bool PERM = true, AFTER_DRAIN = false;
    bf16_t* AX; bf16_t* SZ; bf16_t* G1;
    __device__ __forceinline__ void operator()(const f32x4 (&acc)[2][2][4][2], const Unit& u, int wr, int wc, int fr, int fq) const {
        const int row0 = u.pm * 256 + wr * 64 + fr, seg = u.pn >> 2;
        const int col0 = (u.pn & 3) * 256 + wc * 32 + 8 * fq;
#pragma unroll
        for (int ai = 0; ai < 2; ++ai)
#pragma unroll
            for (int m = 0; m < 4; ++m) {
                const int r = row0 + ai * 128 + m * 16;
#pragma unroll
                for (int bj = 0; bj < 2; ++bj) {
                    f32x4 v0 = acc[ai][bj][m][0], v1 = acc[ai][bj][m][1];
                    const int c = col0 + bj * 128;
                    bf16_t* dp;
                    if (seg == 0) dp = AX + ((size_t)(c >> 4) * S5_RG + (r >> 4)) * 512 + (r & 15) * 16 + (c & 15);
                    else if (seg == 1) { dp = SZ + (size_t)r * 1024 + c;
#pragma unroll
                        for (int j = 0; j < 4; ++j) { v0[j] = siluf_(v0[j]); v1[j] = siluf_(v1[j]); } }
                    else { dp = G1 + (size_t)r * 1024 + c;
#pragma unroll
                        for (int j = 0; j < 4; ++j) { v0[j] = sigmoidf_(v0[j]); v1[j] = sigmoidf_(v1[j]); } }
                    u32x4 w; w.x = pg8::cvt_pk_bf16(v0[0], v0[1]); w.y = pg8::cvt_pk_bf16(v0[2], v0[3]); w.z = pg8::cvt_pk_bf16(v1[0], v1[1]); w.w = pg8::cvt_pk_bf16(v1[2], v1[3]);
                    *(u32x4*)dp = w;
                }
            }
    }
};
struct EpiS5L {
    static constexpr bool PERM = true, AFTER_DRAIN = false;
    bf16_t* AX;
    __device__ __forceinline__ void operator()(const f32x4 (&acc)[2][2][4][2], const Unit& u, int wr, int wc, int fr, int fq) const {
        const int g = u.pm / S5_PMG, rg0 = (u.pm % S5_PMG) * 256 + wr * 64 + fr, col0 = wc * 32 + 8 * fq;
#pragma unroll
        for (int ai = 0; ai < 2; ++ai)
#pragma unroll
            for (int m = 0; m < 4; ++m) {
                const int rg = rg0 + ai * 128 + m * 16;
                if (rg < S5_NCH) {
                    bf16_t* rp = AX + ((size_t)g * S5_RG + rg) * 512 + 256 + col0;
#pragma unroll
                    for (int bj = 0; bj < 2; ++bj) { const f32x4 v0 = acc[ai][bj][m][0], v1 = acc[ai][bj][m][1];
                        u32x4 w; w.x = pg8::cvt_pk_bf16(v0[0], v0[1]); w.y = pg8::cvt_pk_bf16(v0[2], v0[3]); w.z = pg8::cvt_pk_bf16(v1[0], v1[1]); w.w = pg8::cvt_pk_bf16(v1[2], v1[3]);
                        *(u32x4*)(rp + bj * 128) = w; }
                }
            }
    }
};
struct EpiS5Y {
    static constexpr bool PERM = true, AFTER_DRAIN = false;
    const bf16_t* AX; bf16_t* GLUA; const float* dsk;
    __device__ __forceinline__ void operator()(const f32x4 (&acc)[2][2][4][2], const Unit& u, int wr, int wc, int fr, int fq) const {
        const int g = u.pm / S5_PMG, rg0 = (u.pm % S5_PMG) * 256 + wr * 64 + fr, col0 = wc * 32 + 8 * fq;
        const int h0 = col0 & 15;
        const f32x4 d0 = *(const f32x4*)(dsk + g * 16 + h0), d1 = *(const f32x4*)(dsk + g * 16 + h0 + 4);
#pragma unroll
        for (int ai = 0; ai < 2; ++ai)
#pragma unroll
            for (int m = 0; m < 4; ++m) {
                const int rg = rg0 + ai * 128 + m * 16;
                if (rg < S5_NCH) {
#pragma unroll
                    for (int bj = 0; bj < 2; ++bj) {
                        const int c = col0 + bj * 128, t = c >> 4;
                        float uu[8]; unpack8(*(const u32x4*)(AX + ((size_t)g * S5_RG + rg) * 512 + c), uu);
                        const f32x4 v0 = acc[ai][bj][m][0], v1 = acc[ai][bj][m][1];
                        float o[8];
#pragma unroll
                        for (int j = 0; j < 4; ++j) { o[j] = gelu_tanh_(v0[j] + d0[j] * uu[j]); o[4 + j] = gelu_tanh_(v1[j] + d1[j] * uu[4 + j]); }
                        u32x4 w; w.x = pg8::cvt_pk_bf16(o[0], o[1]); w.y = pg8::cvt_pk_bf16(o[2], o[3]); w.z = pg8::cvt_pk_bf16(o[4], o[5]); w.w = pg8::cvt_pk_bf16(o[6], o[7]);
                        *(u32x4*)(GLUA + (size_t)(rg * 16 + t) * 1024 + g * 16 + h0) = w;
                    }
                }
            }
    }
};
DI void ph_s5_consts(const Args& a, int l, bf16_t* CW1, bf16_t* CW2, LAS unsigned char* lds) {
    LAS float* POW = (LAS float*)lds;
    LAS float* BB = POW + 2 * 17 * 64 * 2;
    LAS float* CC = BB + 2 * 64 * 16 * 2;
    LAS float* KT = CC + 16 * 64 * 2;
    const int tid = ltid(a);
    for (int unit = blockIdx.x; unit < 256; unit += gridDim.x) {
        const int g = unit >> 2, q4 = unit & 3;
        __syncthreads();
        for (int i = tid; i < 2 * 17 * 64; i += NT) {
            const int p = i & 63, j = (i >> 6) % 17, d = i / (17 * 64);
            const float stp = expf(a.in[I_SLOG][(l * 2 + d) * 64 + g]);
            const float lre = a.in[I_SLRE][((size_t)(l * 2 + d) * 64 + g) * 64 + p], lim = a.in[I_SLIM][((size_t)(l * 2 + d) * 64 + g) * 64 + p];
            const float mag = expf((float)j * lre * stp), ang = (float)j * (lim * stp);
            POW[i * 2] = mag * cosf(ang); POW[i * 2 + 1] = mag * sinf(ang);
        }
        for (int i = tid; i < 16 * 64; i += NT) { const int p = i & 63, h = i >> 6;
            CC[i * 2] = a.in[I_SCRE][(((size_t)l * 64 + g) * 16 + h) * 64 + p]; CC[i * 2 + 1] = a.in[I_SCIM][(((size_t)l * 64 + g) * 16 + h) * 64 + p]; }
        __syncthreads();
        for (int i = tid; i < 2 * 64 * 16; i += NT) {
            const int h = i & 15, p = (i >> 4) & 63, d = i >> 10;
            const float stp = expf(a.in[I_SLOG][(l * 2 + d) * 64 + g]);
            const float lre = a.in[I_SLRE][((size_t)(l * 2 + d) * 64 + g) * 64 + p], lim = a.in[I_SLIM][((size_t)(l * 2 + d) * 64 + g) * 64 + p];
            const float lbr = POW[((d * 17 + 1) * 64 + p) * 2], lbi = POW[((d * 17 + 1) * 64 + p) * 2 + 1];
            const float dnm = lre * lre + lim * lim;
            const float fre = ((lbr - 1.0f) * lre + lbi * lim) / dnm, fim = (lbi * lre - (lbr - 1.0f) * lim) / dnm;
            const float br = a.in[I_SBRE][(((size_t)l * 64 + g) * 64 + p) * 16 + h], bi = a.in[I_SBIM][(((size_t)l * 64 + g) * 64 + p) * 16 + h];
            BB[i * 2] = fre * br - fim * bi; BB[i * 2 + 1] = fre * bi + fim * br;
        }
        __syncthreads();
        { const int hp = tid & 15, hl = (tid >> 4) & 3, d = (tid >> 6) & 1, tg = tid >> 7, h = 4 * q4 + hl;
          float kt[4];
#pragma unroll
          for (int tt = 0; tt < 4; ++tt) kt[tt] = 0.f;
          for (int p = 0; p < 64; ++p) {
              const float cr = CC[(h * 64 + p) * 2], ci = CC[(h * 64 + p) * 2 + 1];
              const float br = BB[((d * 64 + p) * 16 + hp) * 2], bi = BB[((d * 64 + p) * 16 + hp) * 2 + 1];
              const float gr = cr * br - ci * bi, gi = cr * bi + ci * br;
#pragma unroll
              for (int tt = 0; tt < 4; ++tt) { const int tau = tg * 4 + tt; const float pr = POW[((d * 17 + tau) * 64 + p) * 2], pi = POW[((d * 17 + tau) * 64 + p) * 2 + 1]; kt[tt] += gr * pr - gi * pi; } }
#pragma unroll
          for (int tt = 0; tt < 4; ++tt) KT[((d * 16 + tg * 4 + tt) * 4 + hl) * 16 + hp] = kt[tt]; }
        __syncthreads();
        bf16_t* c1 = CW1 + (size_t)g * 65536;
        for (int i = tid; i < 64 * 128; i += NT) {
            const int k = (i & 127) * 2, nl = i >> 7; const int p = 16 * q4 + (nl & 15), ri = (nl >> 4) & 1, d = nl >> 5, n = d * 128 + ri * 64 + p, s = k >> 4, hp = k & 15;
            const int j = d ? s : 15 - s;
            const float pr = POW[((d * 17 + j) * 64 + p) * 2], pi = POW[((d * 17 + j) * 64 + p) * 2 + 1];
            float o[2];
#pragma unroll
            for (int q = 0; q < 2; ++q) { const float br = BB[((d * 64 + p) * 16 + hp + q) * 2], bi = BB[((d * 64 + p) * 16 + hp + q) * 2 + 1]; o[q] = ri ? (pr * bi + pi * br) : (pr * br - pi * bi); }
            *(unsigned*)(c1 + (size_t)n * 256 + k) = pg8::cvt_pk_bf16(o[0], o[1]);
        }
        bf16_t* c2 = CW2 + (size_t)g * 131072;
        for (int i = tid; i < 64 * 256; i += NT) {
            const int k = (i & 255) * 2, nl = i >> 8; const int t = nl >> 2, hl = nl & 3, h = 4 * q4 + hl, n = t * 16 + h;
            float o[2];
            if (k < 256) { const int s = k >> 4, hp = k & 15;
#pragma unroll
                for (int q = 0; q < 2; ++q) { float v = 0.f; if (s <= t) v += KT[((0 * 16 + (t - s)) * 4 + hl) * 16 + hp + q]; if (s >= t) v += KT[((1 * 16 + (s - t)) * 4 + hl) * 16 + hp + q]; o[q] = v; } }
            else { const int kk = k - 256, d = kk >> 7, ri = (kk >> 6) & 1; const int j = d ? 16 - t : t + 1;
#pragma unroll
                for (int q = 0; q < 2; ++q) { const int p = (kk & 63) + q; const float cr = CC[(h * 64 + p) * 2], ci = CC[(h * 64 + p) * 2 + 1];
                    const float pr = POW[((d * 17 + j) * 64 + p) * 2], pi = POW[((d * 17 + j) * 64 + p) * 2 + 1];
                    o[q] = ri ? -(cr * pi + ci * pr) : (cr * pr - ci * pi); } }
            *(unsigned*)(c2 + (size_t)n * 512 + k) = pg8::cvt_pk_bf16(o[0], o[1]);
        }
    }
    __syncthreads();
}
DI int s5_row(int b, int d, int st) { const int cc = (st < 16) ? (d ? 15 - st : st) : (d ? 271 - st : st - 16); return (st < 16) ? b * 16 + cc : 128 + b * 256 + cc; }
DI void s5_lane_consts(const Args& a, int l, int d, int g, int p, float& ar, float& ai) {
    const float stp = expf(a.in[I_SLOG][(l * 2 + d) * 64 + g]);
    const float lre = a.in[I_SLRE][((size_t)(l * 2 + d) * 64 + g) * 64 + p], lim = a.in[I_SLIM][((size_t)(l * 2 + d) * 64 + g) * 64 + p];
    const float mag = expf(16.0f * lre * stp), ang = 16.0f * (lim * stp);
    ar = mag * cosf(ang); ai = mag * sinf(ang);
}
DI void ph_s5_carry1(const Args& a, int l, bf16_t* AX, float* SEG) {
    const int tid = ltid(a), w = tid >> 6, p = tid & 63;
    for (int item = blockIdx.x * 8 + w; item < 17 * 1024; item += gridDim.x * 8) {
        const int unit = item & 1023, seg = item >> 10, d = unit & 1, g = (unit >> 1) & 63, b = unit >> 7;
        float ar, ai; s5_lane_consts(a, l, d, g, p, ar, ai);
        bf16_t* base = AX + (size_t)g * S5_RG * 512 + 256 + d * 128 + p;
        float lr[16], li[16];
#pragma unroll
        for (int q = 0; q < 16; ++q) { const size_t o = (size_t)s5_row(b, d, seg * 16 + q) * 512; lr[q] = bf2f(base[o]); li[q] = bf2f(base[o + 64]); }
        float xr = 0.f, xi = 0.f;
#pragma unroll
        for (int q = 0; q < 16; ++q) { const size_t o = (size_t)s5_row(b, d, seg * 16 + q) * 512;
            base[o] = f2bf(xr); base[o + 64] = f2bf(xi);
            const float nr = ar * xr - ai * xi + lr[q], ni = ar * xi + ai * xr + li[q]; xr = nr; xi = ni; }
        SEG[((size_t)seg * 1024 + unit) * 128 + p] = xr; SEG[((size_t)seg * 1024 + unit) * 128 + 64 + p] = xi;
    }
}
DI void ph_s5_carry2(const Args& a, int l, bf16_t* AX, const float* SEG) {
    const int tid = ltid(a), w = tid >> 6, p = tid & 63;
    for (int item = blockIdx.x * 8 + w; item < 16 * 1024; item += gridDim.x * 8) {
        const int unit = item & 1023, seg = 1 + (item >> 10), d = unit & 1, g = (unit >> 1) & 63, b = unit >> 7;
        float ar, ai; s5_lane_consts(a, l, d, g, p, ar, ai);
        float sr = ar, si = ai;
#pragma unroll
        for (int q = 0; q < 4; ++q) { const float nr = sr * sr - si * si, ni = 2.0f * sr * si; sr = nr; si = ni; }
        float xr = 0.f, xi = 0.f;
        { float er[16], ei[16];
#pragma unroll
          for (int s2 = 0; s2 < 16; ++s2) { const bool on = s2 < seg; er[s2] = on ? SEG[((size_t)s2 * 1024 + unit) * 128 + p] : 0.f; ei[s2] = on ? SEG[((size_t)s2 * 1024 + unit) * 128 + 64 + p] : 0.f; }
#pragma unroll
          for (int s2 = 0; s2 < 16; ++s2) if (s2 < seg) { const float nr = sr * xr - si * xi + er[s2], ni = sr * xi + si * xr + ei[s2]; xr = nr; xi = ni; } }
        bf16_t* base = AX + (size_t)g * S5_RG * 512 + 256 + d * 128 + p;
        float lr[16], li[16];
#pragma unroll
        for (int q = 0; q < 16; ++q) { const size_t o = (size_t)s5_row(b, d, seg * 16 + q) * 512; lr[q] = bf2f(base[o]); li[q] = bf2f(base[o + 64]); }
#pragma unroll
        for (int q = 0; q < 16; ++q) { const size_t o = (size_t)s5_row(b, d, seg * 16 + q) * 512;
            base[o] = f2bf(lr[q] + xr); base[o + 64] = f2bf(li[q] + xi);
            const float nr = ar * xr - ai * xi, ni = ar * xi + ai * xr; xr = nr; xi = ni; }
    }
}

#ifndef SUBDUP
#define SUBDUP 0
#endif
typedef short bf16x8v __attribute__((ext_vector_type(8)));
typedef short s16x4v __attribute__((ext_vector_type(4)));
typedef __bf16 bfx2_t __attribute__((ext_vector_type(2)));
typedef float f32x2_t __attribute__((ext_vector_type(2)));
#define MFMA16(a_, b_, c_) __builtin_amdgcn_mfma_f32_16x16x32_bf16((a_), (b_), (c_), 0, 0, 0)
DI unsigned pk2(float lo, float hi) { const bfx2_t v = __builtin_convertvector((f32x2_t){lo, hi}, bfx2_t); return __builtin_bit_cast(unsigned, v); }
DI int sw512(int r, int cb) { return r * 512 + (cb ^ ((r & 15) << 4)); }
DI int sw128(int r, int cb) { return r * 128 + (cb ^ ((r & 7) << 4)); }
DI bf16x8v ldsfrag(LAS unsigned char* base, int off) { return *(const LAS bf16x8v*)(base + off); }
DI bf16x8v ldsfrag2(LAS unsigned char* base, int off0, int off1) { const s16x4v lo = *(const LAS s16x4v*)(base + off0), hi = *(const LAS s16x4v*)(base + off1); return __builtin_shufflevector(lo, hi, 0, 1, 2, 3, 4, 5, 6, 7); }
constexpr int ML_GSET = 448;
DI void ml_gates(float igr, float fgr, float ibias, float fbias, int d, float& ms, LAS float* gs, int L) {
    asm volatile("" : "+v"(L));
    const int t = d ? 63 - L : L;
    const float ipv = igr + ibias, lfv = -softplusf_(-(fgr + fbias));
    const float bc = dpp_scan_sum(lfv);
    const float aj = ipv - bc;
    const float cm = dpp_scan_max(aj);
    const float mt = fmaxf(bc + ms, bc + cm);
    const float bend = lane63(bc);
    const float le = bend - bc + ipv;
    const float mle = lane63(dpp_scan_max(le));
    const float mnew = fmaxf(bend + ms, mle);
    gs[t] = bc; gs[64 + t] = aj; gs[128 + t] = mt; gs[192 + t] = __expf(bc + ms - mt); gs[256 + t] = __expf(-mt); gs[320 + t] = __expf(le - mnew) * 0.0625f;
    if (L == 0) gs[384] = __expf(bend + ms - mnew);
    ms = mnew;
}
DI bf16x8v ldstr2(LAS unsigned char* p0, LAS unsigned char* p1) {
    const s16x4v lo = __builtin_amdgcn_ds_read_tr16_b64_v4i16((LAS s16x4v*)p0), hi = __builtin_amdgcn_ds_read_tr16_b64_v4i16((LAS s16x4v*)p1);
    return __builtin_shufflevector(lo, hi, 0, 1, 2, 3, 4, 5, 6, 7); }
DI void ph_ml_scan_mfma(const Args& a, int l, const bf16_t* Q, const bf16_t* K, const bf16_t* V, const float* GATE, bf16_t* HF, bf16_t* HB, LAS unsigned char* lds) {
    constexpr int PQ = 528, PK = 544, PV = 160, PW = 144;
    LAS unsigned char* qs = lds;
    LAS unsigned char* kn = lds + 33792;
    LAS unsigned char* vn = lds + 68608;
    LAS unsigned char* vs = lds + 78848;
    LAS unsigned char* Wm = lds + 89088;
    LAS float* sm = (LAS float*)(lds + 98304);
    LAS float* rsW = sm + 2 * ML_GSET; LAS float* qn = rsW + 128; LAS float* nvec = qn + 128;
    const int tid = ltid(a), w = tid >> 6, ln = tid & 63, l16 = ln & 15, h4 = ln >> 4, tq = (ln & 15) >> 2, tp = ln & 3;
    for (int unit = blockIdx.x; unit < 256; unit += gridDim.x) {
        const int eh = unit & 3, d = (unit >> 2) & 1, hd = (unit >> 3) & 3, b = unit >> 5;
        const float ibias = a.in[I_MIB][(l * 2 + d) * 4 + hd], fbias = a.in[I_MFB][(l * 2 + d) * 4 + hd];
        bf16_t* HO = d ? HB : HF;
        f32x4 Cacc[16];
#pragma unroll
        for (int i = 0; i < 16; ++i) Cacc[i] = (f32x4){0.f, 0.f, 0.f, 0.f};
        float ms = 0.f;
        __syncthreads();
        if (tid < 256) nvec[tid] = 0.f;
#define ML_ROW0(step) (((step) < 4) ? b * 256 + (d ? 3 - (step) : (step)) * 64 : CTXROWS + b * 4096 + (d ? 67 - (step) : (step) - 4) * 64)
        u32x4 pq[4], pk[4], pv[1]; float gi = 0.f, gf = 0.f;
        { const int row0 = ML_ROW0(0);
#pragma unroll
          for (int q = 0; q < 4; ++q) { const int p = tid + 512 * q, r = p >> 5, c8 = p & 31; pq[q] = *(const u32x4*)(Q + (size_t)(row0 + r) * 1024 + hd * 256 + c8 * 8); pk[q] = *(const u32x4*)(K + (size_t)(row0 + r) * 1024 + hd * 256 + c8 * 8); }
#pragma unroll
          for (int q = 0; q < 1; ++q) { const int r = tid >> 3, c8 = tid & 7; pv[q] = *(const u32x4*)(V + (size_t)(row0 + r) * 1024 + hd * 256 + eh * 64 + c8 * 8); }
          if (w == 7) { const int t = d ? 63 - ln : ln; const float* gp = GATE + (size_t)(row0 + t) * 32; gi = gp[d * 4 + hd]; gf = gp[8 + d * 4 + hd]; ml_gates(gi, gf, ibias, fbias, d, ms, sm, ln); } }
        __syncthreads();
        for (int step = 0; step < 68; ++step) {
            const int par = step & 1; LAS float* gs = sm + par * ML_GSET;
            const int row0 = ML_ROW0(step);
            for (int sr_ = 0; sr_ < (SUBDUP == 12 ? 2 : 1); ++sr_) {
#pragma unroll
            for (int q = 0; q < 4; ++q) { const int p = tid + 512 * q, r = p >> 5, c8 = p & 31;
                *(LAS u32x4*)(qs + r * PQ + c8 * 16) = pq[q]; *(LAS u32x4*)(kn + r * PK + c8 * 16) = pk[q]; }
#pragma unroll
            for (int q = 0; q < 1; ++q) { const int r = tid >> 3, c8 = tid & 7;
                *(LAS u32x4*)(vn + r * PV + c8 * 16) = pv[q];
                float f[8]; unpack8(pv[q], f); const float ws = gs[320 + r];
                u32x4 o; o.x = pk2(f[0] * ws, f[1] * ws); o.y = pk2(f[2] * ws, f[3] * ws); o.z = pk2(f[4] * ws, f[5] * ws); o.w = pk2(f[6] * ws, f[7] * ws);
                *(LAS u32x4*)(vs + r * PV + c8 * 16) = o; }
            }
            if (step + 1 < 68) { const int rown = ML_ROW0(step + 1);
#pragma unroll
                for (int q = 0; q < 4; ++q) { const int p = tid + 512 * q, r = p >> 5, c8 = p & 31; pq[q] = *(const u32x4*)(Q + (size_t)(rown + r) * 1024 + hd * 256 + c8 * 8); pk[q] = *(const u32x4*)(K + (size_t)(rown + r) * 1024 + hd * 256 + c8 * 8); }
#pragma unroll
                for (int q = 0; q < 1; ++q) { const int r = tid >> 3, c8 = tid & 7; pv[q] = *(const u32x4*)(V + (size_t)(rown + r) * 1024 + hd * 256 + eh * 64 + c8 * 8); }
                if (w == 7) { const int t = d ? 63 - ln : ln; const float* gp = GATE + (size_t)(rown + t) * 32; gi = gp[d * 4 + hd]; gf = gp[8 + d * 4 + hd]; } }
            lds_barrier();
            for (int sr_ = 0; sr_ < (SUBDUP == 11 ? 2 : 1); ++sr_) { const int it = w >> 1, jp = w & 1, i = it * 16 + l16;
              f32x4 a0 = (f32x4){0.f, 0.f, 0.f, 0.f}, a1 = a0;
              LAS unsigned char* qb = qs + (it * 16 + l16) * PQ + h4 * 16; LAS unsigned char* kb = kn + ((2 * jp) * 16 + l16) * PK + h4 * 16;
              f32x4 qacc = (f32x4){0.f, 0.f, 0.f, 0.f};
#pragma unroll
              for (int ks = 0; ks < 8; ++ks) {
                  const bf16x8v bq = ldsfrag(qb, ks * 64);
                  const bf16x8v k0 = ldsfrag(kb, ks * 64), k1 = ldsfrag(kb, 16 * PK + ks * 64);
                  a0 = MFMA16(k0, bq, a0); a1 = MFMA16(k1, bq, a1);
                  if ((ks >> 2) == jp) {
                      const f32x4 n0 = *(const LAS f32x4*)(nvec + 32 * ks + 8 * h4), n1 = *(const LAS f32x4*)(nvec + 32 * ks + 8 * h4 + 4);
                      u32x4 nw; nw.x = pk2(n0[0], n0[1]); nw.y = pk2(n0[2], n0[3]); nw.z = pk2(n1[0], n1[1]); nw.w = pk2(n1[2], n1[3]);
                      qacc = MFMA16(bq, __builtin_bit_cast(bf16x8v, nw), qacc); } }
              if (l16 == 0) *(LAS f32x4*)(qn + jp * 64 + it * 16 + 4 * h4) = qacc;
              const float bci = gs[i], mti = gs[128 + i];
              float rs = 0.f;
#pragma unroll
              for (int t2 = 0; t2 < 2; ++t2) { const int j0 = (2 * jp + t2) * 16 + 4 * h4; const f32x4 ajv = *(const LAS f32x4*)(gs + 64 + j0); const f32x4 av = t2 ? a1 : a0;
                  float wv[4];
#pragma unroll
                  for (int r = 0; r < 4; ++r) { const int j = j0 + r; const bool valid = d ? (j >= i) : (j <= i); const float e = __expf(bci + ajv[r] - mti) * av[r] * 0.0625f; wv[r] = valid ? e : 0.f; rs += wv[r]; }
                  u32x2 pw; pw.x = pk2(wv[0], wv[1]); pw.y = pk2(wv[2], wv[3]);
                  *(LAS u32x2*)(Wm + i * PW + j0 * 2) = pw; }
              int lnl = ln; asm volatile("" : "+v"(lnl)); rs += shx(rs, 16, lnl); rs += shx(rs, 32, lnl);
              if (h4 == 0) rsW[jp * 64 + i] = rs;
            }
            lds_barrier();
            if (w < 4) { f32x4 num[4];
#pragma unroll
              for (int it = 0; it < 4; ++it) num[it] = (f32x4){0.f, 0.f, 0.f, 0.f};
              LAS unsigned char* qb2 = qs + l16 * PQ + 8 * h4;
              { bf16x8v af[4];
#pragma unroll
                for (int it = 0; it < 4; ++it) af[it] = ldsfrag2(qb2, it * 16 * PQ, it * 16 * PQ + 32);
#pragma unroll
                for (int ks = 0; ks < 8; ++ks) {
                    u32x4 bw; bw.x = pk2(Cacc[2 * ks][0], Cacc[2 * ks][1]); bw.y = pk2(Cacc[2 * ks][2], Cacc[2 * ks][3]); bw.z = pk2(Cacc[2 * ks + 1][0], Cacc[2 * ks + 1][1]); bw.w = pk2(Cacc[2 * ks + 1][2], Cacc[2 * ks + 1][3]);
                    const bf16x8v bfr = __builtin_bit_cast(bf16x8v, bw);
                    bf16x8v nf[4];
#pragma unroll
                    for (int it = 0; it < 4; ++it) nf[it] = (ks + 1 < 8) ? ldsfrag2(qb2, it * 16 * PQ + 64 * (ks + 1), it * 16 * PQ + 64 * (ks + 1) + 32) : af[it];
#pragma unroll
                    for (int it = 0; it < 4; ++it) num[it] = MFMA16(af[it], bfr, num[it]);
#pragma unroll
                    for (int it = 0; it < 4; ++it) af[it] = nf[it];
                    asm volatile("" ::: "memory"); } }
#pragma unroll
              for (int it = 0; it < 4; ++it) { const f32x4 wi = *(const LAS f32x4*)(gs + 192 + it * 16 + 4 * h4); num[it] = num[it] * wi; }
              LAS unsigned char* trb = (LAS unsigned char*)0 + (8 * h4 + tq) * PV + 8 * tp + 32 * w;
              bf16x8v bv[2];
#pragma unroll
              for (int kk = 0; kk < 2; ++kk) bv[kk] = ldstr2(vn + (size_t)trb + (32 * kk) * PV, vn + (size_t)trb + (32 * kk + 4) * PV);
              LAS unsigned char* wb = Wm + l16 * PW + 16 * h4;
#pragma unroll
              for (int kk = 0; kk < 2; ++kk)
#pragma unroll
                  for (int it = 0; it < 4; ++it) { const bf16x8v aw = ldsfrag(wb, it * 16 * PW + 64 * kk); num[it] = MFMA16(aw, bv[kk], num[it]); }
              asm volatile("" ::: "memory");
#pragma unroll
              for (int it = 0; it < 4; ++it) { const int i0 = it * 16 + 4 * h4;
                  const f32x4 r0 = *(const LAS f32x4*)(rsW + i0), r1 = *(const LAS f32x4*)(rsW + 64 + i0), wi = *(const LAS f32x4*)(gs + 192 + i0), qv = *(const LAS f32x4*)(qn + i0) + *(const LAS f32x4*)(qn + 64 + i0), nr = *(const LAS f32x4*)(gs + 256 + i0);
#pragma unroll
                  for (int r = 0; r < 4; ++r) { const float den = r0[r] + r1[r] + wi[r] * qv[r]; const float hv = num[it][r] * __builtin_amdgcn_rcpf(fmaxf(fabsf(den), nr[r]));
                      HO[(size_t)(row0 + i0 + r) * 1024 + hd * 256 + eh * 64 + 16 * w + l16] = (bf16_t)(pk2(hv, 0.f) & 0xffffu); } asm volatile("" ::: "memory"); }
              const float decay = gs[384];
              bf16x8v bs[2];
#pragma unroll
              for (int kk = 0; kk < 2; ++kk) bs[kk] = ldstr2(vs + (size_t)trb + (32 * kk) * PV, vs + (size_t)trb + (32 * kk + 4) * PV);
#pragma unroll
              for (int dt = 0; dt < 16; ++dt) Cacc[dt] = Cacc[dt] * decay;
              LAS unsigned char* ktb = kn + (8 * h4 + tq) * PK + 8 * tp;
              { bf16x8v ak0 = ldstr2(ktb, ktb + 4 * PK), ak1 = ldstr2(ktb + 32 * PK, ktb + 36 * PK);
#pragma unroll
                for (int dt = 0; dt < 16; ++dt) {
                    bf16x8v n0 = ak0, n1 = ak1;
                    if (dt + 1 < 16) { n0 = ldstr2(ktb + 32 * (dt + 1), ktb + 4 * PK + 32 * (dt + 1)); n1 = ldstr2(ktb + 32 * PK + 32 * (dt + 1), ktb + 36 * PK + 32 * (dt + 1)); }
                    Cacc[dt] = MFMA16(ak0, bs[0], Cacc[dt]); Cacc[dt] = MFMA16(ak1, bs[1], Cacc[dt]);
                    ak0 = n0; ak1 = n1; asm volatile("" ::: "memory"); } }
            } else { const float decay = gs[384]; const int dn = tid - 256; float s = 0.f;
#pragma unroll 8
                for (int j = 0; j < 64; ++j) s += gs[320 + j] * bf2f(*(const LAS bf16_t*)(kn + j * PK + 2 * dn));
                nvec[dn] = decay * nvec[dn] + s;
                if (w == 7 && step + 1 < 68) ml_gates(gi, gf, ibias, fbias, d, ms, sm + (par ^ 1) * ML_GSET, ln); }
            lds_barrier();
        }
#undef ML_ROW0
    }
}

#ifndef SUBDUP
#define SUBDUP 0
#endif
#define MFMA16K16(a_, b_, c_) __builtin_amdgcn_mfma_f32_16x16x16bf16_1k((a_), (b_), (c_), 0, 0, 0)
DI s16x4v pack4(const f32x4 v) { u32x2 w; w.x = pk2(v[0], v[1]); w.y = pk2(v[2], v[3]); return __builtin_bit_cast(s16x4v, w); }
DI s16x4v lds8(LAS unsigned char* p) { return *(const LAS s16x4v*)p; }
DI s16x4v ldstr1(LAS unsigned char* p) { return __builtin_amdgcn_ds_read_tr16_b64_v4i16((LAS s16x4v*)p); }
constexpr int GD_GSET = 384;
DI void gdn_gates(float araw, float braw, float nea, float dtb, LAS float* gs, int L, int d) {
    asm volatile("" : "+v"(L));
    const int t = d ? 63 - L : L;
    const float gc = dpp_scan_sum(nea * softplusf_(araw + dtb));
    const float gl = lane63(gc);
    gs[t] = gc; gs[64 + t] = sigmoidf_(braw); gs[128 + t] = __expf(gc); gs[192 + t] = __expf(gl - gc);
    if (L == 0) gs[256] = __expf(gl);
}
DI void ph_gdn_scan_mfma(const Args& a, int l, const bf16_t* Q, const bf16_t* K, const bf16_t* V, const float* GATE, bf16_t* OF, bf16_t* OB, LAS unsigned char* lds) {
    constexpr int PQ = 272, PK = 288, PV = 160, PA = 144, PD = 48;
    LAS unsigned char* qh = lds;
    LAS unsigned char* kh = lds + 17408;
    LAS unsigned char* vv = lds + 35840;
    LAS unsigned char* AM = lds + 54272;
    LAS unsigned char* QM = lds + 63488;
    LAS unsigned char* DINV = lds + 72704;
    LAS float* sm = (LAS float*)(lds + 75776);
    LAS float* nAd = (LAS float*)(lds + 78848);
    const int tid = ltid(a), w = tid >> 6, ln = tid & 63, l16 = ln & 15, h4 = ln >> 4, tq = (ln & 15) >> 2, tp = ln & 3;
    for (int unit = blockIdx.x; unit < 256; unit += gridDim.x) {
        const int eh = unit & 1, d = (unit >> 1) & 1, h = (unit >> 2) & 7, b = unit >> 5;
        const float nea = -__expf(a.in[I_GALOG][(l * 2 + d) * 8 + h]), dtb = a.in[I_GDTB][(l * 2 + d) * 8 + h];
        bf16_t* O = d ? OB : OF;
        f32x4 S[8];
#pragma unroll
        for (int i = 0; i < 8; ++i) S[i] = (f32x4){0.f, 0.f, 0.f, 0.f};
#define GD_ROW0(step) (((step) < 4) ? b * 256 + (d ? 3 - (step) : (step)) * 64 : CTXROWS + b * 4096 + (d ? 67 - (step) : (step) - 4) * 64)
        u32x4 pq[2], pk[2], pv[1]; float ga = 0.f, gb = 0.f;
        __syncthreads();
        { const int row0 = GD_ROW0(0);
#pragma unroll
          for (int q = 0; q < 2; ++q) { const int p = tid + 512 * q, r = p >> 4, c8 = p & 15; const size_t go = (size_t)(row0 + r) * 1024 + h * 128 + c8 * 8;
              pq[q] = *(const u32x4*)(Q + go); pk[q] = *(const u32x4*)(K + go); }
          pv[0] = *(const u32x4*)(V + (size_t)(row0 + (tid >> 3)) * 1024 + h * 128 + eh * 64 + (tid & 7) * 8);
          if (w == 5) { const int t = d ? 63 - ln : ln; const float* gp = GATE + (size_t)(row0 + t) * 32; ga = gp[d * 8 + h]; gb = gp[16 + d * 8 + h]; gdn_gates(ga, gb, nea, dtb, sm, ln, d); } }
        __syncthreads();
        for (int step = 0; step < 68; ++step) {
            const int par = step & 1; LAS float* gs = sm + par * GD_GSET;
            const int row0 = GD_ROW0(step);
#pragma unroll
            for (int q = 0; q < 2; ++q) { const int p = tid + 512 * q, r = p >> 4, c8 = p & 15;
                *(LAS u32x4*)(qh + r * PQ + c8 * 16) = pq[q]; *(LAS u32x4*)(kh + r * PK + c8 * 16) = pk[q]; }
            *(LAS u32x4*)(vv + (tid >> 3) * PV + (tid & 7) * 16) = pv[0];
            if (step + 1 < 68) { const int rown = GD_ROW0(step + 1);
#pragma unroll
                for (int q = 0; q < 2; ++q) { const int p = tid + 512 * q, r = p >> 4, c8 = p & 15; const size_t go = (size_t)(rown + r) * 1024 + h * 128 + c8 * 8;
                    pq[q] = *(const u32x4*)(Q + go); pk[q] = *(const u32x4*)(K + go); }
                pv[0] = *(const u32x4*)(V + (size_t)(rown + (tid >> 3)) * 1024 + h * 128 + eh * 64 + (tid & 7) * 8);
                if (w == 5) { const int t = d ? 63 - ln : ln; const float* gp = GATE + (size_t)(rown + t) * 32; ga = gp[d * 8 + h]; gb = gp[16 + d * 8 + h]; } }
            lds_barrier(); if (SUBDUP == 5) lds_barrier();
            for (int sr_ = 0; sr_ < (SUBDUP == 1 ? 2 : 1); ++sr_) { const int it = w >> 1, jp = w & 1, i = it * 16 + l16;
              f32x4 kk0 = (f32x4){0.f, 0.f, 0.f, 0.f}, kk1 = kk0, qk0 = kk0, qk1 = kk0;
              LAS unsigned char* kb = kh + ((2 * jp) * 16 + l16) * PK + h4 * 16; LAS unsigned char* xk = kh + i * PK + h4 * 16; LAS unsigned char* xq = qh + i * PQ + h4 * 16;
#pragma unroll
              for (int ks = 0; ks < 4; ++ks) { const bf16x8v a0 = ldsfrag(kb, ks * 64), a1 = ldsfrag(kb, 16 * PK + ks * 64), bk = ldsfrag(xk, ks * 64), bq = ldsfrag(xq, ks * 64);
                  kk0 = MFMA16(a0, bk, kk0); kk1 = MFMA16(a1, bk, kk1); qk0 = MFMA16(a0, bq, qk0); qk1 = MFMA16(a1, bq, qk1); }
              const float gci = gs[i], bi = gs[64 + i];
#pragma unroll
              for (int t2 = 0; t2 < 2; ++t2) { const int j0 = (2 * jp + t2) * 16 + 4 * h4; const f32x4 gcj = *(const LAS f32x4*)(gs + j0); const f32x4 kkv = t2 ? kk1 : kk0, qkv = t2 ? qk1 : qk0;
                  float am[4], qm[4];
#pragma unroll
                  for (int r = 0; r < 4; ++r) { const int j = j0 + r; const bool valid = d ? (j >= i) : (j <= i); const float e = __expf(gci - gcj[r]);
                      am[r] = (valid && j != i) ? -bi * kkv[r] * e : 0.f; qm[r] = valid ? qkv[r] * e : 0.f; }
                  u32x2 pa, pm; pa.x = pk2(am[0], am[1]); pa.y = pk2(am[2], am[3]); pm.x = pk2(qm[0], qm[1]); pm.y = pk2(qm[2], qm[3]);
                  *(LAS u32x2*)(AM + i * PA + j0 * 2) = pa; *(LAS u32x2*)(QM + i * PA + j0 * 2) = pm;
                  if (2 * jp + t2 == it) { const int ipos = d ? 15 - l16 : l16;
#pragma unroll
                      for (int r = 0; r < 4; ++r) { const int jpos = d ? 15 - (4 * h4 + r) : 4 * h4 + r; nAd[(it * 16 + ipos) * 16 + jpos] = am[r]; } } } }
            lds_barrier(); if (SUBDUP == 5) lds_barrier();
            for (int sr_ = 0; sr_ < (SUBDUP == 2 ? 2 : 1); ++sr_) if (w == 4) { const int I = ln >> 4, c = ln & 15, cp = d ? 15 - c : c;
                float Dr[16];
                Dr[0] = (cp == 0) ? 1.f : 0.f;
#pragma unroll
                for (int ip = 1; ip < 16; ++ip) {
                    float av[16];
#pragma unroll
                    for (int q4 = 0; q4 < 4; ++q4) { if (q4 * 4 < ip) { const f32x4 x = *(const LAS f32x4*)(nAd + (I * 16 + ip) * 16 + q4 * 4); av[q4 * 4] = x[0]; av[q4 * 4 + 1] = x[1]; av[q4 * 4 + 2] = x[2]; av[q4 * 4 + 3] = x[3]; } }
                    float s = (cp == ip) ? 1.f : 0.f;
#pragma unroll
                    for (int jq = 0; jq < ip; ++jq) s += av[jq] * Dr[jq];
                    Dr[ip] = s; }
#pragma unroll
                for (int ip = 0; ip < 16; ++ip) { const int r = d ? 15 - ip : ip; *(LAS bf16_t*)(DINV + (16 * I + r) * PD + 2 * c) = (bf16_t)(pk2(Dr[ip], 0.f) & 0xffffu); } }
            s16x4v sf[8];
            f32x4 Rt[4], Qs[4];
            if (w < 4) {
#pragma unroll
            for (int dt = 0; dt < 8; ++dt) sf[dt] = pack4(S[dt]);
#pragma unroll
            for (int Tp = 0; Tp < 4; ++Tp) { const int ro = 16 * (d ? 3 - Tp : Tp);
                f32x4 ksv = (f32x4){0.f, 0.f, 0.f, 0.f}, qsv = ksv;
                LAS unsigned char* ka = kh + (ro + l16) * PK + 8 * h4; LAS unsigned char* qa = qh + (ro + l16) * PQ + 8 * h4;
#pragma unroll
                for (int dt = 0; dt < 8; ++dt) { ksv = MFMA16K16(lds8(ka + 32 * dt), sf[dt], ksv); qsv = MFMA16K16(lds8(qa + 32 * dt), sf[dt], qsv); }
                const s16x4v v4 = ldstr1(vv + (ro + 4 * h4 + tq) * PV + (16 * w + 4 * tp) * 2);
                const f32x4 be = *(const LAS f32x4*)(gs + 64 + ro + 4 * h4), eg = *(const LAS f32x4*)(gs + 128 + ro + 4 * h4);
#pragma unroll
                for (int r = 0; r < 4; ++r) { Rt[Tp][r] = be[r] * (bf2f((bf16_t)v4[r]) - eg[r] * ksv[r]); Qs[Tp][r] = eg[r] * qsv[r]; }
                asm volatile("" ::: "memory"); } }
            lds_barrier(); if (SUBDUP == 5) lds_barrier();
            if (w < 4) { s16x4v vf[4]; f32x4 vn[4];
#pragma unroll
              for (int Tp = 0; Tp < 4; ++Tp) { const int ro = 16 * (d ? 3 - Tp : Tp);
                  f32x4 X = Rt[Tp];
#pragma unroll
                  for (int Jp = 0; Jp < Tp; ++Jp) { const int co = 16 * (d ? 3 - Jp : Jp); X = MFMA16K16(lds8(AM + (ro + l16) * PA + (co + 4 * h4) * 2), vf[Jp], X); }
                  const s16x4v xf = pack4(X);
                  vn[Tp] = MFMA16K16(lds8(DINV + (ro + l16) * PD + 8 * h4), xf, ((f32x4){0.f, 0.f, 0.f, 0.f}));
                  vf[Tp] = pack4(vn[Tp]); }
#pragma unroll
              for (int Tp = 0; Tp < 4; ++Tp) { const int ro = 16 * (d ? 3 - Tp : Tp);
                  f32x4 o = Qs[Tp];
#pragma unroll
                  for (int Jp = 0; Jp <= Tp; ++Jp) { const int co = 16 * (d ? 3 - Jp : Jp); o = MFMA16K16(lds8(QM + (ro + l16) * PA + (co + 4 * h4) * 2), vf[Jp], o); }
#pragma unroll
                  for (int r = 0; r < 4; ++r) O[(size_t)(row0 + ro + 4 * h4 + r) * 1024 + h * 128 + eh * 64 + 16 * w + l16] = (bf16_t)(pk2(o[r], 0.f) & 0xffffu);
                  asm volatile("" ::: "memory"); }
              const float gend = gs[256];
              s16x4v vsf[4];
#pragma unroll
              for (int Jp = 0; Jp < 4; ++Jp) { const int co = 16 * (d ? 3 - Jp : Jp); const f32x4 ee = *(const LAS f32x4*)(gs + 192 + co + 4 * h4); vsf[Jp] = pack4(vn[Jp] * ee); }
#pragma unroll
              for (int dt = 0; dt < 8; ++dt) { S[dt] = S[dt] * gend;
#pragma unroll
                  for (int Jp = 0; Jp < 4; ++Jp) { const int co = 16 * (d ? 3 - Jp : Jp); S[dt] = MFMA16K16(ldstr1(kh + (co + 4 * h4 + tq) * PK + (16 * dt + 4 * tp) * 2), vsf[Jp], S[dt]); }
                  if (dt & 1) asm volatile("" ::: "memory"); } }
            for (int sr_ = 0; sr_ < (SUBDUP == 3 ? 2 : 1); ++sr_) if (w == 5 && step + 1 < 68) gdn_gates(ga, gb, nea, dtb, sm + (par ^ 1) * GD_GSET, ln, d);
            lds_barrier(); if (SUBDUP == 5) lds_barrier();
        }
#undef GD_ROW0
    }
}

DI void ph_gdn_scan_pipe(const Args& a, int l, const bf16_t* Q, const bf16_t* K, const bf16_t* V, const float* GATE, bf16_t* OF, bf16_t* OB, LAS unsigned char* lds) {
    constexpr int PQ = 272, PK = 288, PV = 160, PA = 144, PD = 48, SETB = 71680;
    constexpr int O_Q = 0, O_K = 17408, O_V = 35840, O_AM = 46080, O_QM = 55296, O_DI = 64512, O_ND = 67584;
    LAS float* sm = (LAS float*)(lds + 2 * SETB);
    const int tid = ltid(a), w = tid >> 6, ln = tid & 63, l16 = ln & 15, h4 = ln >> 4, tq = (ln & 15) >> 2, tp = ln & 3;
    const bool helper = w >= 4; const int ht = tid - 256;
    for (int unit = blockIdx.x; unit < 256; unit += gridDim.x) {
        const int eh = unit & 1, d = (unit >> 1) & 1, h = (unit >> 2) & 7, b = unit >> 5;
        const float nea = -__expf(a.in[I_GALOG][(l * 2 + d) * 8 + h]), dtb = a.in[I_GDTB][(l * 2 + d) * 8 + h];
        bf16_t* O = d ? OB : OF;
        f32x4 S[8];
#pragma unroll
        for (int i = 0; i < 8; ++i) S[i] = (f32x4){0.f, 0.f, 0.f, 0.f};
#define GD_ROW0(step) (((step) < 4) ? b * 256 + (d ? 3 - (step) : (step)) * 64 : CTXROWS + b * 4096 + (d ? 67 - (step) : (step) - 4) * 64)
        f32x4 Rt[4], Qs[4]; float ga = 0.f, gb = 0.f;
#define GD_FETCH(stp) do { const int rw_ = GD_ROW0(stp); \
        _Pragma("unroll") for (int q_ = 0; q_ < 4; ++q_) { const int p_ = ht + 256 * q_, r_ = p_ >> 4, c8_ = p_ & 15; const size_t go_ = (size_t)(rw_ + r_) * 1024 + h * 128 + c8_ * 8; S[q_] = __builtin_bit_cast(f32x4, *(const u32x4*)(Q + go_)); S[4 + q_] = __builtin_bit_cast(f32x4, *(const u32x4*)(K + go_)); } \
        _Pragma("unroll") for (int q_ = 0; q_ < 2; ++q_) { const int p_ = ht + 256 * q_, r_ = p_ >> 3, c8_ = p_ & 7; Qs[q_] = __builtin_bit_cast(f32x4, *(const u32x4*)(V + (size_t)(rw_ + r_) * 1024 + h * 128 + eh * 64 + c8_ * 8)); } \
        if (w == 5) { const int t_ = d ? 63 - ln : ln; const float* gp_ = GATE + (size_t)(rw_ + t_) * 32; ga = gp_[d * 8 + h]; gb = gp_[16 + d * 8 + h]; } } while (0)
#define GD_STAGE(setb) do { \
        _Pragma("unroll") for (int q_ = 0; q_ < 4; ++q_) { const int p_ = ht + 256 * q_, r_ = p_ >> 4, c8_ = p_ & 15; *(LAS f32x4*)((setb) + O_Q + r_ * PQ + c8_ * 16) = S[q_]; *(LAS f32x4*)((setb) + O_K + r_ * PK + c8_ * 16) = S[4 + q_]; } \
        _Pragma("unroll") for (int q_ = 0; q_ < 2; ++q_) { const int p_ = ht + 256 * q_, r_ = p_ >> 3, c8_ = p_ & 7; *(LAS f32x4*)((setb) + O_V + r_ * PV + c8_ * 16) = Qs[q_]; } } while (0)
#define GD_STAGE_A(setb, gsp) do { LAS unsigned char* kh_ = (setb) + O_K; LAS unsigned char* qh_ = (setb) + O_Q; \
        for (int pi_ = w - 4; pi_ < 10; pi_ += 4) {                   \
            const int Tp_ = pi_ < 1 ? 0 : (pi_ < 3 ? 1 : (pi_ < 6 ? 2 : 3)), Jp_ = pi_ - (Tp_ * (Tp_ + 1)) / 2; \
            const int it_ = d ? 3 - Tp_ : Tp_, jt_ = d ? 3 - Jp_ : Jp_, i_ = it_ * 16 + l16; \
            LAS unsigned char* xk_ = kh_ + i_ * PK + h4 * 16; LAS unsigned char* xq_ = qh_ + i_ * PQ + h4 * 16; \
            const float gci_ = (gsp)[i_], bi_ = (gsp)[64 + i_]; \
            LAS unsigned char* kb_ = kh_ + (jt_ * 16 + l16) * PK + h4 * 16; f32x4 kk_ = (f32x4){0.f, 0.f, 0.f, 0.f}, qk_ = kk_; \
            _Pragma("unroll") for (int ks_ = 0; ks_ < 4; ++ks_) { const bf16x8v a0_ = ldsfrag(kb_, ks_ * 64); kk_ = MFMA16(a0_, ldsfrag(xk_, ks_ * 64), kk_); qk_ = MFMA16(a0_, ldsfrag(xq_, ks_ * 64), qk_); } \
            const int j0_ = jt_ * 16 + 4 * h4; const f32x4 gcj_ = *(const LAS f32x4*)((gsp) + j0_); float am_[4], qm_[4]; \
            _Pragma("unroll") for (int r_ = 0; r_ < 4; ++r_) { const int j_ = j0_ + r_; const bool valid_ = d ? (j_ >= i_) : (j_ <= i_); const float e_ = __expf(gci_ - gcj_[r_]); \
                am_[r_] = (valid_ && j_ != i_) ? -bi_ * kk_[r_] * e_ : 0.f; qm_[r_] = valid_ ? qk_[r_] * e_ : 0.f; } \
            u32x2 pa_, pm_; pa_.x = pk2(am_[0], am_[1]); pa_.y = pk2(am_[2], am_[3]); pm_.x = pk2(qm_[0], qm_[1]); pm_.y = pk2(qm_[2], qm_[3]); \
            *(LAS u32x2*)((setb) + O_AM + i_ * PA + j0_ * 2) = pa_; *(LAS u32x2*)((setb) + O_QM + i_ * PA + j0_ * 2) = pm_; \
            if (jt_ == it_) { LAS float* nd_ = (LAS float*)((setb) + O_ND); const int ipos_ = d ? 15 - l16 : l16; \
                _Pragma("unroll") for (int r_ = 0; r_ < 4; ++r_) { const int jpos_ = d ? 15 - (4 * h4 + r_) : 4 * h4 + r_; nd_[(it_ * 16 + ipos_) * 16 + jpos_] = am_[r_]; } } } } while (0)
        __syncthreads();
        if (helper) { GD_FETCH(0); if (w == 5) gdn_gates(ga, gb, nea, dtb, sm, ln, d); GD_STAGE(lds); GD_FETCH(1); }
        __syncthreads();
        if (helper) GD_STAGE_A(lds, sm);
        __syncthreads();
        for (int step = 0; step < 68; ++step) {
            const int X = step & 1; LAS unsigned char* cur = lds + X * SETB; LAS unsigned char* nxt = lds + (X ^ 1) * SETB;
            LAS float* gs = sm + X * GD_GSET; LAS float* gsn = sm + (X ^ 1) * GD_GSET;
            LAS unsigned char* qh = cur + O_Q; LAS unsigned char* kh = cur + O_K; LAS unsigned char* vv = cur + O_V; LAS unsigned char* AM = cur + O_AM; LAS unsigned char* QM = cur + O_QM; LAS unsigned char* DINV = cur + O_DI;
            const int row0 = GD_ROW0(step);
            s16x4v sf[8];
            if (!helper) {
#pragma unroll
                for (int dt = 0; dt < 8; ++dt) sf[dt] = pack4(S[dt]);
#pragma unroll
                for (int Tp = 0; Tp < 4; ++Tp) { const int ro = 16 * (d ? 3 - Tp : Tp);
                    f32x4 ksv = (f32x4){0.f, 0.f, 0.f, 0.f}, qsv = ksv;
                    LAS unsigned char* ka = kh + (ro + l16) * PK + 8 * h4; LAS unsigned char* qa = qh + (ro + l16) * PQ + 8 * h4;
#pragma unroll
                    for (int dt = 0; dt < 8; ++dt) { ksv = MFMA16K16(lds8(ka + 32 * dt), sf[dt], ksv); qsv = MFMA16K16(lds8(qa + 32 * dt), sf[dt], qsv); }
                    const s16x4v v4 = ldstr1(vv + (ro + 4 * h4 + tq) * PV + (16 * w + 4 * tp) * 2);
                    const f32x4 be = *(const LAS f32x4*)(gs + 64 + ro + 4 * h4), eg = *(const LAS f32x4*)(gs + 128 + ro + 4 * h4);
#pragma unroll
                    for (int r = 0; r < 4; ++r) { Rt[Tp][r] = be[r] * (bf2f((bf16_t)v4[r]) - eg[r] * ksv[r]); Qs[Tp][r] = eg[r] * qsv[r]; }
                    asm volatile("" ::: "memory"); }
            } else {
                if (step + 1 < 68) { GD_STAGE(nxt); if (w == 5) gdn_gates(ga, gb, nea, dtb, gsn, ln, d); if (step + 2 < 68) GD_FETCH(step + 2); }
                if (w == 4) { const int I = ln >> 4, c = ln & 15, cp = d ? 15 - c : c; LAS float* nAd = (LAS float*)(cur + O_ND);
                    float Dr[16];
                    Dr[0] = (cp == 0) ? 1.f : 0.f;
#pragma unroll
                    for (int ip = 1; ip < 16; ++ip) {
                        float av[16];
#pragma unroll
                        for (int q4 = 0; q4 < 4; ++q4) { if (q4 * 4 < ip) { const f32x4 x = *(const LAS f32x4*)(nAd + (I * 16 + ip) * 16 + q4 * 4); av[q4 * 4] = x[0]; av[q4 * 4 + 1] = x[1]; av[q4 * 4 + 2] = x[2]; av[q4 * 4 + 3] = x[3]; } }
                        float s = (cp == ip) ? 1.f : 0.f;
#pragma unroll
                        for (int jq = 0; jq < ip; ++jq) s += av[jq] * Dr[jq];
                        Dr[ip] = s; }
#pragma unroll
                    for (int ip = 0; ip < 16; ++ip) { const int r = d ? 15 - ip : ip; *(LAS bf16_t*)(DINV + (16 * I + r) * PD + 2 * c) = (bf16_t)(pk2(Dr[ip], 0.f) & 0xffffu); } }
            }
            lds_barrier();
            if (!helper) { s16x4v vf[4]; f32x4 vn[4];
#pragma unroll
                for (int Tp = 0; Tp < 4; ++Tp) { const int ro = 16 * (d ? 3 - Tp : Tp);
                    f32x4 Xv = Rt[Tp];
#pragma unroll
                    for (int Jp = 0; Jp < Tp; ++Jp) { const int co = 16 * (d ? 3 - Jp : Jp); Xv = MFMA16K16(lds8(AM + (ro + l16) * PA + (co + 4 * h4) * 2), vf[Jp], Xv); }
                    const s16x4v xf = pack4(Xv);
                    vn[Tp] = MFMA16K16(lds8(DINV + (ro + l16) * PD + 8 * h4), xf, ((f32x4){0.f, 0.f, 0.f, 0.f}));
                    vf[Tp] = pack4(vn[Tp]); }
#pragma unroll
                for (int Tp = 0; Tp < 4; ++Tp) { const int ro = 16 * (d ? 3 - Tp : Tp);
                    f32x4 o = Qs[Tp];
#pragma unroll
                    for (int Jp = 0; Jp <= Tp; ++Jp) { const int co = 16 * (d ? 3 - Jp : Jp); o = MFMA16K16(lds8(QM + (ro + l16) * PA + (co + 4 * h4) * 2), vf[Jp], o); }
#pragma unroll
                    for (int r = 0; r < 4; ++r) O[(size_t)(row0 + ro + 4 * h4 + r) * 1024 + h * 128 + eh * 64 + 16 * w + l16] = (bf16_t)(pk2(o[r], 0.f) & 0xffffu);
                    asm volatile("" ::: "memory"); }
                const float gend = gs[256];
                s16x4v vsf[4];
#pragma unroll
                for (int Jp = 0; Jp < 4; ++Jp) { const int co = 16 * (d ? 3 - Jp : Jp); const f32x4 ee = *(const LAS f32x4*)(gs + 192 + co + 4 * h4); vsf[Jp] = pack4(vn[Jp] * ee); }
#pragma unroll
                for (int dt = 0; dt < 8; ++dt) { S[dt] = S[dt] * gend;
#pragma unroll
                    for (int Jp = 0; Jp < 4; ++Jp) { const int co = 16 * (d ? 3 - Jp : Jp); S[dt] = MFMA16K16(ldstr1(kh + (co + 4 * h4 + tq) * PK + (16 * dt + 4 * tp) * 2), vsf[Jp], S[dt]); }
                    if (dt & 1) asm volatile("" ::: "memory"); }
            } else if (step + 1 < 68) GD_STAGE_A(nxt, gsn);
            lds_barrier();
        }
#undef GD_ROW0
#undef GD_FETCH
#undef GD_STAGE
#undef GD_STAGE_A
    }
}

#ifndef DUP_PHASE
#define DUP_PHASE -1
#endif
constexpr int NPH_LAYER = 21, PH_FINAL = 2 + DEPTH * NPH_LAYER, NPHASE = PH_FINAL + 1;
template <class Epi>
DI void run_gemm(int tid, LAS unsigned char* lds, const bf16_t* A, const bf16_t* Bt, int M, int N, const Epi& E) {
    pg8::Gemm g{A, Bt, M, N, 1024, 1024, 1 << 20, 0, tid}; pg8::StaticOrder S; S.init(M, N, (int)gridDim.x, (int)blockIdx.x);
#if defined(GEMM_STAGGER)
    if (blockIdx.x & 8) { const unsigned long long t0 = __builtin_amdgcn_s_memrealtime(); while (__builtin_amdgcn_s_memrealtime() - t0 < GEMM_STAGGER) __builtin_amdgcn_s_sleep(8); }
#endif
    pg8::gemm_phase<Epi, pg8::StaticOrder, false>(lds, g, S, E, nullptr);
}
template <class Epi>
DI void run_gemm_g(int tid, LAS unsigned char* lds, const bf16_t* A, int lda, int K, const bf16_t* Bt, int M, int N, int pmg, size_t gstride, const Epi& E) {
    pg8::Gemm g{A, Bt, M, N, K, lda, pmg, gstride, tid}; pg8::StaticOrder S; S.init(M, N, (int)gridDim.x, (int)blockIdx.x);
    pg8::gemm_phase<Epi, pg8::StaticOrder, false>(lds, g, S, E, nullptr);
}
__global__ void __launch_bounds__(NT, 2) hy_fwd(Args ka) {
    extern __shared__ __attribute__((aligned(16))) unsigned char lds_raw[];
    LAS unsigned char* lds = (LAS unsigned char*)lds_raw;
    volatile LAS unsigned* xbw = (volatile LAS unsigned*)(lds + LDS_BYTES - 256);
    if (threadIdx.x < 4) xbw[threadIdx.x] = 0u;
    __syncthreads();
    const int lo = ka.ph_lo, hi = ka.ph_hi;
    const int s_wid = __builtin_amdgcn_readfirstlane((int)(threadIdx.x >> 6));
    XcdBarrier bar; bar.bar = (unsigned*)(ka.ws + WS_CTL); bar.x = 0u; bar.st = xbw; bar.wid = s_wid;
    if (hi - lo > 1) bar = xcd_barrier_post((unsigned*)(ka.ws + WS_CTL), xbw, s_wid);
#ifdef PH_ONLY
#define PHEN(p) ((p) == PH_ONLY)
#else
#define PHEN(p) 1
#endif
#define IN(k) (lo <= (k) && (k) < hi)
#define INL(p) (PHEN(p) && IN(pb + (p)))
#define REPS(p) ((DUP_PHASE == (p)) ? 2 : 1)
#define SEAM(k) do { if (IN((k) + 1)) { xcd_barrier(bar); if (DUP_PHASE == 200) xcd_barrier(bar); } } while (0)
#define PH_LOAD \
    Args a; __builtin_memcpy(&a, args_ptr(), sizeof(Args)); a.wid = s_wid; \
    unsigned char* ws = a.ws; \
    float* MOD = (float*)(ws + WS_MOD); float* XCTX = (float*)(ws + WS_XCTX); \
    bf16_t* H = (bf16_t*)(ws + WS_H); bf16_t* MERGED = (bf16_t*)(ws + WS_MERGED); \
    bf16_t* WB0 = (bf16_t*)(ws + WS_WB0); bf16_t* WB1 = (bf16_t*)(ws + WS_WB1); \
    unsigned char* R = ws + WS_R; \
    bf16_t* P0 = (bf16_t*)(R + R_P0); bf16_t* P1 = (bf16_t*)(R + R_P1); bf16_t* P2 = (bf16_t*)(R + R_P2); bf16_t* OF = (bf16_t*)(R + R_OF); bf16_t* OB = (bf16_t*)(R + R_OB); \
    float* GATE2 = (float*)(R + R_G2); \
    float* GATE1 = (float*)(ws + WS_MERGED); bf16_t* HALO = (bf16_t*)(ws + WS_MERGED + SZ_GATE);     \
    float* MODP = (float*)R; \
    bf16_t* AX = (bf16_t*)(R + R5_AX); bf16_t* SZ5 = (bf16_t*)(R + R5_SZ); bf16_t* G15 = (bf16_t*)(R + R5_G1); bf16_t* GLUA = (bf16_t*)(R + R5_GLUA); bf16_t* YBR = (bf16_t*)R; \
    bf16_t* CW1 = (bf16_t*)(ws + WS_H); bf16_t* CW2 = (bf16_t*)(ws + WS_H + SZ_CW1); float* SEG5 = (float*)(ws + WS_H + SZ_CW1 + SZ_CW2); \
    const float* xlat_src = l == 0 ? a.in[I_X] : a.out; const float* xctx_src = l == 0 ? a.in[I_CTX] : XCTX; const float* modl = MOD + (size_t)l * 9 * 3072; \
    (void)MOD; (void)XCTX; (void)H; (void)MERGED; (void)WB0; (void)WB1; (void)P0; (void)P1; (void)P2; (void)OF; (void)OB; (void)GATE2; (void)GATE1; (void)HALO; (void)MODP; (void)AX; (void)SZ5; (void)G15; (void)GLUA; (void)YBR; (void)CW1; (void)CW2; (void)SEG5; (void)xlat_src; (void)xctx_src; (void)modl;
    LAS float* ldsf = (LAS float*)lds;

    { const int l = 0;
    if (PHEN(100) && IN(0)) { PH_LOAD; ph_modp(a, MODP, ldsf); SEAM(0); }
    if (PHEN(101) && IN(1)) { PH_LOAD; ph_mod(a, MODP, MOD); SEAM(1); } }
    for (int l = 0; l < DEPTH; ++l) {
        const int pb = 2 + l * NPH_LAYER;
        const int lro = (l == DEPTH - 1) ? CTXROWS : 0;
        if (INL(0)) { PH_LOAD; for (int rep_ = 0; rep_ < REPS(0); ++rep_) { ph_norm(a, l, xlat_src, xctx_src, modl, H); ph_cvt(wdesc(a, l, 0), WB0, ldsf); } SEAM(pb + 0); }
        if (INL(1)) { PH_LOAD; for (int rep_ = 0; rep_ < REPS(1); ++rep_) { EpiProj E{P0, 0, GATE1, 12, HALO, 0}; run_gemm(ltid(a), lds, H, WB0, MROWS, 3328, E); } SEAM(pb + 1); }
        if (INL(2)) { PH_LOAD; for (int rep_ = 0; rep_ < REPS(2); ++rep_) { if (DUP_PHASE == 102) ph_gdn_conv(a, l, P0, HALO, lds, OF); ph_gdn_conv(a, l, P0, HALO, lds); ph_cvt(wdesc(a, l, 1), WB1, ldsf); } SEAM(pb + 2); }
        if (INL(3)) { PH_LOAD; for (int rep_ = 0; rep_ < REPS(3); ++rep_) { ph_gdn_scan_pipe(a, l, P0, P1, P2, GATE1, OF, OB, lds); } SEAM(pb + 3); }
        if (INL(4)) { PH_LOAD; for (int rep_ = 0; rep_ < REPS(4); ++rep_) { EpiProj E{P0, 9, nullptr, -1, nullptr, lro}; run_gemm(ltid(a), lds, H + (size_t)lro * 1024, WB1, MROWS - lro, 2048, E); } SEAM(pb + 4); }
        if (INL(5)) { PH_LOAD; for (int rep_ = 0; rep_ < REPS(5); ++rep_) { if (DUP_PHASE == 105) ph_gdn_post(a, l, OF, OB, P0, P2); ph_gdn_post(a, l, OF, OB, P0); ph_cvt(wdesc(a, l, 6), WB0, ldsf); } SEAM(pb + 5); }
        if (INL(6)) { PH_LOAD; for (int rep_ = 0; rep_ < REPS(6); ++rep_) { ph_cvt(wdesc(a, l, 2), WB1, ldsf); EpiBranch E{P1, MERGED, 1, lro}; run_gemm(ltid(a), lds, OF + (size_t)lro * 1024, WB0, MROWS - lro, 1024, E); } SEAM(pb + 6); }
        if (INL(7)) { PH_LOAD; for (int rep_ = 0; rep_ < REPS(7); ++rep_) { ph_cvt(wdesc(a, l, 3), WB0, ldsf); EpiProj E{P0, 0, GATE2, 12, nullptr, 0}; run_gemm(ltid(a), lds, H, WB1, MROWS, 3328, E); } SEAM(pb + 7); }
        if (INL(8)) { PH_LOAD; for (int rep_ = 0; rep_ < REPS(8); ++rep_) { ph_ml_scan_mfma(a, l, P0, P1, P2, GATE2, OF, OB, lds); } SEAM(pb + 8); }
        if (INL(9)) { PH_LOAD; for (int rep_ = 0; rep_ < REPS(9); ++rep_) { ph_cvt(wdesc(a, l, 8), WB1, ldsf); EpiProj E{P0, 38, nullptr, -1, nullptr, lro}; run_gemm(ltid(a), lds, H + (size_t)lro * 1024, WB0, MROWS - lro, 3072, E); } SEAM(pb + 9); }
        if (INL(10)) { PH_LOAD; for (int rep_ = 0; rep_ < REPS(10); ++rep_) { ph_ml_post(a, l, OF, OB, P0, P1); } SEAM(pb + 10); }
        if (INL(11)) { PH_LOAD; for (int rep_ = 0; rep_ < REPS(11); ++rep_) { ph_cvt(wdesc(a, l, 4), WB0, ldsf); EpiBranch E{P2, MERGED, 0, lro}; run_gemm(ltid(a), lds, OF + (size_t)lro * 1024, WB1, MROWS - lro, 1024, E); } SEAM(pb + 11); }
        if (INL(12)) { PH_LOAD; for (int rep_ = 0; rep_ < REPS(12); ++rep_) { ph_cvt(wdesc(a, l, 5), WB1, ldsf); EpiS1 E{AX, SZ5, G15}; run_gemm(ltid(a), lds, H, WB0, MROWS, 3072, E); } SEAM(pb + 12); }
        if (INL(13)) { PH_LOAD; for (int rep_ = 0; rep_ < REPS(13); ++rep_) { ph_s5_consts(a, l, CW1, CW2, lds); ph_cvt(wdesc(a, l, 7), WB0, ldsf); } SEAM(pb + 13); }
        if (INL(14)) { PH_LOAD; for (int rep_ = 0; rep_ < REPS(14); ++rep_) { EpiS5L E{AX}; run_gemm_g(ltid(a), lds, AX, 512, 256, CW1, 64 * S5_RG, 256, S5_PMG, (size_t)256 * 256 * 2, E); } SEAM(pb + 14); }
        if (INL(15)) { PH_LOAD; for (int rep_ = 0; rep_ < REPS(15); ++rep_) { ph_s5_carry1(a, l, AX, SEG5); } SEAM(pb + 15); }
        if (INL(16)) { PH_LOAD; ph_s5_carry2(a, l, AX, SEG5); SEAM(pb + 16); }
        if (INL(17)) { PH_LOAD; for (int rep_ = 0; rep_ < REPS(17); ++rep_) { EpiS5Y E{AX, GLUA, a.in[I_SD] + l * 1024}; run_gemm_g(ltid(a), lds, AX, 512, 512, CW2, 64 * S5_RG, 256, S5_PMG, (size_t)256 * 512 * 2, E); } SEAM(pb + 17); }
        if (INL(18)) { PH_LOAD; for (int rep_ = 0; rep_ < REPS(18); ++rep_) { EpiGlu E{SZ5, YBR, a.in[I_SBGLU] + l * 2048, lro}; run_gemm(ltid(a), lds, GLUA + (size_t)lro * 1024, WB1, MROWS - lro, 2048, E); } SEAM(pb + 18); }
        if (INL(19)) { PH_LOAD; for (int rep_ = 0; rep_ < REPS(19); ++rep_) { ph_cvt(wdesc(a, l, 9), WB1, ldsf); EpiBranch E{G15, MERGED, 0, lro}; run_gemm(ltid(a), lds, YBR + (size_t)lro * 1024, WB0, MROWS - lro, 1024, E); } SEAM(pb + 19); }
        if (INL(20)) { PH_LOAD; for (int rep_ = 0; rep_ < REPS(20); ++rep_) {
            const int ro = (l == DEPTH - 1) ? CTXROWS : 0;
            EpiOut E{xlat_src, a.out, xctx_src, XCTX, modl, l, ro};
            run_gemm(ltid(a), lds, MERGED + (size_t)ro * 1024, WB1, MROWS - ro, 1024, E);
            } SEAM(pb + 20);
        }
    }
    if (PHEN(102) && IN(PH_FINAL)) { const int l = 0; PH_LOAD; ph_final(a, a.out); }
#undef IN
#undef SEAM
#undef PH_LOAD
}
}

#ifndef MK_LAUNCHES
#define MK_LAUNCHES 1
#endif
extern "C" void kernel_launch(void* const* d_in, const int* in_sizes, int n_in, void* d_out, int out_size, void* d_ws, size_t ws_size, hipStream_t stream) {
    static int grid = 0;
    if (grid == 0) {
        if (n_in != 28 || out_size != hy::NBATCH * hy::SEQ * hy::D || ws_size < hy::WS_END) { fprintf(stderr, "kernel_launch: unexpected shapes (n_in %d, out %d, ws %zu < %zu)\n", n_in, out_size, ws_size, (size_t)hy::WS_END); grid = -1; return; }
        int dev = 0, cus = 0, per_cu = 0;
        if (hipGetDevice(&dev) != hipSuccess || hipDeviceGetAttribute(&cus, hipDeviceAttributeMultiprocessorCount, dev) != hipSuccess) { grid = -1; return; }
        if (hipFuncSetAttribute((const void*)hy::hy_fwd, hipFuncAttributeMaxDynamicSharedMemorySize, hy::LDS_BYTES) != hipSuccess) { fprintf(stderr, "kernel_launch: hipFuncSetAttribute failed\n"); grid = -1; return; }
        if (hipOccupancyMaxActiveBlocksPerMultiprocessor(&per_cu, (const void*)hy::hy_fwd, hy::NT, hy::LDS_BYTES) != hipSuccess || per_cu < 1) { fprintf(stderr, "kernel_launch: occupancy query says %d\n", per_cu); (void)hipGetLastError(); }
        grid = cus;
    }
    if (grid < 0) return;
    (void)hipMemsetAsync((char*)d_ws + hy::WS_CTL, 0, 65536, stream);
    hy::Args a{};
    for (int i = 0; i < 28; ++i) a.in[i] = (const float*)d_in[i];
    a.out = (float*)d_out; a.ws = (unsigned char*)d_ws;
#if MK_LAUNCHES == 1
    a.ph_lo = 0; a.ph_hi = hy::NPHASE;
    hipLaunchKernelGGL(hy::hy_fwd, dim3(grid), dim3(hy::NT), hy::LDS_BYTES, stream, a);
#else
    for (int p = 0; p < hy::NPHASE; ++p) { a.ph_lo = p; a.ph_hi = p + 1; hipLaunchKernelGGL(hy::hy_fwd, dim3(grid), dim3(hy::NT), hy::LDS_BYTES, stream, a); }
#endif
}
```

```cpp
#include <hip/hip_runtime.h>
#include <cstdio>
#include <cstdint>
#define MK_LAUNCHES 1


#define XB_TMO      128
#define XB_XCNT(j)  (256  + 64 * (j))
#define XB_XSUB(j)  (1280 + 64 * (j))
#define XB_XGEN(j)  (2304 + 64 * (j))
#define XB_TOP      3328
#define XB_TOPGEN   3392
#define XCD_BAR_WORDS 3456
#define XB_SPIN_CAP (1u << 18)
#define LAS __attribute__((address_space(3)))

__device__ __forceinline__ unsigned xb_ld(unsigned* p)              { return __hip_atomic_load(p, __ATOMIC_RELAXED, __HIP_MEMORY_SCOPE_AGENT); }
__device__ __forceinline__ unsigned xb_add(unsigned* p, unsigned v) { return __hip_atomic_fetch_add(p, v, __ATOMIC_RELAXED, __HIP_MEMORY_SCOPE_AGENT); }
__device__ __forceinline__ unsigned xb_xcc_id() { return (unsigned)__builtin_amdgcn_s_getreg((3 << 11) | 20) & 0xFu; }
#define XB_SPIN(cond, bar) do { unsigned _sp = 0; while (cond) { __builtin_amdgcn_s_sleep(1); \
    if ((++_sp & 255u) == 0u) { if (xb_ld(&(bar)[XB_TMO])) break; if (_sp > XB_SPIN_CAP) { atomicAdd(&(bar)[XB_TMO], 1u); break; } } } } while (0)

struct XcdBarrier {
    unsigned* bar; unsigned x;
    int wid;
    volatile LAS unsigned* st;
};

__device__ __forceinline__ bool xb_lead(int wid) { int l; asm volatile("v_mbcnt_lo_u32_b32 %0, -1, 0\n\tv_mbcnt_hi_u32_b32 %0, -1, %0" : "=v"(l)); return wid == 0 && l == 0; }
__device__ __forceinline__ XcdBarrier xcd_barrier_post(unsigned* bar, volatile LAS unsigned* st, int wid) {
    XcdBarrier b; b.bar = bar; b.x = xb_xcc_id(); b.st = st; b.wid = wid;
    if (xb_lead(wid)) (void)xb_add(&bar[XB_XCNT(b.x)], 1u);
    return b;
}
__device__ __forceinline__ void xcd_barrier_complete(unsigned* bar, unsigned x, unsigned& nloc, unsigned& nx) {
    const unsigned G = gridDim.x * gridDim.y * gridDim.z;
    unsigned sum, cnt, mine, sp = 0u;
    for (;;) {
        sum = 0u; cnt = 0u; mine = 0u;
#pragma unroll
        for (unsigned j = 0; j < 16; ++j) { const unsigned c = xb_ld(&bar[XB_XCNT(j)]); sum += c; cnt += (c > 0u) ? 1u : 0u; mine = (j == x) ? c : mine; }
        if (sum == G) break;
        __builtin_amdgcn_s_sleep(1);
        if ((++sp & 255u) == 0u) { if (xb_ld(&bar[XB_TMO])) break; if (sp > XB_SPIN_CAP) { atomicAdd(&bar[XB_TMO], 1u); break; } }
    }
    nloc = mine > 0u ? mine : 1u; nx = cnt > 0u ? cnt : 1u;
}

__device__ __forceinline__ void xcd_barrier(const XcdBarrier& b) {
    asm volatile("s_waitcnt vmcnt(0)" ::: "memory");
    __syncthreads();
    if (xb_lead(b.wid)) {
        unsigned* bar = b.bar;
        __builtin_amdgcn_s_waitcnt(0);
        unsigned nloc = b.st[0], nx = b.st[1];
        if (nloc == 0u) { xcd_barrier_complete(bar, b.x, nloc, nx); b.st[0] = nloc; b.st[1] = nx; }
        const unsigned old = xb_add(&bar[XB_XSUB(b.x)], 1u);
        const unsigned gen = old / nloc;
        if (old + 1u == (gen + 1u) * nloc) {
            __builtin_amdgcn_fence(__ATOMIC_RELEASE, "agent");
            asm volatile("s_waitcnt vmcnt(0)" ::: "memory");
            const unsigned og = xb_add(&bar[XB_TOP], 1u);
            const unsigned tg = og / nx;
            if (og + 1u == (tg + 1u) * nx) xb_add(&bar[XB_TOPGEN], 1u);
            else XB_SPIN(xb_ld(&bar[XB_TOPGEN]) == tg, bar);
            __builtin_amdgcn_fence(__ATOMIC_ACQUIRE, "agent");
            xb_add(&bar[XB_XGEN(b.x)], 1u);
            asm volatile("s_waitcnt vmcnt(0)" ::: "memory");
        } else {
            XB_SPIN(xb_ld(&bar[XB_XGEN(b.x)]) == gen, bar);
            __builtin_amdgcn_fence(__ATOMIC_ACQUIRE, "agent");
            asm volatile("s_waitcnt vmcnt(0)" ::: "memory");
        }
    }
    __syncthreads();
}


namespace pg8 {
#define PG8_LAS __attribute__((address_space(3)))
typedef unsigned short bf16_t;
typedef short bf16x8 __attribute__((ext_vector_type(8)));
typedef float f32x4 __attribute__((ext_vector_type(4)));
typedef unsigned u32x4 __attribute__((ext_vector_type(4)));
constexpr int BM = 256, BK = 64, HALF = 128, HTB = HALF * BK * 2  , STAGE_BYTES = 8 * HTB, NXCD = 8, WGM = 8;

__host__ __device__ __forceinline__ int lds_byte(int r, int c) { const int st = (r >> 4) * 2 + (c >> 5), rr = r & 15, cc = c & 31, ob = rr * 64 + cc * 2; return st * 1024 + (ob ^ (((ob >> 9) & 1) << 5)); }
__host__ __device__ __forceinline__ void stage_rc(int b, int& R, int& C) { const int st = b / 1024, sb = b % 1024, swz = sb ^ (((sb >> 9) & 1) << 5); R = (st >> 1) * 16 + swz / 64; C = (st & 1) * 32 + (swz % 64) / 2; }
__host__ __device__ __forceinline__ int perm32(int rho) { const int n = rho >> 4, i = rho & 15; return 8 * (i >> 2) + 4 * n + (i & 3); }

struct Unit { int pm, pn; };
struct Gemm { const bf16_t* A; const bf16_t* Bt; int M, N, K, lda, pmg; size_t gstride; int tid; };

struct StaticOrder {
    int nM, nN, nwg, G, c;
    __host__ __device__ void init(int M, int N, int G_, int c_) { nM = M / BM; nN = N / BM; nwg = nM * nN; G = G_; c = c_; }
    __host__ __device__ bool next(int i, Unit& u) const {
        const long L = (long)i * G + c; if (L >= nwg) return false;
        int wgid = (int)L; { const int q = nwg / NXCD, r = nwg % NXCD, xcd = wgid % NXCD, off = wgid / NXCD; wgid = (xcd < r ? xcd * (q + 1) : r * (q + 1) + (xcd - r) * q) + off; }
        const int nig = WGM * nN, gid = wgid / nig, fm = gid * WGM, gsz = (nM - fm) < WGM ? (nM - fm) : WGM;
        u.pm = fm + ((wgid % nig) % gsz); u.pn = (wgid % nig) / gsz; return true;
    }
    __device__ __forceinline__ void a_ready(const Unit&) const {}
    __device__ __forceinline__ void done(const Unit&) const {}
};
__device__ __forceinline__ unsigned cvt_pk_bf16(float lo, float hi) { unsigned r; asm volatile("v_cvt_pk_bf16_f32 %0, %1, %2" : "=v"(r) : "v"(lo), "v"(hi)); return r; }
typedef float f32x2 __attribute__((ext_vector_type(2)));
template <class Epi, class Sched, bool STAMP = false>
__device__ __forceinline__ void gemm_phase(PG8_LAS unsigned char* lds, const Gemm g, const Sched& S, const Epi& E, unsigned long long* stamps) {
    const int tid = g.tid, wid = __builtin_amdgcn_readfirstlane(tid >> 6), lane = tid & 63, wr = wid >> 2, wc = wid & 3, fr = lane & 15, fq = lane >> 4;
    const int K = g.K, nt = K / BK;
    int ts_lo = 0, ts_hi = 0, nts = 0; const unsigned long long rt_entry = STAMP ? (unsigned long long)wall_clock64() : 0ull;
#define PG8_STAMP() do { if (STAMP && wid == 0 && nts < 64) { const unsigned long long _c = (unsigned long long)clock64(); \
        ts_lo = (lane == nts) ? (int)(unsigned)_c : ts_lo; ts_hi = (lane == nts) ? (int)(unsigned)(_c >> 32) : ts_hi; ++nts; } } while (0)
    PG8_STAMP();
    unsigned voffA[2], voffB[2];
#pragma unroll
    for (int i = 0; i < 2; ++i) { int R, C; stage_rc(tid * 16 + i * 8192, R, C); const int Rb = Epi::PERM ? ((R & ~31) + perm32(R & 31)) : R;
        voffA[i] = (unsigned)(R * g.lda + C) * 2u; voffB[i] = (unsigned)(Rb * K + C) * 2u; }
    const size_t kstep = (size_t)(BK * 2);
    const size_t hstepA = (size_t)HALF * g.lda * 2, hstepB = (size_t)HALF * K * 2;
    const size_t tstepA = 2 * hstepA, tstepB = 2 * hstepB;
    const unsigned ldsw = (unsigned)wid * 1024u;
    const int aoff = lds_byte(wr * 64 + fr, fq * 8), boff = lds_byte(wc * 32 + fr, fq * 8);
#define PG8_SA(b, h) (((b) * 2 + (h)) * HTB)
#define PG8_SB(b, h) ((4 + (b) * 2 + (h)) * HTB)
#define PG8_STAGE(bufoff, gbase, voff) do { _Pragma("unroll") for (int _i = 0; _i < 2; ++_i) \
        __builtin_amdgcn_global_load_lds((const unsigned*)((const char*)(gbase) + (voff)[_i]), (PG8_LAS unsigned*)(lds + (bufoff) + ldsw + _i * 8192), 16, 0, 0); } while (0)
#define PG8_LDA(dst, b, h) do { _Pragma("unroll") for (int m = 0; m < 4; ++m) _Pragma("unroll") for (int k = 0; k < 2; ++k) dst[m][k] = *(const PG8_LAS bf16x8*)(lds + PG8_SA(b, h) + aoff + m * 2048 + k * 1024); } while (0)
#define PG8_LDB(dst, b, h) do { _Pragma("unroll") for (int n = 0; n < 2; ++n) _Pragma("unroll") for (int k = 0; k < 2; ++k) dst[n][k] = *(const PG8_LAS bf16x8*)(lds + PG8_SB(b, h) + boff + n * 2048 + k * 1024); } while (0)
#define PG8_MMA(ai, bj, At, Bt) do { __builtin_amdgcn_s_setprio(1); _Pragma("unroll") for (int m = 0; m < 4; ++m) _Pragma("unroll") for (int n = 0; n < 2; ++n) _Pragma("unroll") for (int k = 0; k < 2; ++k) \
        acc[ai][bj][m][n] = __builtin_amdgcn_mfma_f32_16x16x32_bf16(Bt[n][k], At[m][k], acc[ai][bj][m][n], 0, 0, 0); __builtin_amdgcn_s_setprio(0); } while (0)
#define PG8_WAIT_V(n) asm volatile("s_waitcnt vmcnt(" #n ")" ::: "memory")
#define PG8_WAIT_L(n) asm volatile("s_waitcnt lgkmcnt(" #n ")" ::: "memory")
#define PG8_BAR __builtin_amdgcn_s_barrier()
#define PG8_SCHED __builtin_amdgcn_sched_barrier(0)
    Unit cur, nxt; int ui = 0;
    if (!S.next(0, cur)) return;
    f32x4 acc[2][2][4][2];
#pragma unroll
    for (int a = 0; a < 2; ++a)
#pragma unroll
        for (int b = 0; b < 2; ++b)
#pragma unroll
            for (int m = 0; m < 4; ++m)
#pragma unroll
                for (int n = 0; n < 2; ++n) acc[a][b][m][n] = (f32x4){0.f, 0.f, 0.f, 0.f};
    bf16x8 At[4][2], B0[2][2], B1[2][2];
    const char* cA = (const char*)g.A + (size_t)cur.pm * tstepA; const char* cB = (const char*)g.Bt + (size_t)(cur.pm / g.pmg) * g.gstride + (size_t)cur.pn * tstepB;
    S.a_ready(cur);
    PG8_STAGE(PG8_SB(0, 0), cB, voffB); PG8_STAGE(PG8_SA(0, 0), cA, voffA); PG8_STAGE(PG8_SB(0, 1), cB + hstepB, voffB); PG8_STAGE(PG8_SA(0, 1), cA + hstepA, voffA);
    if (wr == 1) PG8_BAR;
    PG8_WAIT_V(4); PG8_BAR;
    PG8_STAGE(PG8_SB(1, 0), cB + kstep, voffB); PG8_STAGE(PG8_SA(1, 0), cA + kstep, voffA); PG8_STAGE(PG8_SB(1, 1), cB + hstepB + kstep, voffB);
    PG8_WAIT_V(6); PG8_BAR;
    PG8_STAMP();
    for (;;) {
        const bool has_next = S.next(ui + 1, nxt);
        const char* nA = has_next ? (const char*)g.A + (size_t)nxt.pm * tstepA : cA; const char* nB = has_next ? (const char*)g.Bt + (size_t)(nxt.pm / g.pmg) * g.gstride + (size_t)nxt.pn * tstepB : cB;
#pragma unroll 1
        for (int t = 0; t < nt; t += 2) {
            const bool last = (t == nt - 2);
            const char* a1 = cA + (size_t)(t + 1) * kstep;
            const char* a2 = last ? nA : cA + (size_t)(t + 2) * kstep; const char* b2 = last ? nB : cB + (size_t)(t + 2) * kstep;
            const char* a3 = a2 + kstep; const char* b3 = b2 + kstep;
            if (last && has_next) S.a_ready(nxt);
            PG8_LDB(B0, 0, 0); PG8_SCHED; PG8_LDA(At, 0, 0); PG8_STAGE(PG8_SA(1, 1), a1 + hstepA, voffA);
            PG8_WAIT_L(8); PG8_BAR; PG8_WAIT_L(0); PG8_MMA(0, 0, At, B0); PG8_BAR; PG8_SCHED;
            PG8_LDB(B1, 0, 1); PG8_STAGE(PG8_SB(0, 0), b2, voffB);
            PG8_BAR; PG8_WAIT_L(0); PG8_MMA(0, 1, At, B1); PG8_BAR;
            PG8_LDA(At, 0, 1); PG8_STAGE(PG8_SA(0, 0), a2, voffA);
            PG8_BAR; PG8_WAIT_L(0); PG8_MMA(1, 0, At, B0); PG8_BAR; PG8_SCHED;
            PG8_STAGE(PG8_SB(0, 1), b2 + hstepB, voffB);
            PG8_WAIT_V(6); PG8_BAR; PG8_MMA(1, 1, At, B1); PG8_BAR;
            PG8_LDB(B0, 1, 0); PG8_SCHED; PG8_LDA(At, 1, 0); PG8_STAGE(PG8_SA(0, 1), a2 + hstepA, voffA);
            PG8_WAIT_L(8); PG8_BAR; PG8_WAIT_L(0); PG8_MMA(0, 0, At, B0); PG8_BAR; PG8_SCHED;
            PG8_LDB(B1, 1, 1); PG8_STAGE(PG8_SB(1, 0), b3, voffB);
            PG8_BAR; PG8_WAIT_L(0); PG8_MMA(0, 1, At, B1); PG8_BAR;
            PG8_LDA(At, 1, 1); PG8_STAGE(PG8_SA(1, 0), a3, voffA);
            PG8_BAR; PG8_WAIT_L(0); PG8_MMA(1, 0, At, B0); PG8_BAR; PG8_SCHED;
            PG8_STAGE(PG8_SB(1, 1), b3 + hstepB, voffB);
            PG8_WAIT_V(6); PG8_BAR; PG8_MMA(1, 1, At, B1); PG8_BAR;
        }
        PG8_STAMP();
        if constexpr (!Epi::AFTER_DRAIN) { E(acc, cur, wr, wc, fr, fq); S.done(cur); }
        PG8_STAMP();
        if (!has_next) break;
#pragma unroll
        for (int a = 0; a < 2; ++a)
#pragma unroll
            for (int b = 0; b < 2; ++b)
#pragma unroll
                for (int m = 0; m < 4; ++m)
#pragma unroll
                    for (int n = 0; n < 2; ++n) acc[a][b][m][n] = (f32x4){0.f, 0.f, 0.f, 0.f};
        cur = nxt; cA = nA; cB = nB; ++ui;
    }
    PG8_WAIT_V(0);
    if (wr == 0) PG8_BAR;
    PG8_BAR;
    if constexpr (Epi::AFTER_DRAIN) { E.fused(acc, cur, wr, wc, fr, fq, lds, wid, lane); S.done(cur); }
    PG8_STAMP();
    if (STAMP && wid == 0) { stamps[lane] = lane < nts ? (((unsigned long long)(unsigned)ts_hi << 32) | (unsigned)ts_lo) : 0ull;
        if (lane == 62) stamps[62] = rt_entry; if (lane == 63) stamps[63] = (unsigned long long)wall_clock64(); }
#undef PG8_STAMP
#undef PG8_SA
#undef PG8_SB
#undef PG8_STAGE
#undef PG8_LDA
#undef PG8_LDB
#undef PG8_MMA
#undef PG8_WAIT_V
#undef PG8_WAIT_L
#undef PG8_BAR
#undef PG8_SCHED
}
}


namespace hy {
using pg8::bf16_t; using pg8::f32x4; using pg8::u32x4; using pg8::Unit;
typedef unsigned u32x2 __attribute__((ext_vector_type(2)));
#define DI __device__ __forceinline__
constexpr int D = 1024, NBATCH = 8, SEQ = 4096, CTXL = 256, DEPTH = 4;
constexpr int CTXROWS = NBATCH * CTXL;
constexpr int MROWS = CTXROWS + NBATCH * SEQ;
constexpr int NCHUNK = MROWS / 64;
constexpr int NIN = 14384;
constexpr int NT = 512;
constexpr int LDS_BYTES = 147456 + 256;
constexpr int C_GQ = 0, C_GZ = 3072, C_GA = 4096, C_SU = 4128, C_MQ = 6176, C_MO = 9248, C_MI = 11296, C_GATE = 11312;

constexpr size_t al256(size_t x) { return (x + 255) & ~(size_t)255; }
constexpr size_t SZ_ACT = (size_t)MROWS * 1024 * 2;
constexpr size_t SZ_GATE = (size_t)MROWS * 32 * 4;
constexpr size_t SZ_HALO = (size_t)3 * NCHUNK * 4 * 1024 * 2;
constexpr size_t WS_CTL = 0;
constexpr size_t WS_MOD = 65536, SZ_MOD = (size_t)DEPTH * 9 * 3072 * 4;
constexpr size_t WS_XCTX = al256(WS_MOD + SZ_MOD);
constexpr size_t WS_H = WS_XCTX + (size_t)CTXROWS * 1024 * 4;
constexpr size_t WS_MERGED = WS_H + SZ_ACT;
constexpr size_t SZ_WB = (size_t)3328 * 1024 * 2;
constexpr size_t WS_WB0 = WS_MERGED + SZ_ACT;
constexpr size_t WS_WB1 = WS_WB0 + SZ_WB;
constexpr size_t WS_WB2 = WS_WB1 + SZ_WB;
constexpr size_t WS_R = WS_WB2 + SZ_WB;
constexpr size_t R_P0 = 0, R_P1 = SZ_ACT, R_P2 = 2 * SZ_ACT, R_OF = 3 * SZ_ACT, R_OB = 4 * SZ_ACT, R_G2 = 5 * SZ_ACT, R_M5 = al256(R_G2 + SZ_GATE);
constexpr size_t WS_END = WS_R + R_M5 + 3 * SZ_ACT;
static_assert(SZ_GATE + SZ_HALO <= SZ_ACT, "GDN gate + halo buffers live in the (not yet written) MERGED region");
static_assert((size_t)16 * DEPTH * 9 * 3072 * 4 <= SZ_ACT, "mod partials live in the R region");

struct Args { const float* in[28]; float* out; unsigned char* ws; int ph_lo, ph_hi, wid, pad; };
enum { I_X = 0, I_C, I_CTX, I_CCTX, I_WADA, I_BADA, I_NORMG, I_WIN, I_GCONV, I_GALOG, I_GDTB, I_GNORM, I_SLRE, I_SLIM, I_SLOG, I_SBRE, I_SBIM, I_SCRE, I_SCIM, I_SD, I_SWGLU, I_SBGLU, I_MIB, I_MFB, I_MNORM, I_WBR, I_WOUT, I_FNORM };

typedef const Args __attribute__((address_space(4)))* ArgsP;
DI ArgsP args_ptr() { ArgsP p = (ArgsP)__builtin_amdgcn_kernarg_segment_ptr(); asm volatile("" : "+s"(p)); return p; }
DI int lane_id() { int l; asm volatile("v_mbcnt_lo_u32_b32 %0, -1, 0\n\tv_mbcnt_hi_u32_b32 %0, -1, %0" : "=v"(l)); return l; }
DI int ltid(const Args& a) { return (a.wid << 6) | lane_id(); }
DI void lds_barrier() { asm volatile("s_waitcnt lgkmcnt(0)" ::: "memory"); __builtin_amdgcn_s_barrier(); asm volatile("" ::: "memory"); }
DI float bf2f(bf16_t v) { return __uint_as_float(((unsigned)v) << 16); }
DI float bflo(unsigned w) { return __uint_as_float(w << 16); }
DI float bfhi(unsigned w) { return __uint_as_float(w & 0xffff0000u); }
DI bf16_t f2bf(float f) { return (bf16_t)(pg8::cvt_pk_bf16(f, 0.f) & 0xffffu); }
DI float sigmoidf_(float x) { return __builtin_amdgcn_rcpf(1.0f + __expf(-x)); }
DI float siluf_(float x) { return x * __builtin_amdgcn_rcpf(1.0f + __expf(-x)); }
DI float softplusf_(float x) { return x > 20.f ? x : log1pf(__expf(x)); }
DI float gelu_tanh_(float x) { const float u = 0.7978845608028654f * (x + 0.044715f * x * x * x); return x * __builtin_amdgcn_rcpf(1.0f + __expf(-2.0f * u)); }
DI float shx(float v, int o, int lane) { return __int_as_float(__builtin_amdgcn_ds_bpermute((lane ^ o) << 2, __float_as_int(v))); }
DI float shup(float v, int o, int lane) { return __int_as_float(__builtin_amdgcn_ds_bpermute((lane - o) << 2, __float_as_int(v))); }
DI float shidx(float v, int src) { return __int_as_float(__builtin_amdgcn_ds_bpermute(src << 2, __float_as_int(v))); }
#define DPP_F(old_, src_, ctrl_, rmask_) __int_as_float(__builtin_amdgcn_update_dpp(__float_as_int(old_), __float_as_int(src_), (ctrl_), (rmask_), 0xF, false))
DI float dpp_scan_sum(float v) {
    v += DPP_F(0.f, v, 0x111, 0xF); v += DPP_F(0.f, v, 0x112, 0xF); v += DPP_F(0.f, v, 0x114, 0xF); v += DPP_F(0.f, v, 0x118, 0xF);
    v += DPP_F(0.f, v, 0x142, 0xA); v += DPP_F(0.f, v, 0x143, 0xC); return v; }
DI float dpp_scan_max(float v) {
    const float ninf = -__builtin_inff();
    v = fmaxf(v, DPP_F(ninf, v, 0x111, 0xF)); v = fmaxf(v, DPP_F(ninf, v, 0x112, 0xF)); v = fmaxf(v, DPP_F(ninf, v, 0x114, 0xF)); v = fmaxf(v, DPP_F(ninf, v, 0x118, 0xF));
    v = fmaxf(v, DPP_F(ninf, v, 0x142, 0xA)); v = fmaxf(v, DPP_F(ninf, v, 0x143, 0xC)); return v; }
DI float lane63(float v) { return __int_as_float(__builtin_amdgcn_readlane(__float_as_int(v), 63)); }
DI float wave_sum(float v, int lane) {
#pragma unroll
    for (int o = 32; o >= 1; o >>= 1) v += shx(v, o, lane);
    return v; }
DI void unpack8(const u32x4 w, float (&f)[8]) { f[0] = bflo(w.x); f[1] = bfhi(w.x); f[2] = bflo(w.y); f[3] = bfhi(w.y); f[4] = bflo(w.z); f[5] = bfhi(w.z); f[6] = bflo(w.w); f[7] = bfhi(w.w); }
DI int lat_pos(int l, int s) { return (l & 1) ? (((s & 63) << 6) | (s >> 6)) : s; }

struct EpiProj {
    static constexpr bool PERM = true, AFTER_DRAIN = false;
    bf16_t* d0; int modes; float* gdst; int gtile; bf16_t* halo; int row_off;
    __device__ __forceinline__ void operator()(const f32x4 (&acc)[2][2][4][2], const Unit& u, int wr, int wc, int fr, int fq) const {
        const int row0 = row_off + u.pm * 256 + wr * 64 + fr;
        if (u.pn == gtile) {
            if (wc == 0) {
#pragma unroll
                for (int ai = 0; ai < 2; ++ai)
#pragma unroll
                    for (int m = 0; m < 4; ++m) { float* rp = gdst + (size_t)(row0 + ai * 128 + m * 16) * 32 + 8 * fq; *(f32x4*)rp = acc[ai][0][m][0]; *(f32x4*)(rp + 4) = acc[ai][0][m][1]; }
            }
            return;
        }
        const int seg = u.pn >> 2; bf16_t* base = d0 + (size_t)seg * (SZ_ACT / 2); const int md = (modes >> (2 * seg)) & 3;
        const int col0 = (u.pn & 3) * 256 + wc * 32 + 8 * fq;
#pragma unroll
        for (int ai = 0; ai < 2; ++ai)
#pragma unroll
            for (int m = 0; m < 4; ++m) {
                const int r = row0 + ai * 128 + m * 16;
                bf16_t* rowp = base + (size_t)r * 1024 + col0;
                int hidx = -1;
                if (halo) { if (m == 0 && fr < 2) hidx = fr; if (m == 3 && fr >= 14) hidx = fr - 12; }
#pragma unroll
                for (int bj = 0; bj < 2; ++bj) {
                    f32x4 v0 = acc[ai][bj][m][0], v1 = acc[ai][bj][m][1];
                    if (md == 1) {
#pragma unroll
                        for (int j = 0; j < 4; ++j) { v0[j] = siluf_(v0[j]); v1[j] = siluf_(v1[j]); } }
                    else if (md == 2) {
#pragma unroll
                        for (int j = 0; j < 4; ++j) { v0[j] = sigmoidf_(v0[j]); v1[j] = sigmoidf_(v1[j]); } }
                    u32x4 w; w.x = pg8::cvt_pk_bf16(v0[0], v0[1]); w.y = pg8::cvt_pk_bf16(v0[2], v0[3]); w.z = pg8::cvt_pk_bf16(v1[0], v1[1]); w.w = pg8::cvt_pk_bf16(v1[2], v1[3]);
                    *(u32x4*)(rowp + bj * 128) = w;
                    if (hidx >= 0) *(u32x4*)(halo + ((size_t)seg * (NCHUNK * 4) + (size_t)(r >> 6) * 4 + hidx) * 1024 + col0 + bj * 128) = w;
                }
            }
    }
};
struct EpiBranch {
    static constexpr bool PERM = true, AFTER_DRAIN = false;
    const bf16_t* G; bf16_t* MG; int first, row_off;
    __device__ __forceinline__ void operator()(const f32x4 (&acc)[2][2][4][2], const Unit& u, int wr, int wc, int fr, int fq) const {
        const int row0 = row_off + u.pm * 256 + wr * 64 + fr, col0 = u.pn * 256 + wc * 32 + 8 * fq;
#pragma unroll
        for (int ai = 0; ai < 2; ++ai)
#pragma unroll
            for (int m = 0; m < 4; ++m) {
                const size_t off = (size_t)(row0 + ai * 128 + m * 16) * 1024 + col0;
#pragma unroll
                for (int bj = 0; bj < 2; ++bj) {
                    const u32x4 gw = *(const u32x4*)(G + off + bj * 128);
                    float g[8], o[8]; unpack8(gw, g);
                    if (first) {
#pragma unroll
                        for (int j = 0; j < 8; ++j) o[j] = 0.f; }
                    else { const u32x4 ow = *(const u32x4*)(MG + off + bj * 128); unpack8(ow, o); }
                    const f32x4 v0 = acc[ai][bj][m][0], v1 = acc[ai][bj][m][1];
#pragma unroll
                    for (int j = 0; j < 4; ++j) { o[j] += g[j] * v0[j]; o[4 + j] += g[4 + j] * v1[j]; }
                    u32x4 w; w.x = pg8::cvt_pk_bf16(o[0], o[1]); w.y = pg8::cvt_pk_bf16(o[2], o[3]); w.z = pg8::cvt_pk_bf16(o[4], o[5]); w.w = pg8::cvt_pk_bf16(o[6], o[7]);
                    *(u32x4*)(MG + off + bj * 128) = w;
                }
                asm volatile("" ::: "memory");
            }
    }
};
struct EpiGlu {
    static constexpr bool PERM = true, AFTER_DRAIN = false;
    const bf16_t* SZ; bf16_t* O; const float* bias; int row_off;
    __device__ __forceinline__ void operator()(const f32x4 (&acc)[2][2][4][2], const Unit& u, int wr, int wc, int fr, int fq) const {
        const int row0 = row_off + u.pm * 256 + wr * 64 + fr, col0 = u.pn * 128 + wc * 32 + 8 * fq;
        float ba[8], bg[8];
#pragma unroll
        for (int j = 0; j < 8; ++j) { ba[j] = bias[col0 + j]; bg[j] = bias[1024 + col0 + j]; }
#pragma unroll
        for (int ai = 0; ai < 2; ++ai)
#pragma unroll
            for (int m = 0; m < 4; ++m) {
                const size_t off = (size_t)(row0 + ai * 128 + m * 16) * 1024 + col0;
                const u32x4 zw = *(const u32x4*)(SZ + off); float z[8], o[8]; unpack8(zw, z);
#pragma unroll
                for (int n = 0; n < 2; ++n)
#pragma unroll
                    for (int j = 0; j < 4; ++j) { const int c = 4 * n + j; o[c] = (acc[ai][0][m][n][j] + ba[c]) * sigmoidf_(acc[ai][1][m][n][j] + bg[c]) * z[c]; }
                u32x4 w; w.x = pg8::cvt_pk_bf16(o[0], o[1]); w.y = pg8::cvt_pk_bf16(o[2], o[3]); w.z = pg8::cvt_pk_bf16(o[4], o[5]); w.w = pg8::cvt_pk_bf16(o[6], o[7]);
                *(u32x4*)(O + off) = w;
            }
    }
};
struct EpiOut {
    static constexpr bool PERM = false, AFTER_DRAIN = false;
    const float* xlat_src; float* xlat_dst; const float* xctx_src; float* xctx_dst; const float* mod; int l; int row_off;
    __device__ __forceinline__ void operator()(const f32x4 (&acc)[2][2][4][2], const Unit& u, int wr, int wc, int fr, int fq) const {
        const int row0 = row_off + u.pm * 256 + wr * 64 + fr, col0 = u.pn * 256 + wc * 32 + 4 * fq;
#pragma unroll
        for (int ai = 0; ai < 2; ++ai)
#pragma unroll
            for (int m = 0; m < 4; ++m) {
                const int r = row0 + ai * 128 + m * 16;
                const float* xs; float* xd; const float* gp;
                if (r < CTXROWS) { xs = xctx_src + (size_t)r * 1024; xd = xctx_dst + (size_t)r * 1024; gp = mod + 8 * 3072 + 2048; }
                else { const int q = r - CTXROWS, b = q >> 12, p = lat_pos(l, q & 4095); const size_t o = ((size_t)b * 4096 + p) * 1024; xs = xlat_src + o; xd = xlat_dst + o; gp = mod + b * 3072 + 2048; }
#pragma unroll
                for (int bj = 0; bj < 2; ++bj)
#pragma unroll
                    for (int n = 0; n < 2; ++n) { const int c = col0 + bj * 128 + n * 16; const f32x4 x = *(const f32x4*)(xs + c), g = *(const f32x4*)(gp + c); *(f32x4*)(xd + c) = x + g * acc[ai][bj][m][n]; }
                asm volatile("" ::: "memory");
            }
    }
};

DI void ph_modp(const Args& a, float* modp, LAS float* sl) {
    for (int it = blockIdx.x; it < 384; it += gridDim.x) {
        const int l = it / 96, kq = (it / 6) % 16, nt = it % 6;
        __syncthreads();
        for (int i = ltid(a); i < 576; i += NT) { const int j = i >> 6, k = kq * 64 + (i & 63); const float cv = (j < 8) ? a.in[I_C][j * 1024 + k] : a.in[I_CCTX][k]; sl[i] = siluf_(cv); }
        __syncthreads();
        const int n = nt * 512 + ltid(a);
        float acc[9];
#pragma unroll
        for (int j = 0; j < 9; ++j) acc[j] = 0.f;
        const float* w = a.in[I_WADA] + ((size_t)l * 1024 + kq * 64) * 3072 + n;
#pragma unroll 4
        for (int k = 0; k < 64; ++k) { const float wv = w[(size_t)k * 3072];
#pragma unroll
            for (int j = 0; j < 9; ++j) acc[j] += sl[j * 64 + k] * wv; }
#pragma unroll
        for (int j = 0; j < 9; ++j) modp[(((size_t)kq * 4 + l) * 9 + j) * 3072 + n] = acc[j];
    }
}
DI void ph_mod(const Args& a, const float* modp, float* mod) {
    for (int i = blockIdx.x * NT + ltid(a); i < DEPTH * 9 * 3072; i += gridDim.x * NT) {
        const int l = i / (9 * 3072), n = i % 3072; float s = a.in[I_BADA][l * 3072 + n];
#pragma unroll
        for (int kq = 0; kq < 16; ++kq) s += modp[(size_t)kq * (DEPTH * 9 * 3072) + i];
        mod[i] = s;
    }
}
DI void ph_norm(const Args& a, int l, const float* xlat, const float* xctx, const float* mod, bf16_t* H) {
    const int wave = ltid(a) >> 6, lane = ltid(a) & 63;
    const float* g = a.in[I_NORMG] + l * 1024;
    for (int r = blockIdx.x * 8 + wave; r < MROWS; r += gridDim.x * 8) {
        const float* src; const float* md;
        if (r < CTXROWS) { src = xctx + (size_t)r * 1024; md = mod + 8 * 3072; }
        else { const int q = r - CTXROWS, b = q >> 12, p = lat_pos(l, q & 4095); src = xlat + ((size_t)b * 4096 + p) * 1024; md = mod + b * 3072; }
        f32x4 v[4]; float ss = 0.f;
#pragma unroll
        for (int i = 0; i < 4; ++i) { v[i] = *(const f32x4*)(src + i * 256 + lane * 4); ss += v[i][0] * v[i][0] + v[i][1] * v[i][1] + v[i][2] * v[i][2] + v[i][3] * v[i][3]; }
        ss = wave_sum(ss, lane);
        const float rs = rsqrtf(ss * (1.0f / 1024.0f) + 1e-6f);
#pragma unroll
        for (int i = 0; i < 4; ++i) { const int c = i * 256 + lane * 4;
            const f32x4 gv = *(const f32x4*)(g + c), sh = *(const f32x4*)(md + c), sc = *(const f32x4*)(md + 1024 + c);
            const f32x4 y = (v[i] * rs) * gv * (sc + 1.0f) + sh;
            u32x2 w; w.x = pg8::cvt_pk_bf16(y[0], y[1]); w.y = pg8::cvt_pk_bf16(y[2], y[3]);
            *(u32x2*)(H + (size_t)r * 1024 + c) = w; }
    }
}
DI void ph_final(const Args& a, float* x) {
    const int wave = ltid(a) >> 6, lane = ltid(a) & 63;
    const float* g = a.in[I_FNORM];
    for (int r = blockIdx.x * 8 + wave; r < NBATCH * SEQ; r += gridDim.x * 8) {
        float* src = x + (size_t)r * 1024;
        f32x4 v[4]; float ss = 0.f;
#pragma unroll
        for (int i = 0; i < 4; ++i) { v[i] = *(const f32x4*)(src + i * 256 + lane * 4); ss += v[i][0] * v[i][0] + v[i][1] * v[i][1] + v[i][2] * v[i][2] + v[i][3] * v[i][3]; }
        ss = wave_sum(ss, lane);
        const float rs = rsqrtf(ss * (1.0f / 1024.0f) + 1e-6f);
#pragma unroll
        for (int i = 0; i < 4; ++i) { const int c = i * 256 + lane * 4; const f32x4 gv = *(const f32x4*)(g + c); *(f32x4*)(src + c) = (v[i] * rs) * gv; }
    }
}
struct WDesc { const float* src; int ld, id, n64, tid; };
DI void wmap(int id, int nb, int& col, int& valid) {
    valid = 64;
    switch (id) {
        case 0: if (nb < 48) col = C_GQ + 64 * nb; else if (nb == 48) { col = C_GA; valid = 32; } else { col = 0; valid = 0; } break;
        case 1: col = (nb < 16) ? C_GZ + 64 * nb : C_GATE + 64 * (nb - 16); break;
        case 2: if (nb < 48) col = C_MQ + 64 * nb; else if (nb == 48) { col = C_MI; valid = 16; } else { col = 0; valid = 0; } break;
        case 3: col = (nb < 32) ? C_MO + 64 * nb : C_GATE + 2048 + 64 * (nb - 32); break;
        case 4: col = (nb < 32) ? C_SU + 64 * nb : C_GATE + 1024 + 64 * (nb - 32); break;
        case 5: { const int pn = nb >> 2, q = nb & 3; col = (q >> 1) * 1024 + 128 * pn + (q & 1) * 64; } break;
        default: col = 64 * nb; break;
    }
}
DI WDesc wdesc(const Args& a, int l, int id) {
    WDesc w; w.id = id; w.tid = ltid(a);
    if (id <= 4) { w.src = a.in[I_WIN] + (size_t)l * 1024 * NIN; w.ld = NIN; w.n64 = (id == 0 || id == 2) ? 52 : (id == 1 ? 32 : 48); }
    else if (id == 5) { w.src = a.in[I_SWGLU] + (size_t)l * 1024 * 2048; w.ld = 2048; w.n64 = 32; }
    else if (id <= 8) { w.src = a.in[I_WBR] + ((size_t)l * 3 + (id - 6)) * 1024 * 1024; w.ld = 1024; w.n64 = 16; }
    else { w.src = a.in[I_WOUT] + (size_t)l * 1024 * 1024; w.ld = 1024; w.n64 = 16; }
    return w;
}
DI void ph_cvt(const WDesc w, bf16_t* dst, LAS float* tile) {
    const int tid = w.tid, ntile = w.n64 * 16;
    const int r0 = tid >> 4, c4 = (tid & 15) * 4;
    f32x4 p0, p1; int buf = 0;
#define CVT_FETCH(t_) do { const int nb_ = (t_) >> 4, kb_ = (t_) & 15; int col_, valid_; wmap(w.id, nb_, col_, valid_); \
        const f32x4 z_ = (f32x4){0.f, 0.f, 0.f, 0.f}; const bool on_ = c4 < valid_; \
        p0 = on_ ? *(const f32x4*)(w.src + (size_t)(kb_ * 64 + r0) * w.ld + col_ + c4) : z_; p1 = on_ ? *(const f32x4*)(w.src + (size_t)(kb_ * 64 + r0 + 32) * w.ld + col_ + c4) : z_; } while (0)
    int t = blockIdx.x;
    if (t < ntile) CVT_FETCH(t);
    for (; t < ntile; t += gridDim.x) {
        LAS float* tl = tile + buf * (64 * 65);
        tl[r0 * 65 + c4] = p0[0]; tl[r0 * 65 + c4 + 1] = p0[1]; tl[r0 * 65 + c4 + 2] = p0[2]; tl[r0 * 65 + c4 + 3] = p0[3];
        tl[(r0 + 32) * 65 + c4] = p1[0]; tl[(r0 + 32) * 65 + c4 + 1] = p1[1]; tl[(r0 + 32) * 65 + c4 + 2] = p1[2]; tl[(r0 + 32) * 65 + c4 + 3] = p1[3];
        if (t + (int)gridDim.x < ntile) CVT_FETCH(t + (int)gridDim.x);
        lds_barrier();
        { const int nb = t >> 4, kb = t & 15, n = tid >> 3, kk = (tid & 7) * 8; u32x4 o;
          o.x = pg8::cvt_pk_bf16(tl[(kk + 0) * 65 + n], tl[(kk + 1) * 65 + n]); o.y = pg8::cvt_pk_bf16(tl[(kk + 2) * 65 + n], tl[(kk + 3) * 65 + n]);
          o.z = pg8::cvt_pk_bf16(tl[(kk + 4) * 65 + n], tl[(kk + 5) * 65 + n]); o.w = pg8::cvt_pk_bf16(tl[(kk + 6) * 65 + n], tl[(kk + 7) * 65 + n]);
          *(u32x4*)(dst + (size_t)(nb * 64 + n) * 1024 + kb * 64 + kk) = o; }
        buf ^= 1;
    }
#undef CVT_FETCH
    __syncthreads();
}

DI void gdn_conv_decode(int unit, int& cb, int& seg, int& h) { cb = unit / 24; seg = (unit % 24) >> 3; h = unit & 7; }
DI void ph_gdn_conv(const Args& a, int l, bf16_t* QKV  , const bf16_t* halo, LAS unsigned char* lds, bf16_t* junk = nullptr) {
    constexpr int P = 136, IMG = 68 * P * 2 + 5 * 128 * 4;
    const int tid = ltid(a);
    const float* cw = a.in[I_GCONV] + (size_t)l * 5 * 3072;
    const int nunit = NCHUNK * 24;
    u32x4 rp[3]; f32x4 wreg = (f32x4){0.f, 0.f, 0.f, 0.f};
    int unit = blockIdx.x, buf = 0;
#define CONV_FETCH(un) do { int cb_, seg_, h_; gdn_conv_decode(un, cb_, seg_, h_); const bf16_t* T_ = QKV + (size_t)seg_ * (SZ_ACT / 2); \
        const bool first_ = (cb_ < 32) ? ((cb_ & 3) == 0) : (((cb_ - 32) & 63) == 0), last_ = (cb_ < 32) ? ((cb_ & 3) == 3) : (((cb_ - 32) & 63) == 63); \
        _Pragma("unroll") for (int q_ = 0; q_ < 3; ++q_) { const int i_ = tid + 512 * q_, rr_ = i_ >> 4, c8_ = (i_ & 15) * 8; u32x4 w_ = (u32x4){0u, 0u, 0u, 0u}; \
            if (i_ < 68 * 16) { if (rr_ >= 2 && rr_ < 66) w_ = *(const u32x4*)(T_ + (size_t)(cb_ * 64 + rr_ - 2) * 1024 + h_ * 128 + c8_); \
                else if (rr_ < 2) { if (!first_) w_ = *(const u32x4*)(halo + ((size_t)seg_ * (NCHUNK * 4) + (size_t)(cb_ - 1) * 4 + 2 + rr_) * 1024 + h_ * 128 + c8_); } \
                else { if (!last_) w_ = *(const u32x4*)(halo + ((size_t)seg_ * (NCHUNK * 4) + (size_t)(cb_ + 1) * 4 + (rr_ - 66)) * 1024 + h_ * 128 + c8_); } } \
            rp[q_] = w_; } \
        if (tid < 160) wreg = *(const f32x4*)(cw + (size_t)(tid >> 5) * 3072 + seg_ * 1024 + h_ * 128 + (tid & 31) * 4); } while (0)
    if (unit < nunit) CONV_FETCH(unit);
    for (; unit < nunit; unit += gridDim.x) {
        int cb, seg, h; gdn_conv_decode(unit, cb, seg, h);
        LAS bf16_t* raw = (LAS bf16_t*)(lds + buf * IMG); LAS float* wl = (LAS float*)(lds + buf * IMG + 68 * P * 2);
#pragma unroll
        for (int q = 0; q < 3; ++q) { const int i = tid + 512 * q, rr = i >> 4, c8 = (i & 15) * 8; if (i < 68 * 16) *(LAS u32x4*)(raw + rr * P + c8) = rp[q]; }
        if (tid < 160) *(LAS f32x4*)(wl + tid * 4) = wreg;
        if (unit + (int)gridDim.x < nunit) CONV_FETCH(unit + (int)gridDim.x);
        lds_barrier();
        bf16_t* T = QKV + (size_t)seg * (SZ_ACT / 2);
        const int t = tid >> 3, c0 = (tid & 7) * 16;
        float o[16]; float ss = 0.f;
#pragma unroll
        for (int half = 0; half < 2; ++half) {
            float acc[8];
#pragma unroll
            for (int j = 0; j < 8; ++j) acc[j] = 0.f;
#pragma unroll
            for (int k = 0; k < 5; ++k) {
                const u32x4 w = *(const LAS u32x4*)(raw + (t + k) * P + c0 + half * 8); float x[8]; unpack8(w, x);
                const f32x4 w0 = *(const LAS f32x4*)(wl + k * 128 + c0 + half * 8), w1 = *(const LAS f32x4*)(wl + k * 128 + c0 + half * 8 + 4);
#pragma unroll
                for (int j = 0; j < 4; ++j) { acc[j] += w0[j] * x[j]; acc[4 + j] += w1[j] * x[4 + j]; }
            }
#pragma unroll
            for (int j = 0; j < 8; ++j) { const float sv = siluf_(acc[j]); o[half * 8 + j] = sv; ss += sv * sv; }
        }
        ss += shx(ss, 1, tid & 63); ss += shx(ss, 2, tid & 63); ss += shx(ss, 4, tid & 63);
        float scale = 1.0f;
        if (seg == 0) scale = rsqrtf(ss + 1e-6f) * 0.08838834764831845f;
        else if (seg == 1) scale = rsqrtf(ss + 1e-6f);
        u32x4 w0, w1;
        w0.x = pg8::cvt_pk_bf16(o[0] * scale, o[1] * scale); w0.y = pg8::cvt_pk_bf16(o[2] * scale, o[3] * scale); w0.z = pg8::cvt_pk_bf16(o[4] * scale, o[5] * scale); w0.w = pg8::cvt_pk_bf16(o[6] * scale, o[7] * scale);
        w1.x = pg8::cvt_pk_bf16(o[8] * scale, o[9] * scale); w1.y = pg8::cvt_pk_bf16(o[10] * scale, o[11] * scale); w1.z = pg8::cvt_pk_bf16(o[12] * scale, o[13] * scale); w1.w = pg8::cvt_pk_bf16(o[14] * scale, o[15] * scale);
        bf16_t* op = (junk ? junk : T) + (size_t)(cb * 64 + t) * 1024 + h * 128 + c0;
        *(u32x4*)op = w0; *(u32x4*)(op + 8) = w1;
        buf ^= 1;
    }
#undef CONV_FETCH
    __syncthreads();
}
DI void ph_gdn_scan(const Args& a, int l, const bf16_t* Q, const bf16_t* K, const bf16_t* V, const float* GATE, bf16_t* OF, bf16_t* OB, LAS unsigned char* lds) {
    LAS float* qf = (LAS float*)lds;
    LAS float* kf = qf + 64 * 128;
    LAS float* vf = kf + 64 * 128;
    LAS float* av = vf + 64 * 64;
    LAS float* bt = av + 64;
    LAS float* part = bt + 64;
    LAS float* po = part + 1024;
    const int tid = ltid(a), e = tid & 63, dq = tid >> 6;
    for (int unit = blockIdx.x; unit < 256; unit += gridDim.x) {
        const int eh = unit & 1, d = (unit >> 1) & 1, h = (unit >> 2) & 7, b = unit >> 5;
        const float nea = -__expf(a.in[I_GALOG][(l * 2 + d) * 8 + h]), dtb = a.in[I_GDTB][(l * 2 + d) * 8 + h];
        bf16_t* O = d ? OB : OF;
        float S[16];
#pragma unroll
        for (int j = 0; j < 16; ++j) S[j] = 0.f;
        float opart = 0.f; int prow = -1, par = 0;
        for (int step = 0; step < 68; ++step) {
            const int cc = (step < 4) ? (d ? 3 - step : step) : (d ? 67 - step : step - 4);
            const int row0 = (step < 4) ? b * 256 + cc * 64 : CTXROWS + b * 4096 + cc * 64;
            __syncthreads();
            for (int i = tid; i < 1024; i += NT) { const int r = i >> 4, c8 = (i & 15) * 8; float f[8];
                unpack8(*(const u32x4*)(Q + (size_t)(row0 + r) * 1024 + h * 128 + c8), f);
#pragma unroll
                for (int j = 0; j < 8; ++j) qf[r * 128 + c8 + j] = f[j];
                unpack8(*(const u32x4*)(K + (size_t)(row0 + r) * 1024 + h * 128 + c8), f);
#pragma unroll
                for (int j = 0; j < 8; ++j) kf[r * 128 + c8 + j] = f[j]; }
            { const int r = tid >> 3, c8 = (tid & 7) * 8; float f[8]; unpack8(*(const u32x4*)(V + (size_t)(row0 + r) * 1024 + h * 128 + eh * 64 + c8), f);
#pragma unroll
              for (int j = 0; j < 8; ++j) vf[r * 64 + c8 + j] = f[j]; }
            if (tid < 64) { const float* gp = GATE + (size_t)(row0 + tid) * 32; av[tid] = __expf(nea * softplusf_(gp[d * 8 + h] + dtb)); bt[tid] = sigmoidf_(gp[16 + d * 8 + h]); }
            __syncthreads();
            for (int tt = 0; tt < 64; ++tt) {
                const int t = d ? 63 - tt : tt;
                float kk[16];
#pragma unroll
                for (int j4 = 0; j4 < 4; ++j4) { const f32x4 x = *(const LAS f32x4*)(kf + t * 128 + dq * 16 + j4 * 4); kk[j4 * 4] = x[0]; kk[j4 * 4 + 1] = x[1]; kk[j4 * 4 + 2] = x[2]; kk[j4 * 4 + 3] = x[3]; }
                float p = 0.f;
#pragma unroll
                for (int j = 0; j < 16; ++j) p += kk[j] * S[j];
                part[(par * 8 + dq) * 64 + e] = p; po[(par * 8 + dq) * 64 + e] = opart;
                __syncthreads();
                if (dq == 0 && prow >= 0) { float o = 0.f;
#pragma unroll
                    for (int q = 0; q < 8; ++q) o += po[(par * 8 + q) * 64 + e];
                    O[(size_t)prow * 1024 + h * 128 + eh * 64 + e] = f2bf(o); }
                float ks = 0.f;
#pragma unroll
                for (int q = 0; q < 8; ++q) ks += part[(par * 8 + q) * 64 + e];
                const float at = av[t], vn = bt[t] * (vf[t * 64 + e] - at * ks);
#pragma unroll
                for (int j = 0; j < 16; ++j) S[j] = at * S[j] + kk[j] * vn;
                float qo = 0.f;
#pragma unroll
                for (int j4 = 0; j4 < 4; ++j4) { const f32x4 x = *(const LAS f32x4*)(qf + t * 128 + dq * 16 + j4 * 4); qo += x[0] * S[j4 * 4] + x[1] * S[j4 * 4 + 1] + x[2] * S[j4 * 4 + 2] + x[3] * S[j4 * 4 + 3]; }
                opart = qo; prow = row0 + t; par ^= 1;
            }
        }
        po[(par * 8 + dq) * 64 + e] = opart;
        __syncthreads();
        if (dq == 0) { float o = 0.f;
#pragma unroll
            for (int q = 0; q < 8; ++q) o += po[(par * 8 + q) * 64 + e];
            O[(size_t)prow * 1024 + h * 128 + eh * 64 + e] = f2bf(o); }
        __syncthreads();
    }
}
template <int O> DI float swz_xor(float v) { return __int_as_float(__builtin_amdgcn_ds_swizzle(__float_as_int(v), 0x1F | (O << 10))); }
DI void ph_gdn_post(const Args& a, int l, bf16_t* OF, const bf16_t* OB, const bf16_t* SZ, bf16_t* junk = nullptr) {
    const int tid = ltid(a), wave = tid >> 6, lane = tid & 63;
    const float* g = a.in[I_GNORM] + l * 128 + (lane & 15) * 8;
    const f32x4 g0 = *(const f32x4*)g, g1 = *(const f32x4*)(g + 4);
    const int nit = MROWS * 2, stride = gridDim.x * 8;
    for (int it = blockIdx.x * 8 + wave; it < nit; it += 2 * stride) {
        const int it1 = it + stride; const bool two = it1 < nit;
        const size_t off0 = (size_t)it * 512 + lane * 8, off1 = (size_t)(two ? it1 : it) * 512 + lane * 8;
        const u32x4 f0 = *(const u32x4*)(OF + off0), b0 = *(const u32x4*)(OB + off0), z0 = *(const u32x4*)(SZ + off0);
        const u32x4 f1 = *(const u32x4*)(OF + off1), b1 = *(const u32x4*)(OB + off1), z1 = *(const u32x4*)(SZ + off1);
        float x0[8], x1[8], t0[8], t1[8];
        unpack8(f0, x0); unpack8(b0, t0); unpack8(f1, x1); unpack8(b1, t1);
        float s0 = 0.f, s1 = 0.f;
#pragma unroll
        for (int j = 0; j < 8; ++j) { x0[j] += t0[j]; x1[j] += t1[j]; s0 += x0[j] * x0[j]; s1 += x1[j] * x1[j]; }
        s0 += swz_xor<1>(s0); s1 += swz_xor<1>(s1); s0 += swz_xor<2>(s0); s1 += swz_xor<2>(s1); s0 += swz_xor<4>(s0); s1 += swz_xor<4>(s1); s0 += swz_xor<8>(s0); s1 += swz_xor<8>(s1);
        const float r0 = rsqrtf(s0 * (1.0f / 128.0f) + 1e-6f), r1 = rsqrtf(s1 * (1.0f / 128.0f) + 1e-6f);
        unpack8(z0, t0); unpack8(z1, t1);
        u32x4 w0, w1;
        w0.x = pg8::cvt_pk_bf16(x0[0] * r0 * g0[0] * t0[0], x0[1] * r0 * g0[1] * t0[1]); w0.y = pg8::cvt_pk_bf16(x0[2] * r0 * g0[2] * t0[2], x0[3] * r0 * g0[3] * t0[3]);
        w0.z = pg8::cvt_pk_bf16(x0[4] * r0 * g1[0] * t0[4], x0[5] * r0 * g1[1] * t0[5]); w0.w = pg8::cvt_pk_bf16(x0[6] * r0 * g1[2] * t0[6], x0[7] * r0 * g1[3] * t0[7]);
        w1.x = pg8::cvt_pk_bf16(x1[0] * r1 * g0[0] * t1[0], x1[1] * r1 * g0[1] * t1[1]); w1.y = pg8::cvt_pk_bf16(x1[2] * r1 * g0[2] * t1[2], x1[3] * r1 * g0[3] * t1[3]);
        w1.z = pg8::cvt_pk_bf16(x1[4] * r1 * g1[0] * t1[4], x1[5] * r1 * g1[1] * t1[5]); w1.w = pg8::cvt_pk_bf16(x1[6] * r1 * g1[2] * t1[6], x1[7] * r1 * g1[3] * t1[7]);
        bf16_t* dst = junk ? junk : OF;
        *(u32x4*)(dst + off0) = w0; if (two) *(u32x4*)(dst + off1) = w1;
    }
}

DI void ph_ml_scan(const Args& a, int l, const bf16_t* Q, const bf16_t* K, const bf16_t* V, const float* GATE, bf16_t* HF, bf16_t* HB, LAS unsigned char* lds) {
    LAS bf16_t* qs = (LAS bf16_t*)lds;
    LAS bf16_t* ks = qs + 64 * 256;
    LAS float* vf = (LAS float*)(ks + 64 * 256);
    LAS float* ip = vf + 64 * 64;
    LAS float* lf = ip + 64;
    LAS float* part = lf + 64;
    LAS float* dpart = part + 1024;
    const int tid = ltid(a), e = tid & 63, dq = tid >> 6;
    for (int unit = blockIdx.x; unit < 256; unit += gridDim.x) {
        const int eq = unit & 3, d = (unit >> 2) & 1, hd = (unit >> 3) & 3, b = unit >> 5;
        const float ibias = a.in[I_MIB][(l * 2 + d) * 4 + hd], fbias = a.in[I_MFB][(l * 2 + d) * 4 + hd];
        bf16_t* HO = d ? HB : HF;
        float C[32];
#pragma unroll
        for (int j = 0; j < 32; ++j) C[j] = 0.f;
        float nn = 0.f, m = 0.f; int par = 0;
        for (int step = 0; step < 68; ++step) {
            const int cc = (step < 4) ? (d ? 3 - step : step) : (d ? 67 - step : step - 4);
            const int row0 = (step < 4) ? b * 256 + cc * 64 : CTXROWS + b * 4096 + cc * 64;
            __syncthreads();
            for (int i = tid; i < 2048; i += NT) { const int r = i >> 5, c8 = (i & 31) * 8;
                *(LAS u32x4*)(qs + r * 256 + c8) = *(const u32x4*)(Q + (size_t)(row0 + r) * 1024 + hd * 256 + c8);
                *(LAS u32x4*)(ks + r * 256 + c8) = *(const u32x4*)(K + (size_t)(row0 + r) * 1024 + hd * 256 + c8); }
            { const int r = tid >> 3, c8 = (tid & 7) * 8; float f[8]; unpack8(*(const u32x4*)(V + (size_t)(row0 + r) * 1024 + hd * 256 + eq * 64 + c8), f);
#pragma unroll
              for (int j = 0; j < 8; ++j) vf[r * 64 + c8 + j] = f[j]; }
            if (tid < 64) { const float* gp = GATE + (size_t)(row0 + tid) * 32; ip[tid] = gp[d * 4 + hd] + ibias; lf[tid] = -softplusf_(-(gp[8 + d * 4 + hd] + fbias)); }
            __syncthreads();
            for (int tt = 0; tt < 64; ++tt) {
                const int t = d ? 63 - tt : tt;
                const float it = ip[t], ft = lf[t];
                const float mn = fmaxf(ft + m, it);
                const float fdec = __expf(ft + m - mn), iw = __expf(it - mn) * 0.0625f, nrm = __expf(-mn);
                m = mn;
                const float vv = iw * vf[t * 64 + e];
                float pn = 0.f;
#pragma unroll
                for (int j8 = 0; j8 < 4; ++j8) {
                    float kk[8], qq[8];
                    unpack8(*(const LAS u32x4*)(ks + t * 256 + dq * 32 + j8 * 8), kk);
                    unpack8(*(const LAS u32x4*)(qs + t * 256 + dq * 32 + j8 * 8), qq);
#pragma unroll
                    for (int j = 0; j < 8; ++j) { const float c = fdec * C[j8 * 8 + j] + vv * kk[j]; C[j8 * 8 + j] = c; pn += c * qq[j]; }
                }
                const int dn = dq * 32 + (e & 31);
                nn = fdec * nn + iw * bf2f(ks[t * 256 + dn]);
                float pd = (e < 32) ? nn * bf2f(qs[t * 256 + dn]) : 0.f;
                pd = wave_sum(pd, e);
                part[(par * 8 + dq) * 64 + e] = pn; if (e == 0) dpart[par * 8 + dq] = pd;
                __syncthreads();
                if (dq == 0) { float num = 0.f, den = 0.f;
#pragma unroll
                    for (int q = 0; q < 8; ++q) { num += part[(par * 8 + q) * 64 + e]; den += dpart[par * 8 + q]; }
                    HO[(size_t)(row0 + t) * 1024 + hd * 256 + eq * 64 + e] = f2bf(num / fmaxf(fabsf(den), nrm)); }
                par ^= 1;
            }
        }
        __syncthreads();
    }
}
DI void ph_ml_post(const Args& a, int l, bf16_t* HF, const bf16_t* HB, const bf16_t* SO, const bf16_t* SZ) {
    const int tid = ltid(a), wave = tid >> 6, lane = tid & 63;
    const float* g = a.in[I_MNORM] + l * 256 + (lane & 31) * 8;
    const f32x4 g0 = *(const f32x4*)g, g1 = *(const f32x4*)(g + 4);
    const int nit = MROWS * 2, stride = gridDim.x * 8;
    for (int it = blockIdx.x * 8 + wave; it < nit; it += stride) {
        const size_t off = (size_t)it * 512 + lane * 8;
        const u32x4 f0 = *(const u32x4*)(HF + off), b0 = *(const u32x4*)(HB + off), o0 = *(const u32x4*)(SO + off), z0 = *(const u32x4*)(SZ + off);
        float x[8], t0[8];
        unpack8(f0, x); unpack8(b0, t0);
#pragma unroll
        for (int j = 0; j < 8; ++j) x[j] += t0[j];
        unpack8(o0, t0);
        float s0 = 0.f;
#pragma unroll
        for (int j = 0; j < 8; ++j) { x[j] *= t0[j]; s0 += x[j] * x[j]; }
        s0 += swz_xor<1>(s0); s0 += swz_xor<2>(s0); s0 += swz_xor<4>(s0); s0 += swz_xor<8>(s0); s0 += swz_xor<16>(s0);
        const float r0 = rsqrtf(s0 * (1.0f / 256.0f) + 1e-6f);
        unpack8(z0, t0);
        u32x4 w0;
        w0.x = pg8::cvt_pk_bf16(x[0] * r0 * g0[0] * t0[0], x[1] * r0 * g0[1] * t0[1]); w0.y = pg8::cvt_pk_bf16(x[2] * r0 * g0[2] * t0[2], x[3] * r0 * g0[3] * t0[3]);
        w0.z = pg8::cvt_pk_bf16(x[4] * r0 * g1[0] * t0[4], x[5] * r0 * g1[1] * t0[5]); w0.w = pg8::cvt_pk_bf16(x[6] * r0 * g1[2] * t0[6], x[7] * r0 * g1[3] * t0[7]);
        *(u32x4*)(HF + off) = w0;
    }
}

DI void ph_s5_scan(const Args& a, int l, const bf16_t* U, bf16_t* YF, bf16_t* YB, LAS unsigned char* lds) {
    const int tid = ltid(a), w = tid >> 6, p = tid & 63;
    LAS float* ub = (LAS float*)lds + w * 2304;
    LAS float* yb = ub + 1024;
    LAS float* xb = yb + 1024;
    for (int unit = blockIdx.x; unit < 128; unit += gridDim.x) {
        const int gb = unit & 7, d = (unit >> 3) & 1, b = unit >> 4, g = gb * 8 + w;
        const float stp = expf(a.in[I_SLOG][(l * 2 + d) * 64 + g]);
        const float lre = a.in[I_SLRE][((size_t)(l * 2 + d) * 64 + g) * 64 + p], lim = a.in[I_SLIM][((size_t)(l * 2 + d) * 64 + g) * 64 + p];
        const float mag = expf(lre * stp), lbr = mag * cosf(lim * stp), lbi = mag * sinf(lim * stp);
        const float dnm = lre * lre + lim * lim;
        const float fre = ((lbr - 1.0f) * lre + lbi * lim) / dnm, fim = (lbi * lre - (lbr - 1.0f) * lim) / dnm;
        float bbr[16], bbi[16];
        { const float* br = a.in[I_SBRE] + (((size_t)l * 64 + g) * 64 + p) * 16; const float* bi = a.in[I_SBIM] + (((size_t)l * 64 + g) * 64 + p) * 16;
#pragma unroll
          for (int h = 0; h < 16; ++h) { bbr[h] = fre * br[h] - fim * bi[h]; bbi[h] = fre * bi[h] + fim * br[h]; } }
        const int hh = p & 15, pt = p >> 4;
        float cr[16], ci[16];
        { const float* c0 = a.in[I_SCRE] + (((size_t)l * 64 + g) * 16 + hh) * 64 + pt * 16; const float* c1 = a.in[I_SCIM] + (((size_t)l * 64 + g) * 16 + hh) * 64 + pt * 16;
#pragma unroll
          for (int j = 0; j < 16; ++j) { cr[j] = c0[j]; ci[j] = c1[j]; } }
        bf16_t* Y = d ? YB : YF;
        float xr = 0.f, xi = 0.f; int par = 0;
        for (int step = 0; step < 68; ++step) {
            const int cc = (step < 4) ? (d ? 3 - step : step) : (d ? 67 - step : step - 4);
            const int row0 = (step < 4) ? b * 256 + cc * 64 : CTXROWS + b * 4096 + cc * 64;
            __syncthreads();
            { const bf16_t* up = U + (size_t)(row0 + p) * 1024 + g * 16; float f[8];
              unpack8(*(const u32x4*)up, f);
#pragma unroll
              for (int j = 0; j < 8; ++j) ub[p * 16 + j] = f[j];
              unpack8(*(const u32x4*)(up + 8), f);
#pragma unroll
              for (int j = 0; j < 8; ++j) ub[p * 16 + 8 + j] = f[j]; }
            __syncthreads();
            for (int tt = 0; tt < 64; ++tt) {
                const int t = d ? 63 - tt : tt;
                float bur = 0.f, bui = 0.f;
#pragma unroll
                for (int h4 = 0; h4 < 4; ++h4) { const f32x4 u = *(const LAS f32x4*)(ub + t * 16 + h4 * 4);
#pragma unroll
                    for (int j = 0; j < 4; ++j) { bur += bbr[h4 * 4 + j] * u[j]; bui += bbi[h4 * 4 + j] * u[j]; } }
                const float nxr = lbr * xr - lbi * xi + bur, nxi = lbr * xi + lbi * xr + bui;
                xr = nxr; xi = nxi;
                xb[par * 128 + p] = xr; xb[par * 128 + 64 + p] = xi;
                __syncthreads();
                float y = 0.f;
#pragma unroll
                for (int j4 = 0; j4 < 4; ++j4) { const f32x4 vr = *(const LAS f32x4*)(xb + par * 128 + pt * 16 + j4 * 4), vi = *(const LAS f32x4*)(xb + par * 128 + 64 + pt * 16 + j4 * 4);
#pragma unroll
                    for (int j = 0; j < 4; ++j) y += cr[j4 * 4 + j] * vr[j] - ci[j4 * 4 + j] * vi[j]; }
                y += shx(y, 16, p); y += shx(y, 32, p);
                if (p < 16) yb[t * 16 + p] = y;
                par ^= 1;
            }
            __syncthreads();
            { u32x4 w0, w1; const LAS float* ys = yb + p * 16;
              w0.x = pg8::cvt_pk_bf16(ys[0], ys[1]); w0.y = pg8::cvt_pk_bf16(ys[2], ys[3]); w0.z = pg8::cvt_pk_bf16(ys[4], ys[5]); w0.w = pg8::cvt_pk_bf16(ys[6], ys[7]);
              w1.x = pg8::cvt_pk_bf16(ys[8], ys[9]); w1.y = pg8::cvt_pk_bf16(ys[10], ys[11]); w1.z = pg8::cvt_pk_bf16(ys[12], ys[13]); w1.w = pg8::cvt_pk_bf16(ys[14], ys[15]);
              bf16_t* yp = Y + (size_t)(row0 + p) * 1024 + g * 16; *(u32x4*)yp = w0; *(u32x4*)(yp + 8) = w1; }
        }
        __syncthreads();
    }
}
DI void ph_s5_post(const Args& a, int l, bf16_t* YF, const bf16_t* YB, const bf16_t* U) {
    const float* dsk = a.in[I_SD] + l * 1024;
    for (size_t i = (size_t)blockIdx.x * NT + ltid(a); i < (size_t)MROWS * 128; i += (size_t)gridDim.x * NT) {
        const size_t off = i * 8; const int c = (int)(off & 1023);
        float f[8], bq[8], u[8]; unpack8(*(const u32x4*)(YF + off), f); unpack8(*(const u32x4*)(YB + off), bq); unpack8(*(const u32x4*)(U + off), u);
        const f32x4 d0 = *(const f32x4*)(dsk + c), d1 = *(const f32x4*)(dsk + c + 4);
        float o[8];
#pragma unroll
        for (int j = 0; j < 4; ++j) { o[j] = gelu_tanh_(f[j] + bq[j] + d0[j] * u[j]); o[4 + j] = gelu_tanh_(f[4 + j] + bq[4 + j] + d1[j] * u[4 + j]); }
        u32x4 w; w.x = pg8::cvt_pk_bf16(o[0], o[1]); w.y = pg8::cvt_pk_bf16(o[2], o[3]); w.z = pg8::cvt_pk_bf16(o[4], o[5]); w.w = pg8::cvt_pk_bf16(o[6], o[7]);
        *(u32x4*)(YF + off) = w;
    }
}

constexpr int S5_T = 16, S5_NCH = MROWS / S5_T  , S5_RG = 2304, S5_PMG = S5_RG / 256;
constexpr size_t SZ_AX = (size_t)64 * S5_RG * 512 * 2, SZ_CW1 = (size_t)64 * 256 * 256 * 2, SZ_CW2 = (size_t)64 * 256 * 512 * 2;
constexpr size_t R5_AX = 0, R5_SZ = R_OB, R5_G1 = R_M5, R5_GLUA = R_M5 + SZ_ACT;
static_assert(SZ_AX <= 3 * SZ_ACT, "S5 chunk rows fit the q|k|v tensors"); static_assert(WS_END <= (size_t)940 * 1000 * 1000, "workspace budget");
static_assert(SZ_CW1 + SZ_CW2 + (size_t)17 * 1024 * 128 * 4 <= SZ_ACT, "S5 constants live in the H region once the last projection from H is done");

struct EpiS1 {
    static constexpr bool PERM = true, AFTER_DRAIN = false;
    bf16_t* AX; bf16_t* SZ; bf16_t* G1;
    __device__ __forceinline__ void operator()(const f32x4 (&acc)[2][2][4][2], const Unit& u, int wr, int wc, int fr, int fq) const {
        const int row0 = u.pm * 256 + wr * 64 + fr, seg = u.pn >> 2;
        const int col0 = (u.pn & 3) * 256 + wc * 32 + 8 * fq;
#pragma unroll
        for (int ai = 0; ai < 2; ++ai)
#pragma unroll
            for (int m = 0; m < 4; ++m) {
                const int r = row0 + ai * 128 + m * 16;
#pragma unroll
                for (int bj = 0; bj < 2; ++bj) {
                    f32x4 v0 = acc[ai][bj][m][0], v1 = acc[ai][bj][m][1];
                    const int c = col0 + bj * 128;
                    bf16_t* dp;
                    if (seg == 0) dp = AX + ((size_t)(c >> 4) * S5_RG + (r >> 4)) * 512 + (r & 15) * 16 + (c & 15);
                    else if (seg == 1) { dp = SZ + (size_t)r * 1024 + c;
#pragma unroll
                        for (int j = 0; j < 4; ++j) { v0[j] = siluf_(v0[j]); v1[j] = siluf_(v1[j]); } }
                    else { dp = G1 + (size_t)r * 1024 + c;
#pragma unroll
                        for (int j = 0; j < 4; ++j) { v0[j] = sigmoidf_(v0[j]); v1[j] = sigmoidf_(v1[j]); } }
                    u32x4 w; w.x = pg8::cvt_pk_bf16(v0[0], v0[1]); w.y = pg8::cvt_pk_bf16(v0[2], v0[3]); w.z = pg8::cvt_pk_bf16(v1[0], v1[1]); w.w = pg8::cvt_pk_bf16(v1[2], v1[3]);
                    *(u32x4*)dp = w;
                }
            }
    }
};
struct EpiS5L {
    static constexpr bool PERM = true, AFTER_DRAIN = false;
    bf16_t* AX;
    __device__ __forceinline__ void operator()(const f32x4 (&acc)[2][2][4][2], const Unit& u, int wr, int wc, int fr, int fq) const {
        const int g = u.pm / S5_PMG, rg0 = (u.pm % S5_PMG) * 256 + wr * 64 + fr, col0 = wc * 32 + 8 * fq;
#pragma unroll
        for (int ai = 0; ai < 2; ++ai)
#pragma unroll
            for (int m = 0; m < 4; ++m) {
                const int rg = rg0 + ai * 128 + m * 16;
                if (rg < S5_NCH) {
                    bf16_t* rp = AX + ((size_t)g * S5_RG + rg) * 512 + 256 + col0;
#pragma unroll
                    for (int bj = 0; bj < 2; ++bj) { const f32x4 v0 = acc[ai][bj][m][0], v1 = acc[ai][bj][m][1];
                        u32x4 w; w.x = pg8::cvt_pk_bf16(v0[0], v0[1]); w.y = pg8::cvt_pk_bf16(v0[2], v0[3]); w.z = pg8::cvt_pk_bf16(v1[0], v1[1]); w.w = pg8::cvt_pk_bf16(v1[2], v1[3]);
                        *(u32x4*)(rp + bj * 128) = w; }
                }
            }
    }
};
struct EpiS5Y {
    static constexpr bool PERM = true, AFTER_DRAIN = false;
    const bf16_t* AX; bf16_t* GLUA; const float* dsk;
    __device__ __forceinline__ void operator()(const f32x4 (&acc)[2][2][4][2], const Unit& u, int wr, int wc, int fr, int fq) const {
        const int g = u.pm / S5_PMG, rg0 = (u.pm % S5_PMG) * 256 + wr * 64 + fr, col0 = wc * 32 + 8 * fq;
        const int h0 = col0 & 15;
        const f32x4 d0 = *(const f32x4*)(dsk + g * 16 + h0), d1 = *(const f32x4*)(dsk + g * 16 + h0 + 4);
#pragma unroll
        for (int ai = 0; ai < 2; ++ai)
#pragma unroll
            for (int m = 0; m < 4; ++m) {
                const int rg = rg0 + ai * 128 + m * 16;
                if (rg < S5_NCH) {
#pragma unroll
                    for (int bj = 0; bj < 2; ++bj) {
                        const int c = col0 + bj * 128, t = c >> 4;
                        float uu[8]; unpack8(*(const u32x4*)(AX + ((size_t)g * S5_RG + rg) * 512 + c), uu);
                        const f32x4 v0 = acc[ai][bj][m][0], v1 = acc[ai][bj][m][1];
                        float o[8];
#pragma unroll
                        for (int j = 0; j < 4; ++j) { o[j] = gelu_tanh_(v0[j] + d0[j] * uu[j]); o[4 + j] = gelu_tanh_(v1[j] + d1[j] * uu[4 + j]); }
                        u32x4 w; w.x = pg8::cvt_pk_bf16(o[0], o[1]); w.y = pg8::cvt_pk_bf16(o[2], o[3]); w.z = pg8::cvt_pk_bf16(o[4], o[5]); w.w = pg8::cvt_pk_bf16(o[6], o[7]);
                        *(u32x4*)(GLUA + (size_t)(rg * 16 + t) * 1024 + g * 16 + h0) = w;
                    }
                }
            }
    }
};
DI void ph_s5_consts(const Args& a, int l, bf16_t* CW1, bf16_t* CW2, LAS unsigned char* lds) {
    LAS float* POW = (LAS float*)lds;
    LAS float* BB = POW + 2 * 17 * 64 * 2;
    LAS float* CC = BB + 2 * 64 * 16 * 2;
    LAS float* KT = CC + 16 * 64 * 2;
    const int tid = ltid(a);
    for (int unit = blockIdx.x; unit < 256; unit += gridDim.x) {
        const int g = unit >> 2, q4 = unit & 3;
        __syncthreads();
        for (int i = tid; i < 2 * 17 * 64; i += NT) {
            const int p = i & 63, j = (i >> 6) % 17, d = i / (17 * 64);
            const float stp = expf(a.in[I_SLOG][(l * 2 + d) * 64 + g]);
            const float lre = a.in[I_SLRE][((size_t)(l * 2 + d) * 64 + g) * 64 + p], lim = a.in[I_SLIM][((size_t)(l * 2 + d) * 64 + g) * 64 + p];
            const float mag = expf((float)j * lre * stp), ang = (float)j * (lim * stp);
            POW[i * 2] = mag * cosf(ang); POW[i * 2 + 1] = mag * sinf(ang);
        }
        for (int i = tid; i < 16 * 64; i += NT) { const int p = i & 63, h = i >> 6;
            CC[i * 2] = a.in[I_SCRE][(((size_t)l * 64 + g) * 16 + h) * 64 + p]; CC[i * 2 + 1] = a.in[I_SCIM][(((size_t)l * 64 + g) * 16 + h) * 64 + p]; }
        __syncthreads();
        for (int i = tid; i < 2 * 64 * 16; i += NT) {
            const int h = i & 15, p = (i >> 4) & 63, d = i >> 10;
            const float stp = expf(a.in[I_SLOG][(l * 2 + d) * 64 + g]);
            const float lre = a.in[I_SLRE][((size_t)(l * 2 + d) * 64 + g) * 64 + p], lim = a.in[I_SLIM][((size_t)(l * 2 + d) * 64 + g) * 64 + p];
            const float lbr = POW[((d * 17 + 1) * 64 + p) * 2], lbi = POW[((d * 17 + 1) * 64 + p) * 2 + 1];
            const float dnm = lre * lre + lim * lim;
            const float fre = ((lbr - 1.0f) * lre + lbi * lim) / dnm, fim = (lbi * lre - (lbr - 1.0f) * lim) / dnm;
            const float br = a.in[I_SBRE][(((size_t)l * 64 + g) * 64 + p) * 16 + h], bi = a.in[I_SBIM][(((size_t)l * 64 + g) * 64 + p) * 16 + h];
            BB[i * 2] = fre * br - fim * bi; BB[i * 2 + 1] = fre * bi + fim * br;
        }
        __syncthreads();
        { const int hp = tid & 15, hl = (tid >> 4) & 3, d = (tid >> 6) & 1, tg = tid >> 7, h = 4 * q4 + hl;
          float kt[4];
#pragma unroll
          for (int tt = 0; tt < 4; ++tt) kt[tt] = 0.f;
          for (int p = 0; p < 64; ++p) {
              const float cr = CC[(h * 64 + p) * 2], ci = CC[(h * 64 + p) * 2 + 1];
              const float br = BB[((d * 64 + p) * 16 + hp) * 2], bi = BB[((d * 64 + p) * 16 + hp) * 2 + 1];
              const float gr = cr * br - ci * bi, gi = cr * bi + ci * br;
#pragma unroll
              for (int tt = 0; tt < 4; ++tt) { const int tau = tg * 4 + tt; const float pr = POW[((d * 17 + tau) * 64 + p) * 2], pi = POW[((d * 17 + tau) * 64 + p) * 2 + 1]; kt[tt] += gr * pr - gi * pi; } }
#pragma unroll
          for (int tt = 0; tt < 4; ++tt) KT[((d * 16 + tg * 4 + tt) * 4 + hl) * 16 + hp] = kt[tt]; }
        __syncthreads();
        bf16_t* c1 = CW1 + (size_t)g * 65536;
        for (int i = tid; i < 64 * 128; i += NT) {
            const int k = (i & 127) * 2, nl = i >> 7; const int p = 16 * q4 + (nl & 15), ri = (nl >> 4) & 1, d = nl >> 5, n = d * 128 + ri * 64 + p, s = k >> 4, hp = k & 15;
            const int j = d ? s : 15 - s;
            const float pr = POW[((d * 17 + j) * 64 + p) * 2], pi = POW[((d * 17 + j) * 64 + p) * 2 + 1];
            float o[2];
#pragma unroll
            for (int q = 0; q < 2; ++q) { const float br = BB[((d * 64 + p) * 16 + hp + q) * 2], bi = BB[((d * 64 + p) * 16 + hp + q) * 2 + 1]; o[q] = ri ? (pr * bi + pi * br) : (pr * br - pi * bi); }
            *(unsigned*)(c1 + (size_t)n * 256 + k) = pg8::cvt_pk_bf16(o[0], o[1]);
        }
        bf16_t* c2 = CW2 + (size_t)g * 131072;
        for (int i = tid; i < 64 * 256; i += NT) {
            const int k = (i & 255) * 2, nl = i >> 8; const int t = nl >> 2, hl = nl & 3, h = 4 * q4 + hl, n = t * 16 + h;
            float o[2];
            if (k < 256) { const int s = k >> 4, hp = k & 15;
#pragma unroll
                for (int q = 0; q < 2; ++q) { float v = 0.f; if (s <= t) v += KT[((0 * 16 + (t - s)) * 4 + hl) * 16 + hp + q]; if (s >= t) v += KT[((1 * 16 + (s - t)) * 4 + hl) * 16 + hp + q]; o[q] = v; } }
            else { const int kk = k - 256, d = kk >> 7, ri = (kk >> 6) & 1; const int j = d ? 16 - t : t + 1;
#pragma unroll
                for (int q = 0; q < 2; ++q) { const int p = (kk & 63) + q; const float cr = CC[(h * 64 + p) * 2], ci = CC[(h * 64 + p) * 2 + 1];
                    const float pr = POW[((d * 17 + j) * 64 + p) * 2], pi = POW[((d * 17 + j) * 64 + p) * 2 + 1];
                    o[q] = ri ? -(cr * pi + ci * pr) : (cr * pr - ci * pi); } }
            *(unsigned*)(c2 + (size_t)n * 512 + k) = pg8::cvt_pk_bf16(o[0], o[1]);
        }
    }
    __syncthreads();
}
DI int s5_row(int b, int d, int st) { const int cc = (st < 16) ? (d ? 15 - st : st) : (d ? 271 - st : st - 16); return (st < 16) ? b * 16 + cc : 128 + b * 256 + cc; }
DI void s5_lane_consts(const Args& a, int l, int d, int g, int p, float& ar, float& ai) {
    const float stp = expf(a.in[I_SLOG][(l * 2 + d) * 64 + g]);
    const float lre = a.in[I_SLRE][((size_t)(l * 2 + d) * 64 + g) * 64 + p], lim = a.in[I_SLIM][((size_t)(l * 2 + d) * 64 + g) * 64 + p];
    const float mag = expf(16.0f * lre * stp), ang = 16.0f * (lim * stp);
    ar = mag * cosf(ang); ai = mag * sinf(ang);
}
DI void ph_s5_carry1(const Args& a, int l, bf16_t* AX, float* SEG) {
    const int tid = ltid(a), w = tid >> 6, p = tid & 63;
    for (int item = blockIdx.x * 8 + w; item < 17 * 1024; item += gridDim.x * 8) {
        const int unit = item & 1023, seg = item >> 10, d = unit & 1, g = (unit >> 1) & 63, b = unit >> 7;
        float ar, ai; s5_lane_consts(a, l, d, g, p, ar, ai);
        bf16_t* base = AX + (size_t)g * S5_RG * 512 + 256 + d * 128 + p;
        float lr[16], li[16];
#pragma unroll
        for (int q = 0; q < 16; ++q) { const size_t o = (size_t)s5_row(b, d, seg * 16 + q) * 512; lr[q] = bf2f(base[o]); li[q] = bf2f(base[o + 64]); }
        float xr = 0.f, xi = 0.f;
#pragma unroll
        for (int q = 0; q < 16; ++q) { const size_t o = (size_t)s5_row(b, d, seg * 16 + q) * 512;
            base[o] = f2bf(xr); base[o + 64] = f2bf(xi);
            const float nr = ar * xr - ai * xi + lr[q], ni = ar * xi + ai * xr + li[q]; xr = nr; xi = ni; }
        SEG[((size_t)seg * 1024 + unit) * 128 + p] = xr; SEG[((size_t)seg * 1024 + unit) * 128 + 64 + p] = xi;
    }
}
DI void ph_s5_carry2(const Args& a, int l, bf16_t* AX, const float* SEG) {
    const int tid = ltid(a), w = tid >> 6, p = tid & 63;
    for (int item = blockIdx.x * 8 + w; item < 16 * 1024; item += gridDim.x * 8) {
        const int unit = item & 1023, seg = 1 + (item >> 10), d = unit & 1, g = (unit >> 1) & 63, b = unit >> 7;
        float ar, ai; s5_lane_consts(a, l, d, g, p, ar, ai);
        float sr = ar, si = ai;
#pragma unroll
        for (int q = 0; q < 4; ++q) { const float nr = sr * sr - si * si, ni = 2.0f * sr * si; sr = nr; si = ni; }
        float xr = 0.f, xi = 0.f;
        { float er[16], ei[16];
#pragma unroll
          for (int s2 = 0; s2 < 16; ++s2) { const bool on = s2 < seg; er[s2] = on ? SEG[((size_t)s2 * 1024 + unit) * 128 + p] : 0.f; ei[s2] = on ? SEG[((size_t)s2 * 1024 + unit) * 128 + 64 + p] : 0.f; }
#pragma unroll
          for (int s2 = 0; s2 < 16; ++s2) if (s2 < seg) { const float nr = sr * xr - si * xi + er[s2], ni = sr * xi + si * xr + ei[s2]; xr = nr; xi = ni; } }
        bf16_t* base = AX + (size_t)g * S5_RG * 512 + 256 + d * 128 + p;
        float lr[16], li[16];
#pragma unroll
        for (int q = 0; q < 16; ++q) { const size_t o = (size_t)s5_row(b, d, seg * 16 + q) * 512; lr[q] = bf2f(base[o]); li[q] = bf2f(base[o + 64]); }
#pragma unroll
        for (int q = 0; q < 16; ++q) { const size_t o = (size_t)s5_row(b, d, seg * 16 + q) * 512;
            base[o] = f2bf(lr[q] + xr); base[o + 64] = f2bf(li[q] + xi);
            const float nr = ar * xr - ai * xi, ni = ar * xi + ai * xr; xr = nr; xi = ni; }
    }
}

#ifndef SUBDUP
#define SUBDUP 0
#endif
typedef short bf16x8v __attribute__((ext_vector_type(8)));
typedef short s16x4v __attribute__((ext_vector_type(4)));
typedef __bf16 bfx2_t __attribute__((ext_vector_type(2)));
typedef float f32x2_t __attribute__((ext_vector_type(2)));
#define MFMA16(a_, b_, c_) __builtin_amdgcn_mfma_f32_16x16x32_bf16((a_), (b_), (c_), 0, 0, 0)
DI unsigned pk2(float lo, float hi) { const bfx2_t v = __builtin_convertvector((f32x2_t){lo, hi}, bfx2_t); return __builtin_bit_cast(unsigned, v); }
DI int sw512(int r, int cb) { return r * 512 + (cb ^ ((r & 15) << 4)); }
DI int sw128(int r, int cb) { return r * 128 + (cb ^ ((r & 7) << 4)); }
DI bf16x8v ldsfrag(LAS unsigned char* base, int off) { return *(const LAS bf16x8v*)(base + off); }
DI bf16x8v ldsfrag2(LAS unsigned char* base, int off0, int off1) { const s16x4v lo = *(const LAS s16x4v*)(base + off0), hi = *(const LAS s16x4v*)(base + off1); return __builtin_shufflevector(lo, hi, 0, 1, 2, 3, 4, 5, 6, 7); }
constexpr int ML_GSET = 448;
DI void ml_gates(float igr, float fgr, float ibias, float fbias, int d, float& ms, LAS float* gs, int L) {
    asm volatile("" : "+v"(L));
    const int t = d ? 63 - L : L;
    const float ipv = igr + ibias, lfv = -softplusf_(-(fgr + fbias));
    const float bc = dpp_scan_sum(lfv);
    const float aj = ipv - bc;
    const float cm = dpp_scan_max(aj);
    const float mt = fmaxf(bc + ms, bc + cm);
    const float bend = lane63(bc);
    const float le = bend - bc + ipv;
    const float mle = lane63(dpp_scan_max(le));
    const float mnew = fmaxf(bend + ms, mle);
    gs[t] = bc; gs[64 + t] = aj; gs[128 + t] = mt; gs[192 + t] = __expf(bc + ms - mt); gs[256 + t] = __expf(-mt); gs[320 + t] = __expf(le - mnew) * 0.0625f;
    if (L == 0) gs[384] = __expf(bend + ms - mnew);
    ms = mnew;
}
DI bf16x8v ldstr2(LAS unsigned char* p0, LAS unsigned char* p1) {
    const s16x4v lo = __builtin_amdgcn_ds_read_tr16_b64_v4i16((LAS s16x4v*)p0), hi = __builtin_amdgcn_ds_read_tr16_b64_v4i16((LAS s16x4v*)p1);
    return __builtin_shufflevector(lo, hi, 0, 1, 2, 3, 4, 5, 6, 7); }
DI void ph_ml_scan_mfma(const Args& a, int l, const bf16_t* Q, const bf16_t* K, const bf16_t* V, const float* GATE, bf16_t* HF, bf16_t* HB, LAS unsigned char* lds) {
    constexpr int PQ = 528, PK = 544, PV = 160, PW = 144;
    LAS unsigned char* qs = lds;
    LAS unsigned char* kn = lds + 33792;
    LAS unsigned char* vn = lds + 68608;
    LAS unsigned char* vs = lds + 78848;
    LAS unsigned char* Wm = lds + 89088;
    LAS float* sm = (LAS float*)(lds + 98304);
    LAS float* rsW = sm + 2 * ML_GSET; LAS float* qn = rsW + 128; LAS float* nvec = qn + 128;
    const int tid = ltid(a), w = tid >> 6, ln = tid & 63, l16 = ln & 15, h4 = ln >> 4, tq = (ln & 15) >> 2, tp = ln & 3;
    for (int unit = blockIdx.x; unit < 256; unit += gridDim.x) {
        const int eh = unit & 3, d = (unit >> 2) & 1, hd = (unit >> 3) & 3, b = unit >> 5;
        const float ibias = a.in[I_MIB][(l * 2 + d) * 4 + hd], fbias = a.in[I_MFB][(l * 2 + d) * 4 + hd];
        bf16_t* HO = d ? HB : HF;
        f32x4 Cacc[16];
#pragma unroll
        for (int i = 0; i < 16; ++i) Cacc[i] = (f32x4){0.f, 0.f, 0.f, 0.f};
        float ms = 0.f;
        __syncthreads();
        if (tid < 256) nvec[tid] = 0.f;
#define ML_ROW0(step) (((step) < 4) ? b * 256 + (d ? 3 - (step) : (step)) * 64 : CTXROWS + b * 4096 + (d ? 67 - (step) : (step) - 4) * 64)
        u32x4 pq[4], pk[4], pv[1]; float gi = 0.f, gf = 0.f;
        { const int row0 = ML_ROW0(0);
#pragma unroll
          for (int q = 0; q < 4; ++q) { const int p = tid + 512 * q, r = p >> 5, c8 = p & 31; pq[q] = *(const u32x4*)(Q + (size_t)(row0 + r) * 1024 + hd * 256 + c8 * 8); pk[q] = *(const u32x4*)(K + (size_t)(row0 + r) * 1024 + hd * 256 + c8 * 8); }
#pragma unroll
          for (int q = 0; q < 1; ++q) { const int r = tid >> 3, c8 = tid & 7; pv[q] = *(const u32x4*)(V + (size_t)(row0 + r) * 1024 + hd * 256 + eh * 64 + c8 * 8); }
          if (w == 7) { const int t = d ? 63 - ln : ln; const float* gp = GATE + (size_t)(row0 + t) * 32; gi = gp[d * 4 + hd]; gf = gp[8 + d * 4 + hd]; ml_gates(gi, gf, ibias, fbias, d, ms, sm, ln); } }
        __syncthreads();
        for (int step = 0; step < 68; ++step) {
            const int par = step & 1; LAS float* gs = sm + par * ML_GSET;
            const int row0 = ML_ROW0(step);
            for (int sr_ = 0; sr_ < (SUBDUP == 12 ? 2 : 1); ++sr_) {
#pragma unroll
            for (int q = 0; q < 4; ++q) { const int p = tid + 512 * q, r = p >> 5, c8 = p & 31;
                *(LAS u32x4*)(qs + r * PQ + c8 * 16) = pq[q]; *(LAS u32x4*)(kn + r * PK + c8 * 16) = pk[q]; }
#pragma unroll
            for (int q = 0; q < 1; ++q) { const int r = tid >> 3, c8 = tid & 7;
                *(LAS u32x4*)(vn + r * PV + c8 * 16) = pv[q];
                float f[8]; unpack8(pv[q], f); const float ws = gs[320 + r];
                u32x4 o; o.x = pk2(f[0] * ws, f[1] * ws); o.y = pk2(f[2] * ws, f[3] * ws); o.z = pk2(f[4] * ws, f[5] * ws); o.w = pk2(f[6] * ws, f[7] * ws);
                *(LAS u32x4*)(vs + r * PV + c8 * 16) = o; }
            }
            if (step + 1 < 68) { const int rown = ML_ROW0(step + 1);
#pragma unroll
                for (int q = 0; q < 4; ++q) { const int p = tid + 512 * q, r = p >> 5, c8 = p & 31; pq[q] = *(const u32x4*)(Q + (size_t)(rown + r) * 1024 + hd * 256 + c8 * 8); pk[q] = *(const u32x4*)(K + (size_t)(rown + r) * 1024 + hd * 256 + c8 * 8); }
#pragma unroll
                for (int q = 0; q < 1; ++q) { const int r = tid >> 3, c8 = tid & 7; pv[q] = *(const u32x4*)(V + (size_t)(rown + r) * 1024 + hd * 256 + eh * 64 + c8 * 8); }
                if (w == 7) { const int t = d ? 63 - ln : ln; const float* gp = GATE + (size_t)(rown + t) * 32; gi = gp[d * 4 + hd]; gf = gp[8 + d * 4 + hd]; } }
            lds_barrier();
            for (int sr_ = 0; sr_ < (SUBDUP == 11 ? 2 : 1); ++sr_) { const int it = w >> 1, jp = w & 1, i = it * 16 + l16;
              f32x4 a0 = (f32x4){0.f, 0.f, 0.f, 0.f}, a1 = a0;
              LAS unsigned char* qb = qs + (it * 16 + l16) * PQ + h4 * 16; LAS unsigned char* kb = kn + ((2 * jp) * 16 + l16) * PK + h4 * 16;
              f32x4 qacc = (f32x4){0.f, 0.f, 0.f, 0.f};
#pragma unroll
              for (int ks = 0; ks < 8; ++ks) {
                  const bf16x8v bq = ldsfrag(qb, ks * 64);
                  const bf16x8v k0 = ldsfrag(kb, ks * 64), k1 = ldsfrag(kb, 16 * PK + ks * 64);
                  a0 = MFMA16(k0, bq, a0); a1 = MFMA16(k1, bq, a1);
                  if ((ks >> 2) == jp) {
                      const f32x4 n0 = *(const LAS f32x4*)(nvec + 32 * ks + 8 * h4), n1 = *(const LAS f32x4*)(nvec + 32 * ks + 8 * h4 + 4);
                      u32x4 nw; nw.x = pk2(n0[0], n0[1]); nw.y = pk2(n0[2], n0[3]); nw.z = pk2(n1[0], n1[1]); nw.w = pk2(n1[2], n1[3]);
                      qacc = MFMA16(bq, __builtin_bit_cast(bf16x8v, nw), qacc); } }
              if (l16 == 0) *(LAS f32x4*)(qn + jp * 64 + it * 16 + 4 * h4) = qacc;
              const float bci = gs[i], mti = gs[128 + i];
              float rs = 0.f;
#pragma unroll
              for (int t2 = 0; t2 < 2; ++t2) { const int j0 = (2 * jp + t2) * 16 + 4 * h4; const f32x4 ajv = *(const LAS f32x4*)(gs + 64 + j0); const f32x4 av = t2 ? a1 : a0;
                  float wv[4];
#pragma unroll
                  for (int r = 0; r < 4; ++r) { const int j = j0 + r; const bool valid = d ? (j >= i) : (j <= i); const float e = __expf(bci + ajv[r] - mti) * av[r] * 0.0625f; wv[r] = valid ? e : 0.f; rs += wv[r]; }
                  u32x2 pw; pw.x = pk2(wv[0], wv[1]); pw.y = pk2(wv[2], wv[3]);
                  *(LAS u32x2*)(Wm + i * PW + j0 * 2) = pw; }
              int lnl = ln; asm volatile("" : "+v"(lnl)); rs += shx(rs, 16, lnl); rs += shx(rs, 32, lnl);
              if (h4 == 0) rsW[jp * 64 + i] = rs;
            }
            lds_barrier();
            if (w < 4) { f32x4 num[4];
#pragma unroll
              for (int it = 0; it < 4; ++it) num[it] = (f32x4){0.f, 0.f, 0.f, 0.f};
              LAS unsigned char* qb2 = qs + l16 * PQ + 8 * h4;
              { bf16x8v af[4];
#pragma unroll
                for (int it = 0; it < 4; ++it) af[it] = ldsfrag2(qb2, it * 16 * PQ, it * 16 * PQ + 32);
#pragma unroll
                for (int ks = 0; ks < 8; ++ks) {
                    u32x4 bw; bw.x = pk2(Cacc[2 * ks][0], Cacc[2 * ks][1]); bw.y = pk2(Cacc[2 * ks][2], Cacc[2 * ks][3]); bw.z = pk2(Cacc[2 * ks + 1][0], Cacc[2 * ks + 1][1]); bw.w = pk2(Cacc[2 * ks + 1][2], Cacc[2 * ks + 1][3]);
                    const bf16x8v bfr = __builtin_bit_cast(bf16x8v, bw);
                    bf16x8v nf[4];
#pragma unroll
                    for (int it = 0; it < 4; ++it) nf[it] = (ks + 1 < 8) ? ldsfrag2(qb2, it * 16 * PQ + 64 * (ks + 1), it * 16 * PQ + 64 * (ks + 1) + 32) : af[it];
#pragma unroll
                    for (int it = 0; it < 4; ++it) num[it] = MFMA16(af[it], bfr, num[it]);
#pragma unroll
                    for (int it = 0; it < 4; ++it) af[it] = nf[it];
                    asm volatile("" ::: "memory"); } }
#pragma unroll
              for (int it = 0; it < 4; ++it) { const f32x4 wi = *(const LAS f32x4*)(gs + 192 + it * 16 + 4 * h4); num[it] = num[it] * wi; }
              LAS unsigned char* trb = (LAS unsigned char*)0 + (8 * h4 + tq) * PV + 8 * tp + 32 * w;
              bf16x8v bv[2];
#pragma unroll
              for (int kk = 0; kk < 2; ++kk) bv[kk] = ldstr2(vn + (size_t)trb + (32 * kk) * PV, vn + (size_t)trb + (32 * kk + 4) * PV);
              LAS unsigned char* wb = Wm + l16 * PW + 16 * h4;
#pragma unroll
              for (int kk = 0; kk < 2; ++kk)
#pragma unroll
                  for (int it = 0; it < 4; ++it) { const bf16x8v aw = ldsfrag(wb, it * 16 * PW + 64 * kk); num[it] = MFMA16(aw, bv[kk], num[it]); }
              asm volatile("" ::: "memory");
#pragma unroll
              for (int it = 0; it < 4; ++it) { const int i0 = it * 16 + 4 * h4;
                  const f32x4 r0 = *(const LAS f32x4*)(rsW + i0), r1 = *(const LAS f32x4*)(rsW + 64 + i0), wi = *(const LAS f32x4*)(gs + 192 + i0), qv = *(const LAS f32x4*)(qn + i0) + *(const LAS f32x4*)(qn + 64 + i0), nr = *(const LAS f32x4*)(gs + 256 + i0);
#pragma unroll
                  for (int r = 0; r < 4; ++r) { const float den = r0[r] + r1[r] + wi[r] * qv[r]; const float hv = num[it][r] * __builtin_amdgcn_rcpf(fmaxf(fabsf(den), nr[r]));
                      HO[(size_t)(row0 + i0 + r) * 1024 + hd * 256 + eh * 64 + 16 * w + l16] = (bf16_t)(pk2(hv, 0.f) & 0xffffu); } asm volatile("" ::: "memory"); }
              const float decay = gs[384];
              bf16x8v bs[2];
#pragma unroll
              for (int kk = 0; kk < 2; ++kk) bs[kk] = ldstr2(vs + (size_t)trb + (32 * kk) * PV, vs + (size_t)trb + (32 * kk + 4) * PV);
#pragma unroll
              for (int dt = 0; dt < 16; ++dt) Cacc[dt] = Cacc[dt] * decay;
              LAS unsigned char* ktb = kn + (8 * h4 + tq) * PK + 8 * tp;
              { bf16x8v ak0 = ldstr2(ktb, ktb + 4 * PK), ak1 = ldstr2(ktb + 32 * PK, ktb + 36 * PK);
#pragma unroll
                for (int dt = 0; dt < 16; ++dt) {
                    bf16x8v n0 = ak0, n1 = ak1;
                    if (dt + 1 < 16) { n0 = ldstr2(ktb + 32 * (dt + 1), ktb + 4 * PK + 32 * (dt + 1)); n1 = ldstr2(ktb + 32 * PK + 32 * (dt + 1), ktb + 36 * PK + 32 * (dt + 1)); }
                    Cacc[dt] = MFMA16(ak0, bs[0], Cacc[dt]); Cacc[dt] = MFMA16(ak1, bs[1], Cacc[dt]);
                    ak0 = n0; ak1 = n1; asm volatile("" ::: "memory"); } }
            } else { const float decay = gs[384]; const int dn = tid - 256; float s = 0.f;
#pragma unroll 8
                for (int j = 0; j < 64; ++j) s += gs[320 + j] * bf2f(*(const LAS bf16_t*)(kn + j * PK + 2 * dn));
                nvec[dn] = decay * nvec[dn] + s;
                if (w == 7 && step + 1 < 68) ml_gates(gi, gf, ibias, fbias, d, ms, sm + (par ^ 1) * ML_GSET, ln); }
            lds_barrier();
        }
#undef ML_ROW0
    }
}

#ifndef SUBDUP
#define SUBDUP 0
#endif
#define MFMA16K16(a_, b_, c_) __builtin_amdgcn_mfma_f32_16x16x16bf16_1k((a_), (b_), (c_), 0, 0, 0)
DI s16x4v pack4(const f32x4 v) { u32x2 w; w.x = pk2(v[0], v[1]); w.y = pk2(v[2], v[3]); return __builtin_bit_cast(s16x4v, w); }
DI s16x4v lds8(LAS unsigned char* p) { return *(const LAS s16x4v*)p; }
DI s16x4v ldstr1(LAS unsigned char* p) { return __builtin_amdgcn_ds_read_tr16_b64_v4i16((LAS s16x4v*)p); }
constexpr int GD_GSET = 384;
DI void gdn_gates(float araw, float braw, float nea, float dtb, LAS float* gs, int L, int d) {
    asm volatile("" : "+v"(L));
    const int t = d ? 63 - L : L;
    const float gc = dpp_scan_sum(nea * softplusf_(araw + dtb));
    const float gl = lane63(gc);
    gs[t] = gc; gs[64 + t] = sigmoidf_(braw); gs[128 + t] = __expf(gc); gs[192 + t] = __expf(gl - gc);
    if (L == 0) gs[256] = __expf(gl);
}
DI void ph_gdn_scan_mfma(const Args& a, int l, const bf16_t* Q, const bf16_t* K, const bf16_t* V, const float* GATE, bf16_t* OF, bf16_t* OB, LAS unsigned char* lds) {
    constexpr int PQ = 272, PK = 288, PV = 160, PA = 144, PD = 48;
    LAS unsigned char* qh = lds;
    LAS unsigned char* kh = lds + 17408;
    LAS unsigned char* vv = lds + 35840;
    LAS unsigned char* AM = lds + 54272;
    LAS unsigned char* QM = lds + 63488;
    LAS unsigned char* DINV = lds + 72704;
    LAS float* sm = (LAS float*)(lds + 75776);
    LAS float* nAd = (LAS float*)(lds + 78848);
    const int tid = ltid(a), w = tid >> 6, ln = tid & 63, l16 = ln & 15, h4 = ln >> 4, tq = (ln & 15) >> 2, tp = ln & 3;
    for (int unit = blockIdx.x; unit < 256; unit += gridDim.x) {
        const int eh = unit & 1, d = (unit >> 1) & 1, h = (unit >> 2) & 7, b = unit >> 5;
        const float nea = -__expf(a.in[I_GALOG][(l * 2 + d) * 8 + h]), dtb = a.in[I_GDTB][(l * 2 + d) * 8 + h];
        bf16_t* O = d ? OB : OF;
        f32x4 S[8];
#pragma unroll
        for (int i = 0; i < 8; ++i) S[i] = (f32x4){0.f, 0.f, 0.f, 0.f};
#define GD_ROW0(step) (((step) < 4) ? b * 256 + (d ? 3 - (step) : (step)) * 64 : CTXROWS + b * 4096 + (d ? 67 - (step) : (step) - 4) * 64)
        u32x4 pq[2], pk[2], pv[1]; float ga = 0.f, gb = 0.f;
        __syncthreads();
        { const int row0 = GD_ROW0(0);
#pragma unroll
          for (int q = 0; q < 2; ++q) { const int p = tid + 512 * q, r = p >> 4, c8 = p & 15; const size_t go = (size_t)(row0 + r) * 1024 + h * 128 + c8 * 8;
              pq[q] = *(const u32x4*)(Q + go); pk[q] = *(const u32x4*)(K + go); }
          pv[0] = *(const u32x4*)(V + (size_t)(row0 + (tid >> 3)) * 1024 + h * 128 + eh * 64 + (tid & 7) * 8);
          if (w == 5) { const int t = d ? 63 - ln : ln; const float* gp = GATE + (size_t)(row0 + t) * 32; ga = gp[d * 8 + h]; gb = gp[16 + d * 8 + h]; gdn_gates(ga, gb, nea, dtb, sm, ln, d); } }
        __syncthreads();
        for (int step = 0; step < 68; ++step) {
            const int par = step & 1; LAS float* gs = sm + par * GD_GSET;
            const int row0 = GD_ROW0(step);
#pragma unroll
            for (int q = 0; q < 2; ++q) { const int p = tid + 512 * q, r = p >> 4, c8 = p & 15;
                *(LAS u32x4*)(qh + r * PQ + c8 * 16) = pq[q]; *(LAS u32x4*)(kh + r * PK + c8 * 16) = pk[q]; }
            *(LAS u32x4*)(vv + (tid >> 3) * PV + (tid & 7) * 16) = pv[0];
            if (step + 1 < 68) { const int rown = GD_ROW0(step + 1);
#pragma unroll
                for (int q = 0; q < 2; ++q) { const int p = tid + 512 * q, r = p >> 4, c8 = p & 15; const size_t go = (size_t)(rown + r) * 1024 + h * 128 + c8 * 8;
                    pq[q] = *(const u32x4*)(Q + go); pk[q] = *(const u32x4*)(K + go); }
                pv[0] = *(const u32x4*)(V + (size_t)(rown + (tid >> 3)) * 1024 + h * 128 + eh * 64 + (tid & 7) * 8);
                if (w == 5) { const int t = d ? 63 - ln : ln; const float* gp = GATE + (size_t)(rown + t) * 32; ga = gp[d * 8 + h]; gb = gp[16 + d * 8 + h]; } }
            lds_barrier(); if (SUBDUP == 5) lds_barrier();
            for (int sr_ = 0; sr_ < (SUBDUP == 1 ? 2 : 1); ++sr_) { const int it = w >> 1, jp = w & 1, i = it * 16 + l16;
              f32x4 kk0 = (f32x4){0.f, 0.f, 0.f, 0.f}, kk1 = kk0, qk0 = kk0, qk1 = kk0;
              LAS unsigned char* kb = kh + ((2 * jp) * 16 + l16) * PK + h4 * 16; LAS unsigned char* xk = kh + i * PK + h4 * 16; LAS unsigned char* xq = qh + i * PQ + h4 * 16;
#pragma unroll
              for (int ks = 0; ks < 4; ++ks) { const bf16x8v a0 = ldsfrag(kb, ks * 64), a1 = ldsfrag(kb, 16 * PK + ks * 64), bk = ldsfrag(xk, ks * 64), bq = ldsfrag(xq, ks * 64);
                  kk0 = MFMA16(a0, bk, kk0); kk1 = MFMA16(a1, bk, kk1); qk0 = MFMA16(a0, bq, qk0); qk1 = MFMA16(a1, bq, qk1); }
              const float gci = gs[i], bi = gs[64 + i];
#pragma unroll
              for (int t2 = 0; t2 < 2; ++t2) { const int j0 = (2 * jp + t2) * 16 + 4 * h4; const f32x4 gcj = *(const LAS f32x4*)(gs + j0); const f32x4 kkv = t2 ? kk1 : kk0, qkv = t2 ? qk1 : qk0;
                  float am[4], qm[4];
#pragma unroll
                  for (int r = 0; r < 4; ++r) { const int j = j0 + r; const bool valid = d ? (j >= i) : (j <= i); const float e = __expf(gci - gcj[r]);
                      am[r] = (valid && j != i) ? -bi * kkv[r] * e : 0.f; qm[r] = valid ? qkv[r] * e : 0.f; }
                  u32x2 pa, pm; pa.x = pk2(am[0], am[1]); pa.y = pk2(am[2], am[3]); pm.x = pk2(qm[0], qm[1]); pm.y = pk2(qm[2], qm[3]);
                  *(LAS u32x2*)(AM + i * PA + j0 * 2) = pa; *(LAS u32x2*)(QM + i * PA + j0 * 2) = pm;
                  if (2 * jp + t2 == it) { const int ipos = d ? 15 - l16 : l16;
#pragma unroll
                      for (int r = 0; r < 4; ++r) { const int jpos = d ? 15 - (4 * h4 + r) : 4 * h4 + r; nAd[(it * 16 + ipos) * 16 + jpos] = am[r]; } } } }
            lds_barrier(); if (SUBDUP == 5) lds_barrier();
            for (int sr_ = 0; sr_ < (SUBDUP == 2 ? 2 : 1); ++sr_) if (w == 4) { const int I = ln >> 4, c = ln & 15, cp = d ? 15 - c : c;
                float Dr[16];
                Dr[0] = (cp == 0) ? 1.f : 0.f;
#pragma unroll
                for (int ip = 1; ip < 16; ++ip) {
                    float av[16];
#pragma unroll
                    for (int q4 = 0; q4 < 4; ++q4) { if (q4 * 4 < ip) { const f32x4 x = *(const LAS f32x4*)(nAd + (I * 16 + ip) * 16 + q4 * 4); av[q4 * 4] = x[0]; av[q4 * 4 + 1] = x[1]; av[q4 * 4 + 2] = x[2]; av[q4 * 4 + 3] = x[3]; } }
                    float s = (cp == ip) ? 1.f : 0.f;
#pragma unroll
                    for (int jq = 0; jq < ip; ++jq) s += av[jq] * Dr[jq];
                    Dr[ip] = s; }
#pragma unroll
                for (int ip = 0; ip < 16; ++ip) { const int r = d ? 15 - ip : ip; *(LAS bf16_t*)(DINV + (16 * I + r) * PD + 2 * c) = (bf16_t)(pk2(Dr[ip], 0.f) & 0xffffu); } }
            s16x4v sf[8];
            f32x4 Rt[4], Qs[4];
            if (w < 4) {
#pragma unroll
            for (int dt = 0; dt < 8; ++dt) sf[dt] = pack4(S[dt]);
#pragma unroll
            for (int Tp = 0; Tp < 4; ++Tp) { const int ro = 16 * (d ? 3 - Tp : Tp);
                f32x4 ksv = (f32x4){0.f, 0.f, 0.f, 0.f}, qsv = ksv;
                LAS unsigned char* ka = kh + (ro + l16) * PK + 8 * h4; LAS unsigned char* qa = qh + (ro + l16) * PQ + 8 * h4;
#pragma unroll
                for (int dt = 0; dt < 8; ++dt) { ksv = MFMA16K16(lds8(ka + 32 * dt), sf[dt], ksv); qsv = MFMA16K16(lds8(qa + 32 * dt), sf[dt], qsv); }
                const s16x4v v4 = ldstr1(vv + (ro + 4 * h4 + tq) * PV + (16 * w + 4 * tp) * 2);
                const f32x4 be = *(const LAS f32x4*)(gs + 64 + ro + 4 * h4), eg = *(const LAS f32x4*)(gs + 128 + ro + 4 * h4);
#pragma unroll
                for (int r = 0; r < 4; ++r) { Rt[Tp][r] = be[r] * (bf2f((bf16_t)v4[r]) - eg[r] * ksv[r]); Qs[Tp][r] = eg[r] * qsv[r]; }
                asm volatile("" ::: "memory"); } }
            lds_barrier(); if (SUBDUP == 5) lds_barrier();
            if (w < 4) { s16x4v vf[4]; f32x4 vn[4];
#pragma unroll
              for (int Tp = 0; Tp < 4; ++Tp) { const int ro = 16 * (d ? 3 - Tp : Tp);
                  f32x4 X = Rt[Tp];
#pragma unroll
                  for (int Jp = 0; Jp < Tp; ++Jp) { const int co = 16 * (d ? 3 - Jp : Jp); X = MFMA16K16(lds8(AM + (ro + l16) * PA + (co + 4 * h4) * 2), vf[Jp], X); }
                  const s16x4v xf = pack4(X);
                  vn[Tp] = MFMA16K16(lds8(DINV + (ro + l16) * PD + 8 * h4), xf, ((f32x4){0.f, 0.f, 0.f, 0.f}));
                  vf[Tp] = pack4(vn[Tp]); }
#pragma unroll
              for (int Tp = 0; Tp < 4; ++Tp) { const int ro = 16 * (d ? 3 - Tp : Tp);
                  f32x4 o = Qs[Tp];
#pragma unroll
                  for (int Jp = 0; Jp <= Tp; ++Jp) { const int co = 16 * (d ? 3 - Jp : Jp); o = MFMA16K16(lds8(QM + (ro + l16) * PA + (co + 4 * h4) * 2), vf[Jp], o); }
#pragma unroll
                  for (int r = 0; r < 4; ++r) O[(size_t)(row0 + ro + 4 * h4 + r) * 1024 + h * 128 + eh * 64 + 16 * w + l16] = (bf16_t)(pk2(o[r], 0.f) & 0xffffu);
                  asm volatile("" ::: "memory"); }
              const float gend = gs[256];
              s16x4v vsf[4];
#pragma unroll
              for (int Jp = 0; Jp < 4; ++Jp) { const int co = 16 * (d ? 3 - Jp : Jp); const f32x4 ee = *(const LAS f32x4*)(gs + 192 + co + 4 * h4); vsf[Jp] = pack4(vn[Jp] * ee); }
#pragma unroll
              for (int dt = 0; dt < 8; ++dt) { S[dt] = S[dt] * gend;
#pragma unroll
                  for (int Jp = 0; Jp < 4; ++Jp) { const int co = 16 * (d ? 3 - Jp : Jp); S[dt] = MFMA16K16(ldstr1(kh + (co + 4 * h4 + tq) * PK + (16 * dt + 4 * tp) * 2), vsf[Jp], S[dt]); }
                  if (dt & 1) asm volatile("" ::: "memory"); } }
            for (int sr_ = 0; sr_ < (SUBDUP == 3 ? 2 : 1); ++sr_) if (w == 5 && step + 1 < 68) gdn_gates(ga, gb, nea, dtb, sm + (par ^ 1) * GD_GSET, ln, d);
            lds_barrier(); if (SUBDUP == 5) lds_barrier();
        }
#undef GD_ROW0
    }
}

DI void ph_gdn_scan_pipe(const Args& a, int l, const bf16_t* Q, const bf16_t* K, const bf16_t* V, const float* GATE, bf16_t* OF, bf16_t* OB, LAS unsigned char* lds) {
    constexpr int PQ = 272, PK = 288, PV = 160, PA = 144, PD = 48, SETB = 71680;
    constexpr int O_Q = 0, O_K = 17408, O_V = 35840, O_AM = 46080, O_QM = 55296, O_DI = 64512, O_ND = 67584;
    LAS float* sm = (LAS float*)(lds + 2 * SETB);
    const int tid = ltid(a), w = tid >> 6, ln = tid & 63, l16 = ln & 15, h4 = ln >> 4, tq = (ln & 15) >> 2, tp = ln & 3;
    const bool helper = w >= 4; const int ht = tid - 256;
    for (int unit = blockIdx.x; unit < 256; unit += gridDim.x) {
        const int eh = unit & 1, d = (unit >> 1) & 1, h = (unit >> 2) & 7, b = unit >> 5;
        const float nea = -__expf(a.in[I_GALOG][(l * 2 + d) * 8 + h]), dtb = a.in[I_GDTB][(l * 2 + d) * 8 + h];
        bf16_t* O = d ? OB : OF;
        f32x4 S[8];
#pragma unroll
        for (int i = 0; i < 8; ++i) S[i] = (f32x4){0.f, 0.f, 0.f, 0.f};
#define GD_ROW0(step) (((step) < 4) ? b * 256 + (d ? 3 - (step) : (step)) * 64 : CTXROWS + b * 4096 + (d ? 67 - (step) : (step) - 4) * 64)
        f32x4 Rt[4], Qs[4]; float ga = 0.f, gb = 0.f;
#define GD_FETCH(stp) do { const int rw_ = GD_ROW0(stp); \
        _Pragma("unroll") for (int q_ = 0; q_ < 4; ++q_) { const int p_ = ht + 256 * q_, r_ = p_ >> 4, c8_ = p_ & 15; const size_t go_ = (size_t)(rw_ + r_) * 1024 + h * 128 + c8_ * 8; S[q_] = __builtin_bit_cast(f32x4, *(const u32x4*)(Q + go_)); S[4 + q_] = __builtin_bit_cast(f32x4, *(const u32x4*)(K + go_)); } \
        _Pragma("unroll") for (int q_ = 0; q_ < 2; ++q_) { const int p_ = ht + 256 * q_, r_ = p_ >> 3, c8_ = p_ & 7; Qs[q_] = __builtin_bit_cast(f32x4, *(const u32x4*)(V + (size_t)(rw_ + r_) * 1024 + h * 128 + eh * 64 + c8_ * 8)); } \
        if (w == 5) { const int t_ = d ? 63 - ln : ln; const float* gp_ = GATE + (size_t)(rw_ + t_) * 32; ga = gp_[d * 8 + h]; gb = gp_[16 + d * 8 + h]; } } while (0)
#define GD_STAGE(setb) do { \
        _Pragma("unroll") for (int q_ = 0; q_ < 4; ++q_) { const int p_ = ht + 256 * q_, r_ = p_ >> 4, c8_ = p_ & 15; *(LAS f32x4*)((setb) + O_Q + r_ * PQ + c8_ * 16) = S[q_]; *(LAS f32x4*)((setb) + O_K + r_ * PK + c8_ * 16) = S[4 + q_]; } \
        _Pragma("unroll") for (int q_ = 0; q_ < 2; ++q_) { const int p_ = ht + 256 * q_, r_ = p_ >> 3, c8_ = p_ & 7; *(LAS f32x4*)((setb) + O_V + r_ * PV + c8_ * 16) = Qs[q_]; } } while (0)
#define GD_STAGE_A(setb, gsp) do { LAS unsigned char* kh_ = (setb) + O_K; LAS unsigned char* qh_ = (setb) + O_Q; \
        for (int pi_ = w - 4; pi_ < 10; pi_ += 4) {                   \
            const int Tp_ = pi_ < 1 ? 0 : (pi_ < 3 ? 1 : (pi_ < 6 ? 2 : 3)), Jp_ = pi_ - (Tp_ * (Tp_ + 1)) / 2; \
            const int it_ = d ? 3 - Tp_ : Tp_, jt_ = d ? 3 - Jp_ : Jp_, i_ = it_ * 16 + l16; \
            LAS unsigned char* xk_ = kh_ + i_ * PK + h4 * 16; LAS unsigned char* xq_ = qh_ + i_ * PQ + h4 * 16; \
            const float gci_ = (gsp)[i_], bi_ = (gsp)[64 + i_]; \
            LAS unsigned char* kb_ = kh_ + (jt_ * 16 + l16) * PK + h4 * 16; f32x4 kk_ = (f32x4){0.f, 0.f, 0.f, 0.f}, qk_ = kk_; \
            _Pragma("unroll") for (int ks_ = 0; ks_ < 4; ++ks_) { const bf16x8v a0_ = ldsfrag(kb_, ks_ * 64); kk_ = MFMA16(a0_, ldsfrag(xk_, ks_ * 64), kk_); qk_ = MFMA16(a0_, ldsfrag(xq_, ks_ * 64), qk_); } \
            const int j0_ = jt_ * 16 + 4 * h4; const f32x4 gcj_ = *(const LAS f32x4*)((gsp) + j0_); float am_[4], qm_[4]; \
            _Pragma("unroll") for (int r_ = 0; r_ < 4; ++r_) { const int j_ = j0_ + r_; const bool valid_ = d ? (j_ >= i_) : (j_ <= i_); const float e_ = __expf(gci_ - gcj_[r_]); \
                am_[r_] = (valid_ && j_ != i_) ? -bi_ * kk_[r_] * e_ : 0.f; qm_[r_] = valid_ ? qk_[r_] * e_ : 0.f; } \
            u32x2 pa_, pm_; pa_.x = pk2(am_[0], am_[1]); pa_.y = pk2(am_[2], am_[3]); pm_.x = pk2(qm_[0], qm_[1]); pm_.y = pk2(qm_[2], qm_[3]); \
            *(LAS u32x2*)((setb) + O_AM + i_ * PA + j0_ * 2) = pa_; *(LAS u32x2*)((setb) + O_QM + i_ * PA + j0_ * 2) = pm_; \
            if (jt_ == it_) { LAS float* nd_ = (LAS float*)((setb) + O_ND); const int ipos_ = d ? 15 - l16 : l16; \
                _Pragma("unroll") for (int r_ = 0; r_ < 4; ++r_) { const int jpos_ = d ? 15 - (4 * h4 + r_) : 4 * h4 + r_; nd_[(it_ * 16 + ipos_) * 16 + jpos_] = am_[r_]; } } } } while (0)
        __syncthreads();
        if (helper) { GD_FETCH(0); if (w == 5) gdn_gates(ga, gb, nea, dtb, sm, ln, d); GD_STAGE(lds); GD_FETCH(1); }
        __syncthreads();
        if (helper) GD_STAGE_A(lds, sm);
        __syncthreads();
        for (int step = 0; step < 68; ++step) {
            const int X = step & 1; LAS unsigned char* cur = lds + X * SETB; LAS unsigned char* nxt = lds + (X ^ 1) * SETB;
            LAS float* gs = sm + X * GD_GSET; LAS float* gsn = sm + (X ^ 1) * GD_GSET;
            LAS unsigned char* qh = cur + O_Q; LAS unsigned char* kh = cur + O_K; LAS unsigned char* vv = cur + O_V; LAS unsigned char* AM = cur + O_AM; LAS unsigned char* QM = cur + O_QM; LAS unsigned char* DINV = cur + O_DI;
            const int row0 = GD_ROW0(step);
            s16x4v sf[8];
            if (!helper) {
#pragma unroll
                for (int dt = 0; dt < 8; ++dt) sf[dt] = pack4(S[dt]);
#pragma unroll
                for (int Tp = 0; Tp < 4; ++Tp) { const int ro = 16 * (d ? 3 - Tp : Tp);
                    f32x4 ksv = (f32x4){0.f, 0.f, 0.f, 0.f}, qsv = ksv;
                    LAS unsigned char* ka = kh + (ro + l16) * PK + 8 * h4; LAS unsigned char* qa = qh + (ro + l16) * PQ + 8 * h4;
#pragma unroll
                    for (int dt = 0; dt < 8; ++dt) { ksv = MFMA16K16(lds8(ka + 32 * dt), sf[dt], ksv); qsv = MFMA16K16(lds8(qa + 32 * dt), sf[dt], qsv); }
                    const s16x4v v4 = ldstr1(vv + (ro + 4 * h4 + tq) * PV + (16 * w + 4 * tp) * 2);
                    const f32x4 be = *(const LAS f32x4*)(gs + 64 + ro + 4 * h4), eg = *(const LAS f32x4*)(gs + 128 + ro + 4 * h4);
#pragma unroll
                    for (int r = 0; r < 4; ++r) { Rt[Tp][r] = be[r] * (bf2f((bf16_t)v4[r]) - eg[r] * ksv[r]); Qs[Tp][r] = eg[r] * qsv[r]; }
                    asm volatile("" ::: "memory"); }
            } else {
                if (step + 1 < 68) { GD_STAGE(nxt); if (w == 5) gdn_gates(ga, gb, nea, dtb, gsn, ln, d); if (step + 2 < 68) GD_FETCH(step + 2); }
                if (w == 4) { const int I = ln >> 4, c = ln & 15, cp = d ? 15 - c : c; LAS float* nAd = (LAS float*)(cur + O_ND);
                    float Dr[16];
                    Dr[0] = (cp == 0) ? 1.f : 0.f;
#pragma unroll
                    for (int ip = 1; ip < 16; ++ip) {
                        float av[16];
#pragma unroll
                        for (int q4 = 0; q4 < 4; ++q4) { if (q4 * 4 < ip) { const f32x4 x = *(const LAS f32x4*)(nAd + (I * 16 + ip) * 16 + q4 * 4); av[q4 * 4] = x[0]; av[q4 * 4 + 1] = x[1]; av[q4 * 4 + 2] = x[2]; av[q4 * 4 + 3] = x[3]; } }
                        float s = (cp == ip) ? 1.f : 0.f;
#pragma unroll
                        for (int jq = 0; jq < ip; ++jq) s += av[jq] * Dr[jq];
                        Dr[ip] = s; }
#pragma unroll
                    for (int ip = 0; ip < 16; ++ip) { const int r = d ? 15 - ip : ip; *(LAS bf16_t*)(DINV + (16 * I + r) * PD + 2 * c) = (bf16_t)(pk2(Dr[ip], 0.f) & 0xffffu); } }
            }
            lds_barrier();
            if (!helper) { s16x4v vf[4]; f32x4 vn[4];
#pragma unroll
                for (int Tp = 0; Tp < 4; ++Tp) { const int ro = 16 * (d ? 3 - Tp : Tp);
                    f32x4 Xv = Rt[Tp];
#pragma unroll
                    for (int Jp = 0; Jp < Tp; ++Jp) { const int co = 16 * (d ? 3 - Jp : Jp); Xv = MFMA16K16(lds8(AM + (ro + l16) * PA + (co + 4 * h4) * 2), vf[Jp], Xv); }
                    const s16x4v xf = pack4(Xv);
                    vn[Tp] = MFMA16K16(lds8(DINV + (ro + l16) * PD + 8 * h4), xf, ((f32x4){0.f, 0.f, 0.f, 0.f}));
                    vf[Tp] = pack4(vn[Tp]); }
#pragma unroll
                for (int Tp = 0; Tp < 4; ++Tp) { const int ro = 16 * (d ? 3 - Tp : Tp);
                    f32x4 o = Qs[Tp];
#pragma unroll
                    for (int Jp = 0; Jp <= Tp; ++Jp) { const int co = 16 * (d ? 3 - Jp : Jp); o = MFMA16K16(lds8(QM + (ro + l16) * PA + (co + 4 * h4) * 2), vf[Jp], o); }
#pragma unroll
                    for (int r = 0; r < 4; ++r) O[(size_t)(row0 + ro + 4 * h4 + r) * 1024 + h * 128 + eh * 64 + 16 * w + l16] = (bf16_t)(pk2(o[r], 0.f) & 0xffffu);
                    asm volatile("" ::: "memory"); }
                const float gend = gs[256];
                s16x4v vsf[4];
#pragma unroll
                for (int Jp = 0; Jp < 4; ++Jp) { const int co = 16 * (d ? 3 - Jp : Jp); const f32x4 ee = *(const LAS f32x4*)(gs + 192 + co + 4 * h4); vsf[Jp] = pack4(vn[Jp] * ee); }
#pragma unroll
                for (int dt = 0; dt < 8; ++dt) { S[dt] = S[dt] * gend;
#pragma unroll
                    for (int Jp = 0; Jp < 4; ++Jp) { const int co = 16 * (d ? 3 - Jp : Jp); S[dt] = MFMA16K16(ldstr1(kh + (co + 4 * h4 + tq) * PK + (16 * dt + 4 * tp) * 2), vsf[Jp], S[dt]); }
                    if (dt & 1) asm volatile("" ::: "memory"); }
            } else if (step + 1 < 68) GD_STAGE_A(nxt, gsn);
            lds_barrier();
        }
#undef GD_ROW0
#undef GD_FETCH
#undef GD_STAGE
#undef GD_STAGE_A
    }
}

#ifndef DUP_PHASE
#define DUP_PHASE -1
#endif
constexpr int NPH_LAYER = 19, PH_FINAL = 2 + DEPTH * NPH_LAYER, NPHASE = PH_FINAL + 1;
template <class Epi>
DI void run_gemm(int tid, int c, LAS unsigned char* lds, const bf16_t* A, const bf16_t* Bt, int M, int N, const Epi& E) {
    pg8::Gemm g{A, Bt, M, N, 1024, 1024, 1 << 20, 0, tid}; pg8::StaticOrder S; S.init(M, N, (int)gridDim.x, c);
#if defined(GEMM_STAGGER)
    if (blockIdx.x & 8) { const unsigned long long t0 = __builtin_amdgcn_s_memrealtime(); while (__builtin_amdgcn_s_memrealtime() - t0 < GEMM_STAGGER) __builtin_amdgcn_s_sleep(8); }
#endif
    pg8::gemm_phase<Epi, pg8::StaticOrder, false>(lds, g, S, E, nullptr);
}
template <class Epi>
DI void run_gemm_g(int tid, LAS unsigned char* lds, const bf16_t* A, int lda, int K, const bf16_t* Bt, int M, int N, int pmg, size_t gstride, const Epi& E) {
    pg8::Gemm g{A, Bt, M, N, K, lda, pmg, gstride, tid}; pg8::StaticOrder S; S.init(M, N, (int)gridDim.x, (int)blockIdx.x);
    pg8::gemm_phase<Epi, pg8::StaticOrder, false>(lds, g, S, E, nullptr);
}
__global__ void __launch_bounds__(NT, 2) hy_fwd(Args ka) {
    extern __shared__ __attribute__((aligned(16))) unsigned char lds_raw[];
    LAS unsigned char* lds = (LAS unsigned char*)lds_raw;
    volatile LAS unsigned* xbw = (volatile LAS unsigned*)(lds + LDS_BYTES - 256);
    if (threadIdx.x < 4) xbw[threadIdx.x] = 0u;
    __syncthreads();
    const int lo = ka.ph_lo, hi = ka.ph_hi;
    const int s_wid = __builtin_amdgcn_readfirstlane((int)(threadIdx.x >> 6));
    XcdBarrier bar; bar.bar = (unsigned*)(ka.ws + WS_CTL); bar.x = 0u; bar.st = xbw; bar.wid = s_wid;
    if (hi - lo > 1) bar = xcd_barrier_post((unsigned*)(ka.ws + WS_CTL), xbw, s_wid);
#ifdef PH_ONLY
#define PHEN(p) ((p) == PH_ONLY)
#else
#define PHEN(p) 1
#endif
#define IN(k) (lo <= (k) && (k) < hi)
#define INL(p) (PHEN(p) && IN(pb + (p)))
#define REPS(p) ((DUP_PHASE == (p)) ? 2 : 1)
#define SEAM(k) do { if (IN((k) + 1)) { xcd_barrier(bar); if (DUP_PHASE == 200) xcd_barrier(bar); } } while (0)
#define PH_LOAD \
    Args a; __builtin_memcpy(&a, args_ptr(), sizeof(Args)); a.wid = s_wid; \
    unsigned char* ws = a.ws; \
    float* MOD = (float*)(ws + WS_MOD); float* XCTX = (float*)(ws + WS_XCTX); \
    bf16_t* H = (bf16_t*)(ws + WS_H); bf16_t* MERGED = (bf16_t*)(ws + WS_MERGED); \
    bf16_t* WB0 = (bf16_t*)(ws + WS_WB0); bf16_t* WB1 = (bf16_t*)(ws + WS_WB1); bf16_t* WB2 = (bf16_t*)(ws + WS_WB2); bf16_t* M5B = (bf16_t*)(ws + WS_R + R_M5); \
    unsigned char* R = ws + WS_R; \
    bf16_t* P0 = (bf16_t*)(R + R_P0); bf16_t* P1 = (bf16_t*)(R + R_P1); bf16_t* P2 = (bf16_t*)(R + R_P2); bf16_t* OF = (bf16_t*)(R + R_OF); bf16_t* OB = (bf16_t*)(R + R_OB); \
    float* GATE2 = (float*)(R + R_G2); \
    float* GATE1 = (float*)(ws + WS_MERGED); bf16_t* HALO = (bf16_t*)(ws + WS_MERGED + SZ_GATE);     \
    float* MODP = (float*)R; \
    bf16_t* AX = (bf16_t*)(R + R5_AX); bf16_t* SZ5 = (bf16_t*)(R + R5_SZ); bf16_t* G15 = (bf16_t*)(R + R5_G1); bf16_t* GLUA = (bf16_t*)(R + R5_GLUA); bf16_t* YBR = (bf16_t*)R; \
    bf16_t* CW1 = (bf16_t*)(ws + WS_H); bf16_t* CW2 = (bf16_t*)(ws + WS_H + SZ_CW1); float* SEG5 = (float*)(ws + WS_H + SZ_CW1 + SZ_CW2); \
    const float* xlat_src = l == 0 ? a.in[I_X] : a.out; const float* xctx_src = l == 0 ? a.in[I_CTX] : XCTX; const float* modl = MOD + (size_t)l * 9 * 3072; \
    (void)MOD; (void)XCTX; (void)H; (void)MERGED; (void)WB0; (void)WB1; (void)WB2; (void)M5B; (void)P0; (void)P1; (void)P2; (void)OF; (void)OB; (void)GATE2; (void)GATE1; (void)HALO; (void)MODP; (void)AX; (void)SZ5; (void)G15; (void)GLUA; (void)YBR; (void)CW1; (void)CW2; (void)SEG5; (void)xlat_src; (void)xctx_src; (void)modl;
    LAS float* ldsf = (LAS float*)lds;

    { const int l = 0;
    if (PHEN(100) && IN(0)) { PH_LOAD; ph_modp(a, MODP, ldsf); SEAM(0); }
    if (PHEN(101) && IN(1)) { PH_LOAD; ph_mod(a, MODP, MOD); SEAM(1); } }
    for (int l = 0; l < DEPTH; ++l) {
        const int pb = 2 + l * NPH_LAYER;
        const int lro = (l == DEPTH - 1) ? CTXROWS : 0;
        const int crot = (gridDim.x == 256) ? (int)((blockIdx.x + 224u) & 255u) : (int)blockIdx.x;
        if (INL(0)) { PH_LOAD; ph_norm(a, l, xlat_src, xctx_src, modl, H); ph_cvt(wdesc(a, l, 0), WB0, ldsf); SEAM(pb + 0); }
        if (INL(1)) { PH_LOAD; EpiProj E{P0, 0, GATE1, 12, HALO, 0}; run_gemm(ltid(a), (int)blockIdx.x, lds, H, WB0, MROWS, 3328, E); SEAM(pb + 1); }
        if (INL(2)) { PH_LOAD; ph_gdn_conv(a, l, P0, HALO, lds); ph_cvt(wdesc(a, l, 1), WB1, ldsf); SEAM(pb + 2); }
        if (INL(3)) { PH_LOAD; ph_gdn_scan_pipe(a, l, P0, P1, P2, GATE1, OF, OB, lds); SEAM(pb + 3); }
        if (INL(4)) { PH_LOAD; ph_cvt(wdesc(a, l, 6), WB2, ldsf); EpiProj E{P0, 9, nullptr, -1, nullptr, lro}; run_gemm(ltid(a), (int)blockIdx.x, lds, H + (size_t)lro * 1024, WB1, MROWS - lro, 2048, E); SEAM(pb + 4); }
        if (INL(5)) { PH_LOAD; ph_gdn_post(a, l, OF, OB, P0); ph_cvt(wdesc(a, l, 3), WB0, ldsf); SEAM(pb + 5); }
        if (INL(6)) { PH_LOAD; ph_cvt(wdesc(a, l, 2), WB1, ldsf);
            { EpiBranch E{P1, MERGED, 1, lro}; run_gemm(ltid(a), (int)blockIdx.x, lds, OF + (size_t)lro * 1024, WB2, MROWS - lro, 1024, E); }
            { EpiProj E{M5B, 38, nullptr, -1, nullptr, lro}; run_gemm(ltid(a), crot, lds, H + (size_t)lro * 1024, WB0, MROWS - lro, 3072, E); }
            SEAM(pb + 6); }
        if (INL(7)) { PH_LOAD; ph_cvt(wdesc(a, l, 8), WB2, ldsf); EpiProj E{P0, 0, GATE2, 12, nullptr, 0}; run_gemm(ltid(a), (int)blockIdx.x, lds, H, WB1, MROWS, 3328, E); SEAM(pb + 7); }
        if (INL(8)) { PH_LOAD; ph_ml_scan_mfma(a, l, P0, P1, P2, GATE2, OF, OB, lds); SEAM(pb + 8); }
        if (INL(9)) { PH_LOAD; ph_ml_post(a, l, OF, OB, M5B, M5B + SZ_ACT / 2); ph_cvt(wdesc(a, l, 4), WB0, ldsf); SEAM(pb + 9); }
        if (INL(10)) { PH_LOAD; ph_cvt(wdesc(a, l, 5), WB1, ldsf);
            { EpiBranch E{M5B + 2 * (SZ_ACT / 2), MERGED, 0, lro}; run_gemm(ltid(a), (int)blockIdx.x, lds, OF + (size_t)lro * 1024, WB2, MROWS - lro, 1024, E); }
            { EpiS1 E{AX, SZ5, G15}; run_gemm(ltid(a), crot, lds, H, WB0, MROWS, 3072, E); }
            SEAM(pb + 10); }
        if (INL(11)) { PH_LOAD; ph_s5_consts(a, l, CW1, CW2, lds); ph_cvt(wdesc(a, l, 7), WB2, ldsf); SEAM(pb + 11); }
        if (INL(12)) { PH_LOAD; EpiS5L E{AX}; run_gemm_g(ltid(a), lds, AX, 512, 256, CW1, 64 * S5_RG, 256, S5_PMG, (size_t)256 * 256 * 2, E); SEAM(pb + 12); }
        if (INL(13)) { PH_LOAD; ph_s5_carry1(a, l, AX, SEG5); SEAM(pb + 13); }
        if (INL(14)) { PH_LOAD; ph_s5_carry2(a, l, AX, SEG5); SEAM(pb + 14); }
        if (INL(15)) { PH_LOAD; EpiS5Y E{AX, GLUA, a.in[I_SD] + l * 1024}; run_gemm_g(ltid(a), lds, AX, 512, 512, CW2, 64 * S5_RG, 256, S5_PMG, (size_t)256 * 512 * 2, E); SEAM(pb + 15); }
        if (INL(16)) { PH_LOAD; ph_cvt(wdesc(a, l, 9), WB0, ldsf); EpiGlu E{SZ5, YBR, a.in[I_SBGLU] + l * 2048, lro}; run_gemm(ltid(a), (int)blockIdx.x, lds, GLUA + (size_t)lro * 1024, WB1, MROWS - lro, 2048, E); SEAM(pb + 16); }
        if (INL(17)) { PH_LOAD; EpiBranch E{G15, MERGED, 0, lro}; run_gemm(ltid(a), (int)blockIdx.x, lds, YBR + (size_t)lro * 1024, WB2, MROWS - lro, 1024, E); SEAM(pb + 17); }
        if (INL(18)) { PH_LOAD;
            EpiOut E{xlat_src, a.out, xctx_src, XCTX, modl, l, lro};
            run_gemm(ltid(a), (int)blockIdx.x, lds, MERGED + (size_t)lro * 1024, WB0, MROWS - lro, 1024, E);
            SEAM(pb + 18);
        }
    }
    if (PHEN(102) && IN(PH_FINAL)) { const int l = 0; PH_LOAD; ph_final(a, a.out); }
#undef IN
#undef SEAM
#undef PH_LOAD
}
}

#ifndef MK_LAUNCHES
#define MK_LAUNCHES 1
#endif
extern "C" void kernel_launch(void* const* d_in, const int* in_sizes, int n_in, void* d_out, int out_size, void* d_ws, size_t ws_size, hipStream_t stream) {
    static int grid = 0;
    if (grid == 0) {
        if (n_in != 28 || out_size != hy::NBATCH * hy::SEQ * hy::D || ws_size < hy::WS_END) { fprintf(stderr, "kernel_launch: unexpected shapes (n_in %d, out %d, ws %zu < %zu)\n", n_in, out_size, ws_size, (size_t)hy::WS_END); grid = -1; return; }
        int dev = 0, cus = 0, per_cu = 0;
        if (hipGetDevice(&dev) != hipSuccess || hipDeviceGetAttribute(&cus, hipDeviceAttributeMultiprocessorCount, dev) != hipSuccess) { grid = -1; return; }
        if (hipFuncSetAttribute((const void*)hy::hy_fwd, hipFuncAttributeMaxDynamicSharedMemorySize, hy::LDS_BYTES) != hipSuccess) { fprintf(stderr, "kernel_launch: hipFuncSetAttribute failed\n"); grid = -1; return; }
        if (hipOccupancyMaxActiveBlocksPerMultiprocessor(&per_cu, (const void*)hy::hy_fwd, hy::NT, hy::LDS_BYTES) != hipSuccess || per_cu < 1) { fprintf(stderr, "kernel_launch: occupancy query says %d\n", per_cu); (void)hipGetLastError(); }
        grid = cus;
    }
    if (grid < 0) return;
    (void)hipMemsetAsync((char*)d_ws + hy::WS_CTL, 0, 65536, stream);
    hy::Args a{};
    for (int i = 0; i < 28; ++i) a.in[i] = (const float*)d_in[i];
    a.out = (float*)d_out; a.ws = (unsigned char*)d_ws;
#if MK_LAUNCHES == 1
    a.ph_lo = 0; a.ph_hi = hy::NPHASE;
    hipLaunchKernelGGL(hy::hy_fwd, dim3(grid), dim3(hy::NT), hy::LDS_BYTES, stream, a);
#else
    for (int p = 0; p < hy::NPHASE; ++p) { a.ph_lo = p; a.ph_hi = p + 1; hipLaunchKernelGGL(hy::hy_fwd, dim3(grid), dim3(hy::NT), hy::LDS_BYTES, stream, a); }
#endif
}
```

```cpp
#include <hip/hip_runtime.h>
#include <cstdio>
#include <cstdint>
#define MK_LAUNCHES 1


#define XB_TMO      128
#define XB_XCNT(j)  (256  + 64 * (j))
#define XB_XSUB(j)  (1280 + 64 * (j))
#define XB_XGEN(j)  (2304 + 64 * (j))
#define XB_TOP      3328
#define XB_TOPGEN   3392
#define XCD_BAR_WORDS 3456
#define XB_SPIN_CAP (1u << 18)
#define LAS __attribute__((address_space(3)))

__device__ __forceinline__ unsigned xb_ld(unsigned* p)              { return __hip_atomic_load(p, __ATOMIC_RELAXED, __HIP_MEMORY_SCOPE_AGENT); }
__device__ __forceinline__ unsigned xb_add(unsigned* p, unsigned v) { return __hip_atomic_fetch_add(p, v, __ATOMIC_RELAXED, __HIP_MEMORY_SCOPE_AGENT); }
__device__ __forceinline__ unsigned xb_xcc_id() { return (unsigned)__builtin_amdgcn_s_getreg((3 << 11) | 20) & 0xFu; }
#define XB_SPIN(cond, bar) do { unsigned _sp = 0; while (cond) { __builtin_amdgcn_s_sleep(1); \
    if ((++_sp & 255u) == 0u) { if (xb_ld(&(bar)[XB_TMO])) break; if (_sp > XB_SPIN_CAP) { atomicAdd(&(bar)[XB_TMO], 1u); break; } } } } while (0)

struct XcdBarrier {
    unsigned* bar; unsigned x;
    int wid;
    volatile LAS unsigned* st;
};

__device__ __forceinline__ bool xb_lead(int wid) { int l; asm volatile("v_mbcnt_lo_u32_b32 %0, -1, 0\n\tv_mbcnt_hi_u32_b32 %0, -1, %0" : "=v"(l)); return wid == 0 && l == 0; }
__device__ __forceinline__ XcdBarrier xcd_barrier_post(unsigned* bar, volatile LAS unsigned* st, int wid) {
    XcdBarrier b; b.bar = bar; b.x = xb_xcc_id(); b.st = st; b.wid = wid;
    if (xb_lead(wid)) (void)xb_add(&bar[XB_XCNT(b.x)], 1u);
    return b;
}
__device__ __forceinline__ void xcd_barrier_complete(unsigned* bar, unsigned x, unsigned& nloc, unsigned& nx) {
    const unsigned G = gridDim.x * gridDim.y * gridDim.z;
    unsigned sum, cnt, mine, sp = 0u;
    for (;;) {
        sum = 0u; cnt = 0u; mine = 0u;
#pragma unroll
        for (unsigned j = 0; j < 16; ++j) { const unsigned c = xb_ld(&bar[XB_XCNT(j)]); sum += c; cnt += (c > 0u) ? 1u : 0u; mine = (j == x) ? c : mine; }
        if (sum == G) break;
        __builtin_amdgcn_s_sleep(1);
        if ((++sp & 255u) == 0u) { if (xb_ld(&bar[XB_TMO])) break; if (sp > XB_SPIN_CAP) { atomicAdd(&bar[XB_TMO], 1u); break; } }
    }
    nloc = mine > 0u ? mine : 1u; nx = cnt > 0u ? cnt : 1u;
}

__device__ __forceinline__ void xcd_barrier(const XcdBarrier& b) {
    asm volatile("s_waitcnt vmcnt(0)" ::: "memory");
    __syncthreads();
    if (xb_lead(b.wid)) {
        unsigned* bar = b.bar;
        __builtin_amdgcn_s_waitcnt(0);
        unsigned nloc = b.st[0], nx = b.st[1];
        if (nloc == 0u) { xcd_barrier_complete(bar, b.x, nloc, nx); b.st[0] = nloc; b.st[1] = nx; }
        const unsigned old = xb_add(&bar[XB_XSUB(b.x)], 1u);
        const unsigned gen = old / nloc;
        if (old + 1u == (gen + 1u) * nloc) {
            __builtin_amdgcn_fence(__ATOMIC_RELEASE, "agent");
            asm volatile("s_waitcnt vmcnt(0)" ::: "memory");
            const unsigned og = xb_add(&bar[XB_TOP], 1u);
            const unsigned tg = og / nx;
            if (og + 1u == (tg + 1u) * nx) xb_add(&bar[XB_TOPGEN], 1u);
            else XB_SPIN(xb_ld(&bar[XB_TOPGEN]) == tg, bar);
            __builtin_amdgcn_fence(__ATOMIC_ACQUIRE, "agent");
            xb_add(&bar[XB_XGEN(b.x)], 1u);
            asm volatile("s_waitcnt vmcnt(0)" ::: "memory");
        } else {
            XB_SPIN(xb_ld(&bar[XB_XGEN(b.x)]) == gen, bar);
            __builtin_amdgcn_fence(__ATOMIC_ACQUIRE, "agent");
            asm volatile("s_waitcnt vmcnt(0)" ::: "memory");
        }
    }
    __syncthreads();
}


namespace pg8 {
#define PG8_LAS __attribute__((address_space(3)))
typedef unsigned short bf16_t;
typedef short bf16x8 __attribute__((ext_vector_type(8)));
typedef float f32x4 __attribute__((ext_vector_type(4)));
typedef unsigned u32x4 __attribute__((ext_vector_type(4)));
constexpr int BM = 256, BK = 64, HALF = 128, HTB = HALF * BK * 2  , STAGE_BYTES = 8 * HTB, NXCD = 8, WGM = 8;

__host__ __device__ __forceinline__ int lds_byte(int r, int c) { const int st = (r >> 4) * 2 + (c >> 5), rr = r & 15, cc = c & 31, ob = rr * 64 + cc * 2; return st * 1024 + (ob ^ (((ob >> 9) & 1) << 5)); }
__host__ __device__ __forceinline__ void stage_rc(int b, int& R, int& C) { const int st = b / 1024, sb = b % 1024, swz = sb ^ (((sb >> 9) & 1) << 5); R = (st >> 1) * 16 + swz / 64; C = (st & 1) * 32 + (swz % 64) / 2; }
__host__ __device__ __forceinline__ int perm32(int rho) { const int n = rho >> 4, i = rho & 15; return 8 * (i >> 2) + 4 * n + (i & 3); }

struct Unit { int pm, pn; };
struct Gemm { const bf16_t* A; const bf16_t* Bt; int M, N, K, lda, pmg; size_t gstride; int tid; };

struct StaticOrder {
    int nM, nN, nwg, G, c;
    __host__ __device__ void init(int M, int N, int G_, int c_) { nM = M / BM; nN = N / BM; nwg = nM * nN; G = G_; c = c_; }
    __host__ __device__ bool next(int i, Unit& u) const {
        const long L = (long)i * G + c; if (L >= nwg) return false;
        int wgid = (int)L; { const int q = nwg / NXCD, r = nwg % NXCD, xcd = wgid % NXCD, off = wgid / NXCD; wgid = (xcd < r ? xcd * (q + 1) : r * (q + 1) + (xcd - r) * q) + off; }
        const int nig = WGM * nN, gid = wgid / nig, fm = gid * WGM, gsz = (nM - fm) < WGM ? (nM - fm) : WGM;
        u.pm = fm + ((wgid % nig) % gsz); u.pn = (wgid % nig) / gsz; return true;
    }
    __device__ __forceinline__ void a_ready(const Unit&) const {}
    __device__ __forceinline__ void done(const Unit&) const {}
};
__device__ __forceinline__ unsigned cvt_pk_bf16(float lo, float hi) { unsigned r; asm volatile("v_cvt_pk_bf16_f32 %0, %1, %2" : "=v"(r) : "v"(lo), "v"(hi)); return r; }
typedef float f32x2 __attribute__((ext_vector_type(2)));
template <class Epi, class Sched, bool STAMP = false>
__device__ __forceinline__ void gemm_phase(PG8_LAS unsigned char* lds, const Gemm g, const Sched& S, const Epi& E, unsigned long long* stamps) {
    const int tid = g.tid, wid = __builtin_amdgcn_readfirstlane(tid >> 6), lane = tid & 63, wr = wid >> 2, wc = wid & 3, fr = lane & 15, fq = lane >> 4;
    const int K = g.K, nt = K / BK;
    int ts_lo = 0, ts_hi = 0, nts = 0; const unsigned long long rt_entry = STAMP ? (unsigned long long)wall_clock64() : 0ull;
#define PG8_STAMP() do { if (STAMP && wid == 0 && nts < 64) { const unsigned long long _c = (unsigned long long)clock64(); \
        ts_lo = (lane == nts) ? (int)(unsigned)_c : ts_lo; ts_hi = (lane == nts) ? (int)(unsigned)(_c >> 32) : ts_hi; ++nts; } } while (0)
    PG8_STAMP();
    unsigned voffA[2], voffB[2];
#pragma unroll
    for (int i = 0; i < 2; ++i) { int R, C; stage_rc(tid * 16 + i * 8192, R, C); const int Rb = Epi::PERM ? ((R & ~31) + perm32(R & 31)) : R;
        voffA[i] = (unsigned)(R * g.lda + C) * 2u; voffB[i] = (unsigned)(Rb * K + C) * 2u; }
    const size_t kstep = (size_t)(BK * 2);
    const size_t hstepA = (size_t)HALF * g.lda * 2, hstepB = (size_t)HALF * K * 2;
    const size_t tstepA = 2 * hstepA, tstepB = 2 * hstepB;
    const unsigned ldsw = (unsigned)wid * 1024u;
    const int aoff = lds_byte(wr * 64 + fr, fq * 8), boff = lds_byte(wc * 32 + fr, fq * 8);
#define PG8_SA(b, h) (((b) * 2 + (h)) * HTB)
#define PG8_SB(b, h) ((4 + (b) * 2 + (h)) * HTB)
#define PG8_STAGE(bufoff, gbase, voff) do { _Pragma("unroll") for (int _i = 0; _i < 2; ++_i) \
        __builtin_amdgcn_global_load_lds((const unsigned*)((const char*)(gbase) + (voff)[_i]), (PG8_LAS unsigned*)(lds + (bufoff) + ldsw + _i * 8192), 16, 0, 0); } while (0)
#define PG8_LDA(dst, b, h) do { _Pragma("unroll") for (int m = 0; m < 4; ++m) _Pragma("unroll") for (int k = 0; k < 2; ++k) dst[m][k] = *(const PG8_LAS bf16x8*)(lds + PG8_SA(b, h) + aoff + m * 2048 + k * 1024); } while (0)
#define PG8_LDB(dst, b, h) do { _Pragma("unroll") for (int n = 0; n < 2; ++n) _Pragma("unroll") for (int k = 0; k < 2; ++k) dst[n][k] = *(const PG8_LAS bf16x8*)(lds + PG8_SB(b, h) + boff + n * 2048 + k * 1024); } while (0)
#define PG8_MMA(ai, bj, At, Bt) do { __builtin_amdgcn_s_setprio(1); _Pragma("unroll") for (int m = 0; m < 4; ++m) _Pragma("unroll") for (int n = 0; n < 2; ++n) _Pragma("unroll") for (int k = 0; k < 2; ++k) \
        acc[ai][bj][m][n] = __builtin_amdgcn_mfma_f32_16x16x32_bf16(Bt[n][k], At[m][k], acc[ai][bj][m][n], 0, 0, 0); __builtin_amdgcn_s_setprio(0); } while (0)
#define PG8_WAIT_V(n) asm volatile("s_waitcnt vmcnt(" #n ")" ::: "memory")
#define PG8_WAIT_L(n) asm volatile("s_waitcnt lgkmcnt(" #n ")" ::: "memory")
#define PG8_BAR __builtin_amdgcn_s_barrier()
#define PG8_SCHED __builtin_amdgcn_sched_barrier(0)
    Unit cur, nxt; int ui = 0;
    if (!S.next(0, cur)) return;
    f32x4 acc[2][2][4][2];
#pragma unroll
    for (int a = 0; a < 2; ++a)
#pragma unroll
        for (int b = 0; b < 2; ++b)
#pragma unroll
            for (int m = 0; m < 4; ++m)
#pragma unroll
                for (int n = 0; n < 2; ++n) acc[a][b][m][n] = (f32x4){0.f, 0.f, 0.f, 0.f};
    bf16x8 At[4][2], B0[2][2], B1[2][2];
    const char* cA = (const char*)g.A + (size_t)cur.pm * tstepA; const char* cB = (const char*)g.Bt + (size_t)(cur.pm / g.pmg) * g.gstride + (size_t)cur.pn * tstepB;
    S.a_ready(cur);
    PG8_STAGE(PG8_SB(0, 0), cB, voffB); PG8_STAGE(PG8_SA(0, 0), cA, voffA); PG8_STAGE(PG8_SB(0, 1), cB + hstepB, voffB); PG8_STAGE(PG8_SA(0, 1), cA + hstepA, voffA);
    if (wr == 1) PG8_BAR;
    PG8_WAIT_V(4); PG8_BAR;
    PG8_STAGE(PG8_SB(1, 0), cB + kstep, voffB); PG8_STAGE(PG8_SA(1, 0), cA + kstep, voffA); PG8_STAGE(PG8_SB(1, 1), cB + hstepB + kstep, voffB);
    PG8_WAIT_V(6); PG8_BAR;
    PG8_STAMP();
    for (;;) {
        const bool has_next = S.next(ui + 1, nxt);
        const char* nA = has_next ? (const char*)g.A + (size_t)nxt.pm * tstepA : cA; const char* nB = has_next ? (const char*)g.Bt + (size_t)(nxt.pm / g.pmg) * g.gstride + (size_t)nxt.pn * tstepB : cB;
#pragma unroll 1
        for (int t = 0; t < nt; t += 2) {
            const bool last = (t == nt - 2);
            const char* a1 = cA + (size_t)(t + 1) * kstep;
            const char* a2 = last ? nA : cA + (size_t)(t + 2) * kstep; const char* b2 = last ? nB : cB + (size_t)(t + 2) * kstep;
            const char* a3 = a2 + kstep; const char* b3 = b2 + kstep;
            if (last && has_next) S.a_ready(nxt);
            PG8_LDB(B0, 0, 0); PG8_SCHED; PG8_LDA(At, 0, 0); PG8_STAGE(PG8_SA(1, 1), a1 + hstepA, voffA);
            PG8_WAIT_L(8); PG8_BAR; PG8_WAIT_L(0); PG8_MMA(0, 0, At, B0); PG8_BAR; PG8_SCHED;
            PG8_LDB(B1, 0, 1); PG8_STAGE(PG8_SB(0, 0), b2, voffB);
            PG8_BAR; PG8_WAIT_L(0); PG8_MMA(0, 1, At, B1); PG8_BAR;
            PG8_LDA(At, 0, 1); PG8_STAGE(PG8_SA(0, 0), a2, voffA);
            PG8_BAR; PG8_WAIT_L(0); PG8_MMA(1, 0, At, B0); PG8_BAR; PG8_SCHED;
            PG8_STAGE(PG8_SB(0, 1), b2 + hstepB, voffB);
            PG8_WAIT_V(6); PG8_BAR; PG8_MMA(1, 1, At, B1); PG8_BAR;
            PG8_LDB(B0, 1, 0); PG8_SCHED; PG8_LDA(At, 1, 0); PG8_STAGE(PG8_SA(0, 1), a2 + hstepA, voffA);
            PG8_WAIT_L(8); PG8_BAR; PG8_WAIT_L(0); PG8_MMA(0, 0, At, B0); PG8_BAR; PG8_SCHED;
            PG8_LDB(B1, 1, 1); PG8_STAGE(PG8_SB(1, 0), b3, voffB);
            PG8_BAR; PG8_WAIT_L(0); PG8_MMA(0, 1, At, B1); PG8_BAR;
            PG8_LDA(At, 1, 1); PG8_STAGE(PG8_SA(1, 0), a3, voffA);
            PG8_BAR; PG8_WAIT_L(0); PG8_MMA(1, 0, At, B0); PG8_BAR; PG8_SCHED;
            PG8_STAGE(PG8_SB(1, 1), b3 + hstepB, voffB);
            PG8_WAIT_V(6); PG8_BAR; PG8_MMA(1, 1, At, B1); PG8_BAR;
        }
        PG8_STAMP();
        if constexpr (!Epi::AFTER_DRAIN) { E(acc, cur, wr, wc, fr, fq); S.done(cur); }
        PG8_STAMP();
        if (!has_next) break;
#pragma unroll
        for (int a = 0; a < 2; ++a)
#pragma unroll
            for (int b = 0; b < 2; ++b)
#pragma unroll
                for (int m = 0; m < 4; ++m)
#pragma unroll
                    for (int n = 0; n < 2; ++n) acc[a][b][m][n] = (f32x4){0.f, 0.f, 0.f, 0.f};
        cur = nxt; cA = nA; cB = nB; ++ui;
    }
    PG8_WAIT_V(0);
    if (wr == 0) PG8_BAR;
    PG8_BAR;
    if constexpr (Epi::AFTER_DRAIN) { E.fused(acc, cur, wr, wc, fr, fq, lds, wid, lane); S.done(cur); }
    PG8_STAMP();
    if (STAMP && wid == 0) { stamps[lane] = lane < nts ? (((unsigned long long)(unsigned)ts_hi << 32) | (unsigned)ts_lo) : 0ull;
        if (lane == 62) stamps[62] = rt_entry; if (lane == 63) stamps[63] = (unsigned long long)wall_clock64(); }
#undef PG8_STAMP
#undef PG8_SA
#undef PG8_SB
#undef PG8_STAGE
#undef PG8_LDA
#undef PG8_LDB
#undef PG8_MMA
#undef PG8_WAIT_V
#undef PG8_WAIT_L
#undef PG8_BAR
#undef PG8_SCHED
}
}


namespace hy {
using pg8::bf16_t; using pg8::f32x4; using pg8::u32x4; using pg8::Unit;
typedef unsigned u32x2 __attribute__((ext_vector_type(2)));
#define DI __device__ __forceinline__
constexpr int D = 1024, NBATCH = 8, SEQ = 4096, CTXL = 256, DEPTH = 4;
constexpr int CTXROWS = NBATCH * CTXL;
constexpr int MROWS = CTXROWS + NBATCH * SEQ;
constexpr int NCHUNK = MROWS / 64;
constexpr int NIN = 14384;
constexpr int NT = 512;
constexpr int LDS_BYTES = 147456 + 256;
constexpr int C_GQ = 0, C_GZ = 3072, C_GA = 4096, C_SU = 4128, C_MQ = 6176, C_MO = 9248, C_MI = 11296, C_GATE = 11312;

constexpr size_t al256(size_t x) { return (x + 255) & ~(size_t)255; }
constexpr size_t SZ_ACT = (size_t)MROWS * 1024 * 2;
constexpr size_t SZ_GATE = (size_t)MROWS * 32 * 4;
constexpr size_t SZ_HALO = (size_t)3 * NCHUNK * 4 * 1024 * 2;
constexpr size_t WS_CTL = 0;
constexpr size_t WS_MOD = 65536, SZ_MOD = (size_t)DEPTH * 9 * 3072 * 4;
constexpr size_t WS_XCTX = al256(WS_MOD + SZ_MOD);
constexpr size_t WS_H = WS_XCTX + (size_t)CTXROWS * 1024 * 4;
constexpr size_t WS_MERGED = WS_H + SZ_ACT;
constexpr size_t SZ_WB = (size_t)3328 * 1024 * 2;
constexpr size_t WS_WB0 = WS_MERGED + SZ_ACT;
constexpr size_t WS_WB1 = WS_WB0 + SZ_WB;
constexpr size_t WS_WB2 = WS_WB1 + SZ_WB;
constexpr size_t WS_R = WS_WB2 + SZ_WB;
constexpr size_t R_P0 = 0, R_P1 = SZ_ACT, R_P2 = 2 * SZ_ACT, R_OF = 3 * SZ_ACT, R_OB = 4 * SZ_ACT, R_G2 = 5 * SZ_ACT, R_M5 = al256(R_G2 + SZ_GATE);
constexpr size_t WS_END = WS_R + R_M5 + 3 * SZ_ACT;
static_assert(SZ_GATE + SZ_HALO <= SZ_ACT, "GDN gate + halo buffers live in the (not yet written) MERGED region");
static_assert((size_t)16 * DEPTH * 9 * 3072 * 4 <= SZ_ACT, "mod partials live in the R region");

struct Args { const float* in[28]; float* out; unsigned char* ws; int ph_lo, ph_hi, wid, pad; };
enum { I_X = 0, I_C, I_CTX, I_CCTX, I_WADA, I_BADA, I_NORMG, I_WIN, I_GCONV, I_GALOG, I_GDTB, I_GNORM, I_SLRE, I_SLIM, I_SLOG, I_SBRE, I_SBIM, I_SCRE, I_SCIM, I_SD, I_SWGLU, I_SBGLU, I_MIB, I_MFB, I_MNORM, I_WBR, I_WOUT, I_FNORM };

typedef const Args __attribute__((address_space(4)))* ArgsP;
DI ArgsP args_ptr() { ArgsP p = (ArgsP)__builtin_amdgcn_kernarg_segment_ptr(); asm volatile("" : "+s"(p)); return p; }
DI int lane_id() { int l; asm volatile("v_mbcnt_lo_u32_b32 %0, -1, 0\n\tv_mbcnt_hi_u32_b32 %0, -1, %0" : "=v"(l)); return l; }
DI int ltid(const Args& a) { return (a.wid << 6) | lane_id(); }
DI void lds_barrier() { asm volatile("s_waitcnt lgkmcnt(0)" ::: "memory"); __builtin_amdgcn_s_barrier(); asm volatile("" ::: "memory"); }
DI float bf2f(bf16_t v) { return __uint_as_float(((unsigned)v) << 16); }
DI float bflo(unsigned w) { return __uint_as_float(w << 16); }
DI float bfhi(unsigned w) { return __uint_as_float(w & 0xffff0000u); }
DI bf16_t f2bf(float f) { return (bf16_t)(pg8::cvt_pk_bf16(f, 0.f) & 0xffffu); }
DI float sigmoidf_(float x) { return __builtin_amdgcn_rcpf(1.0f + __expf(-x)); }
DI float siluf_(float x) { return x * __builtin_amdgcn_rcpf(1.0f + __expf(-x)); }
DI float softplusf_(float x) { return x > 20.f ? x : log1pf(__expf(x)); }
DI float softplus_fast_(float x) { return fmaxf(x, 0.f) + __logf(1.0f + __expf(-fabsf(x))); }
DI float gelu_tanh_(float x) { const float u = 0.7978845608028654f * (x + 0.044715f * x * x * x); return x * __builtin_amdgcn_rcpf(1.0f + __expf(-2.0f * u)); }
DI float shx(float v, int o, int lane) { return __int_as_float(__builtin_amdgcn_ds_bpermute((lane ^ o) << 2, __float_as_int(v))); }
DI float shup(float v, int o, int lane) { return __int_as_float(__builtin_amdgcn_ds_bpermute((lane - o) << 2, __float_as_int(v))); }
DI float shidx(float v, int src) { return __int_as_float(__builtin_amdgcn_ds_bpermute(src << 2, __float_as_int(v))); }
#define DPP_F(old_, src_, ctrl_, rmask_) __int_as_float(__builtin_amdgcn_update_dpp(__float_as_int(old_), __float_as_int(src_), (ctrl_), (rmask_), 0xF, false))
DI float dpp_scan_sum(float v) {
    v += DPP_F(0.f, v, 0x111, 0xF); v += DPP_F(0.f, v, 0x112, 0xF); v += DPP_F(0.f, v, 0x114, 0xF); v += DPP_F(0.f, v, 0x118, 0xF);
    v += DPP_F(0.f, v, 0x142, 0xA); v += DPP_F(0.f, v, 0x143, 0xC); return v; }
DI float dpp_scan_max(float v) {
    const float ninf = -__builtin_inff();
    v = fmaxf(v, DPP_F(ninf, v, 0x111, 0xF)); v = fmaxf(v, DPP_F(ninf, v, 0x112, 0xF)); v = fmaxf(v, DPP_F(ninf, v, 0x114, 0xF)); v = fmaxf(v, DPP_F(ninf, v, 0x118, 0xF));
    v = fmaxf(v, DPP_F(ninf, v, 0x142, 0xA)); v = fmaxf(v, DPP_F(ninf, v, 0x143, 0xC)); return v; }
DI float lane63(float v) { return __int_as_float(__builtin_amdgcn_readlane(__float_as_int(v), 63)); }
DI float wave_sum(float v, int lane) {
#pragma unroll
    for (int o = 32; o >= 1; o >>= 1) v += shx(v, o, lane);
    return v; }
DI void unpack8(const u32x4 w, float (&f)[8]) { f[0] = bflo(w.x); f[1] = bfhi(w.x); f[2] = bflo(w.y); f[3] = bfhi(w.y); f[4] = bflo(w.z); f[5] = bfhi(w.z); f[6] = bflo(w.w); f[7] = bfhi(w.w); }
DI int lat_pos(int l, int s) { return (l & 1) ? (((s & 63) << 6) | (s >> 6)) : s; }

struct EpiProj {
    static constexpr bool PERM = true, AFTER_DRAIN = false;
    bf16_t* d0; int modes; float* gdst; int gtile; bf16_t* halo; int row_off;
    __device__ __forceinline__ void operator()(const f32x4 (&acc)[2][2][4][2], const Unit& u, int wr, int wc, int fr, int fq) const {
        const int row0 = row_off + u.pm * 256 + wr * 64 + fr;
        if (u.pn == gtile) {
            if (wc == 0) {
#pragma unroll
                for (int ai = 0; ai < 2; ++ai)
#pragma unroll
                    for (int m = 0; m < 4; ++m) { float* rp = gdst + (size_t)(row0 + ai * 128 + m * 16) * 32 + 8 * fq; *(f32x4*)rp = acc[ai][0][m][0]; *(f32x4*)(rp + 4) = acc[ai][0][m][1]; }
            }
            return;
        }
        const int seg = u.pn >> 2; bf16_t* base = d0 + (size_t)seg * (SZ_ACT / 2); const int md = (modes >> (2 * seg)) & 3;
        const int col0 = (u.pn & 3) * 256 + wc * 32 + 8 * fq;
#pragma unroll
        for (int ai = 0; ai < 2; ++ai)
#pragma unroll
            for (int m = 0; m < 4; ++m) {
                const int r = row0 + ai * 128 + m * 16;
                bf16_t* rowp = base + (size_t)r * 1024 + col0;
                int hidx = -1;
                if (halo) { if (m == 0 && fr < 2) hidx = fr; if (m == 3 && fr >= 14) hidx = fr - 12; }
#pragma unroll
                for (int bj = 0; bj < 2; ++bj) {
                    f32x4 v0 = acc[ai][bj][m][0], v1 = acc[ai][bj][m][1];
                    if (md == 1) {
#pragma unroll
                        for (int j = 0; j < 4; ++j) { v0[j] = siluf_(v0[j]); v1[j] = siluf_(v1[j]); } }
                    else if (md == 2) {
#pragma unroll
                        for (int j = 0; j < 4; ++j) { v0[j] = sigmoidf_(v0[j]); v1[j] = sigmoidf_(v1[j]); } }
                    u32x4 w; w.x = pg8::cvt_pk_bf16(v0[0], v0[1]); w.y = pg8::cvt_pk_bf16(v0[2], v0[3]); w.z = pg8::cvt_pk_bf16(v1[0], v1[1]); w.w = pg8::cvt_pk_bf16(v1[2], v1[3]);
                    *(u32x4*)(rowp + bj * 128) = w;
                    if (hidx >= 0) *(u32x4*)(halo + ((size_t)seg * (NCHUNK * 4) + (size_t)(r >> 6) * 4 + hidx) * 1024 + col0 + bj * 128) = w;
                }
            }
    }
};
struct EpiBranch {
    static constexpr bool PERM = true, AFTER_DRAIN = false;
    const bf16_t* G; bf16_t* MG; int first, row_off;
    __device__ __forceinline__ void operator()(const f32x4 (&acc)[2][2][4][2], const Unit& u, int wr, int wc, int fr, int fq) const {
        const int row0 = row_off + u.pm * 256 + wr * 64 + fr, col0 = u.pn * 256 + wc * 32 + 8 * fq;
#pragma unroll
        for (int ai = 0; ai < 2; ++ai)
#pragma unroll
            for (int m = 0; m < 4; ++m) {
                const size_t off = (size_t)(row0 + ai * 128 + m * 16) * 1024 + col0;
#pragma unroll
                for (int bj = 0; bj < 2; ++bj) {
                    const u32x4 gw = *(const u32x4*)(G + off + bj * 128);
                    float g[8], o[8]; unpack8(gw, g);
                    if (first) {
#pragma unroll
                        for (int j = 0; j < 8; ++j) o[j] = 0.f; }
                    else { const u32x4 ow = *(const u32x4*)(MG + off + bj * 128); unpack8(ow, o); }
                    const f32x4 v0 = acc[ai][bj][m][0], v1 = acc[ai][bj][m][1];
#pragma unroll
                    for (int j = 0; j < 4; ++j) { o[j] += g[j] * v0[j]; o[4 + j] += g[4 + j] * v1[j]; }
                    u32x4 w; w.x = pg8::cvt_pk_bf16(o[0], o[1]); w.y = pg8::cvt_pk_bf16(o[2], o[3]); w.z = pg8::cvt_pk_bf16(o[4], o[5]); w.w = pg8::cvt_pk_bf16(o[6], o[7]);
                    *(u32x4*)(MG + off + bj * 128) = w;
                }
                asm volatile("" ::: "memory");
            }
    }
};
struct EpiGlu {
    static constexpr bool PERM = true, AFTER_DRAIN = false;
    const bf16_t* SZ; bf16_t* O; const float* bias; int row_off;
    __device__ __forceinline__ void operator()(const f32x4 (&acc)[2][2][4][2], const Unit& u, int wr, int wc, int fr, int fq) const {
        const int row0 = row_off + u.pm * 256 + wr * 64 + fr, col0 = u.pn * 128 + wc * 32 + 8 * fq;
        float ba[8], bg[8];
#pragma unroll
        for (int j = 0; j < 8; ++j) { ba[j] = bias[col0 + j]; bg[j] = bias[1024 + col0 + j]; }
#pragma unroll
        for (int ai = 0; ai < 2; ++ai)
#pragma unroll
            for (int m = 0; m < 4; ++m) {
                const size_t off = (size_t)(row0 + ai * 128 + m * 16) * 1024 + col0;
                const u32x4 zw = *(const u32x4*)(SZ + off); float z[8], o[8]; unpack8(zw, z);
#pragma unroll
                for (int n = 0; n < 2; ++n)
#pragma unroll
                    for (int j = 0; j < 4; ++j) { const int c = 4 * n + j; o[c] = (acc[ai][0][m][n][j] + ba[c]) * sigmoidf_(acc[ai][1][m][n][j] + bg[c]) * z[c]; }
                u32x4 w; w.x = pg8::cvt_pk_bf16(o[0], o[1]); w.y = pg8::cvt_pk_bf16(o[2], o[3]); w.z = pg8::cvt_pk_bf16(o[4], o[5]); w.w = pg8::cvt_pk_bf16(o[6], o[7]);
                *(u32x4*)(O + off) = w;
            }
    }
};
struct EpiOut {
    static constexpr bool PERM = false, AFTER_DRAIN = false;
    const float* xlat_src; float* xlat_dst; const float* xctx_src; float* xctx_dst; const float* mod; int l; int row_off;
    __device__ __forceinline__ void operator()(const f32x4 (&acc)[2][2][4][2], const Unit& u, int wr, int wc, int fr, int fq) const {
        const int row0 = row_off + u.pm * 256 + wr * 64 + fr, col0 = u.pn * 256 + wc * 32 + 4 * fq;
#pragma unroll
        for (int ai = 0; ai < 2; ++ai)
#pragma unroll
            for (int m = 0; m < 4; ++m) {
                const int r = row0 + ai * 128 + m * 16;
                const float* xs; float* xd; const float* gp;
                if (r < CTXROWS) { xs = xctx_src + (size_t)r * 1024; xd = xctx_dst + (size_t)r * 1024; gp = mod + 8 * 3072 + 2048; }
                else { const int q = r - CTXROWS, b = q >> 12, p = lat_pos(l, q & 4095); const size_t o = ((size_t)b * 4096 + p) * 1024; xs = xlat_src + o; xd = xlat_dst + o; gp = mod + b * 3072 + 2048; }
#pragma unroll
                for (int bj = 0; bj < 2; ++bj)
#pragma unroll
                    for (int n = 0; n < 2; ++n) { const int c = col0 + bj * 128 + n * 16; const f32x4 x = *(const f32x4*)(xs + c), g = *(const f32x4*)(gp + c); *(f32x4*)(xd + c) = x + g * acc[ai][bj][m][n]; }
                asm volatile("" ::: "memory");
            }
    }
};

DI void ph_modp(const Args& a, float* modp, LAS float* sl) {
    for (int it = blockIdx.x; it < 384; it += gridDim.x) {
        const int l = it / 96, kq = (it / 6) % 16, nt = it % 6;
        __syncthreads();
        for (int i = ltid(a); i < 576; i += NT) { const int j = i >> 6, k = kq * 64 + (i & 63); const float cv = (j < 8) ? a.in[I_C][j * 1024 + k] : a.in[I_CCTX][k]; sl[i] = siluf_(cv); }
        __syncthreads();
        const int n = nt * 512 + ltid(a);
        float acc[9];
#pragma unroll
        for (int j = 0; j < 9; ++j) acc[j] = 0.f;
        const float* w = a.in[I_WADA] + ((size_t)l * 1024 + kq * 64) * 3072 + n;
#pragma unroll 4
        for (int k = 0; k < 64; ++k) { const float wv = w[(size_t)k * 3072];
#pragma unroll
            for (int j = 0; j < 9; ++j) acc[j] += sl[j * 64 + k] * wv; }
#pragma unroll
        for (int j = 0; j < 9; ++j) modp[(((size_t)kq * 4 + l) * 9 + j) * 3072 + n] = acc[j];
    }
}
DI void ph_mod(const Args& a, const float* modp, float* mod) {
    for (int i = blockIdx.x * NT + ltid(a); i < DEPTH * 9 * 3072; i += gridDim.x * NT) {
        const int l = i / (9 * 3072), n = i % 3072; float s = a.in[I_BADA][l * 3072 + n];
#pragma unroll
        for (int kq = 0; kq < 16; ++kq) s += modp[(size_t)kq * (DEPTH * 9 * 3072) + i];
        mod[i] = s;
    }
}
DI void ph_norm(const Args& a, int l, const float* xlat, const float* xctx, const float* mod, bf16_t* H) {
    const int wave = ltid(a) >> 6, lane = ltid(a) & 63;
    const float* g = a.in[I_NORMG] + l * 1024;
    for (int r = blockIdx.x * 8 + wave; r < MROWS; r += gridDim.x * 8) {
        const float* src; const float* md;
        if (r < CTXROWS) { src = xctx + (size_t)r * 1024; md = mod + 8 * 3072; }
        else { const int q = r - CTXROWS, b = q >> 12, p = lat_pos(l, q & 4095); src = xlat + ((size_t)b * 4096 + p) * 1024; md = mod + b * 3072; }
        f32x4 v[4]; float ss = 0.f;
#pragma unroll
        for (int i = 0; i < 4; ++i) { v[i] = *(const f32x4*)(src + i * 256 + lane * 4); ss += v[i][0] * v[i][0] + v[i][1] * v[i][1] + v[i][2] * v[i][2] + v[i][3] * v[i][3]; }
        ss = wave_sum(ss, lane);
        const float rs = rsqrtf(ss * (1.0f / 1024.0f) + 1e-6f);
#pragma unroll
        for (int i = 0; i < 4; ++i) { const int c = i * 256 + lane * 4;
            const f32x4 gv = *(const f32x4*)(g + c), sh = *(const f32x4*)(md + c), sc = *(const f32x4*)(md + 1024 + c);
            const f32x4 y = (v[i] * rs) * gv * (sc + 1.0f) + sh;
            u32x2 w; w.x = pg8::cvt_pk_bf16(y[0], y[1]); w.y = pg8::cvt_pk_bf16(y[2], y[3]);
            *(u32x2*)(H + (size_t)r * 1024 + c) = w; }
    }
}
DI void ph_final(const Args& a, float* x) {
    const int wave = ltid(a) >> 6, lane = ltid(a) & 63;
    const float* g = a.in[I_FNORM];
    for (int r = blockIdx.x * 8 + wave; r < NBATCH * SEQ; r += gridDim.x * 8) {
        float* src = x + (size_t)r * 1024;
        f32x4 v[4]; float ss = 0.f;
#pragma unroll
        for (int i = 0; i < 4; ++i) { v[i] = *(const f32x4*)(src + i * 256 + lane * 4); ss += v[i][0] * v[i][0] + v[i][1] * v[i][1] + v[i][2] * v[i][2] + v[i][3] * v[i][3]; }
        ss = wave_sum(ss, lane);
        const float rs = rsqrtf(ss * (1.0f / 1024.0f) + 1e-6f);
#pragma unroll
        for (int i = 0; i < 4; ++i) { const int c = i * 256 + lane * 4; const f32x4 gv = *(const f32x4*)(g + c); *(f32x4*)(src + c) = (v[i] * rs) * gv; }
    }
}
struct WDesc { const float* src; int ld, id, n64, tid; };
DI void wmap(int id, int nb, int& col, int& valid) {
    valid = 64;
    switch (id) {
        case 0: if (nb < 48) col = C_GQ + 64 * nb; else if (nb == 48) { col = C_GA; valid = 32; } else { col = 0; valid = 0; } break;
        case 1: col = (nb < 16) ? C_GZ + 64 * nb : C_GATE + 64 * (nb - 16); break;
        case 2: if (nb < 48) col = C_MQ + 64 * nb; else if (nb == 48) { col = C_MI; valid = 16; } else { col = 0; valid = 0; } break;
        case 3: col = (nb < 32) ? C_MO + 64 * nb : C_GATE + 2048 + 64 * (nb - 32); break;
        case 4: col = (nb < 32) ? C_SU + 64 * nb : C_GATE + 1024 + 64 * (nb - 32); break;
        case 5: { const int pn = nb >> 2, q = nb & 3; col = (q >> 1) * 1024 + 128 * pn + (q & 1) * 64; } break;
        default: col = 64 * nb; break;
    }
}
DI WDesc wdesc(const Args& a, int l, int id) {
    WDesc w; w.id = id; w.tid = ltid(a);
    if (id <= 4) { w.src = a.in[I_WIN] + (size_t)l * 1024 * NIN; w.ld = NIN; w.n64 = (id == 0 || id == 2) ? 52 : (id == 1 ? 32 : 48); }
    else if (id == 5) { w.src = a.in[I_SWGLU] + (size_t)l * 1024 * 2048; w.ld = 2048; w.n64 = 32; }
    else if (id <= 8) { w.src = a.in[I_WBR] + ((size_t)l * 3 + (id - 6)) * 1024 * 1024; w.ld = 1024; w.n64 = 16; }
    else { w.src = a.in[I_WOUT] + (size_t)l * 1024 * 1024; w.ld = 1024; w.n64 = 16; }
    return w;
}
DI void ph_cvt(const WDesc w, bf16_t* dst, LAS float* tile) {
    const int tid = w.tid, ntile = w.n64 * 16;
    const int r0 = tid >> 4, c4 = (tid & 15) * 4;
    f32x4 p0, p1; int buf = 0;
#define CVT_FETCH(t_) do { const int nb_ = (t_) >> 4, kb_ = (t_) & 15; int col_, valid_; wmap(w.id, nb_, col_, valid_); \
        const f32x4 z_ = (f32x4){0.f, 0.f, 0.f, 0.f}; const bool on_ = c4 < valid_; \
        p0 = on_ ? *(const f32x4*)(w.src + (size_t)(kb_ * 64 + r0) * w.ld + col_ + c4) : z_; p1 = on_ ? *(const f32x4*)(w.src + (size_t)(kb_ * 64 + r0 + 32) * w.ld + col_ + c4) : z_; } while (0)
    int t = blockIdx.x;
    if (t < ntile) CVT_FETCH(t);
    for (; t < ntile; t += gridDim.x) {
        LAS float* tl = tile + buf * (64 * 65);
        tl[r0 * 65 + c4] = p0[0]; tl[r0 * 65 + c4 + 1] = p0[1]; tl[r0 * 65 + c4 + 2] = p0[2]; tl[r0 * 65 + c4 + 3] = p0[3];
        tl[(r0 + 32) * 65 + c4] = p1[0]; tl[(r0 + 32) * 65 + c4 + 1] = p1[1]; tl[(r0 + 32) * 65 + c4 + 2] = p1[2]; tl[(r0 + 32) * 65 + c4 + 3] = p1[3];
        if (t + (int)gridDim.x < ntile) CVT_FETCH(t + (int)gridDim.x);
        lds_barrier();
        { const int nb = t >> 4, kb = t & 15, n = tid >> 3, kk = (tid & 7) * 8; u32x4 o;
          o.x = pg8::cvt_pk_bf16(tl[(kk + 0) * 65 + n], tl[(kk + 1) * 65 + n]); o.y = pg8::cvt_pk_bf16(tl[(kk + 2) * 65 + n], tl[(kk + 3) * 65 + n]);
          o.z = pg8::cvt_pk_bf16(tl[(kk + 4) * 65 + n], tl[(kk + 5) * 65 + n]); o.w = pg8::cvt_pk_bf16(tl[(kk + 6) * 65 + n], tl[(kk + 7) * 65 + n]);
          *(u32x4*)(dst + (size_t)(nb * 64 + n) * 1024 + kb * 64 + kk) = o; }
        buf ^= 1;
    }
#undef CVT_FETCH
    __syncthreads();
}

DI void gdn_conv_decode(int unit, int& cb, int& seg, int& h) { cb = unit / 24; seg = (unit % 24) >> 3; h = unit & 7; }
DI void ph_gdn_conv(const Args& a, int l, bf16_t* QKV  , const bf16_t* halo, LAS unsigned char* lds, bf16_t* junk = nullptr) {
    constexpr int P = 136, IMG = 68 * P * 2 + 5 * 128 * 4;
    const int tid = ltid(a);
    const float* cw = a.in[I_GCONV] + (size_t)l * 5 * 3072;
    const int nunit = NCHUNK * 24;
    u32x4 rp[3]; f32x4 wreg = (f32x4){0.f, 0.f, 0.f, 0.f};
    int unit = blockIdx.x, buf = 0;
#define CONV_FETCH(un) do { int cb_, seg_, h_; gdn_conv_decode(un, cb_, seg_, h_); const bf16_t* T_ = QKV + (size_t)seg_ * (SZ_ACT / 2); \
        const bool first_ = (cb_ < 32) ? ((cb_ & 3) == 0) : (((cb_ - 32) & 63) == 0), last_ = (cb_ < 32) ? ((cb_ & 3) == 3) : (((cb_ - 32) & 63) == 63); \
        _Pragma("unroll") for (int q_ = 0; q_ < 3; ++q_) { const int i_ = tid + 512 * q_, rr_ = i_ >> 4, c8_ = (i_ & 15) * 8; u32x4 w_ = (u32x4){0u, 0u, 0u, 0u}; \
            if (i_ < 68 * 16) { if (rr_ >= 2 && rr_ < 66) w_ = *(const u32x4*)(T_ + (size_t)(cb_ * 64 + rr_ - 2) * 1024 + h_ * 128 + c8_); \
                else if (rr_ < 2) { if (!first_) w_ = *(const u32x4*)(halo + ((size_t)seg_ * (NCHUNK * 4) + (size_t)(cb_ - 1) * 4 + 2 + rr_) * 1024 + h_ * 128 + c8_); } \
                else { if (!last_) w_ = *(const u32x4*)(halo + ((size_t)seg_ * (NCHUNK * 4) + (size_t)(cb_ + 1) * 4 + (rr_ - 66)) * 1024 + h_ * 128 + c8_); } } \
            rp[q_] = w_; } \
        if (tid < 160) wreg = *(const f32x4*)(cw + (size_t)(tid >> 5) * 3072 + seg_ * 1024 + h_ * 128 + (tid & 31) * 4); } while (0)
    if (unit < nunit) CONV_FETCH(unit);
    for (; unit < nunit; unit += gridDim.x) {
        int cb, seg, h; gdn_conv_decode(unit, cb, seg, h);
        LAS bf16_t* raw = (LAS bf16_t*)(lds + buf * IMG); LAS float* wl = (LAS float*)(lds + buf * IMG + 68 * P * 2);
#pragma unroll
        for (int q = 0; q < 3; ++q) { const int i = tid + 512 * q, rr = i >> 4, c8 = (i & 15) * 8; if (i < 68 * 16) *(LAS u32x4*)(raw + rr * P + c8) = rp[q]; }
        if (tid < 160) *(LAS f32x4*)(wl + tid * 4) = wreg;
        if (unit + (int)gridDim.x < nunit) CONV_FETCH(unit + (int)gridDim.x);
        lds_barrier();
        bf16_t* T = QKV + (size_t)seg * (SZ_ACT / 2);
        const int t = tid >> 3, c0 = (tid & 7) * 16;
        float o[16]; float ss = 0.f;
#pragma unroll
        for (int half = 0; half < 2; ++half) {
            float acc[8];
#pragma unroll
            for (int j = 0; j < 8; ++j) acc[j] = 0.f;
#pragma unroll
            for (int k = 0; k < 5; ++k) {
                const u32x4 w = *(const LAS u32x4*)(raw + (t + k) * P + c0 + half * 8); float x[8]; unpack8(w, x);
                const f32x4 w0 = *(const LAS f32x4*)(wl + k * 128 + c0 + half * 8), w1 = *(const LAS f32x4*)(wl + k * 128 + c0 + half * 8 + 4);
#pragma unroll
                for (int j = 0; j < 4; ++j) { acc[j] += w0[j] * x[j]; acc[4 + j] += w1[j] * x[4 + j]; }
            }
#pragma unroll
            for (int j = 0; j < 8; ++j) { const float sv = siluf_(acc[j]); o[half * 8 + j] = sv; ss += sv * sv; }
        }
        ss += shx(ss, 1, tid & 63); ss += shx(ss, 2, tid & 63); ss += shx(ss, 4, tid & 63);
        float scale = 1.0f;
        if (seg == 0) scale = rsqrtf(ss + 1e-6f) * 0.08838834764831845f;
        else if (seg == 1) scale = rsqrtf(ss + 1e-6f);
        u32x4 w0, w1;
        w0.x = pg8::cvt_pk_bf16(o[0] * scale, o[1] * scale); w0.y = pg8::cvt_pk_bf16(o[2] * scale, o[3] * scale); w0.z = pg8::cvt_pk_bf16(o[4] * scale, o[5] * scale); w0.w = pg8::cvt_pk_bf16(o[6] * scale, o[7] * scale);
        w1.x = pg8::cvt_pk_bf16(o[8] * scale, o[9] * scale); w1.y = pg8::cvt_pk_bf16(o[10] * scale, o[11] * scale); w1.z = pg8::cvt_pk_bf16(o[12] * scale, o[13] * scale); w1.w = pg8::cvt_pk_bf16(o[14] * scale, o[15] * scale);
        bf16_t* op = (junk ? junk : T) + (size_t)(cb * 64 + t) * 1024 + h * 128 + c0;
        *(u32x4*)op = w0; *(u32x4*)(op + 8) = w1;
        buf ^= 1;
    }
#undef CONV_FETCH
    __syncthreads();
}
DI void ph_gdn_scan(const Args& a, int l, const bf16_t* Q, const bf16_t* K, const bf16_t* V, const float* GATE, bf16_t* OF, bf16_t* OB, LAS unsigned char* lds) {
    LAS float* qf = (LAS float*)lds;
    LAS float* kf = qf + 64 * 128;
    LAS float* vf = kf + 64 * 128;
    LAS float* av = vf + 64 * 64;
    LAS float* bt = av + 64;
    LAS float* part = bt + 64;
    LAS float* po = part + 1024;
    const int tid = ltid(a), e = tid & 63, dq = tid >> 6;
    for (int unit = blockIdx.x; unit < 256; unit += gridDim.x) {
        const int eh = unit & 1, d = (unit >> 1) & 1, h = (unit >> 2) & 7, b = unit >> 5;
        const float nea = -__expf(a.in[I_GALOG][(l * 2 + d) * 8 + h]), dtb = a.in[I_GDTB][(l * 2 + d) * 8 + h];
        bf16_t* O = d ? OB : OF;
        float S[16];
#pragma unroll
        for (int j = 0; j < 16; ++j) S[j] = 0.f;
        float opart = 0.f; int prow = -1, par = 0;
        for (int step = 0; step < 68; ++step) {
            const int cc = (step < 4) ? (d ? 3 - step : step) : (d ? 67 - step : step - 4);
            const int row0 = (step < 4) ? b * 256 + cc * 64 : CTXROWS + b * 4096 + cc * 64;
            __syncthreads();
            for (int i = tid; i < 1024; i += NT) { const int r = i >> 4, c8 = (i & 15) * 8; float f[8];
                unpack8(*(const u32x4*)(Q + (size_t)(row0 + r) * 1024 + h * 128 + c8), f);
#pragma unroll
                for (int j = 0; j < 8; ++j) qf[r * 128 + c8 + j] = f[j];
                unpack8(*(const u32x4*)(K + (size_t)(row0 + r) * 1024 + h * 128 + c8), f);
#pragma unroll
                for (int j = 0; j < 8; ++j) kf[r * 128 + c8 + j] = f[j]; }
            { const int r = tid >> 3, c8 = (tid & 7) * 8; float f[8]; unpack8(*(const u32x4*)(V + (size_t)(row0 + r) * 1024 + h * 128 + eh * 64 + c8), f);
#pragma unroll
              for (int j = 0; j < 8; ++j) vf[r * 64 + c8 + j] = f[j]; }
            if (tid < 64) { const float* gp = GATE + (size_t)(row0 + tid) * 32; av[tid] = __expf(nea * softplusf_(gp[d * 8 + h] + dtb)); bt[tid] = sigmoidf_(gp[16 + d * 8 + h]); }
            __syncthreads();
            for (int tt = 0; tt < 64; ++tt) {
                const int t = d ? 63 - tt : tt;
                float kk[16];
#pragma unroll
                for (int j4 = 0; j4 < 4; ++j4) { const f32x4 x = *(const LAS f32x4*)(kf + t * 128 + dq * 16 + j4 * 4); kk[j4 * 4] = x[0]; kk[j4 * 4 + 1] = x[1]; kk[j4 * 4 + 2] = x[2]; kk[j4 * 4 + 3] = x[3]; }
                float p = 0.f;
#pragma unroll
                for (int j = 0; j < 16; ++j) p += kk[j] * S[j];
                part[(par * 8 + dq) * 64 + e] = p; po[(par * 8 + dq) * 64 + e] = opart;
                __syncthreads();
                if (dq == 0 && prow >= 0) { float o = 0.f;
#pragma unroll
                    for (int q = 0; q < 8; ++q) o += po[(par * 8 + q) * 64 + e];
                    O[(size_t)prow * 1024 + h * 128 + eh * 64 + e] = f2bf(o); }
                float ks = 0.f;
#pragma unroll
                for (int q = 0; q < 8; ++q) ks += part[(par * 8 + q) * 64 + e];
                const float at = av[t], vn = bt[t] * (vf[t * 64 + e] - at * ks);
#pragma unroll
                for (int j = 0; j < 16; ++j) S[j] = at * S[j] + kk[j] * vn;
                float qo = 0.f;
#pragma unroll
                for (int j4 = 0; j4 < 4; ++j4) { const f32x4 x = *(const LAS f32x4*)(qf + t * 128 + dq * 16 + j4 * 4); qo += x[0] * S[j4 * 4] + x[1] * S[j4 * 4 + 1] + x[2] * S[j4 * 4 + 2] + x[3] * S[j4 * 4 + 3]; }
                opart = qo; prow = row0 + t; par ^= 1;
            }
        }
        po[(par * 8 + dq) * 64 + e] = opart;
        __syncthreads();
        if (dq == 0) { float o = 0.f;
#pragma unroll
            for (int q = 0; q < 8; ++q) o += po[(par * 8 + q) * 64 + e];
            O[(size_t)prow * 1024 + h * 128 + eh * 64 + e] = f2bf(o); }
        __syncthreads();
    }
}
template <int O> DI float swz_xor(float v) { return __int_as_float(__builtin_amdgcn_ds_swizzle(__float_as_int(v), 0x1F | (O << 10))); }
DI void ph_gdn_post(const Args& a, int l, bf16_t* OF, const bf16_t* OB, const bf16_t* SZ, bf16_t* junk = nullptr) {
    const int tid = ltid(a), wave = tid >> 6, lane = tid & 63;
    const float* g = a.in[I_GNORM] + l * 128 + (lane & 15) * 8;
    const f32x4 g0 = *(const f32x4*)g, g1 = *(const f32x4*)(g + 4);
    const int nit = MROWS * 2, stride = gridDim.x * 8;
    for (int it = blockIdx.x * 8 + wave; it < nit; it += 2 * stride) {
        const int it1 = it + stride; const bool two = it1 < nit;
        const size_t off0 = (size_t)it * 512 + lane * 8, off1 = (size_t)(two ? it1 : it) * 512 + lane * 8;
        const u32x4 f0 = *(const u32x4*)(OF + off0), b0 = *(const u32x4*)(OB + off0), z0 = *(const u32x4*)(SZ + off0);
        const u32x4 f1 = *(const u32x4*)(OF + off1), b1 = *(const u32x4*)(OB + off1), z1 = *(const u32x4*)(SZ + off1);
        float x0[8], x1[8], t0[8], t1[8];
        unpack8(f0, x0); unpack8(b0, t0); unpack8(f1, x1); unpack8(b1, t1);
        float s0 = 0.f, s1 = 0.f;
#pragma unroll
        for (int j = 0; j < 8; ++j) { x0[j] += t0[j]; x1[j] += t1[j]; s0 += x0[j] * x0[j]; s1 += x1[j] * x1[j]; }
        s0 += swz_xor<1>(s0); s1 += swz_xor<1>(s1); s0 += swz_xor<2>(s0); s1 += swz_xor<2>(s1); s0 += swz_xor<4>(s0); s1 += swz_xor<4>(s1); s0 += swz_xor<8>(s0); s1 += swz_xor<8>(s1);
        const float r0 = rsqrtf(s0 * (1.0f / 128.0f) + 1e-6f), r1 = rsqrtf(s1 * (1.0f / 128.0f) + 1e-6f);
        unpack8(z0, t0); unpack8(z1, t1);
        u32x4 w0, w1;
        w0.x = pg8::cvt_pk_bf16(x0[0] * r0 * g0[0] * t0[0], x0[1] * r0 * g0[1] * t0[1]); w0.y = pg8::cvt_pk_bf16(x0[2] * r0 * g0[2] * t0[2], x0[3] * r0 * g0[3] * t0[3]);
        w0.z = pg8::cvt_pk_bf16(x0[4] * r0 * g1[0] * t0[4], x0[5] * r0 * g1[1] * t0[5]); w0.w = pg8::cvt_pk_bf16(x0[6] * r0 * g1[2] * t0[6], x0[7] * r0 * g1[3] * t0[7]);
        w1.x = pg8::cvt_pk_bf16(x1[0] * r1 * g0[0] * t1[0], x1[1] * r1 * g0[1] * t1[1]); w1.y = pg8::cvt_pk_bf16(x1[2] * r1 * g0[2] * t1[2], x1[3] * r1 * g0[3] * t1[3]);
        w1.z = pg8::cvt_pk_bf16(x1[4] * r1 * g1[0] * t1[4], x1[5] * r1 * g1[1] * t1[5]); w1.w = pg8::cvt_pk_bf16(x1[6] * r1 * g1[2] * t1[6], x1[7] * r1 * g1[3] * t1[7]);
        bf16_t* dst = junk ? junk : OF;
        *(u32x4*)(dst + off0) = w0; if (two) *(u32x4*)(dst + off1) = w1;
    }
}

DI void ph_ml_scan(const Args& a, int l, const bf16_t* Q, const bf16_t* K, const bf16_t* V, const float* GATE, bf16_t* HF, bf16_t* HB, LAS unsigned char* lds) {
    LAS bf16_t* qs = (LAS bf16_t*)lds;
    LAS bf16_t* ks = qs + 64 * 256;
    LAS float* vf = (LAS float*)(ks + 64 * 256);
    LAS float* ip = vf + 64 * 64;
    LAS float* lf = ip + 64;
    LAS float* part = lf + 64;
    LAS float* dpart = part + 1024;
    const int tid = ltid(a), e = tid & 63, dq = tid >> 6;
    for (int unit = blockIdx.x; unit < 256; unit += gridDim.x) {
        const int eq = unit & 3, d = (unit >> 2) & 1, hd = (unit >> 3) & 3, b = unit >> 5;
        const float ibias = a.in[I_MIB][(l * 2 + d) * 4 + hd], fbias = a.in[I_MFB][(l * 2 + d) * 4 + hd];
        bf16_t* HO = d ? HB : HF;
        float C[32];
#pragma unroll
        for (int j = 0; j < 32; ++j) C[j] = 0.f;
        float nn = 0.f, m = 0.f; int par = 0;
        for (int step = 0; step < 68; ++step) {
            const int cc = (step < 4) ? (d ? 3 - step : step) : (d ? 67 - step : step - 4);
            const int row0 = (step < 4) ? b * 256 + cc * 64 : CTXROWS + b * 4096 + cc * 64;
            __syncthreads();
            for (int i = tid; i < 2048; i += NT) { const int r = i >> 5, c8 = (i & 31) * 8;
                *(LAS u32x4*)(qs + r * 256 + c8) = *(const u32x4*)(Q + (size_t)(row0 + r) * 1024 + hd * 256 + c8);
                *(LAS u32x4*)(ks + r * 256 + c8) = *(const u32x4*)(K + (size_t)(row0 + r) * 1024 + hd * 256 + c8); }
            { const int r = tid >> 3, c8 = (tid & 7) * 8; float f[8]; unpack8(*(const u32x4*)(V + (size_t)(row0 + r) * 1024 + hd * 256 + eq * 64 + c8), f);
#pragma unroll
              for (int j = 0; j < 8; ++j) vf[r * 64 + c8 + j] = f[j]; }
            if (tid < 64) { const float* gp = GATE + (size_t)(row0 + tid) * 32; ip[tid] = gp[d * 4 + hd] + ibias; lf[tid] = -softplusf_(-(gp[8 + d * 4 + hd] + fbias)); }
            __syncthreads();
            for (int tt = 0; tt < 64; ++tt) {
                const int t = d ? 63 - tt : tt;
                const float it = ip[t], ft = lf[t];
                const float mn = fmaxf(ft + m, it);
                const float fdec = __expf(ft + m - mn), iw = __expf(it - mn) * 0.0625f, nrm = __expf(-mn);
                m = mn;
                const float vv = iw * vf[t * 64 + e];
                float pn = 0.f;
#pragma unroll
                for (int j8 = 0; j8 < 4; ++j8) {
                    float kk[8], qq[8];
                    unpack8(*(const LAS u32x4*)(ks + t * 256 + dq * 32 + j8 * 8), kk);
                    unpack8(*(const LAS u32x4*)(qs + t * 256 + dq * 32 + j8 * 8), qq);
#pragma unroll
                    for (int j = 0; j < 8; ++j) { const float c = fdec * C[j8 * 8 + j] + vv * kk[j]; C[j8 * 8 + j] = c; pn += c * qq[j]; }
                }
                const int dn = dq * 32 + (e & 31);
                nn = fdec * nn + iw * bf2f(ks[t * 256 + dn]);
                float pd = (e < 32) ? nn * bf2f(qs[t * 256 + dn]) : 0.f;
                pd = wave_sum(pd, e);
                part[(par * 8 + dq) * 64 + e] = pn; if (e == 0) dpart[par * 8 + dq] = pd;
                __syncthreads();
                if (dq == 0) { float num = 0.f, den = 0.f;
#pragma unroll
                    for (int q = 0; q < 8; ++q) { num += part[(par * 8 + q) * 64 + e]; den += dpart[par * 8 + q]; }
                    HO[(size_t)(row0 + t) * 1024 + hd * 256 + eq * 64 + e] = f2bf(num / fmaxf(fabsf(den), nrm)); }
                par ^= 1;
            }
        }
        __syncthreads();
    }
}
DI void ph_ml_post(const Args& a, int l, bf16_t* HF, const bf16_t* HB, const bf16_t* SO, const bf16_t* SZ) {
    const int tid = ltid(a), wave = tid >> 6, lane = tid & 63;
    const float* g = a.in[I_MNORM] + l * 256 + (lane & 31) * 8;
    const f32x4 g0 = *(const f32x4*)g, g1 = *(const f32x4*)(g + 4);
    const int nit = MROWS * 2, stride = gridDim.x * 8;
    for (int it = blockIdx.x * 8 + wave; it < nit; it += stride) {
        const size_t off = (size_t)it * 512 + lane * 8;
        const u32x4 f0 = *(const u32x4*)(HF + off), b0 = *(const u32x4*)(HB + off), o0 = *(const u32x4*)(SO + off), z0 = *(const u32x4*)(SZ + off);
        float x[8], t0[8];
        unpack8(f0, x); unpack8(b0, t0);
#pragma unroll
        for (int j = 0; j < 8; ++j) x[j] += t0[j];
        unpack8(o0, t0);
        float s0 = 0.f;
#pragma unroll
        for (int j = 0; j < 8; ++j) { x[j] *= t0[j]; s0 += x[j] * x[j]; }
        s0 += swz_xor<1>(s0); s0 += swz_xor<2>(s0); s0 += swz_xor<4>(s0); s0 += swz_xor<8>(s0); s0 += swz_xor<16>(s0);
        const float r0 = rsqrtf(s0 * (1.0f / 256.0f) + 1e-6f);
        unpack8(z0, t0);
        u32x4 w0;
        w0.x = pg8::cvt_pk_bf16(x[0] * r0 * g0[0] * t0[0], x[1] * r0 * g0[1] * t0[1]); w0.y = pg8::cvt_pk_bf16(x[2] * r0 * g0[2] * t0[2], x[3] * r0 * g0[3] * t0[3]);
        w0.z = pg8::cvt_pk_bf16(x[4] * r0 * g1[0] * t0[4], x[5] * r0 * g1[1] * t0[5]); w0.w = pg8::cvt_pk_bf16(x[6] * r0 * g1[2] * t0[6], x[7] * r0 * g1[3] * t0[7]);
        *(u32x4*)(HF + off) = w0;
    }
}

DI void ph_s5_scan(const Args& a, int l, const bf16_t* U, bf16_t* YF, bf16_t* YB, LAS unsigned char* lds) {
    const int tid = ltid(a), w = tid >> 6, p = tid & 63;
    LAS float* ub = (LAS float*)lds + w * 2304;
    LAS float* yb = ub + 1024;
    LAS float* xb = yb + 1024;
    for (int unit = blockIdx.x; unit < 128; unit += gridDim.x) {
        const int gb = unit & 7, d = (unit >> 3) & 1, b = unit >> 4, g = gb * 8 + w;
        const float stp = expf(a.in[I_SLOG][(l * 2 + d) * 64 + g]);
        const float lre = a.in[I_SLRE][((size_t)(l * 2 + d) * 64 + g) * 64 + p], lim = a.in[I_SLIM][((size_t)(l * 2 + d) * 64 + g) * 64 + p];
        const float mag = expf(lre * stp), lbr = mag * cosf(lim * stp), lbi = mag * sinf(lim * stp);
        const float dnm = lre * lre + lim * lim;
        const float fre = ((lbr - 1.0f) * lre + lbi * lim) / dnm, fim = (lbi * lre - (lbr - 1.0f) * lim) / dnm;
        float bbr[16], bbi[16];
        { const float* br = a.in[I_SBRE] + (((size_t)l * 64 + g) * 64 + p) * 16; const float* bi = a.in[I_SBIM] + (((size_t)l * 64 + g) * 64 + p) * 16;
#pragma unroll
          for (int h = 0; h < 16; ++h) { bbr[h] = fre * br[h] - fim * bi[h]; bbi[h] = fre * bi[h] + fim * br[h]; } }
        const int hh = p & 15, pt = p >> 4;
        float cr[16], ci[16];
        { const float* c0 = a.in[I_SCRE] + (((size_t)l * 64 + g) * 16 + hh) * 64 + pt * 16; const float* c1 = a.in[I_SCIM] + (((size_t)l * 64 + g) * 16 + hh) * 64 + pt * 16;
#pragma unroll
          for (int j = 0; j < 16; ++j) { cr[j] = c0[j]; ci[j] = c1[j]; } }
        bf16_t* Y = d ? YB : YF;
        float xr = 0.f, xi = 0.f; int par = 0;
        for (int step = 0; step < 68; ++step) {
            const int cc = (step < 4) ? (d ? 3 - step : step) : (d ? 67 - step : step - 4);
            const int row0 = (step < 4) ? b * 256 + cc * 64 : CTXROWS + b * 4096 + cc * 64;
            __syncthreads();
            { const bf16_t* up = U + (size_t)(row0 + p) * 1024 + g * 16; float f[8];
              unpack8(*(const u32x4*)up, f);
#pragma unroll
              for (int j = 0; j < 8; ++j) ub[p * 16 + j] = f[j];
              unpack8(*(const u32x4*)(up + 8), f);
#pragma unroll
              for (int j = 0; j < 8; ++j) ub[p * 16 + 8 + j] = f[j]; }
            __syncthreads();
            for (int tt = 0; tt < 64; ++tt) {
                const int t = d ? 63 - tt : tt;
                float bur = 0.f, bui = 0.f;
#pragma unroll
                for (int h4 = 0; h4 < 4; ++h4) { const f32x4 u = *(const LAS f32x4*)(ub + t * 16 + h4 * 4);
#pragma unroll
                    for (int j = 0; j < 4; ++j) { bur += bbr[h4 * 4 + j] * u[j]; bui += bbi[h4 * 4 + j] * u[j]; } }
                const float nxr = lbr * xr - lbi * xi + bur, nxi = lbr * xi + lbi * xr + bui;
                xr = nxr; xi = nxi;
                xb[par * 128 + p] = xr; xb[par * 128 + 64 + p] = xi;
                __syncthreads();
                float y = 0.f;
#pragma unroll
                for (int j4 = 0; j4 < 4; ++j4) { const f32x4 vr = *(const LAS f32x4*)(xb + par * 128 + pt * 16 + j4 * 4), vi = *(const LAS f32x4*)(xb + par * 128 + 64 + pt * 16 + j4 * 4);
#pragma unroll
                    for (int j = 0; j < 4; ++j) y += cr[j4 * 4 + j] * vr[j] - ci[j4 * 4 + j] * vi[j]; }
                y += shx(y, 16, p); y += shx(y, 32, p);
                if (p < 16) yb[t * 16 + p] = y;
                par ^= 1;
            }
            __syncthreads();
            { u32x4 w0, w1; const LAS float* ys = yb + p * 16;
              w0.x = pg8::cvt_pk_bf16(ys[0], ys[1]); w0.y = pg8::cvt_pk_bf16(ys[2], ys[3]); w0.z = pg8::cvt_pk_bf16(ys[4], ys[5]); w0.w = pg8::cvt_pk_bf16(ys[6], ys[7]);
              w1.x = pg8::cvt_pk_bf16(ys[8], ys[9]); w1.y = pg8::cvt_pk_bf16(ys[10], ys[11]); w1.z = pg8::cvt_pk_bf16(ys[12], ys[13]); w1.w = pg8::cvt_pk_bf16(ys[14], ys[15]);
              bf16_t* yp = Y + (size_t)(row0 + p) * 1024 + g * 16; *(u32x4*)yp = w0; *(u32x4*)(yp + 8) = w1; }
        }
        __syncthreads();
    }
}
DI void ph_s5_post(const Args& a, int l, bf16_t* YF, const bf16_t* YB, const bf16_t* U) {
    const float* dsk = a.in[I_SD] + l * 1024;
    for (size_t i = (size_t)blockIdx.x * NT + ltid(a); i < (size_t)MROWS * 128; i += (size_t)gridDim.x * NT) {
        const size_t off = i * 8; const int c = (int)(off & 1023);
        float f[8], bq[8], u[8]; unpack8(*(const u32x4*)(YF + off), f); unpack8(*(const u32x4*)(YB + off), bq); unpack8(*(const u32x4*)(U + off), u);
        const f32x4 d0 = *(const f32x4*)(dsk + c), d1 = *(const f32x4*)(dsk + c + 4);
        float o[8];
#pragma unroll
        for (int j = 0; j < 4; ++j) { o[j] = gelu_tanh_(f[j] + bq[j] + d0[j] * u[j]); o[4 + j] = gelu_tanh_(f[4 + j] + bq[4 + j] + d1[j] * u[4 + j]); }
        u32x4 w; w.x = pg8::cvt_pk_bf16(o[0], o[1]); w.y = pg8::cvt_pk_bf16(o[2], o[3]); w.z = pg8::cvt_pk_bf16(o[4], o[5]); w.w = pg8::cvt_pk_bf16(o[6], o[7]);
        *(u32x4*)(YF + off) = w;
    }
}

constexpr int S5_T = 16, S5_NCH = MROWS / S5_T  , S5_RG = 2304, S5_PMG = S5_RG / 256;
constexpr size_t SZ_AX = (size_t)64 * S5_RG * 512 * 2, SZ_CW1 = (size_t)64 * 256 * 256 * 2, SZ_CW2 = (size_t)64 * 256 * 512 * 2;
constexpr size_t R5_AX = 0, R5_SZ = R_OB, R5_G1 = R_M5, R5_GLUA = R_M5 + SZ_ACT;
static_assert(SZ_AX <= 3 * SZ_ACT, "S5 chunk rows fit the q|k|v tensors"); static_assert(WS_END <= (size_t)940 * 1000 * 1000, "workspace budget");
static_assert(SZ_CW1 + SZ_CW2 + (size_t)17 * 1024 * 128 * 4 <= SZ_ACT, "S5 constants live in the H region once the last projection from H is done");

struct EpiS1 {
    static constexpr bool PERM = true, AFTER_DRAIN = false;
    bf16_t* AX; bf16_t* SZ; bf16_t* G1;
    __device__ __forceinline__ void operator()(const f32x4 (&acc)[2][2][4][2], const Unit& u, int wr, int wc, int fr, int fq) const {
        const int row0 = u.pm * 256 + wr * 64 + fr, seg = u.pn >> 2;
        const int col0 = (u.pn & 3) * 256 + wc * 32 + 8 * fq;
#pragma unroll
        for (int ai = 0; ai < 2; ++ai)
#pragma unroll
            for (int m = 0; m < 4; ++m) {
                const int r = row0 + ai * 128 + m * 16;
#pragma unroll
                for (int bj = 0; bj < 2; ++bj) {
                    f32x4 v0 = acc[ai][bj][m][0], v1 = acc[ai][bj][m][1];
                    const int c = col0 + bj * 128;
                    bf16_t* dp;
                    if (seg == 0) dp = AX + ((size_t)(c >> 4) * S5_RG + (r >> 4)) * 512 + (r & 15) * 16 + (c & 15);
                    else if (seg == 1) { dp = SZ + (size_t)r * 1024 + c;
#pragma unroll
                        for (int j = 0; j < 4; ++j) { v0[j] = siluf_(v0[j]); v1[j] = siluf_(v1[j]); } }
                    else { dp = G1 + (size_t)r * 1024 + c;
#pragma unroll
                        for (int j = 0; j < 4; ++j) { v0[j] = sigmoidf_(v0[j]); v1[j] = sigmoidf_(v1[j]); } }
                    u32x4 w; w.x = pg8::cvt_pk_bf16(v0[0], v0[1]); w.y = pg8::cvt_pk_bf16(v0[2], v0[3]); w.z = pg8::cvt_pk_bf16(v1[0], v1[1]); w.w = pg8::cvt_pk_bf16(v1[2], v1[3]);
                    *(u32x4*)dp = w;
                }
            }
    }
};
struct EpiS5L {
    static constexpr bool PERM = true, AFTER_DRAIN = false;
    bf16_t* AX;
    __device__ __forceinline__ void operator()(const f32x4 (&acc)[2][2][4][2], const Unit& u, int wr, int wc, int fr, int fq) const {
        const int g = u.pm / S5_PMG, rg0 = (u.pm % S5_PMG) * 256 + wr * 64 + fr, col0 = wc * 32 + 8 * fq;
#pragma unroll
        for (int ai = 0; ai < 2; ++ai)
#pragma unroll
            for (int m = 0; m < 4; ++m) {
                const int rg = rg0 + ai * 128 + m * 16;
                if (rg < S5_NCH) {
                    bf16_t* rp = AX + ((size_t)g * S5_RG + rg) * 512 + 256 + col0;
#pragma unroll
                    for (int bj = 0; bj < 2; ++bj) { const f32x4 v0 = acc[ai][bj][m][0], v1 = acc[ai][bj][m][1];
                        u32x4 w; w.x = pg8::cvt_pk_bf16(v0[0], v0[1]); w.y = pg8::cvt_pk_bf16(v0[2], v0[3]); w.z = pg8::cvt_pk_bf16(v1[0], v1[1]); w.w = pg8::cvt_pk_bf16(v1[2], v1[3]);
                        *(u32x4*)(rp + bj * 128) = w; }
                }
            }
    }
};
struct EpiS5Y {
    static constexpr bool PERM = true, AFTER_DRAIN = false;
    const bf16_t* AX; bf16_t* GLUA; const float* dsk;
    __device__ __forceinline__ void operator()(const f32x4 (&acc)[2][2][4][2], const Unit& u, int wr, int wc, int fr, int fq) const {
        const int g = u.pm / S5_PMG, rg0 = (u.pm % S5_PMG) * 256 + wr * 64 + fr, col0 = wc * 32 + 8 * fq;
        const int h0 = col0 & 15;
        const f32x4 d0 = *(const f32x4*)(dsk + g * 16 + h0), d1 = *(const f32x4*)(dsk + g * 16 + h0 + 4);
#pragma unroll
        for (int ai = 0; ai < 2; ++ai)
#pragma unroll
            for (int m = 0; m < 4; ++m) {
                const int rg = rg0 + ai * 128 + m * 16;
                if (rg < S5_NCH) {
#pragma unroll
                    for (int bj = 0; bj < 2; ++bj) {
                        const int c = col0 + bj * 128, t = c >> 4;
                        float uu[8]; unpack8(*(const u32x4*)(AX + ((size_t)g * S5_RG + rg) * 512 + c), uu);
                        const f32x4 v0 = acc[ai][bj][m][0], v1 = acc[ai][bj][m][1];
                        float o[8];
#pragma unroll
                        for (int j = 0; j < 4; ++j) { o[j] = gelu_tanh_(v0[j] + d0[j] * uu[j]); o[4 + j] = gelu_tanh_(v1[j] + d1[j] * uu[4 + j]); }
                        u32x4 w; w.x = pg8::cvt_pk_bf16(o[0], o[1]); w.y = pg8::cvt_pk_bf16(o[2], o[3]); w.z = pg8::cvt_pk_bf16(o[4], o[5]); w.w = pg8::cvt_pk_bf16(o[6], o[7]);
                        *(u32x4*)(GLUA + (size_t)(rg * 16 + t) * 1024 + g * 16 + h0) = w;
                    }
                }
            }
    }
};
DI void ph_s5_consts(const Args& a, int l, bf16_t* CW1, bf16_t* CW2, LAS unsigned char* lds) {
    LAS float* POW = (LAS float*)lds;
    LAS float* BB = POW + 2 * 17 * 64 * 2;
    LAS float* CC = BB + 2 * 64 * 16 * 2;
    LAS float* KT = CC + 16 * 64 * 2;
    const int tid = ltid(a);
    for (int unit = blockIdx.x; unit < 256; unit += gridDim.x) {
        const int g = unit >> 2, q4 = unit & 3;
        __syncthreads();
        for (int i = tid; i < 2 * 17 * 64; i += NT) {
            const int p = i & 63, j = (i >> 6) % 17, d = i / (17 * 64);
            const float stp = expf(a.in[I_SLOG][(l * 2 + d) * 64 + g]);
            const float lre = a.in[I_SLRE][((size_t)(l * 2 + d) * 64 + g) * 64 + p], lim = a.in[I_SLIM][((size_t)(l * 2 + d) * 64 + g) * 64 + p];
            const float mag = expf((float)j * lre * stp), ang = (float)j * (lim * stp);
            POW[i * 2] = mag * cosf(ang); POW[i * 2 + 1] = mag * sinf(ang);
        }
        for (int i = tid; i < 16 * 64; i += NT) { const int p = i & 63, h = i >> 6;
            CC[i * 2] = a.in[I_SCRE][(((size_t)l * 64 + g) * 16 + h) * 64 + p]; CC[i * 2 + 1] = a.in[I_SCIM][(((size_t)l * 64 + g) * 16 + h) * 64 + p]; }
        __syncthreads();
        for (int i = tid; i < 2 * 64 * 16; i += NT) {
            const int h = i & 15, p = (i >> 4) & 63, d = i >> 10;
            const float stp = expf(a.in[I_SLOG][(l * 2 + d) * 64 + g]);
            const float lre = a.in[I_SLRE][((size_t)(l * 2 + d) * 64 + g) * 64 + p], lim = a.in[I_SLIM][((size_t)(l * 2 + d) * 64 + g) * 64 + p];
            const float lbr = POW[((d * 17 + 1) * 64 + p) * 2], lbi = POW[((d * 17 + 1) * 64 + p) * 2 + 1];
            const float dnm = lre * lre + lim * lim;
            const float fre = ((lbr - 1.0f) * lre + lbi * lim) / dnm, fim = (lbi * lre - (lbr - 1.0f) * lim) / dnm;
            const float br = a.in[I_SBRE][(((size_t)l * 64 + g) * 64 + p) * 16 + h], bi = a.in[I_SBIM][(((size_t)l * 64 + g) * 64 + p) * 16 + h];
            BB[i * 2] = fre * br - fim * bi; BB[i * 2 + 1] = fre * bi + fim * br;
        }
        __syncthreads();
        { const int hp = tid & 15, hl = (tid >> 4) & 3, d = (tid >> 6) & 1, tg = tid >> 7, h = 4 * q4 + hl;
          float kt[4];
#pragma unroll
          for (int tt = 0; tt < 4; ++tt) kt[tt] = 0.f;
          for (int p = 0; p < 64; ++p) {
              const float cr = CC[(h * 64 + p) * 2], ci = CC[(h * 64 + p) * 2 + 1];
              const float br = BB[((d * 64 + p) * 16 + hp) * 2], bi = BB[((d * 64 + p) * 16 + hp) * 2 + 1];
              const float gr = cr * br - ci * bi, gi = cr * bi + ci * br;
#pragma unroll
              for (int tt = 0; tt < 4; ++tt) { const int tau = tg * 4 + tt; const float pr = POW[((d * 17 + tau) * 64 + p) * 2], pi = POW[((d * 17 + tau) * 64 + p) * 2 + 1]; kt[tt] += gr * pr - gi * pi; } }
#pragma unroll
          for (int tt = 0; tt < 4; ++tt) KT[((d * 16 + tg * 4 + tt) * 4 + hl) * 16 + hp] = kt[tt]; }
        __syncthreads();
        bf16_t* c1 = CW1 + (size_t)g * 65536;
        for (int i = tid; i < 64 * 128; i += NT) {
            const int k = (i & 127) * 2, nl = i >> 7; const int p = 16 * q4 + (nl & 15), ri = (nl >> 4) & 1, d = nl >> 5, n = d * 128 + ri * 64 + p, s = k >> 4, hp = k & 15;
            const int j = d ? s : 15 - s;
            const float pr = POW[((d * 17 + j) * 64 + p) * 2], pi = POW[((d * 17 + j) * 64 + p) * 2 + 1];
            float o[2];
#pragma unroll
            for (int q = 0; q < 2; ++q) { const float br = BB[((d * 64 + p) * 16 + hp + q) * 2], bi = BB[((d * 64 + p) * 16 + hp + q) * 2 + 1]; o[q] = ri ? (pr * bi + pi * br) : (pr * br - pi * bi); }
            *(unsigned*)(c1 + (size_t)n * 256 + k) = pg8::cvt_pk_bf16(o[0], o[1]);
        }
        bf16_t* c2 = CW2 + (size_t)g * 131072;
        for (int i = tid; i < 64 * 256; i += NT) {
            const int k = (i & 255) * 2, nl = i >> 8; const int t = nl >> 2, hl = nl & 3, h = 4 * q4 + hl, n = t * 16 + h;
            float o[2];
            if (k < 256) { const int s = k >> 4, hp = k & 15;
#pragma unroll
                for (int q = 0; q < 2; ++q) { float v = 0.f; if (s <= t) v += KT[((0 * 16 + (t - s)) * 4 + hl) * 16 + hp + q]; if (s >= t) v += KT[((1 * 16 + (s - t)) * 4 + hl) * 16 + hp + q]; o[q] = v; } }
            else { const int kk = k - 256, d = kk >> 7, ri = (kk >> 6) & 1; const int j = d ? 16 - t : t + 1;
#pragma unroll
                for (int q = 0; q < 2; ++q) { const int p = (kk & 63) + q; const float cr = CC[(h * 64 + p) * 2], ci = CC[(h * 64 + p) * 2 + 1];
                    const float pr = POW[((d * 17 + j) * 64 + p) * 2], pi = POW[((d * 17 + j) * 64 + p) * 2 + 1];
                    o[q] = ri ? -(cr * pi + ci * pr) : (cr * pr - ci * pi); } }
            *(unsigned*)(c2 + (size_t)n * 512 + k) = pg8::cvt_pk_bf16(o[0], o[1]);
        }
    }
    __syncthreads();
}
DI int s5_row(int b, int d, int st) { const int cc = (st < 16) ? (d ? 15 - st : st) : (d ? 271 - st : st - 16); return (st < 16) ? b * 16 + cc : 128 + b * 256 + cc; }
DI void s5_lane_consts(const Args& a, int l, int d, int g, int p, float& ar, float& ai) {
    const float stp = expf(a.in[I_SLOG][(l * 2 + d) * 64 + g]);
    const float lre = a.in[I_SLRE][((size_t)(l * 2 + d) * 64 + g) * 64 + p], lim = a.in[I_SLIM][((size_t)(l * 2 + d) * 64 + g) * 64 + p];
    const float mag = expf(16.0f * lre * stp), ang = 16.0f * (lim * stp);
    ar = mag * cosf(ang); ai = mag * sinf(ang);
}
DI void ph_s5_carry1(const Args& a, int l, bf16_t* AX, float* SEG) {
    const int tid = ltid(a), w = tid >> 6, p = tid & 63;
    for (int item = blockIdx.x * 8 + w; item < 17 * 1024; item += gridDim.x * 8) {
        const int unit = item & 1023, seg = item >> 10, d = unit & 1, g = (unit >> 1) & 63, b = unit >> 7;
        float ar, ai; s5_lane_consts(a, l, d, g, p, ar, ai);
        bf16_t* base = AX + (size_t)g * S5_RG * 512 + 256 + d * 128 + p;
        float lr[16], li[16];
#pragma unroll
        for (int q = 0; q < 16; ++q) { const size_t o = (size_t)s5_row(b, d, seg * 16 + q) * 512; lr[q] = bf2f(base[o]); li[q] = bf2f(base[o + 64]); }
        float xr = 0.f, xi = 0.f;
#pragma unroll
        for (int q = 0; q < 16; ++q) { const size_t o = (size_t)s5_row(b, d, seg * 16 + q) * 512;
            base[o] = f2bf(xr); base[o + 64] = f2bf(xi);
            const float nr = ar * xr - ai * xi + lr[q], ni = ar * xi + ai * xr + li[q]; xr = nr; xi = ni; }
        SEG[((size_t)seg * 1024 + unit) * 128 + p] = xr; SEG[((size_t)seg * 1024 + unit) * 128 + 64 + p] = xi;
    }
}
DI void ph_s5_carry2(const Args& a, int l, bf16_t* AX, const float* SEG) {
    const int tid = ltid(a), w = tid >> 6, p = tid & 63;
    for (int item = blockIdx.x * 8 + w; item < 16 * 1024; item += gridDim.x * 8) {
        const int unit = item & 1023, seg = 1 + (item >> 10), d = unit & 1, g = (unit >> 1) & 63, b = unit >> 7;
        float ar, ai; s5_lane_consts(a, l, d, g, p, ar, ai);
        float sr = ar, si = ai;
#pragma unroll
        for (int q = 0; q < 4; ++q) { const float nr = sr * sr - si * si, ni = 2.0f * sr * si; sr = nr; si = ni; }
        float xr = 0.f, xi = 0.f;
        { float er[16], ei[16];
#pragma unroll
          for (int s2 = 0; s2 < 16; ++s2) { const bool on = s2 < seg; er[s2] = on ? SEG[((size_t)s2 * 1024 + unit) * 128 + p] : 0.f; ei[s2] = on ? SEG[((size_t)s2 * 1024 + unit) * 128 + 64 + p] : 0.f; }
#pragma unroll
          for (int s2 = 0; s2 < 16; ++s2) if (s2 < seg) { const float nr = sr * xr - si * xi + er[s2], ni = sr * xi + si * xr + ei[s2]; xr = nr; xi = ni; } }
        bf16_t* base = AX + (size_t)g * S5_RG * 512 + 256 + d * 128 + p;
        float lr[16], li[16];
#pragma unroll
        for (int q = 0; q < 16; ++q) { const size_t o = (size_t)s5_row(b, d, seg * 16 + q) * 512; lr[q] = bf2f(base[o]); li[q] = bf2f(base[o + 64]); }
#pragma unroll
        for (int q = 0; q < 16; ++q) { const size_t o = (size_t)s5_row(b, d, seg * 16 + q) * 512;
            base[o] = f2bf(lr[q] + xr); base[o + 64] = f2bf(li[q] + xi);
            const float nr = ar * xr - ai * xi, ni = ar * xi + ai * xr; xr = nr; xi = ni; }
    }
}

#ifndef SUBDUP
#define SUBDUP 0
#endif
typedef short bf16x8v __attribute__((ext_vector_type(8)));
typedef short s16x4v __attribute__((ext_vector_type(4)));
typedef __bf16 bfx2_t __attribute__((ext_vector_type(2)));
typedef float f32x2_t __attribute__((ext_vector_type(2)));
#define MFMA16(a_, b_, c_) __builtin_amdgcn_mfma_f32_16x16x32_bf16((a_), (b_), (c_), 0, 0, 0)
DI unsigned pk2(float lo, float hi) { const bfx2_t v = __builtin_convertvector((f32x2_t){lo, hi}, bfx2_t); return __builtin_bit_cast(unsigned, v); }
DI int sw512(int r, int cb) { return r * 512 + (cb ^ ((r & 15) << 4)); }
DI int sw128(int r, int cb) { return r * 128 + (cb ^ ((r & 7) << 4)); }
DI bf16x8v ldsfrag(LAS unsigned char* base, int off) { return *(const LAS bf16x8v*)(base + off); }
DI bf16x8v ldsfrag2(LAS unsigned char* base, int off0, int off1) { const s16x4v lo = *(const LAS s16x4v*)(base + off0), hi = *(const LAS s16x4v*)(base + off1); return __builtin_shufflevector(lo, hi, 0, 1, 2, 3, 4, 5, 6, 7); }
constexpr int ML_GSET = 448;
DI void ml_gates(float igr, float fgr, float ibias, float fbias, int d, float& ms, LAS float* gs, int L) {
    asm volatile("" : "+v"(L));
    const int t = d ? 63 - L : L;
    const float ipv = igr + ibias, lfv = -softplusf_(-(fgr + fbias));
    const float bc = dpp_scan_sum(lfv);
    const float aj = ipv - bc;
    const float cm = dpp_scan_max(aj);
    const float mt = fmaxf(bc + ms, bc + cm);
    const float bend = lane63(bc);
    const float le = bend - bc + ipv;
    const float mle = lane63(dpp_scan_max(le));
    const float mnew = fmaxf(bend + ms, mle);
    gs[t] = bc; gs[64 + t] = aj; gs[128 + t] = mt; gs[192 + t] = __expf(bc + ms - mt); gs[256 + t] = __expf(-mt); gs[320 + t] = __expf(le - mnew) * 0.0625f;
    if (L == 0) gs[384] = __expf(bend + ms - mnew);
    ms = mnew;
}
DI bf16x8v ldstr2(LAS unsigned char* p0, LAS unsigned char* p1) {
    const s16x4v lo = __builtin_amdgcn_ds_read_tr16_b64_v4i16((LAS s16x4v*)p0), hi = __builtin_amdgcn_ds_read_tr16_b64_v4i16((LAS s16x4v*)p1);
    return __builtin_shufflevector(lo, hi, 0, 1, 2, 3, 4, 5, 6, 7); }
DI void ph_ml_scan_mfma(const Args& a, int l, const bf16_t* Q, const bf16_t* K, const bf16_t* V, const float* GATE, bf16_t* HF, bf16_t* HB, LAS unsigned char* lds) {
    constexpr int PQ = 528, PK = 544, PV = 160, PW = 144;
    LAS unsigned char* qs = lds;
    LAS unsigned char* kn = lds + 33792;
    LAS unsigned char* vn = lds + 68608;
    LAS unsigned char* vs = lds + 78848;
    LAS unsigned char* Wm = lds + 89088;
    LAS float* sm = (LAS float*)(lds + 98304);
    LAS float* rsW = sm + 2 * ML_GSET; LAS float* qn = rsW + 128; LAS float* nvec = qn + 128;
    const int tid = ltid(a), w = tid >> 6, ln = tid & 63, l16 = ln & 15, h4 = ln >> 4, tq = (ln & 15) >> 2, tp = ln & 3;
    for (int unit = blockIdx.x; unit < 256; unit += gridDim.x) {
        const int eh = unit & 3, d = (unit >> 2) & 1, hd = (unit >> 3) & 3, b = unit >> 5;
        const float ibias = a.in[I_MIB][(l * 2 + d) * 4 + hd], fbias = a.in[I_MFB][(l * 2 + d) * 4 + hd];
        bf16_t* HO = d ? HB : HF;
        f32x4 Cacc[16];
#pragma unroll
        for (int i = 0; i < 16; ++i) Cacc[i] = (f32x4){0.f, 0.f, 0.f, 0.f};
        float ms = 0.f;
        __syncthreads();
        if (tid < 256) nvec[tid] = 0.f;
#define ML_ROW0(step) (((step) < 4) ? b * 256 + (d ? 3 - (step) : (step)) * 64 : CTXROWS + b * 4096 + (d ? 67 - (step) : (step) - 4) * 64)
        u32x4 pq[4], pk[4], pv[1]; float gi = 0.f, gf = 0.f;
        { const int row0 = ML_ROW0(0);
#pragma unroll
          for (int q = 0; q < 4; ++q) { const int p = tid + 512 * q, r = p >> 5, c8 = p & 31; pq[q] = *(const u32x4*)(Q + (size_t)(row0 + r) * 1024 + hd * 256 + c8 * 8); pk[q] = *(const u32x4*)(K + (size_t)(row0 + r) * 1024 + hd * 256 + c8 * 8); }
#pragma unroll
          for (int q = 0; q < 1; ++q) { const int r = tid >> 3, c8 = tid & 7; pv[q] = *(const u32x4*)(V + (size_t)(row0 + r) * 1024 + hd * 256 + eh * 64 + c8 * 8); }
          if (w == 7) { const int t = d ? 63 - ln : ln; const float* gp = GATE + (size_t)(row0 + t) * 32; gi = gp[d * 4 + hd]; gf = gp[8 + d * 4 + hd]; ml_gates(gi, gf, ibias, fbias, d, ms, sm, ln); } }
        __syncthreads();
        for (int step = 0; step < 68; ++step) {
            const int par = step & 1; LAS float* gs = sm + par * ML_GSET;
            const int row0 = ML_ROW0(step);
            for (int sr_ = 0; sr_ < (SUBDUP == 12 ? 2 : 1); ++sr_) {
#pragma unroll
            for (int q = 0; q < 4; ++q) { const int p = tid + 512 * q, r = p >> 5, c8 = p & 31;
                *(LAS u32x4*)(qs + r * PQ + c8 * 16) = pq[q]; *(LAS u32x4*)(kn + r * PK + c8 * 16) = pk[q]; }
#pragma unroll
            for (int q = 0; q < 1; ++q) { const int r = tid >> 3, c8 = tid & 7;
                *(LAS u32x4*)(vn + r * PV + c8 * 16) = pv[q];
                float f[8]; unpack8(pv[q], f); const float ws = gs[320 + r];
                u32x4 o; o.x = pk2(f[0] * ws, f[1] * ws); o.y = pk2(f[2] * ws, f[3] * ws); o.z = pk2(f[4] * ws, f[5] * ws); o.w = pk2(f[6] * ws, f[7] * ws);
                *(LAS u32x4*)(vs + r * PV + c8 * 16) = o; }
            }
            if (step + 1 < 68) { const int rown = ML_ROW0(step + 1);
#pragma unroll
                for (int q = 0; q < 4; ++q) { const int p = tid + 512 * q, r = p >> 5, c8 = p & 31; pq[q] = *(const u32x4*)(Q + (size_t)(rown + r) * 1024 + hd * 256 + c8 * 8); pk[q] = *(const u32x4*)(K + (size_t)(rown + r) * 1024 + hd * 256 + c8 * 8); }
#pragma unroll
                for (int q = 0; q < 1; ++q) { const int r = tid >> 3, c8 = tid & 7; pv[q] = *(const u32x4*)(V + (size_t)(rown + r) * 1024 + hd * 256 + eh * 64 + c8 * 8); }
                if (w == 7) { const int t = d ? 63 - ln : ln; const float* gp = GATE + (size_t)(rown + t) * 32; gi = gp[d * 4 + hd]; gf = gp[8 + d * 4 + hd]; } }
            lds_barrier();
            for (int sr_ = 0; sr_ < (SUBDUP == 11 ? 2 : 1); ++sr_) { const int it = w >> 1, jp = w & 1, i = it * 16 + l16;
              f32x4 a0 = (f32x4){0.f, 0.f, 0.f, 0.f}, a1 = a0;
              LAS unsigned char* qb = qs + (it * 16 + l16) * PQ + h4 * 16; LAS unsigned char* kb = kn + ((2 * jp) * 16 + l16) * PK + h4 * 16;
              f32x4 qacc = (f32x4){0.f, 0.f, 0.f, 0.f};
#pragma unroll
              for (int ks = 0; ks < 8; ++ks) {
                  const bf16x8v bq = ldsfrag(qb, ks * 64);
                  const bf16x8v k0 = ldsfrag(kb, ks * 64), k1 = ldsfrag(kb, 16 * PK + ks * 64);
                  a0 = MFMA16(k0, bq, a0); a1 = MFMA16(k1, bq, a1);
                  if ((ks >> 2) == jp) {
                      const f32x4 n0 = *(const LAS f32x4*)(nvec + 32 * ks + 8 * h4), n1 = *(const LAS f32x4*)(nvec + 32 * ks + 8 * h4 + 4);
                      u32x4 nw; nw.x = pk2(n0[0], n0[1]); nw.y = pk2(n0[2], n0[3]); nw.z = pk2(n1[0], n1[1]); nw.w = pk2(n1[2], n1[3]);
                      qacc = MFMA16(bq, __builtin_bit_cast(bf16x8v, nw), qacc); } }
              if (l16 == 0) *(LAS f32x4*)(qn + jp * 64 + it * 16 + 4 * h4) = qacc;
              const float bci = gs[i], mti = gs[128 + i];
              float rs = 0.f;
#pragma unroll
              for (int t2 = 0; t2 < 2; ++t2) { const int j0 = (2 * jp + t2) * 16 + 4 * h4; const f32x4 ajv = *(const LAS f32x4*)(gs + 64 + j0); const f32x4 av = t2 ? a1 : a0;
                  float wv[4];
#pragma unroll
                  for (int r = 0; r < 4; ++r) { const int j = j0 + r; const bool valid = d ? (j >= i) : (j <= i); const float e = __expf(bci + ajv[r] - mti) * av[r] * 0.0625f; wv[r] = valid ? e : 0.f; rs += wv[r]; }
                  u32x2 pw; pw.x = pk2(wv[0], wv[1]); pw.y = pk2(wv[2], wv[3]);
                  *(LAS u32x2*)(Wm + i * PW + j0 * 2) = pw; }
              int lnl = ln; asm volatile("" : "+v"(lnl)); rs += shx(rs, 16, lnl); rs += shx(rs, 32, lnl);
              if (h4 == 0) rsW[jp * 64 + i] = rs;
            }
            lds_barrier();
            if (w < 4) { f32x4 num[4];
#pragma unroll
              for (int it = 0; it < 4; ++it) num[it] = (f32x4){0.f, 0.f, 0.f, 0.f};
              LAS unsigned char* qb2 = qs + l16 * PQ + 8 * h4;
              { bf16x8v af[4];
#pragma unroll
                for (int it = 0; it < 4; ++it) af[it] = ldsfrag2(qb2, it * 16 * PQ, it * 16 * PQ + 32);
#pragma unroll
                for (int ks = 0; ks < 8; ++ks) {
                    u32x4 bw; bw.x = pk2(Cacc[2 * ks][0], Cacc[2 * ks][1]); bw.y = pk2(Cacc[2 * ks][2], Cacc[2 * ks][3]); bw.z = pk2(Cacc[2 * ks + 1][0], Cacc[2 * ks + 1][1]); bw.w = pk2(Cacc[2 * ks + 1][2], Cacc[2 * ks + 1][3]);
                    const bf16x8v bfr = __builtin_bit_cast(bf16x8v, bw);
                    bf16x8v nf[4];
#pragma unroll
                    for (int it = 0; it < 4; ++it) nf[it] = (ks + 1 < 8) ? ldsfrag2(qb2, it * 16 * PQ + 64 * (ks + 1), it * 16 * PQ + 64 * (ks + 1) + 32) : af[it];
#pragma unroll
                    for (int it = 0; it < 4; ++it) num[it] = MFMA16(af[it], bfr, num[it]);
#pragma unroll
                    for (int it = 0; it < 4; ++it) af[it] = nf[it];
                    asm volatile("" ::: "memory"); } }
#pragma unroll
              for (int it = 0; it < 4; ++it) { const f32x4 wi = *(const LAS f32x4*)(gs + 192 + it * 16 + 4 * h4); num[it] = num[it] * wi; }
              LAS unsigned char* trb = (LAS unsigned char*)0 + (8 * h4 + tq) * PV + 8 * tp + 32 * w;
              bf16x8v bv[2];
#pragma unroll
              for (int kk = 0; kk < 2; ++kk) bv[kk] = ldstr2(vn + (size_t)trb + (32 * kk) * PV, vn + (size_t)trb + (32 * kk + 4) * PV);
              LAS unsigned char* wb = Wm + l16 * PW + 16 * h4;
#pragma unroll
              for (int kk = 0; kk < 2; ++kk)
#pragma unroll
                  for (int it = 0; it < 4; ++it) { const bf16x8v aw = ldsfrag(wb, it * 16 * PW + 64 * kk); num[it] = MFMA16(aw, bv[kk], num[it]); }
              asm volatile("" ::: "memory");
#pragma unroll
              for (int it = 0; it < 4; ++it) { const int i0 = it * 16 + 4 * h4;
                  const f32x4 r0 = *(const LAS f32x4*)(rsW + i0), r1 = *(const LAS f32x4*)(rsW + 64 + i0), wi = *(const LAS f32x4*)(gs + 192 + i0), qv = *(const LAS f32x4*)(qn + i0) + *(const LAS f32x4*)(qn + 64 + i0), nr = *(const LAS f32x4*)(gs + 256 + i0);
#pragma unroll
                  for (int r = 0; r < 4; ++r) { const float den = r0[r] + r1[r] + wi[r] * qv[r]; const float hv = num[it][r] * __builtin_amdgcn_rcpf(fmaxf(fabsf(den), nr[r]));
                      HO[(size_t)(row0 + i0 + r) * 1024 + hd * 256 + eh * 64 + 16 * w + l16] = (bf16_t)(pk2(hv, 0.f) & 0xffffu); } asm volatile("" ::: "memory"); }
              const float decay = gs[384];
              bf16x8v bs[2];
#pragma unroll
              for (int kk = 0; kk < 2; ++kk) bs[kk] = ldstr2(vs + (size_t)trb + (32 * kk) * PV, vs + (size_t)trb + (32 * kk + 4) * PV);
#pragma unroll
              for (int dt = 0; dt < 16; ++dt) Cacc[dt] = Cacc[dt] * decay;
              LAS unsigned char* ktb = kn + (8 * h4 + tq) * PK + 8 * tp;
              { bf16x8v ak0 = ldstr2(ktb, ktb + 4 * PK), ak1 = ldstr2(ktb + 32 * PK, ktb + 36 * PK);
#pragma unroll
                for (int dt = 0; dt < 16; ++dt) {
                    bf16x8v n0 = ak0, n1 = ak1;
                    if (dt + 1 < 16) { n0 = ldstr2(ktb + 32 * (dt + 1), ktb + 4 * PK + 32 * (dt + 1)); n1 = ldstr2(ktb + 32 * PK + 32 * (dt + 1), ktb + 36 * PK + 32 * (dt + 1)); }
                    Cacc[dt] = MFMA16(ak0, bs[0], Cacc[dt]); Cacc[dt] = MFMA16(ak1, bs[1], Cacc[dt]);
                    ak0 = n0; ak1 = n1; asm volatile("" ::: "memory"); } }
            } else { const float decay = gs[384]; const int dn = tid - 256; float s = 0.f;
#pragma unroll 8
                for (int j = 0; j < 64; ++j) s += gs[320 + j] * bf2f(*(const LAS bf16_t*)(kn + j * PK + 2 * dn));
                nvec[dn] = decay * nvec[dn] + s;
                if (w == 7 && step + 1 < 68) ml_gates(gi, gf, ibias, fbias, d, ms, sm + (par ^ 1) * ML_GSET, ln); }
            lds_barrier();
        }
#undef ML_ROW0
    }
}

#ifndef SUBDUP
#define SUBDUP 0
#endif
#define MFMA16K16(a_, b_, c_) __builtin_amdgcn_mfma_f32_16x16x16bf16_1k((a_), (b_), (c_), 0, 0, 0)
DI s16x4v pack4(const f32x4 v) { u32x2 w; w.x = pk2(v[0], v[1]); w.y = pk2(v[2], v[3]); return __builtin_bit_cast(s16x4v, w); }
DI s16x4v lds8(LAS unsigned char* p) { return *(const LAS s16x4v*)p; }
DI s16x4v ldstr1(LAS unsigned char* p) { return __builtin_amdgcn_ds_read_tr16_b64_v4i16((LAS s16x4v*)p); }
constexpr int GD_GSET = 384;
DI void gdn_gates(float araw, float braw, float nea, float dtb, LAS float* gs, int L, int d) {
    asm volatile("" : "+v"(L));
    const int t = d ? 63 - L : L;
    const float gc = dpp_scan_sum(nea * softplusf_(araw + dtb));
    const float gl = lane63(gc);
    gs[t] = gc; gs[64 + t] = sigmoidf_(braw); gs[128 + t] = __expf(gc); gs[192 + t] = __expf(gl - gc);
    if (L == 0) gs[256] = __expf(gl);
}
DI void ph_gdn_scan_mfma(const Args& a, int l, const bf16_t* Q, const bf16_t* K, const bf16_t* V, const float* GATE, bf16_t* OF, bf16_t* OB, LAS unsigned char* lds) {
    constexpr int PQ = 272, PK = 288, PV = 160, PA = 144, PD = 48;
    LAS unsigned char* qh = lds;
    LAS unsigned char* kh = lds + 17408;
    LAS unsigned char* vv = lds + 35840;
    LAS unsigned char* AM = lds + 54272;
    LAS unsigned char* QM = lds + 63488;
    LAS unsigned char* DINV = lds + 72704;
    LAS float* sm = (LAS float*)(lds + 75776);
    LAS float* nAd = (LAS float*)(lds + 78848);
    const int tid = ltid(a), w = tid >> 6, ln = tid & 63, l16 = ln & 15, h4 = ln >> 4, tq = (ln & 15) >> 2, tp = ln & 3;
    for (int unit = blockIdx.x; unit < 256; unit += gridDim.x) {
        const int eh = unit & 1, d = (unit >> 1) & 1, h = (unit >> 2) & 7, b = unit >> 5;
        const float nea = -__expf(a.in[I_GALOG][(l * 2 + d) * 8 + h]), dtb = a.in[I_GDTB][(l * 2 + d) * 8 + h];
        bf16_t* O = d ? OB : OF;
        f32x4 S[8];
#pragma unroll
        for (int i = 0; i < 8; ++i) S[i] = (f32x4){0.f, 0.f, 0.f, 0.f};
#define GD_ROW0(step) (((step) < 4) ? b * 256 + (d ? 3 - (step) : (step)) * 64 : CTXROWS + b * 4096 + (d ? 67 - (step) : (step) - 4) * 64)
        u32x4 pq[2], pk[2], pv[1]; float ga = 0.f, gb = 0.f;
        __syncthreads();
        { const int row0 = GD_ROW0(0);
#pragma unroll
          for (int q = 0; q < 2; ++q) { const int p = tid + 512 * q, r = p >> 4, c8 = p & 15; const size_t go = (size_t)(row0 + r) * 1024 + h * 128 + c8 * 8;
              pq[q] = *(const u32x4*)(Q + go); pk[q] = *(const u32x4*)(K + go); }
          pv[0] = *(const u32x4*)(V + (size_t)(row0 + (tid >> 3)) * 1024 + h * 128 + eh * 64 + (tid & 7) * 8);
          if (w == 5) { const int t = d ? 63 - ln : ln; const float* gp = GATE + (size_t)(row0 + t) * 32; ga = gp[d * 8 + h]; gb = gp[16 + d * 8 + h]; gdn_gates(ga, gb, nea, dtb, sm, ln, d); } }
        __syncthreads();
        for (int step = 0; step < 68; ++step) {
            const int par = step & 1; LAS float* gs = sm + par * GD_GSET;
            const int row0 = GD_ROW0(step);
#pragma unroll
            for (int q = 0; q < 2; ++q) { const int p = tid + 512 * q, r = p >> 4, c8 = p & 15;
                *(LAS u32x4*)(qh + r * PQ + c8 * 16) = pq[q]; *(LAS u32x4*)(kh + r * PK + c8 * 16) = pk[q]; }
            *(LAS u32x4*)(vv + (tid >> 3) * PV + (tid & 7) * 16) = pv[0];
            if (step + 1 < 68) { const int rown = GD_ROW0(step + 1);
#pragma unroll
                for (int q = 0; q < 2; ++q) { const int p = tid + 512 * q, r = p >> 4, c8 = p & 15; const size_t go = (size_t)(rown + r) * 1024 + h * 128 + c8 * 8;
                    pq[q] = *(const u32x4*)(Q + go); pk[q] = *(const u32x4*)(K + go); }
                pv[0] = *(const u32x4*)(V + (size_t)(rown + (tid >> 3)) * 1024 + h * 128 + eh * 64 + (tid & 7) * 8);
                if (w == 5) { const int t = d ? 63 - ln : ln; const float* gp = GATE + (size_t)(rown + t) * 32; ga = gp[d * 8 + h]; gb = gp[16 + d * 8 + h]; } }
            lds_barrier(); if (SUBDUP == 5) lds_barrier();
            for (int sr_ = 0; sr_ < (SUBDUP == 1 ? 2 : 1); ++sr_) { const int it = w >> 1, jp = w & 1, i = it * 16 + l16;
              f32x4 kk0 = (f32x4){0.f, 0.f, 0.f, 0.f}, kk1 = kk0, qk0 = kk0, qk1 = kk0;
              LAS unsigned char* kb = kh + ((2 * jp) * 16 + l16) * PK + h4 * 16; LAS unsigned char* xk = kh + i * PK + h4 * 16; LAS unsigned char* xq = qh + i * PQ + h4 * 16;
#pragma unroll
              for (int ks = 0; ks < 4; ++ks) { const bf16x8v a0 = ldsfrag(kb, ks * 64), a1 = ldsfrag(kb, 16 * PK + ks * 64), bk = ldsfrag(xk, ks * 64), bq = ldsfrag(xq, ks * 64);
                  kk0 = MFMA16(a0, bk, kk0); kk1 = MFMA16(a1, bk, kk1); qk0 = MFMA16(a0, bq, qk0); qk1 = MFMA16(a1, bq, qk1); }
              const float gci = gs[i], bi = gs[64 + i];
#pragma unroll
              for (int t2 = 0; t2 < 2; ++t2) { const int j0 = (2 * jp + t2) * 16 + 4 * h4; const f32x4 gcj = *(const LAS f32x4*)(gs + j0); const f32x4 kkv = t2 ? kk1 : kk0, qkv = t2 ? qk1 : qk0;
                  float am[4], qm[4];
#pragma unroll
                  for (int r = 0; r < 4; ++r) { const int j = j0 + r; const bool valid = d ? (j >= i) : (j <= i); const float e = __expf(gci - gcj[r]);
                      am[r] = (valid && j != i) ? -bi * kkv[r] * e : 0.f; qm[r] = valid ? qkv[r] * e : 0.f; }
                  u32x2 pa, pm; pa.x = pk2(am[0], am[1]); pa.y = pk2(am[2], am[3]); pm.x = pk2(qm[0], qm[1]); pm.y = pk2(qm[2], qm[3]);
                  *(LAS u32x2*)(AM + i * PA + j0 * 2) = pa; *(LAS u32x2*)(QM + i * PA + j0 * 2) = pm;
                  if (2 * jp + t2 == it) { const int ipos = d ? 15 - l16 : l16;
#pragma unroll
                      for (int r = 0; r < 4; ++r) { const int jpos = d ? 15 - (4 * h4 + r) : 4 * h4 + r; nAd[(it * 16 + ipos) * 16 + jpos] = am[r]; } } } }
            lds_barrier(); if (SUBDUP == 5) lds_barrier();
            for (int sr_ = 0; sr_ < (SUBDUP == 2 ? 2 : 1); ++sr_) if (w == 4) { const int I = ln >> 4, c = ln & 15, cp = d ? 15 - c : c;
                float Dr[16];
                Dr[0] = (cp == 0) ? 1.f : 0.f;
#pragma unroll
                for (int ip = 1; ip < 16; ++ip) {
                    float av[16];
#pragma unroll
                    for (int q4 = 0; q4 < 4; ++q4) { if (q4 * 4 < ip) { const f32x4 x = *(const LAS f32x4*)(nAd + (I * 16 + ip) * 16 + q4 * 4); av[q4 * 4] = x[0]; av[q4 * 4 + 1] = x[1]; av[q4 * 4 + 2] = x[2]; av[q4 * 4 + 3] = x[3]; } }
                    float s = (cp == ip) ? 1.f : 0.f;
#pragma unroll
                    for (int jq = 0; jq < ip; ++jq) s += av[jq] * Dr[jq];
                    Dr[ip] = s; }
#pragma unroll
                for (int ip = 0; ip < 16; ++ip) { const int r = d ? 15 - ip : ip; *(LAS bf16_t*)(DINV + (16 * I + r) * PD + 2 * c) = (bf16_t)(pk2(Dr[ip], 0.f) & 0xffffu); } }
            s16x4v sf[8];
            f32x4 Rt[4], Qs[4];
            if (w < 4) {
#pragma unroll
            for (int dt = 0; dt < 8; ++dt) sf[dt] = pack4(S[dt]);
#pragma unroll
            for (int Tp = 0; Tp < 4; ++Tp) { const int ro = 16 * (d ? 3 - Tp : Tp);
                f32x4 ksv = (f32x4){0.f, 0.f, 0.f, 0.f}, qsv = ksv;
                LAS unsigned char* ka = kh + (ro + l16) * PK + 8 * h4; LAS unsigned char* qa = qh + (ro + l16) * PQ + 8 * h4;
#pragma unroll
                for (int dt = 0; dt < 8; ++dt) { ksv = MFMA16K16(lds8(ka + 32 * dt), sf[dt], ksv); qsv = MFMA16K16(lds8(qa + 32 * dt), sf[dt], qsv); }
                const s16x4v v4 = ldstr1(vv + (ro + 4 * h4 + tq) * PV + (16 * w + 4 * tp) * 2);
                const f32x4 be = *(const LAS f32x4*)(gs + 64 + ro + 4 * h4), eg = *(const LAS f32x4*)(gs + 128 + ro + 4 * h4);
#pragma unroll
                for (int r = 0; r < 4; ++r) { Rt[Tp][r] = be[r] * (bf2f((bf16_t)v4[r]) - eg[r] * ksv[r]); Qs[Tp][r] = eg[r] * qsv[r]; }
                asm volatile("" ::: "memory"); } }
            lds_barrier(); if (SUBDUP == 5) lds_barrier();
            if (w < 4) { s16x4v vf[4]; f32x4 vn[4];
#pragma unroll
              for (int Tp = 0; Tp < 4; ++Tp) { const int ro = 16 * (d ? 3 - Tp : Tp);
                  f32x4 X = Rt[Tp];
#pragma unroll
                  for (int Jp = 0; Jp < Tp; ++Jp) { const int co = 16 * (d ? 3 - Jp : Jp); X = MFMA16K16(lds8(AM + (ro + l16) * PA + (co + 4 * h4) * 2), vf[Jp], X); }
                  const s16x4v xf = pack4(X);
                  vn[Tp] = MFMA16K16(lds8(DINV + (ro + l16) * PD + 8 * h4), xf, ((f32x4){0.f, 0.f, 0.f, 0.f}));
                  vf[Tp] = pack4(vn[Tp]); }
#pragma unroll
              for (int Tp = 0; Tp < 4; ++Tp) { const int ro = 16 * (d ? 3 - Tp : Tp);
                  f32x4 o = Qs[Tp];
#pragma unroll
                  for (int Jp = 0; Jp <= Tp; ++Jp) { const int co = 16 * (d ? 3 - Jp : Jp); o = MFMA16K16(lds8(QM + (ro + l16) * PA + (co + 4 * h4) * 2), vf[Jp], o); }
#pragma unroll
                  for (int r = 0; r < 4; ++r) O[(size_t)(row0 + ro + 4 * h4 + r) * 1024 + h * 128 + eh * 64 + 16 * w + l16] = (bf16_t)(pk2(o[r], 0.f) & 0xffffu);
                  asm volatile("" ::: "memory"); }
              const float gend = gs[256];
              s16x4v vsf[4];
#pragma unroll
              for (int Jp = 0; Jp < 4; ++Jp) { const int co = 16 * (d ? 3 - Jp : Jp); const f32x4 ee = *(const LAS f32x4*)(gs + 192 + co + 4 * h4); vsf[Jp] = pack4(vn[Jp] * ee); }
#pragma unroll
              for (int dt = 0; dt < 8; ++dt) { S[dt] = S[dt] * gend;
#pragma unroll
                  for (int Jp = 0; Jp < 4; ++Jp) { const int co = 16 * (d ? 3 - Jp : Jp); S[dt] = MFMA16K16(ldstr1(kh + (co + 4 * h4 + tq) * PK + (16 * dt + 4 * tp) * 2), vsf[Jp], S[dt]); }
                  if (dt & 1) asm volatile("" ::: "memory"); } }
            for (int sr_ = 0; sr_ < (SUBDUP == 3 ? 2 : 1); ++sr_) if (w == 5 && step + 1 < 68) gdn_gates(ga, gb, nea, dtb, sm + (par ^ 1) * GD_GSET, ln, d);
            lds_barrier(); if (SUBDUP == 5) lds_barrier();
        }
#undef GD_ROW0
    }
}

#ifndef GD_HT
#define GD_HT 10
#endif
DI void ph_gdn_scan_pipe(const Args& a, int l, const bf16_t* Q, const bf16_t* K, const bf16_t* V, const float* GATE, bf16_t* OF, bf16_t* OB, LAS unsigned char* lds) {
    constexpr int PQ = 272, PK = 288, PV = 160, PA = 144, PD = 48, SETB = 71680;
    constexpr int O_Q = 0, O_K = 17408, O_V = 35840, O_AM = 46080, O_QM = 55296, O_DI = 64512, O_ND = 67584;
    LAS float* sm = (LAS float*)(lds + 2 * SETB);
    const int tid = ltid(a), w = tid >> 6, ln = tid & 63, l16 = ln & 15, h4 = ln >> 4, tq = (ln & 15) >> 2, tp = ln & 3;
    const bool helper = w >= 4; const int ht = tid - 256;
    for (int unit = blockIdx.x; unit < 256; unit += gridDim.x) {
        const int eh = unit & 1, d = (unit >> 1) & 1, h = (unit >> 2) & 7, b = unit >> 5;
        const float nea = -__expf(a.in[I_GALOG][(l * 2 + d) * 8 + h]), dtb = a.in[I_GDTB][(l * 2 + d) * 8 + h];
        bf16_t* O = d ? OB : OF;
        f32x4 S[8];
#pragma unroll
        for (int i = 0; i < 8; ++i) S[i] = (f32x4){0.f, 0.f, 0.f, 0.f};
#define GD_ROW0(step) (((step) < 4) ? b * 256 + (d ? 3 - (step) : (step)) * 64 : CTXROWS + b * 4096 + (d ? 67 - (step) : (step) - 4) * 64)
        f32x4 Rt[4], Qs[4]; float ga = 0.f, gb = 0.f;
#define GD_FETCH(stp) do { const int rw_ = GD_ROW0(stp); \
        _Pragma("unroll") for (int q_ = 0; q_ < 4; ++q_) { const int p_ = ht + 256 * q_, r_ = p_ >> 4, c8_ = p_ & 15; const size_t go_ = (size_t)(rw_ + r_) * 1024 + h * 128 + c8_ * 8; S[q_] = __builtin_bit_cast(f32x4, *(const u32x4*)(Q + go_)); S[4 + q_] = __builtin_bit_cast(f32x4, *(const u32x4*)(K + go_)); } \
        _Pragma("unroll") for (int q_ = 0; q_ < 2; ++q_) { const int p_ = ht + 256 * q_, r_ = p_ >> 3, c8_ = p_ & 7; Qs[q_] = __builtin_bit_cast(f32x4, *(const u32x4*)(V + (size_t)(rw_ + r_) * 1024 + h * 128 + eh * 64 + c8_ * 8)); } \
        if (w == 5) { const int t_ = d ? 63 - ln : ln; const float* gp_ = GATE + (size_t)(rw_ + t_) * 32; ga = gp_[d * 8 + h]; gb = gp_[16 + d * 8 + h]; } } while (0)
#define GD_STAGE(setb) do { \
        _Pragma("unroll") for (int q_ = 0; q_ < 4; ++q_) { const int p_ = ht + 256 * q_, r_ = p_ >> 4, c8_ = p_ & 15; *(LAS f32x4*)((setb) + O_Q + r_ * PQ + c8_ * 16) = S[q_]; *(LAS f32x4*)((setb) + O_K + r_ * PK + c8_ * 16) = S[4 + q_]; } \
        _Pragma("unroll") for (int q_ = 0; q_ < 2; ++q_) { const int p_ = ht + 256 * q_, r_ = p_ >> 3, c8_ = p_ & 7; *(LAS f32x4*)((setb) + O_V + r_ * PV + c8_ * 16) = Qs[q_]; } } while (0)
#define GD_STAGE_A(setb, gsp, p0_, p1_, ps_) do { LAS unsigned char* kh_ = (setb) + O_K; LAS unsigned char* qh_ = (setb) + O_Q; \
        for (int pi_ = (p0_); pi_ < (p1_); pi_ += (ps_)) {                   \
            const int Tp_ = pi_ < 1 ? 0 : (pi_ < 3 ? 1 : (pi_ < 6 ? 2 : 3)), Jp_ = pi_ - (Tp_ * (Tp_ + 1)) / 2; \
            const int it_ = d ? 3 - Tp_ : Tp_, jt_ = d ? 3 - Jp_ : Jp_, i_ = it_ * 16 + l16; \
            LAS unsigned char* xk_ = kh_ + i_ * PK + h4 * 16; LAS unsigned char* xq_ = qh_ + i_ * PQ + h4 * 16; \
            const float gci_ = (gsp)[i_], bi_ = (gsp)[64 + i_]; \
            LAS unsigned char* kb_ = kh_ + (jt_ * 16 + l16) * PK + h4 * 16; f32x4 kk_ = (f32x4){0.f, 0.f, 0.f, 0.f}, qk_ = kk_; \
            _Pragma("unroll") for (int ks_ = 0; ks_ < 4; ++ks_) { const bf16x8v a0_ = ldsfrag(kb_, ks_ * 64); kk_ = MFMA16(a0_, ldsfrag(xk_, ks_ * 64), kk_); qk_ = MFMA16(a0_, ldsfrag(xq_, ks_ * 64), qk_); } \
            const int j0_ = jt_ * 16 + 4 * h4; const f32x4 gcj_ = *(const LAS f32x4*)((gsp) + j0_); float am_[4], qm_[4]; \
            _Pragma("unroll") for (int r_ = 0; r_ < 4; ++r_) { const int j_ = j0_ + r_; const bool valid_ = d ? (j_ >= i_) : (j_ <= i_); const float e_ = __expf(gci_ - gcj_[r_]); \
                am_[r_] = (valid_ && j_ != i_) ? -bi_ * kk_[r_] * e_ : 0.f; qm_[r_] = valid_ ? qk_[r_] * e_ : 0.f; } \
            u32x2 pa_, pm_; pa_.x = pk2(am_[0], am_[1]); pa_.y = pk2(am_[2], am_[3]); pm_.x = pk2(qm_[0], qm_[1]); pm_.y = pk2(qm_[2], qm_[3]); \
            *(LAS u32x2*)((setb) + O_AM + i_ * PA + j0_ * 2) = pa_; *(LAS u32x2*)((setb) + O_QM + i_ * PA + j0_ * 2) = pm_; \
            if (jt_ == it_) { LAS float* nd_ = (LAS float*)((setb) + O_ND); const int ipos_ = d ? 15 - l16 : l16; \
                _Pragma("unroll") for (int r_ = 0; r_ < 4; ++r_) { const int jpos_ = d ? 15 - (4 * h4 + r_) : 4 * h4 + r_; nd_[(it_ * 16 + ipos_) * 16 + jpos_] = am_[r_]; } } } } while (0)
        __syncthreads();
        if (helper) { GD_FETCH(0); if (w == 5) gdn_gates(ga, gb, nea, dtb, sm, ln, d); GD_STAGE(lds); GD_FETCH(1); }
        __syncthreads();
        if (helper) GD_STAGE_A(lds, sm, w - 4, 10, 4);
        __syncthreads();
        for (int step = 0; step < 68; ++step) {
            const int X = step & 1; LAS unsigned char* cur = lds + X * SETB; LAS unsigned char* nxt = lds + (X ^ 1) * SETB;
            LAS float* gs = sm + X * GD_GSET; LAS float* gsn = sm + (X ^ 1) * GD_GSET;
            LAS unsigned char* qh = cur + O_Q; LAS unsigned char* kh = cur + O_K; LAS unsigned char* vv = cur + O_V; LAS unsigned char* AM = cur + O_AM; LAS unsigned char* QM = cur + O_QM; LAS unsigned char* DINV = cur + O_DI;
            const int row0 = GD_ROW0(step);
            s16x4v sf[8];
            if (!helper) { for (int sr_ = 0; sr_ < (SUBDUP == 22 ? 2 : 1); ++sr_) {
#pragma unroll
                for (int dt = 0; dt < 8; ++dt) sf[dt] = pack4(S[dt]);
#pragma unroll
                for (int Tp = 0; Tp < 4; ++Tp) { const int ro = 16 * (d ? 3 - Tp : Tp);
                    f32x4 ksv = (f32x4){0.f, 0.f, 0.f, 0.f}, qsv = ksv;
                    LAS unsigned char* ka = kh + (ro + l16) * PK + 8 * h4; LAS unsigned char* qa = qh + (ro + l16) * PQ + 8 * h4;
#pragma unroll
                    for (int dt = 0; dt < 8; ++dt) { ksv = MFMA16K16(lds8(ka + 32 * dt), sf[dt], ksv); qsv = MFMA16K16(lds8(qa + 32 * dt), sf[dt], qsv); }
                    const s16x4v v4 = ldstr1(vv + (ro + 4 * h4 + tq) * PV + (16 * w + 4 * tp) * 2);
                    const f32x4 be = *(const LAS f32x4*)(gs + 64 + ro + 4 * h4), eg = *(const LAS f32x4*)(gs + 128 + ro + 4 * h4);
#pragma unroll
                    for (int r = 0; r < 4; ++r) { Rt[Tp][r] = be[r] * (bf2f((bf16_t)v4[r]) - eg[r] * ksv[r]); Qs[Tp][r] = eg[r] * qsv[r]; }
                    asm volatile("" ::: "memory"); } }
            } else {
                if (step + 1 < 68) { GD_STAGE(nxt); if (SUBDUP == 23) GD_STAGE(nxt); if (w == 5) { gdn_gates(ga, gb, nea, dtb, gsn, ln, d); if (SUBDUP == 24) gdn_gates(ga, gb, nea, dtb, gsn, ln, d); } if (step + 2 < 68) GD_FETCH(step + 2); }
                if (w == 4) { const int I = ln >> 4, c = ln & 15, cp = d ? 15 - c : c; LAS float* nAd = (LAS float*)(cur + O_ND);
                    float Dr[16];
                    Dr[0] = (cp == 0) ? 1.f : 0.f;
                    f32x4 nx[4];
                    nx[0] = *(const LAS f32x4*)(nAd + (I * 16 + 1) * 16);
#pragma unroll
                    for (int ip = 1; ip < 16; ++ip) {
                        float av[16];
#pragma unroll
                        for (int q4 = 0; q4 < 4; ++q4) if (q4 * 4 < ip) { av[q4 * 4] = nx[q4][0]; av[q4 * 4 + 1] = nx[q4][1]; av[q4 * 4 + 2] = nx[q4][2]; av[q4 * 4 + 3] = nx[q4][3]; }
                        if (ip + 1 < 16) {
#pragma unroll
                            for (int q4 = 0; q4 < 4; ++q4) if (q4 * 4 < ip + 1) nx[q4] = *(const LAS f32x4*)(nAd + (I * 16 + ip + 1) * 16 + q4 * 4); }
                        float s0 = (cp == ip) ? 1.f : 0.f, s1 = 0.f;
#pragma unroll
                        for (int jq = 0; jq + 1 < ip; ++jq) { if (jq & 1) s1 += av[jq] * Dr[jq]; else s0 += av[jq] * Dr[jq]; }
                        Dr[ip] = (s0 + s1) + av[ip - 1] * Dr[ip - 1]; }
#pragma unroll
                    for (int ip = 0; ip < 16; ++ip) { const int r = d ? 15 - ip : ip; *(LAS bf16_t*)(DINV + (16 * I + r) * PD + 2 * c) = (bf16_t)(pk2(Dr[ip], 0.f) & 0xffffu); } }
            }
            lds_barrier();
            if (!helper) { s16x4v vf[4]; f32x4 vn[4];
#pragma unroll
                for (int Tp = 0; Tp < 4; ++Tp) { const int ro = 16 * (d ? 3 - Tp : Tp);
                    f32x4 Xv = Rt[Tp];
#pragma unroll
                    for (int Jp = 0; Jp < Tp; ++Jp) { const int co = 16 * (d ? 3 - Jp : Jp); Xv = MFMA16K16(lds8(AM + (ro + l16) * PA + (co + 4 * h4) * 2), vf[Jp], Xv); }
                    const s16x4v xf = pack4(Xv);
                    vn[Tp] = MFMA16K16(lds8(DINV + (ro + l16) * PD + 8 * h4), xf, ((f32x4){0.f, 0.f, 0.f, 0.f}));
                    vf[Tp] = pack4(vn[Tp]); }
#pragma unroll
                for (int Tp = 0; Tp < 4; ++Tp) { const int ro = 16 * (d ? 3 - Tp : Tp);
                    f32x4 o = Qs[Tp];
#pragma unroll
                    for (int Jp = 0; Jp <= Tp; ++Jp) { const int co = 16 * (d ? 3 - Jp : Jp); o = MFMA16K16(lds8(QM + (ro + l16) * PA + (co + 4 * h4) * 2), vf[Jp], o); }
#pragma unroll
                    for (int r = 0; r < 4; ++r) O[(size_t)(row0 + ro + 4 * h4 + r) * 1024 + h * 128 + eh * 64 + 16 * w + l16] = (bf16_t)(pk2(o[r], 0.f) & 0xffffu);
                    asm volatile("" ::: "memory"); }
                const float gend = gs[256];
                s16x4v vsf[4];
#pragma unroll
                for (int Jp = 0; Jp < 4; ++Jp) { const int co = 16 * (d ? 3 - Jp : Jp); const f32x4 ee = *(const LAS f32x4*)(gs + 192 + co + 4 * h4); vsf[Jp] = pack4(vn[Jp] * ee); }
#pragma unroll
                for (int dt = 0; dt < 8; ++dt) { S[dt] = S[dt] * gend;
#pragma unroll
                    for (int Jp = 0; Jp < 4; ++Jp) { const int co = 16 * (d ? 3 - Jp : Jp); S[dt] = MFMA16K16(ldstr1(kh + (co + 4 * h4 + tq) * PK + (16 * dt + 4 * tp) * 2), vsf[Jp], S[dt]); }
                    if (dt & 1) asm volatile("" ::: "memory"); }
                if (step + 1 < 68 && GD_HT + w < 10) GD_STAGE_A(nxt, gsn, GD_HT + w, GD_HT + w + 1, 1);
            } else if (step + 1 < 68) { GD_STAGE_A(nxt, gsn, w - 4, GD_HT, 4); }
            lds_barrier();
        }
#undef GD_ROW0
#undef GD_FETCH
#undef GD_STAGE
#undef GD_STAGE_A
    }
}

#ifndef DUP_PHASE
#define DUP_PHASE -1
#endif
constexpr int NPH_LAYER = 19, PH_FINAL = 2 + DEPTH * NPH_LAYER, NPHASE = PH_FINAL + 1;
template <class Epi>
DI void run_gemm(int tid, int c, LAS unsigned char* lds, const bf16_t* A, const bf16_t* Bt, int M, int N, const Epi& E) {
    pg8::Gemm g{A, Bt, M, N, 1024, 1024, 1 << 20, 0, tid}; pg8::StaticOrder S; S.init(M, N, (int)gridDim.x, c);
#if defined(GEMM_STAGGER)
    if (blockIdx.x & 8) { const unsigned long long t0 = __builtin_amdgcn_s_memrealtime(); while (__builtin_amdgcn_s_memrealtime() - t0 < GEMM_STAGGER) __builtin_amdgcn_s_sleep(8); }
#endif
    pg8::gemm_phase<Epi, pg8::StaticOrder, false>(lds, g, S, E, nullptr);
}
template <class Epi>
DI void run_gemm_g(int tid, LAS unsigned char* lds, const bf16_t* A, int lda, int K, const bf16_t* Bt, int M, int N, int pmg, size_t gstride, const Epi& E) {
    pg8::Gemm g{A, Bt, M, N, K, lda, pmg, gstride, tid}; pg8::StaticOrder S; S.init(M, N, (int)gridDim.x, (int)blockIdx.x);
    pg8::gemm_phase<Epi, pg8::StaticOrder, false>(lds, g, S, E, nullptr);
}
__global__ void __launch_bounds__(NT, 2) hy_fwd(Args ka) {
    extern __shared__ __attribute__((aligned(16))) unsigned char lds_raw[];
    LAS unsigned char* lds = (LAS unsigned char*)lds_raw;
    volatile LAS unsigned* xbw = (volatile LAS unsigned*)(lds + LDS_BYTES - 256);
    if (threadIdx.x < 4) xbw[threadIdx.x] = 0u;
    __syncthreads();
    const int lo = ka.ph_lo, hi = ka.ph_hi;
    const int s_wid = __builtin_amdgcn_readfirstlane((int)(threadIdx.x >> 6));
    XcdBarrier bar; bar.bar = (unsigned*)(ka.ws + WS_CTL); bar.x = 0u; bar.st = xbw; bar.wid = s_wid;
    if (hi - lo > 1) bar = xcd_barrier_post((unsigned*)(ka.ws + WS_CTL), xbw, s_wid);
#ifdef PH_ONLY
#define PHEN(p) ((p) == PH_ONLY)
#else
#define PHEN(p) 1
#endif
#define IN(k) (lo <= (k) && (k) < hi)
#define INL(p) (PHEN(p) && IN(pb + (p)))
#define REPS(p) ((DUP_PHASE == (p)) ? 2 : 1)
#define SEAM(k) do { if (IN((k) + 1)) { xcd_barrier(bar); if (DUP_PHASE == 200) xcd_barrier(bar); } } while (0)
#define PH_LOAD \
    Args a; __builtin_memcpy(&a, args_ptr(), sizeof(Args)); a.wid = s_wid; \
    unsigned char* ws = a.ws; \
    float* MOD = (float*)(ws + WS_MOD); float* XCTX = (float*)(ws + WS_XCTX); \
    bf16_t* H = (bf16_t*)(ws + WS_H); bf16_t* MERGED = (bf16_t*)(ws + WS_MERGED); \
    bf16_t* WB0 = (bf16_t*)(ws + WS_WB0); bf16_t* WB1 = (bf16_t*)(ws + WS_WB1); bf16_t* WB2 = (bf16_t*)(ws + WS_WB2); bf16_t* M5B = (bf16_t*)(ws + WS_R + R_M5); \
    unsigned char* R = ws + WS_R; \
    bf16_t* P0 = (bf16_t*)(R + R_P0); bf16_t* P1 = (bf16_t*)(R + R_P1); bf16_t* P2 = (bf16_t*)(R + R_P2); bf16_t* OF = (bf16_t*)(R + R_OF); bf16_t* OB = (bf16_t*)(R + R_OB); \
    float* GATE2 = (float*)(R + R_G2); \
    float* GATE1 = (float*)(ws + WS_MERGED); bf16_t* HALO = (bf16_t*)(ws + WS_MERGED + SZ_GATE);     \
    float* MODP = (float*)R; \
    bf16_t* AX = (bf16_t*)(R + R5_AX); bf16_t* SZ5 = (bf16_t*)(R + R5_SZ); bf16_t* G15 = (bf16_t*)(R + R5_G1); bf16_t* GLUA = (bf16_t*)(R + R5_GLUA); bf16_t* YBR = (bf16_t*)R; \
    bf16_t* CW1 = (bf16_t*)(ws + WS_H); bf16_t* CW2 = (bf16_t*)(ws + WS_H + SZ_CW1); float* SEG5 = (float*)(ws + WS_H + SZ_CW1 + SZ_CW2); \
    const float* xlat_src = l == 0 ? a.in[I_X] : a.out; const float* xctx_src = l == 0 ? a.in[I_CTX] : XCTX; const float* modl = MOD + (size_t)l * 9 * 3072; \
    (void)MOD; (void)XCTX; (void)H; (void)MERGED; (void)WB0; (void)WB1; (void)WB2; (void)M5B; (void)P0; (void)P1; (void)P2; (void)OF; (void)OB; (void)GATE2; (void)GATE1; (void)HALO; (void)MODP; (void)AX; (void)SZ5; (void)G15; (void)GLUA; (void)YBR; (void)CW1; (void)CW2; (void)SEG5; (void)xlat_src; (void)xctx_src; (void)modl;
    LAS float* ldsf = (LAS float*)lds;

    { const int l = 0;
    if (PHEN(100) && IN(0)) { PH_LOAD; ph_modp(a, MODP, ldsf); SEAM(0); }
    if (PHEN(101) && IN(1)) { PH_LOAD; ph_mod(a, MODP, MOD); SEAM(1); } }
    for (int l = 0; l < DEPTH; ++l) {
        const int pb = 2 + l * NPH_LAYER;
        const int lro = (l == DEPTH - 1) ? CTXROWS : 0;
        const int crot = (gridDim.x == 256) ? (int)((blockIdx.x + 224u) & 255u) : (int)blockIdx.x;
        if (INL(0)) { PH_LOAD; ph_norm(a, l, xlat_src, xctx_src, modl, H); ph_cvt(wdesc(a, l, 0), WB0, ldsf); SEAM(pb + 0); }
        if (INL(1)) { PH_LOAD; EpiProj E{P0, 0, GATE1, 12, HALO, 0}; run_gemm(ltid(a), (int)blockIdx.x, lds, H, WB0, MROWS, 3328, E); SEAM(pb + 1); }
        if (INL(2)) { PH_LOAD; ph_gdn_conv(a, l, P0, HALO, lds); ph_cvt(wdesc(a, l, 1), WB1, ldsf); SEAM(pb + 2); }
        if (INL(3)) { PH_LOAD; ph_gdn_scan_pipe(a, l, P0, P1, P2, GATE1, OF, OB, lds); SEAM(pb + 3); }
        if (INL(4)) { PH_LOAD; ph_cvt(wdesc(a, l, 6), WB2, ldsf); EpiProj E{P0, 9, nullptr, -1, nullptr, lro}; run_gemm(ltid(a), (int)blockIdx.x, lds, H + (size_t)lro * 1024, WB1, MROWS - lro, 2048, E); SEAM(pb + 4); }
        if (INL(5)) { PH_LOAD; ph_gdn_post(a, l, OF, OB, P0); ph_cvt(wdesc(a, l, 3), WB0, ldsf); SEAM(pb + 5); }
        if (INL(6)) { PH_LOAD; ph_cvt(wdesc(a, l, 2), WB1, ldsf);
            { EpiBranch E{P1, MERGED, 1, lro}; run_gemm(ltid(a), (int)blockIdx.x, lds, OF + (size_t)lro * 1024, WB2, MROWS - lro, 1024, E); }
            { EpiProj E{M5B, 38, nullptr, -1, nullptr, lro}; run_gemm(ltid(a), crot, lds, H + (size_t)lro * 1024, WB0, MROWS - lro, 3072, E); }
            SEAM(pb + 6); }
        if (INL(7)) { PH_LOAD; ph_cvt(wdesc(a, l, 8), WB2, ldsf); EpiProj E{P0, 0, GATE2, 12, nullptr, 0}; run_gemm(ltid(a), (int)blockIdx.x, lds, H, WB1, MROWS, 3328, E); SEAM(pb + 7); }
        if (INL(8)) { PH_LOAD; ph_ml_scan_mfma(a, l, P0, P1, P2, GATE2, OF, OB, lds); SEAM(pb + 8); }
        if (INL(9)) { PH_LOAD; ph_ml_post(a, l, OF, OB, M5B, M5B + SZ_ACT / 2); ph_cvt(wdesc(a, l, 4), WB0, ldsf); SEAM(pb + 9); }
        if (INL(10)) { PH_LOAD; ph_cvt(wdesc(a, l, 5), WB1, ldsf);
            { EpiBranch E{M5B + 2 * (SZ_ACT / 2), MERGED, 0, lro}; run_gemm(ltid(a), (int)blockIdx.x, lds, OF + (size_t)lro * 1024, WB2, MROWS - lro, 1024, E); }
            { EpiS1 E{AX, SZ5, G15}; run_gemm(ltid(a), crot, lds, H, WB0, MROWS, 3072, E); }
            SEAM(pb + 10); }
        if (INL(11)) { PH_LOAD; ph_s5_consts(a, l, CW1, CW2, lds); ph_cvt(wdesc(a, l, 7), WB2, ldsf); SEAM(pb + 11); }
        if (INL(12)) { PH_LOAD; EpiS5L E{AX}; run_gemm_g(ltid(a), lds, AX, 512, 256, CW1, 64 * S5_RG, 256, S5_PMG, (size_t)256 * 256 * 2, E); SEAM(pb + 12); }
        if (INL(13)) { PH_LOAD; ph_s5_carry1(a, l, AX, SEG5); SEAM(pb + 13); }
        if (INL(14)) { PH_LOAD; ph_s5_carry2(a, l, AX, SEG5); SEAM(pb + 14); }
        if (INL(15)) { PH_LOAD; EpiS5Y E{AX, GLUA, a.in[I_SD] + l * 1024}; run_gemm_g(ltid(a), lds, AX, 512, 512, CW2, 64 * S5_RG, 256, S5_PMG, (size_t)256 * 512 * 2, E); SEAM(pb + 15); }
        if (INL(16)) { PH_LOAD; ph_cvt(wdesc(a, l, 9), WB0, ldsf); EpiGlu E{SZ5, YBR, a.in[I_SBGLU] + l * 2048, lro}; run_gemm(ltid(a), (int)blockIdx.x, lds, GLUA + (size_t)lro * 1024, WB1, MROWS - lro, 2048, E); SEAM(pb + 16); }
        if (INL(17)) { PH_LOAD; EpiBranch E{G15, MERGED, 0, lro}; run_gemm(ltid(a), (int)blockIdx.x, lds, YBR + (size_t)lro * 1024, WB2, MROWS - lro, 1024, E); SEAM(pb + 17); }
        if (INL(18)) { PH_LOAD;
            EpiOut E{xlat_src, a.out, xctx_src, XCTX, modl, l, lro};
            run_gemm(ltid(a), (int)blockIdx.x, lds, MERGED + (size_t)lro * 1024, WB0, MROWS - lro, 1024, E);
            SEAM(pb + 18);
        }
    }
    if (PHEN(102) && IN(PH_FINAL)) { const int l = 0; PH_LOAD; ph_final(a, a.out); }
#undef IN
#undef SEAM
#undef PH_LOAD
}
}

#ifndef MK_LAUNCHES
#define MK_LAUNCHES 1
#endif
extern "C" void kernel_launch(void* const* d_in, const int* in_sizes, int n_in, void* d_out, int out_size, void* d_ws, size_t ws_size, hipStream_t stream) {
    static int grid = 0;
    if (grid == 0) {
        if (n_in != 28 || out_size != hy::NBATCH * hy::SEQ * hy::D || ws_size < hy::WS_END) { fprintf(stderr, "kernel_launch: unexpected shapes (n_in %d, out %d, ws %zu < %zu)\n", n_in, out_size, ws_size, (size_t)hy::WS_END); grid = -1; return; }
        int dev = 0, cus = 0, per_cu = 0;
        if (hipGetDevice(&dev) != hipSuccess || hipDeviceGetAttribute(&cus, hipDeviceAttributeMultiprocessorCount, dev) != hipSuccess) { grid = -1; return; }
        if (hipFuncSetAttribute((const void*)hy::hy_fwd, hipFuncAttributeMaxDynamicSharedMemorySize, hy::LDS_BYTES) != hipSuccess) { fprintf(stderr, "kernel_launch: hipFuncSetAttribute failed\n"); grid = -1; return; }
        if (hipOccupancyMaxActiveBlocksPerMultiprocessor(&per_cu, (const void*)hy::hy_fwd, hy::NT, hy::LDS_BYTES) != hipSuccess || per_cu < 1) { fprintf(stderr, "kernel_launch: occupancy query says %d\n", per_cu); (void)hipGetLastError(); }
        grid = cus;
    }
    if (grid < 0) return;
    (void)hipMemsetAsync((char*)d_ws + hy::WS_CTL, 0, 65536, stream);
    hy::Args a{};
    for (int i = 0; i < 28; ++i) a.in[i] = (const float*)d_in[i];
    a.out = (float*)d_out; a.ws = (unsigned char*)d_ws;
#if MK_LAUNCHES == 1
    a.ph_lo = 0; a.ph_hi = hy::NPHASE;
    hipLaunchKernelGGL(hy::hy_fwd, dim3(grid), dim3(hy::NT), hy::LDS_BYTES, stream, a);
#else
    for (int p = 0; p < hy::NPHASE; ++p) { a.ph_lo = p; a.ph_hi = p + 1; hipLaunchKernelGGL(hy::hy_fwd, dim3(grid), dim3(hy::NT), hy::LDS_BYTES, stream, a); }
#endif
}
```
